# Optimizing an MI355X kernel written in HIP

```python
import math
import jax
import jax.numpy as jnp
from jax import lax
import numpy as np

D_MODEL = 1024
BATCH = 8
SEQ = 4096
DEPTH = 2

GRID_W = 64
CTX_LEN = 256
EPS = 1e-6
N_AB = (DEPTH + 1) // 2
N_RET = DEPTH // 2

GLA_HEADS = 4
GLA_DK = 64
GLA_DV = 128
GLA_RANK = 16
GLA_TAU = 16.0
GLA_CHUNK = 64
AB_QK = GLA_HEADS * GLA_DK
AB_V = GLA_HEADS * GLA_DV
S5_CH = D_MODEL // 2
S5_GROUP = 16
S5_GROUPS = S5_CH // S5_GROUP
S5_P = 64
AB_IN = 2 * AB_QK + 2 * AB_V + 2 * GLA_RANK + S5_CH
AB_MIX = AB_V + S5_CH
RET_HEADS = 4
RET_DK = D_MODEL // RET_HEADS
RET_DV = 2 * RET_DK
RET_CHUNK = 128
RET_QK = RET_HEADS * RET_DK
RET_MIX = RET_HEADS * RET_DV
RET_IN = 2 * RET_QK + 2 * RET_MIX
ROPE_BASE = 10000.0
N_EXPERTS = 32
TOP_K = 4
D_FF = 1024
SWIGLU_LIMIT = 7.0
SWIGLU_ALPHA = 1.702
MOE_BLOCK = 256

kernel_name = 'hybrid_gla_s5_retention_moe_dit'


def rms_norm(x, g):
    xf = x.astype(jnp.float32)
    y = xf * lax.rsqrt(jnp.mean(xf * xf, axis=-1, keepdims=True) + EPS)
    return y * g.astype(jnp.float32)


def modulate(h, shift, scale):
    return h * (1.0 + scale[:, None, :]) + shift[:, None, :]


def chunk_gated_recurrence(q, k, v, log_a, s0, chunk, with_output):
    n = q.shape[2] // chunk

    def blocks(t):
        t = t.astype(jnp.float32)
        return t.reshape(t.shape[0], t.shape[1], n, chunk, t.shape[-1])

    qc, kc, vc = blocks(q), blocks(k), blocks(v)
    b = jnp.cumsum(blocks(log_a), axis=3)
    b_last = b[:, :, :, -1:, :]
    k_state = kc * jnp.exp(b_last - b)
    to_scan = lambda t: jnp.moveaxis(t, 2, 0)
    if with_output:
        q_dec = qc * jnp.exp(b)
        k_inv = kc * jnp.exp(-b)
        lower = jnp.tril(jnp.ones((chunk, chunk), dtype=bool))
        scores = jnp.where(lower, jnp.einsum('bhnik,bhnjk->bhnij', q_dec, k_inv), 0.0)
        o_intra = jnp.einsum('bhnij,bhnjv->bhniv', scores, vc)

        def step(s, xs):
            q_b, k_b, v_b, d_b = xs
            o_b = jnp.einsum('bhik,bhkv->bhiv', q_b, s)
            s = s * jnp.exp(jnp.swapaxes(d_b, -1, -2)) + jnp.einsum('bhjk,bhjv->bhkv', k_b, v_b)
            return s, o_b

        s_fin, o_inter = lax.scan(step, s0, (to_scan(q_dec), to_scan(k_state), to_scan(vc), to_scan(b_last)))
        o = o_intra + jnp.moveaxis(o_inter, 0, 2)
        return o.reshape(o.shape[0], o.shape[1], n * chunk, o.shape[-1]), s_fin

    def step_state(s, xs):
        k_b, v_b, d_b = xs
        return s * jnp.exp(jnp.swapaxes(d_b, -1, -2)) + jnp.einsum('bhjk,bhjv->bhkv', k_b, v_b), None

    s_fin, _ = lax.scan(step_state, s0, (to_scan(k_state), to_scan(vc), to_scan(b_last)))
    return None, s_fin


def prefix_recurrence(ctx_in, lat_in, chunk, reverse, ctx_out):
    flip = (lambda t: jnp.flip(t, axis=2)) if reverse else (lambda t: t)
    q_c, k_c, v_c, a_c = (flip(t) for t in ctx_in)
    q_l, k_l, v_l, a_l = (flip(t) for t in lat_in)
    s0 = jnp.zeros((k_c.shape[0], k_c.shape[1], k_c.shape[-1], v_c.shape[-1]), jnp.float32)
    o_c, s_c = chunk_gated_recurrence(q_c, k_c, v_c, a_c, s0, chunk, ctx_out)
    o_l, _ = chunk_gated_recurrence(q_l, k_l, v_l, a_l, s_c, chunk, True)
    return (flip(o_c) if ctx_out else None), flip(o_l)


def gla_heads(q, k, v, low, wa, ba):
    b, n, _ = q.shape

    def heads(t, dh):
        return t.reshape(b, n, GLA_HEADS, dh).transpose(0, 2, 1, 3)

    lows = jnp.split(low, 2, axis=-1)
    log_a = [heads(jax.nn.log_sigmoid((lows[d] @ wa[d] + ba[d]).astype(jnp.float32)) / GLA_TAU, GLA_DK)
             for d in range(2)]
    return heads(q, GLA_DK) * GLA_DK ** -0.5, heads(k, GLA_DK), heads(v, GLA_DV), log_a


def gla_output(o, g, norm_g):
    b, h, n, dv = o.shape
    o = o * lax.rsqrt(jnp.mean(o * o, axis=-1, keepdims=True) + EPS) * norm_g.astype(jnp.float32)
    return o.transpose(0, 2, 1, 3).reshape(b, n, h * dv) * jax.nn.silu(g.astype(jnp.float32))


def zoh(lam_re, lam_im, log_step):
    step = jnp.exp(log_step.astype(jnp.float32))[:, None]
    lam_re, lam_im = lam_re.astype(jnp.float32), lam_im.astype(jnp.float32)
    mag = jnp.exp(lam_re * step)
    lb_re, lb_im = mag * jnp.cos(lam_im * step), mag * jnp.sin(lam_im * step)
    den = lam_re * lam_re + lam_im * lam_im
    f_re = ((lb_re - 1.0) * lam_re + lb_im * lam_im) / den
    f_im = (lb_im * lam_re - (lb_re - 1.0) * lam_im) / den
    return lb_re, lb_im, f_re, f_im


def complex_diag_scan(a_re, a_im, b_re, b_im):
    n = b_re.shape[0]
    a_re = jnp.broadcast_to(a_re[None, None], (n, 1) + a_re.shape)
    a_im = jnp.broadcast_to(a_im[None, None], (n, 1) + a_im.shape)

    def combine(e1, e2):
        a1r, a1i, b1r, b1i = e1
        a2r, a2i, b2r, b2i = e2
        return (a2r * a1r - a2i * a1i, a2r * a1i + a2i * a1r,
                a2r * b1r - a2i * b1i + b2r, a2r * b1i + a2i * b1r + b2i)

    _, _, s_re, s_im = lax.associative_scan(combine, (a_re, a_im, b_re, b_im), axis=0)
    return s_re, s_im


def s5_bidirectional(u_ctx, u_lat, lam_re, lam_im, log_step, b_re, b_im, c_re, c_im, d_skip, glu_w, glu_b, ctx_out):
    def groups(u):
        return u.astype(jnp.float32).reshape(u.shape[0], u.shape[1], S5_GROUPS, S5_GROUP)

    uc, ul = groups(u_ctx), groups(u_lat)
    y_c, y_l = [], []
    for d in range(2):
        lb_re, lb_im, f_re, f_im = zoh(lam_re[d], lam_im[d], log_step[d])
        bb_re = f_re[..., None] * b_re - f_im[..., None] * b_im
        bb_im = f_re[..., None] * b_im + f_im[..., None] * b_re

        def drive(u):
            br = jnp.einsum('blgc,gpc->lbgp', u, bb_re)
            bi = jnp.einsum('blgc,gpc->lbgp', u, bb_im)
            return (br[::-1], bi[::-1]) if d == 1 else (br, bi)

        def readout(s_re, s_im):
            y = jnp.einsum('lbgp,gcp->blgc', s_re, c_re[d]) - jnp.einsum('lbgp,gcp->blgc', s_im, c_im[d])
            return y[:, ::-1] if d == 1 else y

        sc_re, sc_im = complex_diag_scan(lb_re, lb_im, *drive(uc))
        bl_re, bl_im = drive(ul)
        bl_re = bl_re.at[0].add(lb_re * sc_re[-1] - lb_im * sc_im[-1])
        bl_im = bl_im.at[0].add(lb_re * sc_im[-1] + lb_im * sc_re[-1])
        sl_re, sl_im = complex_diag_scan(lb_re, lb_im, bl_re, bl_im)
        y_l.append(readout(sl_re, sl_im))
        if ctx_out:
            y_c.append(readout(sc_re, sc_im))

    def finish(ys, u):
        y = ys[0] + ys[1] + d_skip.astype(jnp.float32).reshape(S5_GROUPS, S5_GROUP) * u
        y = jax.nn.gelu(y.reshape(y.shape[0], y.shape[1], S5_CH))
        return y * jax.nn.sigmoid(y @ glu_w + glu_b)

    return (finish(y_c, uc) if ctx_out else None), finish(y_l, ul)


def mixer_gla_s5(h_ctx, h_lat, w_in, w_out, gla_wa, gla_ba, gla_norm_g, lam_re, lam_im, log_step,
                 b_re, b_im, c_re, c_im, d_skip, glu_w, glu_b, ctx_out):
    split_at = [AB_QK, 2 * AB_QK, 2 * AB_QK + AB_V, 2 * AB_QK + 2 * AB_V, 2 * AB_QK + 2 * AB_V + 2 * GLA_RANK]
    q_c, k_c, v_c, g_c, low_c, u_c = jnp.split(h_ctx @ w_in, split_at, axis=-1)
    q_l, k_l, v_l, g_l, low_l, u_l = jnp.split(h_lat @ w_in, split_at, axis=-1)
    qc, kc, vc, la_c = gla_heads(q_c, k_c, v_c, low_c, gla_wa, gla_ba)
    ql, kl, vl, la_l = gla_heads(q_l, k_l, v_l, low_l, gla_wa, gla_ba)
    outs = [prefix_recurrence((qc, kc, vc, la_c[d]), (ql, kl, vl, la_l[d]), GLA_CHUNK, d == 1, ctx_out)
            for d in range(2)]
    s5_c, s5_l = s5_bidirectional(u_c, u_l, lam_re, lam_im, log_step, b_re, b_im, c_re, c_im,
                                  d_skip, glu_w, glu_b, ctx_out)
    y_lat = jnp.concatenate([gla_output(outs[0][1] + outs[1][1], g_l, gla_norm_g), s5_l], axis=-1) @ w_out
    y_ctx = None
    if ctx_out:
        y_ctx = jnp.concatenate([gla_output(outs[0][0] + outs[1][0], g_c, gla_norm_g), s5_c], axis=-1) @ w_out
    return y_ctx, y_lat


def axial_rope(t, row, col):
    half = t.shape[-1] // 2
    n_freq = half // 2
    inv_freq = ROPE_BASE ** (-jnp.arange(n_freq, dtype=jnp.float32) / n_freq)

    def rotate(tp, pos):
        ang = pos.astype(jnp.float32)[:, None] * inv_freq
        cos, sin = jnp.cos(ang)[None, :, None, :], jnp.sin(ang)[None, :, None, :]
        t1, t2 = tp[..., :n_freq], tp[..., n_freq:]
        return jnp.concatenate([t1 * cos - t2 * sin, t1 * sin + t2 * cos], axis=-1)

    return jnp.concatenate([rotate(t[..., :half], row), rotate(t[..., half:], col)], axis=-1)


def mixer_retention(h_ctx, h_lat, w_in, w_out, decay_logit, norm_g, row, col, ctx_out):
    split_at = [RET_QK, 2 * RET_QK, 2 * RET_QK + RET_MIX]

    def prep(h, rope):
        b, n, _ = h.shape
        q, k, v, g = jnp.split(h @ w_in, split_at, axis=-1)
        q = q.reshape(b, n, RET_HEADS, RET_DK)
        k = k.reshape(b, n, RET_HEADS, RET_DK)
        v = v.reshape(b, n, RET_HEADS, RET_DV)
        if rope:
            q, k = axial_rope(q, row, col), axial_rope(k, row, col)
        k = k * RET_DK ** -0.5
        return q.transpose(0, 2, 1, 3), k.transpose(0, 2, 1, 3), v.transpose(0, 2, 1, 3), g

    qc, kc, vc, gc = prep(h_ctx, False)
    ql, kl, vl, gl = prep(h_lat, True)
    log_gamma = jax.nn.log_sigmoid(decay_logit.astype(jnp.float32))

    def decay(d, n):
        return jnp.broadcast_to(log_gamma[d][None, :, None, None], (1, RET_HEADS, n, 1))

    outs = [prefix_recurrence((qc, kc, vc, decay(d, qc.shape[2])), (ql, kl, vl, decay(d, ql.shape[2])),
                              RET_CHUNK, d == 1, ctx_out) for d in range(2)]

    def out(o, g):
        b, h, n, dv = o.shape
        mu = jnp.mean(o, axis=-1, keepdims=True)
        var = jnp.mean(jnp.square(o - mu), axis=-1, keepdims=True)
        o = ((o - mu) * lax.rsqrt(var + EPS)).transpose(0, 2, 1, 3).reshape(b, n, h * dv)
        return (o * norm_g.astype(jnp.float32) * jax.nn.silu(g.astype(jnp.float32))) @ w_out

    y_lat = out(outs[0][1] + outs[1][1], gl)
    y_ctx = out(outs[0][0] + outs[1][0], gc) if ctx_out else None
    return y_ctx, y_lat


def moe_ffn(h, w_router, b_router, w_gu, b_gu, w_down, b_down):
    n, d = h.shape
    logits = (h @ w_router + b_router).astype(jnp.float32)
    top_logit, top_e = lax.top_k(logits, TOP_K)
    weights = jax.nn.softmax(top_logit, axis=-1)
    flat_e = top_e.reshape(-1)
    order = jnp.argsort(flat_e)
    e_sorted = flat_e[order]
    counts = jnp.bincount(flat_e, length=N_EXPERTS)
    padded = (counts + MOE_BLOCK - 1) // MOE_BLOCK * MOE_BLOCK
    pad_end = jnp.cumsum(padded)
    pad_start = pad_end - padded
    start = jnp.cumsum(counts) - counts
    dest = pad_start[e_sorted] + jnp.arange(n * TOP_K, dtype=jnp.int32) - start[e_sorted]
    n_blocks = (n * TOP_K + MOE_BLOCK - 1) // MOE_BLOCK + N_EXPERTS
    slot_tok = jnp.full((n_blocks * MOE_BLOCK,), n, jnp.int32).at[dest].set((order // TOP_K).astype(jnp.int32))
    slot_w = jnp.zeros((n_blocks * MOE_BLOCK,), jnp.float32).at[dest].set(weights.reshape(-1)[order])
    block_e = jnp.minimum(jnp.searchsorted(pad_end, jnp.arange(n_blocks, dtype=jnp.int32) * MOE_BLOCK,
                                           side='right'), N_EXPERTS - 1)
    h_pad = jnp.concatenate([h, jnp.zeros((1, d), h.dtype)], axis=0)
    xb = h_pad[slot_tok].reshape(n_blocks, MOE_BLOCK, d)

    def expert_block(args):
        x_blk, e = args
        gu = x_blk @ w_gu[e] + b_gu[e]
        gate = jnp.minimum(gu[:, :D_FF], SWIGLU_LIMIT)
        lin = jnp.clip(gu[:, D_FF:], -SWIGLU_LIMIT, SWIGLU_LIMIT)
        act = gate * jax.nn.sigmoid(SWIGLU_ALPHA * gate) * (lin + 1.0)
        return act @ w_down[e] + b_down[e]

    yb = lax.map(expert_block, (xb, block_e)).reshape(-1, d)
    y = jnp.zeros((n + 1, d), yb.dtype).at[slot_tok].add(yb * slot_w[:, None].astype(yb.dtype))
    return y[:n]


def setup_inputs(seed: int = 0) -> dict:
    key = jax.random.key(seed)
    keys = iter(jax.random.split(key, 64))
    f32 = jnp.float32

    def nrm(shape, scale):
        return scale * jax.random.normal(next(keys), shape, f32)

    def gain(shape):
        return 1.0 + nrm(shape, 0.02)

    lam_re = -0.5 + nrm((N_AB, 2, S5_GROUPS, S5_P), 0.01)
    lam_im = math.pi * jnp.arange(S5_P, dtype=f32) + nrm((N_AB, 2, S5_GROUPS, S5_P), 0.01)
    log_step = jax.random.uniform(next(keys), (N_AB, 2, S5_GROUPS), f32, math.log(1e-3), math.log(1e-1))
    ret_logit = jnp.log(2.0 ** (5.0 + jnp.arange(RET_HEADS, dtype=f32)) - 1.0) + nrm((N_RET, 2, RET_HEADS), 0.01)
    return {
        'x': nrm((BATCH, SEQ, D_MODEL), 1.0),
        'c': nrm((BATCH, D_MODEL), 1.0),
        'ctx': nrm((BATCH, CTX_LEN, D_MODEL), 1.0),
        'c_ctx': nrm((D_MODEL,), 1.0),
        'ada_w': nrm((DEPTH, D_MODEL, 6 * D_MODEL), 0.5 * D_MODEL ** -0.5),
        'ada_b': nrm((DEPTH, 6 * D_MODEL), 0.02),
        'norm1_g': gain((DEPTH, D_MODEL)),
        'norm2_g': gain((DEPTH, D_MODEL)),
        'ab_w_in': nrm((N_AB, D_MODEL, AB_IN), D_MODEL ** -0.5),
        'ab_w_out': nrm((N_AB, AB_MIX, D_MODEL), AB_MIX ** -0.5),
        'gla_wa': nrm((N_AB, 2, GLA_RANK, AB_QK), GLA_RANK ** -0.5),
        'gla_ba': nrm((N_AB, 2, AB_QK), 0.01),
        'gla_norm_g': gain((N_AB, GLA_DV)),
        's5_lam_re': lam_re,
        's5_lam_im': lam_im,
        's5_log_step': log_step,
        's5_b_re': nrm((N_AB, S5_GROUPS, S5_P, S5_GROUP), (2 * S5_GROUP) ** -0.5),
        's5_b_im': nrm((N_AB, S5_GROUPS, S5_P, S5_GROUP), (2 * S5_GROUP) ** -0.5),
        's5_c_re': nrm((N_AB, 2, S5_GROUPS, S5_GROUP, S5_P), (2 * S5_P) ** -0.5),
        's5_c_im': nrm((N_AB, 2, S5_GROUPS, S5_GROUP, S5_P), (2 * S5_P) ** -0.5),
        's5_d': nrm((N_AB, S5_CH), 1.0),
        's5_glu_w': nrm((N_AB, S5_CH, S5_CH), S5_CH ** -0.5),
        's5_glu_b': nrm((N_AB, S5_CH), 0.01),
        'ret_w_in': nrm((N_RET, D_MODEL, RET_IN), D_MODEL ** -0.5),
        'ret_w_out': nrm((N_RET, RET_MIX, D_MODEL), RET_MIX ** -0.5),
        'ret_decay_logit': ret_logit,
        'ret_norm_g': gain((N_RET, RET_MIX)),
        'moe_w_router': nrm((DEPTH, D_MODEL, N_EXPERTS), D_MODEL ** -0.5),
        'moe_b_router': nrm((DEPTH, N_EXPERTS), 0.01),
        'moe_w_gu': nrm((DEPTH, N_EXPERTS, D_MODEL, 2 * D_FF), D_MODEL ** -0.5),
        'moe_b_gu': nrm((DEPTH, N_EXPERTS, 2 * D_FF), 0.01),
        'moe_w_down': nrm((DEPTH, N_EXPERTS, D_FF, D_MODEL), D_FF ** -0.5),
        'moe_b_down': nrm((DEPTH, N_EXPERTS, D_MODEL), 0.01),
        'final_norm_g': gain((D_MODEL,)),
    }


def reference(x, c, ctx, c_ctx, ada_w, ada_b, norm1_g, norm2_g,
              ab_w_in, ab_w_out, gla_wa, gla_ba, gla_norm_g,
              s5_lam_re, s5_lam_im, s5_log_step, s5_b_re, s5_b_im, s5_c_re, s5_c_im,
              s5_d, s5_glu_w, s5_glu_b,
              ret_w_in, ret_w_out, ret_decay_logit, ret_norm_g,
              moe_w_router, moe_b_router, moe_w_gu, moe_b_gu, moe_w_down, moe_b_down,
              final_norm_g):
    batch, n_lat, d = x.shape
    n_ctx = ctx.shape[1]
    rows = n_lat // GRID_W
    row = jnp.broadcast_to(jnp.arange(rows, dtype=jnp.int32)[:, None], (rows, GRID_W)).reshape(-1)
    col = jnp.broadcast_to(jnp.arange(GRID_W, dtype=jnp.int32)[None, :], (rows, GRID_W)).reshape(-1)
    x_lat, x_ctx = x, ctx
    for layer in range(DEPTH):
        ctx_out = layer < DEPTH - 1
        i = layer // 2
        mod_lat = (jax.nn.silu(c) @ ada_w[layer] + ada_b[layer]).astype(jnp.float32)
        mod_ctx = (jax.nn.silu(c_ctx)[None, :] @ ada_w[layer] + ada_b[layer]).astype(jnp.float32)
        sh1_l, sc1_l, g1_l, sh2_l, sc2_l, g2_l = jnp.split(mod_lat, 6, axis=-1)
        sh1_c, sc1_c, g1_c, sh2_c, sc2_c, g2_c = jnp.split(mod_ctx, 6, axis=-1)
        h_lat = modulate(rms_norm(x_lat, norm1_g[layer]), sh1_l, sc1_l)
        h_ctx = modulate(rms_norm(x_ctx, norm1_g[layer]), sh1_c, sc1_c)
        if layer % 2 == 0:
            m_ctx, m_lat = mixer_gla_s5(h_ctx, h_lat, ab_w_in[i], ab_w_out[i], gla_wa[i], gla_ba[i], gla_norm_g[i],
                                        s5_lam_re[i], s5_lam_im[i], s5_log_step[i], s5_b_re[i], s5_b_im[i],
                                        s5_c_re[i], s5_c_im[i], s5_d[i], s5_glu_w[i], s5_glu_b[i], ctx_out)
        else:
            m_ctx, m_lat = mixer_retention(h_ctx, h_lat, ret_w_in[i], ret_w_out[i], ret_decay_logit[i],
                                           ret_norm_g[i], row, col, ctx_out)
        x_lat = (x_lat + g1_l[:, None, :] * m_lat).astype(x.dtype)
        h_lat = modulate(rms_norm(x_lat, norm2_g[layer]), sh2_l, sc2_l).reshape(-1, d)
        if ctx_out:
            x_ctx = (x_ctx + g1_c[:, None, :] * m_ctx).astype(ctx.dtype)
            h_ctx = modulate(rms_norm(x_ctx, norm2_g[layer]), sh2_c, sc2_c).reshape(-1, d)
            y = moe_ffn(jnp.concatenate([h_ctx, h_lat], axis=0), moe_w_router[layer], moe_b_router[layer],
                        moe_w_gu[layer], moe_b_gu[layer], moe_w_down[layer], moe_b_down[layer])
            x_ctx = (x_ctx + g2_c[:, None, :] * y[:batch * n_ctx].reshape(x_ctx.shape)).astype(ctx.dtype)
            y_lat = y[batch * n_ctx:]
        else:
            y_lat = moe_ffn(h_lat, moe_w_router[layer], moe_b_router[layer],
                            moe_w_gu[layer], moe_b_gu[layer], moe_w_down[layer], moe_b_down[layer])
        x_lat = (x_lat + g2_l[:, None, :] * y_lat.reshape(x_lat.shape)).astype(x.dtype)
    return rms_norm(x_lat, final_norm_g).astype(x.dtype)
```

```cpp
#include <hip/hip_runtime.h>
#include <cstdio>
#include <cstdint>
#include <cmath>
namespace pg8 {
#define PG8_LAS __attribute__((address_space(3)))
typedef unsigned short bf16_t;
typedef short bf16x8 __attribute__((ext_vector_type(8)));
typedef float f32x4 __attribute__((ext_vector_type(4)));
typedef unsigned u32x4 __attribute__((ext_vector_type(4)));
constexpr int BM = 256, BK = 64, HALF = 128, HTB = HALF * BK * 2  , STAGE_BYTES = 8 * HTB, NXCD = 8, WGM = 8;

__host__ __device__ __forceinline__ int lds_byte(int r, int c) { const int st = (r >> 4) * 2 + (c >> 5), rr = r & 15, cc = c & 31, ob = rr * 64 + cc * 2; return st * 1024 + (ob ^ (((ob >> 9) & 1) << 5)); }
__host__ __device__ __forceinline__ void stage_rc(int b, int& R, int& C) { const int st = b / 1024, sb = b % 1024, swz = sb ^ (((sb >> 9) & 1) << 5); R = (st >> 1) * 16 + swz / 64; C = (st & 1) * 32 + (swz % 64) / 2; }
__host__ __device__ __forceinline__ int perm32(int rho) { const int n = rho >> 4, i = rho & 15; return 8 * (i >> 2) + 4 * n + (i & 3); }

struct Unit { int pm, pn, pb, e; };
struct Gemm { const bf16_t* A; const bf16_t* Bt; int M, N, K; };

struct StaticOrder {
    int nM, nN, nwg, G, c;
    __host__ __device__ void init(int M, int N, int G_, int c_) { nM = M / BM; nN = N / BM; nwg = nM * nN; G = G_; c = c_; }
    __host__ __device__ bool next(int i, Unit& u) const {
        const long L = (long)i * G + c; if (L >= nwg) return false;
        int wgid = (int)L; { const int q = nwg / NXCD, r = nwg % NXCD, xcd = wgid % NXCD, off = wgid / NXCD; wgid = (xcd < r ? xcd * (q + 1) : r * (q + 1) + (xcd - r) * q) + off; }
        const int nig = WGM * nN, gid = wgid / nig, fm = gid * WGM, gsz = (nM - fm) < WGM ? (nM - fm) : WGM;
        u.pm = fm + ((wgid % nig) % gsz); u.pn = (wgid % nig) / gsz; u.pb = u.pn; u.e = 0; return true;
    }
    __device__ __forceinline__ void a_ready(const Unit&) const {}
    __device__ __forceinline__ void done(const Unit&) const {}
};
__device__ __forceinline__ unsigned cvt_pk_bf16(float lo, float hi) { unsigned r; asm volatile("v_cvt_pk_bf16_f32 %0, %1, %2" : "=v"(r) : "v"(lo), "v"(hi)); return r; }
__device__ __forceinline__ float bflo(unsigned w) { return __uint_as_float(w << 16); }
__device__ __forceinline__ float bfhi(unsigned w) { return __uint_as_float(w & 0xffff0000u); }
__device__ __forceinline__ float sigmoidf_(float z) { return 1.0f / (1.0f + __expf(-z)); }

struct EpiStore {
    static constexpr bool PERM = true, AFTER_DRAIN = false;
    bf16_t* O; int ldc;
    __device__ __forceinline__ void operator()(const f32x4 (&acc)[2][2][4][2], const Unit& u, int wr, int wc, int fr, int fq) const {
        const int row0 = u.pm * BM + wr * 64 + fr, col0 = u.pn * BM + wc * 32 + 8 * fq;
#pragma unroll
        for (int ai = 0; ai < 2; ++ai)
#pragma unroll
            for (int m = 0; m < 4; ++m) { bf16_t* rowp = O + (size_t)(row0 + ai * HALF + m * 16) * ldc + col0;
#pragma unroll
                for (int bj = 0; bj < 2; ++bj) { const f32x4 v0 = acc[ai][bj][m][0], v1 = acc[ai][bj][m][1];
                    u32x4 w; w.x = cvt_pk_bf16(v0[0], v0[1]); w.y = cvt_pk_bf16(v0[2], v0[3]); w.z = cvt_pk_bf16(v1[0], v1[1]); w.w = cvt_pk_bf16(v1[2], v1[3]);
                    *(u32x4*)(rowp + bj * HALF) = w; } }
    }
};
struct EpiGlu {
    static constexpr bool PERM = true, AFTER_DRAIN = false;
    const bf16_t* Y; bf16_t* O; int ldo, ocol0; const float* bias;
    __device__ __forceinline__ void operator()(const f32x4 (&acc)[2][2][4][2], const Unit& u, int wr, int wc, int fr, int fq) const {
        const int row0 = u.pm * BM + wr * 64 + fr, col0 = u.pn * BM + wc * 32 + 8 * fq;
        f32x4 bv[2][2];
#pragma unroll
        for (int bj = 0; bj < 2; ++bj)
#pragma unroll
            for (int n = 0; n < 2; ++n) bv[bj][n] = *(const f32x4*)(bias + col0 + bj * HALF + 4 * n);
#pragma unroll
        for (int ai = 0; ai < 2; ++ai)
#pragma unroll
            for (int m = 0; m < 4; ++m) { const size_t row = (size_t)(row0 + ai * HALF + m * 16);
#pragma unroll
                for (int bj = 0; bj < 2; ++bj) { const int c = col0 + bj * HALF;
                    const u32x4 yv = *(const u32x4*)(Y + row * 512 + c);
                    const f32x4 z0 = acc[ai][bj][m][0] + bv[bj][0], z1 = acc[ai][bj][m][1] + bv[bj][1];
                    u32x4 w;
                    w.x = cvt_pk_bf16(bflo(yv.x) * sigmoidf_(z0[0]), bfhi(yv.x) * sigmoidf_(z0[1]));
                    w.y = cvt_pk_bf16(bflo(yv.y) * sigmoidf_(z0[2]), bfhi(yv.y) * sigmoidf_(z0[3]));
                    w.z = cvt_pk_bf16(bflo(yv.z) * sigmoidf_(z1[0]), bfhi(yv.z) * sigmoidf_(z1[1]));
                    w.w = cvt_pk_bf16(bflo(yv.w) * sigmoidf_(z1[2]), bfhi(yv.w) * sigmoidf_(z1[3]));
                    *(u32x4*)(O + row * ldo + ocol0 + c) = w; } }
    }
};
struct EpiResid {
    static constexpr bool PERM = false, AFTER_DRAIN = false;
    const float* base_ctx; const float* base_lat; float* out; const float* gate; int tile0;
    __device__ __forceinline__ void operator()(const f32x4 (&acc)[2][2][4][2], const Unit& u, int wr, int wc, int fr, int fq) const {
        const int gt = u.pm + tile0, bidx = gt < 8 ? 8 : ((gt - 8) >> 4);
        const float* bt = gt < 8 ? base_ctx + (size_t)gt * 256 * 1024 : base_lat + (size_t)(gt - 8) * 256 * 1024;
        float* ot = out + (size_t)gt * 256 * 1024;
        const int col0 = u.pn * BM + wc * 32 + 4 * fq;
        f32x4 gv[2][2];
#pragma unroll
        for (int bj = 0; bj < 2; ++bj)
#pragma unroll
            for (int n = 0; n < 2; ++n) gv[bj][n] = *(const f32x4*)(gate + bidx * 6144 + col0 + bj * HALF + n * 16);
#pragma unroll
        for (int ai = 0; ai < 2; ++ai)
#pragma unroll
            for (int m = 0; m < 4; ++m) { const size_t off = (size_t)(wr * 64 + fr + ai * HALF + m * 16) * 1024 + col0;
#pragma unroll
                for (int bj = 0; bj < 2; ++bj)
#pragma unroll
                    for (int n = 0; n < 2; ++n) { const f32x4 bs = *(const f32x4*)(bt + off + bj * HALF + n * 16);
                        *(f32x4*)(ot + off + bj * HALF + n * 16) = bs + gv[bj][n] * acc[ai][bj][m][n]; } }
    }
};
struct EpiSwiglu {
    static constexpr bool PERM = true, AFTER_DRAIN = false;
    bf16_t* ACT; const float* bgu;
    __device__ __forceinline__ void operator()(const f32x4 (&acc)[2][2][4][2], const Unit& u, int wr, int wc, int fr, int fq) const {
        const int row0 = u.pm * BM + wr * 64 + fr, lc0 = u.pn * 128 + wc * 32 + 8 * fq;
        const float* bb = bgu + (size_t)u.e * 2048 + lc0;
        f32x4 bg[2], bl[2];
#pragma unroll
        for (int n = 0; n < 2; ++n) { bg[n] = *(const f32x4*)(bb + 4 * n); bl[n] = *(const f32x4*)(bb + 1024 + 4 * n); }
#pragma unroll
        for (int ai = 0; ai < 2; ++ai)
#pragma unroll
            for (int m = 0; m < 4; ++m) { float a[8];
#pragma unroll
                for (int n = 0; n < 2; ++n)
#pragma unroll
                    for (int j = 0; j < 4; ++j) { const float g = fminf(acc[ai][0][m][n][j] + bg[n][j], 7.0f); float l = acc[ai][1][m][n][j] + bl[n][j]; l = fminf(fmaxf(l, -7.0f), 7.0f);
                        a[4 * n + j] = g * sigmoidf_(1.702f * g) * (l + 1.0f); }
                u32x4 w; w.x = cvt_pk_bf16(a[0], a[1]); w.y = cvt_pk_bf16(a[2], a[3]); w.z = cvt_pk_bf16(a[4], a[5]); w.w = cvt_pk_bf16(a[6], a[7]);
                *(u32x4*)(ACT + (size_t)(row0 + ai * HALF + m * 16) * 1024 + lc0) = w; }
    }
};
struct EpiDown {
    static constexpr bool PERM = true, AFTER_DRAIN = false;
    bf16_t* Y; const int* prow_slot; const float* w_slot; const float* bdn;
    __device__ __forceinline__ void operator()(const f32x4 (&acc)[2][2][4][2], const Unit& u, int wr, int wc, int fr, int fq) const {
        const int row0 = u.pm * BM + wr * 64 + fr, col0 = u.pn * BM + wc * 32 + 8 * fq;
        f32x4 bv[2][2];
#pragma unroll
        for (int bj = 0; bj < 2; ++bj)
#pragma unroll
            for (int n = 0; n < 2; ++n) bv[bj][n] = *(const f32x4*)(bdn + (size_t)u.e * 1024 + col0 + bj * HALF + 4 * n);
#pragma unroll
        for (int ai = 0; ai < 2; ++ai)
#pragma unroll
            for (int m = 0; m < 4; ++m) { const int slot = prow_slot[row0 + ai * HALF + m * 16];
                if (slot >= 0) { const float ws = w_slot[slot]; bf16_t* rowp = Y + (size_t)slot * 1024 + col0;
#pragma unroll
                    for (int bj = 0; bj < 2; ++bj) { const f32x4 v0 = (acc[ai][bj][m][0] + bv[bj][0]) * ws, v1 = (acc[ai][bj][m][1] + bv[bj][1]) * ws;
                        u32x4 w; w.x = cvt_pk_bf16(v0[0], v0[1]); w.y = cvt_pk_bf16(v0[2], v0[3]); w.z = cvt_pk_bf16(v1[0], v1[1]); w.w = cvt_pk_bf16(v1[2], v1[3]);
                        *(u32x4*)(rowp + bj * HALF) = w; } } }
    }
};
struct MoeOrder {
    const PG8_LAS unsigned char* tile_e; int ntiles, NT, G, c;
    __device__ __forceinline__ bool next(int i, Unit& u) const {
        const int L = i * G + c; if (L >= ntiles * NT) return false;
        const int T = L / NT; u.pm = T; u.pn = L - T * NT; u.e = __builtin_amdgcn_readfirstlane((int)tile_e[T]); u.pb = u.e * NT + u.pn; return true;
    }
    __device__ __forceinline__ void a_ready(const Unit&) const {}
    __device__ __forceinline__ void done(const Unit&) const {}
};
template <class Epi, class Sched, bool ALIGN_EPI = false, bool SP2 = false>
__device__ __forceinline__ void gemm_phase(PG8_LAS unsigned char* lds, const Gemm g, const Sched& S, const Epi& E) {
    const int tid = threadIdx.x, wid = __builtin_amdgcn_readfirstlane(tid >> 6), lane = tid & 63, wr = wid >> 2, wc = wid & 3, fr = lane & 15, fq = lane >> 4;
    const int K = g.K, nt = K / BK;
    unsigned voffA[2], voffB[2];
#pragma unroll
    for (int i = 0; i < 2; ++i) { int R, C; stage_rc(tid * 16 + i * 8192, R, C); const int Rb = Epi::PERM ? ((R & ~31) + perm32(R & 31)) : R;
        voffA[i] = (unsigned)(R * K + C) * 2u; voffB[i] = (unsigned)(Rb * K + C) * 2u; }
    const size_t kstep = (size_t)(BK * 2);
    const size_t hstep = (size_t)HALF * K * 2;
    const size_t tstep = 2 * hstep;
    const unsigned ldsw = (unsigned)wid * 1024u;
    const int aoff = lds_byte(wr * 64 + fr, fq * 8), boff = lds_byte(wc * 32 + fr, fq * 8);
#define PG8_SA(b, h) (((b) * 2 + (h)) * HTB)
#define PG8_SB(b, h) ((4 + (b) * 2 + (h)) * HTB)
#define PG8_STAGE(bufoff, gbase, voff) do { _Pragma("unroll") for (int _i = 0; _i < 2; ++_i) \
        __builtin_amdgcn_global_load_lds((const unsigned*)((const char*)(gbase) + (voff)[_i]), (PG8_LAS unsigned*)(lds + (bufoff) + ldsw + _i * 8192), 16, 0, 0); } while (0)
#define PG8_LDA(dst, b, h) do { _Pragma("unroll") for (int m = 0; m < 4; ++m) _Pragma("unroll") for (int k = 0; k < 2; ++k) dst[m][k] = *(const PG8_LAS bf16x8*)(lds + PG8_SA(b, h) + aoff + m * 2048 + k * 1024); } while (0)
#define PG8_LDB(dst, b, h) do { _Pragma("unroll") for (int n = 0; n < 2; ++n) _Pragma("unroll") for (int k = 0; k < 2; ++k) dst[n][k] = *(const PG8_LAS bf16x8*)(lds + PG8_SB(b, h) + boff + n * 2048 + k * 1024); } while (0)
#define PG8_MMA(ai, bj, At, Bt) do { __builtin_amdgcn_s_setprio(1); _Pragma("unroll") for (int m = 0; m < 4; ++m) _Pragma("unroll") for (int n = 0; n < 2; ++n) _Pragma("unroll") for (int k = 0; k < 2; ++k) \
        acc[ai][bj][m][n] = __builtin_amdgcn_mfma_f32_16x16x32_bf16(Bt[n][k], At[m][k], acc[ai][bj][m][n], 0, 0, 0); __builtin_amdgcn_s_setprio(0); } while (0)
#define PG8_WAIT_V(n) asm volatile("s_waitcnt vmcnt(" #n ")" ::: "memory")
#define PG8_WAIT_L(n) asm volatile("s_waitcnt lgkmcnt(" #n ")" ::: "memory")
#define PG8_BAR __builtin_amdgcn_s_barrier()
#define PG8_SCHED __builtin_amdgcn_sched_barrier(0)
    Unit cur, nxt; int ui = 0;
    if (!S.next(0, cur)) return;
    f32x4 acc[2][2][4][2];
#pragma unroll
    for (int a = 0; a < 2; ++a)
#pragma unroll
        for (int b = 0; b < 2; ++b)
#pragma unroll
            for (int m = 0; m < 4; ++m)
#pragma unroll
                for (int n = 0; n < 2; ++n) acc[a][b][m][n] = (f32x4){0.f, 0.f, 0.f, 0.f};
    bf16x8 At[4][2], B0[2][2], B1[2][2];
    const char* cA = (const char*)g.A + (size_t)cur.pm * tstep; const char* cB = (const char*)g.Bt + (size_t)cur.pb * tstep;
    S.a_ready(cur);
    if constexpr (SP2) {
        PG8_STAGE(PG8_SB(0, 0), cB, voffB); PG8_STAGE(PG8_SB(0, 1), cB + hstep, voffB); PG8_STAGE(PG8_SA(0, 0), cA, voffA); PG8_STAGE(PG8_SA(0, 1), cA + hstep, voffA);
        if (wr == 1) PG8_BAR;
        PG8_WAIT_V(2); PG8_BAR;
        PG8_STAGE(PG8_SB(1, 0), cB + kstep, voffB); PG8_STAGE(PG8_SA(1, 0), cA + kstep, voffA); PG8_STAGE(PG8_SB(1, 1), cB + hstep + kstep, voffB);
        PG8_WAIT_V(6); PG8_BAR;
    } else {
        PG8_STAGE(PG8_SB(0, 0), cB, voffB); PG8_STAGE(PG8_SA(0, 0), cA, voffA); PG8_STAGE(PG8_SB(0, 1), cB + hstep, voffB); PG8_STAGE(PG8_SA(0, 1), cA + hstep, voffA);
        if (wr == 1) PG8_BAR;
        PG8_WAIT_V(4); PG8_BAR;
        PG8_STAGE(PG8_SB(1, 0), cB + kstep, voffB); PG8_STAGE(PG8_SA(1, 0), cA + kstep, voffA); PG8_STAGE(PG8_SB(1, 1), cB + hstep + kstep, voffB);
        PG8_WAIT_V(6); PG8_BAR;
    }
    for (;;) {
        const bool has_next = S.next(ui + 1, nxt);
        const char* nA = has_next ? (const char*)g.A + (size_t)nxt.pm * tstep : cA; const char* nB = has_next ? (const char*)g.Bt + (size_t)nxt.pb * tstep : cB;
        for (int t = 0; t < nt; t += 2) {
            const bool last = (t == nt - 2);
            const char* a1 = cA + (size_t)(t + 1) * kstep;
            const char* a2 = last ? nA : cA + (size_t)(t + 2) * kstep; const char* b2 = last ? nB : cB + (size_t)(t + 2) * kstep;
            const char* a3 = a2 + kstep; const char* b3 = b2 + kstep;
            if (last && has_next) S.a_ready(nxt);
            if constexpr (SP2) {
            PG8_LDB(B0, 0, 0); PG8_LDB(B1, 0, 1); PG8_SCHED; PG8_LDA(At, 0, 0); PG8_STAGE(PG8_SA(1, 1), a1 + hstep, voffA);
            PG8_WAIT_V(8); PG8_WAIT_L(0); PG8_BAR; PG8_MMA(0, 0, At, B0); PG8_MMA(0, 1, At, B1); PG8_BAR; PG8_SCHED;
            PG8_LDA(At, 0, 1); PG8_STAGE(PG8_SB(0, 0), b2, voffB); PG8_STAGE(PG8_SB(0, 1), b2 + hstep, voffB); PG8_STAGE(PG8_SA(0, 0), a2, voffA);
            PG8_WAIT_V(8); PG8_WAIT_L(0); PG8_BAR; PG8_MMA(1, 0, At, B0); PG8_MMA(1, 1, At, B1); PG8_BAR; PG8_SCHED;
            PG8_LDB(B0, 1, 0); PG8_LDB(B1, 1, 1); PG8_SCHED; PG8_LDA(At, 1, 0); PG8_STAGE(PG8_SA(0, 1), a2 + hstep, voffA);
            PG8_WAIT_V(8); PG8_WAIT_L(0); PG8_BAR; PG8_MMA(0, 0, At, B0); PG8_MMA(0, 1, At, B1); PG8_BAR; PG8_SCHED;
            PG8_LDA(At, 1, 1); PG8_STAGE(PG8_SB(1, 0), b3, voffB); PG8_STAGE(PG8_SB(1, 1), b3 + hstep, voffB); PG8_STAGE(PG8_SA(1, 0), a3, voffA);
            PG8_WAIT_V(8); PG8_WAIT_L(0); PG8_BAR; PG8_MMA(1, 0, At, B0); PG8_MMA(1, 1, At, B1); PG8_BAR; PG8_SCHED;
            } else {
            PG8_LDB(B0, 0, 0); PG8_SCHED; PG8_LDA(At, 0, 0); PG8_STAGE(PG8_SA(1, 1), a1 + hstep, voffA);
            PG8_WAIT_L(8); PG8_BAR; PG8_WAIT_L(0); PG8_MMA(0, 0, At, B0); PG8_BAR; PG8_SCHED;
            PG8_LDB(B1, 0, 1); PG8_STAGE(PG8_SB(0, 0), b2, voffB);
            PG8_BAR; PG8_WAIT_L(0); PG8_MMA(0, 1, At, B1); PG8_BAR;
            PG8_LDA(At, 0, 1); PG8_STAGE(PG8_SA(0, 0), a2, voffA);
            PG8_BAR; PG8_WAIT_L(0); PG8_MMA(1, 0, At, B0); PG8_BAR; PG8_SCHED;
            PG8_STAGE(PG8_SB(0, 1), b2 + hstep, voffB);
            PG8_WAIT_V(6); PG8_BAR; PG8_MMA(1, 1, At, B1); PG8_BAR;
            PG8_LDB(B0, 1, 0); PG8_SCHED; PG8_LDA(At, 1, 0); PG8_STAGE(PG8_SA(0, 1), a2 + hstep, voffA);
            PG8_WAIT_L(8); PG8_BAR; PG8_WAIT_L(0); PG8_MMA(0, 0, At, B0); PG8_BAR; PG8_SCHED;
            PG8_LDB(B1, 1, 1); PG8_STAGE(PG8_SB(1, 0), b3, voffB);
            PG8_BAR; PG8_WAIT_L(0); PG8_MMA(0, 1, At, B1); PG8_BAR;
            PG8_LDA(At, 1, 1); PG8_STAGE(PG8_SA(1, 0), a3, voffA);
            PG8_BAR; PG8_WAIT_L(0); PG8_MMA(1, 0, At, B0); PG8_BAR; PG8_SCHED;
            PG8_STAGE(PG8_SB(1, 1), b3 + hstep, voffB);
            PG8_WAIT_V(6); PG8_BAR; PG8_MMA(1, 1, At, B1); PG8_BAR;
            }
        }
        if constexpr (ALIGN_EPI) { if (wr == 0) PG8_BAR; }
        if constexpr (!Epi::AFTER_DRAIN) { E(acc, cur, wr, wc, fr, fq); S.done(cur); }
        if (!has_next) break;
#pragma unroll
        for (int a = 0; a < 2; ++a)
#pragma unroll
            for (int b = 0; b < 2; ++b)
#pragma unroll
                for (int m = 0; m < 4; ++m)
#pragma unroll
                    for (int n = 0; n < 2; ++n) acc[a][b][m][n] = (f32x4){0.f, 0.f, 0.f, 0.f};
        cur = nxt; cA = nA; cB = nB; ++ui;
        if constexpr (ALIGN_EPI) { if (wr == 1) PG8_BAR; }
    }
    PG8_WAIT_V(0);
    if constexpr (!ALIGN_EPI) { if (wr == 0) PG8_BAR; }
    PG8_BAR;
    if constexpr (Epi::AFTER_DRAIN) { E.fused(acc, cur, wr, wc, fr, fq, lds, wid, lane); S.done(cur); }
#undef PG8_SA
#undef PG8_SB
#undef PG8_STAGE
#undef PG8_LDA
#undef PG8_LDB
#undef PG8_MMA
#undef PG8_WAIT_V
#undef PG8_WAIT_L
#undef PG8_BAR
#undef PG8_SCHED
}
}
constexpr int NWAVES = 8, NTHR = 512;
constexpr int D = 1024, NB = 8, SEQ = 4096, CTX = 256;
constexpr int NCTX = NB * CTX, NLAT = NB * SEQ, MALL = NCTX + NLAT;
constexpr int N0 = 2304, N1 = 6144;
constexpr int C0_Q = 0, C0_K = 256, C0_V = 512, C0_G = 1024, C0_U = 1536, C0_LOW = 2048;
constexpr int C1_Q = 0, C1_K = 1024, C1_V = 2048, C1_G = 4096;
constexpr int NE = 32, MAXTILES = 576;
constexpr float EPS = 1e-6f;
constexpr int NPH = 23;
constexpr size_t MiB = 1u << 20;
constexpr size_t WS_CTL = 0, CTL_ZERO_BYTES = 1 * MiB;
constexpr size_t WS_MOD = 1 * MiB;
constexpr size_t WS_WIN0T = 2 * MiB, WS_WOUT0T = 7 * MiB, WS_WGLUT = 9 * MiB, WS_WIN1T = 10 * MiB, WS_WOUT1T = 22 * MiB;
constexpr size_t WS_SELE = 26 * MiB, WS_WSLOT = 27 * MiB, WS_SPOS = 28 * MiB, WS_PROW = 29 * MiB;
constexpr size_t WS_WGUT = 32 * MiB, WS_WDNT = 288 * MiB;
constexpr size_t WS_XRES = 416 * MiB, WS_H = 552 * MiB, WS_MIX = 620 * MiB, WS_YPRE = 688 * MiB;
constexpr size_t WS_PROJ = 748 * MiB, WS_OREC = 1156 * MiB;
constexpr size_t WS_XG = 748 * MiB, WS_ACT = 1036 * MiB, WS_YSLOT = 1324 * MiB;
constexpr size_t WS_END = 1668 * MiB;
constexpr int CW_TMO = 0, CW_BAR = 4096, CW_GCNT = 16384;
constexpr int RING_BYTES = 131072, LDSCTL_OFF = RING_BYTES, LDS_BYTES = 147456;
constexpr int L_MISC = LDSCTL_OFF;
constexpr int L_TILEE = LDSCTL_OFF + 256;
constexpr int L_TSTART = LDSCTL_OFF + 1024;
constexpr int L_LCNT = LDSCTL_OFF + 1280;
constexpr int L_GBASE = LDSCTL_OFF + 1536;
constexpr int L_BLKE = LDSCTL_OFF + 2048;
constexpr int L_BLKP = LDSCTL_OFF + 5120;

#define GAS __attribute__((address_space(1)))
#define LAS __attribute__((address_space(3)))
typedef unsigned short bf16;
typedef unsigned v4u __attribute__((ext_vector_type(4)));
typedef unsigned v2u __attribute__((ext_vector_type(2)));
typedef float f32x4 __attribute__((ext_vector_type(4)));
typedef GAS unsigned gu32;
#define RLX_AGENT __ATOMIC_RELAXED, __HIP_MEMORY_SCOPE_AGENT
#define LDS_WAIT() asm volatile("s_waitcnt lgkmcnt(0)" ::: "memory")
#define VM_WAIT() asm volatile("s_waitcnt vmcnt(0)" ::: "memory")
__device__ __forceinline__ unsigned f2bf(float f) { unsigned u = __builtin_bit_cast(unsigned, f); return (u + 0x7fffu + ((u >> 16) & 1u)) >> 16; }
__device__ __forceinline__ unsigned pk2(float lo, float hi) { return f2bf(lo) | (f2bf(hi) << 16); }
__device__ __forceinline__ float bf2f(unsigned b) { return __uint_as_float(b << 16); }
__device__ __forceinline__ float blo(unsigned w) { return __uint_as_float(w << 16); }
__device__ __forceinline__ float bhi(unsigned w) { return __uint_as_float(w & 0xffff0000u); }
__device__ __forceinline__ float wave_sum(float v) {
#pragma unroll
    for (int o = 1; o < 64; o <<= 1) v += __shfl_xor(v, o);
    return v;
}
__device__ __forceinline__ float silu_(float z) { return z / (1.0f + __expf(-z)); }
#define XB_TMO      128
#define XB_XCNT(j)  (256  + 64 * (j))
#define XB_XSUB(j)  (1280 + 64 * (j))
#define XB_XGEN(j)  (2304 + 64 * (j))
#define XB_TOP      3328
#define XB_TOPGEN   3392
#define XCD_BAR_WORDS 3456
#define XB_SPIN_CAP (1u << 22)

__device__ __forceinline__ unsigned xb_ld(unsigned* p)              { return __hip_atomic_load(p, __ATOMIC_RELAXED, __HIP_MEMORY_SCOPE_AGENT); }
__device__ __forceinline__ unsigned xb_add(unsigned* p, unsigned v) { return __hip_atomic_fetch_add(p, v, __ATOMIC_RELAXED, __HIP_MEMORY_SCOPE_AGENT); }
__device__ __forceinline__ unsigned xb_xcc_id() { return (unsigned)__builtin_amdgcn_s_getreg((3 << 11) | 20) & 0xFu; }
#define XB_SPIN(cond, bar) do { unsigned _sp = 0; while (cond) { __builtin_amdgcn_s_sleep(1); \
    if ((++_sp & 255u) == 0u) { if (xb_ld(&(bar)[XB_TMO])) break; if (_sp > XB_SPIN_CAP) { atomicAdd(&(bar)[XB_TMO], 1u); break; } } } } while (0)

struct XcdBarrier {
    unsigned* bar; unsigned x;
    volatile LAS unsigned* st;
};

__device__ __forceinline__ XcdBarrier xcd_barrier_post(unsigned* bar, volatile LAS unsigned* st) {
    XcdBarrier b; b.bar = bar; b.x = xb_xcc_id(); b.st = st;
    if (threadIdx.x == 0) (void)xb_add(&bar[XB_XCNT(b.x)], 1u);
    return b;
}
__device__ __forceinline__ void xcd_barrier_complete(unsigned* bar, unsigned x, unsigned& nloc, unsigned& nx) {
    const unsigned G = gridDim.x * gridDim.y * gridDim.z;
    unsigned sum, cnt, mine, sp = 0u;
    for (;;) {
        sum = 0u; cnt = 0u; mine = 0u;
#pragma unroll
        for (unsigned j = 0; j < 16; ++j) { const unsigned c = xb_ld(&bar[XB_XCNT(j)]); sum += c; cnt += (c > 0u) ? 1u : 0u; mine = (j == x) ? c : mine; }
        if (sum == G) break;
        __builtin_amdgcn_s_sleep(1);
        if ((++sp & 255u) == 0u) { if (xb_ld(&bar[XB_TMO])) break; if (sp > XB_SPIN_CAP) { atomicAdd(&bar[XB_TMO], 1u); break; } }
    }
    nloc = mine > 0u ? mine : 1u; nx = cnt > 0u ? cnt : 1u;
}

__device__ __forceinline__ void xcd_barrier(const XcdBarrier& b) {
    asm volatile("s_waitcnt vmcnt(0)" ::: "memory");
    __syncthreads();
    if (threadIdx.x == 0) {
        unsigned* bar = b.bar;
        __builtin_amdgcn_s_waitcnt(0);
        unsigned nloc = b.st[0], nx = b.st[1];
        if (nloc == 0u) { xcd_barrier_complete(bar, b.x, nloc, nx); b.st[0] = nloc; b.st[1] = nx; }
        const unsigned old = xb_add(&bar[XB_XSUB(b.x)], 1u);
        const unsigned gen = old / nloc;
        if (old + 1u == (gen + 1u) * nloc) {
            __builtin_amdgcn_fence(__ATOMIC_RELEASE, "agent");
            asm volatile("s_waitcnt vmcnt(0)" ::: "memory");
            const unsigned og = xb_add(&bar[XB_TOP], 1u);
            const unsigned tg = og / nx;
            if (og + 1u == (tg + 1u) * nx) xb_add(&bar[XB_TOPGEN], 1u);
            else XB_SPIN(xb_ld(&bar[XB_TOPGEN]) == tg, bar);
            __builtin_amdgcn_fence(__ATOMIC_ACQUIRE, "agent");
            xb_add(&bar[XB_XGEN(b.x)], 1u);
            asm volatile("s_waitcnt vmcnt(0)" ::: "memory");
        } else {
            XB_SPIN(xb_ld(&bar[XB_XGEN(b.x)]) == gen, bar);
            __builtin_amdgcn_fence(__ATOMIC_ACQUIRE, "agent");
            asm volatile("s_waitcnt vmcnt(0)" ::: "memory");
        }
    }
    __syncthreads();
}
struct Args { const float* in[34]; float* out; unsigned char* ws; int ph_lo, ph_hi; };
#define CAS __attribute__((address_space(4)))
struct KA {
    const CAS unsigned char* p;
    __device__ __forceinline__ const float* I(int i) const { return *(const float* const CAS*)(p + 8 * i); }
    __device__ __forceinline__ float* OUT() const { return *(float* const CAS*)(p + 8 * 34); }
    __device__ __forceinline__ unsigned char* WS() const { return *(unsigned char* const CAS*)(p + 8 * 35); }
    __device__ __forceinline__ int LO() const { return *(const CAS int*)(p + 8 * 36); }
    __device__ __forceinline__ int HI() const { return *(const CAS int*)(p + 8 * 36 + 4); }
};
__device__ __forceinline__ KA ka_fresh() { KA a; a.p = (const CAS unsigned char*)__builtin_amdgcn_kernarg_segment_ptr(); asm volatile("" : "+s"(a.p)); return a; }
static_assert(sizeof(Args) == 8 * 36 + 8, "kernarg layout");
struct Frame {
    LAS unsigned char* lds;
    volatile LAS unsigned* MISC;
    unsigned* ctl;
    int tid, lane, wave, vcu, G;
};
enum { I_X = 0, I_C, I_CTX, I_CCTX, I_ADAW, I_ADAB, I_N1G, I_N2G, I_ABWIN, I_ABWOUT, I_GLAWA, I_GLABA, I_GLANG, I_LAMRE, I_LAMIM, I_LOGSTEP, I_BRE, I_BIM, I_CRE, I_CIM,
       I_S5D, I_GLUW, I_GLUB, I_RETWIN, I_RETWOUT, I_RETDEC, I_RETNG, I_WROUTER, I_BROUTER, I_WGU, I_BGU, I_WDN, I_BDN, I_FNG };

__device__ __forceinline__ void tr_item(const float* src, int ldsrc, int K, int srccol, float scale, bf16* dst, int dstrow0, int k0, LAS float* scr, int lane) {
    if (srccol >= 0) {
#pragma unroll 8
        for (int i = 0; i < 32; ++i) { const int kk = 2 * i + (lane >> 5); scr[kk * 33 + (lane & 31)] = src[(size_t)(k0 + kk) * ldsrc + srccol + (lane & 31)] * scale; }
    } else {
#pragma unroll 8
        for (int i = 0; i < 32; ++i) { const int kk = 2 * i + (lane >> 5); scr[kk * 33 + (lane & 31)] = 0.f; }
    }
    LDS_WAIT(); asm volatile("" ::: "memory");
    const int c = lane & 7;
#pragma unroll
    for (int j = 0; j < 4; ++j) { const int n = (lane >> 3) + 8 * j; const LAS float* s = scr + (8 * c) * 33 + n;
        v4u o; o.x = pk2(s[0 * 33], s[1 * 33]); o.y = pk2(s[2 * 33], s[3 * 33]); o.z = pk2(s[4 * 33], s[5 * 33]); o.w = pk2(s[6 * 33], s[7 * 33]);
        *(GAS v4u*)(dst + (size_t)(dstrow0 + n) * K + k0 + 8 * c) = o; }
    LDS_WAIT(); asm volatile("" ::: "memory");
}
__device__ __forceinline__ void p0_prologue(Frame& F) {
    const KA A = ka_fresh();
    unsigned char* ws = A.WS();
    LAS float* scr = (LAS float*)(F.lds + F.wave * 8704);
    LAS float* sl = (LAS float*)(F.lds + 69632);
    for (int idx = F.tid; idx < 9 * 1024; idx += NTHR) { const int b = idx >> 10, k = idx & 1023; const float cv = b < 8 ? A.I(I_C)[b * 1024 + k] : A.I(I_CCTX)[k]; sl[k * 12 + b] = silu_(cv); }
    __syncthreads();
    const int gw = F.vcu * NWAVES + F.wave, NGW = F.G * NWAVES, lane = F.lane;
    constexpr int I_MOD = 192, I_IN0 = 1152, I_OUT0 = 512, I_GLU = 128, I_IN1 = 3072, I_OUT1 = 1024, I_GU = 65536, I_DN = 32768;
    constexpr int NITEMS = I_MOD + I_IN0 + I_OUT0 + I_GLU + I_IN1 + I_OUT1 + I_GU + I_DN;
    for (int it = gw; it < NITEMS; it += NGW) {
        int r = it;
        if (r < I_MOD) {
            const int layer = r / 96, col = (r % 96) * 64 + lane;
            const float* w = A.I(I_ADAW) + (size_t)layer * 1024 * 6144 + col;
            float acc[9];
#pragma unroll
            for (int b = 0; b < 9; ++b) acc[b] = 0.f;
            for (int k0 = 0; k0 < 1024; k0 += 8) {
                float wv[8];
#pragma unroll
                for (int u = 0; u < 8; ++u) wv[u] = w[(size_t)(k0 + u) * 6144];
#pragma unroll
                for (int u = 0; u < 8; ++u) {
#pragma unroll
                    for (int b = 0; b < 9; ++b) acc[b] += sl[(k0 + u) * 12 + b] * wv[u]; }
            }
            float* mod = (float*)(ws + WS_MOD) + (size_t)layer * 9 * 6144;
            const float bb = A.I(I_ADAB)[layer * 6144 + col];
#pragma unroll
            for (int b = 0; b < 9; ++b) mod[b * 6144 + col] = acc[b] + bb;
            continue;
        }
        r -= I_MOD;
        if (r < I_IN0) { const int kb = r / 72, n0 = (r % 72) * 32;
            const int sc = n0 < 1536 ? n0 : (n0 < 2048 ? n0 + 32 : (n0 == 2048 ? 1536 : -1));
            tr_item(A.I(I_ABWIN), 2080, 1024, sc, n0 < 256 ? 0.125f : 1.0f, (bf16*)(ws + WS_WIN0T), n0, kb * 64, scr, lane); continue; }
        r -= I_IN0;
        if (r < I_OUT0) { tr_item(A.I(I_ABWOUT), 1024, 1024, (r % 32) * 32, 1.0f, (bf16*)(ws + WS_WOUT0T), (r % 32) * 32, (r / 32) * 64, scr, lane); continue; }
        r -= I_OUT0;
        if (r < I_GLU) { tr_item(A.I(I_GLUW), 512, 512, (r % 16) * 32, 1.0f, (bf16*)(ws + WS_WGLUT), (r % 16) * 32, (r / 16) * 64, scr, lane); continue; }
        r -= I_GLU;
        if (r < I_IN1) { const int n0 = (r % 192) * 32;
            tr_item(A.I(I_RETWIN), 6144, 1024, n0, (n0 >= 1024 && n0 < 2048) ? 0.0625f : 1.0f, (bf16*)(ws + WS_WIN1T), n0, (r / 192) * 64, scr, lane); continue; }
        r -= I_IN1;
        if (r < I_OUT1) { tr_item(A.I(I_RETWOUT), 1024, 2048, (r % 32) * 32, 1.0f, (bf16*)(ws + WS_WOUT1T), (r % 32) * 32, (r / 32) * 64, scr, lane); continue; }
        r -= I_OUT1;
        if (r < I_GU) { const int mat = r >> 10, q = r & 1023, kb = q >> 6, n0 = (q & 63) * 32;
            const int pn = n0 >> 8, bj = (n0 >> 7) & 1, lc = n0 & 127;
            tr_item(A.I(I_WGU) + (size_t)mat * 1024 * 2048, 2048, 1024, bj * 1024 + pn * 128 + lc, 1.0f, (bf16*)(ws + WS_WGUT) + (size_t)mat * 2048 * 1024, n0, kb * 64, scr, lane); continue; }
        r -= I_GU;
        { const int mat = r >> 9, q = r & 511, kb = q >> 5, n0 = (q & 31) * 32;
          tr_item(A.I(I_WDN) + (size_t)mat * 1024 * 1024, 1024, 1024, n0, 1.0f, (bf16*)(ws + WS_WDNT) + (size_t)mat * 1024 * 1024, n0, kb * 64, scr, lane); }
    }
}
__device__ __forceinline__ void modnorm_store(const f32x4 (&v)[4], const float* g, const float* sc, const float* sh, bf16* hrow, int lane, f32x4 (&h)[4]) {
    float ss = 0.f;
#pragma unroll
    for (int j = 0; j < 4; ++j) ss += (v[j].x * v[j].x + v[j].y * v[j].y) + (v[j].z * v[j].z + v[j].w * v[j].w);
    const float r = rsqrtf(wave_sum(ss) * (1.0f / 1024.0f) + EPS);
#pragma unroll
    for (int j = 0; j < 4; ++j) { const int o = 64 * j + lane;
        const f32x4 gg = ((const f32x4*)g)[o], s4 = ((const f32x4*)sc)[o], h4 = ((const f32x4*)sh)[o];
        h[j] = v[j] * r * gg * (s4 + 1.0f) + h4;
        v2u w; w.x = pk2(h[j].x, h[j].y); w.y = pk2(h[j].z, h[j].w);
        ((GAS v2u*)hrow)[o] = w; }
}
__device__ __forceinline__ int bidx_of_row(int row) { return row < NCTX ? 8 : ((row - NCTX) >> 12); }
__device__ __forceinline__ void p_norm1_l0(Frame& F) {
    const KA A = ka_fresh();
    const int gw = F.vcu * NWAVES + F.wave, NGW = F.G * NWAVES, lane = F.lane;
    const float* mod = (const float*)(A.WS() + WS_MOD);
    bf16* H = (bf16*)(A.WS() + WS_H);
    for (int row = gw; row < MALL; row += NGW) {
        const float* xr = row < NCTX ? A.I(I_CTX) + (size_t)row * 1024 : A.I(I_X) + (size_t)(row - NCTX) * 1024;
        f32x4 v[4], h[4];
#pragma unroll
        for (int j = 0; j < 4; ++j) v[j] = ((const f32x4*)xr)[64 * j + lane];
        const float* m = mod + bidx_of_row(row) * 6144;
        modnorm_store(v, A.I(I_N1G), m + 1024, m, H + (size_t)row * 1024, lane, h);
    }
}
__device__ __forceinline__ int seq_row(int b, int dir, int s) {
    return s < CTX ? b * CTX + (dir ? CTX - 1 - s : s) : NCTX + b * SEQ + (dir ? SEQ - 1 - (s - CTX) : (s - CTX));
}
template <int DK, bool GLA>
__device__ __forceinline__ void rec_naive(Frame& F, const bf16* P, int ldp, int qc, int kc, int vc, int DV, int nvs,
                                          float* O, size_t odir_stride, int ldo, int orow0) {
    const KA A = ka_fresh();
    constexpr int KPW = DK / 8, TB = 16;
    LAS float* qs = (LAS float*)(F.lds);
    LAS float* ks = (LAS float*)(F.lds + 16384);
    LAS float* vv = (LAS float*)(F.lds + 32768);
    LAS float* dec = (LAS float*)(F.lds + 36864);
    LAS float* opart = (LAS float*)(F.lds + 40960);
    const int tid = F.tid, lane = F.lane, wave = F.wave;
    const int nitems = NB * 4 * 2 * nvs;
    for (int it = F.vcu; it < nitems; it += F.G) {
        const int vs = it % nvs, dir = (it / nvs) & 1, h = (it / (2 * nvs)) & 3, b = it / (8 * nvs);
        float gamma = 0.f;
        if (!GLA) { const float lg = A.I(I_RETDEC)[dir * 4 + h]; gamma = 1.0f / (1.0f + expf(-lg)); }
        float S[KPW];
#pragma unroll
        for (int i = 0; i < KPW; ++i) S[i] = 0.f;
        for (int s0 = 0; s0 < CTX + SEQ; s0 += TB) {
            for (int idx = tid; idx < TB * DK; idx += NTHR) { const int i = idx / DK, kk = idx % DK; const size_t rb = (size_t)seq_row(b, dir, s0 + i) * ldp;
                qs[idx] = bf2f(P[rb + qc + h * DK + kk]); ks[idx] = bf2f(P[rb + kc + h * DK + kk]); }
            for (int idx = tid; idx < TB * 64; idx += NTHR) { const int i = idx >> 6, c = idx & 63; const size_t rb = (size_t)seq_row(b, dir, s0 + i) * ldp;
                vv[idx] = bf2f(P[rb + vc + h * DV + vs * 64 + c]);
                if (GLA) { float z = A.I(I_GLABA)[dir * 256 + h * 64 + c];
#pragma unroll
                    for (int r = 0; r < 16; ++r) z += bf2f(P[rb + C0_LOW + dir * 16 + r]) * A.I(I_GLAWA)[(dir * 16 + r) * 256 + h * 64 + c];
                    const float ls = fminf(z, 0.f) - log1pf(expf(-fabsf(z)));
                    dec[idx] = expf(ls * (1.0f / 16.0f)); } }
            __syncthreads();
#pragma unroll 1
            for (int i = 0; i < TB; ++i) { const float vval = vv[i * 64 + lane]; float part = 0.f;
#pragma unroll
                for (int kk = 0; kk < KPW; ++kk) { const int kidx = wave * KPW + kk; const float d = GLA ? dec[i * 64 + kidx] : gamma;
                    S[kk] = d * S[kk] + ks[i * DK + kidx] * vval; part += qs[i * DK + kidx] * S[kk]; }
                opart[(i * 8 + wave) * 64 + lane] = part; }
            __syncthreads();
            for (int idx = tid; idx < TB * 64; idx += NTHR) { const int i = idx >> 6, c = idx & 63; float sum = 0.f;
#pragma unroll
                for (int w = 0; w < 8; ++w) sum += opart[(i * 8 + w) * 64 + c];
                const int row = seq_row(b, dir, s0 + i);
                if (row >= orow0) O[(size_t)dir * odir_stride + (size_t)(row - orow0) * ldo + h * DV + vs * 64 + c] = sum; }
        }
        __syncthreads();
    }
}
__device__ __forceinline__ void s5_naive(Frame& F, const bf16* P, float* Y  ) {
    const KA A = ka_fresh();
    const int lane = F.lane;
    if (F.wave >= 2) return;
    for (int chain = F.vcu * 2 + F.wave; chain < NB * 32 * 2; chain += F.G * 2) {
        const int dir = chain & 1, g = (chain >> 1) & 31, b = chain >> 6;
        const float step = expf(A.I(I_LOGSTEP)[dir * 32 + g]);
        const float lr = A.I(I_LAMRE)[(dir * 32 + g) * 64 + lane], li = A.I(I_LAMIM)[(dir * 32 + g) * 64 + lane];
        const float mag = expf(lr * step), lbr = mag * cosf(li * step), lbi = mag * sinf(li * step), den = lr * lr + li * li;
        const float fr = ((lbr - 1.0f) * lr + lbi * li) / den, fi = (lbi * lr - (lbr - 1.0f) * li) / den;
        float bbr[16], bbi[16], cr[16], ci[16];
#pragma unroll
        for (int c = 0; c < 16; ++c) { const float br = A.I(I_BRE)[(g * 64 + lane) * 16 + c], bi = A.I(I_BIM)[(g * 64 + lane) * 16 + c];
            bbr[c] = fr * br - fi * bi; bbi[c] = fr * bi + fi * br;
            cr[c] = A.I(I_CRE)[((dir * 32 + g) * 16 + c) * 64 + lane]; ci[c] = A.I(I_CIM)[((dir * 32 + g) * 16 + c) * 64 + lane]; }
        float sr = 0.f, si = 0.f;
        for (int s0 = 0; s0 < CTX + SEQ; s0 += 4) {
            v4u uu[4][2];
#pragma unroll
            for (int i = 0; i < 4; ++i) { const v4u* up = (const v4u*)(P + (size_t)seq_row(b, dir, s0 + i) * N0 + C0_U + g * 16); uu[i][0] = up[0]; uu[i][1] = up[1]; }
#pragma unroll
            for (int i = 0; i < 4; ++i) {
                float u[16];
#pragma unroll
                for (int q = 0; q < 2; ++q) { u[8 * q + 0] = blo(uu[i][q].x); u[8 * q + 1] = bhi(uu[i][q].x); u[8 * q + 2] = blo(uu[i][q].y); u[8 * q + 3] = bhi(uu[i][q].y);
                    u[8 * q + 4] = blo(uu[i][q].z); u[8 * q + 5] = bhi(uu[i][q].z); u[8 * q + 6] = blo(uu[i][q].w); u[8 * q + 7] = bhi(uu[i][q].w); }
                float br = 0.f, bi = 0.f;
#pragma unroll
                for (int c = 0; c < 16; ++c) { br += bbr[c] * u[c]; bi += bbi[c] * u[c]; }
                const float nr = lbr * sr - lbi * si + br, ni = lbr * si + lbi * sr + bi; sr = nr; si = ni;
                float v[16];
#pragma unroll
                for (int c = 0; c < 16; ++c) v[c] = cr[c] * sr - ci[c] * si;
                const bool b5 = (lane & 32) != 0, b4 = (lane & 16) != 0, b3 = (lane & 8) != 0, b2 = (lane & 4) != 0;
                float w8[8], w4[4], w2[2];
#pragma unroll
                for (int k = 0; k < 8; ++k) { const float send = b5 ? v[k] : v[k + 8], keep = b5 ? v[k + 8] : v[k]; w8[k] = keep + __shfl_xor(send, 32); }
#pragma unroll
                for (int k = 0; k < 4; ++k) { const float send = b4 ? w8[k] : w8[k + 4], keep = b4 ? w8[k + 4] : w8[k]; w4[k] = keep + __shfl_xor(send, 16); }
#pragma unroll
                for (int k = 0; k < 2; ++k) { const float send = b3 ? w4[k] : w4[k + 2], keep = b3 ? w4[k + 2] : w4[k]; w2[k] = keep + __shfl_xor(send, 8); }
                float w1; { const float send = b2 ? w2[0] : w2[1], keep = b2 ? w2[1] : w2[0]; w1 = keep + __shfl_xor(send, 4); }
                w1 += __shfl_xor(w1, 2); w1 += __shfl_xor(w1, 1);
                const int c = (b5 ? 8 : 0) + (b4 ? 4 : 0) + (b3 ? 2 : 0) + (b2 ? 1 : 0);
                if ((lane & 3) == 0) Y[(size_t)dir * MALL * 512 + (size_t)seq_row(b, dir, s0 + i) * 512 + g * 16 + c] = w1;
            }
        }
    }
}
__device__ __forceinline__ void unpack8(const v4u w, float (&f)[8]) { f[0] = blo(w.x); f[1] = bhi(w.x); f[2] = blo(w.y); f[3] = bhi(w.y); f[4] = blo(w.z); f[5] = bhi(w.z); f[6] = blo(w.w); f[7] = bhi(w.w); }
__device__ __forceinline__ v4u pack8(const float (&f)[8]) { v4u w; w.x = pk2(f[0], f[1]); w.y = pk2(f[2], f[3]); w.z = pk2(f[4], f[5]); w.w = pk2(f[6], f[7]); return w; }
__device__ __forceinline__ void p_finish0(Frame& F) {
    const KA A = ka_fresh();
    const int gw = F.vcu * NWAVES + F.wave, NGW = F.G * NWAVES, lane = F.lane, e0 = lane * 8;
    const bf16* P = (const bf16*)(A.WS() + WS_PROJ);
    const float* GO = (const float*)(A.WS() + WS_OREC);
    const float* SY = GO + (size_t)2 * MALL * 512;
    bf16* MIX = (bf16*)(A.WS() + WS_MIX); bf16* YP = (bf16*)(A.WS() + WS_YPRE);
    for (int row = gw; row < MALL; row += NGW) {
        float o[8], gg[8], ng[8];
        { const f32x4* a = (const f32x4*)(GO + (size_t)row * 512 + e0); const f32x4* bq = (const f32x4*)(GO + (size_t)(MALL + row) * 512 + e0);
          const f32x4 a0 = a[0] + bq[0], a1 = a[1] + bq[1]; o[0] = a0.x; o[1] = a0.y; o[2] = a0.z; o[3] = a0.w; o[4] = a1.x; o[5] = a1.y; o[6] = a1.z; o[7] = a1.w; }
        float ss = 0.f;
#pragma unroll
        for (int j = 0; j < 8; ++j) ss += o[j] * o[j];
        ss += __shfl_xor(ss, 1); ss += __shfl_xor(ss, 2); ss += __shfl_xor(ss, 4); ss += __shfl_xor(ss, 8);
        const float r = rsqrtf(ss * (1.0f / 128.0f) + EPS);
        unpack8(*(const v4u*)(P + (size_t)row * N0 + C0_G + e0), gg);
        { const f32x4* n4 = (const f32x4*)(A.I(I_GLANG) + (e0 & 127)); const f32x4 n0 = n4[0], n1 = n4[1]; ng[0] = n0.x; ng[1] = n0.y; ng[2] = n0.z; ng[3] = n0.w; ng[4] = n1.x; ng[5] = n1.y; ng[6] = n1.z; ng[7] = n1.w; }
        float res[8];
#pragma unroll
        for (int j = 0; j < 8; ++j) res[j] = o[j] * r * ng[j] * silu_(gg[j]);
        *(GAS v4u*)(MIX + (size_t)row * 1024 + e0) = pack8(res);
        float u[8], y[8];
        unpack8(*(const v4u*)(P + (size_t)row * N0 + C0_U + e0), u);
        { const f32x4* a = (const f32x4*)(SY + (size_t)row * 512 + e0); const f32x4* bq = (const f32x4*)(SY + (size_t)(MALL + row) * 512 + e0);
          const f32x4 a0 = a[0] + bq[0], a1 = a[1] + bq[1]; y[0] = a0.x; y[1] = a0.y; y[2] = a0.z; y[3] = a0.w; y[4] = a1.x; y[5] = a1.y; y[6] = a1.z; y[7] = a1.w; }
#pragma unroll
        for (int j = 0; j < 8; ++j) { const float t = y[j] + A.I(I_S5D)[e0 + j] * u[j]; res[j] = 0.5f * t * (1.0f + tanhf(0.7978845608f * (t + 0.044715f * t * t * t))); }
        *(GAS v4u*)(YP + (size_t)row * 512 + e0) = pack8(res);
    }
}
__device__ __forceinline__ void p_finish1(Frame& F) {
    const KA A = ka_fresh();
    const int gw = F.vcu * NWAVES + F.wave, NGW = F.G * NWAVES, lane = F.lane;
    const bf16* P = (const bf16*)(A.WS() + WS_PROJ);
    const float* RO = (const float*)(A.WS() + WS_OREC);
    bf16* MIX = (bf16*)(A.WS() + WS_MIX);
    for (int lrow = gw; lrow < NLAT; lrow += NGW) {
#pragma unroll 1
        for (int h = 0; h < 4; ++h) { const int e0 = h * 512 + lane * 8;
            float o[8], gg[8];
            { const f32x4* a = (const f32x4*)(RO + (size_t)lrow * 2048 + e0); const f32x4* bq = (const f32x4*)(RO + (size_t)(NLAT + lrow) * 2048 + e0);
              const f32x4 a0 = a[0] + bq[0], a1 = a[1] + bq[1]; o[0] = a0.x; o[1] = a0.y; o[2] = a0.z; o[3] = a0.w; o[4] = a1.x; o[5] = a1.y; o[6] = a1.z; o[7] = a1.w; }
            float s = 0.f;
#pragma unroll
            for (int j = 0; j < 8; ++j) s += o[j];
            const float mu = wave_sum(s) * (1.0f / 512.0f); float q = 0.f;
#pragma unroll
            for (int j = 0; j < 8; ++j) { o[j] -= mu; q += o[j] * o[j]; }
            const float r = rsqrtf(wave_sum(q) * (1.0f / 512.0f) + EPS);
            unpack8(*(const v4u*)(P + (size_t)(NCTX + lrow) * N1 + C1_G + e0), gg);
            float res[8];
#pragma unroll
            for (int j = 0; j < 8; ++j) res[j] = o[j] * r * A.I(I_RETNG)[e0 + j] * silu_(gg[j]);
            *(GAS v4u*)(MIX + (size_t)lrow * 2048 + e0) = pack8(res); }
    }
}
__device__ __forceinline__ void p_rope(Frame& F) {
    const KA A = ka_fresh();
    const int gw = F.vcu * NWAVES + F.wave, NGW = F.G * NWAVES, lane = F.lane;
    bf16* P = (bf16*)(A.WS() + WS_PROJ);
    const float invf = expf(-(float)lane * (9.210340371976184f / 64.0f));
    for (int lrow = gw; lrow < NLAT; lrow += NGW) {
        const int t = lrow & (SEQ - 1), pr = t >> 6, pc = t & 63;
        float sr, cr, sc, cc; sincosf((float)pr * invf, &sr, &cr); sincosf((float)pc * invf, &sc, &cc);
        bf16* rp = P + (size_t)(NCTX + lrow) * N1;
#pragma unroll 1
        for (int tb = 0; tb < 2048; tb += 256) {
            { const float a = bf2f(rp[tb + lane]), b2 = bf2f(rp[tb + 64 + lane]); rp[tb + lane] = (bf16)f2bf(a * cr - b2 * sr); rp[tb + 64 + lane] = (bf16)f2bf(a * sr + b2 * cr); }
            { const float a = bf2f(rp[tb + 128 + lane]), b2 = bf2f(rp[tb + 192 + lane]); rp[tb + 128 + lane] = (bf16)f2bf(a * cc - b2 * sc); rp[tb + 192 + lane] = (bf16)f2bf(a * sc + b2 * cc); }
        }
    }
}
__device__ __forceinline__ void p_router(Frame& F, int layer) {
    const KA A = ka_fresh();
    const int tid = F.tid, lane = F.lane, wave = F.wave;
    const int moe_row0 = layer ? NCTX : 0, NTOK = layer ? NLAT : MALL;
    const int RPB = (NTOK + F.G - 1) / F.G;
    unsigned char* ws = A.WS();
    int* prow = (int*)(ws + WS_PROW); int* sel_e = (int*)(ws + WS_SELE); float* w_slot = (float*)(ws + WS_WSLOT); int* slot_pos = (int*)(ws + WS_SPOS);
    for (int i = F.vcu * NTHR + tid; i < MAXTILES * 256; i += F.G * NTHR) prow[i] = -1;
    LAS float* Wt = (LAS float*)F.lds;
    LAS int* lcnt = (LAS int*)(F.lds + L_LCNT); LAS int* gbase = (LAS int*)(F.lds + L_GBASE);
    LAS int* blk_e = (LAS int*)(F.lds + L_BLKE); LAS int* blk_p = (LAS int*)(F.lds + L_BLKP);
    const float* wr = A.I(I_WROUTER) + (size_t)layer * 1024 * 32;
    for (int idx = tid; idx < 32768; idx += NTHR) Wt[(idx & 31) * 1024 + (idx >> 5)] = wr[idx];
    if (tid < 32) lcnt[tid] = 0;
    __syncthreads();
    const float* mod = (const float*)(ws + WS_MOD) + (size_t)layer * 9 * 6144;
    const float* XR = (const float*)(ws + WS_XRES); bf16* H = (bf16*)(ws + WS_H);
    const int tok0 = F.vcu * RPB;
    for (int lr = wave; lr < RPB; lr += NWAVES) {
        const int tok = tok0 + lr; if (tok >= NTOK) break;
        const int row = moe_row0 + tok;
        f32x4 v[4], h[4];
#pragma unroll
        for (int j = 0; j < 4; ++j) v[j] = ((const f32x4*)(XR + (size_t)row * 1024))[64 * j + lane];
        const float* m = mod + bidx_of_row(row) * 6144;
        modnorm_store(v, A.I(I_N2G) + layer * 1024, m + 4096, m + 3072, H + (size_t)row * 1024, lane, h);
        float lg[32];
#pragma unroll
        for (int e = 0; e < 32; ++e) { float a = 0.f;
#pragma unroll
            for (int j = 0; j < 4; ++j) { const f32x4 w4 = *(const LAS f32x4*)(Wt + e * 1024 + 4 * (64 * j + lane)); a += (h[j].x * w4.x + h[j].y * w4.y) + (h[j].z * w4.z + h[j].w * w4.w); }
            lg[e] = wave_sum(a) + A.I(I_BROUTER)[layer * 32 + e]; }
        float bv[4]; int bi[4];
#pragma unroll
        for (int r = 0; r < 4; ++r) { float best = -INFINITY; int be = 0;
#pragma unroll
            for (int e = 0; e < 32; ++e) { const bool take = lg[e] > best; best = take ? lg[e] : best; be = take ? e : be; }
            bv[r] = best; bi[r] = be;
#pragma unroll
            for (int e = 0; e < 32; ++e) lg[e] = (e == be) ? -INFINITY : lg[e]; }
        const float e1 = __expf(bv[1] - bv[0]), e2 = __expf(bv[2] - bv[0]), e3 = __expf(bv[3] - bv[0]), inv = 1.0f / (1.0f + e1 + e2 + e3);
        if (lane < 4) { const int ee = lane == 0 ? bi[0] : (lane == 1 ? bi[1] : (lane == 2 ? bi[2] : bi[3]));
            const float wv = (lane == 0 ? 1.0f : (lane == 1 ? e1 : (lane == 2 ? e2 : e3))) * inv;
            sel_e[tok * 4 + lane] = ee; w_slot[tok * 4 + lane] = wv;
            const int lp = __hip_atomic_fetch_add(lcnt + ee, 1, __ATOMIC_RELAXED, __HIP_MEMORY_SCOPE_WORKGROUP);
            blk_e[lr * 4 + lane] = ee; blk_p[lr * 4 + lane] = lp; }
    }
    __syncthreads();
    if (tid < 32) gbase[tid] = (int)__hip_atomic_fetch_add(F.ctl + CW_GCNT + 64 * layer + tid, (unsigned)lcnt[tid], RLX_AGENT);
    __syncthreads();
    for (int idx = tid; idx < RPB * 4; idx += NTHR) { const int tok = tok0 + (idx >> 2); if (tok < NTOK) slot_pos[tok * 4 + (idx & 3)] = gbase[blk_e[idx]] + blk_p[idx]; }
}
__device__ __forceinline__ int moe_tables(Frame& F, int layer) {
    LAS int* ts = (LAS int*)(F.lds + L_TSTART); LAS unsigned char* te = (LAS unsigned char*)(F.lds + L_TILEE);
    __syncthreads();
    if (F.tid == 0) { int acc = 0;
        for (int e = 0; e < 32; ++e) { ts[e] = acc; acc += ((int)__hip_atomic_load(F.ctl + CW_GCNT + 64 * layer + e, RLX_AGENT) + 255) >> 8; }
        ts[32] = acc > MAXTILES ? MAXTILES : acc; }
    __syncthreads();
    const int nt = ts[32];
    for (int T = F.tid; T < nt; T += NTHR) { int e = 0;
        for (int q = 1; q < 32; ++q) e = (T >= ts[q]) ? q : e;
        te[T] = (unsigned char)e; }
    __syncthreads();
    return nt;
}
__device__ __forceinline__ void p_gather(Frame& F, int layer) {
    const KA A = ka_fresh();
    const int gw = F.vcu * NWAVES + F.wave, NGW = F.G * NWAVES, lane = F.lane;
    const int moe_row0 = layer ? NCTX : 0, NTOK = layer ? NLAT : MALL;
    unsigned char* ws = A.WS();
    moe_tables(F, layer);
    const LAS int* ts = (const LAS int*)(F.lds + L_TSTART);
    int* prow = (int*)(ws + WS_PROW); const int* sel_e = (const int*)(ws + WS_SELE); const int* slot_pos = (const int*)(ws + WS_SPOS);
    const bf16* H = (const bf16*)(ws + WS_H); bf16* XG = (bf16*)(ws + WS_XG);
    for (int s = gw; s < NTOK * 4; s += NGW) {
        const int e = sel_e[s], p = ts[e] * 256 + slot_pos[s];
        const v4u* src = (const v4u*)(H + (size_t)(moe_row0 + (s >> 2)) * 1024); GAS v4u* dst = (GAS v4u*)(XG + (size_t)p * 1024);
        const v4u a = src[lane], b2 = src[64 + lane]; dst[lane] = a; dst[64 + lane] = b2;
        if (lane == 0) prow[p] = s;
    }
}
__device__ __forceinline__ void p_combine(Frame& F, int layer) {
    const KA A = ka_fresh();
    const int gw = F.vcu * NWAVES + F.wave, NGW = F.G * NWAVES, lane = F.lane;
    const int moe_row0 = layer ? NCTX : 0, NTOK = layer ? NLAT : MALL;
    unsigned char* ws = A.WS();
    float* XR = (float*)(ws + WS_XRES); bf16* H = (bf16*)(ws + WS_H); const bf16* YS = (const bf16*)(ws + WS_YSLOT);
    const float* mod = (const float*)(ws + WS_MOD);
    for (int tok = gw; tok < NTOK; tok += NGW) {
        const int row = moe_row0 + tok, bidx = bidx_of_row(row);
        const float* g2 = mod + (size_t)layer * 9 * 6144 + bidx * 6144 + 5120;
        f32x4 v[4];
#pragma unroll
        for (int j = 0; j < 4; ++j) { const int o = 64 * j + lane; f32x4 y = (f32x4){0.f, 0.f, 0.f, 0.f};
#pragma unroll
            for (int k = 0; k < 4; ++k) { const v2u w = ((const v2u*)(YS + (size_t)(tok * 4 + k) * 1024))[o]; y += (f32x4){blo(w.x), bhi(w.x), blo(w.y), bhi(w.y)}; }
            v[j] = ((const f32x4*)(XR + (size_t)row * 1024))[o] + ((const f32x4*)g2)[o] * y; }
        if (layer == 0) {
#pragma unroll
            for (int j = 0; j < 4; ++j) ((f32x4*)(XR + (size_t)row * 1024))[64 * j + lane] = v[j];
            const float* m1 = mod + (size_t)9 * 6144 + bidx * 6144; f32x4 h[4];
            modnorm_store(v, A.I(I_N1G) + 1024, m1 + 1024, m1, H + (size_t)row * 1024, lane, h);
        } else {
            float ss = 0.f;
#pragma unroll
            for (int j = 0; j < 4; ++j) ss += (v[j].x * v[j].x + v[j].y * v[j].y) + (v[j].z * v[j].z + v[j].w * v[j].w);
            const float r = rsqrtf(wave_sum(ss) * (1.0f / 1024.0f) + EPS);
#pragma unroll
            for (int j = 0; j < 4; ++j) { const int o = 64 * j + lane; ((f32x4*)(A.OUT() + (size_t)tok * 1024))[o] = v[j] * r * ((const f32x4*)A.I(I_FNG))[o]; }
        }
    }
}
#ifndef MK_ONLY
#define MK_ONLY -1
#endif
#define SON(s) (MK_ONLY < 0 || MK_ONLY == (s))
#define IN(k) (lo <= (k) && (k) < hi)
#define SEAM(k) do { if (IN(k) && IN((k) + 1)) xcd_barrier(bar); } while (0)
template <int layer>
__device__ __forceinline__ void layer_body(Frame& F, const int lo, const int hi, const XcdBarrier& bar) {
    unsigned char* const ws = ka_fresh().WS();
    bf16* const H = (bf16*)(ws + WS_H);
    bf16* const PROJ = (bf16*)(ws + WS_PROJ);
    float* const XRES = (float*)(ws + WS_XRES);
    float* const MOD = (float*)(ws + WS_MOD);

        const int pb = layer ? 13 : 2;
        if (SON(2) && IN(pb)) {
            pg8::Gemm g{H, (const bf16*)(ws + (layer ? WS_WIN1T : WS_WIN0T)), MALL, layer ? N1 : N0, 1024};
            pg8::StaticOrder S; S.init(g.M, g.N, F.G, (int)blockIdx.x);
            pg8::EpiStore E{PROJ, g.N};
            pg8::gemm_phase<pg8::EpiStore, pg8::StaticOrder, true, true>(F.lds, g, S, E);
        }
        SEAM(pb);
        if (layer == 0) {
            if (SON(3) && IN(3)) rec_naive<64, true>(F, PROJ, N0, C0_Q, C0_K, C0_V, 128, 2, (float*)(ws + WS_OREC), (size_t)MALL * 512, 512, 0);
            SEAM(3);
            if (SON(4) && IN(4)) s5_naive(F, PROJ, (float*)(ws + WS_OREC) + (size_t)2 * MALL * 512);
            SEAM(4);
            if (SON(5) && IN(5)) p_finish0(F);
            SEAM(5);
            if (SON(6) && IN(6)) {
                pg8::Gemm g{(const bf16*)(ws + WS_YPRE), (const bf16*)(ws + WS_WGLUT), MALL, 512, 512};
                pg8::StaticOrder S; S.init(g.M, g.N, F.G, (int)blockIdx.x);
                pg8::EpiGlu E{(const bf16*)(ws + WS_YPRE), (bf16*)(ws + WS_MIX), 1024, 512, ka_fresh().I(I_GLUB)};
                pg8::gemm_phase<pg8::EpiGlu, pg8::StaticOrder, true, true>(F.lds, g, S, E);
            }
            SEAM(6);
        } else {
            if (SON(14) && IN(14)) p_rope(F);
            SEAM(14);
            if (SON(15) && IN(15)) rec_naive<256, false>(F, PROJ, N1, C1_Q, C1_K, C1_V, 512, 8, (float*)(ws + WS_OREC), (size_t)NLAT * 2048, 2048, NCTX);
            SEAM(15);
            if (SON(16) && IN(16)) p_finish1(F);
            SEAM(16);
        }
        const int po = layer ? 17 : 7;
        if (SON(7) && IN(po)) {
            pg8::Gemm g{(const bf16*)(ws + WS_MIX), (const bf16*)(ws + (layer ? WS_WOUT1T : WS_WOUT0T)), layer ? NLAT : MALL, 1024, layer ? 2048 : 1024};
            pg8::StaticOrder S; S.init(g.M, g.N, F.G, (int)blockIdx.x);
            pg8::EpiResid E{ka_fresh().I(I_CTX), layer ? (const float*)(XRES + (size_t)NCTX * 1024) : ka_fresh().I(I_X), XRES, MOD + (size_t)layer * 9 * 6144 + 2048, layer ? 8 : 0};
            pg8::gemm_phase<pg8::EpiResid, pg8::StaticOrder, true, true>(F.lds, g, S, E);
        }
        SEAM(po);
        if (SON(8) && IN(po + 1)) p_router(F, layer);
        SEAM(po + 1);
        if (SON(9) && IN(po + 2)) p_gather(F, layer);
        SEAM(po + 2);
        if (SON(10) && IN(po + 3)) {
            const int nt = moe_tables(F, layer);
            pg8::Gemm g{(const bf16*)(ws + WS_XG), (const bf16*)(ws + WS_WGUT) + (size_t)layer * 32 * 2048 * 1024, nt * 256, 2048, 1024};
            pg8::MoeOrder S{(const PG8_LAS unsigned char*)(F.lds + L_TILEE), nt, 8, F.G, F.vcu};
            pg8::EpiSwiglu E{(bf16*)(ws + WS_ACT), ka_fresh().I(I_BGU) + (size_t)layer * 32 * 2048};
            pg8::gemm_phase<pg8::EpiSwiglu, pg8::MoeOrder, true, true>(F.lds, g, S, E);
        }
        SEAM(po + 3);
        if (SON(11) && IN(po + 4)) {
            const int nt = moe_tables(F, layer);
            pg8::Gemm g{(const bf16*)(ws + WS_ACT), (const bf16*)(ws + WS_WDNT) + (size_t)layer * 32 * 1024 * 1024, nt * 256, 1024, 1024};
            pg8::MoeOrder S{(const PG8_LAS unsigned char*)(F.lds + L_TILEE), nt, 4, F.G, F.vcu};
            pg8::EpiDown E{(bf16*)(ws + WS_YSLOT), (const int*)(ws + WS_PROW), (const float*)(ws + WS_WSLOT), ka_fresh().I(I_BDN) + (size_t)layer * 32 * 1024};
            pg8::gemm_phase<pg8::EpiDown, pg8::MoeOrder, true, true>(F.lds, g, S, E);
        }
        SEAM(po + 4);
        if (SON(12) && IN(po + 5)) p_combine(F, layer);
        SEAM(po + 5);
    }
__global__ void __launch_bounds__(NTHR, 2) mk_fwd(Args) {
    extern __shared__ __attribute__((aligned(16))) unsigned char lds[];
    Frame F;
    F.lds = (LAS unsigned char*)lds;
    F.MISC = (volatile LAS unsigned*)(F.lds + L_MISC);
    F.tid = threadIdx.x; F.lane = F.tid & 63; F.wave = __builtin_amdgcn_readfirstlane(F.tid >> 6);
    F.G = gridDim.x; { const int bx = blockIdx.x; F.vcu = (F.G % 8 == 0) ? (bx % 8) * (F.G / 8) + bx / 8 : bx; }
    const KA A0 = ka_fresh();
    unsigned char* ws = A0.WS();
    F.ctl = (unsigned*)(ws + WS_CTL);
    if (F.tid < 64) F.MISC[F.tid] = 0u;
    __syncthreads();
    const int lo = A0.LO(), hi = A0.HI();
    XcdBarrier bar; bar.bar = F.ctl + CW_BAR; bar.x = 0; bar.st = nullptr;
    if (hi - lo > 1) bar = xcd_barrier_post(F.ctl + CW_BAR, F.MISC + 8);

    if (SON(0) && IN(0)) { p0_prologue(F); } SEAM(0);
    if (SON(1) && IN(1)) { p_norm1_l0(F); } SEAM(1);
    layer_body<0>(F, lo, hi, bar);
    layer_body<1>(F, lo, hi, bar);
}

#ifndef MK_MULTI
#define MK_MULTI 1
#endif
extern "C" void kernel_launch(void* const* d_in, const int* in_sizes, int n_in, void* d_out, int out_size, void* d_ws, size_t ws_size, hipStream_t stream) {
    static int grid = 0;
    if (grid == 0) {
        if (n_in != 34 || out_size != NLAT * D || ws_size < WS_END) { fprintf(stderr, "kernel_launch: unexpected sizes: n_in %d out %d ws %zu (need %zu)\n", n_in, out_size, ws_size, (size_t)WS_END); grid = -1; return; }
        int dev = 0, cus = 0;
        if (hipGetDevice(&dev) != hipSuccess || hipDeviceGetAttribute(&cus, hipDeviceAttributeMultiprocessorCount, dev) != hipSuccess) { grid = -1; return; }
        if (hipFuncSetAttribute((const void*)mk_fwd, hipFuncAttributeMaxDynamicSharedMemorySize, LDS_BYTES) != hipSuccess) { fprintf(stderr, "kernel_launch: hipFuncSetAttribute failed\n"); grid = -1; return; }
        int per_cu = 0;
        if (hipOccupancyMaxActiveBlocksPerMultiprocessor(&per_cu, (const void*)mk_fwd, NTHR, LDS_BYTES) != hipSuccess || per_cu < 1) fprintf(stderr, "kernel_launch: occupancy query says %d\n", per_cu);
        (void)hipGetLastError();
        grid = cus;
    }
    if (grid < 0) return;
    (void)in_sizes;
    (void)hipMemsetAsync((char*)d_ws + WS_CTL, 0, CTL_ZERO_BYTES, stream);
    Args a{};
    for (int i = 0; i < 34; ++i) a.in[i] = (const float*)d_in[i];
    a.out = (float*)d_out; a.ws = (unsigned char*)d_ws;
#if MK_MULTI
    for (int p = 0; p < NPH; ++p) { a.ph_lo = p; a.ph_hi = p + 1; hipLaunchKernelGGL(mk_fwd, dim3(grid), dim3(NTHR), LDS_BYTES, stream, a); }
#else
    a.ph_lo = 0; a.ph_hi = NPH; hipLaunchKernelGGL(mk_fwd, dim3(grid), dim3(NTHR), LDS_BYTES, stream, a);
#endif
}
```

```cpp
#include <hip/hip_runtime.h>
#include <cstdio>
#include <cstdint>
#include <cmath>
namespace pg8 {
#define PG8_LAS __attribute__((address_space(3)))
typedef unsigned short bf16_t;
typedef short bf16x8 __attribute__((ext_vector_type(8)));
typedef float f32x4 __attribute__((ext_vector_type(4)));
typedef unsigned u32x4 __attribute__((ext_vector_type(4)));
constexpr int BM = 256, BK = 64, HALF = 128, HTB = HALF * BK * 2  , STAGE_BYTES = 8 * HTB, NXCD = 8, WGM = 8;

__host__ __device__ __forceinline__ int lds_byte(int r, int c) { const int st = (r >> 4) * 2 + (c >> 5), rr = r & 15, cc = c & 31, ob = rr * 64 + cc * 2; return st * 1024 + (ob ^ (((ob >> 9) & 1) << 5)); }
__host__ __device__ __forceinline__ void stage_rc(int b, int& R, int& C) { const int st = b / 1024, sb = b % 1024, swz = sb ^ (((sb >> 9) & 1) << 5); R = (st >> 1) * 16 + swz / 64; C = (st & 1) * 32 + (swz % 64) / 2; }
__host__ __device__ __forceinline__ int perm32(int rho) { const int n = rho >> 4, i = rho & 15; return 8 * (i >> 2) + 4 * n + (i & 3); }

struct Unit { int pm, pn, pb, e; };
struct Gemm { const bf16_t* A; const bf16_t* Bt; int M, N, K; };

struct StaticOrder {
    int nM, nN, nwg, G, c;
    __host__ __device__ void init(int M, int N, int G_, int c_) { nM = M / BM; nN = N / BM; nwg = nM * nN; G = G_; c = c_; }
    __host__ __device__ bool next(int i, Unit& u) const {
        const long L = (long)i * G + c; if (L >= nwg) return false;
        int wgid = (int)L; { const int q = nwg / NXCD, r = nwg % NXCD, xcd = wgid % NXCD, off = wgid / NXCD; wgid = (xcd < r ? xcd * (q + 1) : r * (q + 1) + (xcd - r) * q) + off; }
        const int nig = WGM * nN, gid = wgid / nig, fm = gid * WGM, gsz = (nM - fm) < WGM ? (nM - fm) : WGM;
        u.pm = fm + ((wgid % nig) % gsz); u.pn = (wgid % nig) / gsz; u.pb = u.pn; u.e = 0; return true;
    }
    __device__ __forceinline__ void a_ready(const Unit&) const {}
    __device__ __forceinline__ void done(const Unit&) const {}
};
__device__ __forceinline__ unsigned cvt_pk_bf16(float lo, float hi) { unsigned r; asm volatile("v_cvt_pk_bf16_f32 %0, %1, %2" : "=v"(r) : "v"(lo), "v"(hi)); return r; }
__device__ __forceinline__ float bflo(unsigned w) { return __uint_as_float(w << 16); }
__device__ __forceinline__ float bfhi(unsigned w) { return __uint_as_float(w & 0xffff0000u); }
__device__ __forceinline__ float sigmoidf_(float z) { return 1.0f / (1.0f + __expf(-z)); }

struct EpiStore {
    static constexpr bool PERM = true, AFTER_DRAIN = false;
    bf16_t* O; int ldc;
    __device__ __forceinline__ void operator()(const f32x4 (&acc)[2][2][4][2], const Unit& u, int wr, int wc, int fr, int fq) const {
        const int row0 = u.pm * BM + wr * 64 + fr, col0 = u.pn * BM + wc * 32 + 8 * fq;
#pragma unroll
        for (int ai = 0; ai < 2; ++ai)
#pragma unroll
            for (int m = 0; m < 4; ++m) { bf16_t* rowp = O + (size_t)(row0 + ai * HALF + m * 16) * ldc + col0;
#pragma unroll
                for (int bj = 0; bj < 2; ++bj) { const f32x4 v0 = acc[ai][bj][m][0], v1 = acc[ai][bj][m][1];
                    u32x4 w; w.x = cvt_pk_bf16(v0[0], v0[1]); w.y = cvt_pk_bf16(v0[2], v0[3]); w.z = cvt_pk_bf16(v1[0], v1[1]); w.w = cvt_pk_bf16(v1[2], v1[3]);
                    *(u32x4*)(rowp + bj * HALF) = w; } }
    }
};
struct EpiGlu {
    static constexpr bool PERM = true, AFTER_DRAIN = false;
    const bf16_t* Y; bf16_t* O; int ldo, ocol0; const float* bias;
    __device__ __forceinline__ void operator()(const f32x4 (&acc)[2][2][4][2], const Unit& u, int wr, int wc, int fr, int fq) const {
        const int row0 = u.pm * BM + wr * 64 + fr, col0 = u.pn * BM + wc * 32 + 8 * fq;
        f32x4 bv[2][2];
#pragma unroll
        for (int bj = 0; bj < 2; ++bj)
#pragma unroll
            for (int n = 0; n < 2; ++n) bv[bj][n] = *(const f32x4*)(bias + col0 + bj * HALF + 4 * n);
#pragma unroll
        for (int ai = 0; ai < 2; ++ai)
#pragma unroll
            for (int m = 0; m < 4; ++m) { const size_t row = (size_t)(row0 + ai * HALF + m * 16);
#pragma unroll
                for (int bj = 0; bj < 2; ++bj) { const int c = col0 + bj * HALF;
                    const u32x4 yv = *(const u32x4*)(Y + row * 512 + c);
                    const f32x4 z0 = acc[ai][bj][m][0] + bv[bj][0], z1 = acc[ai][bj][m][1] + bv[bj][1];
                    u32x4 w;
                    w.x = cvt_pk_bf16(bflo(yv.x) * sigmoidf_(z0[0]), bfhi(yv.x) * sigmoidf_(z0[1]));
                    w.y = cvt_pk_bf16(bflo(yv.y) * sigmoidf_(z0[2]), bfhi(yv.y) * sigmoidf_(z0[3]));
                    w.z = cvt_pk_bf16(bflo(yv.z) * sigmoidf_(z1[0]), bfhi(yv.z) * sigmoidf_(z1[1]));
                    w.w = cvt_pk_bf16(bflo(yv.w) * sigmoidf_(z1[2]), bfhi(yv.w) * sigmoidf_(z1[3]));
                    *(u32x4*)(O + row * ldo + ocol0 + c) = w; } }
    }
};
struct EpiResid {
    static constexpr bool PERM = false, AFTER_DRAIN = false;
    const float* base_ctx; const float* base_lat; float* out; const float* gate; int tile0;
    __device__ __forceinline__ void operator()(const f32x4 (&acc)[2][2][4][2], const Unit& u, int wr, int wc, int fr, int fq) const {
        const int gt = u.pm + tile0, bidx = gt < 8 ? 8 : ((gt - 8) >> 4);
        const float* bt = gt < 8 ? base_ctx + (size_t)gt * 256 * 1024 : base_lat + (size_t)(gt - 8) * 256 * 1024;
        float* ot = out + (size_t)gt * 256 * 1024;
        const int col0 = u.pn * BM + wc * 32 + 4 * fq;
        f32x4 gv[2][2];
#pragma unroll
        for (int bj = 0; bj < 2; ++bj)
#pragma unroll
            for (int n = 0; n < 2; ++n) gv[bj][n] = *(const f32x4*)(gate + bidx * 6144 + col0 + bj * HALF + n * 16);
#pragma unroll
        for (int ai = 0; ai < 2; ++ai)
#pragma unroll
            for (int m = 0; m < 4; ++m) { const size_t off = (size_t)(wr * 64 + fr + ai * HALF + m * 16) * 1024 + col0;
#pragma unroll
                for (int bj = 0; bj < 2; ++bj)
#pragma unroll
                    for (int n = 0; n < 2; ++n) { const f32x4 bs = *(const f32x4*)(bt + off + bj * HALF + n * 16);
                        *(f32x4*)(ot + off + bj * HALF + n * 16) = bs + gv[bj][n] * acc[ai][bj][m][n]; } }
    }
};
struct EpiSwiglu {
    static constexpr bool PERM = true, AFTER_DRAIN = false;
    bf16_t* ACT; const float* bgu;
    __device__ __forceinline__ void operator()(const f32x4 (&acc)[2][2][4][2], const Unit& u, int wr, int wc, int fr, int fq) const {
        const int row0 = u.pm * BM + wr * 64 + fr, lc0 = u.pn * 128 + wc * 32 + 8 * fq;
        const float* bb = bgu + (size_t)u.e * 2048 + lc0;
        f32x4 bg[2], bl[2];
#pragma unroll
        for (int n = 0; n < 2; ++n) { bg[n] = *(const f32x4*)(bb + 4 * n); bl[n] = *(const f32x4*)(bb + 1024 + 4 * n); }
#pragma unroll
        for (int ai = 0; ai < 2; ++ai)
#pragma unroll
            for (int m = 0; m < 4; ++m) { float a[8];
#pragma unroll
                for (int n = 0; n < 2; ++n)
#pragma unroll
                    for (int j = 0; j < 4; ++j) { const float g = fminf(acc[ai][0][m][n][j] + bg[n][j], 7.0f); float l = acc[ai][1][m][n][j] + bl[n][j]; l = fminf(fmaxf(l, -7.0f), 7.0f);
                        a[4 * n + j] = g * sigmoidf_(1.702f * g) * (l + 1.0f); }
                u32x4 w; w.x = cvt_pk_bf16(a[0], a[1]); w.y = cvt_pk_bf16(a[2], a[3]); w.z = cvt_pk_bf16(a[4], a[5]); w.w = cvt_pk_bf16(a[6], a[7]);
                *(u32x4*)(ACT + (size_t)(row0 + ai * HALF + m * 16) * 1024 + lc0) = w; }
    }
};
struct EpiDown {
    static constexpr bool PERM = true, AFTER_DRAIN = false;
    bf16_t* Y; const int* prow_slot; const float* w_slot; const float* bdn;
    __device__ __forceinline__ void operator()(const f32x4 (&acc)[2][2][4][2], const Unit& u, int wr, int wc, int fr, int fq) const {
        const int row0 = u.pm * BM + wr * 64 + fr, col0 = u.pn * BM + wc * 32 + 8 * fq;
        f32x4 bv[2][2];
#pragma unroll
        for (int bj = 0; bj < 2; ++bj)
#pragma unroll
            for (int n = 0; n < 2; ++n) bv[bj][n] = *(const f32x4*)(bdn + (size_t)u.e * 1024 + col0 + bj * HALF + 4 * n);
#pragma unroll
        for (int ai = 0; ai < 2; ++ai)
#pragma unroll
            for (int m = 0; m < 4; ++m) { const int slot = prow_slot[row0 + ai * HALF + m * 16];
                if (slot >= 0) { const float ws = w_slot[slot]; bf16_t* rowp = Y + (size_t)slot * 1024 + col0;
#pragma unroll
                    for (int bj = 0; bj < 2; ++bj) { const f32x4 v0 = (acc[ai][bj][m][0] + bv[bj][0]) * ws, v1 = (acc[ai][bj][m][1] + bv[bj][1]) * ws;
                        u32x4 w; w.x = cvt_pk_bf16(v0[0], v0[1]); w.y = cvt_pk_bf16(v0[2], v0[3]); w.z = cvt_pk_bf16(v1[0], v1[1]); w.w = cvt_pk_bf16(v1[2], v1[3]);
                        *(u32x4*)(rowp + bj * HALF) = w; } } }
    }
};
struct MoeOrder {
    const PG8_LAS unsigned char* tile_e; int ntiles, NT, G, c;
    __device__ __forceinline__ bool next(int i, Unit& u) const {
        const int L = i * G + c; if (L >= ntiles * NT) return false;
        const int T = L / NT; u.pm = T; u.pn = L - T * NT; u.e = __builtin_amdgcn_readfirstlane((int)tile_e[T]); u.pb = u.e * NT + u.pn; return true;
    }
    __device__ __forceinline__ void a_ready(const Unit&) const {}
    __device__ __forceinline__ void done(const Unit&) const {}
};
template <class Epi, class Sched, bool ALIGN_EPI = false, bool SP2 = false>
__device__ __forceinline__ void gemm_phase(PG8_LAS unsigned char* lds, const Gemm g, const Sched& S, const Epi& E) {
    const int tid = threadIdx.x, wid = __builtin_amdgcn_readfirstlane(tid >> 6), lane = tid & 63, wr = wid >> 2, wc = wid & 3, fr = lane & 15, fq = lane >> 4;
    const int K = g.K, nt = K / BK;
    unsigned voffA[2], voffB[2];
#pragma unroll
    for (int i = 0; i < 2; ++i) { int R, C; stage_rc(tid * 16 + i * 8192, R, C); const int Rb = Epi::PERM ? ((R & ~31) + perm32(R & 31)) : R;
        voffA[i] = (unsigned)(R * K + C) * 2u; voffB[i] = (unsigned)(Rb * K + C) * 2u; }
    const size_t kstep = (size_t)(BK * 2);
    const size_t hstep = (size_t)HALF * K * 2;
    const size_t tstep = 2 * hstep;
    const unsigned ldsw = (unsigned)wid * 1024u;
    const int aoff = lds_byte(wr * 64 + fr, fq * 8), boff = lds_byte(wc * 32 + fr, fq * 8);
#define PG8_SA(b, h) (((b) * 2 + (h)) * HTB)
#define PG8_SB(b, h) ((4 + (b) * 2 + (h)) * HTB)
#define PG8_STAGE(bufoff, gbase, voff) do { _Pragma("unroll") for (int _i = 0; _i < 2; ++_i) \
        __builtin_amdgcn_global_load_lds((const unsigned*)((const char*)(gbase) + (voff)[_i]), (PG8_LAS unsigned*)(lds + (bufoff) + ldsw + _i * 8192), 16, 0, 0); } while (0)
#define PG8_LDA(dst, b, h) do { _Pragma("unroll") for (int m = 0; m < 4; ++m) _Pragma("unroll") for (int k = 0; k < 2; ++k) dst[m][k] = *(const PG8_LAS bf16x8*)(lds + PG8_SA(b, h) + aoff + m * 2048 + k * 1024); } while (0)
#define PG8_LDB(dst, b, h) do { _Pragma("unroll") for (int n = 0; n < 2; ++n) _Pragma("unroll") for (int k = 0; k < 2; ++k) dst[n][k] = *(const PG8_LAS bf16x8*)(lds + PG8_SB(b, h) + boff + n * 2048 + k * 1024); } while (0)
#define PG8_MMA(ai, bj, At, Bt) do { __builtin_amdgcn_s_setprio(1); _Pragma("unroll") for (int m = 0; m < 4; ++m) _Pragma("unroll") for (int n = 0; n < 2; ++n) _Pragma("unroll") for (int k = 0; k < 2; ++k) \
        acc[ai][bj][m][n] = __builtin_amdgcn_mfma_f32_16x16x32_bf16(Bt[n][k], At[m][k], acc[ai][bj][m][n], 0, 0, 0); __builtin_amdgcn_s_setprio(0); } while (0)
#define PG8_WAIT_V(n) asm volatile("s_waitcnt vmcnt(" #n ")" ::: "memory")
#define PG8_WAIT_L(n) asm volatile("s_waitcnt lgkmcnt(" #n ")" ::: "memory")
#define PG8_BAR __builtin_amdgcn_s_barrier()
#define PG8_SCHED __builtin_amdgcn_sched_barrier(0)
    Unit cur, nxt; int ui = 0;
    if (!S.next(0, cur)) return;
    f32x4 acc[2][2][4][2];
#pragma unroll
    for (int a = 0; a < 2; ++a)
#pragma unroll
        for (int b = 0; b < 2; ++b)
#pragma unroll
            for (int m = 0; m < 4; ++m)
#pragma unroll
                for (int n = 0; n < 2; ++n) acc[a][b][m][n] = (f32x4){0.f, 0.f, 0.f, 0.f};
    bf16x8 At[4][2], B0[2][2], B1[2][2];
    const char* cA = (const char*)g.A + (size_t)cur.pm * tstep; const char* cB = (const char*)g.Bt + (size_t)cur.pb * tstep;
    S.a_ready(cur);
    if constexpr (SP2) {
        PG8_STAGE(PG8_SB(0, 0), cB, voffB); PG8_STAGE(PG8_SB(0, 1), cB + hstep, voffB); PG8_STAGE(PG8_SA(0, 0), cA, voffA); PG8_STAGE(PG8_SA(0, 1), cA + hstep, voffA);
        if (wr == 1) PG8_BAR;
        PG8_WAIT_V(2); PG8_BAR;
        PG8_STAGE(PG8_SB(1, 0), cB + kstep, voffB); PG8_STAGE(PG8_SA(1, 0), cA + kstep, voffA); PG8_STAGE(PG8_SB(1, 1), cB + hstep + kstep, voffB);
        PG8_WAIT_V(6); PG8_BAR;
    } else {
        PG8_STAGE(PG8_SB(0, 0), cB, voffB); PG8_STAGE(PG8_SA(0, 0), cA, voffA); PG8_STAGE(PG8_SB(0, 1), cB + hstep, voffB); PG8_STAGE(PG8_SA(0, 1), cA + hstep, voffA);
        if (wr == 1) PG8_BAR;
        PG8_WAIT_V(4); PG8_BAR;
        PG8_STAGE(PG8_SB(1, 0), cB + kstep, voffB); PG8_STAGE(PG8_SA(1, 0), cA + kstep, voffA); PG8_STAGE(PG8_SB(1, 1), cB + hstep + kstep, voffB);
        PG8_WAIT_V(6); PG8_BAR;
    }
    for (;;) {
        const bool has_next = S.next(ui + 1, nxt);
        const char* nA = has_next ? (const char*)g.A + (size_t)nxt.pm * tstep : cA; const char* nB = has_next ? (const char*)g.Bt + (size_t)nxt.pb * tstep : cB;
        for (int t = 0; t < nt; t += 2) {
            const bool last = (t == nt - 2);
            const char* a1 = cA + (size_t)(t + 1) * kstep;
            const char* a2 = last ? nA : cA + (size_t)(t + 2) * kstep; const char* b2 = last ? nB : cB + (size_t)(t + 2) * kstep;
            const char* a3 = a2 + kstep; const char* b3 = b2 + kstep;
            if (last && has_next) S.a_ready(nxt);
            if constexpr (SP2) {
            PG8_LDB(B0, 0, 0); PG8_LDB(B1, 0, 1); PG8_SCHED; PG8_LDA(At, 0, 0); PG8_STAGE(PG8_SA(1, 1), a1 + hstep, voffA);
            PG8_WAIT_V(8); PG8_WAIT_L(0); PG8_BAR; PG8_MMA(0, 0, At, B0); PG8_MMA(0, 1, At, B1); PG8_BAR; PG8_SCHED;
            PG8_LDA(At, 0, 1); PG8_STAGE(PG8_SB(0, 0), b2, voffB); PG8_STAGE(PG8_SB(0, 1), b2 + hstep, voffB); PG8_STAGE(PG8_SA(0, 0), a2, voffA);
            PG8_WAIT_V(8); PG8_WAIT_L(0); PG8_BAR; PG8_MMA(1, 0, At, B0); PG8_MMA(1, 1, At, B1); PG8_BAR; PG8_SCHED;
            PG8_LDB(B0, 1, 0); PG8_LDB(B1, 1, 1); PG8_SCHED; PG8_LDA(At, 1, 0); PG8_STAGE(PG8_SA(0, 1), a2 + hstep, voffA);
            PG8_WAIT_V(8); PG8_WAIT_L(0); PG8_BAR; PG8_MMA(0, 0, At, B0); PG8_MMA(0, 1, At, B1); PG8_BAR; PG8_SCHED;
            PG8_LDA(At, 1, 1); PG8_STAGE(PG8_SB(1, 0), b3, voffB); PG8_STAGE(PG8_SB(1, 1), b3 + hstep, voffB); PG8_STAGE(PG8_SA(1, 0), a3, voffA);
            PG8_WAIT_V(8); PG8_WAIT_L(0); PG8_BAR; PG8_MMA(1, 0, At, B0); PG8_MMA(1, 1, At, B1); PG8_BAR; PG8_SCHED;
            } else {
            PG8_LDB(B0, 0, 0); PG8_SCHED; PG8_LDA(At, 0, 0); PG8_STAGE(PG8_SA(1, 1), a1 + hstep, voffA);
            PG8_WAIT_L(8); PG8_BAR; PG8_WAIT_L(0); PG8_MMA(0, 0, At, B0); PG8_BAR; PG8_SCHED;
            PG8_LDB(B1, 0, 1); PG8_STAGE(PG8_SB(0, 0), b2, voffB);
            PG8_BAR; PG8_WAIT_L(0); PG8_MMA(0, 1, At, B1); PG8_BAR;
            PG8_LDA(At, 0, 1); PG8_STAGE(PG8_SA(0, 0), a2, voffA);
            PG8_BAR; PG8_WAIT_L(0); PG8_MMA(1, 0, At, B0); PG8_BAR; PG8_SCHED;
            PG8_STAGE(PG8_SB(0, 1), b2 + hstep, voffB);
            PG8_WAIT_V(6); PG8_BAR; PG8_MMA(1, 1, At, B1); PG8_BAR;
            PG8_LDB(B0, 1, 0); PG8_SCHED; PG8_LDA(At, 1, 0); PG8_STAGE(PG8_SA(0, 1), a2 + hstep, voffA);
            PG8_WAIT_L(8); PG8_BAR; PG8_WAIT_L(0); PG8_MMA(0, 0, At, B0); PG8_BAR; PG8_SCHED;
            PG8_LDB(B1, 1, 1); PG8_STAGE(PG8_SB(1, 0), b3, voffB);
            PG8_BAR; PG8_WAIT_L(0); PG8_MMA(0, 1, At, B1); PG8_BAR;
            PG8_LDA(At, 1, 1); PG8_STAGE(PG8_SA(1, 0), a3, voffA);
            PG8_BAR; PG8_WAIT_L(0); PG8_MMA(1, 0, At, B0); PG8_BAR; PG8_SCHED;
            PG8_STAGE(PG8_SB(1, 1), b3 + hstep, voffB);
            PG8_WAIT_V(6); PG8_BAR; PG8_MMA(1, 1, At, B1); PG8_BAR;
            }
        }
        if constexpr (ALIGN_EPI) { if (wr == 0) PG8_BAR; }
        if constexpr (!Epi::AFTER_DRAIN) { E(acc, cur, wr, wc, fr, fq); S.done(cur); }
        if (!has_next) break;
#pragma unroll
        for (int a = 0; a < 2; ++a)
#pragma unroll
            for (int b = 0; b < 2; ++b)
#pragma unroll
                for (int m = 0; m < 4; ++m)
#pragma unroll
                    for (int n = 0; n < 2; ++n) acc[a][b][m][n] = (f32x4){0.f, 0.f, 0.f, 0.f};
        cur = nxt; cA = nA; cB = nB; ++ui;
        if constexpr (ALIGN_EPI) { if (wr == 1) PG8_BAR; }
    }
    PG8_WAIT_V(0);
    if constexpr (!ALIGN_EPI) { if (wr == 0) PG8_BAR; }
    PG8_BAR;
    if constexpr (Epi::AFTER_DRAIN) { E.fused(acc, cur, wr, wc, fr, fq, lds, wid, lane); S.done(cur); }
#undef PG8_SA
#undef PG8_SB
#undef PG8_STAGE
#undef PG8_LDA
#undef PG8_LDB
#undef PG8_MMA
#undef PG8_WAIT_V
#undef PG8_WAIT_L
#undef PG8_BAR
#undef PG8_SCHED
}
}
constexpr int NWAVES = 8, NTHR = 512;
constexpr int D = 1024, NB = 8, SEQ = 4096, CTX = 256;
constexpr int NCTX = NB * CTX, NLAT = NB * SEQ, MALL = NCTX + NLAT;
constexpr int N0 = 2304, N1 = 6144;
constexpr int C0_Q = 0, C0_K = 256, C0_V = 512, C0_G = 1024, C0_U = 1536, C0_LOW = 2048;
constexpr int C1_Q = 0, C1_K = 1024, C1_V = 2048, C1_G = 4096;
constexpr int NE = 32, MAXTILES = 576;
constexpr float EPS = 1e-6f;
constexpr int NPH = 23;
constexpr size_t MiB = 1u << 20;
constexpr size_t WS_CTL = 0, CTL_ZERO_BYTES = 1 * MiB;
constexpr size_t WS_MOD = 1 * MiB;
constexpr size_t WS_WIN0T = 2 * MiB, WS_WOUT0T = 7 * MiB, WS_WGLUT = 9 * MiB, WS_WIN1T = 10 * MiB, WS_WOUT1T = 22 * MiB;
constexpr size_t WS_SELE = 26 * MiB, WS_WSLOT = 27 * MiB, WS_SPOS = 28 * MiB, WS_PROW = 29 * MiB;
constexpr size_t WS_WGUT = 32 * MiB, WS_WDNT = 288 * MiB;
constexpr size_t WS_XRES = 416 * MiB, WS_H = 552 * MiB, WS_MIX = 620 * MiB, WS_YPRE = 688 * MiB;
constexpr size_t WS_PROJ = 748 * MiB, WS_OREC = 1156 * MiB;
constexpr size_t WS_XG = 748 * MiB, WS_ACT = 1036 * MiB, WS_YSLOT = 1324 * MiB;
constexpr size_t WS_END = 1668 * MiB;
constexpr int CW_TMO = 0, CW_BAR = 4096, CW_GCNT = 16384;
constexpr int RING_BYTES = 131072, LDSCTL_OFF = RING_BYTES, LDS_BYTES = 147456;
constexpr int L_MISC = LDSCTL_OFF;
constexpr int L_TILEE = LDSCTL_OFF + 256;
constexpr int L_TSTART = LDSCTL_OFF + 1024;
constexpr int L_LCNT = LDSCTL_OFF + 1280;
constexpr int L_GBASE = LDSCTL_OFF + 1536;
constexpr int L_BLKE = LDSCTL_OFF + 2048;
constexpr int L_BLKP = LDSCTL_OFF + 5120;

#define GAS __attribute__((address_space(1)))
#define LAS __attribute__((address_space(3)))
typedef unsigned short bf16;
typedef unsigned v4u __attribute__((ext_vector_type(4)));
typedef unsigned v2u __attribute__((ext_vector_type(2)));
typedef float f32x4 __attribute__((ext_vector_type(4)));
typedef GAS unsigned gu32;
#define RLX_AGENT __ATOMIC_RELAXED, __HIP_MEMORY_SCOPE_AGENT
#define LDS_WAIT() asm volatile("s_waitcnt lgkmcnt(0)" ::: "memory")
#define VM_WAIT() asm volatile("s_waitcnt vmcnt(0)" ::: "memory")
__device__ __forceinline__ unsigned f2bf(float f) { unsigned u = __builtin_bit_cast(unsigned, f); return (u + 0x7fffu + ((u >> 16) & 1u)) >> 16; }
__device__ __forceinline__ unsigned pk2(float lo, float hi) { return f2bf(lo) | (f2bf(hi) << 16); }
__device__ __forceinline__ float bf2f(unsigned b) { return __uint_as_float(b << 16); }
__device__ __forceinline__ float blo(unsigned w) { return __uint_as_float(w << 16); }
__device__ __forceinline__ float bhi(unsigned w) { return __uint_as_float(w & 0xffff0000u); }
__device__ __forceinline__ float wave_sum(float v) {
#pragma unroll
    for (int o = 1; o < 64; o <<= 1) v += __shfl_xor(v, o);
    return v;
}
__device__ __forceinline__ float silu_(float z) { return z / (1.0f + __expf(-z)); }
#define XB_TMO      128
#define XB_XCNT(j)  (256  + 64 * (j))
#define XB_XSUB(j)  (1280 + 64 * (j))
#define XB_XGEN(j)  (2304 + 64 * (j))
#define XB_TOP      3328
#define XB_TOPGEN   3392
#define XCD_BAR_WORDS 3456
#define XB_SPIN_CAP (1u << 22)

__device__ __forceinline__ unsigned xb_ld(unsigned* p)              { return __hip_atomic_load(p, __ATOMIC_RELAXED, __HIP_MEMORY_SCOPE_AGENT); }
__device__ __forceinline__ unsigned xb_add(unsigned* p, unsigned v) { return __hip_atomic_fetch_add(p, v, __ATOMIC_RELAXED, __HIP_MEMORY_SCOPE_AGENT); }
__device__ __forceinline__ unsigned xb_xcc_id() { return (unsigned)__builtin_amdgcn_s_getreg((3 << 11) | 20) & 0xFu; }
#define XB_SPIN(cond, bar) do { unsigned _sp = 0; while (cond) { __builtin_amdgcn_s_sleep(1); \
    if ((++_sp & 255u) == 0u) { if (xb_ld(&(bar)[XB_TMO])) break; if (_sp > XB_SPIN_CAP) { atomicAdd(&(bar)[XB_TMO], 1u); break; } } } } while (0)

struct XcdBarrier {
    unsigned* bar; unsigned x;
    volatile LAS unsigned* st;
};

__device__ __forceinline__ XcdBarrier xcd_barrier_post(unsigned* bar, volatile LAS unsigned* st) {
    XcdBarrier b; b.bar = bar; b.x = xb_xcc_id(); b.st = st;
    if (threadIdx.x == 0) (void)xb_add(&bar[XB_XCNT(b.x)], 1u);
    return b;
}
__device__ __forceinline__ void xcd_barrier_complete(unsigned* bar, unsigned x, unsigned& nloc, unsigned& nx) {
    const unsigned G = gridDim.x * gridDim.y * gridDim.z;
    unsigned sum, cnt, mine, sp = 0u;
    for (;;) {
        sum = 0u; cnt = 0u; mine = 0u;
#pragma unroll
        for (unsigned j = 0; j < 16; ++j) { const unsigned c = xb_ld(&bar[XB_XCNT(j)]); sum += c; cnt += (c > 0u) ? 1u : 0u; mine = (j == x) ? c : mine; }
        if (sum == G) break;
        __builtin_amdgcn_s_sleep(1);
        if ((++sp & 255u) == 0u) { if (xb_ld(&bar[XB_TMO])) break; if (sp > XB_SPIN_CAP) { atomicAdd(&bar[XB_TMO], 1u); break; } }
    }
    nloc = mine > 0u ? mine : 1u; nx = cnt > 0u ? cnt : 1u;
}

__device__ __forceinline__ void xcd_barrier(const XcdBarrier& b) {
    asm volatile("s_waitcnt vmcnt(0)" ::: "memory");
    __syncthreads();
    if (threadIdx.x == 0) {
        unsigned* bar = b.bar;
        __builtin_amdgcn_s_waitcnt(0);
        unsigned nloc = b.st[0], nx = b.st[1];
        if (nloc == 0u) { xcd_barrier_complete(bar, b.x, nloc, nx); b.st[0] = nloc; b.st[1] = nx; }
        const unsigned old = xb_add(&bar[XB_XSUB(b.x)], 1u);
        const unsigned gen = old / nloc;
        if (old + 1u == (gen + 1u) * nloc) {
            __builtin_amdgcn_fence(__ATOMIC_RELEASE, "agent");
            asm volatile("s_waitcnt vmcnt(0)" ::: "memory");
            const unsigned og = xb_add(&bar[XB_TOP], 1u);
            const unsigned tg = og / nx;
            if (og + 1u == (tg + 1u) * nx) xb_add(&bar[XB_TOPGEN], 1u);
            else XB_SPIN(xb_ld(&bar[XB_TOPGEN]) == tg, bar);
            __builtin_amdgcn_fence(__ATOMIC_ACQUIRE, "agent");
            xb_add(&bar[XB_XGEN(b.x)], 1u);
            asm volatile("s_waitcnt vmcnt(0)" ::: "memory");
        } else {
            XB_SPIN(xb_ld(&bar[XB_XGEN(b.x)]) == gen, bar);
            __builtin_amdgcn_fence(__ATOMIC_ACQUIRE, "agent");
            asm volatile("s_waitcnt vmcnt(0)" ::: "memory");
        }
    }
    __syncthreads();
}
struct Args { const float* in[34]; float* out; unsigned char* ws; int ph_lo, ph_hi; };
#define CAS __attribute__((address_space(4)))
struct KA {
    const CAS unsigned char* p;
    __device__ __forceinline__ const float* I(int i) const { return *(const float* const CAS*)(p + 8 * i); }
    __device__ __forceinline__ float* OUT() const { return *(float* const CAS*)(p + 8 * 34); }
    __device__ __forceinline__ unsigned char* WS() const { return *(unsigned char* const CAS*)(p + 8 * 35); }
    __device__ __forceinline__ int LO() const { return *(const CAS int*)(p + 8 * 36); }
    __device__ __forceinline__ int HI() const { return *(const CAS int*)(p + 8 * 36 + 4); }
};
__device__ __forceinline__ KA ka_fresh() { KA a; a.p = (const CAS unsigned char*)__builtin_amdgcn_kernarg_segment_ptr(); asm volatile("" : "+s"(a.p)); return a; }
static_assert(sizeof(Args) == 8 * 36 + 8, "kernarg layout");
struct Frame {
    LAS unsigned char* lds;
    volatile LAS unsigned* MISC;
    unsigned* ctl;
    int tid, lane, wave, vcu, G;
};
enum { I_X = 0, I_C, I_CTX, I_CCTX, I_ADAW, I_ADAB, I_N1G, I_N2G, I_ABWIN, I_ABWOUT, I_GLAWA, I_GLABA, I_GLANG, I_LAMRE, I_LAMIM, I_LOGSTEP, I_BRE, I_BIM, I_CRE, I_CIM,
       I_S5D, I_GLUW, I_GLUB, I_RETWIN, I_RETWOUT, I_RETDEC, I_RETNG, I_WROUTER, I_BROUTER, I_WGU, I_BGU, I_WDN, I_BDN, I_FNG };

__device__ __forceinline__ void tr_item(const float* src, int ldsrc, int K, int srccol, float scale, bf16* dst, int dstrow0, int k0, LAS float* scr, int lane) {
    if (srccol >= 0) {
#pragma unroll 8
        for (int i = 0; i < 32; ++i) { const int kk = 2 * i + (lane >> 5); scr[kk * 33 + (lane & 31)] = src[(size_t)(k0 + kk) * ldsrc + srccol + (lane & 31)] * scale; }
    } else {
#pragma unroll 8
        for (int i = 0; i < 32; ++i) { const int kk = 2 * i + (lane >> 5); scr[kk * 33 + (lane & 31)] = 0.f; }
    }
    LDS_WAIT(); asm volatile("" ::: "memory");
    const int c = lane & 7;
#pragma unroll
    for (int j = 0; j < 4; ++j) { const int n = (lane >> 3) + 8 * j; const LAS float* s = scr + (8 * c) * 33 + n;
        v4u o; o.x = pk2(s[0 * 33], s[1 * 33]); o.y = pk2(s[2 * 33], s[3 * 33]); o.z = pk2(s[4 * 33], s[5 * 33]); o.w = pk2(s[6 * 33], s[7 * 33]);
        *(GAS v4u*)(dst + (size_t)(dstrow0 + n) * K + k0 + 8 * c) = o; }
    LDS_WAIT(); asm volatile("" ::: "memory");
}
__device__ __forceinline__ void p0_prologue(Frame& F) {
    const KA A = ka_fresh();
    unsigned char* ws = A.WS();
    LAS float* scr = (LAS float*)(F.lds + F.wave * 8704);
    LAS float* sl = (LAS float*)(F.lds + 69632);
    for (int idx = F.tid; idx < 9 * 1024; idx += NTHR) { const int b = idx >> 10, k = idx & 1023; const float cv = b < 8 ? A.I(I_C)[b * 1024 + k] : A.I(I_CCTX)[k]; sl[k * 12 + b] = silu_(cv); }
    __syncthreads();
    const int gw = F.vcu * NWAVES + F.wave, NGW = F.G * NWAVES, lane = F.lane;
    constexpr int I_MOD = 192, I_IN0 = 1152, I_OUT0 = 512, I_GLU = 128, I_IN1 = 3072, I_OUT1 = 1024, I_GU = 65536, I_DN = 32768;
    constexpr int NITEMS = I_MOD + I_IN0 + I_OUT0 + I_GLU + I_IN1 + I_OUT1 + I_GU + I_DN;
    for (int it = gw; it < NITEMS; it += NGW) {
        int r = it;
        if (r < I_MOD) {
            const int layer = r / 96, col = (r % 96) * 64 + lane;
            const float* w = A.I(I_ADAW) + (size_t)layer * 1024 * 6144 + col;
            float acc[9];
#pragma unroll
            for (int b = 0; b < 9; ++b) acc[b] = 0.f;
            for (int k0 = 0; k0 < 1024; k0 += 8) {
                float wv[8];
#pragma unroll
                for (int u = 0; u < 8; ++u) wv[u] = w[(size_t)(k0 + u) * 6144];
#pragma unroll
                for (int u = 0; u < 8; ++u) {
#pragma unroll
                    for (int b = 0; b < 9; ++b) acc[b] += sl[(k0 + u) * 12 + b] * wv[u]; }
            }
            float* mod = (float*)(ws + WS_MOD) + (size_t)layer * 9 * 6144;
            const float bb = A.I(I_ADAB)[layer * 6144 + col];
#pragma unroll
            for (int b = 0; b < 9; ++b) mod[b * 6144 + col] = acc[b] + bb;
            continue;
        }
        r -= I_MOD;
        if (r < I_IN0) { const int kb = r / 72, n0 = (r % 72) * 32;
            const int sc = n0 < 1536 ? n0 : (n0 < 2048 ? n0 + 32 : (n0 == 2048 ? 1536 : -1));
            tr_item(A.I(I_ABWIN), 2080, 1024, sc, n0 < 256 ? 0.125f : 1.0f, (bf16*)(ws + WS_WIN0T), n0, kb * 64, scr, lane); continue; }
        r -= I_IN0;
        if (r < I_OUT0) { tr_item(A.I(I_ABWOUT), 1024, 1024, (r % 32) * 32, 1.0f, (bf16*)(ws + WS_WOUT0T), (r % 32) * 32, (r / 32) * 64, scr, lane); continue; }
        r -= I_OUT0;
        if (r < I_GLU) { tr_item(A.I(I_GLUW), 512, 512, (r % 16) * 32, 1.0f, (bf16*)(ws + WS_WGLUT), (r % 16) * 32, (r / 16) * 64, scr, lane); continue; }
        r -= I_GLU;
        if (r < I_IN1) { const int n0 = (r % 192) * 32;
            tr_item(A.I(I_RETWIN), 6144, 1024, n0, (n0 >= 1024 && n0 < 2048) ? 0.0625f : 1.0f, (bf16*)(ws + WS_WIN1T), n0, (r / 192) * 64, scr, lane); continue; }
        r -= I_IN1;
        if (r < I_OUT1) { tr_item(A.I(I_RETWOUT), 1024, 2048, (r % 32) * 32, 1.0f, (bf16*)(ws + WS_WOUT1T), (r % 32) * 32, (r / 32) * 64, scr, lane); continue; }
        r -= I_OUT1;
        if (r < I_GU) { const int mat = r >> 10, q = r & 1023, kb = q >> 6, n0 = (q & 63) * 32;
            const int pn = n0 >> 8, bj = (n0 >> 7) & 1, lc = n0 & 127;
            tr_item(A.I(I_WGU) + (size_t)mat * 1024 * 2048, 2048, 1024, bj * 1024 + pn * 128 + lc, 1.0f, (bf16*)(ws + WS_WGUT) + (size_t)mat * 2048 * 1024, n0, kb * 64, scr, lane); continue; }
        r -= I_GU;
        { const int mat = r >> 9, q = r & 511, kb = q >> 5, n0 = (q & 31) * 32;
          tr_item(A.I(I_WDN) + (size_t)mat * 1024 * 1024, 1024, 1024, n0, 1.0f, (bf16*)(ws + WS_WDNT) + (size_t)mat * 1024 * 1024, n0, kb * 64, scr, lane); }
    }
}
__device__ __forceinline__ void modnorm_store(const f32x4 (&v)[4], const float* g, const float* sc, const float* sh, bf16* hrow, int lane, f32x4 (&h)[4]) {
    float ss = 0.f;
#pragma unroll
    for (int j = 0; j < 4; ++j) ss += (v[j].x * v[j].x + v[j].y * v[j].y) + (v[j].z * v[j].z + v[j].w * v[j].w);
    const float r = rsqrtf(wave_sum(ss) * (1.0f / 1024.0f) + EPS);
#pragma unroll
    for (int j = 0; j < 4; ++j) { const int o = 64 * j + lane;
        const f32x4 gg = ((const f32x4*)g)[o], s4 = ((const f32x4*)sc)[o], h4 = ((const f32x4*)sh)[o];
        h[j] = v[j] * r * gg * (s4 + 1.0f) + h4;
        v2u w; w.x = pk2(h[j].x, h[j].y); w.y = pk2(h[j].z, h[j].w);
        ((GAS v2u*)hrow)[o] = w; }
}
__device__ __forceinline__ int bidx_of_row(int row) { return row < NCTX ? 8 : ((row - NCTX) >> 12); }
__device__ __forceinline__ void p_norm1_l0(Frame& F) {
    const KA A = ka_fresh();
    const int gw = F.vcu * NWAVES + F.wave, NGW = F.G * NWAVES, lane = F.lane;
    const float* mod = (const float*)(A.WS() + WS_MOD);
    bf16* H = (bf16*)(A.WS() + WS_H);
    for (int row = gw; row < MALL; row += NGW) {
        const float* xr = row < NCTX ? A.I(I_CTX) + (size_t)row * 1024 : A.I(I_X) + (size_t)(row - NCTX) * 1024;
        f32x4 v[4], h[4];
#pragma unroll
        for (int j = 0; j < 4; ++j) v[j] = ((const f32x4*)xr)[64 * j + lane];
        const float* m = mod + bidx_of_row(row) * 6144;
        modnorm_store(v, A.I(I_N1G), m + 1024, m, H + (size_t)row * 1024, lane, h);
    }
}
__device__ __forceinline__ int seq_row(int b, int dir, int s) {
    return s < CTX ? b * CTX + (dir ? CTX - 1 - s : s) : NCTX + b * SEQ + (dir ? SEQ - 1 - (s - CTX) : (s - CTX));
}
template <int DK, bool GLA>
__device__ __forceinline__ void rec_naive(Frame& F, const bf16* P, int ldp, int qc, int kc, int vc, int DV, int nvs,
                                          float* O, size_t odir_stride, int ldo, int orow0) {
    const KA A = ka_fresh();
    constexpr int KPW = DK / 8, TB = 16;
    LAS float* qs = (LAS float*)(F.lds);
    LAS float* ks = (LAS float*)(F.lds + 16384);
    LAS float* vv = (LAS float*)(F.lds + 32768);
    LAS float* dec = (LAS float*)(F.lds + 36864);
    LAS float* opart = (LAS float*)(F.lds + 40960);
    const int tid = F.tid, lane = F.lane, wave = F.wave;
    const int nitems = NB * 4 * 2 * nvs;
    for (int it = F.vcu; it < nitems; it += F.G) {
        const int vs = it % nvs, dir = (it / nvs) & 1, h = (it / (2 * nvs)) & 3, b = it / (8 * nvs);
        float gamma = 0.f;
        if (!GLA) { const float lg = A.I(I_RETDEC)[dir * 4 + h]; gamma = 1.0f / (1.0f + expf(-lg)); }
        float S[KPW];
#pragma unroll
        for (int i = 0; i < KPW; ++i) S[i] = 0.f;
        for (int s0 = 0; s0 < CTX + SEQ; s0 += TB) {
            for (int idx = tid; idx < TB * DK; idx += NTHR) { const int i = idx / DK, kk = idx % DK; const size_t rb = (size_t)seq_row(b, dir, s0 + i) * ldp;
                qs[idx] = bf2f(P[rb + qc + h * DK + kk]); ks[idx] = bf2f(P[rb + kc + h * DK + kk]); }
            for (int idx = tid; idx < TB * 64; idx += NTHR) { const int i = idx >> 6, c = idx & 63; const size_t rb = (size_t)seq_row(b, dir, s0 + i) * ldp;
                vv[idx] = bf2f(P[rb + vc + h * DV + vs * 64 + c]);
                if (GLA) { float z = A.I(I_GLABA)[dir * 256 + h * 64 + c];
#pragma unroll
                    for (int r = 0; r < 16; ++r) z += bf2f(P[rb + C0_LOW + dir * 16 + r]) * A.I(I_GLAWA)[(dir * 16 + r) * 256 + h * 64 + c];
                    const float ls = fminf(z, 0.f) - log1pf(expf(-fabsf(z)));
                    dec[idx] = expf(ls * (1.0f / 16.0f)); } }
            __syncthreads();
#pragma unroll 1
            for (int i = 0; i < TB; ++i) { const float vval = vv[i * 64 + lane]; float part = 0.f;
#pragma unroll
                for (int kk = 0; kk < KPW; ++kk) { const int kidx = wave * KPW + kk; const float d = GLA ? dec[i * 64 + kidx] : gamma;
                    S[kk] = d * S[kk] + ks[i * DK + kidx] * vval; part += qs[i * DK + kidx] * S[kk]; }
                opart[(i * 8 + wave) * 64 + lane] = part; }
            __syncthreads();
            for (int idx = tid; idx < TB * 64; idx += NTHR) { const int i = idx >> 6, c = idx & 63; float sum = 0.f;
#pragma unroll
                for (int w = 0; w < 8; ++w) sum += opart[(i * 8 + w) * 64 + c];
                const int row = seq_row(b, dir, s0 + i);
                if (row >= orow0) O[(size_t)dir * odir_stride + (size_t)(row - orow0) * ldo + h * DV + vs * 64 + c] = sum; }
        }
        __syncthreads();
    }
}
__device__ __forceinline__ void s5_naive(Frame& F, const bf16* P, float* Y  ) {
    const KA A = ka_fresh();
    const int lane = F.lane;
    if (F.wave >= 2) return;
    for (int chain = F.vcu * 2 + F.wave; chain < NB * 32 * 2; chain += F.G * 2) {
        const int dir = chain & 1, g = (chain >> 1) & 31, b = chain >> 6;
        const float step = expf(A.I(I_LOGSTEP)[dir * 32 + g]);
        const float lr = A.I(I_LAMRE)[(dir * 32 + g) * 64 + lane], li = A.I(I_LAMIM)[(dir * 32 + g) * 64 + lane];
        const float mag = expf(lr * step), lbr = mag * cosf(li * step), lbi = mag * sinf(li * step), den = lr * lr + li * li;
        const float fr = ((lbr - 1.0f) * lr + lbi * li) / den, fi = (lbi * lr - (lbr - 1.0f) * li) / den;
        float bbr[16], bbi[16], cr[16], ci[16];
#pragma unroll
        for (int c = 0; c < 16; ++c) { const float br = A.I(I_BRE)[(g * 64 + lane) * 16 + c], bi = A.I(I_BIM)[(g * 64 + lane) * 16 + c];
            bbr[c] = fr * br - fi * bi; bbi[c] = fr * bi + fi * br;
            cr[c] = A.I(I_CRE)[((dir * 32 + g) * 16 + c) * 64 + lane]; ci[c] = A.I(I_CIM)[((dir * 32 + g) * 16 + c) * 64 + lane]; }
        float sr = 0.f, si = 0.f;
        for (int s0 = 0; s0 < CTX + SEQ; s0 += 4) {
            v4u uu[4][2];
#pragma unroll
            for (int i = 0; i < 4; ++i) { const v4u* up = (const v4u*)(P + (size_t)seq_row(b, dir, s0 + i) * N0 + C0_U + g * 16); uu[i][0] = up[0]; uu[i][1] = up[1]; }
#pragma unroll
            for (int i = 0; i < 4; ++i) {
                float u[16];
#pragma unroll
                for (int q = 0; q < 2; ++q) { u[8 * q + 0] = blo(uu[i][q].x); u[8 * q + 1] = bhi(uu[i][q].x); u[8 * q + 2] = blo(uu[i][q].y); u[8 * q + 3] = bhi(uu[i][q].y);
                    u[8 * q + 4] = blo(uu[i][q].z); u[8 * q + 5] = bhi(uu[i][q].z); u[8 * q + 6] = blo(uu[i][q].w); u[8 * q + 7] = bhi(uu[i][q].w); }
                float br = 0.f, bi = 0.f;
#pragma unroll
                for (int c = 0; c < 16; ++c) { br += bbr[c] * u[c]; bi += bbi[c] * u[c]; }
                const float nr = lbr * sr - lbi * si + br, ni = lbr * si + lbi * sr + bi; sr = nr; si = ni;
                float v[16];
#pragma unroll
                for (int c = 0; c < 16; ++c) v[c] = cr[c] * sr - ci[c] * si;
                const bool b5 = (lane & 32) != 0, b4 = (lane & 16) != 0, b3 = (lane & 8) != 0, b2 = (lane & 4) != 0;
                float w8[8], w4[4], w2[2];
#pragma unroll
                for (int k = 0; k < 8; ++k) { const float send = b5 ? v[k] : v[k + 8], keep = b5 ? v[k + 8] : v[k]; w8[k] = keep + __shfl_xor(send, 32); }
#pragma unroll
                for (int k = 0; k < 4; ++k) { const float send = b4 ? w8[k] : w8[k + 4], keep = b4 ? w8[k + 4] : w8[k]; w4[k] = keep + __shfl_xor(send, 16); }
#pragma unroll
                for (int k = 0; k < 2; ++k) { const float send = b3 ? w4[k] : w4[k + 2], keep = b3 ? w4[k + 2] : w4[k]; w2[k] = keep + __shfl_xor(send, 8); }
                float w1; { const float send = b2 ? w2[0] : w2[1], keep = b2 ? w2[1] : w2[0]; w1 = keep + __shfl_xor(send, 4); }
                w1 += __shfl_xor(w1, 2); w1 += __shfl_xor(w1, 1);
                const int c = (b5 ? 8 : 0) + (b4 ? 4 : 0) + (b3 ? 2 : 0) + (b2 ? 1 : 0);
                if ((lane & 3) == 0) Y[(size_t)dir * MALL * 512 + (size_t)seq_row(b, dir, s0 + i) * 512 + g * 16 + c] = w1;
            }
        }
    }
}
__device__ __forceinline__ void unpack8(const v4u w, float (&f)[8]) { f[0] = blo(w.x); f[1] = bhi(w.x); f[2] = blo(w.y); f[3] = bhi(w.y); f[4] = blo(w.z); f[5] = bhi(w.z); f[6] = blo(w.w); f[7] = bhi(w.w); }
__device__ __forceinline__ v4u pack8(const float (&f)[8]) { v4u w; w.x = pk2(f[0], f[1]); w.y = pk2(f[2], f[3]); w.z = pk2(f[4], f[5]); w.w = pk2(f[6], f[7]); return w; }
__device__ __forceinline__ void p_finish0(Frame& F) {
    const KA A = ka_fresh();
    const int gw = F.vcu * NWAVES + F.wave, NGW = F.G * NWAVES, lane = F.lane, e0 = lane * 8;
    const bf16* P = (const bf16*)(A.WS() + WS_PROJ);
    const float* GO = (const float*)(A.WS() + WS_OREC);
    const float* SY = GO + (size_t)2 * MALL * 512;
    bf16* MIX = (bf16*)(A.WS() + WS_MIX); bf16* YP = (bf16*)(A.WS() + WS_YPRE);
    for (int row = gw; row < MALL; row += NGW) {
        float o[8], gg[8], ng[8];
        { const f32x4* a = (const f32x4*)(GO + (size_t)row * 512 + e0); const f32x4* bq = (const f32x4*)(GO + (size_t)(MALL + row) * 512 + e0);
          const f32x4 a0 = a[0] + bq[0], a1 = a[1] + bq[1]; o[0] = a0.x; o[1] = a0.y; o[2] = a0.z; o[3] = a0.w; o[4] = a1.x; o[5] = a1.y; o[6] = a1.z; o[7] = a1.w; }
        float ss = 0.f;
#pragma unroll
        for (int j = 0; j < 8; ++j) ss += o[j] * o[j];
        ss += __shfl_xor(ss, 1); ss += __shfl_xor(ss, 2); ss += __shfl_xor(ss, 4); ss += __shfl_xor(ss, 8);
        const float r = rsqrtf(ss * (1.0f / 128.0f) + EPS);
        unpack8(*(const v4u*)(P + (size_t)row * N0 + C0_G + e0), gg);
        { const f32x4* n4 = (const f32x4*)(A.I(I_GLANG) + (e0 & 127)); const f32x4 n0 = n4[0], n1 = n4[1]; ng[0] = n0.x; ng[1] = n0.y; ng[2] = n0.z; ng[3] = n0.w; ng[4] = n1.x; ng[5] = n1.y; ng[6] = n1.z; ng[7] = n1.w; }
        float res[8];
#pragma unroll
        for (int j = 0; j < 8; ++j) res[j] = o[j] * r * ng[j] * silu_(gg[j]);
        *(GAS v4u*)(MIX + (size_t)row * 1024 + e0) = pack8(res);
        float u[8], y[8];
        unpack8(*(const v4u*)(P + (size_t)row * N0 + C0_U + e0), u);
        { const f32x4* a = (const f32x4*)(SY + (size_t)row * 512 + e0); const f32x4* bq = (const f32x4*)(SY + (size_t)(MALL + row) * 512 + e0);
          const f32x4 a0 = a[0] + bq[0], a1 = a[1] + bq[1]; y[0] = a0.x; y[1] = a0.y; y[2] = a0.z; y[3] = a0.w; y[4] = a1.x; y[5] = a1.y; y[6] = a1.z; y[7] = a1.w; }
#pragma unroll
        for (int j = 0; j < 8; ++j) { const float t = y[j] + A.I(I_S5D)[e0 + j] * u[j]; res[j] = 0.5f * t * (1.0f + tanhf(0.7978845608f * (t + 0.044715f * t * t * t))); }
        *(GAS v4u*)(YP + (size_t)row * 512 + e0) = pack8(res);
    }
}
__device__ __forceinline__ void p_finish1(Frame& F) {
    const KA A = ka_fresh();
    const int gw = F.vcu * NWAVES + F.wave, NGW = F.G * NWAVES, lane = F.lane;
    const bf16* P = (const bf16*)(A.WS() + WS_PROJ);
    const float* RO = (const float*)(A.WS() + WS_OREC);
    bf16* MIX = (bf16*)(A.WS() + WS_MIX);
    for (int lrow = gw; lrow < NLAT; lrow += NGW) {
#pragma unroll 1
        for (int h = 0; h < 4; ++h) { const int e0 = h * 512 + lane * 8;
            float o[8], gg[8];
            { const f32x4* a = (const f32x4*)(RO + (size_t)lrow * 2048 + e0); const f32x4* bq = (const f32x4*)(RO + (size_t)(NLAT + lrow) * 2048 + e0);
              const f32x4 a0 = a[0] + bq[0], a1 = a[1] + bq[1]; o[0] = a0.x; o[1] = a0.y; o[2] = a0.z; o[3] = a0.w; o[4] = a1.x; o[5] = a1.y; o[6] = a1.z; o[7] = a1.w; }
            float s = 0.f;
#pragma unroll
            for (int j = 0; j < 8; ++j) s += o[j];
            const float mu = wave_sum(s) * (1.0f / 512.0f); float q = 0.f;
#pragma unroll
            for (int j = 0; j < 8; ++j) { o[j] -= mu; q += o[j] * o[j]; }
            const float r = rsqrtf(wave_sum(q) * (1.0f / 512.0f) + EPS);
            unpack8(*(const v4u*)(P + (size_t)(NCTX + lrow) * N1 + C1_G + e0), gg);
            float res[8];
#pragma unroll
            for (int j = 0; j < 8; ++j) res[j] = o[j] * r * A.I(I_RETNG)[e0 + j] * silu_(gg[j]);
            *(GAS v4u*)(MIX + (size_t)lrow * 2048 + e0) = pack8(res); }
    }
}
__device__ __forceinline__ void p_rope(Frame& F) {
    const KA A = ka_fresh();
    const int gw = F.vcu * NWAVES + F.wave, NGW = F.G * NWAVES, lane = F.lane;
    bf16* P = (bf16*)(A.WS() + WS_PROJ);
    const float invf = expf(-(float)lane * (9.210340371976184f / 64.0f));
    for (int lrow = gw; lrow < NLAT; lrow += NGW) {
        const int t = lrow & (SEQ - 1), pr = t >> 6, pc = t & 63;
        float sr, cr, sc, cc; sincosf((float)pr * invf, &sr, &cr); sincosf((float)pc * invf, &sc, &cc);
        bf16* rp = P + (size_t)(NCTX + lrow) * N1;
#pragma unroll 1
        for (int tb = 0; tb < 2048; tb += 256) {
            { const float a = bf2f(rp[tb + lane]), b2 = bf2f(rp[tb + 64 + lane]); rp[tb + lane] = (bf16)f2bf(a * cr - b2 * sr); rp[tb + 64 + lane] = (bf16)f2bf(a * sr + b2 * cr); }
            { const float a = bf2f(rp[tb + 128 + lane]), b2 = bf2f(rp[tb + 192 + lane]); rp[tb + 128 + lane] = (bf16)f2bf(a * cc - b2 * sc); rp[tb + 192 + lane] = (bf16)f2bf(a * sc + b2 * cc); }
        }
    }
}
__device__ __forceinline__ void p_router(Frame& F, int layer) {
    const KA A = ka_fresh();
    const int tid = F.tid, lane = F.lane, wave = F.wave;
    const int moe_row0 = layer ? NCTX : 0, NTOK = layer ? NLAT : MALL;
    const int RPB = (NTOK + F.G - 1) / F.G;
    unsigned char* ws = A.WS();
    int* prow = (int*)(ws + WS_PROW); int* sel_e = (int*)(ws + WS_SELE); float* w_slot = (float*)(ws + WS_WSLOT); int* slot_pos = (int*)(ws + WS_SPOS);
    for (int i = F.vcu * NTHR + tid; i < MAXTILES * 256; i += F.G * NTHR) prow[i] = -1;
    LAS float* Wt = (LAS float*)F.lds;
    LAS int* lcnt = (LAS int*)(F.lds + L_LCNT); LAS int* gbase = (LAS int*)(F.lds + L_GBASE);
    LAS int* blk_e = (LAS int*)(F.lds + L_BLKE); LAS int* blk_p = (LAS int*)(F.lds + L_BLKP);
    const float* wr = A.I(I_WROUTER) + (size_t)layer * 1024 * 32;
    for (int idx = tid; idx < 32768; idx += NTHR) Wt[(idx & 31) * 1024 + (idx >> 5)] = wr[idx];
    if (tid < 32) lcnt[tid] = 0;
    __syncthreads();
    const float* mod = (const float*)(ws + WS_MOD) + (size_t)layer * 9 * 6144;
    const float* XR = (const float*)(ws + WS_XRES); bf16* H = (bf16*)(ws + WS_H);
    const int tok0 = F.vcu * RPB;
    for (int lr = wave; lr < RPB; lr += NWAVES) {
        const int tok = tok0 + lr; if (tok >= NTOK) break;
        const int row = moe_row0 + tok;
        f32x4 v[4], h[4];
#pragma unroll
        for (int j = 0; j < 4; ++j) v[j] = ((const f32x4*)(XR + (size_t)row * 1024))[64 * j + lane];
        const float* m = mod + bidx_of_row(row) * 6144;
        modnorm_store(v, A.I(I_N2G) + layer * 1024, m + 4096, m + 3072, H + (size_t)row * 1024, lane, h);
        float lg[32];
#pragma unroll
        for (int e = 0; e < 32; ++e) { float a = 0.f;
#pragma unroll
            for (int j = 0; j < 4; ++j) { const f32x4 w4 = *(const LAS f32x4*)(Wt + e * 1024 + 4 * (64 * j + lane)); a += (h[j].x * w4.x + h[j].y * w4.y) + (h[j].z * w4.z + h[j].w * w4.w); }
            lg[e] = wave_sum(a) + A.I(I_BROUTER)[layer * 32 + e]; }
        float bv[4]; int bi[4];
#pragma unroll
        for (int r = 0; r < 4; ++r) { float best = -INFINITY; int be = 0;
#pragma unroll
            for (int e = 0; e < 32; ++e) { const bool take = lg[e] > best; best = take ? lg[e] : best; be = take ? e : be; }
            bv[r] = best; bi[r] = be;
#pragma unroll
            for (int e = 0; e < 32; ++e) lg[e] = (e == be) ? -INFINITY : lg[e]; }
        const float e1 = __expf(bv[1] - bv[0]), e2 = __expf(bv[2] - bv[0]), e3 = __expf(bv[3] - bv[0]), inv = 1.0f / (1.0f + e1 + e2 + e3);
        if (lane < 4) { const int ee = lane == 0 ? bi[0] : (lane == 1 ? bi[1] : (lane == 2 ? bi[2] : bi[3]));
            const float wv = (lane == 0 ? 1.0f : (lane == 1 ? e1 : (lane == 2 ? e2 : e3))) * inv;
            sel_e[tok * 4 + lane] = ee; w_slot[tok * 4 + lane] = wv;
            const int lp = __hip_atomic_fetch_add(lcnt + ee, 1, __ATOMIC_RELAXED, __HIP_MEMORY_SCOPE_WORKGROUP);
            blk_e[lr * 4 + lane] = ee; blk_p[lr * 4 + lane] = lp; }
    }
    __syncthreads();
    if (tid < 32) gbase[tid] = (int)__hip_atomic_fetch_add(F.ctl + CW_GCNT + 64 * layer + tid, (unsigned)lcnt[tid], RLX_AGENT);
    __syncthreads();
    for (int idx = tid; idx < RPB * 4; idx += NTHR) { const int tok = tok0 + (idx >> 2); if (tok < NTOK) slot_pos[tok * 4 + (idx & 3)] = gbase[blk_e[idx]] + blk_p[idx]; }
}
__device__ __forceinline__ int moe_tables(Frame& F, int layer) {
    LAS int* ts = (LAS int*)(F.lds + L_TSTART); LAS unsigned char* te = (LAS unsigned char*)(F.lds + L_TILEE);
    __syncthreads();
    if (F.tid == 0) { int acc = 0;
        for (int e = 0; e < 32; ++e) { ts[e] = acc; acc += ((int)__hip_atomic_load(F.ctl + CW_GCNT + 64 * layer + e, RLX_AGENT) + 255) >> 8; }
        ts[32] = acc > MAXTILES ? MAXTILES : acc; }
    __syncthreads();
    const int nt = ts[32];
    for (int T = F.tid; T < nt; T += NTHR) { int e = 0;
        for (int q = 1; q < 32; ++q) e = (T >= ts[q]) ? q : e;
        te[T] = (unsigned char)e; }
    __syncthreads();
    return nt;
}
__device__ __forceinline__ void p_gather(Frame& F, int layer) {
    const KA A = ka_fresh();
    const int gw = F.vcu * NWAVES + F.wave, NGW = F.G * NWAVES, lane = F.lane;
    const int moe_row0 = layer ? NCTX : 0, NTOK = layer ? NLAT : MALL;
    unsigned char* ws = A.WS();
    moe_tables(F, layer);
    const LAS int* ts = (const LAS int*)(F.lds + L_TSTART);
    int* prow = (int*)(ws + WS_PROW); const int* sel_e = (const int*)(ws + WS_SELE); const int* slot_pos = (const int*)(ws + WS_SPOS);
    const bf16* H = (const bf16*)(ws + WS_H); bf16* XG = (bf16*)(ws + WS_XG);
    for (int s = gw; s < NTOK * 4; s += NGW) {
        const int e = sel_e[s], p = ts[e] * 256 + slot_pos[s];
        const v4u* src = (const v4u*)(H + (size_t)(moe_row0 + (s >> 2)) * 1024); GAS v4u* dst = (GAS v4u*)(XG + (size_t)p * 1024);
        const v4u a = src[lane], b2 = src[64 + lane]; dst[lane] = a; dst[64 + lane] = b2;
        if (lane == 0) prow[p] = s;
    }
}
__device__ __forceinline__ void p_combine(Frame& F, int layer) {
    const KA A = ka_fresh();
    const int gw = F.vcu * NWAVES + F.wave, NGW = F.G * NWAVES, lane = F.lane;
    const int moe_row0 = layer ? NCTX : 0, NTOK = layer ? NLAT : MALL;
    unsigned char* ws = A.WS();
    float* XR = (float*)(ws + WS_XRES); bf16* H = (bf16*)(ws + WS_H); const bf16* YS = (const bf16*)(ws + WS_YSLOT);
    const float* mod = (const float*)(ws + WS_MOD);
    for (int tok = gw; tok < NTOK; tok += NGW) {
        const int row = moe_row0 + tok, bidx = bidx_of_row(row);
        const float* g2 = mod + (size_t)layer * 9 * 6144 + bidx * 6144 + 5120;
        f32x4 v[4];
#pragma unroll
        for (int j = 0; j < 4; ++j) { const int o = 64 * j + lane; f32x4 y = (f32x4){0.f, 0.f, 0.f, 0.f};
#pragma unroll
            for (int k = 0; k < 4; ++k) { const v2u w = ((const v2u*)(YS + (size_t)(tok * 4 + k) * 1024))[o]; y += (f32x4){blo(w.x), bhi(w.x), blo(w.y), bhi(w.y)}; }
            v[j] = ((const f32x4*)(XR + (size_t)row * 1024))[o] + ((const f32x4*)g2)[o] * y; }
        if (layer == 0) {
#pragma unroll
            for (int j = 0; j < 4; ++j) ((f32x4*)(XR + (size_t)row * 1024))[64 * j + lane] = v[j];
            const float* m1 = mod + (size_t)9 * 6144 + bidx * 6144; f32x4 h[4];
            modnorm_store(v, A.I(I_N1G) + 1024, m1 + 1024, m1, H + (size_t)row * 1024, lane, h);
        } else {
            float ss = 0.f;
#pragma unroll
            for (int j = 0; j < 4; ++j) ss += (v[j].x * v[j].x + v[j].y * v[j].y) + (v[j].z * v[j].z + v[j].w * v[j].w);
            const float r = rsqrtf(wave_sum(ss) * (1.0f / 1024.0f) + EPS);
#pragma unroll
            for (int j = 0; j < 4; ++j) { const int o = 64 * j + lane; ((f32x4*)(A.OUT() + (size_t)tok * 1024))[o] = v[j] * r * ((const f32x4*)A.I(I_FNG))[o]; }
        }
    }
}
#ifndef MK_ONLY
#define MK_ONLY -1
#endif
#define SON(s) (MK_ONLY < 0 || MK_ONLY == (s))
#define IN(k) (lo <= (k) && (k) < hi)
#define SEAM(k) do { if (IN(k) && IN((k) + 1)) xcd_barrier(bar); } while (0)
template <int layer>
__device__ __forceinline__ void layer_body(Frame& F, const int lo, const int hi, const XcdBarrier& bar) {
    unsigned char* const ws = ka_fresh().WS();
    bf16* const H = (bf16*)(ws + WS_H);
    bf16* const PROJ = (bf16*)(ws + WS_PROJ);
    float* const XRES = (float*)(ws + WS_XRES);
    float* const MOD = (float*)(ws + WS_MOD);

        const int pb = layer ? 13 : 2;
        if (SON(2) && IN(pb)) {
            pg8::Gemm g{H, (const bf16*)(ws + (layer ? WS_WIN1T : WS_WIN0T)), MALL, layer ? N1 : N0, 1024};
            pg8::StaticOrder S; S.init(g.M, g.N, F.G, (int)blockIdx.x);
            pg8::EpiStore E{PROJ, g.N};
            pg8::gemm_phase<pg8::EpiStore, pg8::StaticOrder, true, true>(F.lds, g, S, E);
        }
        SEAM(pb);
        if (layer == 0) {
            if (SON(3) && IN(3)) rec_naive<64, true>(F, PROJ, N0, C0_Q, C0_K, C0_V, 128, 2, (float*)(ws + WS_OREC), (size_t)MALL * 512, 512, 0);
            SEAM(3);
            if (SON(4) && IN(4)) s5_naive(F, PROJ, (float*)(ws + WS_OREC) + (size_t)2 * MALL * 512);
            SEAM(4);
            if (SON(5) && IN(5)) p_finish0(F);
            SEAM(5);
            if (SON(6) && IN(6)) {
                pg8::Gemm g{(const bf16*)(ws + WS_YPRE), (const bf16*)(ws + WS_WGLUT), MALL, 512, 512};
                pg8::StaticOrder S; S.init(g.M, g.N, F.G, (int)blockIdx.x);
                pg8::EpiGlu E{(const bf16*)(ws + WS_YPRE), (bf16*)(ws + WS_MIX), 1024, 512, ka_fresh().I(I_GLUB)};
                pg8::gemm_phase<pg8::EpiGlu, pg8::StaticOrder, true, true>(F.lds, g, S, E);
            }
            SEAM(6);
        } else {
            if (SON(14) && IN(14)) p_rope(F);
            SEAM(14);
            if (SON(15) && IN(15)) rec_naive<256, false>(F, PROJ, N1, C1_Q, C1_K, C1_V, 512, 8, (float*)(ws + WS_OREC), (size_t)NLAT * 2048, 2048, NCTX);
            SEAM(15);
            if (SON(16) && IN(16)) p_finish1(F);
            SEAM(16);
        }
        const int po = layer ? 17 : 7;
        if (SON(7) && IN(po)) {
            pg8::Gemm g{(const bf16*)(ws + WS_MIX), (const bf16*)(ws + (layer ? WS_WOUT1T : WS_WOUT0T)), layer ? NLAT : MALL, 1024, layer ? 2048 : 1024};
            pg8::StaticOrder S; S.init(g.M, g.N, F.G, (int)blockIdx.x);
            pg8::EpiResid E{ka_fresh().I(I_CTX), layer ? (const float*)(XRES + (size_t)NCTX * 1024) : ka_fresh().I(I_X), XRES, MOD + (size_t)layer * 9 * 6144 + 2048, layer ? 8 : 0};
            pg8::gemm_phase<pg8::EpiResid, pg8::StaticOrder, true, true>(F.lds, g, S, E);
        }
        SEAM(po);
        if (SON(8) && IN(po + 1)) p_router(F, layer);
        SEAM(po + 1);
        if (SON(9) && IN(po + 2)) p_gather(F, layer);
        SEAM(po + 2);
        if (SON(10) && IN(po + 3)) {
            const int nt = moe_tables(F, layer);
            pg8::Gemm g{(const bf16*)(ws + WS_XG), (const bf16*)(ws + WS_WGUT) + (size_t)layer * 32 * 2048 * 1024, nt * 256, 2048, 1024};
            pg8::MoeOrder S{(const PG8_LAS unsigned char*)(F.lds + L_TILEE), nt, 8, F.G, F.vcu};
            pg8::EpiSwiglu E{(bf16*)(ws + WS_ACT), ka_fresh().I(I_BGU) + (size_t)layer * 32 * 2048};
            pg8::gemm_phase<pg8::EpiSwiglu, pg8::MoeOrder, true, true>(F.lds, g, S, E);
        }
        SEAM(po + 3);
        if (SON(11) && IN(po + 4)) {
            const int nt = moe_tables(F, layer);
            pg8::Gemm g{(const bf16*)(ws + WS_ACT), (const bf16*)(ws + WS_WDNT) + (size_t)layer * 32 * 1024 * 1024, nt * 256, 1024, 1024};
            pg8::MoeOrder S{(const PG8_LAS unsigned char*)(F.lds + L_TILEE), nt, 4, F.G, F.vcu};
            pg8::EpiDown E{(bf16*)(ws + WS_YSLOT), (const int*)(ws + WS_PROW), (const float*)(ws + WS_WSLOT), ka_fresh().I(I_BDN) + (size_t)layer * 32 * 1024};
            pg8::gemm_phase<pg8::EpiDown, pg8::MoeOrder, true, true>(F.lds, g, S, E);
        }
        SEAM(po + 4);
        if (SON(12) && IN(po + 5)) p_combine(F, layer);
        SEAM(po + 5);
    }
__global__ void __launch_bounds__(NTHR, 2) mk_fwd(Args) {
    extern __shared__ __attribute__((aligned(16))) unsigned char lds[];
    Frame F;
    F.lds = (LAS unsigned char*)lds;
    F.MISC = (volatile LAS unsigned*)(F.lds + L_MISC);
    F.tid = threadIdx.x; F.lane = F.tid & 63; F.wave = __builtin_amdgcn_readfirstlane(F.tid >> 6);
    F.G = gridDim.x; { const int bx = blockIdx.x; F.vcu = (F.G % 8 == 0) ? (bx % 8) * (F.G / 8) + bx / 8 : bx; }
    const KA A0 = ka_fresh();
    unsigned char* ws = A0.WS();
    F.ctl = (unsigned*)(ws + WS_CTL);
    if (F.tid < 64) F.MISC[F.tid] = 0u;
    __syncthreads();
    const int lo = A0.LO(), hi = A0.HI();
    XcdBarrier bar; bar.bar = F.ctl + CW_BAR; bar.x = 0; bar.st = nullptr;
    if (hi - lo > 1) bar = xcd_barrier_post(F.ctl + CW_BAR, F.MISC + 8);

    if (SON(0) && IN(0)) { p0_prologue(F); } SEAM(0);
    if (SON(1) && IN(1)) { p_norm1_l0(F); } SEAM(1);
    layer_body<0>(F, lo, hi, bar);
    layer_body<1>(F, lo, hi, bar);
}

#ifndef MK_MULTI
#define MK_MULTI 0
#endif
extern "C" void kernel_launch(void* const* d_in, const int* in_sizes, int n_in, void* d_out, int out_size, void* d_ws, size_t ws_size, hipStream_t stream) {
    static int grid = 0;
    if (grid == 0) {
        if (n_in != 34 || out_size != NLAT * D || ws_size < WS_END) { fprintf(stderr, "kernel_launch: unexpected sizes: n_in %d out %d ws %zu (need %zu)\n", n_in, out_size, ws_size, (size_t)WS_END); grid = -1; return; }
        int dev = 0, cus = 0;
        if (hipGetDevice(&dev) != hipSuccess || hipDeviceGetAttribute(&cus, hipDeviceAttributeMultiprocessorCount, dev) != hipSuccess) { grid = -1; return; }
        if (hipFuncSetAttribute((const void*)mk_fwd, hipFuncAttributeMaxDynamicSharedMemorySize, LDS_BYTES) != hipSuccess) { fprintf(stderr, "kernel_launch: hipFuncSetAttribute failed\n"); grid = -1; return; }
        int per_cu = 0;
        if (hipOccupancyMaxActiveBlocksPerMultiprocessor(&per_cu, (const void*)mk_fwd, NTHR, LDS_BYTES) != hipSuccess || per_cu < 1) fprintf(stderr, "kernel_launch: occupancy query says %d\n", per_cu);
        (void)hipGetLastError();
        grid = cus;
    }
    if (grid < 0) return;
    (void)in_sizes;
    (void)hipMemsetAsync((char*)d_ws + WS_CTL, 0, CTL_ZERO_BYTES, stream);
    Args a{};
    for (int i = 0; i < 34; ++i) a.in[i] = (const float*)d_in[i];
    a.out = (float*)d_out; a.ws = (unsigned char*)d_ws;
#if MK_MULTI
    for (int p = 0; p < NPH; ++p) { a.ph_lo = p; a.ph_hi = p + 1; hipLaunchKernelGGL(mk_fwd, dim3(grid), dim3(NTHR), LDS_BYTES, stream, a); }
#else
    a.ph_lo = 0; a.ph_hi = NPH; hipLaunchKernelGGL(mk_fwd, dim3(grid), dim3(NTHR), LDS_BYTES, stream, a);
#endif
}
```

```cpp
#include <hip/hip_runtime.h>
#include <cstdio>
#include <cstdint>
#include <cmath>
namespace pg8 {
#define PG8_LAS __attribute__((address_space(3)))
typedef unsigned short bf16_t;
typedef short bf16x8 __attribute__((ext_vector_type(8)));
typedef float f32x4 __attribute__((ext_vector_type(4)));
typedef unsigned u32x4 __attribute__((ext_vector_type(4)));
constexpr int BM = 256, BK = 64, HALF = 128, HTB = HALF * BK * 2  , STAGE_BYTES = 8 * HTB, NXCD = 8, WGM = 8;

__host__ __device__ __forceinline__ int lds_byte(int r, int c) { const int st = (r >> 4) * 2 + (c >> 5), rr = r & 15, cc = c & 31, ob = rr * 64 + cc * 2; return st * 1024 + (ob ^ (((ob >> 9) & 1) << 5)); }
__host__ __device__ __forceinline__ void stage_rc(int b, int& R, int& C) { const int st = b / 1024, sb = b % 1024, swz = sb ^ (((sb >> 9) & 1) << 5); R = (st >> 1) * 16 + swz / 64; C = (st & 1) * 32 + (swz % 64) / 2; }
__host__ __device__ __forceinline__ int perm32(int rho) { const int n = rho >> 4, i = rho & 15; return 8 * (i >> 2) + 4 * n + (i & 3); }

struct Unit { int pm, pn, pb, e; };
struct Gemm { const bf16_t* A; const bf16_t* Bt; int M, N, K; };

struct StaticOrder {
    int nM, nN, nwg, G, c;
    __host__ __device__ void init(int M, int N, int G_, int c_) { nM = M / BM; nN = N / BM; nwg = nM * nN; G = G_; c = c_; }
    __host__ __device__ bool next(int i, Unit& u) const {
        const long L = (long)i * G + c; if (L >= nwg) return false;
        int wgid = (int)L; { const int q = nwg / NXCD, r = nwg % NXCD, xcd = wgid % NXCD, off = wgid / NXCD; wgid = (xcd < r ? xcd * (q + 1) : r * (q + 1) + (xcd - r) * q) + off; }
        const int nig = WGM * nN, gid = wgid / nig, fm = gid * WGM, gsz = (nM - fm) < WGM ? (nM - fm) : WGM;
        u.pm = fm + ((wgid % nig) % gsz); u.pn = (wgid % nig) / gsz; u.pb = u.pn; u.e = 0; return true;
    }
    __device__ __forceinline__ void a_ready(const Unit&) const {}
    __device__ __forceinline__ void done(const Unit&) const {}
};
__device__ __forceinline__ unsigned cvt_pk_bf16(float lo, float hi) { unsigned r; asm volatile("v_cvt_pk_bf16_f32 %0, %1, %2" : "=v"(r) : "v"(lo), "v"(hi)); return r; }
__device__ __forceinline__ float bflo(unsigned w) { return __uint_as_float(w << 16); }
__device__ __forceinline__ float bfhi(unsigned w) { return __uint_as_float(w & 0xffff0000u); }
__device__ __forceinline__ float sigmoidf_(float z) { return 1.0f / (1.0f + __expf(-z)); }

struct EpiStore {
    static constexpr bool PERM = true, AFTER_DRAIN = false;
    bf16_t* O; int ldc;
    __device__ __forceinline__ void operator()(const f32x4 (&acc)[2][2][4][2], const Unit& u, int wr, int wc, int fr, int fq) const {
        const int row0 = u.pm * BM + wr * 64 + fr, col0 = u.pn * BM + wc * 32 + 8 * fq;
#pragma unroll
        for (int ai = 0; ai < 2; ++ai)
#pragma unroll
            for (int m = 0; m < 4; ++m) { bf16_t* rowp = O + (size_t)(row0 + ai * HALF + m * 16) * ldc + col0;
#pragma unroll
                for (int bj = 0; bj < 2; ++bj) { const f32x4 v0 = acc[ai][bj][m][0], v1 = acc[ai][bj][m][1];
                    u32x4 w; w.x = cvt_pk_bf16(v0[0], v0[1]); w.y = cvt_pk_bf16(v0[2], v0[3]); w.z = cvt_pk_bf16(v1[0], v1[1]); w.w = cvt_pk_bf16(v1[2], v1[3]);
                    *(u32x4*)(rowp + bj * HALF) = w; } }
    }
};
struct EpiGlu {
    static constexpr bool PERM = true, AFTER_DRAIN = false;
    const bf16_t* Y; bf16_t* O; int ldo, ocol0; const float* bias;
    __device__ __forceinline__ void operator()(const f32x4 (&acc)[2][2][4][2], const Unit& u, int wr, int wc, int fr, int fq) const {
        const int row0 = u.pm * BM + wr * 64 + fr, col0 = u.pn * BM + wc * 32 + 8 * fq;
        f32x4 bv[2][2];
#pragma unroll
        for (int bj = 0; bj < 2; ++bj)
#pragma unroll
            for (int n = 0; n < 2; ++n) bv[bj][n] = *(const f32x4*)(bias + col0 + bj * HALF + 4 * n);
#pragma unroll
        for (int ai = 0; ai < 2; ++ai)
#pragma unroll
            for (int m = 0; m < 4; ++m) { const size_t row = (size_t)(row0 + ai * HALF + m * 16);
#pragma unroll
                for (int bj = 0; bj < 2; ++bj) { const int c = col0 + bj * HALF;
                    const u32x4 yv = *(const u32x4*)(Y + row * 512 + c);
                    const f32x4 z0 = acc[ai][bj][m][0] + bv[bj][0], z1 = acc[ai][bj][m][1] + bv[bj][1];
                    u32x4 w;
                    w.x = cvt_pk_bf16(bflo(yv.x) * sigmoidf_(z0[0]), bfhi(yv.x) * sigmoidf_(z0[1]));
                    w.y = cvt_pk_bf16(bflo(yv.y) * sigmoidf_(z0[2]), bfhi(yv.y) * sigmoidf_(z0[3]));
                    w.z = cvt_pk_bf16(bflo(yv.z) * sigmoidf_(z1[0]), bfhi(yv.z) * sigmoidf_(z1[1]));
                    w.w = cvt_pk_bf16(bflo(yv.w) * sigmoidf_(z1[2]), bfhi(yv.w) * sigmoidf_(z1[3]));
                    *(u32x4*)(O + row * ldo + ocol0 + c) = w; } }
    }
};
struct EpiResid {
    static constexpr bool PERM = false, AFTER_DRAIN = false;
    const float* base_ctx; const float* base_lat; float* out; const float* gate; int tile0;
    __device__ __forceinline__ void operator()(const f32x4 (&acc)[2][2][4][2], const Unit& u, int wr, int wc, int fr, int fq) const {
        const int gt = u.pm + tile0, bidx = gt < 8 ? 8 : ((gt - 8) >> 4);
        const float* bt = gt < 8 ? base_ctx + (size_t)gt * 256 * 1024 : base_lat + (size_t)(gt - 8) * 256 * 1024;
        float* ot = out + (size_t)gt * 256 * 1024;
        const int col0 = u.pn * BM + wc * 32 + 4 * fq;
        f32x4 gv[2][2];
#pragma unroll
        for (int bj = 0; bj < 2; ++bj)
#pragma unroll
            for (int n = 0; n < 2; ++n) gv[bj][n] = *(const f32x4*)(gate + bidx * 6144 + col0 + bj * HALF + n * 16);
#pragma unroll
        for (int ai = 0; ai < 2; ++ai)
#pragma unroll
            for (int m = 0; m < 4; ++m) { const size_t off = (size_t)(wr * 64 + fr + ai * HALF + m * 16) * 1024 + col0;
#pragma unroll
                for (int bj = 0; bj < 2; ++bj)
#pragma unroll
                    for (int n = 0; n < 2; ++n) { const f32x4 bs = *(const f32x4*)(bt + off + bj * HALF + n * 16);
                        *(f32x4*)(ot + off + bj * HALF + n * 16) = bs + gv[bj][n] * acc[ai][bj][m][n]; } }
    }
};
struct EpiSwiglu {
    static constexpr bool PERM = true, AFTER_DRAIN = false;
    bf16_t* ACT; const float* bgu;
    __device__ __forceinline__ void operator()(const f32x4 (&acc)[2][2][4][2], const Unit& u, int wr, int wc, int fr, int fq) const {
        const int row0 = u.pm * BM + wr * 64 + fr, lc0 = u.pn * 128 + wc * 32 + 8 * fq;
        const float* bb = bgu + (size_t)u.e * 2048 + lc0;
        f32x4 bg[2], bl[2];
#pragma unroll
        for (int n = 0; n < 2; ++n) { bg[n] = *(const f32x4*)(bb + 4 * n); bl[n] = *(const f32x4*)(bb + 1024 + 4 * n); }
#pragma unroll
        for (int ai = 0; ai < 2; ++ai)
#pragma unroll
            for (int m = 0; m < 4; ++m) { float a[8];
#pragma unroll
                for (int n = 0; n < 2; ++n)
#pragma unroll
                    for (int j = 0; j < 4; ++j) { const float g = fminf(acc[ai][0][m][n][j] + bg[n][j], 7.0f); float l = acc[ai][1][m][n][j] + bl[n][j]; l = fminf(fmaxf(l, -7.0f), 7.0f);
                        a[4 * n + j] = g * sigmoidf_(1.702f * g) * (l + 1.0f); }
                u32x4 w; w.x = cvt_pk_bf16(a[0], a[1]); w.y = cvt_pk_bf16(a[2], a[3]); w.z = cvt_pk_bf16(a[4], a[5]); w.w = cvt_pk_bf16(a[6], a[7]);
                *(u32x4*)(ACT + (size_t)(row0 + ai * HALF + m * 16) * 1024 + lc0) = w; }
    }
};
struct EpiDown {
    static constexpr bool PERM = true, AFTER_DRAIN = false;
    bf16_t* Y; const int* prow_slot; const float* w_slot; const float* bdn;
    __device__ __forceinline__ void operator()(const f32x4 (&acc)[2][2][4][2], const Unit& u, int wr, int wc, int fr, int fq) const {
        const int row0 = u.pm * BM + wr * 64 + fr, col0 = u.pn * BM + wc * 32 + 8 * fq;
        f32x4 bv[2][2];
#pragma unroll
        for (int bj = 0; bj < 2; ++bj)
#pragma unroll
            for (int n = 0; n < 2; ++n) bv[bj][n] = *(const f32x4*)(bdn + (size_t)u.e * 1024 + col0 + bj * HALF + 4 * n);
#pragma unroll
        for (int ai = 0; ai < 2; ++ai)
#pragma unroll
            for (int m = 0; m < 4; ++m) { const int slot = prow_slot[row0 + ai * HALF + m * 16];
                if (slot >= 0) { const float ws = w_slot[slot]; bf16_t* rowp = Y + (size_t)slot * 1024 + col0;
#pragma unroll
                    for (int bj = 0; bj < 2; ++bj) { const f32x4 v0 = (acc[ai][bj][m][0] + bv[bj][0]) * ws, v1 = (acc[ai][bj][m][1] + bv[bj][1]) * ws;
                        u32x4 w; w.x = cvt_pk_bf16(v0[0], v0[1]); w.y = cvt_pk_bf16(v0[2], v0[3]); w.z = cvt_pk_bf16(v1[0], v1[1]); w.w = cvt_pk_bf16(v1[2], v1[3]);
                        *(u32x4*)(rowp + bj * HALF) = w; } } }
    }
};
struct MoeOrder {
    const PG8_LAS unsigned char* tile_e; int ntiles, NT, G, c;
    __device__ __forceinline__ bool next(int i, Unit& u) const {
        const int L = i * G + c; if (L >= ntiles * NT) return false;
        const int T = L / NT; u.pm = T; u.pn = L - T * NT; u.e = __builtin_amdgcn_readfirstlane((int)tile_e[T]); u.pb = u.e * NT + u.pn; return true;
    }
    __device__ __forceinline__ void a_ready(const Unit&) const {}
    __device__ __forceinline__ void done(const Unit&) const {}
};
template <class Epi, class Sched, bool ALIGN_EPI = false, bool SP2 = false>
__device__ __forceinline__ void gemm_phase(PG8_LAS unsigned char* lds, const Gemm g, const Sched& S, const Epi& E) {
    const int tid = threadIdx.x, wid = __builtin_amdgcn_readfirstlane(tid >> 6), lane = tid & 63, wr = wid >> 2, wc = wid & 3, fr = lane & 15, fq = lane >> 4;
    const int K = g.K, nt = K / BK;
    unsigned voffA[2], voffB[2];
#pragma unroll
    for (int i = 0; i < 2; ++i) { int R, C; stage_rc(tid * 16 + i * 8192, R, C); const int Rb = Epi::PERM ? ((R & ~31) + perm32(R & 31)) : R;
        voffA[i] = (unsigned)(R * K + C) * 2u; voffB[i] = (unsigned)(Rb * K + C) * 2u; }
    const size_t kstep = (size_t)(BK * 2);
    const size_t hstep = (size_t)HALF * K * 2;
    const size_t tstep = 2 * hstep;
    const unsigned ldsw = (unsigned)wid * 1024u;
    const int aoff = lds_byte(wr * 64 + fr, fq * 8), boff = lds_byte(wc * 32 + fr, fq * 8);
#define PG8_SA(b, h) (((b) * 2 + (h)) * HTB)
#define PG8_SB(b, h) ((4 + (b) * 2 + (h)) * HTB)
#define PG8_STAGE(bufoff, gbase, voff) do { _Pragma("unroll") for (int _i = 0; _i < 2; ++_i) \
        __builtin_amdgcn_global_load_lds((const unsigned*)((const char*)(gbase) + (voff)[_i]), (PG8_LAS unsigned*)(lds + (bufoff) + ldsw + _i * 8192), 16, 0, 0); } while (0)
#define PG8_LDA(dst, b, h) do { _Pragma("unroll") for (int m = 0; m < 4; ++m) _Pragma("unroll") for (int k = 0; k < 2; ++k) dst[m][k] = *(const PG8_LAS bf16x8*)(lds + PG8_SA(b, h) + aoff + m * 2048 + k * 1024); } while (0)
#define PG8_LDB(dst, b, h) do { _Pragma("unroll") for (int n = 0; n < 2; ++n) _Pragma("unroll") for (int k = 0; k < 2; ++k) dst[n][k] = *(const PG8_LAS bf16x8*)(lds + PG8_SB(b, h) + boff + n * 2048 + k * 1024); } while (0)
#define PG8_MMA(ai, bj, At, Bt) do { __builtin_amdgcn_s_setprio(1); _Pragma("unroll") for (int m = 0; m < 4; ++m) _Pragma("unroll") for (int n = 0; n < 2; ++n) _Pragma("unroll") for (int k = 0; k < 2; ++k) \
        acc[ai][bj][m][n] = __builtin_amdgcn_mfma_f32_16x16x32_bf16(Bt[n][k], At[m][k], acc[ai][bj][m][n], 0, 0, 0); __builtin_amdgcn_s_setprio(0); } while (0)
#define PG8_WAIT_V(n) asm volatile("s_waitcnt vmcnt(" #n ")" ::: "memory")
#define PG8_WAIT_L(n) asm volatile("s_waitcnt lgkmcnt(" #n ")" ::: "memory")
#define PG8_BAR __builtin_amdgcn_s_barrier()
#define PG8_SCHED __builtin_amdgcn_sched_barrier(0)
    Unit cur, nxt; int ui = 0;
    if (!S.next(0, cur)) return;
    f32x4 acc[2][2][4][2];
#pragma unroll
    for (int a = 0; a < 2; ++a)
#pragma unroll
        for (int b = 0; b < 2; ++b)
#pragma unroll
            for (int m = 0; m < 4; ++m)
#pragma unroll
                for (int n = 0; n < 2; ++n) acc[a][b][m][n] = (f32x4){0.f, 0.f, 0.f, 0.f};
    bf16x8 At[4][2], B0[2][2], B1[2][2];
    const char* cA = (const char*)g.A + (size_t)cur.pm * tstep; const char* cB = (const char*)g.Bt + (size_t)cur.pb * tstep;
    S.a_ready(cur);
    if constexpr (SP2) {
        PG8_STAGE(PG8_SB(0, 0), cB, voffB); PG8_STAGE(PG8_SB(0, 1), cB + hstep, voffB); PG8_STAGE(PG8_SA(0, 0), cA, voffA); PG8_STAGE(PG8_SA(0, 1), cA + hstep, voffA);
        if (wr == 1) PG8_BAR;
        PG8_WAIT_V(2); PG8_BAR;
        PG8_STAGE(PG8_SB(1, 0), cB + kstep, voffB); PG8_STAGE(PG8_SA(1, 0), cA + kstep, voffA); PG8_STAGE(PG8_SB(1, 1), cB + hstep + kstep, voffB);
        PG8_WAIT_V(6); PG8_BAR;
    } else {
        PG8_STAGE(PG8_SB(0, 0), cB, voffB); PG8_STAGE(PG8_SA(0, 0), cA, voffA); PG8_STAGE(PG8_SB(0, 1), cB + hstep, voffB); PG8_STAGE(PG8_SA(0, 1), cA + hstep, voffA);
        if (wr == 1) PG8_BAR;
        PG8_WAIT_V(4); PG8_BAR;
        PG8_STAGE(PG8_SB(1, 0), cB + kstep, voffB); PG8_STAGE(PG8_SA(1, 0), cA + kstep, voffA); PG8_STAGE(PG8_SB(1, 1), cB + hstep + kstep, voffB);
        PG8_WAIT_V(6); PG8_BAR;
    }
    for (;;) {
        const bool has_next = S.next(ui + 1, nxt);
        const char* nA = has_next ? (const char*)g.A + (size_t)nxt.pm * tstep : cA; const char* nB = has_next ? (const char*)g.Bt + (size_t)nxt.pb * tstep : cB;
        for (int t = 0; t < nt; t += 2) {
            const bool last = (t == nt - 2);
            const char* a1 = cA + (size_t)(t + 1) * kstep;
            const char* a2 = last ? nA : cA + (size_t)(t + 2) * kstep; const char* b2 = last ? nB : cB + (size_t)(t + 2) * kstep;
            const char* a3 = a2 + kstep; const char* b3 = b2 + kstep;
            if (last && has_next) S.a_ready(nxt);
            if constexpr (SP2) {
            PG8_LDB(B0, 0, 0); PG8_LDB(B1, 0, 1); PG8_SCHED; PG8_LDA(At, 0, 0); PG8_STAGE(PG8_SA(1, 1), a1 + hstep, voffA);
            PG8_WAIT_V(8); PG8_WAIT_L(0); PG8_BAR; PG8_MMA(0, 0, At, B0); PG8_MMA(0, 1, At, B1); PG8_BAR; PG8_SCHED;
            PG8_LDA(At, 0, 1); PG8_STAGE(PG8_SB(0, 0), b2, voffB); PG8_STAGE(PG8_SB(0, 1), b2 + hstep, voffB); PG8_STAGE(PG8_SA(0, 0), a2, voffA);
            PG8_WAIT_V(8); PG8_WAIT_L(0); PG8_BAR; PG8_MMA(1, 0, At, B0); PG8_MMA(1, 1, At, B1); PG8_BAR; PG8_SCHED;
            PG8_LDB(B0, 1, 0); PG8_LDB(B1, 1, 1); PG8_SCHED; PG8_LDA(At, 1, 0); PG8_STAGE(PG8_SA(0, 1), a2 + hstep, voffA);
            PG8_WAIT_V(8); PG8_WAIT_L(0); PG8_BAR; PG8_MMA(0, 0, At, B0); PG8_MMA(0, 1, At, B1); PG8_BAR; PG8_SCHED;
            PG8_LDA(At, 1, 1); PG8_STAGE(PG8_SB(1, 0), b3, voffB); PG8_STAGE(PG8_SB(1, 1), b3 + hstep, voffB); PG8_STAGE(PG8_SA(1, 0), a3, voffA);
            PG8_WAIT_V(8); PG8_WAIT_L(0); PG8_BAR; PG8_MMA(1, 0, At, B0); PG8_MMA(1, 1, At, B1); PG8_BAR; PG8_SCHED;
            } else {
            PG8_LDB(B0, 0, 0); PG8_SCHED; PG8_LDA(At, 0, 0); PG8_STAGE(PG8_SA(1, 1), a1 + hstep, voffA);
            PG8_WAIT_L(8); PG8_BAR; PG8_WAIT_L(0); PG8_MMA(0, 0, At, B0); PG8_BAR; PG8_SCHED;
            PG8_LDB(B1, 0, 1); PG8_STAGE(PG8_SB(0, 0), b2, voffB);
            PG8_BAR; PG8_WAIT_L(0); PG8_MMA(0, 1, At, B1); PG8_BAR;
            PG8_LDA(At, 0, 1); PG8_STAGE(PG8_SA(0, 0), a2, voffA);
            PG8_BAR; PG8_WAIT_L(0); PG8_MMA(1, 0, At, B0); PG8_BAR; PG8_SCHED;
            PG8_STAGE(PG8_SB(0, 1), b2 + hstep, voffB);
            PG8_WAIT_V(6); PG8_BAR; PG8_MMA(1, 1, At, B1); PG8_BAR;
            PG8_LDB(B0, 1, 0); PG8_SCHED; PG8_LDA(At, 1, 0); PG8_STAGE(PG8_SA(0, 1), a2 + hstep, voffA);
            PG8_WAIT_L(8); PG8_BAR; PG8_WAIT_L(0); PG8_MMA(0, 0, At, B0); PG8_BAR; PG8_SCHED;
            PG8_LDB(B1, 1, 1); PG8_STAGE(PG8_SB(1, 0), b3, voffB);
            PG8_BAR; PG8_WAIT_L(0); PG8_MMA(0, 1, At, B1); PG8_BAR;
            PG8_LDA(At, 1, 1); PG8_STAGE(PG8_SA(1, 0), a3, voffA);
            PG8_BAR; PG8_WAIT_L(0); PG8_MMA(1, 0, At, B0); PG8_BAR; PG8_SCHED;
            PG8_STAGE(PG8_SB(1, 1), b3 + hstep, voffB);
            PG8_WAIT_V(6); PG8_BAR; PG8_MMA(1, 1, At, B1); PG8_BAR;
            }
        }
        if constexpr (ALIGN_EPI) { if (wr == 0) PG8_BAR; }
        if constexpr (!Epi::AFTER_DRAIN) { E(acc, cur, wr, wc, fr, fq); S.done(cur); }
        if (!has_next) break;
#pragma unroll
        for (int a = 0; a < 2; ++a)
#pragma unroll
            for (int b = 0; b < 2; ++b)
#pragma unroll
                for (int m = 0; m < 4; ++m)
#pragma unroll
                    for (int n = 0; n < 2; ++n) acc[a][b][m][n] = (f32x4){0.f, 0.f, 0.f, 0.f};
        cur = nxt; cA = nA; cB = nB; ++ui;
        if constexpr (ALIGN_EPI) { if (wr == 1) PG8_BAR; }
    }
    PG8_WAIT_V(0);
    if constexpr (!ALIGN_EPI) { if (wr == 0) PG8_BAR; }
    PG8_BAR;
    if constexpr (Epi::AFTER_DRAIN) { E.fused(acc, cur, wr, wc, fr, fq, lds, wid, lane); S.done(cur); }
#undef PG8_SA
#undef PG8_SB
#undef PG8_STAGE
#undef PG8_LDA
#undef PG8_LDB
#undef PG8_MMA
#undef PG8_WAIT_V
#undef PG8_WAIT_L
#undef PG8_BAR
#undef PG8_SCHED
}
}
constexpr int NWAVES = 8, NTHR = 512;
constexpr int D = 1024, NB = 8, SEQ = 4096, CTX = 256;
constexpr int NCTX = NB * CTX, NLAT = NB * SEQ, MALL = NCTX + NLAT;
constexpr int N0 = 2304, N1 = 6144;
constexpr int C0_Q = 0, C0_K = 256, C0_V = 512, C0_G = 1024, C0_U = 1536, C0_LOW = 2048;
constexpr int C1_Q = 0, C1_K = 1024, C1_V = 2048, C1_G = 4096;
constexpr int NE = 32, MAXTILES = 576;
constexpr float EPS = 1e-6f;
constexpr int NPH = 24;
enum { PH_PRO = 0, PH_NORM1, PH_INPROJ0, PH_GLAPREP, PH_GLA, PH_S5, PH_FIN0, PH_GLU, PH_OUT0, PH_ROUTER0, PH_GATHER0, PH_GU0, PH_DOWN0, PH_COMB0,
       PH_INPROJ1, PH_ROPE, PH_RET, PH_FIN1, PH_OUT1, PH_ROUTER1, PH_GATHER1, PH_GU1, PH_DOWN1, PH_COMB1 };
#ifndef MK_NAIVE_GLA
#define MK_NAIVE_GLA 0
#endif
#ifndef MK_NAIVE_RET
#define MK_NAIVE_RET 0
#endif
constexpr size_t MiB = 1u << 20;
constexpr size_t WS_CTL = 0, CTL_ZERO_BYTES = 1 * MiB;
constexpr size_t WS_MOD = 1 * MiB;
constexpr size_t WS_WIN0T = 2 * MiB, WS_WOUT0T = 7 * MiB, WS_WGLUT = 9 * MiB, WS_WIN1T = 10 * MiB, WS_WOUT1T = 22 * MiB;
constexpr size_t WS_SELE = 26 * MiB, WS_WSLOT = 27 * MiB, WS_SPOS = 28 * MiB, WS_PROW = 29 * MiB;
constexpr size_t WS_WGUT = 32 * MiB, WS_WDNT = 288 * MiB;
constexpr size_t WS_XRES = 416 * MiB, WS_H = 552 * MiB, WS_MIX = 620 * MiB, WS_YPRE = 688 * MiB;
constexpr size_t WS_PROJ = 748 * MiB, WS_OREC = 1156 * MiB;
constexpr size_t WS_XG = 748 * MiB, WS_ACT = 1036 * MiB, WS_YSLOT = 1324 * MiB;
constexpr size_t WS_END = 1668 * MiB;
constexpr int CW_TMO = 0, CW_BAR = 4096, CW_GCNT = 16384;
constexpr int RING_BYTES = 131072, LDSCTL_OFF = RING_BYTES, LDS_BYTES = 147456;
constexpr int L_MISC = LDSCTL_OFF;
constexpr int L_TILEE = LDSCTL_OFF + 256;
constexpr int L_TSTART = LDSCTL_OFF + 1024;
constexpr int L_LCNT = LDSCTL_OFF + 1280;
constexpr int L_GBASE = LDSCTL_OFF + 1536;
constexpr int L_BLKE = LDSCTL_OFF + 2048;
constexpr int L_BLKP = LDSCTL_OFF + 5120;

#define GAS __attribute__((address_space(1)))
#define LAS __attribute__((address_space(3)))
typedef unsigned short bf16;
typedef unsigned v4u __attribute__((ext_vector_type(4)));
typedef unsigned v2u __attribute__((ext_vector_type(2)));
typedef float f32x4 __attribute__((ext_vector_type(4)));
typedef GAS unsigned gu32;
#define RLX_AGENT __ATOMIC_RELAXED, __HIP_MEMORY_SCOPE_AGENT
#define LDS_WAIT() asm volatile("s_waitcnt lgkmcnt(0)" ::: "memory")
#define VM_WAIT() asm volatile("s_waitcnt vmcnt(0)" ::: "memory")
__device__ __forceinline__ unsigned f2bf(float f) { unsigned u = __builtin_bit_cast(unsigned, f); return (u + 0x7fffu + ((u >> 16) & 1u)) >> 16; }
__device__ __forceinline__ unsigned pk2(float lo, float hi) { return f2bf(lo) | (f2bf(hi) << 16); }
__device__ __forceinline__ float bf2f(unsigned b) { return __uint_as_float(b << 16); }
__device__ __forceinline__ float blo(unsigned w) { return __uint_as_float(w << 16); }
__device__ __forceinline__ float bhi(unsigned w) { return __uint_as_float(w & 0xffff0000u); }
__device__ __forceinline__ float wave_sum(float v) {
#pragma unroll
    for (int o = 1; o < 64; o <<= 1) v += __shfl_xor(v, o);
    return v;
}
__device__ __forceinline__ float silu_(float z) { return z / (1.0f + __expf(-z)); }
#define XB_TMO      128
#define XB_XCNT(j)  (256  + 64 * (j))
#define XB_XSUB(j)  (1280 + 64 * (j))
#define XB_XGEN(j)  (2304 + 64 * (j))
#define XB_TOP      3328
#define XB_TOPGEN   3392
#define XCD_BAR_WORDS 3456
#define XB_SPIN_CAP (1u << 22)

__device__ __forceinline__ unsigned xb_ld(unsigned* p)              { return __hip_atomic_load(p, __ATOMIC_RELAXED, __HIP_MEMORY_SCOPE_AGENT); }
__device__ __forceinline__ unsigned xb_add(unsigned* p, unsigned v) { return __hip_atomic_fetch_add(p, v, __ATOMIC_RELAXED, __HIP_MEMORY_SCOPE_AGENT); }
__device__ __forceinline__ unsigned xb_xcc_id() { return (unsigned)__builtin_amdgcn_s_getreg((3 << 11) | 20) & 0xFu; }
#define XB_SPIN(cond, bar) do { unsigned _sp = 0; while (cond) { __builtin_amdgcn_s_sleep(1); \
    if ((++_sp & 255u) == 0u) { if (xb_ld(&(bar)[XB_TMO])) break; if (_sp > XB_SPIN_CAP) { atomicAdd(&(bar)[XB_TMO], 1u); break; } } } } while (0)

struct XcdBarrier {
    unsigned* bar; unsigned x;
    volatile LAS unsigned* st;
};

__device__ __forceinline__ XcdBarrier xcd_barrier_post(unsigned* bar, volatile LAS unsigned* st) {
    XcdBarrier b; b.bar = bar; b.x = xb_xcc_id(); b.st = st;
    if (threadIdx.x == 0) (void)xb_add(&bar[XB_XCNT(b.x)], 1u);
    return b;
}
__device__ __forceinline__ void xcd_barrier_complete(unsigned* bar, unsigned x, unsigned& nloc, unsigned& nx) {
    const unsigned G = gridDim.x * gridDim.y * gridDim.z;
    unsigned sum, cnt, mine, sp = 0u;
    for (;;) {
        sum = 0u; cnt = 0u; mine = 0u;
#pragma unroll
        for (unsigned j = 0; j < 16; ++j) { const unsigned c = xb_ld(&bar[XB_XCNT(j)]); sum += c; cnt += (c > 0u) ? 1u : 0u; mine = (j == x) ? c : mine; }
        if (sum == G) break;
        __builtin_amdgcn_s_sleep(1);
        if ((++sp & 255u) == 0u) { if (xb_ld(&bar[XB_TMO])) break; if (sp > XB_SPIN_CAP) { atomicAdd(&bar[XB_TMO], 1u); break; } }
    }
    nloc = mine > 0u ? mine : 1u; nx = cnt > 0u ? cnt : 1u;
}

__device__ __forceinline__ void xcd_barrier(const XcdBarrier& b) {
    asm volatile("s_waitcnt vmcnt(0)" ::: "memory");
    __syncthreads();
    if (threadIdx.x == 0) {
        unsigned* bar = b.bar;
        __builtin_amdgcn_s_waitcnt(0);
        unsigned nloc = b.st[0], nx = b.st[1];
        if (nloc == 0u) { xcd_barrier_complete(bar, b.x, nloc, nx); b.st[0] = nloc; b.st[1] = nx; }
        const unsigned old = xb_add(&bar[XB_XSUB(b.x)], 1u);
        const unsigned gen = old / nloc;
        if (old + 1u == (gen + 1u) * nloc) {
            __builtin_amdgcn_fence(__ATOMIC_RELEASE, "agent");
            asm volatile("s_waitcnt vmcnt(0)" ::: "memory");
            const unsigned og = xb_add(&bar[XB_TOP], 1u);
            const unsigned tg = og / nx;
            if (og + 1u == (tg + 1u) * nx) xb_add(&bar[XB_TOPGEN], 1u);
            else XB_SPIN(xb_ld(&bar[XB_TOPGEN]) == tg, bar);
            __builtin_amdgcn_fence(__ATOMIC_ACQUIRE, "agent");
            xb_add(&bar[XB_XGEN(b.x)], 1u);
            asm volatile("s_waitcnt vmcnt(0)" ::: "memory");
        } else {
            XB_SPIN(xb_ld(&bar[XB_XGEN(b.x)]) == gen, bar);
            __builtin_amdgcn_fence(__ATOMIC_ACQUIRE, "agent");
            asm volatile("s_waitcnt vmcnt(0)" ::: "memory");
        }
    }
    __syncthreads();
}
struct Args { const float* in[34]; float* out; unsigned char* ws; int ph_lo, ph_hi; };
#define CAS __attribute__((address_space(4)))
struct KA {
    const CAS unsigned char* p;
    __device__ __forceinline__ const float* I(int i) const { return *(const float* const CAS*)(p + 8 * i); }
    __device__ __forceinline__ float* OUT() const { return *(float* const CAS*)(p + 8 * 34); }
    __device__ __forceinline__ unsigned char* WS() const { return *(unsigned char* const CAS*)(p + 8 * 35); }
    __device__ __forceinline__ int LO() const { return *(const CAS int*)(p + 8 * 36); }
    __device__ __forceinline__ int HI() const { return *(const CAS int*)(p + 8 * 36 + 4); }
};
__device__ __forceinline__ KA ka_fresh() { KA a; a.p = (const CAS unsigned char*)__builtin_amdgcn_kernarg_segment_ptr(); asm volatile("" : "+s"(a.p)); return a; }
static_assert(sizeof(Args) == 8 * 36 + 8, "kernarg layout");
struct Frame {
    LAS unsigned char* lds;
    volatile LAS unsigned* MISC;
    unsigned* ctl;
    int tid, lane, wave, vcu, G;
};
enum { I_X = 0, I_C, I_CTX, I_CCTX, I_ADAW, I_ADAB, I_N1G, I_N2G, I_ABWIN, I_ABWOUT, I_GLAWA, I_GLABA, I_GLANG, I_LAMRE, I_LAMIM, I_LOGSTEP, I_BRE, I_BIM, I_CRE, I_CIM,
       I_S5D, I_GLUW, I_GLUB, I_RETWIN, I_RETWOUT, I_RETDEC, I_RETNG, I_WROUTER, I_BROUTER, I_WGU, I_BGU, I_WDN, I_BDN, I_FNG };

__device__ __forceinline__ void tr_item(const float* src, int ldsrc, int K, int srccol, float scale, bf16* dst, int dstrow0, int k0, LAS float* scr, int lane) {
    if (srccol >= 0) {
#pragma unroll 8
        for (int i = 0; i < 32; ++i) { const int kk = 2 * i + (lane >> 5); scr[kk * 33 + (lane & 31)] = src[(size_t)(k0 + kk) * ldsrc + srccol + (lane & 31)] * scale; }
    } else {
#pragma unroll 8
        for (int i = 0; i < 32; ++i) { const int kk = 2 * i + (lane >> 5); scr[kk * 33 + (lane & 31)] = 0.f; }
    }
    LDS_WAIT(); asm volatile("" ::: "memory");
    const int c = lane & 7;
#pragma unroll
    for (int j = 0; j < 4; ++j) { const int n = (lane >> 3) + 8 * j; const LAS float* s = scr + (8 * c) * 33 + n;
        v4u o; o.x = pk2(s[0 * 33], s[1 * 33]); o.y = pk2(s[2 * 33], s[3 * 33]); o.z = pk2(s[4 * 33], s[5 * 33]); o.w = pk2(s[6 * 33], s[7 * 33]);
        *(GAS v4u*)(dst + (size_t)(dstrow0 + n) * K + k0 + 8 * c) = o; }
    LDS_WAIT(); asm volatile("" ::: "memory");
}
__device__ __forceinline__ void p0_prologue(Frame& F) {
    const KA A = ka_fresh();
    unsigned char* ws = A.WS();
    LAS float* scr = (LAS float*)(F.lds + F.wave * 8704);
    LAS float* sl = (LAS float*)(F.lds + 69632);
    for (int idx = F.tid; idx < 9 * 1024; idx += NTHR) { const int b = idx >> 10, k = idx & 1023; const float cv = b < 8 ? A.I(I_C)[b * 1024 + k] : A.I(I_CCTX)[k]; sl[k * 12 + b] = silu_(cv); }
    __syncthreads();
    const int gw = F.vcu * NWAVES + F.wave, NGW = F.G * NWAVES, lane = F.lane;
    constexpr int I_MOD = 192, I_IN0 = 1152, I_OUT0 = 512, I_GLU = 128, I_IN1 = 3072, I_OUT1 = 1024, I_GU = 65536, I_DN = 32768;
    constexpr int NITEMS = I_MOD + I_IN0 + I_OUT0 + I_GLU + I_IN1 + I_OUT1 + I_GU + I_DN;
    for (int it = gw; it < NITEMS; it += NGW) {
        int r = it;
        if (r < I_MOD) {
            const int layer = r / 96, col = (r % 96) * 64 + lane;
            const float* w = A.I(I_ADAW) + (size_t)layer * 1024 * 6144 + col;
            float acc[9];
#pragma unroll
            for (int b = 0; b < 9; ++b) acc[b] = 0.f;
            for (int k0 = 0; k0 < 1024; k0 += 8) {
                float wv[8];
#pragma unroll
                for (int u = 0; u < 8; ++u) wv[u] = w[(size_t)(k0 + u) * 6144];
#pragma unroll
                for (int u = 0; u < 8; ++u) {
#pragma unroll
                    for (int b = 0; b < 9; ++b) acc[b] += sl[(k0 + u) * 12 + b] * wv[u]; }
            }
            float* mod = (float*)(ws + WS_MOD) + (size_t)layer * 9 * 6144;
            const float bb = A.I(I_ADAB)[layer * 6144 + col];
#pragma unroll
            for (int b = 0; b < 9; ++b) mod[b * 6144 + col] = acc[b] + bb;
            continue;
        }
        r -= I_MOD;
        if (r < I_IN0) { const int kb = r / 72, n0 = (r % 72) * 32;
            const int sc = n0 < 1536 ? n0 : (n0 < 2048 ? n0 + 32 : (n0 == 2048 ? 1536 : -1));
            tr_item(A.I(I_ABWIN), 2080, 1024, sc, n0 < 256 ? 0.125f : 1.0f, (bf16*)(ws + WS_WIN0T), n0, kb * 64, scr, lane); continue; }
        r -= I_IN0;
        if (r < I_OUT0) { tr_item(A.I(I_ABWOUT), 1024, 1024, (r % 32) * 32, 1.0f, (bf16*)(ws + WS_WOUT0T), (r % 32) * 32, (r / 32) * 64, scr, lane); continue; }
        r -= I_OUT0;
        if (r < I_GLU) { tr_item(A.I(I_GLUW), 512, 512, (r % 16) * 32, 1.0f, (bf16*)(ws + WS_WGLUT), (r % 16) * 32, (r / 16) * 64, scr, lane); continue; }
        r -= I_GLU;
        if (r < I_IN1) { const int n0 = (r % 192) * 32;
            tr_item(A.I(I_RETWIN), 6144, 1024, n0, (n0 >= 1024 && n0 < 2048) ? 0.0625f : 1.0f, (bf16*)(ws + WS_WIN1T), n0, (r / 192) * 64, scr, lane); continue; }
        r -= I_IN1;
        if (r < I_OUT1) { tr_item(A.I(I_RETWOUT), 1024, 2048, (r % 32) * 32, 1.0f, (bf16*)(ws + WS_WOUT1T), (r % 32) * 32, (r / 32) * 64, scr, lane); continue; }
        r -= I_OUT1;
        if (r < I_GU) { const int mat = r >> 10, q = r & 1023, kb = q >> 6, n0 = (q & 63) * 32;
            const int pn = n0 >> 8, bj = (n0 >> 7) & 1, lc = n0 & 127;
            tr_item(A.I(I_WGU) + (size_t)mat * 1024 * 2048, 2048, 1024, bj * 1024 + pn * 128 + lc, 1.0f, (bf16*)(ws + WS_WGUT) + (size_t)mat * 2048 * 1024, n0, kb * 64, scr, lane); continue; }
        r -= I_GU;
        { const int mat = r >> 9, q = r & 511, kb = q >> 5, n0 = (q & 31) * 32;
          tr_item(A.I(I_WDN) + (size_t)mat * 1024 * 1024, 1024, 1024, n0, 1.0f, (bf16*)(ws + WS_WDNT) + (size_t)mat * 1024 * 1024, n0, kb * 64, scr, lane); }
    }
}
__device__ __forceinline__ void modnorm_store(const f32x4 (&v)[4], const float* g, const float* sc, const float* sh, bf16* hrow, int lane, f32x4 (&h)[4]) {
    float ss = 0.f;
#pragma unroll
    for (int j = 0; j < 4; ++j) ss += (v[j].x * v[j].x + v[j].y * v[j].y) + (v[j].z * v[j].z + v[j].w * v[j].w);
    const float r = rsqrtf(wave_sum(ss) * (1.0f / 1024.0f) + EPS);
#pragma unroll
    for (int j = 0; j < 4; ++j) { const int o = 64 * j + lane;
        const f32x4 gg = ((const f32x4*)g)[o], s4 = ((const f32x4*)sc)[o], h4 = ((const f32x4*)sh)[o];
        h[j] = v[j] * r * gg * (s4 + 1.0f) + h4;
        v2u w; w.x = pk2(h[j].x, h[j].y); w.y = pk2(h[j].z, h[j].w);
        ((GAS v2u*)hrow)[o] = w; }
}
__device__ __forceinline__ int bidx_of_row(int row) { return row < NCTX ? 8 : ((row - NCTX) >> 12); }
__device__ __forceinline__ void p_norm1_l0(Frame& F) {
    const KA A = ka_fresh();
    const int gw = F.vcu * NWAVES + F.wave, NGW = F.G * NWAVES, lane = F.lane;
    const float* mod = (const float*)(A.WS() + WS_MOD);
    bf16* H = (bf16*)(A.WS() + WS_H);
    for (int row = gw; row < MALL; row += NGW) {
        const float* xr = row < NCTX ? A.I(I_CTX) + (size_t)row * 1024 : A.I(I_X) + (size_t)(row - NCTX) * 1024;
        f32x4 v[4], h[4];
#pragma unroll
        for (int j = 0; j < 4; ++j) v[j] = ((const f32x4*)xr)[64 * j + lane];
        const float* m = mod + bidx_of_row(row) * 6144;
        modnorm_store(v, A.I(I_N1G), m + 1024, m, H + (size_t)row * 1024, lane, h);
    }
}
__device__ __forceinline__ int seq_row(int b, int dir, int s) {
    return s < CTX ? b * CTX + (dir ? CTX - 1 - s : s) : NCTX + b * SEQ + (dir ? SEQ - 1 - (s - CTX) : (s - CTX));
}
template <int DK, bool GLA>
__device__ __forceinline__ void rec_naive(Frame& F, const bf16* P, int ldp, int qc, int kc, int vc, int DV, int nvs,
                                          float* O, size_t odir_stride, int ldo, int orow0) {
    const KA A = ka_fresh();
    constexpr int KPW = DK / 8, TB = 16;
    LAS float* qs = (LAS float*)(F.lds);
    LAS float* ks = (LAS float*)(F.lds + 16384);
    LAS float* vv = (LAS float*)(F.lds + 32768);
    LAS float* dec = (LAS float*)(F.lds + 36864);
    LAS float* opart = (LAS float*)(F.lds + 40960);
    const int tid = F.tid, lane = F.lane, wave = F.wave;
    const int nitems = NB * 4 * 2 * nvs;
    for (int it = F.vcu; it < nitems; it += F.G) {
        const int vs = it % nvs, dir = (it / nvs) & 1, h = (it / (2 * nvs)) & 3, b = it / (8 * nvs);
        float gamma = 0.f;
        if (!GLA) { const float lg = A.I(I_RETDEC)[dir * 4 + h]; gamma = 1.0f / (1.0f + expf(-lg)); }
        float S[KPW];
#pragma unroll
        for (int i = 0; i < KPW; ++i) S[i] = 0.f;
        for (int s0 = 0; s0 < CTX + SEQ; s0 += TB) {
            for (int idx = tid; idx < TB * DK; idx += NTHR) { const int i = idx / DK, kk = idx % DK; const size_t rb = (size_t)seq_row(b, dir, s0 + i) * ldp;
                qs[idx] = bf2f(P[rb + qc + h * DK + kk]); ks[idx] = bf2f(P[rb + kc + h * DK + kk]); }
            for (int idx = tid; idx < TB * 64; idx += NTHR) { const int i = idx >> 6, c = idx & 63; const size_t rb = (size_t)seq_row(b, dir, s0 + i) * ldp;
                vv[idx] = bf2f(P[rb + vc + h * DV + vs * 64 + c]);
                if (GLA) { float z = A.I(I_GLABA)[dir * 256 + h * 64 + c];
#pragma unroll
                    for (int r = 0; r < 16; ++r) z += bf2f(P[rb + C0_LOW + dir * 16 + r]) * A.I(I_GLAWA)[(dir * 16 + r) * 256 + h * 64 + c];
                    const float ls = fminf(z, 0.f) - log1pf(expf(-fabsf(z)));
                    dec[idx] = expf(ls * (1.0f / 16.0f)); } }
            __syncthreads();
#pragma unroll 1
            for (int i = 0; i < TB; ++i) { const float vval = vv[i * 64 + lane]; float part = 0.f;
#pragma unroll
                for (int kk = 0; kk < KPW; ++kk) { const int kidx = wave * KPW + kk; const float d = GLA ? dec[i * 64 + kidx] : gamma;
                    S[kk] = d * S[kk] + ks[i * DK + kidx] * vval; part += qs[i * DK + kidx] * S[kk]; }
                opart[(i * 8 + wave) * 64 + lane] = part; }
            __syncthreads();
            for (int idx = tid; idx < TB * 64; idx += NTHR) { const int i = idx >> 6, c = idx & 63; float sum = 0.f;
#pragma unroll
                for (int w = 0; w < 8; ++w) sum += opart[(i * 8 + w) * 64 + c];
                const int row = seq_row(b, dir, s0 + i);
                if (row >= orow0) O[(size_t)dir * odir_stride + (size_t)(row - orow0) * ldo + h * DV + vs * 64 + c] = sum; }
        }
        __syncthreads();
    }
}
__device__ __forceinline__ void s5_naive(Frame& F, const bf16* P, float* Y  ) {
    const KA A = ka_fresh();
    const int lane = F.lane;
    if (F.wave >= 2) return;
    for (int chain = F.vcu * 2 + F.wave; chain < NB * 32 * 2; chain += F.G * 2) {
        const int dir = chain & 1, g = (chain >> 1) & 31, b = chain >> 6;
        const float step = expf(A.I(I_LOGSTEP)[dir * 32 + g]);
        const float lr = A.I(I_LAMRE)[(dir * 32 + g) * 64 + lane], li = A.I(I_LAMIM)[(dir * 32 + g) * 64 + lane];
        const float mag = expf(lr * step), lbr = mag * cosf(li * step), lbi = mag * sinf(li * step), den = lr * lr + li * li;
        const float fr = ((lbr - 1.0f) * lr + lbi * li) / den, fi = (lbi * lr - (lbr - 1.0f) * li) / den;
        float bbr[16], bbi[16], cr[16], ci[16];
#pragma unroll
        for (int c = 0; c < 16; ++c) { const float br = A.I(I_BRE)[(g * 64 + lane) * 16 + c], bi = A.I(I_BIM)[(g * 64 + lane) * 16 + c];
            bbr[c] = fr * br - fi * bi; bbi[c] = fr * bi + fi * br;
            cr[c] = A.I(I_CRE)[((dir * 32 + g) * 16 + c) * 64 + lane]; ci[c] = A.I(I_CIM)[((dir * 32 + g) * 16 + c) * 64 + lane]; }
        float sr = 0.f, si = 0.f;
        for (int s0 = 0; s0 < CTX + SEQ; s0 += 4) {
            v4u uu[4][2];
#pragma unroll
            for (int i = 0; i < 4; ++i) { const v4u* up = (const v4u*)(P + (size_t)seq_row(b, dir, s0 + i) * N0 + C0_U + g * 16); uu[i][0] = up[0]; uu[i][1] = up[1]; }
#pragma unroll
            for (int i = 0; i < 4; ++i) {
                float u[16];
#pragma unroll
                for (int q = 0; q < 2; ++q) { u[8 * q + 0] = blo(uu[i][q].x); u[8 * q + 1] = bhi(uu[i][q].x); u[8 * q + 2] = blo(uu[i][q].y); u[8 * q + 3] = bhi(uu[i][q].y);
                    u[8 * q + 4] = blo(uu[i][q].z); u[8 * q + 5] = bhi(uu[i][q].z); u[8 * q + 6] = blo(uu[i][q].w); u[8 * q + 7] = bhi(uu[i][q].w); }
                float br = 0.f, bi = 0.f;
#pragma unroll
                for (int c = 0; c < 16; ++c) { br += bbr[c] * u[c]; bi += bbi[c] * u[c]; }
                const float nr = lbr * sr - lbi * si + br, ni = lbr * si + lbi * sr + bi; sr = nr; si = ni;
                float v[16];
#pragma unroll
                for (int c = 0; c < 16; ++c) v[c] = cr[c] * sr - ci[c] * si;
                const bool b5 = (lane & 32) != 0, b4 = (lane & 16) != 0, b3 = (lane & 8) != 0, b2 = (lane & 4) != 0;
                float w8[8], w4[4], w2[2];
#pragma unroll
                for (int k = 0; k < 8; ++k) { const float send = b5 ? v[k] : v[k + 8], keep = b5 ? v[k + 8] : v[k]; w8[k] = keep + __shfl_xor(send, 32); }
#pragma unroll
                for (int k = 0; k < 4; ++k) { const float send = b4 ? w8[k] : w8[k + 4], keep = b4 ? w8[k + 4] : w8[k]; w4[k] = keep + __shfl_xor(send, 16); }
#pragma unroll
                for (int k = 0; k < 2; ++k) { const float send = b3 ? w4[k] : w4[k + 2], keep = b3 ? w4[k + 2] : w4[k]; w2[k] = keep + __shfl_xor(send, 8); }
                float w1; { const float send = b2 ? w2[0] : w2[1], keep = b2 ? w2[1] : w2[0]; w1 = keep + __shfl_xor(send, 4); }
                w1 += __shfl_xor(w1, 2); w1 += __shfl_xor(w1, 1);
                const int c = (b5 ? 8 : 0) + (b4 ? 4 : 0) + (b3 ? 2 : 0) + (b2 ? 1 : 0);
                if ((lane & 3) == 0) Y[(size_t)dir * MALL * 512 + (size_t)seq_row(b, dir, s0 + i) * 512 + g * 16 + c] = w1;
            }
        }
    }
}
__device__ __forceinline__ void unpack8(const v4u w, float (&f)[8]) { f[0] = blo(w.x); f[1] = bhi(w.x); f[2] = blo(w.y); f[3] = bhi(w.y); f[4] = blo(w.z); f[5] = bhi(w.z); f[6] = blo(w.w); f[7] = bhi(w.w); }
__device__ __forceinline__ v4u pack8(const float (&f)[8]) { v4u w; w.x = pk2(f[0], f[1]); w.y = pk2(f[2], f[3]); w.z = pk2(f[4], f[5]); w.w = pk2(f[6], f[7]); return w; }
__device__ __forceinline__ void p_finish0(Frame& F) {
    const KA A = ka_fresh();
    const int gw = F.vcu * NWAVES + F.wave, NGW = F.G * NWAVES, lane = F.lane, e0 = lane * 8;
    const bf16* P = (const bf16*)(A.WS() + WS_PROJ);
    const float* GO = (const float*)(A.WS() + WS_OREC);
    const float* SY = GO + (size_t)2 * MALL * 512;
    bf16* MIX = (bf16*)(A.WS() + WS_MIX); bf16* YP = (bf16*)(A.WS() + WS_YPRE);
    for (int row = gw; row < MALL; row += NGW) {
        float o[8], gg[8], ng[8];
#if MK_NAIVE_GLA
        { const f32x4* a = (const f32x4*)(GO + (size_t)row * 512 + e0); const f32x4* bq = (const f32x4*)(GO + (size_t)(MALL + row) * 512 + e0);
          const f32x4 a0 = a[0] + bq[0], a1 = a[1] + bq[1]; o[0] = a0.x; o[1] = a0.y; o[2] = a0.z; o[3] = a0.w; o[4] = a1.x; o[5] = a1.y; o[6] = a1.z; o[7] = a1.w; }
#else
        { const bf16* GO16 = (const bf16*)GO; float f0[8], f1[8]; unpack8(*(const v4u*)(GO16 + (size_t)row * 512 + e0), f0); unpack8(*(const v4u*)(GO16 + (size_t)(MALL + row) * 512 + e0), f1);
#pragma unroll
          for (int j = 0; j < 8; ++j) o[j] = f0[j] + f1[j]; }
#endif
        float ss = 0.f;
#pragma unroll
        for (int j = 0; j < 8; ++j) ss += o[j] * o[j];
        ss += __shfl_xor(ss, 1); ss += __shfl_xor(ss, 2); ss += __shfl_xor(ss, 4); ss += __shfl_xor(ss, 8);
        const float r = rsqrtf(ss * (1.0f / 128.0f) + EPS);
        unpack8(*(const v4u*)(P + (size_t)row * N0 + C0_G + e0), gg);
        { const f32x4* n4 = (const f32x4*)(A.I(I_GLANG) + (e0 & 127)); const f32x4 n0 = n4[0], n1 = n4[1]; ng[0] = n0.x; ng[1] = n0.y; ng[2] = n0.z; ng[3] = n0.w; ng[4] = n1.x; ng[5] = n1.y; ng[6] = n1.z; ng[7] = n1.w; }
        float res[8];
#pragma unroll
        for (int j = 0; j < 8; ++j) res[j] = o[j] * r * ng[j] * silu_(gg[j]);
        *(GAS v4u*)(MIX + (size_t)row * 1024 + e0) = pack8(res);
        float u[8], y[8];
        unpack8(*(const v4u*)(P + (size_t)row * N0 + C0_U + e0), u);
        { const f32x4* a = (const f32x4*)(SY + (size_t)row * 512 + e0); const f32x4* bq = (const f32x4*)(SY + (size_t)(MALL + row) * 512 + e0);
          const f32x4 a0 = a[0] + bq[0], a1 = a[1] + bq[1]; y[0] = a0.x; y[1] = a0.y; y[2] = a0.z; y[3] = a0.w; y[4] = a1.x; y[5] = a1.y; y[6] = a1.z; y[7] = a1.w; }
#pragma unroll
        for (int j = 0; j < 8; ++j) { const float t = y[j] + A.I(I_S5D)[e0 + j] * u[j]; res[j] = 0.5f * t * (1.0f + tanhf(0.7978845608f * (t + 0.044715f * t * t * t))); }
        *(GAS v4u*)(YP + (size_t)row * 512 + e0) = pack8(res);
    }
}
__device__ __forceinline__ void p_finish1(Frame& F) {
    const KA A = ka_fresh();
    const int gw = F.vcu * NWAVES + F.wave, NGW = F.G * NWAVES, lane = F.lane;
    const bf16* P = (const bf16*)(A.WS() + WS_PROJ);
    const float* RO = (const float*)(A.WS() + WS_OREC);
    bf16* MIX = (bf16*)(A.WS() + WS_MIX);
    for (int lrow = gw; lrow < NLAT; lrow += NGW) {
#pragma unroll 1
        for (int h = 0; h < 4; ++h) { const int e0 = h * 512 + lane * 8;
            float o[8], gg[8];
#if MK_NAIVE_RET
            { const f32x4* a = (const f32x4*)(RO + (size_t)lrow * 2048 + e0); const f32x4* bq = (const f32x4*)(RO + (size_t)(NLAT + lrow) * 2048 + e0);
              const f32x4 a0 = a[0] + bq[0], a1 = a[1] + bq[1]; o[0] = a0.x; o[1] = a0.y; o[2] = a0.z; o[3] = a0.w; o[4] = a1.x; o[5] = a1.y; o[6] = a1.z; o[7] = a1.w; }
#else
            { const bf16* RO16 = (const bf16*)RO; float f0[8], f1[8]; unpack8(*(const v4u*)(RO16 + (size_t)lrow * 2048 + e0), f0); unpack8(*(const v4u*)(RO16 + (size_t)(NLAT + lrow) * 2048 + e0), f1);
#pragma unroll
              for (int j = 0; j < 8; ++j) o[j] = f0[j] + f1[j]; }
#endif
            float s = 0.f;
#pragma unroll
            for (int j = 0; j < 8; ++j) s += o[j];
            const float mu = wave_sum(s) * (1.0f / 512.0f); float q = 0.f;
#pragma unroll
            for (int j = 0; j < 8; ++j) { o[j] -= mu; q += o[j] * o[j]; }
            const float r = rsqrtf(wave_sum(q) * (1.0f / 512.0f) + EPS);
            unpack8(*(const v4u*)(P + (size_t)(NCTX + lrow) * N1 + C1_G + e0), gg);
            float res[8];
#pragma unroll
            for (int j = 0; j < 8; ++j) res[j] = o[j] * r * A.I(I_RETNG)[e0 + j] * silu_(gg[j]);
            *(GAS v4u*)(MIX + (size_t)lrow * 2048 + e0) = pack8(res); }
    }
}
__device__ __forceinline__ void p_rope(Frame& F) {
    const KA A = ka_fresh();
    const int gw = F.vcu * NWAVES + F.wave, NGW = F.G * NWAVES, lane = F.lane;
    bf16* P = (bf16*)(A.WS() + WS_PROJ);
    const float invf = expf(-(float)lane * (9.210340371976184f / 64.0f));
    for (int lrow = gw; lrow < NLAT; lrow += NGW) {
        const int t = lrow & (SEQ - 1), pr = t >> 6, pc = t & 63;
        float sr, cr, sc, cc; sincosf((float)pr * invf, &sr, &cr); sincosf((float)pc * invf, &sc, &cc);
        bf16* rp = P + (size_t)(NCTX + lrow) * N1;
#pragma unroll 1
        for (int tb = 0; tb < 2048; tb += 256) {
            { const float a = bf2f(rp[tb + lane]), b2 = bf2f(rp[tb + 64 + lane]); rp[tb + lane] = (bf16)f2bf(a * cr - b2 * sr); rp[tb + 64 + lane] = (bf16)f2bf(a * sr + b2 * cr); }
            { const float a = bf2f(rp[tb + 128 + lane]), b2 = bf2f(rp[tb + 192 + lane]); rp[tb + 128 + lane] = (bf16)f2bf(a * cc - b2 * sc); rp[tb + 192 + lane] = (bf16)f2bf(a * sc + b2 * cc); }
        }
    }
}
__device__ __forceinline__ void p_router(Frame& F, int layer) {
    const KA A = ka_fresh();
    const int tid = F.tid, lane = F.lane, wave = F.wave;
    const int moe_row0 = layer ? NCTX : 0, NTOK = layer ? NLAT : MALL;
    const int RPB = (NTOK + F.G - 1) / F.G;
    unsigned char* ws = A.WS();
    int* prow = (int*)(ws + WS_PROW); int* sel_e = (int*)(ws + WS_SELE); float* w_slot = (float*)(ws + WS_WSLOT); int* slot_pos = (int*)(ws + WS_SPOS);
    for (int i = F.vcu * NTHR + tid; i < MAXTILES * 256; i += F.G * NTHR) prow[i] = -1;
    LAS float* Wt = (LAS float*)F.lds;
    LAS int* lcnt = (LAS int*)(F.lds + L_LCNT); LAS int* gbase = (LAS int*)(F.lds + L_GBASE);
    LAS int* blk_e = (LAS int*)(F.lds + L_BLKE); LAS int* blk_p = (LAS int*)(F.lds + L_BLKP);
    const float* wr = A.I(I_WROUTER) + (size_t)layer * 1024 * 32;
    for (int idx = tid; idx < 32768; idx += NTHR) Wt[(idx & 31) * 1024 + (idx >> 5)] = wr[idx];
    if (tid < 32) lcnt[tid] = 0;
    __syncthreads();
    const float* mod = (const float*)(ws + WS_MOD) + (size_t)layer * 9 * 6144;
    const float* XR = (const float*)(ws + WS_XRES); bf16* H = (bf16*)(ws + WS_H);
    const int tok0 = F.vcu * RPB;
    for (int lr = wave; lr < RPB; lr += NWAVES) {
        const int tok = tok0 + lr; if (tok >= NTOK) break;
        const int row = moe_row0 + tok;
        f32x4 v[4], h[4];
#pragma unroll
        for (int j = 0; j < 4; ++j) v[j] = ((const f32x4*)(XR + (size_t)row * 1024))[64 * j + lane];
        const float* m = mod + bidx_of_row(row) * 6144;
        modnorm_store(v, A.I(I_N2G) + layer * 1024, m + 4096, m + 3072, H + (size_t)row * 1024, lane, h);
        float lg[32];
#pragma unroll
        for (int e = 0; e < 32; ++e) { float a = 0.f;
#pragma unroll
            for (int j = 0; j < 4; ++j) { const f32x4 w4 = *(const LAS f32x4*)(Wt + e * 1024 + 4 * (64 * j + lane)); a += (h[j].x * w4.x + h[j].y * w4.y) + (h[j].z * w4.z + h[j].w * w4.w); }
            lg[e] = wave_sum(a) + A.I(I_BROUTER)[layer * 32 + e]; }
        float bv[4]; int bi[4];
#pragma unroll
        for (int r = 0; r < 4; ++r) { float best = -INFINITY; int be = 0;
#pragma unroll
            for (int e = 0; e < 32; ++e) { const bool take = lg[e] > best; best = take ? lg[e] : best; be = take ? e : be; }
            bv[r] = best; bi[r] = be;
#pragma unroll
            for (int e = 0; e < 32; ++e) lg[e] = (e == be) ? -INFINITY : lg[e]; }
        const float e1 = __expf(bv[1] - bv[0]), e2 = __expf(bv[2] - bv[0]), e3 = __expf(bv[3] - bv[0]), inv = 1.0f / (1.0f + e1 + e2 + e3);
        if (lane < 4) { const int ee = lane == 0 ? bi[0] : (lane == 1 ? bi[1] : (lane == 2 ? bi[2] : bi[3]));
            const float wv = (lane == 0 ? 1.0f : (lane == 1 ? e1 : (lane == 2 ? e2 : e3))) * inv;
            sel_e[tok * 4 + lane] = ee; w_slot[tok * 4 + lane] = wv;
            const int lp = __hip_atomic_fetch_add(lcnt + ee, 1, __ATOMIC_RELAXED, __HIP_MEMORY_SCOPE_WORKGROUP);
            blk_e[lr * 4 + lane] = ee; blk_p[lr * 4 + lane] = lp; }
    }
    __syncthreads();
    if (tid < 32) gbase[tid] = (int)__hip_atomic_fetch_add(F.ctl + CW_GCNT + 64 * layer + tid, (unsigned)lcnt[tid], RLX_AGENT);
    __syncthreads();
    for (int idx = tid; idx < RPB * 4; idx += NTHR) { const int tok = tok0 + (idx >> 2); if (tok < NTOK) slot_pos[tok * 4 + (idx & 3)] = gbase[blk_e[idx]] + blk_p[idx]; }
}
__device__ __forceinline__ int moe_tables(Frame& F, int layer) {
    LAS int* ts = (LAS int*)(F.lds + L_TSTART); LAS unsigned char* te = (LAS unsigned char*)(F.lds + L_TILEE);
    __syncthreads();
    if (F.tid == 0) { int acc = 0;
        for (int e = 0; e < 32; ++e) { ts[e] = acc; acc += ((int)__hip_atomic_load(F.ctl + CW_GCNT + 64 * layer + e, RLX_AGENT) + 255) >> 8; }
        ts[32] = acc > MAXTILES ? MAXTILES : acc; }
    __syncthreads();
    const int nt = ts[32];
    for (int T = F.tid; T < nt; T += NTHR) { int e = 0;
        for (int q = 1; q < 32; ++q) e = (T >= ts[q]) ? q : e;
        te[T] = (unsigned char)e; }
    __syncthreads();
    return nt;
}
__device__ __forceinline__ void p_gather(Frame& F, int layer) {
    const KA A = ka_fresh();
    const int gw = F.vcu * NWAVES + F.wave, NGW = F.G * NWAVES, lane = F.lane;
    const int moe_row0 = layer ? NCTX : 0, NTOK = layer ? NLAT : MALL;
    unsigned char* ws = A.WS();
    moe_tables(F, layer);
    const LAS int* ts = (const LAS int*)(F.lds + L_TSTART);
    int* prow = (int*)(ws + WS_PROW); const int* sel_e = (const int*)(ws + WS_SELE); const int* slot_pos = (const int*)(ws + WS_SPOS);
    const bf16* H = (const bf16*)(ws + WS_H); bf16* XG = (bf16*)(ws + WS_XG);
    for (int s = gw; s < NTOK * 4; s += NGW) {
        const int e = sel_e[s], p = ts[e] * 256 + slot_pos[s];
        const v4u* src = (const v4u*)(H + (size_t)(moe_row0 + (s >> 2)) * 1024); GAS v4u* dst = (GAS v4u*)(XG + (size_t)p * 1024);
        const v4u a = src[lane], b2 = src[64 + lane]; dst[lane] = a; dst[64 + lane] = b2;
        if (lane == 0) prow[p] = s;
    }
}
__device__ __forceinline__ void p_combine(Frame& F, int layer) {
    const KA A = ka_fresh();
    const int gw = F.vcu * NWAVES + F.wave, NGW = F.G * NWAVES, lane = F.lane;
    const int moe_row0 = layer ? NCTX : 0, NTOK = layer ? NLAT : MALL;
    unsigned char* ws = A.WS();
    float* XR = (float*)(ws + WS_XRES); bf16* H = (bf16*)(ws + WS_H); const bf16* YS = (const bf16*)(ws + WS_YSLOT);
    const float* mod = (const float*)(ws + WS_MOD);
    for (int tok = gw; tok < NTOK; tok += NGW) {
        const int row = moe_row0 + tok, bidx = bidx_of_row(row);
        const float* g2 = mod + (size_t)layer * 9 * 6144 + bidx * 6144 + 5120;
        f32x4 v[4];
#pragma unroll
        for (int j = 0; j < 4; ++j) { const int o = 64 * j + lane; f32x4 y = (f32x4){0.f, 0.f, 0.f, 0.f};
#pragma unroll
            for (int k = 0; k < 4; ++k) { const v2u w = ((const v2u*)(YS + (size_t)(tok * 4 + k) * 1024))[o]; y += (f32x4){blo(w.x), bhi(w.x), blo(w.y), bhi(w.y)}; }
            v[j] = ((const f32x4*)(XR + (size_t)row * 1024))[o] + ((const f32x4*)g2)[o] * y; }
        if (layer == 0) {
#pragma unroll
            for (int j = 0; j < 4; ++j) ((f32x4*)(XR + (size_t)row * 1024))[64 * j + lane] = v[j];
            const float* m1 = mod + (size_t)9 * 6144 + bidx * 6144; f32x4 h[4];
            modnorm_store(v, A.I(I_N1G) + 1024, m1 + 1024, m1, H + (size_t)row * 1024, lane, h);
        } else {
            float ss = 0.f;
#pragma unroll
            for (int j = 0; j < 4; ++j) ss += (v[j].x * v[j].x + v[j].y * v[j].y) + (v[j].z * v[j].z + v[j].w * v[j].w);
            const float r = rsqrtf(wave_sum(ss) * (1.0f / 1024.0f) + EPS);
#pragma unroll
            for (int j = 0; j < 4; ++j) { const int o = 64 * j + lane; ((f32x4*)(A.OUT() + (size_t)tok * 1024))[o] = v[j] * r * ((const f32x4*)A.I(I_FNG))[o]; }
        }
    }
}
typedef short s16x4 __attribute__((ext_vector_type(4)));
typedef short bfx8 __attribute__((ext_vector_type(8)));
typedef short v4i16_t __attribute__((ext_vector_type(4)));
#define MFMA16(a, b, c) __builtin_amdgcn_mfma_f32_16x16x32_bf16((a), (b), (c), 0, 0, 0)
__device__ __forceinline__ bfx8 frag_n(const LAS unsigned char* tile, int stride, int r0, int k0, int lane) {
    return *(const LAS bfx8*)(tile + (r0 + (lane & 15)) * stride + (k0 + 8 * (lane >> 4)) * 2);
}
__device__ __forceinline__ bfx8 frag_t(const LAS unsigned char* tile, int stride, int k0, int n0, int lane) {
    const int g = lane >> 4, q = (lane & 15) >> 2, p = lane & 3;
    const LAS unsigned char* a = tile + (k0 + 8 * g + q) * stride + (n0 + 4 * p) * 2;
    const s16x4 lo = __builtin_bit_cast(s16x4, __builtin_amdgcn_ds_read_tr16_b64_v4i16((LAS v4i16_t*)a));
    const s16x4 hi = __builtin_bit_cast(s16x4, __builtin_amdgcn_ds_read_tr16_b64_v4i16((LAS v4i16_t*)(a + 4 * stride)));
    return __builtin_shufflevector(lo, hi, 0, 1, 2, 3, 4, 5, 6, 7);
}
__device__ __forceinline__ v4u scale8(const v4u w, float s) { float f[8]; unpack8(w, f);
#pragma unroll
    for (int j = 0; j < 8; ++j) f[j] *= s;
    return pack8(f); }

template <int DK, int DVS, bool GLA>
__device__ __forceinline__ void rec_mfma(Frame& F, const bf16* Qsrc, const bf16* Ksrc, const bf16* K2src, size_t qdir_stride, int ldq, int qcol, int kcol,
                                         const bf16* Vsrc, int ldv, int vcol, int DV, const float* EB,
                                         bf16* O, size_t odir_stride, int ldo, int orow0) {
    const KA A = ka_fresh();
    constexpr int SQ = DK * 2 + 16, SV = DVS * 2 + 16, SP = 144, SS = DK * 2 + 16;
    constexpr int O_QD = 0, O_KI = O_QD + 64 * SQ, O_KS = O_KI + 64 * SQ, O_V = O_KS + (GLA ? 64 * SQ : 0), O_VD = O_V + 64 * SV, O_P = O_VD + (GLA ? 0 : 64 * SV), O_ST = O_P + 64 * SP, O_EB = O_ST + DVS * SS;
    static_assert(O_EB + DK * 4 <= RING_BYTES, "rec_mfma LDS");
    constexpr int NVS = 0;  (void)NVS;
    constexpr int VT_PER = DVS / 32, KT_PER = DK / 64, QCH = DK / 8  , QN = (64 * QCH) / NTHR, VCH = DVS / 8, KSTEPS = DK / 32;
    static_assert(QN >= 1 && VT_PER >= 1 && KT_PER >= 1, "shape");
    const LAS unsigned char* L = F.lds;
    const int tid = F.tid, lane = F.lane, w = F.wave, it = w & 3, vg = w >> 2, kg = w & 3, g4 = lane >> 4, l15 = lane & 15;
    const int nvs = DV / DVS, nitems = NB * 4 * 2 * nvs;
    for (int item = F.vcu; item < nitems; item += F.G) {
        const int vs = item % nvs, dir = (item / nvs) & 1, h = (item / (2 * nvs)) & 3, b = item / (8 * nvs);
        float lg2 = 0.f;
        if (!GLA) { const float lgt = A.I(I_RETDEC)[dir * 4 + h]; lg2 = -log2f(1.0f + expf(-lgt)); }
        const bf16* qb = Qsrc + (GLA ? (size_t)dir * qdir_stride : 0) + qcol + h * DK;
        const bf16* kb = Ksrc + (GLA ? (size_t)dir * qdir_stride : 0) + kcol + h * DK;
        const bf16* k2b = GLA ? K2src + (size_t)dir * qdir_stride + kcol + h * DK : kb;
        const bf16* vb = Vsrc + vcol + h * DV + vs * DVS;
        f32x4 Sacc[VT_PER][KT_PER];
#pragma unroll
        for (int a = 0; a < VT_PER; ++a)
#pragma unroll
            for (int c2 = 0; c2 < KT_PER; ++c2) Sacc[a][c2] = (f32x4){0.f, 0.f, 0.f, 0.f};
        for (int i = tid; i < DVS * SS / 4; i += NTHR) ((LAS unsigned*)(F.lds + O_ST))[i] = 0u;
        v4u rq[QN], rk[QN], rk2[GLA ? QN : 1], rv; float peb = 0.f;
        rv = (v4u){0u, 0u, 0u, 0u};
#define REC_LOAD(c) do { \
            _Pragma("unroll") for (int n = 0; n < QN; ++n) { const int pi = tid + NTHR * n, r = pi / QCH, ch = pi % QCH; const size_t ro = (size_t)seq_row(b, dir, 64 * (c) + r) * ldq + ch * 8; \
                rq[n] = *(const v4u*)(qb + ro); rk[n] = *(const v4u*)(kb + ro); if (GLA) rk2[n] = *(const v4u*)(k2b + ro); } \
            if (tid < 64 * VCH) { const int r = tid / VCH, ch = tid % VCH; rv = *(const v4u*)(vb + (size_t)seq_row(b, dir, 64 * (c) + r) * ldv + ch * 8); } \
            if (GLA && tid < DK) peb = EB[(((size_t)dir * NB + b) * 68 + (c)) * (4 * DK) + h * DK + tid]; } while (0)
        REC_LOAD(0);
        for (int c = 0; c < 68; ++c) {
#pragma unroll
            for (int n = 0; n < QN; ++n) { const int pi = tid + NTHR * n, r = pi / QCH, ch = pi % QCH;
                *(LAS v4u*)(F.lds + O_QD + r * SQ + ch * 16) = rq[n]; *(LAS v4u*)(F.lds + O_KI + r * SQ + ch * 16) = rk[n];
                if (GLA) *(LAS v4u*)(F.lds + O_KS + r * SQ + ch * 16) = rk2[n]; }
            if (tid < 64 * VCH) { const int r = tid / VCH, ch = tid % VCH;
                *(LAS v4u*)(F.lds + O_V + r * SV + ch * 16) = rv;
                if (!GLA) *(LAS v4u*)(F.lds + O_VD + r * SV + ch * 16) = scale8(rv, exp2f(lg2 * (float)(63 - r))); }
            if (GLA && tid < DK) ((LAS float*)(F.lds + O_EB))[tid] = peb;
            if (c + 1 < 68) REC_LOAD(c + 1);
            __syncthreads();
#pragma unroll
            for (int q2 = 0; q2 < 2; ++q2) { const int jt = 2 * vg + q2; f32x4 acc = (f32x4){0.f, 0.f, 0.f, 0.f};
                if (jt <= it) {
#pragma unroll
                    for (int ks = 0; ks < KSTEPS; ++ks) acc = MFMA16(frag_n(L + O_KI, SQ, 16 * jt, 32 * ks, lane), frag_n(L + O_QD, SQ, 16 * it, 32 * ks, lane), acc);
                    const int i = 16 * it + l15;
#pragma unroll
                    for (int r = 0; r < 4; ++r) { const int j = 16 * jt + 4 * g4 + r; float vv = (j <= i) ? acc[r] : 0.f; if (!GLA) vv *= exp2f(lg2 * (float)(i - j)); acc[r] = vv; }
                }
                v2u pw; pw.x = pk2(acc[0], acc[1]); pw.y = pk2(acc[2], acc[3]);
                *(LAS v2u*)(F.lds + O_P + (16 * it + l15) * SP + (16 * jt + 4 * g4) * 2) = pw; }
            f32x4 oacc[VT_PER];
#pragma unroll
            for (int a = 0; a < VT_PER; ++a) { oacc[a] = (f32x4){0.f, 0.f, 0.f, 0.f};
#pragma unroll
                for (int ks = 0; ks < KSTEPS; ++ks) oacc[a] = MFMA16(frag_n(L + O_ST, SS, 16 * (vg * VT_PER + a), 32 * ks, lane), frag_n(L + O_QD, SQ, 16 * it, 32 * ks, lane), oacc[a]);
                if (!GLA) oacc[a] *= exp2f(lg2 * (float)(16 * it + l15 + 1)); }
            __syncthreads();
            { const int row = seq_row(b, dir, 64 * c + 16 * it + l15);
#pragma unroll
              for (int a = 0; a < VT_PER; ++a) { const int vt = vg * VT_PER + a;
#pragma unroll
                for (int js = 0; js < 2; ++js) oacc[a] = MFMA16(frag_t(L + O_V, SV, 32 * js, 16 * vt, lane), frag_n(L + O_P, SP, 16 * it, 32 * js, lane), oacc[a]);
                if (row >= orow0) { v2u ow; ow.x = pk2(oacc[a][0], oacc[a][1]); ow.y = pk2(oacc[a][2], oacc[a][3]);
                    *(GAS v2u*)(O + (size_t)dir * odir_stride + (size_t)(row - orow0) * ldo + h * DV + vs * DVS + 16 * vt + 4 * g4) = ow; } } }
            { bfx8 fv[VT_PER][2];
#pragma unroll
              for (int a = 0; a < VT_PER; ++a)
#pragma unroll
                for (int js = 0; js < 2; ++js) fv[a][js] = frag_t(L + (GLA ? O_V : O_VD), SV, 32 * js, 16 * (vg * VT_PER + a), lane);
              const float g64 = GLA ? 1.0f : exp2f(lg2 * 64.0f);
#pragma unroll
              for (int c2 = 0; c2 < KT_PER; ++c2) { const int kt = kg * KT_PER + c2;
                const bfx8 fk0 = frag_t(L + (GLA ? O_KS : O_KI), SQ, 0, 16 * kt, lane), fk1 = frag_t(L + (GLA ? O_KS : O_KI), SQ, 32, 16 * kt, lane);
                f32x4 sc4 = (f32x4){g64, g64, g64, g64};
                if (GLA) sc4 = *(const LAS f32x4*)(L + O_EB + (16 * kt + 4 * g4) * 4);
#pragma unroll
                for (int a = 0; a < VT_PER; ++a) { f32x4 s = Sacc[a][c2] * sc4;
                    s = MFMA16(fk0, fv[a][0], s); s = MFMA16(fk1, fv[a][1], s); Sacc[a][c2] = s;
                    v2u sw; sw.x = pk2(s[0], s[1]); sw.y = pk2(s[2], s[3]);
                    *(LAS v2u*)(F.lds + O_ST + (16 * (vg * VT_PER + a) + l15) * SS + (16 * kt + 4 * g4) * 2) = sw; } } }
            __syncthreads();
        }
#undef REC_LOAD
    }
}
__device__ __forceinline__ float gla_logdecay(const bf16* P, size_t rb, int dir, const float (&wa)[16], float ba) {
    const v4u l0 = *(const v4u*)(P + rb + C0_LOW + dir * 16), l1 = *(const v4u*)(P + rb + C0_LOW + dir * 16 + 8);
    float f0[8], f1[8]; unpack8(l0, f0); unpack8(l1, f1);
    float z = ba;
#pragma unroll
    for (int r = 0; r < 8; ++r) z += f0[r] * wa[r];
#pragma unroll
    for (int r = 0; r < 8; ++r) z += f1[r] * wa[8 + r];
    return (fminf(z, 0.f) - log1pf(expf(-fabsf(z)))) * (1.0f / 16.0f);
}
__device__ __forceinline__ void p_gla_prep(Frame& F, const bf16* P, bf16* QD, bf16* KI, bf16* KS, float* EB) {
    const KA A = ka_fresh();
    const int tid = F.tid, col = tid & 255, half = tid >> 8;
    LAS float* tot = (LAS float*)F.lds;
    for (int item = F.vcu; item < 2 * NB * 68; item += F.G) {
        const int c = item % 68, b = (item / 68) % NB, dir = item / (68 * NB);
        float wa[16];
#pragma unroll
        for (int r = 0; r < 16; ++r) wa[r] = A.I(I_GLAWA)[(dir * 16 + r) * 256 + col];
        const float ba = A.I(I_GLABA)[dir * 256 + col];
        float run = 0.f;
#pragma unroll 4
        for (int t = 0; t < 32; ++t) run += gla_logdecay(P, (size_t)seq_row(b, dir, 64 * c + 32 * half + t) * N0, dir, wa, ba);
        tot[half * 256 + col] = run;
        __syncthreads();
        const float blast = tot[col] + tot[256 + col];
        float bt = half ? tot[col] : 0.f;
        __syncthreads();
#pragma unroll 4
        for (int t = 0; t < 32; ++t) { const int row = seq_row(b, dir, 64 * c + 32 * half + t);
            bt += gla_logdecay(P, (size_t)row * N0, dir, wa, ba);
            const float q = bf2f(P[(size_t)row * N0 + C0_Q + col]), k = bf2f(P[(size_t)row * N0 + C0_K + col]);
            const size_t o = ((size_t)dir * MALL + row) * 256 + col;
            QD[o] = (bf16)f2bf(q * expf(bt)); KI[o] = (bf16)f2bf(k * expf(-bt)); KS[o] = (bf16)f2bf(k * expf(blast - bt)); }
        if (half == 0) EB[(((size_t)dir * NB + b) * 68 + c) * 256 + col] = expf(blast);
    }
}
#ifndef MK_ONLY
#define MK_ONLY -1
#endif
#define SON(s) (MK_ONLY < 0 || MK_ONLY == (s))
#define IN(k) (lo <= (k) && (k) < hi)
#define SEAM(k) do { if (IN(k) && IN((k) + 1)) xcd_barrier(bar); } while (0)
template <int layer>
__device__ __forceinline__ void layer_body(Frame& F, const int lo, const int hi, const XcdBarrier& bar) {
    unsigned char* const ws = ka_fresh().WS();
    bf16* const H = (bf16*)(ws + WS_H);
    bf16* const PROJ = (bf16*)(ws + WS_PROJ);
    float* const XRES = (float*)(ws + WS_XRES);
    float* const MOD = (float*)(ws + WS_MOD);

        const int pb = layer ? PH_INPROJ1 : PH_INPROJ0;
        if (SON(2) && IN(pb)) {
            pg8::Gemm g{H, (const bf16*)(ws + (layer ? WS_WIN1T : WS_WIN0T)), MALL, layer ? N1 : N0, 1024};
            pg8::StaticOrder S; S.init(g.M, g.N, F.G, (int)blockIdx.x);
            pg8::EpiStore E{PROJ, g.N};
            pg8::gemm_phase<pg8::EpiStore, pg8::StaticOrder, true, true>(F.lds, g, S, E);
        }
        SEAM(pb);
        if (layer == 0) {
#if MK_NAIVE_GLA
            SEAM(PH_GLAPREP);
            if (SON(3) && IN(PH_GLA)) rec_naive<64, true>(F, PROJ, N0, C0_Q, C0_K, C0_V, 128, 2, (float*)(ws + WS_OREC), (size_t)MALL * 512, 512, 0);
#else
            bf16* const GQD = (bf16*)(ws + WS_OREC + 280 * MiB); bf16* const GKI = GQD + (size_t)2 * MALL * 256; bf16* const GKS = GKI + (size_t)2 * MALL * 256; float* const GEB = (float*)(ws + WS_OREC + 384 * MiB);
            if (SON(13) && IN(PH_GLAPREP)) p_gla_prep(F, PROJ, GQD, GKI, GKS, GEB);
            SEAM(PH_GLAPREP);
            if (SON(3) && IN(PH_GLA)) rec_mfma<64, 32, true>(F, GQD, GKI, GKS, (size_t)MALL * 256, 256, 0, 0, PROJ, N0, C0_V, 128, GEB, (bf16*)(ws + WS_OREC), (size_t)MALL * 512, 512, 0);
#endif
            SEAM(PH_GLA);
            if (SON(4) && IN(PH_S5)) s5_naive(F, PROJ, (float*)(ws + WS_OREC) + (size_t)2 * MALL * 512);
            SEAM(PH_S5);
            if (SON(5) && IN(PH_FIN0)) p_finish0(F);
            SEAM(PH_FIN0);
            if (SON(6) && IN(PH_GLU)) {
                pg8::Gemm g{(const bf16*)(ws + WS_YPRE), (const bf16*)(ws + WS_WGLUT), MALL, 512, 512};
                pg8::StaticOrder S; S.init(g.M, g.N, F.G, (int)blockIdx.x);
                pg8::EpiGlu E{(const bf16*)(ws + WS_YPRE), (bf16*)(ws + WS_MIX), 1024, 512, ka_fresh().I(I_GLUB)};
                pg8::gemm_phase<pg8::EpiGlu, pg8::StaticOrder, true, true>(F.lds, g, S, E);
            }
            SEAM(PH_GLU);
        } else {
            if (SON(14) && IN(PH_ROPE)) p_rope(F);
            SEAM(PH_ROPE);
#if MK_NAIVE_RET
            if (SON(15) && IN(PH_RET)) rec_naive<256, false>(F, PROJ, N1, C1_Q, C1_K, C1_V, 512, 8, (float*)(ws + WS_OREC), (size_t)NLAT * 2048, 2048, NCTX);
#else
            if (SON(15) && IN(PH_RET)) rec_mfma<256, 64, false>(F, PROJ, PROJ, PROJ, 0, N1, C1_Q, C1_K, PROJ, N1, C1_V, 512, nullptr, (bf16*)(ws + WS_OREC), (size_t)NLAT * 2048, 2048, NCTX);
#endif
            SEAM(PH_RET);
            if (SON(16) && IN(PH_FIN1)) p_finish1(F);
            SEAM(PH_FIN1);
        }
        const int po = layer ? PH_OUT1 : PH_OUT0;
        if (SON(7) && IN(po)) {
            pg8::Gemm g{(const bf16*)(ws + WS_MIX), (const bf16*)(ws + (layer ? WS_WOUT1T : WS_WOUT0T)), layer ? NLAT : MALL, 1024, layer ? 2048 : 1024};
            pg8::StaticOrder S; S.init(g.M, g.N, F.G, (int)blockIdx.x);
            pg8::EpiResid E{ka_fresh().I(I_CTX), layer ? (const float*)(XRES + (size_t)NCTX * 1024) : ka_fresh().I(I_X), XRES, MOD + (size_t)layer * 9 * 6144 + 2048, layer ? 8 : 0};
            pg8::gemm_phase<pg8::EpiResid, pg8::StaticOrder, true, true>(F.lds, g, S, E);
        }
        SEAM(po);
        if (SON(8) && IN(po + 1)) p_router(F, layer);
        SEAM(po + 1);
        if (SON(9) && IN(po + 2)) p_gather(F, layer);
        SEAM(po + 2);
        if (SON(10) && IN(po + 3)) {
            const int nt = moe_tables(F, layer);
            pg8::Gemm g{(const bf16*)(ws + WS_XG), (const bf16*)(ws + WS_WGUT) + (size_t)layer * 32 * 2048 * 1024, nt * 256, 2048, 1024};
            pg8::MoeOrder S{(const PG8_LAS unsigned char*)(F.lds + L_TILEE), nt, 8, F.G, F.vcu};
            pg8::EpiSwiglu E{(bf16*)(ws + WS_ACT), ka_fresh().I(I_BGU) + (size_t)layer * 32 * 2048};
            pg8::gemm_phase<pg8::EpiSwiglu, pg8::MoeOrder, true, true>(F.lds, g, S, E);
        }
        SEAM(po + 3);
        if (SON(11) && IN(po + 4)) {
            const int nt = moe_tables(F, layer);
            pg8::Gemm g{(const bf16*)(ws + WS_ACT), (const bf16*)(ws + WS_WDNT) + (size_t)layer * 32 * 1024 * 1024, nt * 256, 1024, 1024};
            pg8::MoeOrder S{(const PG8_LAS unsigned char*)(F.lds + L_TILEE), nt, 4, F.G, F.vcu};
            pg8::EpiDown E{(bf16*)(ws + WS_YSLOT), (const int*)(ws + WS_PROW), (const float*)(ws + WS_WSLOT), ka_fresh().I(I_BDN) + (size_t)layer * 32 * 1024};
            pg8::gemm_phase<pg8::EpiDown, pg8::MoeOrder, true, true>(F.lds, g, S, E);
        }
        SEAM(po + 4);
        if (SON(12) && IN(po + 5)) p_combine(F, layer);
        SEAM(po + 5);
    }
__global__ void __launch_bounds__(NTHR, 2) mk_fwd(Args) {
    extern __shared__ __attribute__((aligned(16))) unsigned char lds[];
    Frame F;
    F.lds = (LAS unsigned char*)lds;
    F.MISC = (volatile LAS unsigned*)(F.lds + L_MISC);
    F.tid = threadIdx.x; F.lane = F.tid & 63; F.wave = __builtin_amdgcn_readfirstlane(F.tid >> 6);
    F.G = gridDim.x; { const int bx = blockIdx.x; F.vcu = (F.G % 8 == 0) ? (bx % 8) * (F.G / 8) + bx / 8 : bx; }
    const KA A0 = ka_fresh();
    unsigned char* ws = A0.WS();
    F.ctl = (unsigned*)(ws + WS_CTL);
    if (F.tid < 64) F.MISC[F.tid] = 0u;
    __syncthreads();
    const int lo = A0.LO(), hi = A0.HI();
    XcdBarrier bar; bar.bar = F.ctl + CW_BAR; bar.x = 0; bar.st = nullptr;
    if (hi - lo > 1) bar = xcd_barrier_post(F.ctl + CW_BAR, F.MISC + 8);

    if (SON(0) && IN(0)) { p0_prologue(F); } SEAM(0);
    if (SON(1) && IN(1)) { p_norm1_l0(F); } SEAM(1);
    layer_body<0>(F, lo, hi, bar);
    layer_body<1>(F, lo, hi, bar);
}

#ifndef MK_MULTI
#define MK_MULTI 0
#endif
extern "C" void kernel_launch(void* const* d_in, const int* in_sizes, int n_in, void* d_out, int out_size, void* d_ws, size_t ws_size, hipStream_t stream) {
    static int grid = 0;
    if (grid == 0) {
        if (n_in != 34 || out_size != NLAT * D || ws_size < WS_END) { fprintf(stderr, "kernel_launch: unexpected sizes: n_in %d out %d ws %zu (need %zu)\n", n_in, out_size, ws_size, (size_t)WS_END); grid = -1; return; }
        int dev = 0, cus = 0;
        if (hipGetDevice(&dev) != hipSuccess || hipDeviceGetAttribute(&cus, hipDeviceAttributeMultiprocessorCount, dev) != hipSuccess) { grid = -1; return; }
        if (hipFuncSetAttribute((const void*)mk_fwd, hipFuncAttributeMaxDynamicSharedMemorySize, LDS_BYTES) != hipSuccess) { fprintf(stderr, "kernel_launch: hipFuncSetAttribute failed\n"); grid = -1; return; }
        int per_cu = 0;
        if (hipOccupancyMaxActiveBlocksPerMultiprocessor(&per_cu, (const void*)mk_fwd, NTHR, LDS_BYTES) != hipSuccess || per_cu < 1) fprintf(stderr, "kernel_launch: occupancy query says %d\n", per_cu);
        (void)hipGetLastError();
        grid = cus;
    }
    if (grid < 0) return;
    (void)in_sizes;
    (void)hipMemsetAsync((char*)d_ws + WS_CTL, 0, CTL_ZERO_BYTES, stream);
    Args a{};
    for (int i = 0; i < 34; ++i) a.in[i] = (const float*)d_in[i];
    a.out = (float*)d_out; a.ws = (unsigned char*)d_ws;
#if MK_MULTI
    for (int p = 0; p < NPH; ++p) { a.ph_lo = p; a.ph_hi = p + 1; hipLaunchKernelGGL(mk_fwd, dim3(grid), dim3(NTHR), LDS_BYTES, stream, a); }
#else
    a.ph_lo = 0; a.ph_hi = NPH; hipLaunchKernelGGL(mk_fwd, dim3(grid), dim3(NTHR), LDS_BYTES, stream, a);
#endif
}
```

```cpp
#include <hip/hip_runtime.h>
#include <cstdio>
#include <cstdint>
#include <cmath>
namespace pg8 {
#define PG8_LAS __attribute__((address_space(3)))
typedef unsigned short bf16_t;
typedef short bf16x8 __attribute__((ext_vector_type(8)));
typedef float f32x4 __attribute__((ext_vector_type(4)));
typedef unsigned u32x4 __attribute__((ext_vector_type(4)));
constexpr int BM = 256, BK = 64, HALF = 128, HTB = HALF * BK * 2  , STAGE_BYTES = 8 * HTB, NXCD = 8, WGM = 8;

__host__ __device__ __forceinline__ int lds_byte(int r, int c) { const int st = (r >> 4) * 2 + (c >> 5), rr = r & 15, cc = c & 31, ob = rr * 64 + cc * 2; return st * 1024 + (ob ^ (((ob >> 9) & 1) << 5)); }
__host__ __device__ __forceinline__ void stage_rc(int b, int& R, int& C) { const int st = b / 1024, sb = b % 1024, swz = sb ^ (((sb >> 9) & 1) << 5); R = (st >> 1) * 16 + swz / 64; C = (st & 1) * 32 + (swz % 64) / 2; }
__host__ __device__ __forceinline__ int perm32(int rho) { const int n = rho >> 4, i = rho & 15; return 8 * (i >> 2) + 4 * n + (i & 3); }

struct Unit { int pm, pn, pb, e; };
struct Gemm { const bf16_t* A; const bf16_t* Bt; int M, N, K, lda; };

struct StaticOrder {
    int nM, nN, nwg, G, c;
    __host__ __device__ void init(int M, int N, int G_, int c_) { nM = M / BM; nN = N / BM; nwg = nM * nN; G = G_; c = c_; }
    __host__ __device__ bool next(int i, Unit& u) const {
        const long L = (long)i * G + c; if (L >= nwg) return false;
        int wgid = (int)L; { const int q = nwg / NXCD, r = nwg % NXCD, xcd = wgid % NXCD, off = wgid / NXCD; wgid = (xcd < r ? xcd * (q + 1) : r * (q + 1) + (xcd - r) * q) + off; }
        const int nig = WGM * nN, gid = wgid / nig, fm = gid * WGM, gsz = (nM - fm) < WGM ? (nM - fm) : WGM;
        u.pm = fm + ((wgid % nig) % gsz); u.pn = (wgid % nig) / gsz; u.pb = u.pn; u.e = 0; return true;
    }
    __device__ __forceinline__ void a_ready(const Unit&) const {}
    __device__ __forceinline__ void done(const Unit&) const {}
};
__device__ __forceinline__ unsigned cvt_pk_bf16(float lo, float hi) { unsigned r; asm volatile("v_cvt_pk_bf16_f32 %0, %1, %2" : "=v"(r) : "v"(lo), "v"(hi)); return r; }
__device__ __forceinline__ float bflo(unsigned w) { return __uint_as_float(w << 16); }
__device__ __forceinline__ float bfhi(unsigned w) { return __uint_as_float(w & 0xffff0000u); }
__device__ __forceinline__ float sigmoidf_(float z) { return 1.0f / (1.0f + __expf(-z)); }

struct EpiStore {
    static constexpr bool PERM = true, AFTER_DRAIN = false;
    bf16_t* O; int ldc;
    __device__ __forceinline__ void operator()(const f32x4 (&acc)[2][2][4][2], const Unit& u, int wr, int wc, int fr, int fq) const {
        const int row0 = u.pm * BM + wr * 64 + fr, col0 = u.pn * BM + wc * 32 + 8 * fq;
#pragma unroll
        for (int ai = 0; ai < 2; ++ai)
#pragma unroll
            for (int m = 0; m < 4; ++m) { bf16_t* rowp = O + (size_t)(row0 + ai * HALF + m * 16) * ldc + col0;
#pragma unroll
                for (int bj = 0; bj < 2; ++bj) { const f32x4 v0 = acc[ai][bj][m][0], v1 = acc[ai][bj][m][1];
                    u32x4 w; w.x = cvt_pk_bf16(v0[0], v0[1]); w.y = cvt_pk_bf16(v0[2], v0[3]); w.z = cvt_pk_bf16(v1[0], v1[1]); w.w = cvt_pk_bf16(v1[2], v1[3]);
                    *(u32x4*)(rowp + bj * HALF) = w; } }
    }
};
struct EpiGlu {
    static constexpr bool PERM = true, AFTER_DRAIN = false;
    const bf16_t* Y; bf16_t* O; int ldo, ocol0; const float* bias;
    __device__ __forceinline__ void operator()(const f32x4 (&acc)[2][2][4][2], const Unit& u, int wr, int wc, int fr, int fq) const {
        const int row0 = u.pm * BM + wr * 64 + fr, col0 = u.pn * BM + wc * 32 + 8 * fq;
        f32x4 bv[2][2];
#pragma unroll
        for (int bj = 0; bj < 2; ++bj)
#pragma unroll
            for (int n = 0; n < 2; ++n) bv[bj][n] = *(const f32x4*)(bias + col0 + bj * HALF + 4 * n);
#pragma unroll
        for (int ai = 0; ai < 2; ++ai)
#pragma unroll
            for (int m = 0; m < 4; ++m) { const size_t row = (size_t)(row0 + ai * HALF + m * 16);
#pragma unroll
                for (int bj = 0; bj < 2; ++bj) { const int c = col0 + bj * HALF;
                    const u32x4 yv = *(const u32x4*)(Y + row * 512 + c);
                    const f32x4 z0 = acc[ai][bj][m][0] + bv[bj][0], z1 = acc[ai][bj][m][1] + bv[bj][1];
                    u32x4 w;
                    w.x = cvt_pk_bf16(bflo(yv.x) * sigmoidf_(z0[0]), bfhi(yv.x) * sigmoidf_(z0[1]));
                    w.y = cvt_pk_bf16(bflo(yv.y) * sigmoidf_(z0[2]), bfhi(yv.y) * sigmoidf_(z0[3]));
                    w.z = cvt_pk_bf16(bflo(yv.z) * sigmoidf_(z1[0]), bfhi(yv.z) * sigmoidf_(z1[1]));
                    w.w = cvt_pk_bf16(bflo(yv.w) * sigmoidf_(z1[2]), bfhi(yv.w) * sigmoidf_(z1[3]));
                    *(u32x4*)(O + row * ldo + ocol0 + c) = w; } }
    }
};
struct EpiResid {
    static constexpr bool PERM = false, AFTER_DRAIN = false;
    const float* base_ctx; const float* base_lat; float* out; const float* gate; int tile0;
    __device__ __forceinline__ void operator()(const f32x4 (&acc)[2][2][4][2], const Unit& u, int wr, int wc, int fr, int fq) const {
        const int gt = u.pm + tile0, bidx = gt < 8 ? 8 : ((gt - 8) >> 4);
        const float* bt = gt < 8 ? base_ctx + (size_t)gt * 256 * 1024 : base_lat + (size_t)(gt - 8) * 256 * 1024;
        float* ot = out + (size_t)gt * 256 * 1024;
        const int col0 = u.pn * BM + wc * 32 + 4 * fq;
        f32x4 gv[2][2];
#pragma unroll
        for (int bj = 0; bj < 2; ++bj)
#pragma unroll
            for (int n = 0; n < 2; ++n) gv[bj][n] = *(const f32x4*)(gate + bidx * 6144 + col0 + bj * HALF + n * 16);
#pragma unroll
        for (int ai = 0; ai < 2; ++ai)
#pragma unroll
            for (int m = 0; m < 4; ++m) { const size_t off = (size_t)(wr * 64 + fr + ai * HALF + m * 16) * 1024 + col0;
#pragma unroll
                for (int bj = 0; bj < 2; ++bj)
#pragma unroll
                    for (int n = 0; n < 2; ++n) { const f32x4 bs = *(const f32x4*)(bt + off + bj * HALF + n * 16);
                        *(f32x4*)(ot + off + bj * HALF + n * 16) = bs + gv[bj][n] * acc[ai][bj][m][n]; } }
    }
};
struct EpiSwiglu {
    static constexpr bool PERM = true, AFTER_DRAIN = false;
    bf16_t* ACT; const float* bgu;
    __device__ __forceinline__ void operator()(const f32x4 (&acc)[2][2][4][2], const Unit& u, int wr, int wc, int fr, int fq) const {
        const int row0 = u.pm * BM + wr * 64 + fr, lc0 = u.pn * 128 + wc * 32 + 8 * fq;
        const float* bb = bgu + (size_t)u.e * 2048 + lc0;
        f32x4 bg[2], bl[2];
#pragma unroll
        for (int n = 0; n < 2; ++n) { bg[n] = *(const f32x4*)(bb + 4 * n); bl[n] = *(const f32x4*)(bb + 1024 + 4 * n); }
#pragma unroll
        for (int ai = 0; ai < 2; ++ai)
#pragma unroll
            for (int m = 0; m < 4; ++m) { float a[8];
#pragma unroll
                for (int n = 0; n < 2; ++n)
#pragma unroll
                    for (int j = 0; j < 4; ++j) { const float g = fminf(acc[ai][0][m][n][j] + bg[n][j], 7.0f); float l = acc[ai][1][m][n][j] + bl[n][j]; l = fminf(fmaxf(l, -7.0f), 7.0f);
                        a[4 * n + j] = g * sigmoidf_(1.702f * g) * (l + 1.0f); }
                u32x4 w; w.x = cvt_pk_bf16(a[0], a[1]); w.y = cvt_pk_bf16(a[2], a[3]); w.z = cvt_pk_bf16(a[4], a[5]); w.w = cvt_pk_bf16(a[6], a[7]);
                *(u32x4*)(ACT + (size_t)(row0 + ai * HALF + m * 16) * 1024 + lc0) = w; }
    }
};
struct EpiDown {
    static constexpr bool PERM = true, AFTER_DRAIN = false;
    bf16_t* Y; const int* prow_slot; const float* w_slot; const float* bdn;
    __device__ __forceinline__ void operator()(const f32x4 (&acc)[2][2][4][2], const Unit& u, int wr, int wc, int fr, int fq) const {
        const int row0 = u.pm * BM + wr * 64 + fr, col0 = u.pn * BM + wc * 32 + 8 * fq;
        f32x4 bv[2][2];
#pragma unroll
        for (int bj = 0; bj < 2; ++bj)
#pragma unroll
            for (int n = 0; n < 2; ++n) bv[bj][n] = *(const f32x4*)(bdn + (size_t)u.e * 1024 + col0 + bj * HALF + 4 * n);
#pragma unroll
        for (int ai = 0; ai < 2; ++ai)
#pragma unroll
            for (int m = 0; m < 4; ++m) { const int slot = prow_slot[row0 + ai * HALF + m * 16];
                if (slot >= 0) { const float ws = w_slot[slot]; bf16_t* rowp = Y + (size_t)slot * 1024 + col0;
#pragma unroll
                    for (int bj = 0; bj < 2; ++bj) { const f32x4 v0 = (acc[ai][bj][m][0] + bv[bj][0]) * ws, v1 = (acc[ai][bj][m][1] + bv[bj][1]) * ws;
                        u32x4 w; w.x = cvt_pk_bf16(v0[0], v0[1]); w.y = cvt_pk_bf16(v0[2], v0[3]); w.z = cvt_pk_bf16(v1[0], v1[1]); w.w = cvt_pk_bf16(v1[2], v1[3]);
                        *(u32x4*)(rowp + bj * HALF) = w; } } }
    }
};
struct MoeOrder {
    const PG8_LAS unsigned char* tile_e; int ntiles, NT, G, c;
    __device__ __forceinline__ bool next(int i, Unit& u) const {
        const int L = i * G + c; if (L >= ntiles * NT) return false;
        const int T = L / NT; u.pm = T; u.pn = L - T * NT; u.e = __builtin_amdgcn_readfirstlane((int)tile_e[T]); u.pb = u.e * NT + u.pn; return true;
    }
    __device__ __forceinline__ void a_ready(const Unit&) const {}
    __device__ __forceinline__ void done(const Unit&) const {}
};

struct EpiStoreU {
    static constexpr bool PERM = true, AFTER_DRAIN = false;
    bf16_t* O; int ldc; bf16_t* A2;
    __device__ __forceinline__ void operator()(const f32x4 (&acc)[2][2][4][2], const Unit& u, int wr, int wc, int fr, int fq) const {
        const int row0 = u.pm * BM + wr * 64 + fr, col0 = u.pn * BM + wc * 32 + 8 * fq;
#pragma unroll
        for (int ai = 0; ai < 2; ++ai)
#pragma unroll
            for (int m = 0; m < 4; ++m) { const int R = row0 + ai * HALF + m * 16; bf16_t* rowp = O + (size_t)R * ldc + col0;
                int r, t; if (R < 2048) { r = (R >> 8) * 272 + ((R & 255) >> 4); t = R & 15; } else { const int R2 = R - 2048; r = (R2 >> 12) * 272 + 16 + ((R2 & 4095) >> 4); t = R2 & 15; }
#pragma unroll
                for (int bj = 0; bj < 2; ++bj) { const f32x4 v0 = acc[ai][bj][m][0], v1 = acc[ai][bj][m][1];
                    u32x4 w; w.x = cvt_pk_bf16(v0[0], v0[1]); w.y = cvt_pk_bf16(v0[2], v0[3]); w.z = cvt_pk_bf16(v1[0], v1[1]); w.w = cvt_pk_bf16(v1[2], v1[3]);
                    *(u32x4*)(rowp + bj * HALF) = w;
                    if (u.pn >= 6) { const int g = (u.pn - 6) * 16 + bj * 8 + wc * 2 + (fq >> 1);
                        *(u32x4*)(A2 + ((size_t)g * 2304 + r) * 512 + t * 16 + (fq & 1) * 8) = w; } } }
    }
};
struct EpiF32Plain {
    static constexpr bool PERM = true, AFTER_DRAIN = false;
    float* C;
    __device__ __forceinline__ void operator()(const f32x4 (&acc)[2][2][4][2], const Unit& u, int wr, int wc, int fr, int fq) const {
        float* base = C + (size_t)(u.pm * BM + wr * 64 + fr) * 256 + wc * 32 + 8 * fq;
#pragma unroll
        for (int ai = 0; ai < 2; ++ai)
#pragma unroll
            for (int m = 0; m < 4; ++m) {
#pragma unroll
                for (int bj = 0; bj < 2; ++bj) { float* p = base + (ai * HALF + m * 16) * 256 + bj * HALF;
                    *(f32x4*)p = acc[ai][bj][m][0]; *(f32x4*)(p + 4) = acc[ai][bj][m][1]; } }
    }
};
struct EpiS5Out {
    static constexpr bool PERM = true, AFTER_DRAIN = false;
    const bf16_t* A2; bf16_t* YP; const float* dskip;
    __device__ __forceinline__ void operator()(const f32x4 (&acc)[2][2][4][2], const Unit& u, int wr, int wc, int fr, int fq) const {
        const int g = u.e;
#pragma unroll
        for (int ai = 0; ai < 2; ++ai)
#pragma unroll
            for (int m = 0; m < 4; ++m) { const int rr = (u.pm - g * 9) * BM + wr * 64 + fr + ai * HALF + m * 16;
                if (rr < 2176) { const int b = rr / 272, n = rr - b * 272;
                    const int tok0 = n < 16 ? b * 256 + n * 16 : 2048 + b * 4096 + (n - 16) * 16;
#pragma unroll
                    for (int bj = 0; bj < 2; ++bj) { const int col = bj * HALF + wc * 32 + 8 * fq, t = col >> 4, c0 = col & 15;
                        const u32x4 uv = *(const u32x4*)(A2 + ((size_t)g * 2304 + rr) * 512 + col);
                        const f32x4 d0 = *(const f32x4*)(dskip + g * 16 + c0), d1 = *(const f32x4*)(dskip + g * 16 + c0 + 4);
                        float y[8];
                        y[0] = acc[ai][bj][m][0][0] + d0[0] * bflo(uv.x); y[1] = acc[ai][bj][m][0][1] + d0[1] * bfhi(uv.x); y[2] = acc[ai][bj][m][0][2] + d0[2] * bflo(uv.y); y[3] = acc[ai][bj][m][0][3] + d0[3] * bfhi(uv.y);
                        y[4] = acc[ai][bj][m][1][0] + d1[0] * bflo(uv.z); y[5] = acc[ai][bj][m][1][1] + d1[1] * bfhi(uv.z); y[6] = acc[ai][bj][m][1][2] + d1[2] * bflo(uv.w); y[7] = acc[ai][bj][m][1][3] + d1[3] * bfhi(uv.w);
#pragma unroll
                        for (int j = 0; j < 8; ++j) { const float z = y[j], th = 0.7978845608f * (z + 0.044715f * z * z * z); const float e2 = __expf(2.0f * th); y[j] = 0.5f * z * (1.0f + (1.0f - 2.0f / (e2 + 1.0f))); }
                        u32x4 w; w.x = cvt_pk_bf16(y[0], y[1]); w.y = cvt_pk_bf16(y[2], y[3]); w.z = cvt_pk_bf16(y[4], y[5]); w.w = cvt_pk_bf16(y[6], y[7]);
                        *(u32x4*)(YP + (size_t)(tok0 + t) * 512 + g * 16 + c0) = w; } } }
    }
};
struct GroupOrder {
    int tpg, nunits, G, c;
    __device__ __forceinline__ bool next(int i, Unit& u) const { const int L = i * G + c; if (L >= nunits) return false; u.pm = L; u.pn = 0; u.e = L / tpg; u.pb = u.e; return true; }
    __device__ __forceinline__ void a_ready(const Unit&) const {}
    __device__ __forceinline__ void done(const Unit&) const {}
};
template <class Epi, class Sched, bool ALIGN_EPI = false, bool SP2 = false>
__device__ __forceinline__ void gemm_phase(PG8_LAS unsigned char* lds, const Gemm g, const Sched& S, const Epi& E) {
    const int tid = threadIdx.x, wid = __builtin_amdgcn_readfirstlane(tid >> 6), lane = tid & 63, wr = wid >> 2, wc = wid & 3, fr = lane & 15, fq = lane >> 4;
    int K_ = g.K; asm volatile("" : "+s"(K_));
    const int K = K_, nt = K / BK;
    unsigned voffA[2], voffB[2];
#pragma unroll
    for (int i = 0; i < 2; ++i) { int R, C; stage_rc(tid * 16 + i * 8192, R, C); const int Rb = Epi::PERM ? ((R & ~31) + perm32(R & 31)) : R;
        voffA[i] = (unsigned)(R * g.lda + C) * 2u; voffB[i] = (unsigned)(Rb * K + C) * 2u; }
    const size_t kstep = (size_t)(BK * 2);
    const size_t hstep = (size_t)HALF * K * 2;
    const size_t tstep = 2 * hstep;
    const size_t hstepA = (size_t)HALF * g.lda * 2, tstepA = 2 * hstepA;
    const unsigned ldsw = (unsigned)wid * 1024u;
    const int aoff = lds_byte(wr * 64 + fr, fq * 8), boff = lds_byte(wc * 32 + fr, fq * 8);
#define PG8_SA(b, h) (((b) * 2 + (h)) * HTB)
#define PG8_SB(b, h) ((4 + (b) * 2 + (h)) * HTB)
#define PG8_STAGE(bufoff, gbase, voff) do { _Pragma("unroll") for (int _i = 0; _i < 2; ++_i) \
        __builtin_amdgcn_global_load_lds((const unsigned*)((const char*)(gbase) + (voff)[_i]), (PG8_LAS unsigned*)(lds + (bufoff) + ldsw + _i * 8192), 16, 0, 0); } while (0)
#define PG8_LDA(dst, b, h) do { _Pragma("unroll") for (int m = 0; m < 4; ++m) _Pragma("unroll") for (int k = 0; k < 2; ++k) dst[m][k] = *(const PG8_LAS bf16x8*)(lds + PG8_SA(b, h) + aoff + m * 2048 + k * 1024); } while (0)
#define PG8_LDB(dst, b, h) do { _Pragma("unroll") for (int n = 0; n < 2; ++n) _Pragma("unroll") for (int k = 0; k < 2; ++k) dst[n][k] = *(const PG8_LAS bf16x8*)(lds + PG8_SB(b, h) + boff + n * 2048 + k * 1024); } while (0)
#define PG8_MMA(ai, bj, At, Bt) do { __builtin_amdgcn_s_setprio(1); _Pragma("unroll") for (int m = 0; m < 4; ++m) _Pragma("unroll") for (int n = 0; n < 2; ++n) _Pragma("unroll") for (int k = 0; k < 2; ++k) \
        acc[ai][bj][m][n] = __builtin_amdgcn_mfma_f32_16x16x32_bf16(Bt[n][k], At[m][k], acc[ai][bj][m][n], 0, 0, 0); __builtin_amdgcn_s_setprio(0); } while (0)
#define PG8_WAIT_V(n) asm volatile("s_waitcnt vmcnt(" #n ")" ::: "memory")
#define PG8_WAIT_L(n) asm volatile("s_waitcnt lgkmcnt(" #n ")" ::: "memory")
#define PG8_BAR __builtin_amdgcn_s_barrier()
#define PG8_SCHED __builtin_amdgcn_sched_barrier(0)
    Unit cur, nxt; int ui = 0;
    if (!S.next(0, cur)) return;
    f32x4 acc[2][2][4][2];
#pragma unroll
    for (int a = 0; a < 2; ++a)
#pragma unroll
        for (int b = 0; b < 2; ++b)
#pragma unroll
            for (int m = 0; m < 4; ++m)
#pragma unroll
                for (int n = 0; n < 2; ++n) acc[a][b][m][n] = (f32x4){0.f, 0.f, 0.f, 0.f};
    bf16x8 At[4][2], B0[2][2], B1[2][2];
    const char* cA = (const char*)g.A + (size_t)cur.pm * tstepA; const char* cB = (const char*)g.Bt + (size_t)cur.pb * tstep;
    S.a_ready(cur);
    if constexpr (SP2) {
        PG8_STAGE(PG8_SB(0, 0), cB, voffB); PG8_STAGE(PG8_SB(0, 1), cB + hstep, voffB); PG8_STAGE(PG8_SA(0, 0), cA, voffA); PG8_STAGE(PG8_SA(0, 1), cA + hstepA, voffA);
        if (wr == 1) PG8_BAR;
        PG8_WAIT_V(2); PG8_BAR;
        PG8_STAGE(PG8_SB(1, 0), cB + kstep, voffB); PG8_STAGE(PG8_SA(1, 0), cA + kstep, voffA); PG8_STAGE(PG8_SB(1, 1), cB + hstep + kstep, voffB);
        PG8_WAIT_V(6); PG8_BAR;
    } else {
        PG8_STAGE(PG8_SB(0, 0), cB, voffB); PG8_STAGE(PG8_SA(0, 0), cA, voffA); PG8_STAGE(PG8_SB(0, 1), cB + hstep, voffB); PG8_STAGE(PG8_SA(0, 1), cA + hstepA, voffA);
        if (wr == 1) PG8_BAR;
        PG8_WAIT_V(4); PG8_BAR;
        PG8_STAGE(PG8_SB(1, 0), cB + kstep, voffB); PG8_STAGE(PG8_SA(1, 0), cA + kstep, voffA); PG8_STAGE(PG8_SB(1, 1), cB + hstep + kstep, voffB);
        PG8_WAIT_V(6); PG8_BAR;
    }
    for (;;) {
        const bool has_next = S.next(ui + 1, nxt);
        const char* nA = has_next ? (const char*)g.A + (size_t)nxt.pm * tstepA : cA; const char* nB = has_next ? (const char*)g.Bt + (size_t)nxt.pb * tstep : cB;
        for (int t = 0; t < nt; t += 2) {
            const bool last = (t == nt - 2);
            const char* a1 = cA + (size_t)(t + 1) * kstep;
            const char* a2 = last ? nA : cA + (size_t)(t + 2) * kstep; const char* b2 = last ? nB : cB + (size_t)(t + 2) * kstep;
            const char* a3 = a2 + kstep; const char* b3 = b2 + kstep;
            if (last && has_next) S.a_ready(nxt);
            if constexpr (SP2) {
            PG8_LDB(B0, 0, 0); PG8_LDB(B1, 0, 1); PG8_SCHED; PG8_LDA(At, 0, 0); PG8_STAGE(PG8_SA(1, 1), a1 + hstepA, voffA);
            PG8_WAIT_V(8); PG8_WAIT_L(0); PG8_BAR; PG8_MMA(0, 0, At, B0); PG8_MMA(0, 1, At, B1); PG8_BAR; PG8_SCHED;
            PG8_LDA(At, 0, 1); PG8_STAGE(PG8_SB(0, 0), b2, voffB); PG8_STAGE(PG8_SB(0, 1), b2 + hstep, voffB); PG8_STAGE(PG8_SA(0, 0), a2, voffA);
            PG8_WAIT_V(8); PG8_WAIT_L(0); PG8_BAR; PG8_MMA(1, 0, At, B0); PG8_MMA(1, 1, At, B1); PG8_BAR; PG8_SCHED;
            PG8_LDB(B0, 1, 0); PG8_LDB(B1, 1, 1); PG8_SCHED; PG8_LDA(At, 1, 0); PG8_STAGE(PG8_SA(0, 1), a2 + hstepA, voffA);
            PG8_WAIT_V(8); PG8_WAIT_L(0); PG8_BAR; PG8_MMA(0, 0, At, B0); PG8_MMA(0, 1, At, B1); PG8_BAR; PG8_SCHED;
            PG8_LDA(At, 1, 1); PG8_STAGE(PG8_SB(1, 0), b3, voffB); PG8_STAGE(PG8_SB(1, 1), b3 + hstep, voffB); PG8_STAGE(PG8_SA(1, 0), a3, voffA);
            PG8_WAIT_V(8); PG8_WAIT_L(0); PG8_BAR; PG8_MMA(1, 0, At, B0); PG8_MMA(1, 1, At, B1); PG8_BAR; PG8_SCHED;
            } else {
            PG8_LDB(B0, 0, 0); PG8_SCHED; PG8_LDA(At, 0, 0); PG8_STAGE(PG8_SA(1, 1), a1 + hstepA, voffA);
            PG8_WAIT_L(8); PG8_BAR; PG8_WAIT_L(0); PG8_MMA(0, 0, At, B0); PG8_BAR; PG8_SCHED;
            PG8_LDB(B1, 0, 1); PG8_STAGE(PG8_SB(0, 0), b2, voffB);
            PG8_BAR; PG8_WAIT_L(0); PG8_MMA(0, 1, At, B1); PG8_BAR;
            PG8_LDA(At, 0, 1); PG8_STAGE(PG8_SA(0, 0), a2, voffA);
            PG8_BAR; PG8_WAIT_L(0); PG8_MMA(1, 0, At, B0); PG8_BAR; PG8_SCHED;
            PG8_STAGE(PG8_SB(0, 1), b2 + hstep, voffB);
            PG8_WAIT_V(6); PG8_BAR; PG8_MMA(1, 1, At, B1); PG8_BAR;
            PG8_LDB(B0, 1, 0); PG8_SCHED; PG8_LDA(At, 1, 0); PG8_STAGE(PG8_SA(0, 1), a2 + hstepA, voffA);
            PG8_WAIT_L(8); PG8_BAR; PG8_WAIT_L(0); PG8_MMA(0, 0, At, B0); PG8_BAR; PG8_SCHED;
            PG8_LDB(B1, 1, 1); PG8_STAGE(PG8_SB(1, 0), b3, voffB);
            PG8_BAR; PG8_WAIT_L(0); PG8_MMA(0, 1, At, B1); PG8_BAR;
            PG8_LDA(At, 1, 1); PG8_STAGE(PG8_SA(1, 0), a3, voffA);
            PG8_BAR; PG8_WAIT_L(0); PG8_MMA(1, 0, At, B0); PG8_BAR; PG8_SCHED;
            PG8_STAGE(PG8_SB(1, 1), b3 + hstep, voffB);
            PG8_WAIT_V(6); PG8_BAR; PG8_MMA(1, 1, At, B1); PG8_BAR;
            }
        }
        if constexpr (ALIGN_EPI) { if (wr == 0) PG8_BAR; }
        if constexpr (!Epi::AFTER_DRAIN) { E(acc, cur, wr, wc, fr, fq); S.done(cur); }
        if (!has_next) break;
#pragma unroll
        for (int a = 0; a < 2; ++a)
#pragma unroll
            for (int b = 0; b < 2; ++b)
#pragma unroll
                for (int m = 0; m < 4; ++m)
#pragma unroll
                    for (int n = 0; n < 2; ++n) acc[a][b][m][n] = (f32x4){0.f, 0.f, 0.f, 0.f};
        cur = nxt; cA = nA; cB = nB; ++ui;
        if constexpr (ALIGN_EPI) { if (wr == 1) PG8_BAR; }
    }
    PG8_WAIT_V(0);
    if constexpr (!ALIGN_EPI) { if (wr == 0) PG8_BAR; }
    PG8_BAR;
    if constexpr (Epi::AFTER_DRAIN) { E.fused(acc, cur, wr, wc, fr, fq, lds, wid, lane); S.done(cur); }
#undef PG8_SA
#undef PG8_SB
#undef PG8_STAGE
#undef PG8_LDA
#undef PG8_LDB
#undef PG8_MMA
#undef PG8_WAIT_V
#undef PG8_WAIT_L
#undef PG8_BAR
#undef PG8_SCHED
}
}
constexpr int NWAVES = 8, NTHR = 512;
constexpr int D = 1024, NB = 8, SEQ = 4096, CTX = 256;
constexpr int NCTX = NB * CTX, NLAT = NB * SEQ, MALL = NCTX + NLAT;
constexpr int N0 = 2304, N1 = 6144;
constexpr int C0_Q = 0, C0_K = 256, C0_V = 512, C0_G = 1024, C0_U = 1536, C0_LOW = 2048;
constexpr int C1_Q = 0, C1_K = 1024, C1_V = 2048, C1_G = 4096;
constexpr int NE = 32, MAXTILES = 576;
constexpr float EPS = 1e-6f;
constexpr int NPH = 24;
enum { PH_PRO = 0, PH_NORM1, PH_INPROJ0, PH_GLAPREP, PH_GLA, PH_S5, PH_FIN0, PH_GLU, PH_OUT0, PH_ROUTER0, PH_GATHER0, PH_GU0, PH_DOWN0, PH_COMB0,
       PH_INPROJ1, PH_ROPE, PH_RET, PH_FIN1, PH_OUT1, PH_ROUTER1, PH_GATHER1, PH_GU1, PH_DOWN1, PH_COMB1 };
#ifndef MK_NAIVE_GLA
#define MK_NAIVE_GLA 0
#endif
#ifndef MK_NAIVE_S5
#define MK_NAIVE_S5 0
#endif
#ifndef MK_NAIVE_RET
#define MK_NAIVE_RET 0
#endif
constexpr size_t MiB = 1u << 20;
constexpr size_t WS_CTL = 0, CTL_ZERO_BYTES = 1 * MiB;
constexpr size_t WS_MOD = 1 * MiB;
constexpr size_t WS_WIN0T = 2 * MiB, WS_WOUT0T = 7 * MiB, WS_WGLUT = 9 * MiB, WS_WIN1T = 10 * MiB, WS_WOUT1T = 22 * MiB;
constexpr size_t WS_SELE = 26 * MiB, WS_WSLOT = 27 * MiB, WS_SPOS = 28 * MiB, WS_PROW = 29 * MiB;
constexpr size_t WS_WGUT = 32 * MiB, WS_WDNT = 288 * MiB;
constexpr size_t WS_XRES = 416 * MiB, WS_H = 552 * MiB, WS_MIX = 620 * MiB, WS_YPRE = 688 * MiB;
constexpr size_t WS_PROJ = 748 * MiB, WS_OREC = 1156 * MiB;
constexpr size_t WS_XG = 748 * MiB, WS_ACT = 1036 * MiB, WS_YSLOT = 1324 * MiB;
constexpr size_t WS_S5W1 = 1556 * MiB, WS_S5W2 = 1560 * MiB, WS_A2 = 1568 * MiB, WS_SLOC = 1668 * MiB;
constexpr size_t WS_END = 1740 * MiB;
constexpr int CW_TMO = 0, CW_BAR = 4096, CW_GCNT = 16384;
constexpr int RING_BYTES = 131072, LDSCTL_OFF = RING_BYTES, LDS_BYTES = 147456;
constexpr int L_MISC = LDSCTL_OFF;
constexpr int L_TILEE = LDSCTL_OFF + 256;
constexpr int L_TSTART = LDSCTL_OFF + 1024;
constexpr int L_LCNT = LDSCTL_OFF + 1280;
constexpr int L_GBASE = LDSCTL_OFF + 1536;
constexpr int L_BLKE = LDSCTL_OFF + 2048;
constexpr int L_BLKP = LDSCTL_OFF + 5120;

#define GAS __attribute__((address_space(1)))
#define LAS __attribute__((address_space(3)))
typedef unsigned short bf16;
typedef unsigned v4u __attribute__((ext_vector_type(4)));
typedef unsigned v2u __attribute__((ext_vector_type(2)));
typedef float f32x4 __attribute__((ext_vector_type(4)));
typedef GAS unsigned gu32;
#define RLX_AGENT __ATOMIC_RELAXED, __HIP_MEMORY_SCOPE_AGENT
#define LDS_WAIT() asm volatile("s_waitcnt lgkmcnt(0)" ::: "memory")
#define VM_WAIT() asm volatile("s_waitcnt vmcnt(0)" ::: "memory")
__device__ __forceinline__ unsigned f2bf(float f) { unsigned u = __builtin_bit_cast(unsigned, f); return (u + 0x7fffu + ((u >> 16) & 1u)) >> 16; }
__device__ __forceinline__ unsigned pk2(float lo, float hi) { return f2bf(lo) | (f2bf(hi) << 16); }
__device__ __forceinline__ float bf2f(unsigned b) { return __uint_as_float(b << 16); }
__device__ __forceinline__ float blo(unsigned w) { return __uint_as_float(w << 16); }
__device__ __forceinline__ float bhi(unsigned w) { return __uint_as_float(w & 0xffff0000u); }
__device__ __forceinline__ float wave_sum(float v) {
#pragma unroll
    for (int o = 1; o < 64; o <<= 1) v += __shfl_xor(v, o);
    return v;
}
__device__ __forceinline__ float silu_(float z) { return z / (1.0f + __expf(-z)); }
#define XB_TMO      128
#define XB_XCNT(j)  (256  + 64 * (j))
#define XB_XSUB(j)  (1280 + 64 * (j))
#define XB_XGEN(j)  (2304 + 64 * (j))
#define XB_TOP      3328
#define XB_TOPGEN   3392
#define XCD_BAR_WORDS 3456
#define XB_SPIN_CAP (1u << 22)

__device__ __forceinline__ unsigned xb_ld(unsigned* p)              { return __hip_atomic_load(p, __ATOMIC_RELAXED, __HIP_MEMORY_SCOPE_AGENT); }
__device__ __forceinline__ unsigned xb_add(unsigned* p, unsigned v) { return __hip_atomic_fetch_add(p, v, __ATOMIC_RELAXED, __HIP_MEMORY_SCOPE_AGENT); }
__device__ __forceinline__ unsigned xb_xcc_id() { return (unsigned)__builtin_amdgcn_s_getreg((3 << 11) | 20) & 0xFu; }
#define XB_SPIN(cond, bar) do { unsigned _sp = 0; while (cond) { __builtin_amdgcn_s_sleep(1); \
    if ((++_sp & 255u) == 0u) { if (xb_ld(&(bar)[XB_TMO])) break; if (_sp > XB_SPIN_CAP) { atomicAdd(&(bar)[XB_TMO], 1u); break; } } } } while (0)

struct XcdBarrier {
    unsigned* bar; unsigned x;
    volatile LAS unsigned* st;
};

__device__ __forceinline__ XcdBarrier xcd_barrier_post(unsigned* bar, volatile LAS unsigned* st) {
    XcdBarrier b; b.bar = bar; b.x = xb_xcc_id(); b.st = st;
    if (threadIdx.x == 0) (void)xb_add(&bar[XB_XCNT(b.x)], 1u);
    return b;
}
__device__ __forceinline__ void xcd_barrier_complete(unsigned* bar, unsigned x, unsigned& nloc, unsigned& nx) {
    const unsigned G = gridDim.x * gridDim.y * gridDim.z;
    unsigned sum, cnt, mine, sp = 0u;
    for (;;) {
        sum = 0u; cnt = 0u; mine = 0u;
#pragma unroll
        for (unsigned j = 0; j < 16; ++j) { const unsigned c = xb_ld(&bar[XB_XCNT(j)]); sum += c; cnt += (c > 0u) ? 1u : 0u; mine = (j == x) ? c : mine; }
        if (sum == G) break;
        __builtin_amdgcn_s_sleep(1);
        if ((++sp & 255u) == 0u) { if (xb_ld(&bar[XB_TMO])) break; if (sp > XB_SPIN_CAP) { atomicAdd(&bar[XB_TMO], 1u); break; } }
    }
    nloc = mine > 0u ? mine : 1u; nx = cnt > 0u ? cnt : 1u;
}

__device__ __forceinline__ void xcd_barrier(const XcdBarrier& b) {
    asm volatile("s_waitcnt vmcnt(0)" ::: "memory");
    __syncthreads();
    if (threadIdx.x == 0) {
        unsigned* bar = b.bar;
        __builtin_amdgcn_s_waitcnt(0);
        unsigned nloc = b.st[0], nx = b.st[1];
        if (nloc == 0u) { xcd_barrier_complete(bar, b.x, nloc, nx); b.st[0] = nloc; b.st[1] = nx; }
        const unsigned old = xb_add(&bar[XB_XSUB(b.x)], 1u);
        const unsigned gen = old / nloc;
        if (old + 1u == (gen + 1u) * nloc) {
            __builtin_amdgcn_fence(__ATOMIC_RELEASE, "agent");
            asm volatile("s_waitcnt vmcnt(0)" ::: "memory");
            const unsigned og = xb_add(&bar[XB_TOP], 1u);
            const unsigned tg = og / nx;
            if (og + 1u == (tg + 1u) * nx) xb_add(&bar[XB_TOPGEN], 1u);
            else XB_SPIN(xb_ld(&bar[XB_TOPGEN]) == tg, bar);
            __builtin_amdgcn_fence(__ATOMIC_ACQUIRE, "agent");
            xb_add(&bar[XB_XGEN(b.x)], 1u);
            asm volatile("s_waitcnt vmcnt(0)" ::: "memory");
        } else {
            XB_SPIN(xb_ld(&bar[XB_XGEN(b.x)]) == gen, bar);
            __builtin_amdgcn_fence(__ATOMIC_ACQUIRE, "agent");
            asm volatile("s_waitcnt vmcnt(0)" ::: "memory");
        }
    }
    __syncthreads();
}
struct Args { const float* in[34]; float* out; unsigned char* ws; int ph_lo, ph_hi; };
#define CAS __attribute__((address_space(4)))
struct KA {
    const CAS unsigned char* p;
    __device__ __forceinline__ const float* I(int i) const { return *(const float* const CAS*)(p + 8 * i); }
    __device__ __forceinline__ float* OUT() const { return *(float* const CAS*)(p + 8 * 34); }
    __device__ __forceinline__ unsigned char* WS() const { return *(unsigned char* const CAS*)(p + 8 * 35); }
    __device__ __forceinline__ int LO() const { return *(const CAS int*)(p + 8 * 36); }
    __device__ __forceinline__ int HI() const { return *(const CAS int*)(p + 8 * 36 + 4); }
};
__device__ __forceinline__ KA ka_fresh() { KA a; a.p = (const CAS unsigned char*)__builtin_amdgcn_kernarg_segment_ptr(); asm volatile("" : "+s"(a.p)); return a; }
static_assert(sizeof(Args) == 8 * 36 + 8, "kernarg layout");
struct Frame {
    LAS unsigned char* lds;
    volatile LAS unsigned* MISC;
    unsigned* ctl;
    int tid, lane, wave, vcu, G;
};
enum { I_X = 0, I_C, I_CTX, I_CCTX, I_ADAW, I_ADAB, I_N1G, I_N2G, I_ABWIN, I_ABWOUT, I_GLAWA, I_GLABA, I_GLANG, I_LAMRE, I_LAMIM, I_LOGSTEP, I_BRE, I_BIM, I_CRE, I_CIM,
       I_S5D, I_GLUW, I_GLUB, I_RETWIN, I_RETWOUT, I_RETDEC, I_RETNG, I_WROUTER, I_BROUTER, I_WGU, I_BGU, I_WDN, I_BDN, I_FNG };

constexpr int S5_ROWS = 2304, S5_CH = 272;
struct S5Par { float lr, li, step; };
__device__ __forceinline__ void s5_cpow(float lr, float li, float step, float n, float& ar, float& ai) { const float mag = expf(lr * step * n); float s, c; sincosf(li * step * n, &s, &c); ar = mag * c; ai = mag * s; }
__device__ __forceinline__ void s5_zoh_f(float lr, float li, float step, float& fr, float& fi) { float ar, ai; s5_cpow(lr, li, step, 1.0f, ar, ai); const float den = lr * lr + li * li;
    fr = ((ar - 1.0f) * lr + ai * li) / den; fi = (ai * lr - (ar - 1.0f) * li) / den; }
__device__ __forceinline__ void s5_table_item(const KA& A, int kind, int idx, bf16* W1T, bf16* W2T, LAS float* scr, int lane) {
    if (kind == 0) {
        const int g = idx >> 8, n = idx & 255, dir = n >> 7, ri = (n >> 6) & 1, p = n & 63;
        const float lr = A.I(I_LAMRE)[(dir * 32 + g) * 64 + p], li = A.I(I_LAMIM)[(dir * 32 + g) * 64 + p], step = expf(A.I(I_LOGSTEP)[dir * 32 + g]);
        float fr, fi; s5_zoh_f(lr, li, step, fr, fi);
        const int t = lane >> 2, c0 = (lane & 3) * 4;
        float ar, ai; s5_cpow(lr, li, step, (float)(dir ? t : 15 - t), ar, ai);
        const float gr = ar * fr - ai * fi, gi = ar * fi + ai * fr;
        float o[4];
#pragma unroll
        for (int j = 0; j < 4; ++j) { const float br = A.I(I_BRE)[(g * 64 + p) * 16 + c0 + j], bi = A.I(I_BIM)[(g * 64 + p) * 16 + c0 + j]; o[j] = ri ? (gr * bi + gi * br) : (gr * br - gi * bi); }
        v2u w; w.x = pk2(o[0], o[1]); w.y = pk2(o[2], o[3]);
        *(GAS v2u*)(W1T + ((size_t)g * 256 + n) * 256 + 4 * lane) = w;
    } else if (kind == 1) {
        const int g = idx >> 8, n = idx & 255, t = n >> 4, cp = n & 15;
        const int dir = lane >> 5, ri = (lane >> 4) & 1, p0 = (lane & 15) * 4;
        const float step = expf(A.I(I_LOGSTEP)[dir * 32 + g]);
        float o[4];
#pragma unroll
        for (int j = 0; j < 4; ++j) { const int p = p0 + j;
            const float lr = A.I(I_LAMRE)[(dir * 32 + g) * 64 + p], li = A.I(I_LAMIM)[(dir * 32 + g) * 64 + p];
            float ar, ai; s5_cpow(lr, li, step, (float)(dir ? 16 - t : t + 1), ar, ai);
            const float cr = A.I(I_CRE)[((dir * 32 + g) * 16 + cp) * 64 + p], ci = A.I(I_CIM)[((dir * 32 + g) * 16 + cp) * 64 + p];
            o[j] = ri ? -(cr * ai + ci * ar) : (cr * ar - ci * ai); }
        v2u w; w.x = pk2(o[0], o[1]); w.y = pk2(o[2], o[3]);
        *(GAS v2u*)(W2T + ((size_t)g * 256 + n) * 512 + 256 + 4 * lane) = w;
    } else {
        const int g = idx >> 4, tau = idx & 15;
        {
#pragma unroll
            for (int dir = 0; dir < 2; ++dir) { const float lr = A.I(I_LAMRE)[(dir * 32 + g) * 64 + lane], li = A.I(I_LAMIM)[(dir * 32 + g) * 64 + lane], step = expf(A.I(I_LOGSTEP)[dir * 32 + g]);
                float fr, fi, ar, ai; s5_zoh_f(lr, li, step, fr, fi); s5_cpow(lr, li, step, (float)tau, ar, ai);
                scr[(dir * 64 + lane) * 2] = ar * fr - ai * fi; scr[(dir * 64 + lane) * 2 + 1] = ar * fi + ai * fr; }
        }
        LDS_WAIT(); asm volatile("" ::: "memory");
        const int cp = lane >> 2, c0 = (lane & 3) * 4;
        float kf[4] = {0.f, 0.f, 0.f, 0.f}, kb2[4] = {0.f, 0.f, 0.f, 0.f};
        for (int p = 0; p < 64; ++p) {
            const f32x4 b4r = *(const f32x4*)(A.I(I_BRE) + (g * 64 + p) * 16 + c0), b4i = *(const f32x4*)(A.I(I_BIM) + (g * 64 + p) * 16 + c0);
#pragma unroll
            for (int dir = 0; dir < 2; ++dir) { const float gr = scr[(dir * 64 + p) * 2], gi = scr[(dir * 64 + p) * 2 + 1];
                const float cr = A.I(I_CRE)[((dir * 32 + g) * 16 + cp) * 64 + p], ci = A.I(I_CIM)[((dir * 32 + g) * 16 + cp) * 64 + p];
#pragma unroll
                for (int j = 0; j < 4; ++j) { const float xr = gr * b4r[j] - gi * b4i[j], xi = gr * b4i[j] + gi * b4r[j]; const float v = cr * xr - ci * xi;
                    if (dir == 0) kf[j] += v; else kb2[j] += v; } }
        }
        LDS_WAIT(); asm volatile("" ::: "memory");
        bf16* Wg = W2T + (size_t)g * 256 * 512;
        if (tau == 0) { v2u w; w.x = pk2(kf[0] + kb2[0], kf[1] + kb2[1]); w.y = pk2(kf[2] + kb2[2], kf[3] + kb2[3]);
            for (int t = 0; t < 16; ++t) *(GAS v2u*)(Wg + (size_t)(t * 16 + cp) * 512 + t * 16 + c0) = w;
        } else { v2u wf, wb; wf.x = pk2(kf[0], kf[1]); wf.y = pk2(kf[2], kf[3]); wb.x = pk2(kb2[0], kb2[1]); wb.y = pk2(kb2[2], kb2[3]);
            for (int t = tau; t < 16; ++t) *(GAS v2u*)(Wg + (size_t)(t * 16 + cp) * 512 + (t - tau) * 16 + c0) = wf;
            for (int t = 0; t + tau < 16; ++t) *(GAS v2u*)(Wg + (size_t)(t * 16 + cp) * 512 + (t + tau) * 16 + c0) = wb; }
    }
}
__device__ __forceinline__ void p_s5_scan(Frame& F, const float* SLOC, bf16* A2) {
    const KA A = ka_fresh();
    if (F.tid >= 128) return;
    for (int idx = F.vcu * 128 + F.tid; idx < NB * 32 * 2 * 64; idx += F.G * 128) {
        const int p = idx & 63, dir = (idx >> 6) & 1, g = (idx >> 7) & 31, b = idx >> 12;
        const float lr = A.I(I_LAMRE)[(dir * 32 + g) * 64 + p], li = A.I(I_LAMIM)[(dir * 32 + g) * 64 + p], step = expf(A.I(I_LOGSTEP)[dir * 32 + g]);
        float ar, ai; s5_cpow(lr, li, step, 16.0f, ar, ai);
        float sr = 0.f, si = 0.f;
        const size_t rbase = (size_t)g * S5_ROWS + (size_t)b * S5_CH;
        for (int q0 = 0; q0 < S5_CH; q0 += 8) {
            float lre[8], lim[8];
#pragma unroll
            for (int u = 0; u < 8; ++u) { const int q = q0 + u, n = dir ? (q < 16 ? 15 - q : 271 - (q - 16)) : q; const float* sp = SLOC + (rbase + n) * 256 + dir * 128 + p; lre[u] = sp[0]; lim[u] = sp[64]; }
#pragma unroll
            for (int u = 0; u < 8; ++u) { const int q = q0 + u, n = dir ? (q < 16 ? 15 - q : 271 - (q - 16)) : q; bf16* ap = A2 + (rbase + n) * 512 + 256 + dir * 128 + p;
                ap[0] = (bf16)f2bf(sr); ap[64] = (bf16)f2bf(si);
                const float nr = ar * sr - ai * si + lre[u], ni = ar * si + ai * sr + lim[u]; sr = nr; si = ni; }
        }
    }
}
__device__ __forceinline__ void tr_item(const float* src, int ldsrc, int K, int srccol, float scale, bf16* dst, int dstrow0, int k0, LAS float* scr, int lane) {
    if (srccol >= 0) {
#pragma unroll 8
        for (int i = 0; i < 32; ++i) { const int kk = 2 * i + (lane >> 5); scr[kk * 33 + (lane & 31)] = src[(size_t)(k0 + kk) * ldsrc + srccol + (lane & 31)] * scale; }
    } else {
#pragma unroll 8
        for (int i = 0; i < 32; ++i) { const int kk = 2 * i + (lane >> 5); scr[kk * 33 + (lane & 31)] = 0.f; }
    }
    LDS_WAIT(); asm volatile("" ::: "memory");
    const int c = lane & 7;
#pragma unroll
    for (int j = 0; j < 4; ++j) { const int n = (lane >> 3) + 8 * j; const LAS float* s = scr + (8 * c) * 33 + n;
        v4u o; o.x = pk2(s[0 * 33], s[1 * 33]); o.y = pk2(s[2 * 33], s[3 * 33]); o.z = pk2(s[4 * 33], s[5 * 33]); o.w = pk2(s[6 * 33], s[7 * 33]);
        *(GAS v4u*)(dst + (size_t)(dstrow0 + n) * K + k0 + 8 * c) = o; }
    LDS_WAIT(); asm volatile("" ::: "memory");
}
__device__ __forceinline__ void p0_prologue(Frame& F) {
    const KA A = ka_fresh();
    unsigned char* ws = A.WS();
    LAS float* scr = (LAS float*)(F.lds + F.wave * 8704);
    LAS float* sl = (LAS float*)(F.lds + 69632);
    for (int idx = F.tid; idx < 9 * 1024; idx += NTHR) { const int b = idx >> 10, k = idx & 1023; const float cv = b < 8 ? A.I(I_C)[b * 1024 + k] : A.I(I_CCTX)[k]; sl[k * 12 + b] = silu_(cv); }
    __syncthreads();
    const int gw = F.vcu * NWAVES + F.wave, NGW = F.G * NWAVES, lane = F.lane;
    constexpr int I_MOD = 192, I_S5A = 8192, I_S5B = 8192, I_S5C = 512, I_IN0 = 1152, I_OUT0 = 512, I_GLU = 128, I_IN1 = 3072, I_OUT1 = 1024, I_GU = 65536, I_DN = 32768;
    constexpr int NITEMS = I_MOD + I_S5A + I_S5B + I_S5C + I_IN0 + I_OUT0 + I_GLU + I_IN1 + I_OUT1 + I_GU + I_DN;
    for (int it = gw; it < NITEMS; it += NGW) {
        int r = it;
        if (r < I_MOD) {
            const int layer = r / 96, col = (r % 96) * 64 + lane;
            const float* w = A.I(I_ADAW) + (size_t)layer * 1024 * 6144 + col;
            float acc[9];
#pragma unroll
            for (int b = 0; b < 9; ++b) acc[b] = 0.f;
            for (int k0 = 0; k0 < 1024; k0 += 8) {
                float wv[8];
#pragma unroll
                for (int u = 0; u < 8; ++u) wv[u] = w[(size_t)(k0 + u) * 6144];
#pragma unroll
                for (int u = 0; u < 8; ++u) {
#pragma unroll
                    for (int b = 0; b < 9; ++b) acc[b] += sl[(k0 + u) * 12 + b] * wv[u]; }
            }
            float* mod = (float*)(ws + WS_MOD) + (size_t)layer * 9 * 6144;
            const float bb = A.I(I_ADAB)[layer * 6144 + col];
#pragma unroll
            for (int b = 0; b < 9; ++b) mod[b * 6144 + col] = acc[b] + bb;
            continue;
        }
        r -= I_MOD;
        if (r < I_S5A) { s5_table_item(A, 0, r, (bf16*)(ws + WS_S5W1), (bf16*)(ws + WS_S5W2), scr, lane); continue; }
        r -= I_S5A;
        if (r < I_S5B) { s5_table_item(A, 1, r, (bf16*)(ws + WS_S5W1), (bf16*)(ws + WS_S5W2), scr, lane); continue; }
        r -= I_S5B;
        if (r < I_S5C) { s5_table_item(A, 2, r, (bf16*)(ws + WS_S5W1), (bf16*)(ws + WS_S5W2), scr, lane); continue; }
        r -= I_S5C;
        if (r < I_IN0) { const int kb = r / 72, n0 = (r % 72) * 32;
            const int sc = n0 < 1536 ? n0 : (n0 < 2048 ? n0 + 32 : (n0 == 2048 ? 1536 : -1));
            tr_item(A.I(I_ABWIN), 2080, 1024, sc, n0 < 256 ? 0.125f : 1.0f, (bf16*)(ws + WS_WIN0T), n0, kb * 64, scr, lane); continue; }
        r -= I_IN0;
        if (r < I_OUT0) { tr_item(A.I(I_ABWOUT), 1024, 1024, (r % 32) * 32, 1.0f, (bf16*)(ws + WS_WOUT0T), (r % 32) * 32, (r / 32) * 64, scr, lane); continue; }
        r -= I_OUT0;
        if (r < I_GLU) { tr_item(A.I(I_GLUW), 512, 512, (r % 16) * 32, 1.0f, (bf16*)(ws + WS_WGLUT), (r % 16) * 32, (r / 16) * 64, scr, lane); continue; }
        r -= I_GLU;
        if (r < I_IN1) { const int n0 = (r % 192) * 32;
            tr_item(A.I(I_RETWIN), 6144, 1024, n0, (n0 >= 1024 && n0 < 2048) ? 0.0625f : 1.0f, (bf16*)(ws + WS_WIN1T), n0, (r / 192) * 64, scr, lane); continue; }
        r -= I_IN1;
        if (r < I_OUT1) { tr_item(A.I(I_RETWOUT), 1024, 2048, (r % 32) * 32, 1.0f, (bf16*)(ws + WS_WOUT1T), (r % 32) * 32, (r / 32) * 64, scr, lane); continue; }
        r -= I_OUT1;
        if (r < I_GU) { const int mat = r >> 10, q = r & 1023, kb = q >> 6, n0 = (q & 63) * 32;
            const int pn = n0 >> 8, bj = (n0 >> 7) & 1, lc = n0 & 127;
            tr_item(A.I(I_WGU) + (size_t)mat * 1024 * 2048, 2048, 1024, bj * 1024 + pn * 128 + lc, 1.0f, (bf16*)(ws + WS_WGUT) + (size_t)mat * 2048 * 1024, n0, kb * 64, scr, lane); continue; }
        r -= I_GU;
        { const int mat = r >> 9, q = r & 511, kb = q >> 5, n0 = (q & 31) * 32;
          tr_item(A.I(I_WDN) + (size_t)mat * 1024 * 1024, 1024, 1024, n0, 1.0f, (bf16*)(ws + WS_WDNT) + (size_t)mat * 1024 * 1024, n0, kb * 64, scr, lane); }
    }
}
__device__ __forceinline__ void modnorm_store(const f32x4 (&v)[4], const float* g, const float* sc, const float* sh, bf16* hrow, int lane, f32x4 (&h)[4]) {
    float ss = 0.f;
#pragma unroll
    for (int j = 0; j < 4; ++j) ss += (v[j].x * v[j].x + v[j].y * v[j].y) + (v[j].z * v[j].z + v[j].w * v[j].w);
    const float r = rsqrtf(wave_sum(ss) * (1.0f / 1024.0f) + EPS);
#pragma unroll
    for (int j = 0; j < 4; ++j) { const int o = 64 * j + lane;
        const f32x4 gg = ((const f32x4*)g)[o], s4 = ((const f32x4*)sc)[o], h4 = ((const f32x4*)sh)[o];
        h[j] = v[j] * r * gg * (s4 + 1.0f) + h4;
        v2u w; w.x = pk2(h[j].x, h[j].y); w.y = pk2(h[j].z, h[j].w);
        ((GAS v2u*)hrow)[o] = w; }
}
__device__ __forceinline__ int bidx_of_row(int row) { return row < NCTX ? 8 : ((row - NCTX) >> 12); }
__device__ __forceinline__ void p_norm1_l0(Frame& F) {
    const KA A = ka_fresh();
    const int gw = F.vcu * NWAVES + F.wave, NGW = F.G * NWAVES, lane = F.lane;
    const float* mod = (const float*)(A.WS() + WS_MOD);
    bf16* H = (bf16*)(A.WS() + WS_H);
    for (int row = gw; row < MALL; row += NGW) {
        const float* xr = row < NCTX ? A.I(I_CTX) + (size_t)row * 1024 : A.I(I_X) + (size_t)(row - NCTX) * 1024;
        f32x4 v[4], h[4];
#pragma unroll
        for (int j = 0; j < 4; ++j) v[j] = ((const f32x4*)xr)[64 * j + lane];
        const float* m = mod + bidx_of_row(row) * 6144;
        modnorm_store(v, A.I(I_N1G), m + 1024, m, H + (size_t)row * 1024, lane, h);
    }
}
__device__ __forceinline__ int seq_row(int b, int dir, int s) {
    return s < CTX ? b * CTX + (dir ? CTX - 1 - s : s) : NCTX + b * SEQ + (dir ? SEQ - 1 - (s - CTX) : (s - CTX));
}
template <int DK, bool GLA>
__device__ __forceinline__ void rec_naive(Frame& F, const bf16* P, int ldp, int qc, int kc, int vc, int DV, int nvs,
                                          float* O, size_t odir_stride, int ldo, int orow0) {
    const KA A = ka_fresh();
    constexpr int KPW = DK / 8, TB = 16;
    LAS float* qs = (LAS float*)(F.lds);
    LAS float* ks = (LAS float*)(F.lds + 16384);
    LAS float* vv = (LAS float*)(F.lds + 32768);
    LAS float* dec = (LAS float*)(F.lds + 36864);
    LAS float* opart = (LAS float*)(F.lds + 40960);
    const int tid = F.tid, lane = F.lane, wave = F.wave;
    const int nitems = NB * 4 * 2 * nvs;
    for (int it = F.vcu; it < nitems; it += F.G) {
        const int vs = it % nvs, dir = (it / nvs) & 1, h = (it / (2 * nvs)) & 3, b = it / (8 * nvs);
        float gamma = 0.f;
        if (!GLA) { const float lg = A.I(I_RETDEC)[dir * 4 + h]; gamma = 1.0f / (1.0f + expf(-lg)); }
        float S[KPW];
#pragma unroll
        for (int i = 0; i < KPW; ++i) S[i] = 0.f;
        for (int s0 = 0; s0 < CTX + SEQ; s0 += TB) {
            for (int idx = tid; idx < TB * DK; idx += NTHR) { const int i = idx / DK, kk = idx % DK; const size_t rb = (size_t)seq_row(b, dir, s0 + i) * ldp;
                qs[idx] = bf2f(P[rb + qc + h * DK + kk]); ks[idx] = bf2f(P[rb + kc + h * DK + kk]); }
            for (int idx = tid; idx < TB * 64; idx += NTHR) { const int i = idx >> 6, c = idx & 63; const size_t rb = (size_t)seq_row(b, dir, s0 + i) * ldp;
                vv[idx] = bf2f(P[rb + vc + h * DV + vs * 64 + c]);
                if (GLA) { float z = A.I(I_GLABA)[dir * 256 + h * 64 + c];
#pragma unroll
                    for (int r = 0; r < 16; ++r) z += bf2f(P[rb + C0_LOW + dir * 16 + r]) * A.I(I_GLAWA)[(dir * 16 + r) * 256 + h * 64 + c];
                    const float ls = fminf(z, 0.f) - log1pf(expf(-fabsf(z)));
                    dec[idx] = expf(ls * (1.0f / 16.0f)); } }
            __syncthreads();
#pragma unroll 1
            for (int i = 0; i < TB; ++i) { const float vval = vv[i * 64 + lane]; float part = 0.f;
#pragma unroll
                for (int kk = 0; kk < KPW; ++kk) { const int kidx = wave * KPW + kk; const float d = GLA ? dec[i * 64 + kidx] : gamma;
                    S[kk] = d * S[kk] + ks[i * DK + kidx] * vval; part += qs[i * DK + kidx] * S[kk]; }
                opart[(i * 8 + wave) * 64 + lane] = part; }
            __syncthreads();
            for (int idx = tid; idx < TB * 64; idx += NTHR) { const int i = idx >> 6, c = idx & 63; float sum = 0.f;
#pragma unroll
                for (int w = 0; w < 8; ++w) sum += opart[(i * 8 + w) * 64 + c];
                const int row = seq_row(b, dir, s0 + i);
                if (row >= orow0) O[(size_t)dir * odir_stride + (size_t)(row - orow0) * ldo + h * DV + vs * 64 + c] = sum; }
        }
        __syncthreads();
    }
}
__device__ __forceinline__ void s5_naive(Frame& F, const bf16* P, float* Y  ) {
    const KA A = ka_fresh();
    const int lane = F.lane;
    if (F.wave >= 2) return;
    for (int chain = F.vcu * 2 + F.wave; chain < NB * 32 * 2; chain += F.G * 2) {
        const int dir = chain & 1, g = (chain >> 1) & 31, b = chain >> 6;
        const float step = expf(A.I(I_LOGSTEP)[dir * 32 + g]);
        const float lr = A.I(I_LAMRE)[(dir * 32 + g) * 64 + lane], li = A.I(I_LAMIM)[(dir * 32 + g) * 64 + lane];
        const float mag = expf(lr * step), lbr = mag * cosf(li * step), lbi = mag * sinf(li * step), den = lr * lr + li * li;
        const float fr = ((lbr - 1.0f) * lr + lbi * li) / den, fi = (lbi * lr - (lbr - 1.0f) * li) / den;
        float bbr[16], bbi[16], cr[16], ci[16];
#pragma unroll
        for (int c = 0; c < 16; ++c) { const float br = A.I(I_BRE)[(g * 64 + lane) * 16 + c], bi = A.I(I_BIM)[(g * 64 + lane) * 16 + c];
            bbr[c] = fr * br - fi * bi; bbi[c] = fr * bi + fi * br;
            cr[c] = A.I(I_CRE)[((dir * 32 + g) * 16 + c) * 64 + lane]; ci[c] = A.I(I_CIM)[((dir * 32 + g) * 16 + c) * 64 + lane]; }
        float sr = 0.f, si = 0.f;
        for (int s0 = 0; s0 < CTX + SEQ; s0 += 4) {
            v4u uu[4][2];
#pragma unroll
            for (int i = 0; i < 4; ++i) { const v4u* up = (const v4u*)(P + (size_t)seq_row(b, dir, s0 + i) * N0 + C0_U + g * 16); uu[i][0] = up[0]; uu[i][1] = up[1]; }
#pragma unroll
            for (int i = 0; i < 4; ++i) {
                float u[16];
#pragma unroll
                for (int q = 0; q < 2; ++q) { u[8 * q + 0] = blo(uu[i][q].x); u[8 * q + 1] = bhi(uu[i][q].x); u[8 * q + 2] = blo(uu[i][q].y); u[8 * q + 3] = bhi(uu[i][q].y);
                    u[8 * q + 4] = blo(uu[i][q].z); u[8 * q + 5] = bhi(uu[i][q].z); u[8 * q + 6] = blo(uu[i][q].w); u[8 * q + 7] = bhi(uu[i][q].w); }
                float br = 0.f, bi = 0.f;
#pragma unroll
                for (int c = 0; c < 16; ++c) { br += bbr[c] * u[c]; bi += bbi[c] * u[c]; }
                const float nr = lbr * sr - lbi * si + br, ni = lbr * si + lbi * sr + bi; sr = nr; si = ni;
                float v[16];
#pragma unroll
                for (int c = 0; c < 16; ++c) v[c] = cr[c] * sr - ci[c] * si;
                const bool b5 = (lane & 32) != 0, b4 = (lane & 16) != 0, b3 = (lane & 8) != 0, b2 = (lane & 4) != 0;
                float w8[8], w4[4], w2[2];
#pragma unroll
                for (int k = 0; k < 8; ++k) { const float send = b5 ? v[k] : v[k + 8], keep = b5 ? v[k + 8] : v[k]; w8[k] = keep + __shfl_xor(send, 32); }
#pragma unroll
                for (int k = 0; k < 4; ++k) { const float send = b4 ? w8[k] : w8[k + 4], keep = b4 ? w8[k + 4] : w8[k]; w4[k] = keep + __shfl_xor(send, 16); }
#pragma unroll
                for (int k = 0; k < 2; ++k) { const float send = b3 ? w4[k] : w4[k + 2], keep = b3 ? w4[k + 2] : w4[k]; w2[k] = keep + __shfl_xor(send, 8); }
                float w1; { const float send = b2 ? w2[0] : w2[1], keep = b2 ? w2[1] : w2[0]; w1 = keep + __shfl_xor(send, 4); }
                w1 += __shfl_xor(w1, 2); w1 += __shfl_xor(w1, 1);
                const int c = (b5 ? 8 : 0) + (b4 ? 4 : 0) + (b3 ? 2 : 0) + (b2 ? 1 : 0);
                if ((lane & 3) == 0) Y[(size_t)dir * MALL * 512 + (size_t)seq_row(b, dir, s0 + i) * 512 + g * 16 + c] = w1;
            }
        }
    }
}
__device__ __forceinline__ void unpack8(const v4u w, float (&f)[8]) { f[0] = blo(w.x); f[1] = bhi(w.x); f[2] = blo(w.y); f[3] = bhi(w.y); f[4] = blo(w.z); f[5] = bhi(w.z); f[6] = blo(w.w); f[7] = bhi(w.w); }
__device__ __forceinline__ v4u pack8(const float (&f)[8]) { v4u w; w.x = pk2(f[0], f[1]); w.y = pk2(f[2], f[3]); w.z = pk2(f[4], f[5]); w.w = pk2(f[6], f[7]); return w; }
__device__ __forceinline__ void p_finish0(Frame& F) {
    const KA A = ka_fresh();
    const int gw = F.vcu * NWAVES + F.wave, NGW = F.G * NWAVES, lane = F.lane, e0 = lane * 8;
    const bf16* P = (const bf16*)(A.WS() + WS_PROJ);
    const float* GO = (const float*)(A.WS() + WS_OREC);
    const float* SY = GO + (size_t)2 * MALL * 512;
    bf16* MIX = (bf16*)(A.WS() + WS_MIX); bf16* YP = (bf16*)(A.WS() + WS_YPRE);
    for (int row = gw; row < MALL; row += NGW) {
        float o[8], gg[8], ng[8];
#if MK_NAIVE_GLA
        { const f32x4* a = (const f32x4*)(GO + (size_t)row * 512 + e0); const f32x4* bq = (const f32x4*)(GO + (size_t)(MALL + row) * 512 + e0);
          const f32x4 a0 = a[0] + bq[0], a1 = a[1] + bq[1]; o[0] = a0.x; o[1] = a0.y; o[2] = a0.z; o[3] = a0.w; o[4] = a1.x; o[5] = a1.y; o[6] = a1.z; o[7] = a1.w; }
#else
        { const bf16* GO16 = (const bf16*)GO; float f0[8], f1[8]; unpack8(*(const v4u*)(GO16 + (size_t)row * 512 + e0), f0); unpack8(*(const v4u*)(GO16 + (size_t)(MALL + row) * 512 + e0), f1);
#pragma unroll
          for (int j = 0; j < 8; ++j) o[j] = f0[j] + f1[j]; }
#endif
        float ss = 0.f;
#pragma unroll
        for (int j = 0; j < 8; ++j) ss += o[j] * o[j];
        ss += __shfl_xor(ss, 1); ss += __shfl_xor(ss, 2); ss += __shfl_xor(ss, 4); ss += __shfl_xor(ss, 8);
        const float r = rsqrtf(ss * (1.0f / 128.0f) + EPS);
        unpack8(*(const v4u*)(P + (size_t)row * N0 + C0_G + e0), gg);
        { const f32x4* n4 = (const f32x4*)(A.I(I_GLANG) + (e0 & 127)); const f32x4 n0 = n4[0], n1 = n4[1]; ng[0] = n0.x; ng[1] = n0.y; ng[2] = n0.z; ng[3] = n0.w; ng[4] = n1.x; ng[5] = n1.y; ng[6] = n1.z; ng[7] = n1.w; }
        float res[8];
#pragma unroll
        for (int j = 0; j < 8; ++j) res[j] = o[j] * r * ng[j] * silu_(gg[j]);
        *(GAS v4u*)(MIX + (size_t)row * 1024 + e0) = pack8(res);
#if MK_NAIVE_S5
        float u[8], y[8];
        unpack8(*(const v4u*)(P + (size_t)row * N0 + C0_U + e0), u);
        { const f32x4* a = (const f32x4*)(SY + (size_t)row * 512 + e0); const f32x4* bq = (const f32x4*)(SY + (size_t)(MALL + row) * 512 + e0);
          const f32x4 a0 = a[0] + bq[0], a1 = a[1] + bq[1]; y[0] = a0.x; y[1] = a0.y; y[2] = a0.z; y[3] = a0.w; y[4] = a1.x; y[5] = a1.y; y[6] = a1.z; y[7] = a1.w; }
#pragma unroll
        for (int j = 0; j < 8; ++j) { const float t = y[j] + A.I(I_S5D)[e0 + j] * u[j]; res[j] = 0.5f * t * (1.0f + tanhf(0.7978845608f * (t + 0.044715f * t * t * t))); }
        *(GAS v4u*)(YP + (size_t)row * 512 + e0) = pack8(res);
#endif
    }
}
__device__ __forceinline__ void p_finish1(Frame& F) {
    const KA A = ka_fresh();
    const int gw = F.vcu * NWAVES + F.wave, NGW = F.G * NWAVES, lane = F.lane;
    const bf16* P = (const bf16*)(A.WS() + WS_PROJ);
    const float* RO = (const float*)(A.WS() + WS_OREC);
    bf16* MIX = (bf16*)(A.WS() + WS_MIX);
    for (int lrow = gw; lrow < NLAT; lrow += NGW) {
#pragma unroll 1
        for (int h = 0; h < 4; ++h) { const int e0 = h * 512 + lane * 8;
            float o[8], gg[8];
#if MK_NAIVE_RET
            { const f32x4* a = (const f32x4*)(RO + (size_t)lrow * 2048 + e0); const f32x4* bq = (const f32x4*)(RO + (size_t)(NLAT + lrow) * 2048 + e0);
              const f32x4 a0 = a[0] + bq[0], a1 = a[1] + bq[1]; o[0] = a0.x; o[1] = a0.y; o[2] = a0.z; o[3] = a0.w; o[4] = a1.x; o[5] = a1.y; o[6] = a1.z; o[7] = a1.w; }
#else
            { const bf16* RO16 = (const bf16*)RO; float f0[8], f1[8]; unpack8(*(const v4u*)(RO16 + (size_t)lrow * 2048 + e0), f0); unpack8(*(const v4u*)(RO16 + (size_t)(NLAT + lrow) * 2048 + e0), f1);
#pragma unroll
              for (int j = 0; j < 8; ++j) o[j] = f0[j] + f1[j]; }
#endif
            float s = 0.f;
#pragma unroll
            for (int j = 0; j < 8; ++j) s += o[j];
            const float mu = wave_sum(s) * (1.0f / 512.0f); float q = 0.f;
#pragma unroll
            for (int j = 0; j < 8; ++j) { o[j] -= mu; q += o[j] * o[j]; }
            const float r = rsqrtf(wave_sum(q) * (1.0f / 512.0f) + EPS);
            unpack8(*(const v4u*)(P + (size_t)(NCTX + lrow) * N1 + C1_G + e0), gg);
            float res[8];
#pragma unroll
            for (int j = 0; j < 8; ++j) res[j] = o[j] * r * A.I(I_RETNG)[e0 + j] * silu_(gg[j]);
            *(GAS v4u*)(MIX + (size_t)lrow * 2048 + e0) = pack8(res); }
    }
}
__device__ __forceinline__ void p_rope(Frame& F) {
    const KA A = ka_fresh();
    const int gw = F.vcu * NWAVES + F.wave, NGW = F.G * NWAVES, lane = F.lane;
    bf16* P = (bf16*)(A.WS() + WS_PROJ);
    const float invf = expf(-(float)lane * (9.210340371976184f / 64.0f));
    for (int lrow = gw; lrow < NLAT; lrow += NGW) {
        const int t = lrow & (SEQ - 1), pr = t >> 6, pc = t & 63;
        float sr, cr, sc, cc; sincosf((float)pr * invf, &sr, &cr); sincosf((float)pc * invf, &sc, &cc);
        bf16* rp = P + (size_t)(NCTX + lrow) * N1;
#pragma unroll 1
        for (int tb = 0; tb < 2048; tb += 256) {
            { const float a = bf2f(rp[tb + lane]), b2 = bf2f(rp[tb + 64 + lane]); rp[tb + lane] = (bf16)f2bf(a * cr - b2 * sr); rp[tb + 64 + lane] = (bf16)f2bf(a * sr + b2 * cr); }
            { const float a = bf2f(rp[tb + 128 + lane]), b2 = bf2f(rp[tb + 192 + lane]); rp[tb + 128 + lane] = (bf16)f2bf(a * cc - b2 * sc); rp[tb + 192 + lane] = (bf16)f2bf(a * sc + b2 * cc); }
        }
    }
}
__device__ __forceinline__ void p_router(Frame& F, int layer) {
    const KA A = ka_fresh();
    const int tid = F.tid, lane = F.lane, wave = F.wave;
    const int moe_row0 = layer ? NCTX : 0, NTOK = layer ? NLAT : MALL;
    const int RPB = (NTOK + F.G - 1) / F.G;
    unsigned char* ws = A.WS();
    int* prow = (int*)(ws + WS_PROW); int* sel_e = (int*)(ws + WS_SELE); float* w_slot = (float*)(ws + WS_WSLOT); int* slot_pos = (int*)(ws + WS_SPOS);
    for (int i = F.vcu * NTHR + tid; i < MAXTILES * 256; i += F.G * NTHR) prow[i] = -1;
    LAS float* Wt = (LAS float*)F.lds;
    LAS int* lcnt = (LAS int*)(F.lds + L_LCNT); LAS int* gbase = (LAS int*)(F.lds + L_GBASE);
    LAS int* blk_e = (LAS int*)(F.lds + L_BLKE); LAS int* blk_p = (LAS int*)(F.lds + L_BLKP);
    const float* wr = A.I(I_WROUTER) + (size_t)layer * 1024 * 32;
    for (int idx = tid; idx < 32768; idx += NTHR) Wt[(idx & 31) * 1024 + (idx >> 5)] = wr[idx];
    if (tid < 32) lcnt[tid] = 0;
    __syncthreads();
    const float* mod = (const float*)(ws + WS_MOD) + (size_t)layer * 9 * 6144;
    const float* XR = (const float*)(ws + WS_XRES); bf16* H = (bf16*)(ws + WS_H);
    const int tok0 = F.vcu * RPB;
    for (int lr = wave; lr < RPB; lr += NWAVES) {
        const int tok = tok0 + lr; if (tok >= NTOK) break;
        const int row = moe_row0 + tok;
        f32x4 v[4], h[4];
#pragma unroll
        for (int j = 0; j < 4; ++j) v[j] = ((const f32x4*)(XR + (size_t)row * 1024))[64 * j + lane];
        const float* m = mod + bidx_of_row(row) * 6144;
        modnorm_store(v, A.I(I_N2G) + layer * 1024, m + 4096, m + 3072, H + (size_t)row * 1024, lane, h);
        float lg[32];
#pragma unroll
        for (int e = 0; e < 32; ++e) { float a = 0.f;
#pragma unroll
            for (int j = 0; j < 4; ++j) { const f32x4 w4 = *(const LAS f32x4*)(Wt + e * 1024 + 4 * (64 * j + lane)); a += (h[j].x * w4.x + h[j].y * w4.y) + (h[j].z * w4.z + h[j].w * w4.w); }
            lg[e] = wave_sum(a) + A.I(I_BROUTER)[layer * 32 + e]; }
        float bv[4]; int bi[4];
#pragma unroll
        for (int r = 0; r < 4; ++r) { float best = -INFINITY; int be = 0;
#pragma unroll
            for (int e = 0; e < 32; ++e) { const bool take = lg[e] > best; best = take ? lg[e] : best; be = take ? e : be; }
            bv[r] = best; bi[r] = be;
#pragma unroll
            for (int e = 0; e < 32; ++e) lg[e] = (e == be) ? -INFINITY : lg[e]; }
        const float e1 = __expf(bv[1] - bv[0]), e2 = __expf(bv[2] - bv[0]), e3 = __expf(bv[3] - bv[0]), inv = 1.0f / (1.0f + e1 + e2 + e3);
        if (lane < 4) { const int ee = lane == 0 ? bi[0] : (lane == 1 ? bi[1] : (lane == 2 ? bi[2] : bi[3]));
            const float wv = (lane == 0 ? 1.0f : (lane == 1 ? e1 : (lane == 2 ? e2 : e3))) * inv;
            sel_e[tok * 4 + lane] = ee; w_slot[tok * 4 + lane] = wv;
            const int lp = __hip_atomic_fetch_add(lcnt + ee, 1, __ATOMIC_RELAXED, __HIP_MEMORY_SCOPE_WORKGROUP);
            blk_e[lr * 4 + lane] = ee; blk_p[lr * 4 + lane] = lp; }
    }
    __syncthreads();
    if (tid < 32) gbase[tid] = (int)__hip_atomic_fetch_add(F.ctl + CW_GCNT + 64 * layer + tid, (unsigned)lcnt[tid], RLX_AGENT);
    __syncthreads();
    for (int idx = tid; idx < RPB * 4; idx += NTHR) { const int tok = tok0 + (idx >> 2); if (tok < NTOK) slot_pos[tok * 4 + (idx & 3)] = gbase[blk_e[idx]] + blk_p[idx]; }
}
__device__ __forceinline__ int moe_tables(Frame& F, int layer) {
    LAS int* ts = (LAS int*)(F.lds + L_TSTART); LAS unsigned char* te = (LAS unsigned char*)(F.lds + L_TILEE);
    __syncthreads();
    if (F.tid == 0) { int acc = 0;
        for (int e = 0; e < 32; ++e) { ts[e] = acc; acc += ((int)__hip_atomic_load(F.ctl + CW_GCNT + 64 * layer + e, RLX_AGENT) + 255) >> 8; }
        ts[32] = acc > MAXTILES ? MAXTILES : acc; }
    __syncthreads();
    const int nt = ts[32];
    for (int T = F.tid; T < nt; T += NTHR) { int e = 0;
        for (int q = 1; q < 32; ++q) e = (T >= ts[q]) ? q : e;
        te[T] = (unsigned char)e; }
    __syncthreads();
    return nt;
}
__device__ __forceinline__ void p_gather(Frame& F, int layer) {
    const KA A = ka_fresh();
    const int gw = F.vcu * NWAVES + F.wave, NGW = F.G * NWAVES, lane = F.lane;
    const int moe_row0 = layer ? NCTX : 0, NTOK = layer ? NLAT : MALL;
    unsigned char* ws = A.WS();
    moe_tables(F, layer);
    const LAS int* ts = (const LAS int*)(F.lds + L_TSTART);
    int* prow = (int*)(ws + WS_PROW); const int* sel_e = (const int*)(ws + WS_SELE); const int* slot_pos = (const int*)(ws + WS_SPOS);
    const bf16* H = (const bf16*)(ws + WS_H); bf16* XG = (bf16*)(ws + WS_XG);
    for (int s = gw; s < NTOK * 4; s += NGW) {
        const int e = sel_e[s], p = ts[e] * 256 + slot_pos[s];
        const v4u* src = (const v4u*)(H + (size_t)(moe_row0 + (s >> 2)) * 1024); GAS v4u* dst = (GAS v4u*)(XG + (size_t)p * 1024);
        const v4u a = src[lane], b2 = src[64 + lane]; dst[lane] = a; dst[64 + lane] = b2;
        if (lane == 0) prow[p] = s;
    }
}
__device__ __forceinline__ void p_combine(Frame& F, int layer) {
    const KA A = ka_fresh();
    const int gw = F.vcu * NWAVES + F.wave, NGW = F.G * NWAVES, lane = F.lane;
    const int moe_row0 = layer ? NCTX : 0, NTOK = layer ? NLAT : MALL;
    unsigned char* ws = A.WS();
    float* XR = (float*)(ws + WS_XRES); bf16* H = (bf16*)(ws + WS_H); const bf16* YS = (const bf16*)(ws + WS_YSLOT);
    const float* mod = (const float*)(ws + WS_MOD);
    for (int tok = gw; tok < NTOK; tok += NGW) {
        const int row = moe_row0 + tok, bidx = bidx_of_row(row);
        const float* g2 = mod + (size_t)layer * 9 * 6144 + bidx * 6144 + 5120;
        f32x4 v[4];
#pragma unroll
        for (int j = 0; j < 4; ++j) { const int o = 64 * j + lane; f32x4 y = (f32x4){0.f, 0.f, 0.f, 0.f};
#pragma unroll
            for (int k = 0; k < 4; ++k) { const v2u w = ((const v2u*)(YS + (size_t)(tok * 4 + k) * 1024))[o]; y += (f32x4){blo(w.x), bhi(w.x), blo(w.y), bhi(w.y)}; }
            v[j] = ((const f32x4*)(XR + (size_t)row * 1024))[o] + ((const f32x4*)g2)[o] * y; }
        if (layer == 0) {
#pragma unroll
            for (int j = 0; j < 4; ++j) ((f32x4*)(XR + (size_t)row * 1024))[64 * j + lane] = v[j];
            const float* m1 = mod + (size_t)9 * 6144 + bidx * 6144; f32x4 h[4];
            modnorm_store(v, A.I(I_N1G) + 1024, m1 + 1024, m1, H + (size_t)row * 1024, lane, h);
        } else {
            float ss = 0.f;
#pragma unroll
            for (int j = 0; j < 4; ++j) ss += (v[j].x * v[j].x + v[j].y * v[j].y) + (v[j].z * v[j].z + v[j].w * v[j].w);
            const float r = rsqrtf(wave_sum(ss) * (1.0f / 1024.0f) + EPS);
#pragma unroll
            for (int j = 0; j < 4; ++j) { const int o = 64 * j + lane; ((f32x4*)(A.OUT() + (size_t)tok * 1024))[o] = v[j] * r * ((const f32x4*)A.I(I_FNG))[o]; }
        }
    }
}
typedef short s16x4 __attribute__((ext_vector_type(4)));
typedef short bfx8 __attribute__((ext_vector_type(8)));
typedef short v4i16_t __attribute__((ext_vector_type(4)));
#define MFMA16(a, b, c) __builtin_amdgcn_mfma_f32_16x16x32_bf16((a), (b), (c), 0, 0, 0)
__device__ __forceinline__ bfx8 frag_n(const LAS unsigned char* tile, int stride, int r0, int k0, int lane) {
    return *(const LAS bfx8*)(tile + (r0 + (lane & 15)) * stride + (k0 + 8 * (lane >> 4)) * 2);
}
__device__ __forceinline__ bfx8 frag_t(const LAS unsigned char* tile, int stride, int k0, int n0, int lane) {
    const int g = lane >> 4, q = (lane & 15) >> 2, p = lane & 3;
    const LAS unsigned char* a = tile + (k0 + 8 * g + q) * stride + (n0 + 4 * p) * 2;
    const s16x4 lo = __builtin_bit_cast(s16x4, __builtin_amdgcn_ds_read_tr16_b64_v4i16((LAS v4i16_t*)a));
    const s16x4 hi = __builtin_bit_cast(s16x4, __builtin_amdgcn_ds_read_tr16_b64_v4i16((LAS v4i16_t*)(a + 4 * stride)));
    return __builtin_shufflevector(lo, hi, 0, 1, 2, 3, 4, 5, 6, 7);
}
__device__ __forceinline__ v4u scale8(const v4u w, float s) { float f[8]; unpack8(w, f);
#pragma unroll
    for (int j = 0; j < 8; ++j) f[j] *= s;
    return pack8(f); }

template <int DK, int DVS, bool GLA>
__device__ __forceinline__ void rec_mfma(Frame& F, const bf16* Qsrc, const bf16* Ksrc, const bf16* K2src, size_t qdir_stride, int ldq, int qcol, int kcol,
                                         const bf16* Vsrc, int ldv, int vcol, int DV, const float* EB,
                                         bf16* O, size_t odir_stride, int ldo, int orow0) {
    const KA A = ka_fresh();
    constexpr int SQ = DK * 2 + 16, SV = DVS * 2 + 16, SP = 144, SS = DK * 2 + 16;
    constexpr int O_QD = 0, O_KI = O_QD + 64 * SQ, O_KS = O_KI + 64 * SQ, O_V = O_KS + (GLA ? 64 * SQ : 0), O_VD = O_V + 64 * SV, O_P = O_VD + (GLA ? 0 : 64 * SV), O_ST = O_P + 64 * SP, O_EB = O_ST + DVS * SS;
    static_assert(O_EB + DK * 4 <= RING_BYTES, "rec_mfma LDS");
    constexpr int NVS = 0;  (void)NVS;
    constexpr int VT_PER = DVS / 32, KT_PER = DK / 64, QCH = DK / 8  , QN = (64 * QCH) / NTHR, VCH = DVS / 8, KSTEPS = DK / 32;
    static_assert(QN >= 1 && VT_PER >= 1 && KT_PER >= 1, "shape");
    const LAS unsigned char* L = F.lds;
    const int tid = F.tid, lane = F.lane, w = F.wave, it = w & 3, vg = w >> 2, kg = w & 3, g4 = lane >> 4, l15 = lane & 15;
    const int nvs = DV / DVS, nitems = NB * 4 * 2 * nvs;
    for (int item = F.vcu; item < nitems; item += F.G) {
        const int vs = item % nvs, dir = (item / nvs) & 1, h = (item / (2 * nvs)) & 3, b = item / (8 * nvs);
        float lg2 = 0.f;
        if (!GLA) { const float lgt = A.I(I_RETDEC)[dir * 4 + h]; lg2 = -log2f(1.0f + expf(-lgt)); }
        const bf16* qb = Qsrc + (GLA ? (size_t)dir * qdir_stride : 0) + qcol + h * DK;
        const bf16* kb = Ksrc + (GLA ? (size_t)dir * qdir_stride : 0) + kcol + h * DK;
        const bf16* k2b = GLA ? K2src + (size_t)dir * qdir_stride + kcol + h * DK : kb;
        const bf16* vb = Vsrc + vcol + h * DV + vs * DVS;
        f32x4 Sacc[VT_PER][KT_PER];
#pragma unroll
        for (int a = 0; a < VT_PER; ++a)
#pragma unroll
            for (int c2 = 0; c2 < KT_PER; ++c2) Sacc[a][c2] = (f32x4){0.f, 0.f, 0.f, 0.f};
        for (int i = tid; i < DVS * SS / 4; i += NTHR) ((LAS unsigned*)(F.lds + O_ST))[i] = 0u;
        v4u rq[QN], rk[QN], rk2[GLA ? QN : 1], rv; float peb = 0.f;
        rv = (v4u){0u, 0u, 0u, 0u};
#define REC_LOAD(c) do { \
            _Pragma("unroll") for (int n = 0; n < QN; ++n) { const int pi = tid + NTHR * n, r = pi / QCH, ch = pi % QCH; const size_t ro = (size_t)seq_row(b, dir, 64 * (c) + r) * ldq + ch * 8; \
                rq[n] = *(const v4u*)(qb + ro); rk[n] = *(const v4u*)(kb + ro); if (GLA) rk2[n] = *(const v4u*)(k2b + ro); } \
            if (tid < 64 * VCH) { const int r = tid / VCH, ch = tid % VCH; rv = *(const v4u*)(vb + (size_t)seq_row(b, dir, 64 * (c) + r) * ldv + ch * 8); } \
            if (GLA && tid < DK) peb = EB[(((size_t)dir * NB + b) * 68 + (c)) * (4 * DK) + h * DK + tid]; } while (0)
        REC_LOAD(0);
        for (int c = 0; c < 68; ++c) {
#pragma unroll
            for (int n = 0; n < QN; ++n) { const int pi = tid + NTHR * n, r = pi / QCH, ch = pi % QCH;
                *(LAS v4u*)(F.lds + O_QD + r * SQ + ch * 16) = rq[n]; *(LAS v4u*)(F.lds + O_KI + r * SQ + ch * 16) = rk[n];
                if (GLA) *(LAS v4u*)(F.lds + O_KS + r * SQ + ch * 16) = rk2[n]; }
            if (tid < 64 * VCH) { const int r = tid / VCH, ch = tid % VCH;
                *(LAS v4u*)(F.lds + O_V + r * SV + ch * 16) = rv;
                if (!GLA) *(LAS v4u*)(F.lds + O_VD + r * SV + ch * 16) = scale8(rv, exp2f(lg2 * (float)(63 - r))); }
            if (GLA && tid < DK) ((LAS float*)(F.lds + O_EB))[tid] = peb;
            if (c + 1 < 68) REC_LOAD(c + 1);
            __syncthreads();
#pragma unroll
            for (int q2 = 0; q2 < 2; ++q2) { const int jt = 2 * vg + q2; f32x4 acc = (f32x4){0.f, 0.f, 0.f, 0.f};
                if (jt <= it) {
#pragma unroll
                    for (int ks = 0; ks < KSTEPS; ++ks) acc = MFMA16(frag_n(L + O_KI, SQ, 16 * jt, 32 * ks, lane), frag_n(L + O_QD, SQ, 16 * it, 32 * ks, lane), acc);
                    const int i = 16 * it + l15;
#pragma unroll
                    for (int r = 0; r < 4; ++r) { const int j = 16 * jt + 4 * g4 + r; float vv = (j <= i) ? acc[r] : 0.f; if (!GLA) vv *= exp2f(lg2 * (float)(i - j)); acc[r] = vv; }
                }
                v2u pw; pw.x = pk2(acc[0], acc[1]); pw.y = pk2(acc[2], acc[3]);
                *(LAS v2u*)(F.lds + O_P + (16 * it + l15) * SP + (16 * jt + 4 * g4) * 2) = pw; }
            f32x4 oacc[VT_PER];
#pragma unroll
            for (int a = 0; a < VT_PER; ++a) { oacc[a] = (f32x4){0.f, 0.f, 0.f, 0.f};
#pragma unroll
                for (int ks = 0; ks < KSTEPS; ++ks) oacc[a] = MFMA16(frag_n(L + O_ST, SS, 16 * (vg * VT_PER + a), 32 * ks, lane), frag_n(L + O_QD, SQ, 16 * it, 32 * ks, lane), oacc[a]);
                if (!GLA) oacc[a] *= exp2f(lg2 * (float)(16 * it + l15 + 1)); }
            __syncthreads();
            { const int row = seq_row(b, dir, 64 * c + 16 * it + l15);
#pragma unroll
              for (int a = 0; a < VT_PER; ++a) { const int vt = vg * VT_PER + a;
#pragma unroll
                for (int js = 0; js < 2; ++js) oacc[a] = MFMA16(frag_t(L + O_V, SV, 32 * js, 16 * vt, lane), frag_n(L + O_P, SP, 16 * it, 32 * js, lane), oacc[a]);
                if (row >= orow0) { v2u ow; ow.x = pk2(oacc[a][0], oacc[a][1]); ow.y = pk2(oacc[a][2], oacc[a][3]);
                    *(GAS v2u*)(O + (size_t)dir * odir_stride + (size_t)(row - orow0) * ldo + h * DV + vs * DVS + 16 * vt + 4 * g4) = ow; } } }
            { bfx8 fv[VT_PER][2];
#pragma unroll
              for (int a = 0; a < VT_PER; ++a)
#pragma unroll
                for (int js = 0; js < 2; ++js) fv[a][js] = frag_t(L + (GLA ? O_V : O_VD), SV, 32 * js, 16 * (vg * VT_PER + a), lane);
              const float g64 = GLA ? 1.0f : exp2f(lg2 * 64.0f);
#pragma unroll
              for (int c2 = 0; c2 < KT_PER; ++c2) { const int kt = kg * KT_PER + c2;
                const bfx8 fk0 = frag_t(L + (GLA ? O_KS : O_KI), SQ, 0, 16 * kt, lane), fk1 = frag_t(L + (GLA ? O_KS : O_KI), SQ, 32, 16 * kt, lane);
                f32x4 sc4 = (f32x4){g64, g64, g64, g64};
                if (GLA) sc4 = *(const LAS f32x4*)(L + O_EB + (16 * kt + 4 * g4) * 4);
#pragma unroll
                for (int a = 0; a < VT_PER; ++a) { f32x4 s = Sacc[a][c2] * sc4;
                    s = MFMA16(fk0, fv[a][0], s); s = MFMA16(fk1, fv[a][1], s); Sacc[a][c2] = s;
                    v2u sw; sw.x = pk2(s[0], s[1]); sw.y = pk2(s[2], s[3]);
                    *(LAS v2u*)(F.lds + O_ST + (16 * (vg * VT_PER + a) + l15) * SS + (16 * kt + 4 * g4) * 2) = sw; } } }
            __syncthreads();
        }
#undef REC_LOAD
    }
}
__device__ __forceinline__ float gla_logdecay(const bf16* P, size_t rb, int dir, const float (&wa)[16], float ba) {
    const v4u l0 = *(const v4u*)(P + rb + C0_LOW + dir * 16), l1 = *(const v4u*)(P + rb + C0_LOW + dir * 16 + 8);
    float f0[8], f1[8]; unpack8(l0, f0); unpack8(l1, f1);
    float z = ba;
#pragma unroll
    for (int r = 0; r < 8; ++r) z += f0[r] * wa[r];
#pragma unroll
    for (int r = 0; r < 8; ++r) z += f1[r] * wa[8 + r];
    return (fminf(z, 0.f) - log1pf(expf(-fabsf(z)))) * (1.0f / 16.0f);
}
__device__ __forceinline__ void p_gla_prep(Frame& F, const bf16* P, bf16* QD, bf16* KI, bf16* KS, float* EB) {
    const KA A = ka_fresh();
    const int tid = F.tid, col = tid & 255, half = tid >> 8;
    LAS float* tot = (LAS float*)F.lds;
    for (int item = F.vcu; item < 2 * NB * 68; item += F.G) {
        const int c = item % 68, b = (item / 68) % NB, dir = item / (68 * NB);
        float wa[16];
#pragma unroll
        for (int r = 0; r < 16; ++r) wa[r] = A.I(I_GLAWA)[(dir * 16 + r) * 256 + col];
        const float ba = A.I(I_GLABA)[dir * 256 + col];
        float run = 0.f;
#pragma unroll 4
        for (int t = 0; t < 32; ++t) run += gla_logdecay(P, (size_t)seq_row(b, dir, 64 * c + 32 * half + t) * N0, dir, wa, ba);
        tot[half * 256 + col] = run;
        __syncthreads();
        const float blast = tot[col] + tot[256 + col];
        float bt = half ? tot[col] : 0.f;
        __syncthreads();
#pragma unroll 4
        for (int t = 0; t < 32; ++t) { const int row = seq_row(b, dir, 64 * c + 32 * half + t);
            bt += gla_logdecay(P, (size_t)row * N0, dir, wa, ba);
            const float q = bf2f(P[(size_t)row * N0 + C0_Q + col]), k = bf2f(P[(size_t)row * N0 + C0_K + col]);
            const size_t o = ((size_t)dir * MALL + row) * 256 + col;
            QD[o] = (bf16)f2bf(q * expf(bt)); KI[o] = (bf16)f2bf(k * expf(-bt)); KS[o] = (bf16)f2bf(k * expf(blast - bt)); }
        if (half == 0) EB[(((size_t)dir * NB + b) * 68 + c) * 256 + col] = expf(blast);
    }
}
#ifndef MK_ONLY
#define MK_ONLY -1
#endif
#define SON(s) (MK_ONLY < 0 || MK_ONLY == (s))
#define IN(k) (lo <= (k) && (k) < hi)
#define SEAM(k) do { if (IN(k) && IN((k) + 1)) xcd_barrier(bar); } while (0)
template <int layer>
__device__ __forceinline__ void layer_body(Frame& F, const int lo, const int hi, const XcdBarrier& bar) {
    unsigned char* const ws = ka_fresh().WS();
    bf16* const H = (bf16*)(ws + WS_H);
    bf16* const PROJ = (bf16*)(ws + WS_PROJ);
    float* const XRES = (float*)(ws + WS_XRES);
    float* const MOD = (float*)(ws + WS_MOD);

        const int pb = layer ? PH_INPROJ1 : PH_INPROJ0;
        if (SON(2) && IN(pb)) {
            pg8::Gemm g{H, (const bf16*)(ws + (layer ? WS_WIN1T : WS_WIN0T)), MALL, layer ? N1 : N0, 1024, 1024};
            pg8::StaticOrder S; S.init(g.M, g.N, F.G, (int)blockIdx.x);
            if constexpr (layer == 0 && !MK_NAIVE_S5) { pg8::EpiStoreU E{PROJ, g.N, (bf16*)(ws + WS_A2)};
                pg8::gemm_phase<pg8::EpiStoreU, pg8::StaticOrder, true, true>(F.lds, g, S, E); }
            else { pg8::EpiStore E{PROJ, g.N};
                pg8::gemm_phase<pg8::EpiStore, pg8::StaticOrder, true, true>(F.lds, g, S, E); }
        }
        SEAM(pb);
        if (layer == 0) {
#if MK_NAIVE_GLA
            SEAM(PH_GLAPREP);
            if (SON(3) && IN(PH_GLA)) rec_naive<64, true>(F, PROJ, N0, C0_Q, C0_K, C0_V, 128, 2, (float*)(ws + WS_OREC), (size_t)MALL * 512, 512, 0);
#else
            bf16* const GQD = (bf16*)(ws + WS_OREC + 280 * MiB); bf16* const GKI = GQD + (size_t)2 * MALL * 256; bf16* const GKS = GKI + (size_t)2 * MALL * 256; float* const GEB = (float*)(ws + WS_OREC + 384 * MiB);
            if (SON(13) && IN(PH_GLAPREP)) p_gla_prep(F, PROJ, GQD, GKI, GKS, GEB);
#if !MK_NAIVE_S5
            if (SON(17) && IN(PH_GLAPREP)) {
                __syncthreads();
                pg8::Gemm g{(const bf16*)(ws + WS_A2), (const bf16*)(ws + WS_S5W1), 32 * S5_ROWS, 256, 256, 512};
                pg8::GroupOrder S{9, 288, F.G, F.vcu};
                pg8::EpiF32Plain E{(float*)(ws + WS_SLOC)};
                pg8::gemm_phase<pg8::EpiF32Plain, pg8::GroupOrder, true, true>(F.lds, g, S, E);
            }
#endif
            SEAM(PH_GLAPREP);
#if !MK_NAIVE_S5
            if (SON(18) && IN(PH_GLA)) { p_s5_scan(F, (const float*)(ws + WS_SLOC), (bf16*)(ws + WS_A2)); __syncthreads(); }
#endif
            if (SON(3) && IN(PH_GLA)) rec_mfma<64, 32, true>(F, GQD, GKI, GKS, (size_t)MALL * 256, 256, 0, 0, PROJ, N0, C0_V, 128, GEB, (bf16*)(ws + WS_OREC), (size_t)MALL * 512, 512, 0);
#endif
            SEAM(PH_GLA);
#if MK_NAIVE_S5
            if (SON(4) && IN(PH_S5)) s5_naive(F, PROJ, (float*)(ws + WS_OREC) + (size_t)2 * MALL * 512);
#else
            if (SON(4) && IN(PH_S5)) {
                pg8::Gemm g{(const bf16*)(ws + WS_A2), (const bf16*)(ws + WS_S5W2), 32 * S5_ROWS, 256, 512, 512};
                pg8::GroupOrder S{9, 288, F.G, F.vcu};
                pg8::EpiS5Out E{(const bf16*)(ws + WS_A2), (bf16*)(ws + WS_YPRE), ka_fresh().I(I_S5D)};
                pg8::gemm_phase<pg8::EpiS5Out, pg8::GroupOrder, true, true>(F.lds, g, S, E);
            }
#endif
            SEAM(PH_S5);
            if (SON(5) && IN(PH_FIN0)) p_finish0(F);
            SEAM(PH_FIN0);
            if (SON(6) && IN(PH_GLU)) {
                pg8::Gemm g{(const bf16*)(ws + WS_YPRE), (const bf16*)(ws + WS_WGLUT), MALL, 512, 512, 512};
                pg8::StaticOrder S; S.init(g.M, g.N, F.G, (int)blockIdx.x);
                pg8::EpiGlu E{(const bf16*)(ws + WS_YPRE), (bf16*)(ws + WS_MIX), 1024, 512, ka_fresh().I(I_GLUB)};
                pg8::gemm_phase<pg8::EpiGlu, pg8::StaticOrder, true, true>(F.lds, g, S, E);
            }
            SEAM(PH_GLU);
        } else {
            if (SON(14) && IN(PH_ROPE)) p_rope(F);
            SEAM(PH_ROPE);
#if MK_NAIVE_RET
            if (SON(15) && IN(PH_RET)) rec_naive<256, false>(F, PROJ, N1, C1_Q, C1_K, C1_V, 512, 8, (float*)(ws + WS_OREC), (size_t)NLAT * 2048, 2048, NCTX);
#else
            if (SON(15) && IN(PH_RET)) rec_mfma<256, 64, false>(F, PROJ, PROJ, PROJ, 0, N1, C1_Q, C1_K, PROJ, N1, C1_V, 512, nullptr, (bf16*)(ws + WS_OREC), (size_t)NLAT * 2048, 2048, NCTX);
#endif
            SEAM(PH_RET);
            if (SON(16) && IN(PH_FIN1)) p_finish1(F);
            SEAM(PH_FIN1);
        }
        const int po = layer ? PH_OUT1 : PH_OUT0;
        if (SON(7) && IN(po)) {
            pg8::Gemm g{(const bf16*)(ws + WS_MIX), (const bf16*)(ws + (layer ? WS_WOUT1T : WS_WOUT0T)), layer ? NLAT : MALL, 1024, layer ? 2048 : 1024, layer ? 2048 : 1024};
            pg8::StaticOrder S; S.init(g.M, g.N, F.G, (int)blockIdx.x);
            pg8::EpiResid E{ka_fresh().I(I_CTX), layer ? (const float*)(XRES + (size_t)NCTX * 1024) : ka_fresh().I(I_X), XRES, MOD + (size_t)layer * 9 * 6144 + 2048, layer ? 8 : 0};
            pg8::gemm_phase<pg8::EpiResid, pg8::StaticOrder, true, true>(F.lds, g, S, E);
        }
        SEAM(po);
        if (SON(8) && IN(po + 1)) p_router(F, layer);
        SEAM(po + 1);
        if (SON(9) && IN(po + 2)) p_gather(F, layer);
        SEAM(po + 2);
        if (SON(10) && IN(po + 3)) {
            const int nt = moe_tables(F, layer);
            pg8::Gemm g{(const bf16*)(ws + WS_XG), (const bf16*)(ws + WS_WGUT) + (size_t)layer * 32 * 2048 * 1024, nt * 256, 2048, 1024, 1024};
            pg8::MoeOrder S{(const PG8_LAS unsigned char*)(F.lds + L_TILEE), nt, 8, F.G, F.vcu};
            pg8::EpiSwiglu E{(bf16*)(ws + WS_ACT), ka_fresh().I(I_BGU) + (size_t)layer * 32 * 2048};
            pg8::gemm_phase<pg8::EpiSwiglu, pg8::MoeOrder, true, true>(F.lds, g, S, E);
        }
        SEAM(po + 3);
        if (SON(11) && IN(po + 4)) {
            const int nt = moe_tables(F, layer);
            pg8::Gemm g{(const bf16*)(ws + WS_ACT), (const bf16*)(ws + WS_WDNT) + (size_t)layer * 32 * 1024 * 1024, nt * 256, 1024, 1024, 1024};
            pg8::MoeOrder S{(const PG8_LAS unsigned char*)(F.lds + L_TILEE), nt, 4, F.G, F.vcu};
            pg8::EpiDown E{(bf16*)(ws + WS_YSLOT), (const int*)(ws + WS_PROW), (const float*)(ws + WS_WSLOT), ka_fresh().I(I_BDN) + (size_t)layer * 32 * 1024};
            pg8::gemm_phase<pg8::EpiDown, pg8::MoeOrder, true, true>(F.lds, g, S, E);
        }
        SEAM(po + 4);
        if (SON(12) && IN(po + 5)) p_combine(F, layer);
        SEAM(po + 5);
    }
__global__ void __launch_bounds__(NTHR, 2) mk_fwd(Args) {
    extern __shared__ __attribute__((aligned(16))) unsigned char lds[];
    Frame F;
    F.lds = (LAS unsigned char*)lds;
    F.MISC = (volatile LAS unsigned*)(F.lds + L_MISC);
    F.tid = threadIdx.x; F.lane = F.tid & 63; F.wave = __builtin_amdgcn_readfirstlane(F.tid >> 6);
    F.G = gridDim.x; { const int bx = blockIdx.x; F.vcu = (F.G % 8 == 0) ? (bx % 8) * (F.G / 8) + bx / 8 : bx; }
    const KA A0 = ka_fresh();
    unsigned char* ws = A0.WS();
    F.ctl = (unsigned*)(ws + WS_CTL);
    if (F.tid < 64) F.MISC[F.tid] = 0u;
    __syncthreads();
    const int lo = A0.LO(), hi = A0.HI();
    XcdBarrier bar; bar.bar = F.ctl + CW_BAR; bar.x = 0; bar.st = nullptr;
    if (hi - lo > 1) bar = xcd_barrier_post(F.ctl + CW_BAR, F.MISC + 8);

    if (SON(0) && IN(0)) { p0_prologue(F); } SEAM(0);
    if (SON(1) && IN(1)) { p_norm1_l0(F); } SEAM(1);
    layer_body<0>(F, lo, hi, bar);
    layer_body<1>(F, lo, hi, bar);
}

#ifndef MK_MULTI
#define MK_MULTI 0
#endif
extern "C" void kernel_launch(void* const* d_in, const int* in_sizes, int n_in, void* d_out, int out_size, void* d_ws, size_t ws_size, hipStream_t stream) {
    static int grid = 0;
    if (grid == 0) {
        if (n_in != 34 || out_size != NLAT * D || ws_size < WS_END) { fprintf(stderr, "kernel_launch: unexpected sizes: n_in %d out %d ws %zu (need %zu)\n", n_in, out_size, ws_size, (size_t)WS_END); grid = -1; return; }
        int dev = 0, cus = 0;
        if (hipGetDevice(&dev) != hipSuccess || hipDeviceGetAttribute(&cus, hipDeviceAttributeMultiprocessorCount, dev) != hipSuccess) { grid = -1; return; }
        if (hipFuncSetAttribute((const void*)mk_fwd, hipFuncAttributeMaxDynamicSharedMemorySize, LDS_BYTES) != hipSuccess) { fprintf(stderr, "kernel_launch: hipFuncSetAttribute failed\n"); grid = -1; return; }
        int per_cu = 0;
        if (hipOccupancyMaxActiveBlocksPerMultiprocessor(&per_cu, (const void*)mk_fwd, NTHR, LDS_BYTES) != hipSuccess || per_cu < 1) fprintf(stderr, "kernel_launch: occupancy query says %d\n", per_cu);
        (void)hipGetLastError();
        grid = cus;
    }
    if (grid < 0) return;
    (void)in_sizes;
    (void)hipMemsetAsync((char*)d_ws + WS_CTL, 0, CTL_ZERO_BYTES, stream);
    Args a{};
    for (int i = 0; i < 34; ++i) a.in[i] = (const float*)d_in[i];
    a.out = (float*)d_out; a.ws = (unsigned char*)d_ws;
#if MK_MULTI
    for (int p = 0; p < NPH; ++p) { a.ph_lo = p; a.ph_hi = p + 1; hipLaunchKernelGGL(mk_fwd, dim3(grid), dim3(NTHR), LDS_BYTES, stream, a); }
#else
    a.ph_lo = 0; a.ph_hi = NPH; hipLaunchKernelGGL(mk_fwd, dim3(grid), dim3(NTHR), LDS_BYTES, stream, a);
#endif
}
```

```cpp
#include <hip/hip_runtime.h>
#include <cstdio>
#include <cstdint>
#include <cmath>
namespace pg8 {
#define PG8_LAS __attribute__((address_space(3)))
typedef unsigned short bf16_t;
typedef short bf16x8 __attribute__((ext_vector_type(8)));
typedef float f32x4 __attribute__((ext_vector_type(4)));
typedef unsigned u32x4 __attribute__((ext_vector_type(4)));
constexpr int BM = 256, BK = 64, HALF = 128, HTB = HALF * BK * 2  , STAGE_BYTES = 8 * HTB, NXCD = 8, WGM = 8;

__host__ __device__ __forceinline__ int lds_byte(int r, int c) { const int st = (r >> 4) * 2 + (c >> 5), rr = r & 15, cc = c & 31, ob = rr * 64 + cc * 2; return st * 1024 + (ob ^ (((ob >> 9) & 1) << 5)); }
__host__ __device__ __forceinline__ void stage_rc(int b, int& R, int& C) { const int st = b / 1024, sb = b % 1024, swz = sb ^ (((sb >> 9) & 1) << 5); R = (st >> 1) * 16 + swz / 64; C = (st & 1) * 32 + (swz % 64) / 2; }
__host__ __device__ __forceinline__ int perm32(int rho) { const int n = rho >> 4, i = rho & 15; return 8 * (i >> 2) + 4 * n + (i & 3); }

struct Unit { int pm, pn, pb, e; };
struct Gemm { const bf16_t* A; const bf16_t* Bt; int M, N, K, lda; };

struct StaticOrder {
    int nM, nN, nwg, G, c;
    __host__ __device__ void init(int M, int N, int G_, int c_) { nM = M / BM; nN = N / BM; nwg = nM * nN; G = G_; c = c_; }
    __host__ __device__ bool next(int i, Unit& u) const {
        const long L = (long)i * G + c; if (L >= nwg) return false;
        int wgid = (int)L; { const int q = nwg / NXCD, r = nwg % NXCD, xcd = wgid % NXCD, off = wgid / NXCD; wgid = (xcd < r ? xcd * (q + 1) : r * (q + 1) + (xcd - r) * q) + off; }
        const int nig = WGM * nN, gid = wgid / nig, fm = gid * WGM, gsz = (nM - fm) < WGM ? (nM - fm) : WGM;
        u.pm = fm + ((wgid % nig) % gsz); u.pn = (wgid % nig) / gsz; u.pb = u.pn; u.e = 0; return true;
    }
    __device__ __forceinline__ void a_ready(const Unit&) const {}
    __device__ __forceinline__ void done(const Unit&) const {}
};
__device__ __forceinline__ unsigned cvt_pk_bf16(float lo, float hi) { unsigned r; asm volatile("v_cvt_pk_bf16_f32 %0, %1, %2" : "=v"(r) : "v"(lo), "v"(hi)); return r; }
__device__ __forceinline__ float bflo(unsigned w) { return __uint_as_float(w << 16); }
__device__ __forceinline__ float bfhi(unsigned w) { return __uint_as_float(w & 0xffff0000u); }
__device__ __forceinline__ float sigmoidf_(float z) { return 1.0f / (1.0f + __expf(-z)); }

struct EpiStore {
    static constexpr bool PERM = true, AFTER_DRAIN = false;
    bf16_t* O; int ldc;
    __device__ __forceinline__ void operator()(const f32x4 (&acc)[2][2][4][2], const Unit& u, int wr, int wc, int fr, int fq) const {
        const int row0 = u.pm * BM + wr * 64 + fr, col0 = u.pn * BM + wc * 32 + 8 * fq;
#pragma unroll
        for (int ai = 0; ai < 2; ++ai)
#pragma unroll
            for (int m = 0; m < 4; ++m) { bf16_t* rowp = O + (size_t)(row0 + ai * HALF + m * 16) * ldc + col0;
#pragma unroll
                for (int bj = 0; bj < 2; ++bj) { const f32x4 v0 = acc[ai][bj][m][0], v1 = acc[ai][bj][m][1];
                    u32x4 w; w.x = cvt_pk_bf16(v0[0], v0[1]); w.y = cvt_pk_bf16(v0[2], v0[3]); w.z = cvt_pk_bf16(v1[0], v1[1]); w.w = cvt_pk_bf16(v1[2], v1[3]);
                    *(u32x4*)(rowp + bj * HALF) = w; } }
    }
};
struct EpiGlu {
    static constexpr bool PERM = true, AFTER_DRAIN = false;
    const bf16_t* Y; bf16_t* O; int ldo, ocol0; const float* bias;
    __device__ __forceinline__ void operator()(const f32x4 (&acc)[2][2][4][2], const Unit& u, int wr, int wc, int fr, int fq) const {
        const int row0 = u.pm * BM + wr * 64 + fr, col0 = u.pn * BM + wc * 32 + 8 * fq;
        f32x4 bv[2][2];
#pragma unroll
        for (int bj = 0; bj < 2; ++bj)
#pragma unroll
            for (int n = 0; n < 2; ++n) bv[bj][n] = *(const f32x4*)(bias + col0 + bj * HALF + 4 * n);
#pragma unroll
        for (int ai = 0; ai < 2; ++ai)
#pragma unroll
            for (int m = 0; m < 4; ++m) { const size_t row = (size_t)(row0 + ai * HALF + m * 16);
#pragma unroll
                for (int bj = 0; bj < 2; ++bj) { const int c = col0 + bj * HALF;
                    const u32x4 yv = *(const u32x4*)(Y + row * 512 + c);
                    const f32x4 z0 = acc[ai][bj][m][0] + bv[bj][0], z1 = acc[ai][bj][m][1] + bv[bj][1];
                    u32x4 w;
                    w.x = cvt_pk_bf16(bflo(yv.x) * sigmoidf_(z0[0]), bfhi(yv.x) * sigmoidf_(z0[1]));
                    w.y = cvt_pk_bf16(bflo(yv.y) * sigmoidf_(z0[2]), bfhi(yv.y) * sigmoidf_(z0[3]));
                    w.z = cvt_pk_bf16(bflo(yv.z) * sigmoidf_(z1[0]), bfhi(yv.z) * sigmoidf_(z1[1]));
                    w.w = cvt_pk_bf16(bflo(yv.w) * sigmoidf_(z1[2]), bfhi(yv.w) * sigmoidf_(z1[3]));
                    *(u32x4*)(O + row * ldo + ocol0 + c) = w; } }
    }
};
struct EpiResid {
    static constexpr bool PERM = false, AFTER_DRAIN = false;
    const float* base_ctx; const float* base_lat; float* out; const float* gate; int tile0;
    __device__ __forceinline__ void operator()(const f32x4 (&acc)[2][2][4][2], const Unit& u, int wr, int wc, int fr, int fq) const {
        const int gt = u.pm + tile0, bidx = gt < 8 ? 8 : ((gt - 8) >> 4);
        const float* bt = gt < 8 ? base_ctx + (size_t)gt * 256 * 1024 : base_lat + (size_t)(gt - 8) * 256 * 1024;
        float* ot = out + (size_t)gt * 256 * 1024;
        const int col0 = u.pn * BM + wc * 32 + 4 * fq;
        f32x4 gv[2][2];
#pragma unroll
        for (int bj = 0; bj < 2; ++bj)
#pragma unroll
            for (int n = 0; n < 2; ++n) gv[bj][n] = *(const f32x4*)(gate + bidx * 6144 + col0 + bj * HALF + n * 16);
#pragma unroll
        for (int ai = 0; ai < 2; ++ai)
#pragma unroll
            for (int m = 0; m < 4; ++m) { const size_t off = (size_t)(wr * 64 + fr + ai * HALF + m * 16) * 1024 + col0;
#pragma unroll
                for (int bj = 0; bj < 2; ++bj)
#pragma unroll
                    for (int n = 0; n < 2; ++n) { const f32x4 bs = *(const f32x4*)(bt + off + bj * HALF + n * 16);
                        *(f32x4*)(ot + off + bj * HALF + n * 16) = bs + gv[bj][n] * acc[ai][bj][m][n]; } }
    }
};
struct EpiSwiglu {
    static constexpr bool PERM = true, AFTER_DRAIN = false;
    bf16_t* ACT; const float* bgu;
    __device__ __forceinline__ void operator()(const f32x4 (&acc)[2][2][4][2], const Unit& u, int wr, int wc, int fr, int fq) const {
        const int row0 = u.pm * BM + wr * 64 + fr, lc0 = u.pn * 128 + wc * 32 + 8 * fq;
        const float* bb = bgu + (size_t)u.e * 2048 + lc0;
        f32x4 bg[2], bl[2];
#pragma unroll
        for (int n = 0; n < 2; ++n) { bg[n] = *(const f32x4*)(bb + 4 * n); bl[n] = *(const f32x4*)(bb + 1024 + 4 * n); }
#pragma unroll
        for (int ai = 0; ai < 2; ++ai)
#pragma unroll
            for (int m = 0; m < 4; ++m) { float a[8];
#pragma unroll
                for (int n = 0; n < 2; ++n)
#pragma unroll
                    for (int j = 0; j < 4; ++j) { const float g = fminf(acc[ai][0][m][n][j] + bg[n][j], 7.0f); float l = acc[ai][1][m][n][j] + bl[n][j]; l = fminf(fmaxf(l, -7.0f), 7.0f);
                        a[4 * n + j] = g * sigmoidf_(1.702f * g) * (l + 1.0f); }
                u32x4 w; w.x = cvt_pk_bf16(a[0], a[1]); w.y = cvt_pk_bf16(a[2], a[3]); w.z = cvt_pk_bf16(a[4], a[5]); w.w = cvt_pk_bf16(a[6], a[7]);
                *(u32x4*)(ACT + (size_t)(row0 + ai * HALF + m * 16) * 1024 + lc0) = w; }
    }
};
struct EpiDown {
    static constexpr bool PERM = true, AFTER_DRAIN = false;
    bf16_t* Y; const int* prow_slot; const float* w_slot; const float* bdn;
    __device__ __forceinline__ void operator()(const f32x4 (&acc)[2][2][4][2], const Unit& u, int wr, int wc, int fr, int fq) const {
        const int row0 = u.pm * BM + wr * 64 + fr, col0 = u.pn * BM + wc * 32 + 8 * fq;
        f32x4 bv[2][2];
#pragma unroll
        for (int bj = 0; bj < 2; ++bj)
#pragma unroll
            for (int n = 0; n < 2; ++n) bv[bj][n] = *(const f32x4*)(bdn + (size_t)u.e * 1024 + col0 + bj * HALF + 4 * n);
#pragma unroll
        for (int ai = 0; ai < 2; ++ai)
#pragma unroll
            for (int m = 0; m < 4; ++m) { const int slot = prow_slot[row0 + ai * HALF + m * 16];
                if (slot >= 0) { const float ws = w_slot[slot]; bf16_t* rowp = Y + (size_t)slot * 1024 + col0;
#pragma unroll
                    for (int bj = 0; bj < 2; ++bj) { const f32x4 v0 = (acc[ai][bj][m][0] + bv[bj][0]) * ws, v1 = (acc[ai][bj][m][1] + bv[bj][1]) * ws;
                        u32x4 w; w.x = cvt_pk_bf16(v0[0], v0[1]); w.y = cvt_pk_bf16(v0[2], v0[3]); w.z = cvt_pk_bf16(v1[0], v1[1]); w.w = cvt_pk_bf16(v1[2], v1[3]);
                        *(u32x4*)(rowp + bj * HALF) = w; } } }
    }
};
struct MoeOrder {
    const PG8_LAS unsigned char* tile_e; int ntiles, NT, G, c; const int* prow_slot; int row0;
    __device__ __forceinline__ int rowidx(const Unit& u, int r) const { const int s = prow_slot[u.pm * BM + r]; return row0 + (s >= 0 ? (s >> 2) : 0); }
    __device__ __forceinline__ bool next(int i, Unit& u) const {
        const int L = i * G + c; if (L >= ntiles * NT) return false;
        const int T = L / NT; u.pm = T; u.pn = L - T * NT; u.e = __builtin_amdgcn_readfirstlane((int)tile_e[T]); u.pb = u.e * NT + u.pn; return true;
    }
    __device__ __forceinline__ void a_ready(const Unit&) const {}
    __device__ __forceinline__ void done(const Unit&) const {}
};

struct EpiStoreU {
    static constexpr bool PERM = true, AFTER_DRAIN = false;
    bf16_t* O; int ldc; bf16_t* A2;
    __device__ __forceinline__ void operator()(const f32x4 (&acc)[2][2][4][2], const Unit& u, int wr, int wc, int fr, int fq) const {
        const int row0 = u.pm * BM + wr * 64 + fr, col0 = u.pn * BM + wc * 32 + 8 * fq;
#pragma unroll
        for (int ai = 0; ai < 2; ++ai)
#pragma unroll
            for (int m = 0; m < 4; ++m) { const int R = row0 + ai * HALF + m * 16; bf16_t* rowp = O + (size_t)R * ldc + col0;
                int r, t; if (R < 2048) { r = (R >> 8) * 272 + ((R & 255) >> 4); t = R & 15; } else { const int R2 = R - 2048; r = (R2 >> 12) * 272 + 16 + ((R2 & 4095) >> 4); t = R2 & 15; }
#pragma unroll
                for (int bj = 0; bj < 2; ++bj) { const f32x4 v0 = acc[ai][bj][m][0], v1 = acc[ai][bj][m][1];
                    u32x4 w; w.x = cvt_pk_bf16(v0[0], v0[1]); w.y = cvt_pk_bf16(v0[2], v0[3]); w.z = cvt_pk_bf16(v1[0], v1[1]); w.w = cvt_pk_bf16(v1[2], v1[3]);
                    *(u32x4*)(rowp + bj * HALF) = w;
                    if (u.pn >= 6) { const int g = (u.pn - 6) * 16 + bj * 8 + wc * 2 + (fq >> 1);
                        *(u32x4*)(A2 + ((size_t)g * 2304 + r) * 512 + t * 16 + (fq & 1) * 8) = w; } } }
    }
};
struct EpiF32Plain {
    static constexpr bool PERM = true, AFTER_DRAIN = false;
    float* C;
    __device__ __forceinline__ void operator()(const f32x4 (&acc)[2][2][4][2], const Unit& u, int wr, int wc, int fr, int fq) const {
        float* base = C + (size_t)(u.pm * BM + wr * 64 + fr) * 256 + wc * 32 + 8 * fq;
#pragma unroll
        for (int ai = 0; ai < 2; ++ai)
#pragma unroll
            for (int m = 0; m < 4; ++m) {
#pragma unroll
                for (int bj = 0; bj < 2; ++bj) { float* p = base + (ai * HALF + m * 16) * 256 + bj * HALF;
                    *(f32x4*)p = acc[ai][bj][m][0]; *(f32x4*)(p + 4) = acc[ai][bj][m][1]; } }
    }
};
struct EpiS5Out {
    static constexpr bool PERM = true, AFTER_DRAIN = false;
    const bf16_t* A2; bf16_t* YP; const float* dskip;
    __device__ __forceinline__ void operator()(const f32x4 (&acc)[2][2][4][2], const Unit& u, int wr, int wc, int fr, int fq) const {
        const int g = u.e;
#pragma unroll
        for (int ai = 0; ai < 2; ++ai)
#pragma unroll
            for (int m = 0; m < 4; ++m) { const int rr = (u.pm - g * 9) * BM + wr * 64 + fr + ai * HALF + m * 16;
                if (rr < 2176) { const int b = rr / 272, n = rr - b * 272;
                    const int tok0 = n < 16 ? b * 256 + n * 16 : 2048 + b * 4096 + (n - 16) * 16;
#pragma unroll
                    for (int bj = 0; bj < 2; ++bj) { const int col = bj * HALF + wc * 32 + 8 * fq, t = col >> 4, c0 = col & 15;
                        const u32x4 uv = *(const u32x4*)(A2 + ((size_t)g * 2304 + rr) * 512 + col);
                        const f32x4 d0 = *(const f32x4*)(dskip + g * 16 + c0), d1 = *(const f32x4*)(dskip + g * 16 + c0 + 4);
                        float y[8];
                        y[0] = acc[ai][bj][m][0][0] + d0[0] * bflo(uv.x); y[1] = acc[ai][bj][m][0][1] + d0[1] * bfhi(uv.x); y[2] = acc[ai][bj][m][0][2] + d0[2] * bflo(uv.y); y[3] = acc[ai][bj][m][0][3] + d0[3] * bfhi(uv.y);
                        y[4] = acc[ai][bj][m][1][0] + d1[0] * bflo(uv.z); y[5] = acc[ai][bj][m][1][1] + d1[1] * bfhi(uv.z); y[6] = acc[ai][bj][m][1][2] + d1[2] * bflo(uv.w); y[7] = acc[ai][bj][m][1][3] + d1[3] * bfhi(uv.w);
#pragma unroll
                        for (int j = 0; j < 8; ++j) { const float z = y[j], th = 0.7978845608f * (z + 0.044715f * z * z * z); const float e2 = __expf(2.0f * th); y[j] = 0.5f * z * (1.0f + (1.0f - 2.0f / (e2 + 1.0f))); }
                        u32x4 w; w.x = cvt_pk_bf16(y[0], y[1]); w.y = cvt_pk_bf16(y[2], y[3]); w.z = cvt_pk_bf16(y[4], y[5]); w.w = cvt_pk_bf16(y[6], y[7]);
                        *(u32x4*)(YP + (size_t)(tok0 + t) * 512 + g * 16 + c0) = w; } } }
    }
};
struct GroupOrder {
    int tpg, nunits, G, c;
    __device__ __forceinline__ bool next(int i, Unit& u) const { const int L = i * G + c; if (L >= nunits) return false; u.pm = L; u.pn = 0; u.e = L / tpg; u.pb = u.e; return true; }
    __device__ __forceinline__ void a_ready(const Unit&) const {}
    __device__ __forceinline__ void done(const Unit&) const {}
};
template <class Epi, class Sched, bool ALIGN_EPI = false, bool SP2 = false, bool GATHER = false>
__device__ __forceinline__ void gemm_phase(PG8_LAS unsigned char* lds, const Gemm g, const Sched& S, const Epi& E) {
    static_assert(!GATHER || SP2, "gathered A staging is implemented in the SP2 loop only");
    const int tid = threadIdx.x, wid = __builtin_amdgcn_readfirstlane(tid >> 6), lane = tid & 63, wr = wid >> 2, wc = wid & 3, fr = lane & 15, fq = lane >> 4;
    int K_ = g.K; asm volatile("" : "+s"(K_));
    const int K = K_, nt = K / BK;
    unsigned voffA[2], voffB[2];
#pragma unroll
    for (int i = 0; i < 2; ++i) { int R, C; stage_rc(tid * 16 + i * 8192, R, C); const int Rb = Epi::PERM ? ((R & ~31) + perm32(R & 31)) : R;
        voffA[i] = (unsigned)(R * g.lda + C) * 2u; voffB[i] = (unsigned)(Rb * K + C) * 2u; }
    const size_t kstep = (size_t)(BK * 2);
    const size_t hstep = (size_t)HALF * K * 2;
    const size_t tstep = 2 * hstep;
    const size_t hstepA = (size_t)HALF * g.lda * 2, tstepA = 2 * hstepA;
    const unsigned ldsw = (unsigned)wid * 1024u;
    const int aoff = lds_byte(wr * 64 + fr, fq * 8), boff = lds_byte(wc * 32 + fr, fq * 8);
#define PG8_SA(b, h) (((b) * 2 + (h)) * HTB)
#define PG8_SB(b, h) ((4 + (b) * 2 + (h)) * HTB)
#define PG8_STAGE(bufoff, gbase, voff) do { _Pragma("unroll") for (int _i = 0; _i < 2; ++_i) \
        __builtin_amdgcn_global_load_lds((const unsigned*)((const char*)(gbase) + (voff)[_i]), (PG8_LAS unsigned*)(lds + (bufoff) + ldsw + _i * 8192), 16, 0, 0); } while (0)
#define PG8_STAGE_H0(bufoff, gbase) do { if constexpr (GATHER) PG8_STAGE(bufoff, gbase, voffA0); else PG8_STAGE(bufoff, gbase, voffA); } while (0)
#define PG8_STAGE_H1(bufoff, gbase) do { if constexpr (GATHER) PG8_STAGE(bufoff, gbase, voffA1); else PG8_STAGE(bufoff, (gbase) + hstepA, voffA); } while (0)
#define PG8_GOFF(unit, h, dst) do { _Pragma("unroll") for (int _i = 0; _i < 2; ++_i) { int _R, _C; stage_rc(tid * 16 + _i * 8192, _R, _C); dst[_i] = (unsigned)S.rowidx(unit, (h) * HALF + _R); } } while (0)
#define PG8_GCONV(dst, src) do { _Pragma("unroll") for (int _i = 0; _i < 2; ++_i) { int _R, _C; stage_rc(tid * 16 + _i * 8192, _R, _C); dst[_i] = (src[_i] * (unsigned)g.lda + (unsigned)_C) * 2u; } } while (0)
#define PG8_LDA(dst, b, h) do { _Pragma("unroll") for (int m = 0; m < 4; ++m) _Pragma("unroll") for (int k = 0; k < 2; ++k) dst[m][k] = *(const PG8_LAS bf16x8*)(lds + PG8_SA(b, h) + aoff + m * 2048 + k * 1024); } while (0)
#define PG8_LDB(dst, b, h) do { _Pragma("unroll") for (int n = 0; n < 2; ++n) _Pragma("unroll") for (int k = 0; k < 2; ++k) dst[n][k] = *(const PG8_LAS bf16x8*)(lds + PG8_SB(b, h) + boff + n * 2048 + k * 1024); } while (0)
#define PG8_MMA(ai, bj, At, Bt) do { __builtin_amdgcn_s_setprio(1); _Pragma("unroll") for (int m = 0; m < 4; ++m) _Pragma("unroll") for (int n = 0; n < 2; ++n) _Pragma("unroll") for (int k = 0; k < 2; ++k) \
        acc[ai][bj][m][n] = __builtin_amdgcn_mfma_f32_16x16x32_bf16(Bt[n][k], At[m][k], acc[ai][bj][m][n], 0, 0, 0); __builtin_amdgcn_s_setprio(0); } while (0)
#define PG8_WAIT_V(n) asm volatile("s_waitcnt vmcnt(" #n ")" ::: "memory")
#define PG8_WAIT_L(n) asm volatile("s_waitcnt lgkmcnt(" #n ")" ::: "memory")
#define PG8_BAR __builtin_amdgcn_s_barrier()
#define PG8_SCHED __builtin_amdgcn_sched_barrier(0)
    Unit cur, nxt; int ui = 0;
    if (!S.next(0, cur)) return;
    f32x4 acc[2][2][4][2];
#pragma unroll
    for (int a = 0; a < 2; ++a)
#pragma unroll
        for (int b = 0; b < 2; ++b)
#pragma unroll
            for (int m = 0; m < 4; ++m)
#pragma unroll
                for (int n = 0; n < 2; ++n) acc[a][b][m][n] = (f32x4){0.f, 0.f, 0.f, 0.f};
    bf16x8 At[4][2], B0[2][2], B1[2][2];
    const char* cA = (const char*)g.A + (GATHER ? (size_t)0 : (size_t)cur.pm * tstepA);
    unsigned voffA0[2] = {0u, 0u}, voffA1[2] = {0u, 0u}, nidx0[2] = {0u, 0u}, nidx1[2] = {0u, 0u};
    if constexpr (GATHER) { PG8_GOFF(cur, 0, nidx0); PG8_GOFF(cur, 1, nidx1); PG8_GCONV(voffA0, nidx0); PG8_GCONV(voffA1, nidx1); } const char* cB = (const char*)g.Bt + (size_t)cur.pb * tstep;
    S.a_ready(cur);
    if constexpr (SP2) {
        PG8_STAGE(PG8_SB(0, 0), cB, voffB); PG8_STAGE(PG8_SB(0, 1), cB + hstep, voffB); PG8_STAGE_H0(PG8_SA(0, 0), cA); PG8_STAGE_H1(PG8_SA(0, 1), cA);
        if (wr == 1) PG8_BAR;
        PG8_WAIT_V(2); PG8_BAR;
        PG8_STAGE(PG8_SB(1, 0), cB + kstep, voffB); PG8_STAGE_H0(PG8_SA(1, 0), cA + kstep); PG8_STAGE(PG8_SB(1, 1), cB + hstep + kstep, voffB);
        PG8_WAIT_V(6); PG8_BAR;
    } else {
        PG8_STAGE(PG8_SB(0, 0), cB, voffB); PG8_STAGE_H0(PG8_SA(0, 0), cA); PG8_STAGE(PG8_SB(0, 1), cB + hstep, voffB); PG8_STAGE_H1(PG8_SA(0, 1), cA);
        if (wr == 1) PG8_BAR;
        PG8_WAIT_V(4); PG8_BAR;
        PG8_STAGE(PG8_SB(1, 0), cB + kstep, voffB); PG8_STAGE_H0(PG8_SA(1, 0), cA + kstep); PG8_STAGE(PG8_SB(1, 1), cB + hstep + kstep, voffB);
        PG8_WAIT_V(6); PG8_BAR;
    }
    for (;;) {
        const bool has_next = S.next(ui + 1, nxt);
        const char* nA = (has_next && !GATHER) ? (const char*)g.A + (size_t)nxt.pm * tstepA : cA; const char* nB = has_next ? (const char*)g.Bt + (size_t)nxt.pb * tstep : cB;
        for (int t = 0; t < nt; t += 2) {
            const bool last = (t == nt - 2);
            const char* a1 = cA + (size_t)(t + 1) * kstep;
            const char* a2 = last ? nA : cA + (size_t)(t + 2) * kstep; const char* b2 = last ? nB : cB + (size_t)(t + 2) * kstep;
            const char* a3 = a2 + kstep; const char* b3 = b2 + kstep;
            if (last && has_next) S.a_ready(nxt);
            if constexpr (GATHER) { if (has_next && t == nt - 4) { PG8_GOFF(nxt, 0, nidx0); PG8_GOFF(nxt, 1, nidx1); }
                                    if (has_next && last) PG8_GCONV(voffA0, nidx0); }
            if constexpr (SP2) {
            PG8_LDB(B0, 0, 0); PG8_LDB(B1, 0, 1); PG8_SCHED; PG8_LDA(At, 0, 0); PG8_STAGE_H1(PG8_SA(1, 1), a1);
            if constexpr (GATHER) { if (has_next && last) PG8_GCONV(voffA1, nidx1); }
            PG8_WAIT_V(8); PG8_WAIT_L(0); PG8_BAR; PG8_MMA(0, 0, At, B0); PG8_MMA(0, 1, At, B1); PG8_BAR; PG8_SCHED;
            PG8_LDA(At, 0, 1); PG8_STAGE(PG8_SB(0, 0), b2, voffB); PG8_STAGE(PG8_SB(0, 1), b2 + hstep, voffB); PG8_STAGE_H0(PG8_SA(0, 0), a2);
            PG8_WAIT_V(8); PG8_WAIT_L(0); PG8_BAR; PG8_MMA(1, 0, At, B0); PG8_MMA(1, 1, At, B1); PG8_BAR; PG8_SCHED;
            PG8_LDB(B0, 1, 0); PG8_LDB(B1, 1, 1); PG8_SCHED; PG8_LDA(At, 1, 0); PG8_STAGE_H1(PG8_SA(0, 1), a2);
            PG8_WAIT_V(8); PG8_WAIT_L(0); PG8_BAR; PG8_MMA(0, 0, At, B0); PG8_MMA(0, 1, At, B1); PG8_BAR; PG8_SCHED;
            PG8_LDA(At, 1, 1); PG8_STAGE(PG8_SB(1, 0), b3, voffB); PG8_STAGE(PG8_SB(1, 1), b3 + hstep, voffB); PG8_STAGE_H0(PG8_SA(1, 0), a3);
            PG8_WAIT_V(8); PG8_WAIT_L(0); PG8_BAR; PG8_MMA(1, 0, At, B0); PG8_MMA(1, 1, At, B1); PG8_BAR; PG8_SCHED;
            } else {
            PG8_LDB(B0, 0, 0); PG8_SCHED; PG8_LDA(At, 0, 0); PG8_STAGE(PG8_SA(1, 1), a1 + hstepA, voffA);
            PG8_WAIT_L(8); PG8_BAR; PG8_WAIT_L(0); PG8_MMA(0, 0, At, B0); PG8_BAR; PG8_SCHED;
            PG8_LDB(B1, 0, 1); PG8_STAGE(PG8_SB(0, 0), b2, voffB);
            PG8_BAR; PG8_WAIT_L(0); PG8_MMA(0, 1, At, B1); PG8_BAR;
            PG8_LDA(At, 0, 1); PG8_STAGE(PG8_SA(0, 0), a2, voffA);
            PG8_BAR; PG8_WAIT_L(0); PG8_MMA(1, 0, At, B0); PG8_BAR; PG8_SCHED;
            PG8_STAGE(PG8_SB(0, 1), b2 + hstep, voffB);
            PG8_WAIT_V(6); PG8_BAR; PG8_MMA(1, 1, At, B1); PG8_BAR;
            PG8_LDB(B0, 1, 0); PG8_SCHED; PG8_LDA(At, 1, 0); PG8_STAGE(PG8_SA(0, 1), a2 + hstepA, voffA);
            PG8_WAIT_L(8); PG8_BAR; PG8_WAIT_L(0); PG8_MMA(0, 0, At, B0); PG8_BAR; PG8_SCHED;
            PG8_LDB(B1, 1, 1); PG8_STAGE(PG8_SB(1, 0), b3, voffB);
            PG8_BAR; PG8_WAIT_L(0); PG8_MMA(0, 1, At, B1); PG8_BAR;
            PG8_LDA(At, 1, 1); PG8_STAGE(PG8_SA(1, 0), a3, voffA);
            PG8_BAR; PG8_WAIT_L(0); PG8_MMA(1, 0, At, B0); PG8_BAR; PG8_SCHED;
            PG8_STAGE(PG8_SB(1, 1), b3 + hstep, voffB);
            PG8_WAIT_V(6); PG8_BAR; PG8_MMA(1, 1, At, B1); PG8_BAR;
            }
        }
        if constexpr (ALIGN_EPI) { if (wr == 0) PG8_BAR; }
        if constexpr (!Epi::AFTER_DRAIN) { E(acc, cur, wr, wc, fr, fq); S.done(cur); }
        if (!has_next) break;
#pragma unroll
        for (int a = 0; a < 2; ++a)
#pragma unroll
            for (int b = 0; b < 2; ++b)
#pragma unroll
                for (int m = 0; m < 4; ++m)
#pragma unroll
                    for (int n = 0; n < 2; ++n) acc[a][b][m][n] = (f32x4){0.f, 0.f, 0.f, 0.f};
        cur = nxt; cA = nA; cB = nB; ++ui;
        if constexpr (ALIGN_EPI) { if (wr == 1) PG8_BAR; }
    }
    PG8_WAIT_V(0);
    if constexpr (!ALIGN_EPI) { if (wr == 0) PG8_BAR; }
    PG8_BAR;
    if constexpr (Epi::AFTER_DRAIN) { E.fused(acc, cur, wr, wc, fr, fq, lds, wid, lane); S.done(cur); }
#undef PG8_SA
#undef PG8_SB
#undef PG8_STAGE
#undef PG8_STAGE_H0
#undef PG8_STAGE_H1
#undef PG8_GOFF
#undef PG8_GCONV
#undef PG8_LDA
#undef PG8_LDB
#undef PG8_MMA
#undef PG8_WAIT_V
#undef PG8_WAIT_L
#undef PG8_BAR
#undef PG8_SCHED
}
}
constexpr int NWAVES = 8, NTHR = 512;
constexpr int D = 1024, NB = 8, SEQ = 4096, CTX = 256;
constexpr int NCTX = NB * CTX, NLAT = NB * SEQ, MALL = NCTX + NLAT;
constexpr int N0 = 2304, N1 = 6144;
constexpr int C0_Q = 0, C0_K = 256, C0_V = 512, C0_G = 1024, C0_U = 1536, C0_LOW = 2048;
constexpr int C1_Q = 0, C1_K = 1024, C1_V = 2048, C1_G = 4096;
constexpr int NE = 32, MAXTILES = 576;
constexpr float EPS = 1e-6f;
constexpr int NPH = 24;
enum { PH_PRO = 0, PH_NORM1, PH_INPROJ0, PH_GLAPREP, PH_GLA, PH_S5, PH_FIN0, PH_GLU, PH_OUT0, PH_ROUTER0, PH_GATHER0, PH_GU0, PH_DOWN0, PH_COMB0,
       PH_INPROJ1, PH_ROPE, PH_RET, PH_FIN1, PH_OUT1, PH_ROUTER1, PH_GATHER1, PH_GU1, PH_DOWN1, PH_COMB1 };
#ifndef MK_NAIVE_GLA
#define MK_NAIVE_GLA 0
#endif
#ifndef MK_NAIVE_S5
#define MK_NAIVE_S5 0
#endif
#ifndef MK_NAIVE_RET
#define MK_NAIVE_RET 0
#endif
constexpr size_t MiB = 1u << 20;
constexpr size_t WS_CTL = 0, CTL_ZERO_BYTES = 1 * MiB;
constexpr size_t WS_MOD = 1 * MiB;
constexpr size_t WS_WIN0T = 2 * MiB, WS_WOUT0T = 7 * MiB, WS_WGLUT = 9 * MiB, WS_WIN1T = 10 * MiB, WS_WOUT1T = 22 * MiB;
constexpr size_t WS_SELE = 26 * MiB, WS_WSLOT = 27 * MiB, WS_SPOS = 28 * MiB, WS_PROW = 29 * MiB;
constexpr size_t WS_WGUT = 32 * MiB, WS_WDNT = 288 * MiB;
constexpr size_t WS_XRES = 416 * MiB, WS_H = 552 * MiB, WS_MIX = 620 * MiB, WS_YPRE = 688 * MiB;
constexpr size_t WS_PROJ = 748 * MiB, WS_OREC = 1156 * MiB;
constexpr size_t WS_XG = 748 * MiB, WS_ACT = 1036 * MiB, WS_YSLOT = 1324 * MiB;
constexpr size_t WS_S5W1 = 1556 * MiB, WS_S5W2 = 1560 * MiB, WS_A2 = 1568 * MiB, WS_SLOC = 1668 * MiB;
constexpr size_t WS_END = 1740 * MiB;
constexpr int CW_TMO = 0, CW_BAR = 4096, CW_GCNT = 16384;
constexpr int RING_BYTES = 131072, LDSCTL_OFF = RING_BYTES, LDS_BYTES = 147456;
constexpr int L_MISC = LDSCTL_OFF;
constexpr int L_TILEE = LDSCTL_OFF + 256;
constexpr int L_TSTART = LDSCTL_OFF + 1024;
constexpr int L_LCNT = LDSCTL_OFF + 1280;
constexpr int L_GBASE = LDSCTL_OFF + 1536;
constexpr int L_BLKE = LDSCTL_OFF + 2048;
constexpr int L_BLKP = LDSCTL_OFF + 5120;

#define GAS __attribute__((address_space(1)))
#define LAS __attribute__((address_space(3)))
typedef unsigned short bf16;
typedef unsigned v4u __attribute__((ext_vector_type(4)));
typedef unsigned v2u __attribute__((ext_vector_type(2)));
typedef float f32x4 __attribute__((ext_vector_type(4)));
typedef GAS unsigned gu32;
#define RLX_AGENT __ATOMIC_RELAXED, __HIP_MEMORY_SCOPE_AGENT
#define LDS_WAIT() asm volatile("s_waitcnt lgkmcnt(0)" ::: "memory")
#define VM_WAIT() asm volatile("s_waitcnt vmcnt(0)" ::: "memory")
__device__ __forceinline__ unsigned f2bf(float f) { unsigned u = __builtin_bit_cast(unsigned, f); return (u + 0x7fffu + ((u >> 16) & 1u)) >> 16; }
__device__ __forceinline__ unsigned pk2(float lo, float hi) { return f2bf(lo) | (f2bf(hi) << 16); }
__device__ __forceinline__ float bf2f(unsigned b) { return __uint_as_float(b << 16); }
__device__ __forceinline__ float blo(unsigned w) { return __uint_as_float(w << 16); }
__device__ __forceinline__ float bhi(unsigned w) { return __uint_as_float(w & 0xffff0000u); }
__device__ __forceinline__ float wave_sum(float v) {
#pragma unroll
    for (int o = 1; o < 64; o <<= 1) v += __shfl_xor(v, o);
    return v;
}
__device__ __forceinline__ float silu_(float z) { return z / (1.0f + __expf(-z)); }
#define XB_TMO      128
#define XB_XCNT(j)  (256  + 64 * (j))
#define XB_XSUB(j)  (1280 + 64 * (j))
#define XB_XGEN(j)  (2304 + 64 * (j))
#define XB_TOP      3328
#define XB_TOPGEN   3392
#define XCD_BAR_WORDS 3456
#define XB_SPIN_CAP (1u << 22)

__device__ __forceinline__ unsigned xb_ld(unsigned* p)              { return __hip_atomic_load(p, __ATOMIC_RELAXED, __HIP_MEMORY_SCOPE_AGENT); }
__device__ __forceinline__ unsigned xb_add(unsigned* p, unsigned v) { return __hip_atomic_fetch_add(p, v, __ATOMIC_RELAXED, __HIP_MEMORY_SCOPE_AGENT); }
__device__ __forceinline__ unsigned xb_xcc_id() { return (unsigned)__builtin_amdgcn_s_getreg((3 << 11) | 20) & 0xFu; }
#define XB_SPIN(cond, bar) do { unsigned _sp = 0; while (cond) { __builtin_amdgcn_s_sleep(1); \
    if ((++_sp & 255u) == 0u) { if (xb_ld(&(bar)[XB_TMO])) break; if (_sp > XB_SPIN_CAP) { atomicAdd(&(bar)[XB_TMO], 1u); break; } } } } while (0)

struct XcdBarrier {
    unsigned* bar; unsigned x;
    volatile LAS unsigned* st;
};

__device__ __forceinline__ XcdBarrier xcd_barrier_post(unsigned* bar, volatile LAS unsigned* st) {
    XcdBarrier b; b.bar = bar; b.x = xb_xcc_id(); b.st = st;
    if (threadIdx.x == 0) (void)xb_add(&bar[XB_XCNT(b.x)], 1u);
    return b;
}
__device__ __forceinline__ void xcd_barrier_complete(unsigned* bar, unsigned x, unsigned& nloc, unsigned& nx) {
    const unsigned G = gridDim.x * gridDim.y * gridDim.z;
    unsigned sum, cnt, mine, sp = 0u;
    for (;;) {
        sum = 0u; cnt = 0u; mine = 0u;
#pragma unroll
        for (unsigned j = 0; j < 16; ++j) { const unsigned c = xb_ld(&bar[XB_XCNT(j)]); sum += c; cnt += (c > 0u) ? 1u : 0u; mine = (j == x) ? c : mine; }
        if (sum == G) break;
        __builtin_amdgcn_s_sleep(1);
        if ((++sp & 255u) == 0u) { if (xb_ld(&bar[XB_TMO])) break; if (sp > XB_SPIN_CAP) { atomicAdd(&bar[XB_TMO], 1u); break; } }
    }
    nloc = mine > 0u ? mine : 1u; nx = cnt > 0u ? cnt : 1u;
}

__device__ __forceinline__ void xcd_barrier(const XcdBarrier& b) {
    asm volatile("s_waitcnt vmcnt(0)" ::: "memory");
    __syncthreads();
    if (threadIdx.x == 0) {
        unsigned* bar = b.bar;
        __builtin_amdgcn_s_waitcnt(0);
        unsigned nloc = b.st[0], nx = b.st[1];
        if (nloc == 0u) { xcd_barrier_complete(bar, b.x, nloc, nx); b.st[0] = nloc; b.st[1] = nx; }
        const unsigned old = xb_add(&bar[XB_XSUB(b.x)], 1u);
        const unsigned gen = old / nloc;
        if (old + 1u == (gen + 1u) * nloc) {
            __builtin_amdgcn_fence(__ATOMIC_RELEASE, "agent");
            asm volatile("s_waitcnt vmcnt(0)" ::: "memory");
            const unsigned og = xb_add(&bar[XB_TOP], 1u);
            const unsigned tg = og / nx;
            if (og + 1u == (tg + 1u) * nx) xb_add(&bar[XB_TOPGEN], 1u);
            else XB_SPIN(xb_ld(&bar[XB_TOPGEN]) == tg, bar);
            __builtin_amdgcn_fence(__ATOMIC_ACQUIRE, "agent");
            xb_add(&bar[XB_XGEN(b.x)], 1u);
            asm volatile("s_waitcnt vmcnt(0)" ::: "memory");
        } else {
            XB_SPIN(xb_ld(&bar[XB_XGEN(b.x)]) == gen, bar);
            __builtin_amdgcn_fence(__ATOMIC_ACQUIRE, "agent");
            asm volatile("s_waitcnt vmcnt(0)" ::: "memory");
        }
    }
    __syncthreads();
}
struct Args { const float* in[34]; float* out; unsigned char* ws; int ph_lo, ph_hi; };
#define CAS __attribute__((address_space(4)))
struct KA {
    const CAS unsigned char* p;
    __device__ __forceinline__ const float* I(int i) const { return *(const float* const CAS*)(p + 8 * i); }
    __device__ __forceinline__ float* OUT() const { return *(float* const CAS*)(p + 8 * 34); }
    __device__ __forceinline__ unsigned char* WS() const { return *(unsigned char* const CAS*)(p + 8 * 35); }
    __device__ __forceinline__ int LO() const { return *(const CAS int*)(p + 8 * 36); }
    __device__ __forceinline__ int HI() const { return *(const CAS int*)(p + 8 * 36 + 4); }
};
__device__ __forceinline__ KA ka_fresh() { KA a; a.p = (const CAS unsigned char*)__builtin_amdgcn_kernarg_segment_ptr(); asm volatile("" : "+s"(a.p)); return a; }
static_assert(sizeof(Args) == 8 * 36 + 8, "kernarg layout");
struct Frame {
    LAS unsigned char* lds;
    volatile LAS unsigned* MISC;
    unsigned* ctl;
    int tid, lane, wave, vcu, G;
};
enum { I_X = 0, I_C, I_CTX, I_CCTX, I_ADAW, I_ADAB, I_N1G, I_N2G, I_ABWIN, I_ABWOUT, I_GLAWA, I_GLABA, I_GLANG, I_LAMRE, I_LAMIM, I_LOGSTEP, I_BRE, I_BIM, I_CRE, I_CIM,
       I_S5D, I_GLUW, I_GLUB, I_RETWIN, I_RETWOUT, I_RETDEC, I_RETNG, I_WROUTER, I_BROUTER, I_WGU, I_BGU, I_WDN, I_BDN, I_FNG };

constexpr int S5_ROWS = 2304, S5_CH = 272;
struct S5Par { float lr, li, step; };
__device__ __forceinline__ void s5_cpow(float lr, float li, float step, float n, float& ar, float& ai) { const float mag = expf(lr * step * n); float s, c; sincosf(li * step * n, &s, &c); ar = mag * c; ai = mag * s; }
__device__ __forceinline__ void s5_zoh_f(float lr, float li, float step, float& fr, float& fi) { float ar, ai; s5_cpow(lr, li, step, 1.0f, ar, ai); const float den = lr * lr + li * li;
    fr = ((ar - 1.0f) * lr + ai * li) / den; fi = (ai * lr - (ar - 1.0f) * li) / den; }
__device__ __forceinline__ void s5_table_item(const KA& A, int kind, int idx, bf16* W1T, bf16* W2T, LAS float* scr, int lane) {
    if (kind == 0) {
        const int g = idx >> 8, n = idx & 255, dir = n >> 7, ri = (n >> 6) & 1, p = n & 63;
        const float lr = A.I(I_LAMRE)[(dir * 32 + g) * 64 + p], li = A.I(I_LAMIM)[(dir * 32 + g) * 64 + p], step = expf(A.I(I_LOGSTEP)[dir * 32 + g]);
        float fr, fi; s5_zoh_f(lr, li, step, fr, fi);
        const int t = lane >> 2, c0 = (lane & 3) * 4;
        float ar, ai; s5_cpow(lr, li, step, (float)(dir ? t : 15 - t), ar, ai);
        const float gr = ar * fr - ai * fi, gi = ar * fi + ai * fr;
        float o[4];
#pragma unroll
        for (int j = 0; j < 4; ++j) { const float br = A.I(I_BRE)[(g * 64 + p) * 16 + c0 + j], bi = A.I(I_BIM)[(g * 64 + p) * 16 + c0 + j]; o[j] = ri ? (gr * bi + gi * br) : (gr * br - gi * bi); }
        v2u w; w.x = pk2(o[0], o[1]); w.y = pk2(o[2], o[3]);
        *(GAS v2u*)(W1T + ((size_t)g * 256 + n) * 256 + 4 * lane) = w;
    } else if (kind == 1) {
        const int g = idx >> 8, n = idx & 255, t = n >> 4, cp = n & 15;
        const int dir = lane >> 5, ri = (lane >> 4) & 1, p0 = (lane & 15) * 4;
        const float step = expf(A.I(I_LOGSTEP)[dir * 32 + g]);
        float o[4];
#pragma unroll
        for (int j = 0; j < 4; ++j) { const int p = p0 + j;
            const float lr = A.I(I_LAMRE)[(dir * 32 + g) * 64 + p], li = A.I(I_LAMIM)[(dir * 32 + g) * 64 + p];
            float ar, ai; s5_cpow(lr, li, step, (float)(dir ? 16 - t : t + 1), ar, ai);
            const float cr = A.I(I_CRE)[((dir * 32 + g) * 16 + cp) * 64 + p], ci = A.I(I_CIM)[((dir * 32 + g) * 16 + cp) * 64 + p];
            o[j] = ri ? -(cr * ai + ci * ar) : (cr * ar - ci * ai); }
        v2u w; w.x = pk2(o[0], o[1]); w.y = pk2(o[2], o[3]);
        *(GAS v2u*)(W2T + ((size_t)g * 256 + n) * 512 + 256 + 4 * lane) = w;
    } else {
        const int g = idx >> 4, tau = idx & 15;
        {
#pragma unroll
            for (int dir = 0; dir < 2; ++dir) { const float lr = A.I(I_LAMRE)[(dir * 32 + g) * 64 + lane], li = A.I(I_LAMIM)[(dir * 32 + g) * 64 + lane], step = expf(A.I(I_LOGSTEP)[dir * 32 + g]);
                float fr, fi, ar, ai; s5_zoh_f(lr, li, step, fr, fi); s5_cpow(lr, li, step, (float)tau, ar, ai);
                scr[(dir * 64 + lane) * 2] = ar * fr - ai * fi; scr[(dir * 64 + lane) * 2 + 1] = ar * fi + ai * fr; }
        }
        LDS_WAIT(); asm volatile("" ::: "memory");
        const int cp = lane >> 2, c0 = (lane & 3) * 4;
        float kf[4] = {0.f, 0.f, 0.f, 0.f}, kb2[4] = {0.f, 0.f, 0.f, 0.f};
        for (int p = 0; p < 64; ++p) {
            const f32x4 b4r = *(const f32x4*)(A.I(I_BRE) + (g * 64 + p) * 16 + c0), b4i = *(const f32x4*)(A.I(I_BIM) + (g * 64 + p) * 16 + c0);
#pragma unroll
            for (int dir = 0; dir < 2; ++dir) { const float gr = scr[(dir * 64 + p) * 2], gi = scr[(dir * 64 + p) * 2 + 1];
                const float cr = A.I(I_CRE)[((dir * 32 + g) * 16 + cp) * 64 + p], ci = A.I(I_CIM)[((dir * 32 + g) * 16 + cp) * 64 + p];
#pragma unroll
                for (int j = 0; j < 4; ++j) { const float xr = gr * b4r[j] - gi * b4i[j], xi = gr * b4i[j] + gi * b4r[j]; const float v = cr * xr - ci * xi;
                    if (dir == 0) kf[j] += v; else kb2[j] += v; } }
        }
        LDS_WAIT(); asm volatile("" ::: "memory");
        bf16* Wg = W2T + (size_t)g * 256 * 512;
        if (tau == 0) { v2u w; w.x = pk2(kf[0] + kb2[0], kf[1] + kb2[1]); w.y = pk2(kf[2] + kb2[2], kf[3] + kb2[3]);
            for (int t = 0; t < 16; ++t) *(GAS v2u*)(Wg + (size_t)(t * 16 + cp) * 512 + t * 16 + c0) = w;
        } else { v2u wf, wb; wf.x = pk2(kf[0], kf[1]); wf.y = pk2(kf[2], kf[3]); wb.x = pk2(kb2[0], kb2[1]); wb.y = pk2(kb2[2], kb2[3]);
            for (int t = tau; t < 16; ++t) *(GAS v2u*)(Wg + (size_t)(t * 16 + cp) * 512 + (t - tau) * 16 + c0) = wf;
            for (int t = 0; t + tau < 16; ++t) *(GAS v2u*)(Wg + (size_t)(t * 16 + cp) * 512 + (t + tau) * 16 + c0) = wb; }
    }
}
__device__ __forceinline__ void p_s5_scan(Frame& F, const float* SLOC, bf16* A2) {
    const KA A = ka_fresh();
    if (F.tid >= 128) return;
    for (int idx = F.vcu * 128 + F.tid; idx < NB * 32 * 2 * 64; idx += F.G * 128) {
        const int p = idx & 63, dir = (idx >> 6) & 1, g = (idx >> 7) & 31, b = idx >> 12;
        const float lr = A.I(I_LAMRE)[(dir * 32 + g) * 64 + p], li = A.I(I_LAMIM)[(dir * 32 + g) * 64 + p], step = expf(A.I(I_LOGSTEP)[dir * 32 + g]);
        float ar, ai; s5_cpow(lr, li, step, 16.0f, ar, ai);
        float sr = 0.f, si = 0.f;
        const size_t rbase = (size_t)g * S5_ROWS + (size_t)b * S5_CH;
        for (int q0 = 0; q0 < S5_CH; q0 += 8) {
            float lre[8], lim[8];
#pragma unroll
            for (int u = 0; u < 8; ++u) { const int q = q0 + u, n = dir ? (q < 16 ? 15 - q : 271 - (q - 16)) : q; const float* sp = SLOC + (rbase + n) * 256 + dir * 128 + p; lre[u] = sp[0]; lim[u] = sp[64]; }
#pragma unroll
            for (int u = 0; u < 8; ++u) { const int q = q0 + u, n = dir ? (q < 16 ? 15 - q : 271 - (q - 16)) : q; bf16* ap = A2 + (rbase + n) * 512 + 256 + dir * 128 + p;
                ap[0] = (bf16)f2bf(sr); ap[64] = (bf16)f2bf(si);
                const float nr = ar * sr - ai * si + lre[u], ni = ar * si + ai * sr + lim[u]; sr = nr; si = ni; }
        }
    }
}
__device__ __forceinline__ void tr_item(const float* src, int ldsrc, int K, int srccol, float scale, bf16* dst, int dstrow0, int k0, LAS float* scr, int lane) {
    if (srccol >= 0) {
        float t[32]; const float* sp = src + (size_t)(k0 + (lane >> 5)) * ldsrc + srccol + (lane & 31);
#pragma unroll
        for (int i = 0; i < 32; ++i) t[i] = sp[(size_t)(2 * i) * ldsrc];
#pragma unroll
        for (int i = 0; i < 32; ++i) scr[(2 * i + (lane >> 5)) * 33 + (lane & 31)] = t[i] * scale;
    } else {
#pragma unroll 8
        for (int i = 0; i < 32; ++i) { const int kk = 2 * i + (lane >> 5); scr[kk * 33 + (lane & 31)] = 0.f; }
    }
    LDS_WAIT(); asm volatile("" ::: "memory");
    const int c = lane & 7;
#pragma unroll
    for (int j = 0; j < 4; ++j) { const int n = (lane >> 3) + 8 * j; const LAS float* s = scr + (8 * c) * 33 + n;
        v4u o; o.x = pk2(s[0 * 33], s[1 * 33]); o.y = pk2(s[2 * 33], s[3 * 33]); o.z = pk2(s[4 * 33], s[5 * 33]); o.w = pk2(s[6 * 33], s[7 * 33]);
        *(GAS v4u*)(dst + (size_t)(dstrow0 + n) * K + k0 + 8 * c) = o; }
    LDS_WAIT(); asm volatile("" ::: "memory");
}
__device__ __forceinline__ void p0_prologue(Frame& F) {
    const KA A = ka_fresh();
    unsigned char* ws = A.WS();
    LAS float* scr = (LAS float*)(F.lds + F.wave * 8704);
    LAS float* sl = (LAS float*)(F.lds + 69632);
    for (int idx = F.tid; idx < 9 * 1024; idx += NTHR) { const int b = idx >> 10, k = idx & 1023; const float cv = b < 8 ? A.I(I_C)[b * 1024 + k] : A.I(I_CCTX)[k]; sl[k * 12 + b] = silu_(cv); }
    __syncthreads();
    const int gw = F.vcu * NWAVES + F.wave, NGW = F.G * NWAVES, lane = F.lane;
    for (int m = F.vcu; m < 192; m += F.G) {
        const int layer = m / 96, col = (m % 96) * 64 + lane;
        const float* w = A.I(I_ADAW) + (size_t)layer * 1024 * 6144 + (size_t)(F.wave * 128) * 6144 + col;
        float acc[9];
#pragma unroll
        for (int b = 0; b < 9; ++b) acc[b] = 0.f;
        for (int k0 = 0; k0 < 128; k0 += 16) {
            float wv[16];
#pragma unroll
            for (int u = 0; u < 16; ++u) wv[u] = w[(size_t)(k0 + u) * 6144];
#pragma unroll
            for (int u = 0; u < 16; ++u) {
#pragma unroll
                for (int b = 0; b < 9; ++b) acc[b] += sl[(F.wave * 128 + k0 + u) * 12 + b] * wv[u]; }
        }
        LAS float* red = (LAS float*)(F.lds);
#pragma unroll
        for (int b = 0; b < 9; ++b) red[(F.wave * 9 + b) * 64 + lane] = acc[b];
        __syncthreads();
        for (int idx = F.tid; idx < 9 * 64; idx += NTHR) { const int b = idx >> 6, l = idx & 63; float s = 0.f;
#pragma unroll
            for (int wv2 = 0; wv2 < 8; ++wv2) s += red[(wv2 * 9 + b) * 64 + l];
            const int c2 = (m % 96) * 64 + l;
            ((float*)(ws + WS_MOD))[(size_t)layer * 9 * 6144 + b * 6144 + c2] = s + A.I(I_ADAB)[layer * 6144 + c2]; }
        __syncthreads();
    }
    constexpr int I_S5A = 8192, I_S5B = 8192, I_S5C = 512, I_IN0 = 1152, I_OUT0 = 512, I_GLU = 128, I_IN1 = 3072, I_OUT1 = 1024, I_GU = 65536, I_DN = 32768;
    constexpr int NITEMS = I_S5A + I_S5B + I_S5C + I_IN0 + I_OUT0 + I_GLU + I_IN1 + I_OUT1 + I_GU + I_DN;
    for (int it = gw; it < NITEMS; it += NGW) {
        int r = it;
        if (r < I_S5A) { s5_table_item(A, 0, r, (bf16*)(ws + WS_S5W1), (bf16*)(ws + WS_S5W2), scr, lane); continue; }
        r -= I_S5A;
        if (r < I_S5B) { s5_table_item(A, 1, r, (bf16*)(ws + WS_S5W1), (bf16*)(ws + WS_S5W2), scr, lane); continue; }
        r -= I_S5B;
        if (r < I_S5C) { s5_table_item(A, 2, r, (bf16*)(ws + WS_S5W1), (bf16*)(ws + WS_S5W2), scr, lane); continue; }
        r -= I_S5C;
        if (r < I_IN0) { const int kb = r / 72, n0 = (r % 72) * 32;
            const int sc = n0 < 1536 ? n0 : (n0 < 2048 ? n0 + 32 : (n0 == 2048 ? 1536 : -1));
            tr_item(A.I(I_ABWIN), 2080, 1024, sc, n0 < 256 ? 0.125f : 1.0f, (bf16*)(ws + WS_WIN0T), n0, kb * 64, scr, lane); continue; }
        r -= I_IN0;
        if (r < I_OUT0) { tr_item(A.I(I_ABWOUT), 1024, 1024, (r % 32) * 32, 1.0f, (bf16*)(ws + WS_WOUT0T), (r % 32) * 32, (r / 32) * 64, scr, lane); continue; }
        r -= I_OUT0;
        if (r < I_GLU) { tr_item(A.I(I_GLUW), 512, 512, (r % 16) * 32, 1.0f, (bf16*)(ws + WS_WGLUT), (r % 16) * 32, (r / 16) * 64, scr, lane); continue; }
        r -= I_GLU;
        if (r < I_IN1) { const int n0 = (r % 192) * 32;
            tr_item(A.I(I_RETWIN), 6144, 1024, n0, (n0 >= 1024 && n0 < 2048) ? 0.0625f : 1.0f, (bf16*)(ws + WS_WIN1T), n0, (r / 192) * 64, scr, lane); continue; }
        r -= I_IN1;
        if (r < I_OUT1) { tr_item(A.I(I_RETWOUT), 1024, 2048, (r % 32) * 32, 1.0f, (bf16*)(ws + WS_WOUT1T), (r % 32) * 32, (r / 32) * 64, scr, lane); continue; }
        r -= I_OUT1;
        if (r < I_GU) { const int mat = r >> 10, q = r & 1023, kb = q >> 6, n0 = (q & 63) * 32;
            const int pn = n0 >> 8, bj = (n0 >> 7) & 1, lc = n0 & 127;
            tr_item(A.I(I_WGU) + (size_t)mat * 1024 * 2048, 2048, 1024, bj * 1024 + pn * 128 + lc, 1.0f, (bf16*)(ws + WS_WGUT) + (size_t)mat * 2048 * 1024, n0, kb * 64, scr, lane); continue; }
        r -= I_GU;
        { const int mat = r >> 9, q = r & 511, kb = q >> 5, n0 = (q & 31) * 32;
          tr_item(A.I(I_WDN) + (size_t)mat * 1024 * 1024, 1024, 1024, n0, 1.0f, (bf16*)(ws + WS_WDNT) + (size_t)mat * 1024 * 1024, n0, kb * 64, scr, lane); }
    }
}
__device__ __forceinline__ void modnorm_store(const f32x4 (&v)[4], const float* g, const float* sc, const float* sh, bf16* hrow, int lane, f32x4 (&h)[4]) {
    float ss = 0.f;
#pragma unroll
    for (int j = 0; j < 4; ++j) ss += (v[j].x * v[j].x + v[j].y * v[j].y) + (v[j].z * v[j].z + v[j].w * v[j].w);
    const float r = rsqrtf(wave_sum(ss) * (1.0f / 1024.0f) + EPS);
#pragma unroll
    for (int j = 0; j < 4; ++j) { const int o = 64 * j + lane;
        const f32x4 gg = ((const f32x4*)g)[o], s4 = ((const f32x4*)sc)[o], h4 = ((const f32x4*)sh)[o];
        h[j] = v[j] * r * gg * (s4 + 1.0f) + h4;
        v2u w; w.x = pk2(h[j].x, h[j].y); w.y = pk2(h[j].z, h[j].w);
        ((GAS v2u*)hrow)[o] = w; }
}
__device__ __forceinline__ int bidx_of_row(int row) { return row < NCTX ? 8 : ((row - NCTX) >> 12); }
__device__ __forceinline__ void p_norm1_l0(Frame& F) {
    const KA A = ka_fresh();
    const int gw = F.vcu * NWAVES + F.wave, NGW = F.G * NWAVES, lane = F.lane;
    const float* mod = (const float*)(A.WS() + WS_MOD);
    bf16* H = (bf16*)(A.WS() + WS_H);
    for (int row = gw; row < MALL; row += NGW) {
        const float* xr = row < NCTX ? A.I(I_CTX) + (size_t)row * 1024 : A.I(I_X) + (size_t)(row - NCTX) * 1024;
        f32x4 v[4], h[4];
#pragma unroll
        for (int j = 0; j < 4; ++j) v[j] = ((const f32x4*)xr)[64 * j + lane];
        const float* m = mod + bidx_of_row(row) * 6144;
        modnorm_store(v, A.I(I_N1G), m + 1024, m, H + (size_t)row * 1024, lane, h);
    }
}
__device__ __forceinline__ int seq_row(int b, int dir, int s) {
    return s < CTX ? b * CTX + (dir ? CTX - 1 - s : s) : NCTX + b * SEQ + (dir ? SEQ - 1 - (s - CTX) : (s - CTX));
}
template <int DK, bool GLA>
__device__ __forceinline__ void rec_naive(Frame& F, const bf16* P, int ldp, int qc, int kc, int vc, int DV, int nvs,
                                          float* O, size_t odir_stride, int ldo, int orow0) {
    const KA A = ka_fresh();
    constexpr int KPW = DK / 8, TB = 16;
    LAS float* qs = (LAS float*)(F.lds);
    LAS float* ks = (LAS float*)(F.lds + 16384);
    LAS float* vv = (LAS float*)(F.lds + 32768);
    LAS float* dec = (LAS float*)(F.lds + 36864);
    LAS float* opart = (LAS float*)(F.lds + 40960);
    const int tid = F.tid, lane = F.lane, wave = F.wave;
    const int nitems = NB * 4 * 2 * nvs;
    for (int it = F.vcu; it < nitems; it += F.G) {
        const int vs = it % nvs, dir = (it / nvs) & 1, h = (it / (2 * nvs)) & 3, b = it / (8 * nvs);
        float gamma = 0.f;
        if (!GLA) { const float lg = A.I(I_RETDEC)[dir * 4 + h]; gamma = 1.0f / (1.0f + expf(-lg)); }
        float S[KPW];
#pragma unroll
        for (int i = 0; i < KPW; ++i) S[i] = 0.f;
        for (int s0 = 0; s0 < CTX + SEQ; s0 += TB) {
            for (int idx = tid; idx < TB * DK; idx += NTHR) { const int i = idx / DK, kk = idx % DK; const size_t rb = (size_t)seq_row(b, dir, s0 + i) * ldp;
                qs[idx] = bf2f(P[rb + qc + h * DK + kk]); ks[idx] = bf2f(P[rb + kc + h * DK + kk]); }
            for (int idx = tid; idx < TB * 64; idx += NTHR) { const int i = idx >> 6, c = idx & 63; const size_t rb = (size_t)seq_row(b, dir, s0 + i) * ldp;
                vv[idx] = bf2f(P[rb + vc + h * DV + vs * 64 + c]);
                if (GLA) { float z = A.I(I_GLABA)[dir * 256 + h * 64 + c];
#pragma unroll
                    for (int r = 0; r < 16; ++r) z += bf2f(P[rb + C0_LOW + dir * 16 + r]) * A.I(I_GLAWA)[(dir * 16 + r) * 256 + h * 64 + c];
                    const float ls = fminf(z, 0.f) - log1pf(expf(-fabsf(z)));
                    dec[idx] = expf(ls * (1.0f / 16.0f)); } }
            __syncthreads();
#pragma unroll 1
            for (int i = 0; i < TB; ++i) { const float vval = vv[i * 64 + lane]; float part = 0.f;
#pragma unroll
                for (int kk = 0; kk < KPW; ++kk) { const int kidx = wave * KPW + kk; const float d = GLA ? dec[i * 64 + kidx] : gamma;
                    S[kk] = d * S[kk] + ks[i * DK + kidx] * vval; part += qs[i * DK + kidx] * S[kk]; }
                opart[(i * 8 + wave) * 64 + lane] = part; }
            __syncthreads();
            for (int idx = tid; idx < TB * 64; idx += NTHR) { const int i = idx >> 6, c = idx & 63; float sum = 0.f;
#pragma unroll
                for (int w = 0; w < 8; ++w) sum += opart[(i * 8 + w) * 64 + c];
                const int row = seq_row(b, dir, s0 + i);
                if (row >= orow0) O[(size_t)dir * odir_stride + (size_t)(row - orow0) * ldo + h * DV + vs * 64 + c] = sum; }
        }
        __syncthreads();
    }
}
__device__ __forceinline__ void s5_naive(Frame& F, const bf16* P, float* Y  ) {
    const KA A = ka_fresh();
    const int lane = F.lane;
    if (F.wave >= 2) return;
    for (int chain = F.vcu * 2 + F.wave; chain < NB * 32 * 2; chain += F.G * 2) {
        const int dir = chain & 1, g = (chain >> 1) & 31, b = chain >> 6;
        const float step = expf(A.I(I_LOGSTEP)[dir * 32 + g]);
        const float lr = A.I(I_LAMRE)[(dir * 32 + g) * 64 + lane], li = A.I(I_LAMIM)[(dir * 32 + g) * 64 + lane];
        const float mag = expf(lr * step), lbr = mag * cosf(li * step), lbi = mag * sinf(li * step), den = lr * lr + li * li;
        const float fr = ((lbr - 1.0f) * lr + lbi * li) / den, fi = (lbi * lr - (lbr - 1.0f) * li) / den;
        float bbr[16], bbi[16], cr[16], ci[16];
#pragma unroll
        for (int c = 0; c < 16; ++c) { const float br = A.I(I_BRE)[(g * 64 + lane) * 16 + c], bi = A.I(I_BIM)[(g * 64 + lane) * 16 + c];
            bbr[c] = fr * br - fi * bi; bbi[c] = fr * bi + fi * br;
            cr[c] = A.I(I_CRE)[((dir * 32 + g) * 16 + c) * 64 + lane]; ci[c] = A.I(I_CIM)[((dir * 32 + g) * 16 + c) * 64 + lane]; }
        float sr = 0.f, si = 0.f;
        for (int s0 = 0; s0 < CTX + SEQ; s0 += 4) {
            v4u uu[4][2];
#pragma unroll
            for (int i = 0; i < 4; ++i) { const v4u* up = (const v4u*)(P + (size_t)seq_row(b, dir, s0 + i) * N0 + C0_U + g * 16); uu[i][0] = up[0]; uu[i][1] = up[1]; }
#pragma unroll
            for (int i = 0; i < 4; ++i) {
                float u[16];
#pragma unroll
                for (int q = 0; q < 2; ++q) { u[8 * q + 0] = blo(uu[i][q].x); u[8 * q + 1] = bhi(uu[i][q].x); u[8 * q + 2] = blo(uu[i][q].y); u[8 * q + 3] = bhi(uu[i][q].y);
                    u[8 * q + 4] = blo(uu[i][q].z); u[8 * q + 5] = bhi(uu[i][q].z); u[8 * q + 6] = blo(uu[i][q].w); u[8 * q + 7] = bhi(uu[i][q].w); }
                float br = 0.f, bi = 0.f;
#pragma unroll
                for (int c = 0; c < 16; ++c) { br += bbr[c] * u[c]; bi += bbi[c] * u[c]; }
                const float nr = lbr * sr - lbi * si + br, ni = lbr * si + lbi * sr + bi; sr = nr; si = ni;
                float v[16];
#pragma unroll
                for (int c = 0; c < 16; ++c) v[c] = cr[c] * sr - ci[c] * si;
                const bool b5 = (lane & 32) != 0, b4 = (lane & 16) != 0, b3 = (lane & 8) != 0, b2 = (lane & 4) != 0;
                float w8[8], w4[4], w2[2];
#pragma unroll
                for (int k = 0; k < 8; ++k) { const float send = b5 ? v[k] : v[k + 8], keep = b5 ? v[k + 8] : v[k]; w8[k] = keep + __shfl_xor(send, 32); }
#pragma unroll
                for (int k = 0; k < 4; ++k) { const float send = b4 ? w8[k] : w8[k + 4], keep = b4 ? w8[k + 4] : w8[k]; w4[k] = keep + __shfl_xor(send, 16); }
#pragma unroll
                for (int k = 0; k < 2; ++k) { const float send = b3 ? w4[k] : w4[k + 2], keep = b3 ? w4[k + 2] : w4[k]; w2[k] = keep + __shfl_xor(send, 8); }
                float w1; { const float send = b2 ? w2[0] : w2[1], keep = b2 ? w2[1] : w2[0]; w1 = keep + __shfl_xor(send, 4); }
                w1 += __shfl_xor(w1, 2); w1 += __shfl_xor(w1, 1);
                const int c = (b5 ? 8 : 0) + (b4 ? 4 : 0) + (b3 ? 2 : 0) + (b2 ? 1 : 0);
                if ((lane & 3) == 0) Y[(size_t)dir * MALL * 512 + (size_t)seq_row(b, dir, s0 + i) * 512 + g * 16 + c] = w1;
            }
        }
    }
}
__device__ __forceinline__ void unpack8(const v4u w, float (&f)[8]) { f[0] = blo(w.x); f[1] = bhi(w.x); f[2] = blo(w.y); f[3] = bhi(w.y); f[4] = blo(w.z); f[5] = bhi(w.z); f[6] = blo(w.w); f[7] = bhi(w.w); }
__device__ __forceinline__ v4u pack8(const float (&f)[8]) { v4u w; w.x = pk2(f[0], f[1]); w.y = pk2(f[2], f[3]); w.z = pk2(f[4], f[5]); w.w = pk2(f[6], f[7]); return w; }
__device__ __forceinline__ void p_finish0(Frame& F) {
    const KA A = ka_fresh();
    const int gw = F.vcu * NWAVES + F.wave, NGW = F.G * NWAVES, lane = F.lane, e0 = lane * 8;
    const bf16* P = (const bf16*)(A.WS() + WS_PROJ);
    const float* GO = (const float*)(A.WS() + WS_OREC);
    const float* SY = GO + (size_t)2 * MALL * 512;
    bf16* MIX = (bf16*)(A.WS() + WS_MIX); bf16* YP = (bf16*)(A.WS() + WS_YPRE);
    for (int row = gw; row < MALL; row += NGW) {
        float o[8], gg[8], ng[8];
#if MK_NAIVE_GLA
        { const f32x4* a = (const f32x4*)(GO + (size_t)row * 512 + e0); const f32x4* bq = (const f32x4*)(GO + (size_t)(MALL + row) * 512 + e0);
          const f32x4 a0 = a[0] + bq[0], a1 = a[1] + bq[1]; o[0] = a0.x; o[1] = a0.y; o[2] = a0.z; o[3] = a0.w; o[4] = a1.x; o[5] = a1.y; o[6] = a1.z; o[7] = a1.w; }
#else
        { const bf16* GO16 = (const bf16*)GO; float f0[8], f1[8]; unpack8(*(const v4u*)(GO16 + (size_t)row * 512 + e0), f0); unpack8(*(const v4u*)(GO16 + (size_t)(MALL + row) * 512 + e0), f1);
#pragma unroll
          for (int j = 0; j < 8; ++j) o[j] = f0[j] + f1[j]; }
#endif
        float ss = 0.f;
#pragma unroll
        for (int j = 0; j < 8; ++j) ss += o[j] * o[j];
        ss += __shfl_xor(ss, 1); ss += __shfl_xor(ss, 2); ss += __shfl_xor(ss, 4); ss += __shfl_xor(ss, 8);
        const float r = rsqrtf(ss * (1.0f / 128.0f) + EPS);
        unpack8(*(const v4u*)(P + (size_t)row * N0 + C0_G + e0), gg);
        { const f32x4* n4 = (const f32x4*)(A.I(I_GLANG) + (e0 & 127)); const f32x4 n0 = n4[0], n1 = n4[1]; ng[0] = n0.x; ng[1] = n0.y; ng[2] = n0.z; ng[3] = n0.w; ng[4] = n1.x; ng[5] = n1.y; ng[6] = n1.z; ng[7] = n1.w; }
        float res[8];
#pragma unroll
        for (int j = 0; j < 8; ++j) res[j] = o[j] * r * ng[j] * silu_(gg[j]);
        *(GAS v4u*)(MIX + (size_t)row * 1024 + e0) = pack8(res);
#if MK_NAIVE_S5
        float u[8], y[8];
        unpack8(*(const v4u*)(P + (size_t)row * N0 + C0_U + e0), u);
        { const f32x4* a = (const f32x4*)(SY + (size_t)row * 512 + e0); const f32x4* bq = (const f32x4*)(SY + (size_t)(MALL + row) * 512 + e0);
          const f32x4 a0 = a[0] + bq[0], a1 = a[1] + bq[1]; y[0] = a0.x; y[1] = a0.y; y[2] = a0.z; y[3] = a0.w; y[4] = a1.x; y[5] = a1.y; y[6] = a1.z; y[7] = a1.w; }
#pragma unroll
        for (int j = 0; j < 8; ++j) { const float t = y[j] + A.I(I_S5D)[e0 + j] * u[j]; res[j] = 0.5f * t * (1.0f + tanhf(0.7978845608f * (t + 0.044715f * t * t * t))); }
        *(GAS v4u*)(YP + (size_t)row * 512 + e0) = pack8(res);
#endif
    }
}
__device__ __forceinline__ void p_finish1(Frame& F) {
    const KA A = ka_fresh();
    const int gw = F.vcu * NWAVES + F.wave, NGW = F.G * NWAVES, lane = F.lane;
    const bf16* P = (const bf16*)(A.WS() + WS_PROJ);
    const float* RO = (const float*)(A.WS() + WS_OREC);
    bf16* MIX = (bf16*)(A.WS() + WS_MIX);
    for (int lrow = gw; lrow < NLAT; lrow += NGW) {
#pragma unroll 1
        for (int h = 0; h < 4; ++h) { const int e0 = h * 512 + lane * 8;
            float o[8], gg[8];
#if MK_NAIVE_RET
            { const f32x4* a = (const f32x4*)(RO + (size_t)lrow * 2048 + e0); const f32x4* bq = (const f32x4*)(RO + (size_t)(NLAT + lrow) * 2048 + e0);
              const f32x4 a0 = a[0] + bq[0], a1 = a[1] + bq[1]; o[0] = a0.x; o[1] = a0.y; o[2] = a0.z; o[3] = a0.w; o[4] = a1.x; o[5] = a1.y; o[6] = a1.z; o[7] = a1.w; }
#else
            { const bf16* RO16 = (const bf16*)RO; float f0[8], f1[8]; unpack8(*(const v4u*)(RO16 + (size_t)lrow * 2048 + e0), f0); unpack8(*(const v4u*)(RO16 + (size_t)(NLAT + lrow) * 2048 + e0), f1);
#pragma unroll
              for (int j = 0; j < 8; ++j) o[j] = f0[j] + f1[j]; }
#endif
            float s = 0.f;
#pragma unroll
            for (int j = 0; j < 8; ++j) s += o[j];
            const float mu = wave_sum(s) * (1.0f / 512.0f); float q = 0.f;
#pragma unroll
            for (int j = 0; j < 8; ++j) { o[j] -= mu; q += o[j] * o[j]; }
            const float r = rsqrtf(wave_sum(q) * (1.0f / 512.0f) + EPS);
            unpack8(*(const v4u*)(P + (size_t)(NCTX + lrow) * N1 + C1_G + e0), gg);
            float res[8];
#pragma unroll
            for (int j = 0; j < 8; ++j) res[j] = o[j] * r * A.I(I_RETNG)[e0 + j] * silu_(gg[j]);
            *(GAS v4u*)(MIX + (size_t)lrow * 2048 + e0) = pack8(res); }
    }
}
__device__ __forceinline__ void p_rope(Frame& F) {
    const KA A = ka_fresh();
    const int gw = F.vcu * NWAVES + F.wave, NGW = F.G * NWAVES, lane = F.lane;
    bf16* P = (bf16*)(A.WS() + WS_PROJ);
    const float invf = expf(-(float)lane * (9.210340371976184f / 64.0f));
    for (int lrow = gw; lrow < NLAT; lrow += NGW) {
        const int t = lrow & (SEQ - 1), pr = t >> 6, pc = t & 63;
        float sr, cr, sc, cc; sincosf((float)pr * invf, &sr, &cr); sincosf((float)pc * invf, &sc, &cc);
        bf16* rp = P + (size_t)(NCTX + lrow) * N1;
#pragma unroll 1
        for (int tb = 0; tb < 2048; tb += 256) {
            { const float a = bf2f(rp[tb + lane]), b2 = bf2f(rp[tb + 64 + lane]); rp[tb + lane] = (bf16)f2bf(a * cr - b2 * sr); rp[tb + 64 + lane] = (bf16)f2bf(a * sr + b2 * cr); }
            { const float a = bf2f(rp[tb + 128 + lane]), b2 = bf2f(rp[tb + 192 + lane]); rp[tb + 128 + lane] = (bf16)f2bf(a * cc - b2 * sc); rp[tb + 192 + lane] = (bf16)f2bf(a * sc + b2 * cc); }
        }
    }
}
__device__ __forceinline__ void p_router(Frame& F, int layer) {
    const KA A = ka_fresh();
    const int tid = F.tid, lane = F.lane, wave = F.wave;
    const int moe_row0 = layer ? NCTX : 0, NTOK = layer ? NLAT : MALL;
    const int RPB = (NTOK + F.G - 1) / F.G;
    unsigned char* ws = A.WS();
    int* prow = (int*)(ws + WS_PROW); int* sel_e = (int*)(ws + WS_SELE); float* w_slot = (float*)(ws + WS_WSLOT); int* slot_pos = (int*)(ws + WS_SPOS);
    for (int i = F.vcu * NTHR + tid; i < MAXTILES * 256; i += F.G * NTHR) prow[i] = -1;
    LAS float* Wt = (LAS float*)F.lds;
    LAS int* lcnt = (LAS int*)(F.lds + L_LCNT); LAS int* gbase = (LAS int*)(F.lds + L_GBASE);
    LAS int* blk_e = (LAS int*)(F.lds + L_BLKE); LAS int* blk_p = (LAS int*)(F.lds + L_BLKP);
    const float* wr = A.I(I_WROUTER) + (size_t)layer * 1024 * 32;
    for (int idx = tid; idx < 32768; idx += NTHR) Wt[(idx & 31) * 1024 + (idx >> 5)] = wr[idx];
    if (tid < 32) lcnt[tid] = 0;
    __syncthreads();
    const float* mod = (const float*)(ws + WS_MOD) + (size_t)layer * 9 * 6144;
    const float* XR = (const float*)(ws + WS_XRES); bf16* H = (bf16*)(ws + WS_H);
    const int tok0 = F.vcu * RPB;
    for (int lr = wave; lr < RPB; lr += NWAVES) {
        const int tok = tok0 + lr; if (tok >= NTOK) break;
        const int row = moe_row0 + tok;
        f32x4 v[4], h[4];
#pragma unroll
        for (int j = 0; j < 4; ++j) v[j] = ((const f32x4*)(XR + (size_t)row * 1024))[64 * j + lane];
        const float* m = mod + bidx_of_row(row) * 6144;
        modnorm_store(v, A.I(I_N2G) + layer * 1024, m + 4096, m + 3072, H + (size_t)row * 1024, lane, h);
        float lg[32];
#pragma unroll
        for (int e = 0; e < 32; ++e) { float a = 0.f;
#pragma unroll
            for (int j = 0; j < 4; ++j) { const f32x4 w4 = *(const LAS f32x4*)(Wt + e * 1024 + 4 * (64 * j + lane)); a += (h[j].x * w4.x + h[j].y * w4.y) + (h[j].z * w4.z + h[j].w * w4.w); }
            lg[e] = wave_sum(a) + A.I(I_BROUTER)[layer * 32 + e]; }
        float bv[4]; int bi[4];
#pragma unroll
        for (int r = 0; r < 4; ++r) { float best = -INFINITY; int be = 0;
#pragma unroll
            for (int e = 0; e < 32; ++e) { const bool take = lg[e] > best; best = take ? lg[e] : best; be = take ? e : be; }
            bv[r] = best; bi[r] = be;
#pragma unroll
            for (int e = 0; e < 32; ++e) lg[e] = (e == be) ? -INFINITY : lg[e]; }
        const float e1 = __expf(bv[1] - bv[0]), e2 = __expf(bv[2] - bv[0]), e3 = __expf(bv[3] - bv[0]), inv = 1.0f / (1.0f + e1 + e2 + e3);
        if (lane < 4) { const int ee = lane == 0 ? bi[0] : (lane == 1 ? bi[1] : (lane == 2 ? bi[2] : bi[3]));
            const float wv = (lane == 0 ? 1.0f : (lane == 1 ? e1 : (lane == 2 ? e2 : e3))) * inv;
            sel_e[tok * 4 + lane] = ee; w_slot[tok * 4 + lane] = wv;
            const int lp = __hip_atomic_fetch_add(lcnt + ee, 1, __ATOMIC_RELAXED, __HIP_MEMORY_SCOPE_WORKGROUP);
            blk_e[lr * 4 + lane] = ee; blk_p[lr * 4 + lane] = lp; }
    }
    __syncthreads();
    if (tid < 32) gbase[tid] = (int)__hip_atomic_fetch_add(F.ctl + CW_GCNT + 64 * layer + tid, (unsigned)lcnt[tid], RLX_AGENT);
    __syncthreads();
    for (int idx = tid; idx < RPB * 4; idx += NTHR) { const int tok = tok0 + (idx >> 2); if (tok < NTOK) slot_pos[tok * 4 + (idx & 3)] = gbase[blk_e[idx]] + blk_p[idx]; }
}
__device__ __forceinline__ int moe_tables(Frame& F, int layer) {
    LAS int* ts = (LAS int*)(F.lds + L_TSTART); LAS unsigned char* te = (LAS unsigned char*)(F.lds + L_TILEE);
    __syncthreads();
    if (F.tid == 0) { int acc = 0;
        for (int e = 0; e < 32; ++e) { ts[e] = acc; acc += ((int)__hip_atomic_load(F.ctl + CW_GCNT + 64 * layer + e, RLX_AGENT) + 255) >> 8; }
        ts[32] = acc > MAXTILES ? MAXTILES : acc; }
    __syncthreads();
    const int nt = ts[32];
    for (int T = F.tid; T < nt; T += NTHR) { int e = 0;
        for (int q = 1; q < 32; ++q) e = (T >= ts[q]) ? q : e;
        te[T] = (unsigned char)e; }
    __syncthreads();
    return nt;
}
__device__ __forceinline__ void p_gather(Frame& F, int layer) {
    const KA A = ka_fresh();
    const int NTOK = layer ? NLAT : MALL;
    unsigned char* ws = A.WS();
    moe_tables(F, layer);
    const LAS int* ts = (const LAS int*)(F.lds + L_TSTART);
    int* prow = (int*)(ws + WS_PROW); const int* sel_e = (const int*)(ws + WS_SELE); const int* slot_pos = (const int*)(ws + WS_SPOS);
    for (int s = F.vcu * NTHR + F.tid; s < NTOK * 4; s += F.G * NTHR) prow[ts[sel_e[s]] * 256 + slot_pos[s]] = s;
}
__device__ __forceinline__ void p_combine(Frame& F, int layer) {
    const KA A = ka_fresh();
    const int gw = F.vcu * NWAVES + F.wave, NGW = F.G * NWAVES, lane = F.lane;
    const int moe_row0 = layer ? NCTX : 0, NTOK = layer ? NLAT : MALL;
    unsigned char* ws = A.WS();
    float* XR = (float*)(ws + WS_XRES); bf16* H = (bf16*)(ws + WS_H); const bf16* YS = (const bf16*)(ws + WS_YSLOT);
    const float* mod = (const float*)(ws + WS_MOD);
    for (int tok = gw; tok < NTOK; tok += NGW) {
        const int row = moe_row0 + tok, bidx = bidx_of_row(row);
        const float* g2 = mod + (size_t)layer * 9 * 6144 + bidx * 6144 + 5120;
        f32x4 v[4];
#pragma unroll
        for (int j = 0; j < 4; ++j) { const int o = 64 * j + lane; f32x4 y = (f32x4){0.f, 0.f, 0.f, 0.f};
#pragma unroll
            for (int k = 0; k < 4; ++k) { const v2u w = ((const v2u*)(YS + (size_t)(tok * 4 + k) * 1024))[o]; y += (f32x4){blo(w.x), bhi(w.x), blo(w.y), bhi(w.y)}; }
            v[j] = ((const f32x4*)(XR + (size_t)row * 1024))[o] + ((const f32x4*)g2)[o] * y; }
        if (layer == 0) {
#pragma unroll
            for (int j = 0; j < 4; ++j) ((f32x4*)(XR + (size_t)row * 1024))[64 * j + lane] = v[j];
            const float* m1 = mod + (size_t)9 * 6144 + bidx * 6144; f32x4 h[4];
            modnorm_store(v, A.I(I_N1G) + 1024, m1 + 1024, m1, H + (size_t)row * 1024, lane, h);
        } else {
            float ss = 0.f;
#pragma unroll
            for (int j = 0; j < 4; ++j) ss += (v[j].x * v[j].x + v[j].y * v[j].y) + (v[j].z * v[j].z + v[j].w * v[j].w);
            const float r = rsqrtf(wave_sum(ss) * (1.0f / 1024.0f) + EPS);
#pragma unroll
            for (int j = 0; j < 4; ++j) { const int o = 64 * j + lane; ((f32x4*)(A.OUT() + (size_t)tok * 1024))[o] = v[j] * r * ((const f32x4*)A.I(I_FNG))[o]; }
        }
    }
}
typedef short s16x4 __attribute__((ext_vector_type(4)));
typedef short bfx8 __attribute__((ext_vector_type(8)));
typedef short v4i16_t __attribute__((ext_vector_type(4)));
#define MFMA16(a, b, c) __builtin_amdgcn_mfma_f32_16x16x32_bf16((a), (b), (c), 0, 0, 0)
__device__ __forceinline__ bfx8 frag_n(const LAS unsigned char* tile, int stride, int r0, int k0, int lane) {
    return *(const LAS bfx8*)(tile + (r0 + (lane & 15)) * stride + (k0 + 8 * (lane >> 4)) * 2);
}
__device__ __forceinline__ bfx8 frag_t(const LAS unsigned char* tile, int stride, int k0, int n0, int lane) {
    const int g = lane >> 4, q = (lane & 15) >> 2, p = lane & 3;
    const LAS unsigned char* a = tile + (k0 + 8 * g + q) * stride + (n0 + 4 * p) * 2;
    const s16x4 lo = __builtin_bit_cast(s16x4, __builtin_amdgcn_ds_read_tr16_b64_v4i16((LAS v4i16_t*)a));
    const s16x4 hi = __builtin_bit_cast(s16x4, __builtin_amdgcn_ds_read_tr16_b64_v4i16((LAS v4i16_t*)(a + 4 * stride)));
    return __builtin_shufflevector(lo, hi, 0, 1, 2, 3, 4, 5, 6, 7);
}
__device__ __forceinline__ v4u scale8(const v4u w, float s) { float f[8]; unpack8(w, f);
#pragma unroll
    for (int j = 0; j < 8; ++j) f[j] *= s;
    return pack8(f); }

template <int DK, int DVS, bool GLA>
__device__ __forceinline__ void rec_mfma(Frame& F, const bf16* Qsrc, const bf16* Ksrc, const bf16* K2src, size_t qdir_stride, int ldq, int qcol, int kcol,
                                         const bf16* Vsrc, int ldv, int vcol, int DV, const float* EB,
                                         bf16* O, size_t odir_stride, int ldo, int orow0) {
    const KA A = ka_fresh();
    constexpr int SQ = DK * 2 + 16, SV = DVS * 2 + 16, SP = 144, SS = DK * 2 + 16;
    constexpr int O_QD = 0, O_KI = O_QD + 64 * SQ, O_KS = O_KI + 64 * SQ, O_V = O_KS + (GLA ? 64 * SQ : 0), O_VD = O_V + 64 * SV, O_P = O_VD + (GLA ? 0 : 64 * SV), O_ST = O_P + 64 * SP, O_EB = O_ST + DVS * SS;
    static_assert(O_EB + DK * 4 <= RING_BYTES, "rec_mfma LDS");
    constexpr int NVS = 0;  (void)NVS;
    constexpr int VT_PER = DVS / 32, KT_PER = DK / 64, QCH = DK / 8  , QN = (64 * QCH) / NTHR, VCH = DVS / 8, KSTEPS = DK / 32;
    static_assert(QN >= 1 && VT_PER >= 1 && KT_PER >= 1, "shape");
    const LAS unsigned char* L = F.lds;
    const int tid = F.tid, lane = F.lane, w = F.wave, it = w & 3, vg = w >> 2, kg = w & 3, g4 = lane >> 4, l15 = lane & 15;
    const int nvs = DV / DVS, nitems = NB * 4 * 2 * nvs;
    for (int item = F.vcu; item < nitems; item += F.G) {
        const int vs = item % nvs, dir = (item / nvs) & 1, h = (item / (2 * nvs)) & 3, b = item / (8 * nvs);
        float lg2 = 0.f;
        if (!GLA) { const float lgt = A.I(I_RETDEC)[dir * 4 + h]; lg2 = -log2f(1.0f + expf(-lgt)); }
        const bf16* qb = Qsrc + (GLA ? (size_t)dir * qdir_stride : 0) + qcol + h * DK;
        const bf16* kb = Ksrc + (GLA ? (size_t)dir * qdir_stride : 0) + kcol + h * DK;
        const bf16* k2b = GLA ? K2src + (size_t)dir * qdir_stride + kcol + h * DK : kb;
        const bf16* vb = Vsrc + vcol + h * DV + vs * DVS;
        f32x4 Sacc[VT_PER][KT_PER];
#pragma unroll
        for (int a = 0; a < VT_PER; ++a)
#pragma unroll
            for (int c2 = 0; c2 < KT_PER; ++c2) Sacc[a][c2] = (f32x4){0.f, 0.f, 0.f, 0.f};
        for (int i = tid; i < DVS * SS / 4; i += NTHR) ((LAS unsigned*)(F.lds + O_ST))[i] = 0u;
        v4u rq[QN], rk[QN], rk2[GLA ? QN : 1], rv; float peb = 0.f;
        rv = (v4u){0u, 0u, 0u, 0u};
#define REC_LOAD(c) do { \
            _Pragma("unroll") for (int n = 0; n < QN; ++n) { const int pi = tid + NTHR * n, r = pi / QCH, ch = pi % QCH; const size_t ro = (size_t)seq_row(b, dir, 64 * (c) + r) * ldq + ch * 8; \
                rq[n] = *(const v4u*)(qb + ro); rk[n] = *(const v4u*)(kb + ro); if (GLA) rk2[n] = *(const v4u*)(k2b + ro); } \
            if (tid < 64 * VCH) { const int r = tid / VCH, ch = tid % VCH; rv = *(const v4u*)(vb + (size_t)seq_row(b, dir, 64 * (c) + r) * ldv + ch * 8); } \
            if (GLA && tid < DK) peb = EB[(((size_t)dir * NB + b) * 68 + (c)) * (4 * DK) + h * DK + tid]; } while (0)
        REC_LOAD(0);
        for (int c = 0; c < 68; ++c) {
#pragma unroll
            for (int n = 0; n < QN; ++n) { const int pi = tid + NTHR * n, r = pi / QCH, ch = pi % QCH;
                *(LAS v4u*)(F.lds + O_QD + r * SQ + ch * 16) = rq[n]; *(LAS v4u*)(F.lds + O_KI + r * SQ + ch * 16) = rk[n];
                if (GLA) *(LAS v4u*)(F.lds + O_KS + r * SQ + ch * 16) = rk2[n]; }
            if (tid < 64 * VCH) { const int r = tid / VCH, ch = tid % VCH;
                *(LAS v4u*)(F.lds + O_V + r * SV + ch * 16) = rv;
                if (!GLA) *(LAS v4u*)(F.lds + O_VD + r * SV + ch * 16) = scale8(rv, exp2f(lg2 * (float)(63 - r))); }
            if (GLA && tid < DK) ((LAS float*)(F.lds + O_EB))[tid] = peb;
            if (c + 1 < 68) REC_LOAD(c + 1);
            __syncthreads();
#pragma unroll
            for (int q2 = 0; q2 < 2; ++q2) { const int jt = 2 * vg + q2; f32x4 acc = (f32x4){0.f, 0.f, 0.f, 0.f};
                if (jt <= it) {
#pragma unroll
                    for (int ks = 0; ks < KSTEPS; ++ks) acc = MFMA16(frag_n(L + O_KI, SQ, 16 * jt, 32 * ks, lane), frag_n(L + O_QD, SQ, 16 * it, 32 * ks, lane), acc);
                    const int i = 16 * it + l15;
#pragma unroll
                    for (int r = 0; r < 4; ++r) { const int j = 16 * jt + 4 * g4 + r; float vv = (j <= i) ? acc[r] : 0.f; if (!GLA) vv *= exp2f(lg2 * (float)(i - j)); acc[r] = vv; }
                }
                v2u pw; pw.x = pk2(acc[0], acc[1]); pw.y = pk2(acc[2], acc[3]);
                *(LAS v2u*)(F.lds + O_P + (16 * it + l15) * SP + (16 * jt + 4 * g4) * 2) = pw; }
            f32x4 oacc[VT_PER];
#pragma unroll
            for (int a = 0; a < VT_PER; ++a) { oacc[a] = (f32x4){0.f, 0.f, 0.f, 0.f};
#pragma unroll
                for (int ks = 0; ks < KSTEPS; ++ks) oacc[a] = MFMA16(frag_n(L + O_ST, SS, 16 * (vg * VT_PER + a), 32 * ks, lane), frag_n(L + O_QD, SQ, 16 * it, 32 * ks, lane), oacc[a]);
                if (!GLA) oacc[a] *= exp2f(lg2 * (float)(16 * it + l15 + 1)); }
            __syncthreads();
            { const int row = seq_row(b, dir, 64 * c + 16 * it + l15);
#pragma unroll
              for (int a = 0; a < VT_PER; ++a) { const int vt = vg * VT_PER + a;
#pragma unroll
                for (int js = 0; js < 2; ++js) oacc[a] = MFMA16(frag_t(L + O_V, SV, 32 * js, 16 * vt, lane), frag_n(L + O_P, SP, 16 * it, 32 * js, lane), oacc[a]);
                if (row >= orow0) { v2u ow; ow.x = pk2(oacc[a][0], oacc[a][1]); ow.y = pk2(oacc[a][2], oacc[a][3]);
                    *(GAS v2u*)(O + (size_t)dir * odir_stride + (size_t)(row - orow0) * ldo + h * DV + vs * DVS + 16 * vt + 4 * g4) = ow; } } }
            { bfx8 fv[VT_PER][2];
#pragma unroll
              for (int a = 0; a < VT_PER; ++a)
#pragma unroll
                for (int js = 0; js < 2; ++js) fv[a][js] = frag_t(L + (GLA ? O_V : O_VD), SV, 32 * js, 16 * (vg * VT_PER + a), lane);
              const float g64 = GLA ? 1.0f : exp2f(lg2 * 64.0f);
#pragma unroll
              for (int c2 = 0; c2 < KT_PER; ++c2) { const int kt = kg * KT_PER + c2;
                const bfx8 fk0 = frag_t(L + (GLA ? O_KS : O_KI), SQ, 0, 16 * kt, lane), fk1 = frag_t(L + (GLA ? O_KS : O_KI), SQ, 32, 16 * kt, lane);
                f32x4 sc4 = (f32x4){g64, g64, g64, g64};
                if (GLA) sc4 = *(const LAS f32x4*)(L + O_EB + (16 * kt + 4 * g4) * 4);
#pragma unroll
                for (int a = 0; a < VT_PER; ++a) { f32x4 s = Sacc[a][c2] * sc4;
                    s = MFMA16(fk0, fv[a][0], s); s = MFMA16(fk1, fv[a][1], s); Sacc[a][c2] = s;
                    v2u sw; sw.x = pk2(s[0], s[1]); sw.y = pk2(s[2], s[3]);
                    *(LAS v2u*)(F.lds + O_ST + (16 * (vg * VT_PER + a) + l15) * SS + (16 * kt + 4 * g4) * 2) = sw; } } }
            __syncthreads();
        }
#undef REC_LOAD
    }
}
__device__ __forceinline__ float gla_logdecay(const bf16* P, size_t rb, int dir, const float (&wa)[16], float ba) {
    const v4u l0 = *(const v4u*)(P + rb + C0_LOW + dir * 16), l1 = *(const v4u*)(P + rb + C0_LOW + dir * 16 + 8);
    float f0[8], f1[8]; unpack8(l0, f0); unpack8(l1, f1);
    float z = ba;
#pragma unroll
    for (int r = 0; r < 8; ++r) z += f0[r] * wa[r];
#pragma unroll
    for (int r = 0; r < 8; ++r) z += f1[r] * wa[8 + r];
    return (fminf(z, 0.f) - log1pf(expf(-fabsf(z)))) * (1.0f / 16.0f);
}
__device__ __forceinline__ void p_gla_prep(Frame& F, const bf16* P, bf16* QD, bf16* KI, bf16* KS, float* EB) {
    const KA A = ka_fresh();
    const int tid = F.tid, col = tid & 255, half = tid >> 8;
    LAS float* tot = (LAS float*)F.lds;
    for (int item = F.vcu; item < 2 * NB * 68; item += F.G) {
        const int c = item % 68, b = (item / 68) % NB, dir = item / (68 * NB);
        float wa[16];
#pragma unroll
        for (int r = 0; r < 16; ++r) wa[r] = A.I(I_GLAWA)[(dir * 16 + r) * 256 + col];
        const float ba = A.I(I_GLABA)[dir * 256 + col];
        float run = 0.f;
#pragma unroll 4
        for (int t = 0; t < 32; ++t) run += gla_logdecay(P, (size_t)seq_row(b, dir, 64 * c + 32 * half + t) * N0, dir, wa, ba);
        tot[half * 256 + col] = run;
        __syncthreads();
        const float blast = tot[col] + tot[256 + col];
        float bt = half ? tot[col] : 0.f;
        __syncthreads();
#pragma unroll 4
        for (int t = 0; t < 32; ++t) { const int row = seq_row(b, dir, 64 * c + 32 * half + t);
            bt += gla_logdecay(P, (size_t)row * N0, dir, wa, ba);
            const float q = bf2f(P[(size_t)row * N0 + C0_Q + col]), k = bf2f(P[(size_t)row * N0 + C0_K + col]);
            const size_t o = ((size_t)dir * MALL + row) * 256 + col;
            QD[o] = (bf16)f2bf(q * expf(bt)); KI[o] = (bf16)f2bf(k * expf(-bt)); KS[o] = (bf16)f2bf(k * expf(blast - bt)); }
        if (half == 0) EB[(((size_t)dir * NB + b) * 68 + c) * 256 + col] = expf(blast);
    }
}
#ifndef MK_ONLY
#define MK_ONLY -1
#endif
#define SON(s) (MK_ONLY < 0 || MK_ONLY == (s))
#define IN(k) (lo <= (k) && (k) < hi)
#define SEAM(k) do { if (IN(k) && IN((k) + 1)) xcd_barrier(bar); } while (0)
template <int layer>
__device__ __forceinline__ void layer_body(Frame& F, const int lo, const int hi, const XcdBarrier& bar) {
    unsigned char* const ws = ka_fresh().WS();
    bf16* const H = (bf16*)(ws + WS_H);
    bf16* const PROJ = (bf16*)(ws + WS_PROJ);
    float* const XRES = (float*)(ws + WS_XRES);
    float* const MOD = (float*)(ws + WS_MOD);

        const int pb = layer ? PH_INPROJ1 : PH_INPROJ0;
        if (SON(2) && IN(pb)) {
            pg8::Gemm g{H, (const bf16*)(ws + (layer ? WS_WIN1T : WS_WIN0T)), MALL, layer ? N1 : N0, 1024, 1024};
            pg8::StaticOrder S; S.init(g.M, g.N, F.G, (int)blockIdx.x);
            if constexpr (layer == 0 && !MK_NAIVE_S5) { pg8::EpiStoreU E{PROJ, g.N, (bf16*)(ws + WS_A2)};
                pg8::gemm_phase<pg8::EpiStoreU, pg8::StaticOrder, true, true>(F.lds, g, S, E); }
            else { pg8::EpiStore E{PROJ, g.N};
                pg8::gemm_phase<pg8::EpiStore, pg8::StaticOrder, true, true>(F.lds, g, S, E); }
        }
        SEAM(pb);
        if (layer == 0) {
#if MK_NAIVE_GLA
            SEAM(PH_GLAPREP);
            if (SON(3) && IN(PH_GLA)) rec_naive<64, true>(F, PROJ, N0, C0_Q, C0_K, C0_V, 128, 2, (float*)(ws + WS_OREC), (size_t)MALL * 512, 512, 0);
#else
            bf16* const GQD = (bf16*)(ws + WS_OREC + 280 * MiB); bf16* const GKI = GQD + (size_t)2 * MALL * 256; bf16* const GKS = GKI + (size_t)2 * MALL * 256; float* const GEB = (float*)(ws + WS_OREC + 384 * MiB);
            if (SON(13) && IN(PH_GLAPREP)) p_gla_prep(F, PROJ, GQD, GKI, GKS, GEB);
#if !MK_NAIVE_S5
            if (SON(17) && IN(PH_GLAPREP)) {
                __syncthreads();
                pg8::Gemm g{(const bf16*)(ws + WS_A2), (const bf16*)(ws + WS_S5W1), 32 * S5_ROWS, 256, 256, 512};
                pg8::GroupOrder S{9, 288, F.G, F.vcu};
                pg8::EpiF32Plain E{(float*)(ws + WS_SLOC)};
                pg8::gemm_phase<pg8::EpiF32Plain, pg8::GroupOrder, true, true>(F.lds, g, S, E);
            }
#endif
            SEAM(PH_GLAPREP);
#if !MK_NAIVE_S5
            if (SON(18) && IN(PH_GLA)) { p_s5_scan(F, (const float*)(ws + WS_SLOC), (bf16*)(ws + WS_A2)); __syncthreads(); }
#endif
            if (SON(3) && IN(PH_GLA)) rec_mfma<64, 32, true>(F, GQD, GKI, GKS, (size_t)MALL * 256, 256, 0, 0, PROJ, N0, C0_V, 128, GEB, (bf16*)(ws + WS_OREC), (size_t)MALL * 512, 512, 0);
#endif
            SEAM(PH_GLA);
#if MK_NAIVE_S5
            if (SON(4) && IN(PH_S5)) s5_naive(F, PROJ, (float*)(ws + WS_OREC) + (size_t)2 * MALL * 512);
#else
            if (SON(4) && IN(PH_S5)) {
                pg8::Gemm g{(const bf16*)(ws + WS_A2), (const bf16*)(ws + WS_S5W2), 32 * S5_ROWS, 256, 512, 512};
                pg8::GroupOrder S{9, 288, F.G, F.vcu};
                pg8::EpiS5Out E{(const bf16*)(ws + WS_A2), (bf16*)(ws + WS_YPRE), ka_fresh().I(I_S5D)};
                pg8::gemm_phase<pg8::EpiS5Out, pg8::GroupOrder, true, true>(F.lds, g, S, E);
            }
#endif
            SEAM(PH_S5);
            if (SON(5) && IN(PH_FIN0)) p_finish0(F);
            SEAM(PH_FIN0);
            if (SON(6) && IN(PH_GLU)) {
                pg8::Gemm g{(const bf16*)(ws + WS_YPRE), (const bf16*)(ws + WS_WGLUT), MALL, 512, 512, 512};
                pg8::StaticOrder S; S.init(g.M, g.N, F.G, (int)blockIdx.x);
                pg8::EpiGlu E{(const bf16*)(ws + WS_YPRE), (bf16*)(ws + WS_MIX), 1024, 512, ka_fresh().I(I_GLUB)};
                pg8::gemm_phase<pg8::EpiGlu, pg8::StaticOrder, true, true>(F.lds, g, S, E);
            }
            SEAM(PH_GLU);
        } else {
            if (SON(14) && IN(PH_ROPE)) p_rope(F);
            SEAM(PH_ROPE);
#if MK_NAIVE_RET
            if (SON(15) && IN(PH_RET)) rec_naive<256, false>(F, PROJ, N1, C1_Q, C1_K, C1_V, 512, 8, (float*)(ws + WS_OREC), (size_t)NLAT * 2048, 2048, NCTX);
#else
            if (SON(15) && IN(PH_RET)) rec_mfma<256, 64, false>(F, PROJ, PROJ, PROJ, 0, N1, C1_Q, C1_K, PROJ, N1, C1_V, 512, nullptr, (bf16*)(ws + WS_OREC), (size_t)NLAT * 2048, 2048, NCTX);
#endif
            SEAM(PH_RET);
            if (SON(16) && IN(PH_FIN1)) p_finish1(F);
            SEAM(PH_FIN1);
        }
        const int po = layer ? PH_OUT1 : PH_OUT0;
        if (SON(7) && IN(po)) {
            pg8::Gemm g{(const bf16*)(ws + WS_MIX), (const bf16*)(ws + (layer ? WS_WOUT1T : WS_WOUT0T)), layer ? NLAT : MALL, 1024, layer ? 2048 : 1024, layer ? 2048 : 1024};
            pg8::StaticOrder S; S.init(g.M, g.N, F.G, (int)blockIdx.x);
            pg8::EpiResid E{ka_fresh().I(I_CTX), layer ? (const float*)(XRES + (size_t)NCTX * 1024) : ka_fresh().I(I_X), XRES, MOD + (size_t)layer * 9 * 6144 + 2048, layer ? 8 : 0};
            pg8::gemm_phase<pg8::EpiResid, pg8::StaticOrder, true, true>(F.lds, g, S, E);
        }
        SEAM(po);
        if (SON(8) && IN(po + 1)) p_router(F, layer);
        SEAM(po + 1);
        if (SON(9) && IN(po + 2)) p_gather(F, layer);
        SEAM(po + 2);
        if (SON(10) && IN(po + 3)) {
            const int nt = moe_tables(F, layer);
            pg8::Gemm g{H, (const bf16*)(ws + WS_WGUT) + (size_t)layer * 32 * 2048 * 1024, nt * 256, 2048, 1024, 1024};
            pg8::MoeOrder S{(const PG8_LAS unsigned char*)(F.lds + L_TILEE), nt, 8, F.G, F.vcu, (const int*)(ws + WS_PROW), layer ? NCTX : 0};
            pg8::EpiSwiglu E{(bf16*)(ws + WS_ACT), ka_fresh().I(I_BGU) + (size_t)layer * 32 * 2048};
            pg8::gemm_phase<pg8::EpiSwiglu, pg8::MoeOrder, true, true, true>(F.lds, g, S, E);
        }
        SEAM(po + 3);
        if (SON(11) && IN(po + 4)) {
            const int nt = moe_tables(F, layer);
            pg8::Gemm g{(const bf16*)(ws + WS_ACT), (const bf16*)(ws + WS_WDNT) + (size_t)layer * 32 * 1024 * 1024, nt * 256, 1024, 1024, 1024};
            pg8::MoeOrder S{(const PG8_LAS unsigned char*)(F.lds + L_TILEE), nt, 4, F.G, F.vcu, (const int*)(ws + WS_PROW), 0};
            pg8::EpiDown E{(bf16*)(ws + WS_YSLOT), (const int*)(ws + WS_PROW), (const float*)(ws + WS_WSLOT), ka_fresh().I(I_BDN) + (size_t)layer * 32 * 1024};
            pg8::gemm_phase<pg8::EpiDown, pg8::MoeOrder, true, true>(F.lds, g, S, E);
        }
        SEAM(po + 4);
        if (SON(12) && IN(po + 5)) p_combine(F, layer);
        SEAM(po + 5);
    }
__global__ void __launch_bounds__(NTHR, 2) mk_fwd(Args) {
    extern __shared__ __attribute__((aligned(16))) unsigned char lds[];
    Frame F;
    F.lds = (LAS unsigned char*)lds;
    F.MISC = (volatile LAS unsigned*)(F.lds + L_MISC);
    F.tid = threadIdx.x; F.lane = F.tid & 63; F.wave = __builtin_amdgcn_readfirstlane(F.tid >> 6);
    F.G = gridDim.x; { const int bx = blockIdx.x; F.vcu = (F.G % 8 == 0) ? (bx % 8) * (F.G / 8) + bx / 8 : bx; }
    const KA A0 = ka_fresh();
    unsigned char* ws = A0.WS();
    F.ctl = (unsigned*)(ws + WS_CTL);
    if (F.tid < 64) F.MISC[F.tid] = 0u;
    __syncthreads();
    const int lo = A0.LO(), hi = A0.HI();
    XcdBarrier bar; bar.bar = F.ctl + CW_BAR; bar.x = 0; bar.st = nullptr;
    if (hi - lo > 1) bar = xcd_barrier_post(F.ctl + CW_BAR, F.MISC + 8);

    if (SON(0) && IN(0)) { p0_prologue(F); } SEAM(0);
    if (SON(1) && IN(1)) { p_norm1_l0(F); } SEAM(1);
    layer_body<0>(F, lo, hi, bar);
    layer_body<1>(F, lo, hi, bar);
}

#ifndef MK_MULTI
#define MK_MULTI 0
#endif
extern "C" void kernel_launch(void* const* d_in, const int* in_sizes, int n_in, void* d_out, int out_size, void* d_ws, size_t ws_size, hipStream_t stream) {
    static int grid = 0;
    if (grid == 0) {
        if (n_in != 34 || out_size != NLAT * D || ws_size < WS_END) { fprintf(stderr, "kernel_launch: unexpected sizes: n_in %d out %d ws %zu (need %zu)\n", n_in, out_size, ws_size, (size_t)WS_END); grid = -1; return; }
        int dev = 0, cus = 0;
        if (hipGetDevice(&dev) != hipSuccess || hipDeviceGetAttribute(&cus, hipDeviceAttributeMultiprocessorCount, dev) != hipSuccess) { grid = -1; return; }
        if (hipFuncSetAttribute((const void*)mk_fwd, hipFuncAttributeMaxDynamicSharedMemorySize, LDS_BYTES) != hipSuccess) { fprintf(stderr, "kernel_launch: hipFuncSetAttribute failed\n"); grid = -1; return; }
        int per_cu = 0;
        if (hipOccupancyMaxActiveBlocksPerMultiprocessor(&per_cu, (const void*)mk_fwd, NTHR, LDS_BYTES) != hipSuccess || per_cu < 1) fprintf(stderr, "kernel_launch: occupancy query says %d\n", per_cu);
        (void)hipGetLastError();
        grid = cus;
    }
    if (grid < 0) return;
    (void)in_sizes;
    (void)hipMemsetAsync((char*)d_ws + WS_CTL, 0, CTL_ZERO_BYTES, stream);
    Args a{};
    for (int i = 0; i < 34; ++i) a.in[i] = (const float*)d_in[i];
    a.out = (float*)d_out; a.ws = (unsigned char*)d_ws;
#if MK_MULTI
    for (int p = 0; p < NPH; ++p) { a.ph_lo = p; a.ph_hi = p + 1; hipLaunchKernelGGL(mk_fwd, dim3(grid), dim3(NTHR), LDS_BYTES, stream, a); }
#else
    a.ph_lo = 0; a.ph_hi = NPH; hipLaunchKernelGGL(mk_fwd, dim3(grid), dim3(NTHR), LDS_BYTES, stream, a);
#endif
}
```

```cpp
#include <hip/hip_runtime.h>
#include <cstdio>
#include <cstdint>
#include <cmath>
namespace pg8 {
#define PG8_LAS __attribute__((address_space(3)))
typedef unsigned short bf16_t;
typedef short bf16x8 __attribute__((ext_vector_type(8)));
typedef float f32x4 __attribute__((ext_vector_type(4)));
typedef unsigned u32x4 __attribute__((ext_vector_type(4)));
constexpr int BM = 256, BK = 64, HALF = 128, HTB = HALF * BK * 2  , STAGE_BYTES = 8 * HTB, NXCD = 8, WGM = 8;

__host__ __device__ __forceinline__ int lds_byte(int r, int c) { const int st = (r >> 4) * 2 + (c >> 5), rr = r & 15, cc = c & 31, ob = rr * 64 + cc * 2; return st * 1024 + (ob ^ (((ob >> 9) & 1) << 5)); }
__host__ __device__ __forceinline__ void stage_rc(int b, int& R, int& C) { const int st = b / 1024, sb = b % 1024, swz = sb ^ (((sb >> 9) & 1) << 5); R = (st >> 1) * 16 + swz / 64; C = (st & 1) * 32 + (swz % 64) / 2; }
__host__ __device__ __forceinline__ int perm32(int rho) { const int n = rho >> 4, i = rho & 15; return 8 * (i >> 2) + 4 * n + (i & 3); }

struct Unit { int pm, pn, pb, e; };
struct Gemm { const bf16_t* A; const bf16_t* Bt; int M, N, K, lda; };

struct StaticOrder {
    int nM, nN, nwg, G, c;
    __host__ __device__ void init(int M, int N, int G_, int c_) { nM = M / BM; nN = N / BM; nwg = nM * nN; G = G_; c = c_; }
    __host__ __device__ bool next(int i, Unit& u) const {
        const long L = (long)i * G + c; if (L >= nwg) return false;
        int wgid = (int)L; { const int q = nwg / NXCD, r = nwg % NXCD, xcd = wgid % NXCD, off = wgid / NXCD; wgid = (xcd < r ? xcd * (q + 1) : r * (q + 1) + (xcd - r) * q) + off; }
        const int nig = WGM * nN, gid = wgid / nig, fm = gid * WGM, gsz = (nM - fm) < WGM ? (nM - fm) : WGM;
        u.pm = fm + ((wgid % nig) % gsz); u.pn = (wgid % nig) / gsz; u.pb = u.pn; u.e = 0; return true;
    }
    __device__ __forceinline__ void a_ready(const Unit&) const {}
    __device__ __forceinline__ void done(const Unit&) const {}
};
__device__ __forceinline__ unsigned cvt_pk_bf16(float lo, float hi) { unsigned r; asm volatile("v_cvt_pk_bf16_f32 %0, %1, %2" : "=v"(r) : "v"(lo), "v"(hi)); return r; }
__device__ __forceinline__ float bflo(unsigned w) { return __uint_as_float(w << 16); }
__device__ __forceinline__ float bfhi(unsigned w) { return __uint_as_float(w & 0xffff0000u); }
__device__ __forceinline__ float sigmoidf_(float z) { return 1.0f / (1.0f + __expf(-z)); }

struct EpiStore {
    static constexpr bool PERM = true, AFTER_DRAIN = false;
    bf16_t* O; int ldc;
    __device__ __forceinline__ void operator()(const f32x4 (&acc)[2][2][4][2], const Unit& u, int wr, int wc, int fr, int fq) const {
        const int row0 = u.pm * BM + wr * 64 + fr, col0 = u.pn * BM + wc * 32 + 8 * fq;
#pragma unroll
        for (int ai = 0; ai < 2; ++ai)
#pragma unroll
            for (int m = 0; m < 4; ++m) { bf16_t* rowp = O + (size_t)(row0 + ai * HALF + m * 16) * ldc + col0;
#pragma unroll
                for (int bj = 0; bj < 2; ++bj) { const f32x4 v0 = acc[ai][bj][m][0], v1 = acc[ai][bj][m][1];
                    u32x4 w; w.x = cvt_pk_bf16(v0[0], v0[1]); w.y = cvt_pk_bf16(v0[2], v0[3]); w.z = cvt_pk_bf16(v1[0], v1[1]); w.w = cvt_pk_bf16(v1[2], v1[3]);
                    *(u32x4*)(rowp + bj * HALF) = w; } }
    }
};
struct EpiGlu {
    static constexpr bool PERM = true, AFTER_DRAIN = false;
    const bf16_t* Y; bf16_t* O; int ldo, ocol0; const float* bias;
    __device__ __forceinline__ void operator()(const f32x4 (&acc)[2][2][4][2], const Unit& u, int wr, int wc, int fr, int fq) const {
        const int row0 = u.pm * BM + wr * 64 + fr, col0 = u.pn * BM + wc * 32 + 8 * fq;
        f32x4 bv[2][2];
#pragma unroll
        for (int bj = 0; bj < 2; ++bj)
#pragma unroll
            for (int n = 0; n < 2; ++n) bv[bj][n] = *(const f32x4*)(bias + col0 + bj * HALF + 4 * n);
#pragma unroll
        for (int ai = 0; ai < 2; ++ai)
#pragma unroll
            for (int m = 0; m < 4; ++m) { const size_t row = (size_t)(row0 + ai * HALF + m * 16);
#pragma unroll
                for (int bj = 0; bj < 2; ++bj) { const int c = col0 + bj * HALF;
                    const u32x4 yv = *(const u32x4*)(Y + row * 512 + c);
                    const f32x4 z0 = acc[ai][bj][m][0] + bv[bj][0], z1 = acc[ai][bj][m][1] + bv[bj][1];
                    u32x4 w;
                    w.x = cvt_pk_bf16(bflo(yv.x) * sigmoidf_(z0[0]), bfhi(yv.x) * sigmoidf_(z0[1]));
                    w.y = cvt_pk_bf16(bflo(yv.y) * sigmoidf_(z0[2]), bfhi(yv.y) * sigmoidf_(z0[3]));
                    w.z = cvt_pk_bf16(bflo(yv.z) * sigmoidf_(z1[0]), bfhi(yv.z) * sigmoidf_(z1[1]));
                    w.w = cvt_pk_bf16(bflo(yv.w) * sigmoidf_(z1[2]), bfhi(yv.w) * sigmoidf_(z1[3]));
                    *(u32x4*)(O + row * ldo + ocol0 + c) = w; } }
    }
};
struct EpiResid {
    static constexpr bool PERM = false, AFTER_DRAIN = false;
    const float* base_ctx; const float* base_lat; float* out; const float* gate; int tile0;
    __device__ __forceinline__ void operator()(const f32x4 (&acc)[2][2][4][2], const Unit& u, int wr, int wc, int fr, int fq) const {
        const int gt = u.pm + tile0, bidx = gt < 8 ? 8 : ((gt - 8) >> 4);
        const float* bt = gt < 8 ? base_ctx + (size_t)gt * 256 * 1024 : base_lat + (size_t)(gt - 8) * 256 * 1024;
        float* ot = out + (size_t)gt * 256 * 1024;
        const int col0 = u.pn * BM + wc * 32 + 4 * fq;
        f32x4 gv[2][2];
#pragma unroll
        for (int bj = 0; bj < 2; ++bj)
#pragma unroll
            for (int n = 0; n < 2; ++n) gv[bj][n] = *(const f32x4*)(gate + bidx * 6144 + col0 + bj * HALF + n * 16);
#pragma unroll
        for (int ai = 0; ai < 2; ++ai)
#pragma unroll
            for (int m = 0; m < 4; ++m) { const size_t off = (size_t)(wr * 64 + fr + ai * HALF + m * 16) * 1024 + col0;
#pragma unroll
                for (int bj = 0; bj < 2; ++bj)
#pragma unroll
                    for (int n = 0; n < 2; ++n) { const f32x4 bs = *(const f32x4*)(bt + off + bj * HALF + n * 16);
                        *(f32x4*)(ot + off + bj * HALF + n * 16) = bs + gv[bj][n] * acc[ai][bj][m][n]; } }
    }
};
struct EpiSwiglu {
    static constexpr bool PERM = true, AFTER_DRAIN = false;
    bf16_t* ACT; const float* bgu;
    __device__ __forceinline__ void operator()(const f32x4 (&acc)[2][2][4][2], const Unit& u, int wr, int wc, int fr, int fq) const {
        const int row0 = u.pm * BM + wr * 64 + fr, lc0 = u.pn * 128 + wc * 32 + 8 * fq;
        const float* bb = bgu + (size_t)u.e * 2048 + lc0;
        f32x4 bg[2], bl[2];
#pragma unroll
        for (int n = 0; n < 2; ++n) { bg[n] = *(const f32x4*)(bb + 4 * n); bl[n] = *(const f32x4*)(bb + 1024 + 4 * n); }
#pragma unroll
        for (int ai = 0; ai < 2; ++ai)
#pragma unroll
            for (int m = 0; m < 4; ++m) { float a[8];
#pragma unroll
                for (int n = 0; n < 2; ++n)
#pragma unroll
                    for (int j = 0; j < 4; ++j) { const float g = fminf(acc[ai][0][m][n][j] + bg[n][j], 7.0f); float l = acc[ai][1][m][n][j] + bl[n][j]; l = fminf(fmaxf(l, -7.0f), 7.0f);
                        a[4 * n + j] = g * sigmoidf_(1.702f * g) * (l + 1.0f); }
                u32x4 w; w.x = cvt_pk_bf16(a[0], a[1]); w.y = cvt_pk_bf16(a[2], a[3]); w.z = cvt_pk_bf16(a[4], a[5]); w.w = cvt_pk_bf16(a[6], a[7]);
                *(u32x4*)(ACT + (size_t)(row0 + ai * HALF + m * 16) * 1024 + lc0) = w; }
    }
};
struct EpiDown {
    static constexpr bool PERM = true, AFTER_DRAIN = false;
    bf16_t* Y; const int* elist; const PG8_LAS int* tpos; const PG8_LAS int* tcnt; const float* w_slot; const float* bdn;
    __device__ __forceinline__ void operator()(const f32x4 (&acc)[2][2][4][2], const Unit& u, int wr, int wc, int fr, int fq) const {
        const int col0 = u.pn * BM + wc * 32 + 8 * fq, tp0 = tpos[u.pm], tc0 = tcnt[u.pm]; const int* el = elist + (size_t)u.e * 34816;
        f32x4 bv[2][2];
#pragma unroll
        for (int bj = 0; bj < 2; ++bj)
#pragma unroll
            for (int n = 0; n < 2; ++n) bv[bj][n] = *(const f32x4*)(bdn + (size_t)u.e * 1024 + col0 + bj * HALF + 4 * n);
#pragma unroll
        for (int ai = 0; ai < 2; ++ai)
#pragma unroll
            for (int m = 0; m < 4; ++m) { const int pos = tp0 + wr * 64 + fr + ai * HALF + m * 16; const int slot = pos < tc0 ? el[pos] : -1;
                if (slot >= 0) { const float ws = w_slot[slot]; bf16_t* rowp = Y + (size_t)slot * 1024 + col0;
#pragma unroll
                    for (int bj = 0; bj < 2; ++bj) { const f32x4 v0 = (acc[ai][bj][m][0] + bv[bj][0]) * ws, v1 = (acc[ai][bj][m][1] + bv[bj][1]) * ws;
                        u32x4 w; w.x = cvt_pk_bf16(v0[0], v0[1]); w.y = cvt_pk_bf16(v0[2], v0[3]); w.z = cvt_pk_bf16(v1[0], v1[1]); w.w = cvt_pk_bf16(v1[2], v1[3]);
                        *(u32x4*)(rowp + bj * HALF) = w; } } }
    }
};
struct MoeOrder {
    const PG8_LAS unsigned char* tile_e; int ntiles, NT, G, c; const int* elist; const PG8_LAS int* tpos; const PG8_LAS int* tcnt; int row0;
    __device__ __forceinline__ int rowidx(const Unit& u, int r) const { const int pos = tpos[u.pm] + r; const int s = pos < tcnt[u.pm] ? elist[(size_t)u.e * 34816 + pos] : 0; return row0 + (s >> 2); }
    __device__ __forceinline__ bool next(int i, Unit& u) const {
        const int L = i * G + c; if (L >= ntiles * NT) return false;
        const int T = L / NT; u.pm = T; u.pn = L - T * NT; u.e = __builtin_amdgcn_readfirstlane((int)tile_e[T]); u.pb = u.e * NT + u.pn; return true;
    }
    __device__ __forceinline__ void a_ready(const Unit&) const {}
    __device__ __forceinline__ void done(const Unit&) const {}
};

struct EpiStoreU {
    static constexpr bool PERM = true, AFTER_DRAIN = false;
    bf16_t* O; int ldc; bf16_t* A2;
    __device__ __forceinline__ void operator()(const f32x4 (&acc)[2][2][4][2], const Unit& u, int wr, int wc, int fr, int fq) const {
        const int row0 = u.pm * BM + wr * 64 + fr, col0 = u.pn * BM + wc * 32 + 8 * fq;
#pragma unroll
        for (int ai = 0; ai < 2; ++ai)
#pragma unroll
            for (int m = 0; m < 4; ++m) { const int R = row0 + ai * HALF + m * 16; bf16_t* rowp = O + (size_t)R * ldc + col0;
                int r, t; if (R < 2048) { r = (R >> 8) * 272 + ((R & 255) >> 4); t = R & 15; } else { const int R2 = R - 2048; r = (R2 >> 12) * 272 + 16 + ((R2 & 4095) >> 4); t = R2 & 15; }
#pragma unroll
                for (int bj = 0; bj < 2; ++bj) { const f32x4 v0 = acc[ai][bj][m][0], v1 = acc[ai][bj][m][1];
                    u32x4 w; w.x = cvt_pk_bf16(v0[0], v0[1]); w.y = cvt_pk_bf16(v0[2], v0[3]); w.z = cvt_pk_bf16(v1[0], v1[1]); w.w = cvt_pk_bf16(v1[2], v1[3]);
                    *(u32x4*)(rowp + bj * HALF) = w;
                    if (u.pn >= 6) { const int g = (u.pn - 6) * 16 + bj * 8 + wc * 2 + (fq >> 1);
                        *(u32x4*)(A2 + ((size_t)g * 2304 + r) * 512 + t * 16 + (fq & 1) * 8) = w; } } }
    }
};
struct EpiF32Plain {
    static constexpr bool PERM = true, AFTER_DRAIN = false;
    float* C;
    __device__ __forceinline__ void operator()(const f32x4 (&acc)[2][2][4][2], const Unit& u, int wr, int wc, int fr, int fq) const {
        float* base = C + (size_t)(u.pm * BM + wr * 64 + fr) * 256 + wc * 32 + 8 * fq;
#pragma unroll
        for (int ai = 0; ai < 2; ++ai)
#pragma unroll
            for (int m = 0; m < 4; ++m) {
#pragma unroll
                for (int bj = 0; bj < 2; ++bj) { float* p = base + (ai * HALF + m * 16) * 256 + bj * HALF;
                    *(f32x4*)p = acc[ai][bj][m][0]; *(f32x4*)(p + 4) = acc[ai][bj][m][1]; } }
    }
};
struct EpiS5Out {
    static constexpr bool PERM = true, AFTER_DRAIN = false;
    const bf16_t* A2; bf16_t* YP; const float* dskip;
    __device__ __forceinline__ void operator()(const f32x4 (&acc)[2][2][4][2], const Unit& u, int wr, int wc, int fr, int fq) const {
        const int g = u.e;
#pragma unroll
        for (int ai = 0; ai < 2; ++ai)
#pragma unroll
            for (int m = 0; m < 4; ++m) { const int rr = (u.pm - g * 9) * BM + wr * 64 + fr + ai * HALF + m * 16;
                if (rr < 2176) { const int b = rr / 272, n = rr - b * 272;
                    const int tok0 = n < 16 ? b * 256 + n * 16 : 2048 + b * 4096 + (n - 16) * 16;
#pragma unroll
                    for (int bj = 0; bj < 2; ++bj) { const int col = bj * HALF + wc * 32 + 8 * fq, t = col >> 4, c0 = col & 15;
                        const u32x4 uv = *(const u32x4*)(A2 + ((size_t)g * 2304 + rr) * 512 + col);
                        const f32x4 d0 = *(const f32x4*)(dskip + g * 16 + c0), d1 = *(const f32x4*)(dskip + g * 16 + c0 + 4);
                        float y[8];
                        y[0] = acc[ai][bj][m][0][0] + d0[0] * bflo(uv.x); y[1] = acc[ai][bj][m][0][1] + d0[1] * bfhi(uv.x); y[2] = acc[ai][bj][m][0][2] + d0[2] * bflo(uv.y); y[3] = acc[ai][bj][m][0][3] + d0[3] * bfhi(uv.y);
                        y[4] = acc[ai][bj][m][1][0] + d1[0] * bflo(uv.z); y[5] = acc[ai][bj][m][1][1] + d1[1] * bfhi(uv.z); y[6] = acc[ai][bj][m][1][2] + d1[2] * bflo(uv.w); y[7] = acc[ai][bj][m][1][3] + d1[3] * bfhi(uv.w);
#pragma unroll
                        for (int j = 0; j < 8; ++j) { const float z = y[j], th = 0.7978845608f * (z + 0.044715f * z * z * z); const float e2 = __expf(2.0f * th); y[j] = 0.5f * z * (1.0f + (1.0f - 2.0f / (e2 + 1.0f))); }
                        u32x4 w; w.x = cvt_pk_bf16(y[0], y[1]); w.y = cvt_pk_bf16(y[2], y[3]); w.z = cvt_pk_bf16(y[4], y[5]); w.w = cvt_pk_bf16(y[6], y[7]);
                        *(u32x4*)(YP + (size_t)(tok0 + t) * 512 + g * 16 + c0) = w; } } }
    }
};
struct GroupOrder {
    int tpg, nunits, G, c;
    __device__ __forceinline__ bool next(int i, Unit& u) const { const int L = i * G + c; if (L >= nunits) return false; u.pm = L; u.pn = 0; u.e = L / tpg; u.pb = u.e; return true; }
    __device__ __forceinline__ void a_ready(const Unit&) const {}
    __device__ __forceinline__ void done(const Unit&) const {}
};
template <class Epi, class Sched, bool ALIGN_EPI = false, bool SP2 = false, bool GATHER = false>
__device__ __forceinline__ void gemm_phase(PG8_LAS unsigned char* lds, const Gemm g, const Sched& S, const Epi& E) {
    static_assert(!GATHER || SP2, "gathered A staging is implemented in the SP2 loop only");
    const int tid = threadIdx.x, wid = __builtin_amdgcn_readfirstlane(tid >> 6), lane = tid & 63, wr = wid >> 2, wc = wid & 3, fr = lane & 15, fq = lane >> 4;
    int K_ = g.K; asm volatile("" : "+s"(K_));
    const int K = K_, nt = K / BK;
    unsigned voffA[2], voffB[2];
#pragma unroll
    for (int i = 0; i < 2; ++i) { int R, C; stage_rc(tid * 16 + i * 8192, R, C); const int Rb = Epi::PERM ? ((R & ~31) + perm32(R & 31)) : R;
        voffA[i] = (unsigned)(R * g.lda + C) * 2u; voffB[i] = (unsigned)(Rb * K + C) * 2u; }
    const size_t kstep = (size_t)(BK * 2);
    const size_t hstep = (size_t)HALF * K * 2;
    const size_t tstep = 2 * hstep;
    const size_t hstepA = (size_t)HALF * g.lda * 2, tstepA = 2 * hstepA;
    const unsigned ldsw = (unsigned)wid * 1024u;
    const int aoff = lds_byte(wr * 64 + fr, fq * 8), boff = lds_byte(wc * 32 + fr, fq * 8);
#define PG8_SA(b, h) (((b) * 2 + (h)) * HTB)
#define PG8_SB(b, h) ((4 + (b) * 2 + (h)) * HTB)
#define PG8_STAGE(bufoff, gbase, voff) do { _Pragma("unroll") for (int _i = 0; _i < 2; ++_i) \
        __builtin_amdgcn_global_load_lds((const unsigned*)((const char*)(gbase) + (voff)[_i]), (PG8_LAS unsigned*)(lds + (bufoff) + ldsw + _i * 8192), 16, 0, 0); } while (0)
#define PG8_STAGE_H0(bufoff, gbase) do { if constexpr (GATHER) PG8_STAGE(bufoff, gbase, voffA0); else PG8_STAGE(bufoff, gbase, voffA); } while (0)
#define PG8_STAGE_H1(bufoff, gbase) do { if constexpr (GATHER) PG8_STAGE(bufoff, gbase, voffA1); else PG8_STAGE(bufoff, (gbase) + hstepA, voffA); } while (0)
#define PG8_GOFF(unit, h, dst) do { _Pragma("unroll") for (int _i = 0; _i < 2; ++_i) { int _R, _C; stage_rc(tid * 16 + _i * 8192, _R, _C); dst[_i] = (unsigned)S.rowidx(unit, (h) * HALF + _R); } } while (0)
#define PG8_GCONV(dst, src) do { _Pragma("unroll") for (int _i = 0; _i < 2; ++_i) { int _R, _C; stage_rc(tid * 16 + _i * 8192, _R, _C); dst[_i] = (src[_i] * (unsigned)g.lda + (unsigned)_C) * 2u; } } while (0)
#define PG8_LDA(dst, b, h) do { _Pragma("unroll") for (int m = 0; m < 4; ++m) _Pragma("unroll") for (int k = 0; k < 2; ++k) dst[m][k] = *(const PG8_LAS bf16x8*)(lds + PG8_SA(b, h) + aoff + m * 2048 + k * 1024); } while (0)
#define PG8_LDB(dst, b, h) do { _Pragma("unroll") for (int n = 0; n < 2; ++n) _Pragma("unroll") for (int k = 0; k < 2; ++k) dst[n][k] = *(const PG8_LAS bf16x8*)(lds + PG8_SB(b, h) + boff + n * 2048 + k * 1024); } while (0)
#define PG8_MMA(ai, bj, At, Bt) do { __builtin_amdgcn_s_setprio(1); _Pragma("unroll") for (int m = 0; m < 4; ++m) _Pragma("unroll") for (int n = 0; n < 2; ++n) _Pragma("unroll") for (int k = 0; k < 2; ++k) \
        acc[ai][bj][m][n] = __builtin_amdgcn_mfma_f32_16x16x32_bf16(Bt[n][k], At[m][k], acc[ai][bj][m][n], 0, 0, 0); __builtin_amdgcn_s_setprio(0); } while (0)
#define PG8_WAIT_V(n) asm volatile("s_waitcnt vmcnt(" #n ")" ::: "memory")
#define PG8_WAIT_L(n) asm volatile("s_waitcnt lgkmcnt(" #n ")" ::: "memory")
#define PG8_BAR __builtin_amdgcn_s_barrier()
#define PG8_SCHED __builtin_amdgcn_sched_barrier(0)
    Unit cur, nxt; int ui = 0;
    if (!S.next(0, cur)) return;
    f32x4 acc[2][2][4][2];
#pragma unroll
    for (int a = 0; a < 2; ++a)
#pragma unroll
        for (int b = 0; b < 2; ++b)
#pragma unroll
            for (int m = 0; m < 4; ++m)
#pragma unroll
                for (int n = 0; n < 2; ++n) acc[a][b][m][n] = (f32x4){0.f, 0.f, 0.f, 0.f};
    bf16x8 At[4][2], B0[2][2], B1[2][2];
    const char* cA = (const char*)g.A + (GATHER ? (size_t)0 : (size_t)cur.pm * tstepA);
    unsigned voffA0[2] = {0u, 0u}, voffA1[2] = {0u, 0u}, nidx0[2] = {0u, 0u}, nidx1[2] = {0u, 0u};
    if constexpr (GATHER) { PG8_GOFF(cur, 0, nidx0); PG8_GOFF(cur, 1, nidx1); PG8_GCONV(voffA0, nidx0); PG8_GCONV(voffA1, nidx1); } const char* cB = (const char*)g.Bt + (size_t)cur.pb * tstep;
    S.a_ready(cur);
    if constexpr (SP2) {
        PG8_STAGE(PG8_SB(0, 0), cB, voffB); PG8_STAGE(PG8_SB(0, 1), cB + hstep, voffB); PG8_STAGE_H0(PG8_SA(0, 0), cA); PG8_STAGE_H1(PG8_SA(0, 1), cA);
        if (wr == 1) PG8_BAR;
        PG8_WAIT_V(2); PG8_BAR;
        PG8_STAGE(PG8_SB(1, 0), cB + kstep, voffB); PG8_STAGE_H0(PG8_SA(1, 0), cA + kstep); PG8_STAGE(PG8_SB(1, 1), cB + hstep + kstep, voffB);
        PG8_WAIT_V(6); PG8_BAR;
    } else {
        PG8_STAGE(PG8_SB(0, 0), cB, voffB); PG8_STAGE_H0(PG8_SA(0, 0), cA); PG8_STAGE(PG8_SB(0, 1), cB + hstep, voffB); PG8_STAGE_H1(PG8_SA(0, 1), cA);
        if (wr == 1) PG8_BAR;
        PG8_WAIT_V(4); PG8_BAR;
        PG8_STAGE(PG8_SB(1, 0), cB + kstep, voffB); PG8_STAGE_H0(PG8_SA(1, 0), cA + kstep); PG8_STAGE(PG8_SB(1, 1), cB + hstep + kstep, voffB);
        PG8_WAIT_V(6); PG8_BAR;
    }
    for (;;) {
        const bool has_next = S.next(ui + 1, nxt);
        const char* nA = (has_next && !GATHER) ? (const char*)g.A + (size_t)nxt.pm * tstepA : cA; const char* nB = has_next ? (const char*)g.Bt + (size_t)nxt.pb * tstep : cB;
        for (int t = 0; t < nt; t += 2) {
            const bool last = (t == nt - 2);
            const char* a1 = cA + (size_t)(t + 1) * kstep;
            const char* a2 = last ? nA : cA + (size_t)(t + 2) * kstep; const char* b2 = last ? nB : cB + (size_t)(t + 2) * kstep;
            const char* a3 = a2 + kstep; const char* b3 = b2 + kstep;
            if (last && has_next) S.a_ready(nxt);
            if constexpr (GATHER) { if (has_next && t == nt - 4) { PG8_GOFF(nxt, 0, nidx0); PG8_GOFF(nxt, 1, nidx1); }
                                    if (has_next && last) PG8_GCONV(voffA0, nidx0); }
            if constexpr (SP2) {
            PG8_LDB(B0, 0, 0); PG8_LDB(B1, 0, 1); PG8_SCHED; PG8_LDA(At, 0, 0); PG8_STAGE_H1(PG8_SA(1, 1), a1);
            if constexpr (GATHER) { if (has_next && last) PG8_GCONV(voffA1, nidx1); }
            PG8_WAIT_V(8); PG8_WAIT_L(0); PG8_BAR; PG8_MMA(0, 0, At, B0); PG8_MMA(0, 1, At, B1); PG8_BAR; PG8_SCHED;
            PG8_LDA(At, 0, 1); PG8_STAGE(PG8_SB(0, 0), b2, voffB); PG8_STAGE(PG8_SB(0, 1), b2 + hstep, voffB); PG8_STAGE_H0(PG8_SA(0, 0), a2);
            PG8_WAIT_V(8); PG8_WAIT_L(0); PG8_BAR; PG8_MMA(1, 0, At, B0); PG8_MMA(1, 1, At, B1); PG8_BAR; PG8_SCHED;
            PG8_LDB(B0, 1, 0); PG8_LDB(B1, 1, 1); PG8_SCHED; PG8_LDA(At, 1, 0); PG8_STAGE_H1(PG8_SA(0, 1), a2);
            PG8_WAIT_V(8); PG8_WAIT_L(0); PG8_BAR; PG8_MMA(0, 0, At, B0); PG8_MMA(0, 1, At, B1); PG8_BAR; PG8_SCHED;
            PG8_LDA(At, 1, 1); PG8_STAGE(PG8_SB(1, 0), b3, voffB); PG8_STAGE(PG8_SB(1, 1), b3 + hstep, voffB); PG8_STAGE_H0(PG8_SA(1, 0), a3);
            PG8_WAIT_V(8); PG8_WAIT_L(0); PG8_BAR; PG8_MMA(1, 0, At, B0); PG8_MMA(1, 1, At, B1); PG8_BAR; PG8_SCHED;
            } else {
            PG8_LDB(B0, 0, 0); PG8_SCHED; PG8_LDA(At, 0, 0); PG8_STAGE(PG8_SA(1, 1), a1 + hstepA, voffA);
            PG8_WAIT_L(8); PG8_BAR; PG8_WAIT_L(0); PG8_MMA(0, 0, At, B0); PG8_BAR; PG8_SCHED;
            PG8_LDB(B1, 0, 1); PG8_STAGE(PG8_SB(0, 0), b2, voffB);
            PG8_BAR; PG8_WAIT_L(0); PG8_MMA(0, 1, At, B1); PG8_BAR;
            PG8_LDA(At, 0, 1); PG8_STAGE(PG8_SA(0, 0), a2, voffA);
            PG8_BAR; PG8_WAIT_L(0); PG8_MMA(1, 0, At, B0); PG8_BAR; PG8_SCHED;
            PG8_STAGE(PG8_SB(0, 1), b2 + hstep, voffB);
            PG8_WAIT_V(6); PG8_BAR; PG8_MMA(1, 1, At, B1); PG8_BAR;
            PG8_LDB(B0, 1, 0); PG8_SCHED; PG8_LDA(At, 1, 0); PG8_STAGE(PG8_SA(0, 1), a2 + hstepA, voffA);
            PG8_WAIT_L(8); PG8_BAR; PG8_WAIT_L(0); PG8_MMA(0, 0, At, B0); PG8_BAR; PG8_SCHED;
            PG8_LDB(B1, 1, 1); PG8_STAGE(PG8_SB(1, 0), b3, voffB);
            PG8_BAR; PG8_WAIT_L(0); PG8_MMA(0, 1, At, B1); PG8_BAR;
            PG8_LDA(At, 1, 1); PG8_STAGE(PG8_SA(1, 0), a3, voffA);
            PG8_BAR; PG8_WAIT_L(0); PG8_MMA(1, 0, At, B0); PG8_BAR; PG8_SCHED;
            PG8_STAGE(PG8_SB(1, 1), b3 + hstep, voffB);
            PG8_WAIT_V(6); PG8_BAR; PG8_MMA(1, 1, At, B1); PG8_BAR;
            }
        }
        if constexpr (ALIGN_EPI) { if (wr == 0) PG8_BAR; }
        if constexpr (!Epi::AFTER_DRAIN) { E(acc, cur, wr, wc, fr, fq); S.done(cur); }
        if (!has_next) break;
#pragma unroll
        for (int a = 0; a < 2; ++a)
#pragma unroll
            for (int b = 0; b < 2; ++b)
#pragma unroll
                for (int m = 0; m < 4; ++m)
#pragma unroll
                    for (int n = 0; n < 2; ++n) acc[a][b][m][n] = (f32x4){0.f, 0.f, 0.f, 0.f};
        cur = nxt; cA = nA; cB = nB; ++ui;
        if constexpr (ALIGN_EPI) { if (wr == 1) PG8_BAR; }
    }
    PG8_WAIT_V(0);
    if constexpr (!ALIGN_EPI) { if (wr == 0) PG8_BAR; }
    PG8_BAR;
    if constexpr (Epi::AFTER_DRAIN) { E.fused(acc, cur, wr, wc, fr, fq, lds, wid, lane); S.done(cur); }
#undef PG8_SA
#undef PG8_SB
#undef PG8_STAGE
#undef PG8_STAGE_H0
#undef PG8_STAGE_H1
#undef PG8_GOFF
#undef PG8_GCONV
#undef PG8_LDA
#undef PG8_LDB
#undef PG8_MMA
#undef PG8_WAIT_V
#undef PG8_WAIT_L
#undef PG8_BAR
#undef PG8_SCHED
}
}
constexpr int NWAVES = 8, NTHR = 512;
constexpr int D = 1024, NB = 8, SEQ = 4096, CTX = 256;
constexpr int NCTX = NB * CTX, NLAT = NB * SEQ, MALL = NCTX + NLAT;
constexpr int N0 = 2304, N1 = 6144;
constexpr int C0_Q = 0, C0_K = 256, C0_V = 512, C0_G = 1024, C0_U = 1536, C0_LOW = 2048;
constexpr int C1_Q = 0, C1_K = 1024, C1_V = 2048, C1_G = 4096;
constexpr int NE = 32, MAXTILES = 576;
constexpr float EPS = 1e-6f;
constexpr int NPH = 24;
enum { PH_PRO = 0, PH_NORM1, PH_INPROJ0, PH_GLAPREP, PH_GLA, PH_S5, PH_FIN0, PH_GLU, PH_OUT0, PH_ROUTER0, PH_GATHER0, PH_GU0, PH_DOWN0, PH_COMB0,
       PH_INPROJ1, PH_ROPE, PH_RET, PH_FIN1, PH_OUT1, PH_ROUTER1, PH_GATHER1, PH_GU1, PH_DOWN1, PH_COMB1 };
#ifndef MK_NAIVE_GLA
#define MK_NAIVE_GLA 0
#endif
#ifndef MK_NAIVE_S5
#define MK_NAIVE_S5 0
#endif
#ifndef MK_NAIVE_RET
#define MK_NAIVE_RET 0
#endif
constexpr size_t MiB = 1u << 20;
constexpr size_t WS_CTL = 0, CTL_ZERO_BYTES = 1 * MiB;
constexpr size_t WS_MOD = 1 * MiB;
constexpr size_t WS_WIN0T = 2 * MiB, WS_WOUT0T = 7 * MiB, WS_WGLUT = 9 * MiB, WS_WIN1T = 10 * MiB, WS_WOUT1T = 22 * MiB;
constexpr size_t WS_SELE = 26 * MiB, WS_WSLOT = 27 * MiB, WS_SPOS = 28 * MiB, WS_PROW = 29 * MiB;
constexpr size_t WS_WGUT = 32 * MiB, WS_WDNT = 288 * MiB;
constexpr size_t WS_XRES = 416 * MiB, WS_H = 552 * MiB, WS_MIX = 620 * MiB, WS_YPRE = 688 * MiB;
constexpr size_t WS_PROJ = 748 * MiB, WS_OREC = 1156 * MiB;
constexpr size_t WS_XG = 748 * MiB, WS_ACT = 1036 * MiB, WS_YSLOT = 1324 * MiB;
constexpr size_t WS_S5W1 = 1556 * MiB, WS_S5W2 = 1560 * MiB, WS_A2 = 1568 * MiB, WS_SLOC = 1668 * MiB;
constexpr size_t WS_ELIST = 1740 * MiB;
constexpr size_t WS_END = 1746 * MiB;
constexpr int CW_TMO = 0, CW_BAR = 4096, CW_GCNT = 16384;
constexpr int RING_BYTES = 131072, LDSCTL_OFF = RING_BYTES, LDS_BYTES = 147456;
constexpr int L_MISC = LDSCTL_OFF;
constexpr int L_TILEE = LDSCTL_OFF + 256;
constexpr int L_TSTART = LDSCTL_OFF + 1024;
constexpr int L_LCNT = LDSCTL_OFF + 1280;
constexpr int L_GBASE = LDSCTL_OFF + 1536;
constexpr int L_BLKE = LDSCTL_OFF + 2048;
constexpr int L_BLKP = LDSCTL_OFF + 5120;
constexpr int L_TPOS = L_BLKE, L_TCNT = L_BLKP;

#define GAS __attribute__((address_space(1)))
#define LAS __attribute__((address_space(3)))
typedef unsigned short bf16;
typedef unsigned v4u __attribute__((ext_vector_type(4)));
typedef unsigned v2u __attribute__((ext_vector_type(2)));
typedef float f32x4 __attribute__((ext_vector_type(4)));
typedef GAS unsigned gu32;
#define RLX_AGENT __ATOMIC_RELAXED, __HIP_MEMORY_SCOPE_AGENT
#define LDS_WAIT() asm volatile("s_waitcnt lgkmcnt(0)" ::: "memory")
#define VM_WAIT() asm volatile("s_waitcnt vmcnt(0)" ::: "memory")
__device__ __forceinline__ unsigned f2bf(float f) { unsigned u = __builtin_bit_cast(unsigned, f); return (u + 0x7fffu + ((u >> 16) & 1u)) >> 16; }
__device__ __forceinline__ unsigned pk2(float lo, float hi) { return f2bf(lo) | (f2bf(hi) << 16); }
__device__ __forceinline__ float bf2f(unsigned b) { return __uint_as_float(b << 16); }
__device__ __forceinline__ float blo(unsigned w) { return __uint_as_float(w << 16); }
__device__ __forceinline__ float bhi(unsigned w) { return __uint_as_float(w & 0xffff0000u); }
__device__ __forceinline__ float wave_sum(float v) {
#pragma unroll
    for (int o = 1; o < 64; o <<= 1) v += __shfl_xor(v, o);
    return v;
}
__device__ __forceinline__ float silu_(float z) { return z / (1.0f + __expf(-z)); }
#define XB_TMO      128
#define XB_XCNT(j)  (256  + 64 * (j))
#define XB_XSUB(j)  (1280 + 64 * (j))
#define XB_XGEN(j)  (2304 + 64 * (j))
#define XB_TOP      3328
#define XB_TOPGEN   3392
#define XCD_BAR_WORDS 3456
#define XB_SPIN_CAP (1u << 22)

__device__ __forceinline__ unsigned xb_ld(unsigned* p)              { return __hip_atomic_load(p, __ATOMIC_RELAXED, __HIP_MEMORY_SCOPE_AGENT); }
__device__ __forceinline__ unsigned xb_add(unsigned* p, unsigned v) { return __hip_atomic_fetch_add(p, v, __ATOMIC_RELAXED, __HIP_MEMORY_SCOPE_AGENT); }
__device__ __forceinline__ unsigned xb_xcc_id() { return (unsigned)__builtin_amdgcn_s_getreg((3 << 11) | 20) & 0xFu; }
#define XB_SPIN(cond, bar) do { unsigned _sp = 0; while (cond) { __builtin_amdgcn_s_sleep(1); \
    if ((++_sp & 255u) == 0u) { if (xb_ld(&(bar)[XB_TMO])) break; if (_sp > XB_SPIN_CAP) { atomicAdd(&(bar)[XB_TMO], 1u); break; } } } } while (0)

struct XcdBarrier {
    unsigned* bar; unsigned x;
    volatile LAS unsigned* st;
};

__device__ __forceinline__ XcdBarrier xcd_barrier_post(unsigned* bar, volatile LAS unsigned* st) {
    XcdBarrier b; b.bar = bar; b.x = xb_xcc_id(); b.st = st;
    if (threadIdx.x == 0) (void)xb_add(&bar[XB_XCNT(b.x)], 1u);
    return b;
}
__device__ __forceinline__ void xcd_barrier_complete(unsigned* bar, unsigned x, unsigned& nloc, unsigned& nx) {
    const unsigned G = gridDim.x * gridDim.y * gridDim.z;
    unsigned sum, cnt, mine, sp = 0u;
    for (;;) {
        sum = 0u; cnt = 0u; mine = 0u;
#pragma unroll
        for (unsigned j = 0; j < 16; ++j) { const unsigned c = xb_ld(&bar[XB_XCNT(j)]); sum += c; cnt += (c > 0u) ? 1u : 0u; mine = (j == x) ? c : mine; }
        if (sum == G) break;
        __builtin_amdgcn_s_sleep(1);
        if ((++sp & 255u) == 0u) { if (xb_ld(&bar[XB_TMO])) break; if (sp > XB_SPIN_CAP) { atomicAdd(&bar[XB_TMO], 1u); break; } }
    }
    nloc = mine > 0u ? mine : 1u; nx = cnt > 0u ? cnt : 1u;
}

__device__ __forceinline__ void xcd_barrier(const XcdBarrier& b) {
    asm volatile("s_waitcnt vmcnt(0)" ::: "memory");
    __syncthreads();
    if (threadIdx.x == 0) {
        unsigned* bar = b.bar;
        __builtin_amdgcn_s_waitcnt(0);
        unsigned nloc = b.st[0], nx = b.st[1];
        if (nloc == 0u) { xcd_barrier_complete(bar, b.x, nloc, nx); b.st[0] = nloc; b.st[1] = nx; }
        const unsigned old = xb_add(&bar[XB_XSUB(b.x)], 1u);
        const unsigned gen = old / nloc;
        if (old + 1u == (gen + 1u) * nloc) {
            __builtin_amdgcn_fence(__ATOMIC_RELEASE, "agent");
            asm volatile("s_waitcnt vmcnt(0)" ::: "memory");
            const unsigned og = xb_add(&bar[XB_TOP], 1u);
            const unsigned tg = og / nx;
            if (og + 1u == (tg + 1u) * nx) xb_add(&bar[XB_TOPGEN], 1u);
            else XB_SPIN(xb_ld(&bar[XB_TOPGEN]) == tg, bar);
            __builtin_amdgcn_fence(__ATOMIC_ACQUIRE, "agent");
            xb_add(&bar[XB_XGEN(b.x)], 1u);
            asm volatile("s_waitcnt vmcnt(0)" ::: "memory");
        } else {
            XB_SPIN(xb_ld(&bar[XB_XGEN(b.x)]) == gen, bar);
            __builtin_amdgcn_fence(__ATOMIC_ACQUIRE, "agent");
            asm volatile("s_waitcnt vmcnt(0)" ::: "memory");
        }
    }
    __syncthreads();
}
struct Args { const float* in[34]; float* out; unsigned char* ws; int ph_lo, ph_hi; };
#define CAS __attribute__((address_space(4)))
struct KA {
    const CAS unsigned char* p;
    __device__ __forceinline__ const float* I(int i) const { return *(const float* const CAS*)(p + 8 * i); }
    __device__ __forceinline__ float* OUT() const { return *(float* const CAS*)(p + 8 * 34); }
    __device__ __forceinline__ unsigned char* WS() const { return *(unsigned char* const CAS*)(p + 8 * 35); }
    __device__ __forceinline__ int LO() const { return *(const CAS int*)(p + 8 * 36); }
    __device__ __forceinline__ int HI() const { return *(const CAS int*)(p + 8 * 36 + 4); }
};
__device__ __forceinline__ KA ka_fresh() { KA a; a.p = (const CAS unsigned char*)__builtin_amdgcn_kernarg_segment_ptr(); asm volatile("" : "+s"(a.p)); return a; }
static_assert(sizeof(Args) == 8 * 36 + 8, "kernarg layout");
struct Frame {
    LAS unsigned char* lds;
    volatile LAS unsigned* MISC;
    unsigned* ctl;
    int tid, lane, wave, vcu, G;
};
enum { I_X = 0, I_C, I_CTX, I_CCTX, I_ADAW, I_ADAB, I_N1G, I_N2G, I_ABWIN, I_ABWOUT, I_GLAWA, I_GLABA, I_GLANG, I_LAMRE, I_LAMIM, I_LOGSTEP, I_BRE, I_BIM, I_CRE, I_CIM,
       I_S5D, I_GLUW, I_GLUB, I_RETWIN, I_RETWOUT, I_RETDEC, I_RETNG, I_WROUTER, I_BROUTER, I_WGU, I_BGU, I_WDN, I_BDN, I_FNG };

constexpr int S5_ROWS = 2304, S5_CH = 272;
struct S5Par { float lr, li, step; };
__device__ __forceinline__ void s5_cpow(float lr, float li, float step, float n, float& ar, float& ai) { const float mag = expf(lr * step * n); float s, c; sincosf(li * step * n, &s, &c); ar = mag * c; ai = mag * s; }
__device__ __forceinline__ void s5_zoh_f(float lr, float li, float step, float& fr, float& fi) { float ar, ai; s5_cpow(lr, li, step, 1.0f, ar, ai); const float den = lr * lr + li * li;
    fr = ((ar - 1.0f) * lr + ai * li) / den; fi = (ai * lr - (ar - 1.0f) * li) / den; }
__device__ __forceinline__ void s5_table_item(const KA& A, int kind, int idx, bf16* W1T, bf16* W2T, LAS float* scr, int lane) {
    if (kind == 0) {
        const int g = idx >> 8, n = idx & 255, dir = n >> 7, ri = (n >> 6) & 1, p = n & 63;
        const float lr = A.I(I_LAMRE)[(dir * 32 + g) * 64 + p], li = A.I(I_LAMIM)[(dir * 32 + g) * 64 + p], step = expf(A.I(I_LOGSTEP)[dir * 32 + g]);
        float fr, fi; s5_zoh_f(lr, li, step, fr, fi);
        const int t = lane >> 2, c0 = (lane & 3) * 4;
        float ar, ai; s5_cpow(lr, li, step, (float)(dir ? t : 15 - t), ar, ai);
        const float gr = ar * fr - ai * fi, gi = ar * fi + ai * fr;
        float o[4];
#pragma unroll
        for (int j = 0; j < 4; ++j) { const float br = A.I(I_BRE)[(g * 64 + p) * 16 + c0 + j], bi = A.I(I_BIM)[(g * 64 + p) * 16 + c0 + j]; o[j] = ri ? (gr * bi + gi * br) : (gr * br - gi * bi); }
        v2u w; w.x = pk2(o[0], o[1]); w.y = pk2(o[2], o[3]);
        *(GAS v2u*)(W1T + ((size_t)g * 256 + n) * 256 + 4 * lane) = w;
    } else if (kind == 1) {
        const int g = idx >> 8, n = idx & 255, t = n >> 4, cp = n & 15;
        const int dir = lane >> 5, ri = (lane >> 4) & 1, p0 = (lane & 15) * 4;
        const float step = expf(A.I(I_LOGSTEP)[dir * 32 + g]);
        float o[4];
#pragma unroll
        for (int j = 0; j < 4; ++j) { const int p = p0 + j;
            const float lr = A.I(I_LAMRE)[(dir * 32 + g) * 64 + p], li = A.I(I_LAMIM)[(dir * 32 + g) * 64 + p];
            float ar, ai; s5_cpow(lr, li, step, (float)(dir ? 16 - t : t + 1), ar, ai);
            const float cr = A.I(I_CRE)[((dir * 32 + g) * 16 + cp) * 64 + p], ci = A.I(I_CIM)[((dir * 32 + g) * 16 + cp) * 64 + p];
            o[j] = ri ? -(cr * ai + ci * ar) : (cr * ar - ci * ai); }
        v2u w; w.x = pk2(o[0], o[1]); w.y = pk2(o[2], o[3]);
        *(GAS v2u*)(W2T + ((size_t)g * 256 + n) * 512 + 256 + 4 * lane) = w;
    } else {
        const int g = idx >> 4, tau = idx & 15;
        {
#pragma unroll
            for (int dir = 0; dir < 2; ++dir) { const float lr = A.I(I_LAMRE)[(dir * 32 + g) * 64 + lane], li = A.I(I_LAMIM)[(dir * 32 + g) * 64 + lane], step = expf(A.I(I_LOGSTEP)[dir * 32 + g]);
                float fr, fi, ar, ai; s5_zoh_f(lr, li, step, fr, fi); s5_cpow(lr, li, step, (float)tau, ar, ai);
                scr[(dir * 64 + lane) * 2] = ar * fr - ai * fi; scr[(dir * 64 + lane) * 2 + 1] = ar * fi + ai * fr; }
        }
        LDS_WAIT(); asm volatile("" ::: "memory");
        const int cp = lane >> 2, c0 = (lane & 3) * 4;
        float kf[4] = {0.f, 0.f, 0.f, 0.f}, kb2[4] = {0.f, 0.f, 0.f, 0.f};
        for (int p = 0; p < 64; ++p) {
            const f32x4 b4r = *(const f32x4*)(A.I(I_BRE) + (g * 64 + p) * 16 + c0), b4i = *(const f32x4*)(A.I(I_BIM) + (g * 64 + p) * 16 + c0);
#pragma unroll
            for (int dir = 0; dir < 2; ++dir) { const float gr = scr[(dir * 64 + p) * 2], gi = scr[(dir * 64 + p) * 2 + 1];
                const float cr = A.I(I_CRE)[((dir * 32 + g) * 16 + cp) * 64 + p], ci = A.I(I_CIM)[((dir * 32 + g) * 16 + cp) * 64 + p];
#pragma unroll
                for (int j = 0; j < 4; ++j) { const float xr = gr * b4r[j] - gi * b4i[j], xi = gr * b4i[j] + gi * b4r[j]; const float v = cr * xr - ci * xi;
                    if (dir == 0) kf[j] += v; else kb2[j] += v; } }
        }
        LDS_WAIT(); asm volatile("" ::: "memory");
        bf16* Wg = W2T + (size_t)g * 256 * 512;
        if (tau == 0) { v2u w; w.x = pk2(kf[0] + kb2[0], kf[1] + kb2[1]); w.y = pk2(kf[2] + kb2[2], kf[3] + kb2[3]);
            for (int t = 0; t < 16; ++t) *(GAS v2u*)(Wg + (size_t)(t * 16 + cp) * 512 + t * 16 + c0) = w;
        } else { v2u wf, wb; wf.x = pk2(kf[0], kf[1]); wf.y = pk2(kf[2], kf[3]); wb.x = pk2(kb2[0], kb2[1]); wb.y = pk2(kb2[2], kb2[3]);
            for (int t = tau; t < 16; ++t) *(GAS v2u*)(Wg + (size_t)(t * 16 + cp) * 512 + (t - tau) * 16 + c0) = wf;
            for (int t = 0; t + tau < 16; ++t) *(GAS v2u*)(Wg + (size_t)(t * 16 + cp) * 512 + (t + tau) * 16 + c0) = wb; }
    }
}
__device__ __forceinline__ void p_s5_scan(Frame& F, const float* SLOC, bf16* A2) {
    const KA A = ka_fresh();
    if (F.tid >= 128) return;
    for (int idx = F.vcu * 128 + F.tid; idx < NB * 32 * 2 * 64; idx += F.G * 128) {
        const int p = idx & 63, dir = (idx >> 6) & 1, g = (idx >> 7) & 31, b = idx >> 12;
        const float lr = A.I(I_LAMRE)[(dir * 32 + g) * 64 + p], li = A.I(I_LAMIM)[(dir * 32 + g) * 64 + p], step = expf(A.I(I_LOGSTEP)[dir * 32 + g]);
        float ar, ai; s5_cpow(lr, li, step, 16.0f, ar, ai);
        float sr = 0.f, si = 0.f;
        const size_t rbase = (size_t)g * S5_ROWS + (size_t)b * S5_CH;
        for (int q0 = 0; q0 < S5_CH; q0 += 8) {
            float lre[8], lim[8];
#pragma unroll
            for (int u = 0; u < 8; ++u) { const int q = q0 + u, n = dir ? (q < 16 ? 15 - q : 271 - (q - 16)) : q; const float* sp = SLOC + (rbase + n) * 256 + dir * 128 + p; lre[u] = sp[0]; lim[u] = sp[64]; }
#pragma unroll
            for (int u = 0; u < 8; ++u) { const int q = q0 + u, n = dir ? (q < 16 ? 15 - q : 271 - (q - 16)) : q; bf16* ap = A2 + (rbase + n) * 512 + 256 + dir * 128 + p;
                ap[0] = (bf16)f2bf(sr); ap[64] = (bf16)f2bf(si);
                const float nr = ar * sr - ai * si + lre[u], ni = ar * si + ai * sr + lim[u]; sr = nr; si = ni; }
        }
    }
}
__device__ __forceinline__ void tr_item(const float* src, int ldsrc, int K, int srccol, float scale, bf16* dst, int dstrow0, int k0, LAS float* scr, int lane) {
    if (srccol >= 0) {
        float t[32]; const float* sp = src + (size_t)(k0 + (lane >> 5)) * ldsrc + srccol + (lane & 31);
#pragma unroll
        for (int i = 0; i < 32; ++i) t[i] = sp[(size_t)(2 * i) * ldsrc];
#pragma unroll
        for (int i = 0; i < 32; ++i) scr[(2 * i + (lane >> 5)) * 33 + (lane & 31)] = t[i] * scale;
    } else {
#pragma unroll 8
        for (int i = 0; i < 32; ++i) { const int kk = 2 * i + (lane >> 5); scr[kk * 33 + (lane & 31)] = 0.f; }
    }
    LDS_WAIT(); asm volatile("" ::: "memory");
    const int c = lane & 7;
#pragma unroll
    for (int j = 0; j < 4; ++j) { const int n = (lane >> 3) + 8 * j; const LAS float* s = scr + (8 * c) * 33 + n;
        v4u o; o.x = pk2(s[0 * 33], s[1 * 33]); o.y = pk2(s[2 * 33], s[3 * 33]); o.z = pk2(s[4 * 33], s[5 * 33]); o.w = pk2(s[6 * 33], s[7 * 33]);
        *(GAS v4u*)(dst + (size_t)(dstrow0 + n) * K + k0 + 8 * c) = o; }
    LDS_WAIT(); asm volatile("" ::: "memory");
}
__device__ __forceinline__ void p0_prologue(Frame& F) {
    const KA A = ka_fresh();
    unsigned char* ws = A.WS();
    LAS float* scr = (LAS float*)(F.lds + F.wave * 8704);
    LAS float* sl = (LAS float*)(F.lds + 69632);
    for (int idx = F.tid; idx < 9 * 1024; idx += NTHR) { const int b = idx >> 10, k = idx & 1023; const float cv = b < 8 ? A.I(I_C)[b * 1024 + k] : A.I(I_CCTX)[k]; sl[k * 12 + b] = silu_(cv); }
    __syncthreads();
    const int gw = F.vcu * NWAVES + F.wave, NGW = F.G * NWAVES, lane = F.lane;
    for (int m = F.vcu; m < 192; m += F.G) {
        const int layer = m / 96, col = (m % 96) * 64 + lane;
        const float* w = A.I(I_ADAW) + (size_t)layer * 1024 * 6144 + (size_t)(F.wave * 128) * 6144 + col;
        float acc[9];
#pragma unroll
        for (int b = 0; b < 9; ++b) acc[b] = 0.f;
        for (int k0 = 0; k0 < 128; k0 += 16) {
            float wv[16];
#pragma unroll
            for (int u = 0; u < 16; ++u) wv[u] = w[(size_t)(k0 + u) * 6144];
#pragma unroll
            for (int u = 0; u < 16; ++u) {
#pragma unroll
                for (int b = 0; b < 9; ++b) acc[b] += sl[(F.wave * 128 + k0 + u) * 12 + b] * wv[u]; }
        }
        LAS float* red = (LAS float*)(F.lds);
#pragma unroll
        for (int b = 0; b < 9; ++b) red[(F.wave * 9 + b) * 64 + lane] = acc[b];
        __syncthreads();
        for (int idx = F.tid; idx < 9 * 64; idx += NTHR) { const int b = idx >> 6, l = idx & 63; float s = 0.f;
#pragma unroll
            for (int wv2 = 0; wv2 < 8; ++wv2) s += red[(wv2 * 9 + b) * 64 + l];
            const int c2 = (m % 96) * 64 + l;
            ((float*)(ws + WS_MOD))[(size_t)layer * 9 * 6144 + b * 6144 + c2] = s + A.I(I_ADAB)[layer * 6144 + c2]; }
        __syncthreads();
    }
    constexpr int I_S5A = 8192, I_S5B = 8192, I_S5C = 512, I_IN0 = 1152, I_OUT0 = 512, I_GLU = 128, I_IN1 = 3072, I_OUT1 = 1024, I_GU = 65536, I_DN = 32768;
    constexpr int NITEMS = I_S5A + I_S5B + I_S5C + I_IN0 + I_OUT0 + I_GLU + I_IN1 + I_OUT1 + I_GU + I_DN;
    for (int it = gw; it < NITEMS; it += NGW) {
        int r = it;
        if (r < I_S5A) { s5_table_item(A, 0, r, (bf16*)(ws + WS_S5W1), (bf16*)(ws + WS_S5W2), scr, lane); continue; }
        r -= I_S5A;
        if (r < I_S5B) { s5_table_item(A, 1, r, (bf16*)(ws + WS_S5W1), (bf16*)(ws + WS_S5W2), scr, lane); continue; }
        r -= I_S5B;
        if (r < I_S5C) { s5_table_item(A, 2, r, (bf16*)(ws + WS_S5W1), (bf16*)(ws + WS_S5W2), scr, lane); continue; }
        r -= I_S5C;
        if (r < I_IN0) { const int kb = r / 72, n0 = (r % 72) * 32;
            const int sc = n0 < 1536 ? n0 : (n0 < 2048 ? n0 + 32 : (n0 == 2048 ? 1536 : -1));
            tr_item(A.I(I_ABWIN), 2080, 1024, sc, n0 < 256 ? 0.125f : 1.0f, (bf16*)(ws + WS_WIN0T), n0, kb * 64, scr, lane); continue; }
        r -= I_IN0;
        if (r < I_OUT0) { tr_item(A.I(I_ABWOUT), 1024, 1024, (r % 32) * 32, 1.0f, (bf16*)(ws + WS_WOUT0T), (r % 32) * 32, (r / 32) * 64, scr, lane); continue; }
        r -= I_OUT0;
        if (r < I_GLU) { tr_item(A.I(I_GLUW), 512, 512, (r % 16) * 32, 1.0f, (bf16*)(ws + WS_WGLUT), (r % 16) * 32, (r / 16) * 64, scr, lane); continue; }
        r -= I_GLU;
        if (r < I_IN1) { const int n0 = (r % 192) * 32;
            tr_item(A.I(I_RETWIN), 6144, 1024, n0, (n0 >= 1024 && n0 < 2048) ? 0.0625f : 1.0f, (bf16*)(ws + WS_WIN1T), n0, (r / 192) * 64, scr, lane); continue; }
        r -= I_IN1;
        if (r < I_OUT1) { tr_item(A.I(I_RETWOUT), 1024, 2048, (r % 32) * 32, 1.0f, (bf16*)(ws + WS_WOUT1T), (r % 32) * 32, (r / 32) * 64, scr, lane); continue; }
        r -= I_OUT1;
        if (r < I_GU) { const int mat = r >> 10, q = r & 1023, kb = q >> 6, n0 = (q & 63) * 32;
            const int pn = n0 >> 8, bj = (n0 >> 7) & 1, lc = n0 & 127;
            tr_item(A.I(I_WGU) + (size_t)mat * 1024 * 2048, 2048, 1024, bj * 1024 + pn * 128 + lc, 1.0f, (bf16*)(ws + WS_WGUT) + (size_t)mat * 2048 * 1024, n0, kb * 64, scr, lane); continue; }
        r -= I_GU;
        { const int mat = r >> 9, q = r & 511, kb = q >> 5, n0 = (q & 31) * 32;
          tr_item(A.I(I_WDN) + (size_t)mat * 1024 * 1024, 1024, 1024, n0, 1.0f, (bf16*)(ws + WS_WDNT) + (size_t)mat * 1024 * 1024, n0, kb * 64, scr, lane); }
    }
}
__device__ __forceinline__ void modnorm_store(const f32x4 (&v)[4], const float* g, const float* sc, const float* sh, bf16* hrow, int lane, f32x4 (&h)[4]) {
    float ss = 0.f;
#pragma unroll
    for (int j = 0; j < 4; ++j) ss += (v[j].x * v[j].x + v[j].y * v[j].y) + (v[j].z * v[j].z + v[j].w * v[j].w);
    const float r = rsqrtf(wave_sum(ss) * (1.0f / 1024.0f) + EPS);
#pragma unroll
    for (int j = 0; j < 4; ++j) { const int o = 64 * j + lane;
        const f32x4 gg = ((const f32x4*)g)[o], s4 = ((const f32x4*)sc)[o], h4 = ((const f32x4*)sh)[o];
        h[j] = v[j] * r * gg * (s4 + 1.0f) + h4;
        v2u w; w.x = pk2(h[j].x, h[j].y); w.y = pk2(h[j].z, h[j].w);
        ((GAS v2u*)hrow)[o] = w; }
}
__device__ __forceinline__ int bidx_of_row(int row) { return row < NCTX ? 8 : ((row - NCTX) >> 12); }
__device__ __forceinline__ void p_norm1_l0(Frame& F) {
    const KA A = ka_fresh();
    const int gw = F.vcu * NWAVES + F.wave, NGW = F.G * NWAVES, lane = F.lane;
    const float* mod = (const float*)(A.WS() + WS_MOD);
    bf16* H = (bf16*)(A.WS() + WS_H);
    for (int row = gw; row < MALL; row += NGW) {
        const float* xr = row < NCTX ? A.I(I_CTX) + (size_t)row * 1024 : A.I(I_X) + (size_t)(row - NCTX) * 1024;
        f32x4 v[4], h[4];
#pragma unroll
        for (int j = 0; j < 4; ++j) v[j] = ((const f32x4*)xr)[64 * j + lane];
        const float* m = mod + bidx_of_row(row) * 6144;
        modnorm_store(v, A.I(I_N1G), m + 1024, m, H + (size_t)row * 1024, lane, h);
    }
}
__device__ __forceinline__ int seq_row(int b, int dir, int s) {
    return s < CTX ? b * CTX + (dir ? CTX - 1 - s : s) : NCTX + b * SEQ + (dir ? SEQ - 1 - (s - CTX) : (s - CTX));
}
template <int DK, bool GLA>
__device__ __forceinline__ void rec_naive(Frame& F, const bf16* P, int ldp, int qc, int kc, int vc, int DV, int nvs,
                                          float* O, size_t odir_stride, int ldo, int orow0) {
    const KA A = ka_fresh();
    constexpr int KPW = DK / 8, TB = 16;
    LAS float* qs = (LAS float*)(F.lds);
    LAS float* ks = (LAS float*)(F.lds + 16384);
    LAS float* vv = (LAS float*)(F.lds + 32768);
    LAS float* dec = (LAS float*)(F.lds + 36864);
    LAS float* opart = (LAS float*)(F.lds + 40960);
    const int tid = F.tid, lane = F.lane, wave = F.wave;
    const int nitems = NB * 4 * 2 * nvs;
    for (int it = F.vcu; it < nitems; it += F.G) {
        const int vs = it % nvs, dir = (it / nvs) & 1, h = (it / (2 * nvs)) & 3, b = it / (8 * nvs);
        float gamma = 0.f;
        if (!GLA) { const float lg = A.I(I_RETDEC)[dir * 4 + h]; gamma = 1.0f / (1.0f + expf(-lg)); }
        float S[KPW];
#pragma unroll
        for (int i = 0; i < KPW; ++i) S[i] = 0.f;
        for (int s0 = 0; s0 < CTX + SEQ; s0 += TB) {
            for (int idx = tid; idx < TB * DK; idx += NTHR) { const int i = idx / DK, kk = idx % DK; const size_t rb = (size_t)seq_row(b, dir, s0 + i) * ldp;
                qs[idx] = bf2f(P[rb + qc + h * DK + kk]); ks[idx] = bf2f(P[rb + kc + h * DK + kk]); }
            for (int idx = tid; idx < TB * 64; idx += NTHR) { const int i = idx >> 6, c = idx & 63; const size_t rb = (size_t)seq_row(b, dir, s0 + i) * ldp;
                vv[idx] = bf2f(P[rb + vc + h * DV + vs * 64 + c]);
                if (GLA) { float z = A.I(I_GLABA)[dir * 256 + h * 64 + c];
#pragma unroll
                    for (int r = 0; r < 16; ++r) z += bf2f(P[rb + C0_LOW + dir * 16 + r]) * A.I(I_GLAWA)[(dir * 16 + r) * 256 + h * 64 + c];
                    const float ls = fminf(z, 0.f) - log1pf(expf(-fabsf(z)));
                    dec[idx] = expf(ls * (1.0f / 16.0f)); } }
            __syncthreads();
#pragma unroll 1
            for (int i = 0; i < TB; ++i) { const float vval = vv[i * 64 + lane]; float part = 0.f;
#pragma unroll
                for (int kk = 0; kk < KPW; ++kk) { const int kidx = wave * KPW + kk; const float d = GLA ? dec[i * 64 + kidx] : gamma;
                    S[kk] = d * S[kk] + ks[i * DK + kidx] * vval; part += qs[i * DK + kidx] * S[kk]; }
                opart[(i * 8 + wave) * 64 + lane] = part; }
            __syncthreads();
            for (int idx = tid; idx < TB * 64; idx += NTHR) { const int i = idx >> 6, c = idx & 63; float sum = 0.f;
#pragma unroll
                for (int w = 0; w < 8; ++w) sum += opart[(i * 8 + w) * 64 + c];
                const int row = seq_row(b, dir, s0 + i);
                if (row >= orow0) O[(size_t)dir * odir_stride + (size_t)(row - orow0) * ldo + h * DV + vs * 64 + c] = sum; }
        }
        __syncthreads();
    }
}
__device__ __forceinline__ void s5_naive(Frame& F, const bf16* P, float* Y  ) {
    const KA A = ka_fresh();
    const int lane = F.lane;
    if (F.wave >= 2) return;
    for (int chain = F.vcu * 2 + F.wave; chain < NB * 32 * 2; chain += F.G * 2) {
        const int dir = chain & 1, g = (chain >> 1) & 31, b = chain >> 6;
        const float step = expf(A.I(I_LOGSTEP)[dir * 32 + g]);
        const float lr = A.I(I_LAMRE)[(dir * 32 + g) * 64 + lane], li = A.I(I_LAMIM)[(dir * 32 + g) * 64 + lane];
        const float mag = expf(lr * step), lbr = mag * cosf(li * step), lbi = mag * sinf(li * step), den = lr * lr + li * li;
        const float fr = ((lbr - 1.0f) * lr + lbi * li) / den, fi = (lbi * lr - (lbr - 1.0f) * li) / den;
        float bbr[16], bbi[16], cr[16], ci[16];
#pragma unroll
        for (int c = 0; c < 16; ++c) { const float br = A.I(I_BRE)[(g * 64 + lane) * 16 + c], bi = A.I(I_BIM)[(g * 64 + lane) * 16 + c];
            bbr[c] = fr * br - fi * bi; bbi[c] = fr * bi + fi * br;
            cr[c] = A.I(I_CRE)[((dir * 32 + g) * 16 + c) * 64 + lane]; ci[c] = A.I(I_CIM)[((dir * 32 + g) * 16 + c) * 64 + lane]; }
        float sr = 0.f, si = 0.f;
        for (int s0 = 0; s0 < CTX + SEQ; s0 += 4) {
            v4u uu[4][2];
#pragma unroll
            for (int i = 0; i < 4; ++i) { const v4u* up = (const v4u*)(P + (size_t)seq_row(b, dir, s0 + i) * N0 + C0_U + g * 16); uu[i][0] = up[0]; uu[i][1] = up[1]; }
#pragma unroll
            for (int i = 0; i < 4; ++i) {
                float u[16];
#pragma unroll
                for (int q = 0; q < 2; ++q) { u[8 * q + 0] = blo(uu[i][q].x); u[8 * q + 1] = bhi(uu[i][q].x); u[8 * q + 2] = blo(uu[i][q].y); u[8 * q + 3] = bhi(uu[i][q].y);
                    u[8 * q + 4] = blo(uu[i][q].z); u[8 * q + 5] = bhi(uu[i][q].z); u[8 * q + 6] = blo(uu[i][q].w); u[8 * q + 7] = bhi(uu[i][q].w); }
                float br = 0.f, bi = 0.f;
#pragma unroll
                for (int c = 0; c < 16; ++c) { br += bbr[c] * u[c]; bi += bbi[c] * u[c]; }
                const float nr = lbr * sr - lbi * si + br, ni = lbr * si + lbi * sr + bi; sr = nr; si = ni;
                float v[16];
#pragma unroll
                for (int c = 0; c < 16; ++c) v[c] = cr[c] * sr - ci[c] * si;
                const bool b5 = (lane & 32) != 0, b4 = (lane & 16) != 0, b3 = (lane & 8) != 0, b2 = (lane & 4) != 0;
                float w8[8], w4[4], w2[2];
#pragma unroll
                for (int k = 0; k < 8; ++k) { const float send = b5 ? v[k] : v[k + 8], keep = b5 ? v[k + 8] : v[k]; w8[k] = keep + __shfl_xor(send, 32); }
#pragma unroll
                for (int k = 0; k < 4; ++k) { const float send = b4 ? w8[k] : w8[k + 4], keep = b4 ? w8[k + 4] : w8[k]; w4[k] = keep + __shfl_xor(send, 16); }
#pragma unroll
                for (int k = 0; k < 2; ++k) { const float send = b3 ? w4[k] : w4[k + 2], keep = b3 ? w4[k + 2] : w4[k]; w2[k] = keep + __shfl_xor(send, 8); }
                float w1; { const float send = b2 ? w2[0] : w2[1], keep = b2 ? w2[1] : w2[0]; w1 = keep + __shfl_xor(send, 4); }
                w1 += __shfl_xor(w1, 2); w1 += __shfl_xor(w1, 1);
                const int c = (b5 ? 8 : 0) + (b4 ? 4 : 0) + (b3 ? 2 : 0) + (b2 ? 1 : 0);
                if ((lane & 3) == 0) Y[(size_t)dir * MALL * 512 + (size_t)seq_row(b, dir, s0 + i) * 512 + g * 16 + c] = w1;
            }
        }
    }
}
__device__ __forceinline__ void unpack8(const v4u w, float (&f)[8]) { f[0] = blo(w.x); f[1] = bhi(w.x); f[2] = blo(w.y); f[3] = bhi(w.y); f[4] = blo(w.z); f[5] = bhi(w.z); f[6] = blo(w.w); f[7] = bhi(w.w); }
__device__ __forceinline__ v4u pack8(const float (&f)[8]) { v4u w; w.x = pk2(f[0], f[1]); w.y = pk2(f[2], f[3]); w.z = pk2(f[4], f[5]); w.w = pk2(f[6], f[7]); return w; }
__device__ __forceinline__ void p_finish0(Frame& F) {
    const KA A = ka_fresh();
    const int gw = F.vcu * NWAVES + F.wave, NGW = F.G * NWAVES, lane = F.lane, e0 = lane * 8;
    const bf16* P = (const bf16*)(A.WS() + WS_PROJ);
    const float* GO = (const float*)(A.WS() + WS_OREC);
    const float* SY = GO + (size_t)2 * MALL * 512;
    bf16* MIX = (bf16*)(A.WS() + WS_MIX); bf16* YP = (bf16*)(A.WS() + WS_YPRE);
    for (int row = gw; row < MALL; row += NGW) {
        float o[8], gg[8], ng[8];
#if MK_NAIVE_GLA
        { const f32x4* a = (const f32x4*)(GO + (size_t)row * 512 + e0); const f32x4* bq = (const f32x4*)(GO + (size_t)(MALL + row) * 512 + e0);
          const f32x4 a0 = a[0] + bq[0], a1 = a[1] + bq[1]; o[0] = a0.x; o[1] = a0.y; o[2] = a0.z; o[3] = a0.w; o[4] = a1.x; o[5] = a1.y; o[6] = a1.z; o[7] = a1.w; }
#else
        { const bf16* GO16 = (const bf16*)GO; float f0[8], f1[8]; unpack8(*(const v4u*)(GO16 + (size_t)row * 512 + e0), f0); unpack8(*(const v4u*)(GO16 + (size_t)(MALL + row) * 512 + e0), f1);
#pragma unroll
          for (int j = 0; j < 8; ++j) o[j] = f0[j] + f1[j]; }
#endif
        float ss = 0.f;
#pragma unroll
        for (int j = 0; j < 8; ++j) ss += o[j] * o[j];
        ss += __shfl_xor(ss, 1); ss += __shfl_xor(ss, 2); ss += __shfl_xor(ss, 4); ss += __shfl_xor(ss, 8);
        const float r = rsqrtf(ss * (1.0f / 128.0f) + EPS);
        unpack8(*(const v4u*)(P + (size_t)row * N0 + C0_G + e0), gg);
        { const f32x4* n4 = (const f32x4*)(A.I(I_GLANG) + (e0 & 127)); const f32x4 n0 = n4[0], n1 = n4[1]; ng[0] = n0.x; ng[1] = n0.y; ng[2] = n0.z; ng[3] = n0.w; ng[4] = n1.x; ng[5] = n1.y; ng[6] = n1.z; ng[7] = n1.w; }
        float res[8];
#pragma unroll
        for (int j = 0; j < 8; ++j) res[j] = o[j] * r * ng[j] * silu_(gg[j]);
        *(GAS v4u*)(MIX + (size_t)row * 1024 + e0) = pack8(res);
#if MK_NAIVE_S5
        float u[8], y[8];
        unpack8(*(const v4u*)(P + (size_t)row * N0 + C0_U + e0), u);
        { const f32x4* a = (const f32x4*)(SY + (size_t)row * 512 + e0); const f32x4* bq = (const f32x4*)(SY + (size_t)(MALL + row) * 512 + e0);
          const f32x4 a0 = a[0] + bq[0], a1 = a[1] + bq[1]; y[0] = a0.x; y[1] = a0.y; y[2] = a0.z; y[3] = a0.w; y[4] = a1.x; y[5] = a1.y; y[6] = a1.z; y[7] = a1.w; }
#pragma unroll
        for (int j = 0; j < 8; ++j) { const float t = y[j] + A.I(I_S5D)[e0 + j] * u[j]; res[j] = 0.5f * t * (1.0f + tanhf(0.7978845608f * (t + 0.044715f * t * t * t))); }
        *(GAS v4u*)(YP + (size_t)row * 512 + e0) = pack8(res);
#endif
    }
}
__device__ __forceinline__ void p_finish1(Frame& F) {
    const KA A = ka_fresh();
    const int gw = F.vcu * NWAVES + F.wave, NGW = F.G * NWAVES, lane = F.lane;
    const bf16* P = (const bf16*)(A.WS() + WS_PROJ);
    const float* RO = (const float*)(A.WS() + WS_OREC);
    bf16* MIX = (bf16*)(A.WS() + WS_MIX);
    for (int lrow = gw; lrow < NLAT; lrow += NGW) {
#pragma unroll 1
        for (int h = 0; h < 4; ++h) { const int e0 = h * 512 + lane * 8;
            float o[8], gg[8];
#if MK_NAIVE_RET
            { const f32x4* a = (const f32x4*)(RO + (size_t)lrow * 2048 + e0); const f32x4* bq = (const f32x4*)(RO + (size_t)(NLAT + lrow) * 2048 + e0);
              const f32x4 a0 = a[0] + bq[0], a1 = a[1] + bq[1]; o[0] = a0.x; o[1] = a0.y; o[2] = a0.z; o[3] = a0.w; o[4] = a1.x; o[5] = a1.y; o[6] = a1.z; o[7] = a1.w; }
#else
            { const bf16* RO16 = (const bf16*)RO; float f0[8], f1[8]; unpack8(*(const v4u*)(RO16 + (size_t)lrow * 2048 + e0), f0); unpack8(*(const v4u*)(RO16 + (size_t)(NLAT + lrow) * 2048 + e0), f1);
#pragma unroll
              for (int j = 0; j < 8; ++j) o[j] = f0[j] + f1[j]; }
#endif
            float s = 0.f;
#pragma unroll
            for (int j = 0; j < 8; ++j) s += o[j];
            const float mu = wave_sum(s) * (1.0f / 512.0f); float q = 0.f;
#pragma unroll
            for (int j = 0; j < 8; ++j) { o[j] -= mu; q += o[j] * o[j]; }
            const float r = rsqrtf(wave_sum(q) * (1.0f / 512.0f) + EPS);
            unpack8(*(const v4u*)(P + (size_t)(NCTX + lrow) * N1 + C1_G + e0), gg);
            float res[8];
#pragma unroll
            for (int j = 0; j < 8; ++j) res[j] = o[j] * r * A.I(I_RETNG)[e0 + j] * silu_(gg[j]);
            *(GAS v4u*)(MIX + (size_t)lrow * 2048 + e0) = pack8(res); }
    }
}
__device__ __forceinline__ void p_rope(Frame& F) {
    const KA A = ka_fresh();
    const int gw = F.vcu * NWAVES + F.wave, NGW = F.G * NWAVES, lane = F.lane;
    bf16* P = (bf16*)(A.WS() + WS_PROJ);
    LAS float* ct = (LAS float*)F.lds;
    LAS float* st = ct + 4096;
    for (int i = F.tid; i < 4096; i += NTHR) { const int pos = i >> 6, fi = i & 63; float sn, cs; sincosf((float)pos * expf(-(float)fi * (9.210340371976184f / 64.0f)), &sn, &cs); ct[i] = cs; st[i] = sn; }
    __syncthreads();
    for (int lrow = gw; lrow < NLAT; lrow += NGW) {
        const int t = lrow & (SEQ - 1), pr = t >> 6, pc = t & 63;
        bf16* rp = P + (size_t)(NCTX + lrow) * N1;
        v4u a[2], b2[2]; int off[2], pos[2], f0[2];
#pragma unroll
        for (int q = 0; q < 2; ++q) { const int task = lane + 64 * q, tens = task >> 4, half = (task >> 3) & 1, ch = task & 7;
            off[q] = tens * 256 + half * 128 + ch * 8; pos[q] = half ? pc : pr; f0[q] = ch * 8;
            a[q] = *(const v4u*)(rp + off[q]); b2[q] = *(const v4u*)(rp + off[q] + 64); }
#pragma unroll
        for (int q = 0; q < 2; ++q) { float x[8], y[8], xo[8], yo[8]; unpack8(a[q], x); unpack8(b2[q], y);
            const f32x4 c0 = *(const LAS f32x4*)(ct + pos[q] * 64 + f0[q]), c1 = *(const LAS f32x4*)(ct + pos[q] * 64 + f0[q] + 4), s0 = *(const LAS f32x4*)(st + pos[q] * 64 + f0[q]), s1 = *(const LAS f32x4*)(st + pos[q] * 64 + f0[q] + 4);
#pragma unroll
            for (int j = 0; j < 8; ++j) { const float cs = j < 4 ? c0[j & 3] : c1[j & 3], sn = j < 4 ? s0[j & 3] : s1[j & 3]; xo[j] = x[j] * cs - y[j] * sn; yo[j] = x[j] * sn + y[j] * cs; }
            *(GAS v4u*)(rp + off[q]) = pack8(xo); *(GAS v4u*)(rp + off[q] + 64) = pack8(yo); }
    }
}
__device__ __forceinline__ void p_router(Frame& F, int layer) {
    const KA A = ka_fresh();
    const int tid = F.tid, lane = F.lane, wave = F.wave;
    const int moe_row0 = layer ? NCTX : 0, NTOK = layer ? NLAT : MALL;
    const int RPB = (NTOK + F.G - 1) / F.G;
    unsigned char* ws = A.WS();
    int* prow = (int*)(ws + WS_PROW); int* sel_e = (int*)(ws + WS_SELE); float* w_slot = (float*)(ws + WS_WSLOT); int* slot_pos = (int*)(ws + WS_SPOS);
    LAS float* Wt = (LAS float*)F.lds;
    LAS int* lcnt = (LAS int*)(F.lds + L_LCNT); LAS int* gbase = (LAS int*)(F.lds + L_GBASE);
    LAS int* blk_e = (LAS int*)(F.lds + L_BLKE); LAS int* blk_p = (LAS int*)(F.lds + L_BLKP);
    const float* wr = A.I(I_WROUTER) + (size_t)layer * 1024 * 32;
    for (int idx = tid; idx < 32768; idx += NTHR) Wt[(idx & 31) * 1024 + (idx >> 5)] = wr[idx];
    if (tid < 32) lcnt[tid] = 0;
    __syncthreads();
    const float* mod = (const float*)(ws + WS_MOD) + (size_t)layer * 9 * 6144;
    const float* XR = (const float*)(ws + WS_XRES); bf16* H = (bf16*)(ws + WS_H);
    const int tok0 = F.vcu * RPB;
    for (int lr = wave; lr < RPB; lr += NWAVES) {
        const int tok = tok0 + lr; if (tok >= NTOK) break;
        const int row = moe_row0 + tok;
        f32x4 v[4], h[4];
#pragma unroll
        for (int j = 0; j < 4; ++j) v[j] = ((const f32x4*)(XR + (size_t)row * 1024))[64 * j + lane];
        const float* m = mod + bidx_of_row(row) * 6144;
        modnorm_store(v, A.I(I_N2G) + layer * 1024, m + 4096, m + 3072, H + (size_t)row * 1024, lane, h);
        float lg[32];
#pragma unroll
        for (int e = 0; e < 32; ++e) { float a = 0.f;
#pragma unroll
            for (int j = 0; j < 4; ++j) { const f32x4 w4 = *(const LAS f32x4*)(Wt + e * 1024 + 4 * (64 * j + lane)); a += (h[j].x * w4.x + h[j].y * w4.y) + (h[j].z * w4.z + h[j].w * w4.w); }
            lg[e] = wave_sum(a) + A.I(I_BROUTER)[layer * 32 + e]; }
        float bv[4]; int bi[4];
#pragma unroll
        for (int r = 0; r < 4; ++r) { float best = -INFINITY; int be = 0;
#pragma unroll
            for (int e = 0; e < 32; ++e) { const bool take = lg[e] > best; best = take ? lg[e] : best; be = take ? e : be; }
            bv[r] = best; bi[r] = be;
#pragma unroll
            for (int e = 0; e < 32; ++e) lg[e] = (e == be) ? -INFINITY : lg[e]; }
        const float e1 = __expf(bv[1] - bv[0]), e2 = __expf(bv[2] - bv[0]), e3 = __expf(bv[3] - bv[0]), inv = 1.0f / (1.0f + e1 + e2 + e3);
        if (lane < 4) { const int ee = lane == 0 ? bi[0] : (lane == 1 ? bi[1] : (lane == 2 ? bi[2] : bi[3]));
            const float wv = (lane == 0 ? 1.0f : (lane == 1 ? e1 : (lane == 2 ? e2 : e3))) * inv;
            sel_e[tok * 4 + lane] = ee; w_slot[tok * 4 + lane] = wv;
            const int lp = __hip_atomic_fetch_add(lcnt + ee, 1, __ATOMIC_RELAXED, __HIP_MEMORY_SCOPE_WORKGROUP);
            blk_e[lr * 4 + lane] = ee; blk_p[lr * 4 + lane] = lp; }
    }
    __syncthreads();
    if (tid < 32) gbase[tid] = (int)__hip_atomic_fetch_add(F.ctl + CW_GCNT + 64 * layer + tid, (unsigned)lcnt[tid], RLX_AGENT);
    __syncthreads();
    int* elist = (int*)(ws + WS_ELIST);
    for (int idx = tid; idx < RPB * 4; idx += NTHR) { const int tok = tok0 + (idx >> 2); if (tok < NTOK) { const int e = blk_e[idx]; elist[(size_t)e * MALL + gbase[e] + blk_p[idx]] = tok * 4 + (idx & 3); } }
}
__device__ __forceinline__ int moe_tables(Frame& F, int layer) {
    LAS int* ts = (LAS int*)(F.lds + L_TSTART); LAS unsigned char* te = (LAS unsigned char*)(F.lds + L_TILEE);
    __syncthreads();
    if (F.tid == 0) { int acc = 0;
        for (int e = 0; e < 32; ++e) { ts[e] = acc; acc += ((int)__hip_atomic_load(F.ctl + CW_GCNT + 64 * layer + e, RLX_AGENT) + 255) >> 8; }
        ts[32] = acc > MAXTILES ? MAXTILES : acc; }
    __syncthreads();
    const int nt = ts[32];
    LAS int* tpos = (LAS int*)(F.lds + L_TPOS); LAS int* tcnt = (LAS int*)(F.lds + L_TCNT);
    for (int T = F.tid; T < nt; T += NTHR) { int e = 0;
        for (int q = 1; q < 32; ++q) e = (T >= ts[q]) ? q : e;
        te[T] = (unsigned char)e; tpos[T] = (T - ts[e]) * 256; tcnt[T] = (int)__hip_atomic_load(F.ctl + CW_GCNT + 64 * layer + e, RLX_AGENT); }
    __syncthreads();
    return nt;
}
__device__ __forceinline__ void p_combine(Frame& F, int layer) {
    const KA A = ka_fresh();
    const int gw = F.vcu * NWAVES + F.wave, NGW = F.G * NWAVES, lane = F.lane;
    const int moe_row0 = layer ? NCTX : 0, NTOK = layer ? NLAT : MALL;
    unsigned char* ws = A.WS();
    float* XR = (float*)(ws + WS_XRES); bf16* H = (bf16*)(ws + WS_H); const bf16* YS = (const bf16*)(ws + WS_YSLOT);
    const float* mod = (const float*)(ws + WS_MOD);
    float palpha = 1.0f;
#if defined(MK_PROBE) && MK_PROBE >= 0
    {
      const unsigned* st = F.ctl + 20000 + 2 * MK_PROBE;
      const unsigned long long t0 = ((unsigned long long)__hip_atomic_load(st + 1, RLX_AGENT) << 32) | __hip_atomic_load(st, RLX_AGENT), t1 = ((unsigned long long)__hip_atomic_load(st + 3, RLX_AGENT) << 32) | __hip_atomic_load(st + 2, RLX_AGENT);
      palpha = 1.0f + exp2f((float)(t1 - t0) * 0.01f * 0.01f * 3.321928095f); }
#endif
    for (int tok = gw; tok < NTOK; tok += NGW) {
        const int row = moe_row0 + tok, bidx = bidx_of_row(row);
        const float* g2 = mod + (size_t)layer * 9 * 6144 + bidx * 6144 + 5120;
        f32x4 v[4];
#pragma unroll
        for (int j = 0; j < 4; ++j) { const int o = 64 * j + lane; f32x4 y = (f32x4){0.f, 0.f, 0.f, 0.f};
#pragma unroll
            for (int k = 0; k < 4; ++k) { const v2u w = ((const v2u*)(YS + (size_t)(tok * 4 + k) * 1024))[o]; y += (f32x4){blo(w.x), bhi(w.x), blo(w.y), bhi(w.y)}; }
            v[j] = ((const f32x4*)(XR + (size_t)row * 1024))[o] + ((const f32x4*)g2)[o] * y; }
        if (layer == 0) {
#pragma unroll
            for (int j = 0; j < 4; ++j) ((f32x4*)(XR + (size_t)row * 1024))[64 * j + lane] = v[j];
            const float* m1 = mod + (size_t)9 * 6144 + bidx * 6144; f32x4 h[4];
            modnorm_store(v, A.I(I_N1G) + 1024, m1 + 1024, m1, H + (size_t)row * 1024, lane, h);
        } else {
            float ss = 0.f;
#pragma unroll
            for (int j = 0; j < 4; ++j) ss += (v[j].x * v[j].x + v[j].y * v[j].y) + (v[j].z * v[j].z + v[j].w * v[j].w);
            const float r = rsqrtf(wave_sum(ss) * (1.0f / 1024.0f) + EPS);
#pragma unroll
            for (int j = 0; j < 4; ++j) { const int o = 64 * j + lane; ((f32x4*)(A.OUT() + (size_t)tok * 1024))[o] = v[j] * (r * palpha) * ((const f32x4*)A.I(I_FNG))[o]; }
        }
    }
}
typedef short s16x4 __attribute__((ext_vector_type(4)));
typedef short bfx8 __attribute__((ext_vector_type(8)));
typedef short v4i16_t __attribute__((ext_vector_type(4)));
#define MFMA16(a, b, c) __builtin_amdgcn_mfma_f32_16x16x32_bf16((a), (b), (c), 0, 0, 0)
__device__ __forceinline__ bfx8 frag_n(const LAS unsigned char* tile, int stride, int r0, int k0, int lane) {
    return *(const LAS bfx8*)(tile + (r0 + (lane & 15)) * stride + (k0 + 8 * (lane >> 4)) * 2);
}
__device__ __forceinline__ bfx8 frag_t(const LAS unsigned char* tile, int stride, int k0, int n0, int lane) {
    const int g = lane >> 4, q = (lane & 15) >> 2, p = lane & 3;
    const LAS unsigned char* a = tile + (k0 + 8 * g + q) * stride + (n0 + 4 * p) * 2;
    const s16x4 lo = __builtin_bit_cast(s16x4, __builtin_amdgcn_ds_read_tr16_b64_v4i16((LAS v4i16_t*)a));
    const s16x4 hi = __builtin_bit_cast(s16x4, __builtin_amdgcn_ds_read_tr16_b64_v4i16((LAS v4i16_t*)(a + 4 * stride)));
    return __builtin_shufflevector(lo, hi, 0, 1, 2, 3, 4, 5, 6, 7);
}
__device__ __forceinline__ v4u scale8(const v4u w, float s) { float f[8]; unpack8(w, f);
#pragma unroll
    for (int j = 0; j < 8; ++j) f[j] *= s;
    return pack8(f); }

template <int DK, int DVS, bool GLA>
__device__ __forceinline__ void rec_mfma(Frame& F, const bf16* Qsrc, const bf16* Ksrc, const bf16* K2src, size_t qdir_stride, int ldq, int qcol, int kcol,
                                         const bf16* Vsrc, int ldv, int vcol, int DV, const float* EB,
                                         bf16* O, size_t odir_stride, int ldo, int orow0) {
    const KA A = ka_fresh();
    constexpr int SQ = DK * 2 + 16, SV = DVS * 2 + 16, SP = 144, SS = DK * 2 + 16;
    constexpr int O_QD = 0, O_KI = O_QD + 64 * SQ, O_KS = O_KI + 64 * SQ, O_V = O_KS + (GLA ? 64 * SQ : 0), O_VD = O_V + 64 * SV, O_P = O_VD + (GLA ? 0 : 64 * SV), O_ST = O_P + 64 * SP, O_EB = O_ST + DVS * SS;
    static_assert(O_EB + DK * 4 <= RING_BYTES, "rec_mfma LDS");
    constexpr int NVS = 0;  (void)NVS;
    constexpr int VT_PER = DVS / 32, KT_PER = DK / 64, QCH = DK / 8  , QN = (64 * QCH) / NTHR, VCH = DVS / 8, KSTEPS = DK / 32;
    static_assert(QN >= 1 && VT_PER >= 1 && KT_PER >= 1, "shape");
    const LAS unsigned char* L = F.lds;
    const int tid = F.tid, lane = F.lane, w = F.wave, it = w & 3, vg = w >> 2, kg = w & 3, g4 = lane >> 4, l15 = lane & 15;
    const int nvs = DV / DVS, nitems = NB * 4 * 2 * nvs;
    for (int item = F.vcu; item < nitems; item += F.G) {
        const int vs = item % nvs, dir = (item / nvs) & 1, h = (item / (2 * nvs)) & 3, b = item / (8 * nvs);
        float lg2 = 0.f;
        if (!GLA) { const float lgt = A.I(I_RETDEC)[dir * 4 + h]; lg2 = -log2f(1.0f + expf(-lgt)); }
        const bf16* qb = Qsrc + (GLA ? (size_t)dir * qdir_stride : 0) + qcol + h * DK;
        const bf16* kb = Ksrc + (GLA ? (size_t)dir * qdir_stride : 0) + kcol + h * DK;
        const bf16* k2b = GLA ? K2src + (size_t)dir * qdir_stride + kcol + h * DK : kb;
        const bf16* vb = Vsrc + vcol + h * DV + vs * DVS;
        f32x4 Sacc[VT_PER][KT_PER];
#pragma unroll
        for (int a = 0; a < VT_PER; ++a)
#pragma unroll
            for (int c2 = 0; c2 < KT_PER; ++c2) Sacc[a][c2] = (f32x4){0.f, 0.f, 0.f, 0.f};
        for (int i = tid; i < DVS * SS / 4; i += NTHR) ((LAS unsigned*)(F.lds + O_ST))[i] = 0u;
        v4u rq[QN], rk[QN], rk2[GLA ? QN : 1], rv; float peb = 0.f;
        rv = (v4u){0u, 0u, 0u, 0u};
#define REC_LOAD(c) do { \
            _Pragma("unroll") for (int n = 0; n < QN; ++n) { const int pi = tid + NTHR * n, r = pi / QCH, ch = pi % QCH; const size_t ro = (size_t)seq_row(b, dir, 64 * (c) + r) * ldq + ch * 8; \
                rq[n] = *(const v4u*)(qb + ro); rk[n] = *(const v4u*)(kb + ro); if (GLA) rk2[n] = *(const v4u*)(k2b + ro); } \
            if (tid < 64 * VCH) { const int r = tid / VCH, ch = tid % VCH; rv = *(const v4u*)(vb + (size_t)seq_row(b, dir, 64 * (c) + r) * ldv + ch * 8); } \
            if (GLA && tid < DK) peb = EB[(((size_t)dir * NB + b) * 68 + (c)) * (4 * DK) + h * DK + tid]; } while (0)
        REC_LOAD(0);
        for (int c = 0; c < 68; ++c) {
#pragma unroll
            for (int n = 0; n < QN; ++n) { const int pi = tid + NTHR * n, r = pi / QCH, ch = pi % QCH;
                *(LAS v4u*)(F.lds + O_QD + r * SQ + ch * 16) = rq[n]; *(LAS v4u*)(F.lds + O_KI + r * SQ + ch * 16) = rk[n];
                if (GLA) *(LAS v4u*)(F.lds + O_KS + r * SQ + ch * 16) = rk2[n]; }
            if (tid < 64 * VCH) { const int r = tid / VCH, ch = tid % VCH;
                *(LAS v4u*)(F.lds + O_V + r * SV + ch * 16) = rv;
                if (!GLA) *(LAS v4u*)(F.lds + O_VD + r * SV + ch * 16) = scale8(rv, exp2f(lg2 * (float)(63 - r))); }
            if (GLA && tid < DK) ((LAS float*)(F.lds + O_EB))[tid] = peb;
            if (c + 1 < 68) REC_LOAD(c + 1);
            __syncthreads();
#pragma unroll
            for (int q2 = 0; q2 < 2; ++q2) { const int jt = 2 * vg + q2; f32x4 acc = (f32x4){0.f, 0.f, 0.f, 0.f};
                if (jt <= it) {
#pragma unroll
                    for (int ks = 0; ks < KSTEPS; ++ks) acc = MFMA16(frag_n(L + O_KI, SQ, 16 * jt, 32 * ks, lane), frag_n(L + O_QD, SQ, 16 * it, 32 * ks, lane), acc);
                    const int i = 16 * it + l15;
#pragma unroll
                    for (int r = 0; r < 4; ++r) { const int j = 16 * jt + 4 * g4 + r; float vv = (j <= i) ? acc[r] : 0.f; if (!GLA) vv *= exp2f(lg2 * (float)(i - j)); acc[r] = vv; }
                }
                v2u pw; pw.x = pk2(acc[0], acc[1]); pw.y = pk2(acc[2], acc[3]);
                *(LAS v2u*)(F.lds + O_P + (16 * it + l15) * SP + (16 * jt + 4 * g4) * 2) = pw; }
            f32x4 oacc[VT_PER];
#pragma unroll
            for (int a = 0; a < VT_PER; ++a) { oacc[a] = (f32x4){0.f, 0.f, 0.f, 0.f};
#pragma unroll
                for (int ks = 0; ks < KSTEPS; ++ks) oacc[a] = MFMA16(frag_n(L + O_ST, SS, 16 * (vg * VT_PER + a), 32 * ks, lane), frag_n(L + O_QD, SQ, 16 * it, 32 * ks, lane), oacc[a]);
                if (!GLA) oacc[a] *= exp2f(lg2 * (float)(16 * it + l15 + 1)); }
            __syncthreads();
            { const int row = seq_row(b, dir, 64 * c + 16 * it + l15);
#pragma unroll
              for (int a = 0; a < VT_PER; ++a) { const int vt = vg * VT_PER + a;
#pragma unroll
                for (int js = 0; js < 2; ++js) oacc[a] = MFMA16(frag_t(L + O_V, SV, 32 * js, 16 * vt, lane), frag_n(L + O_P, SP, 16 * it, 32 * js, lane), oacc[a]);
                if (row >= orow0) { v2u ow; ow.x = pk2(oacc[a][0], oacc[a][1]); ow.y = pk2(oacc[a][2], oacc[a][3]);
                    *(GAS v2u*)(O + (size_t)dir * odir_stride + (size_t)(row - orow0) * ldo + h * DV + vs * DVS + 16 * vt + 4 * g4) = ow; } } }
            { bfx8 fv[VT_PER][2];
#pragma unroll
              for (int a = 0; a < VT_PER; ++a)
#pragma unroll
                for (int js = 0; js < 2; ++js) fv[a][js] = frag_t(L + (GLA ? O_V : O_VD), SV, 32 * js, 16 * (vg * VT_PER + a), lane);
              const float g64 = GLA ? 1.0f : exp2f(lg2 * 64.0f);
#pragma unroll
              for (int c2 = 0; c2 < KT_PER; ++c2) { const int kt = kg * KT_PER + c2;
                const bfx8 fk0 = frag_t(L + (GLA ? O_KS : O_KI), SQ, 0, 16 * kt, lane), fk1 = frag_t(L + (GLA ? O_KS : O_KI), SQ, 32, 16 * kt, lane);
                f32x4 sc4 = (f32x4){g64, g64, g64, g64};
                if (GLA) sc4 = *(const LAS f32x4*)(L + O_EB + (16 * kt + 4 * g4) * 4);
#pragma unroll
                for (int a = 0; a < VT_PER; ++a) { f32x4 s = Sacc[a][c2] * sc4;
                    s = MFMA16(fk0, fv[a][0], s); s = MFMA16(fk1, fv[a][1], s); Sacc[a][c2] = s;
                    v2u sw; sw.x = pk2(s[0], s[1]); sw.y = pk2(s[2], s[3]);
                    *(LAS v2u*)(F.lds + O_ST + (16 * (vg * VT_PER + a) + l15) * SS + (16 * kt + 4 * g4) * 2) = sw; } } }
            __syncthreads();
        }
#undef REC_LOAD
    }
}
__device__ __forceinline__ void p_gla_prep(Frame& F, const bf16* P, bf16* QD, bf16* KI, bf16* KS, float* EB) {
    const KA A = ka_fresh();
    const int tid = F.tid;
    LAS float* lb = (LAS float*)F.lds;
    LAS float* wal = (LAS float*)(F.lds + 66560);
    LAS float* tot = (LAS float*)(F.lds + 66560 + 17408);
    constexpr int LBS = 260;
    int cur_dir = -1;
    for (int item = F.vcu; item < 2 * NB * 68; item += F.G) {
        const int c = item % 68, b = (item / 68) % NB, dir = item / (68 * NB);
        if (dir != cur_dir) { __syncthreads();
            for (int i = tid; i < 16 * 256; i += NTHR) wal[i] = A.I(I_GLAWA)[dir * 4096 + i];
            if (tid < 256) wal[4096 + tid] = A.I(I_GLABA)[dir * 256 + tid];
            cur_dir = dir; __syncthreads(); }
        const int t = tid >> 3, cg = tid & 7, row = seq_row(b, dir, 64 * c + t);
        {
            float lw[16]; { float f0[8], f1[8]; unpack8(*(const v4u*)(P + (size_t)row * N0 + C0_LOW + dir * 16), f0); unpack8(*(const v4u*)(P + (size_t)row * N0 + C0_LOW + dir * 16 + 8), f1);
#pragma unroll
                for (int j = 0; j < 8; ++j) { lw[j] = f0[j]; lw[8 + j] = f1[j]; } }
#pragma unroll
            for (int q = 0; q < 8; ++q) { const int col = cg * 32 + q * 4;
                f32x4 z = *(const LAS f32x4*)(wal + 4096 + col);
#pragma unroll
                for (int r = 0; r < 16; ++r) z += *(const LAS f32x4*)(wal + r * 256 + col) * lw[r];
                f32x4 o;
#pragma unroll
                for (int j = 0; j < 4; ++j) o[j] = (fminf(z[j], 0.f) - __logf(1.0f + __expf(-fabsf(z[j])))) * (1.0f / 16.0f);
                *(LAS f32x4*)(lb + t * LBS + col) = o; }
        }
        __syncthreads();
        {
            const int col = tid & 255, half = tid >> 8; float run = 0.f;
#pragma unroll 8
            for (int i = 0; i < 32; ++i) { run += lb[(32 * half + i) * LBS + col]; lb[(32 * half + i) * LBS + col] = run; }
            if (half == 0) tot[col] = run;
            __syncthreads();
            if (half == 1) { const float off = tot[col];
#pragma unroll 8
                for (int i = 32; i < 64; ++i) lb[i * LBS + col] += off; }
        }
        __syncthreads();
        {
#pragma unroll
            for (int q = 0; q < 4; ++q) { const int col = cg * 32 + q * 8;
                float qf[8], kf[8], o1[8], o2[8], o3[8];
                unpack8(*(const v4u*)(P + (size_t)row * N0 + C0_Q + col), qf); unpack8(*(const v4u*)(P + (size_t)row * N0 + C0_K + col), kf);
#pragma unroll
                for (int j = 0; j < 8; ++j) { const float bt = lb[t * LBS + col + j], bl = lb[63 * LBS + col + j]; const float eb = __expf(bt);
                    o1[j] = qf[j] * eb; o2[j] = kf[j] * __expf(-bt); o3[j] = kf[j] * __expf(bl - bt); }
                const size_t o = ((size_t)dir * MALL + row) * 256 + col;
                *(GAS v4u*)(QD + o) = pack8(o1); *(GAS v4u*)(KI + o) = pack8(o2); *(GAS v4u*)(KS + o) = pack8(o3); }
            if (tid < 256) EB[(((size_t)dir * NB + b) * 68 + c) * 256 + tid] = __expf(lb[63 * LBS + tid]);
        }
        __syncthreads();
    }
}
#ifndef MK_ONLY
#define MK_ONLY -1
#endif
#define SON(s) (MK_ONLY < 0 || MK_ONLY == (s))
#define IN(k) (lo <= (k) && (k) < hi)
#ifndef MK_PROBE
#define MK_PROBE -1
#endif
#ifndef MK_REP
#define MK_REP -1
#endif
#define REPS(s) for (int _rep = 0; _rep < ((MK_REP == (s)) ? 2 : 1); ++_rep)
#define STAMP(k) do { if (MK_PROBE >= 0 && blockIdx.x == 0 && F.tid == 0) { const unsigned long long _t = wall_clock64(); __hip_atomic_store(F.ctl + 20000 + 2 * (k), (unsigned)_t, RLX_AGENT); __hip_atomic_store(F.ctl + 20001 + 2 * (k), (unsigned)(_t >> 32), RLX_AGENT); } } while (0)
#define SEAM(k) do { if (IN(k) && IN((k) + 1)) { xcd_barrier(bar); STAMP((k) + 1); } } while (0)
template <int layer>
__device__ __forceinline__ void layer_body(Frame& F, const int lo, const int hi, const XcdBarrier& bar) {
    unsigned char* const ws = ka_fresh().WS();
    bf16* const H = (bf16*)(ws + WS_H);
    bf16* const PROJ = (bf16*)(ws + WS_PROJ);
    float* const XRES = (float*)(ws + WS_XRES);
    float* const MOD = (float*)(ws + WS_MOD);

        const int pb = layer ? PH_INPROJ1 : PH_INPROJ0;
        if (SON(2) && IN(pb)) {
            pg8::Gemm g{H, (const bf16*)(ws + (layer ? WS_WIN1T : WS_WIN0T)), MALL, layer ? N1 : N0, 1024, 1024};
            pg8::StaticOrder S; S.init(g.M, g.N, F.G, (int)blockIdx.x);
            if constexpr (layer == 0 && !MK_NAIVE_S5) { pg8::EpiStoreU E{PROJ, g.N, (bf16*)(ws + WS_A2)};
                pg8::gemm_phase<pg8::EpiStoreU, pg8::StaticOrder, true, true>(F.lds, g, S, E); }
            else { pg8::EpiStore E{PROJ, g.N};
                pg8::gemm_phase<pg8::EpiStore, pg8::StaticOrder, true, true>(F.lds, g, S, E); }
        }
        SEAM(pb);
        if (layer == 0) {
#if MK_NAIVE_GLA
            SEAM(PH_GLAPREP);
            if (SON(3) && IN(PH_GLA)) rec_naive<64, true>(F, PROJ, N0, C0_Q, C0_K, C0_V, 128, 2, (float*)(ws + WS_OREC), (size_t)MALL * 512, 512, 0);
#else
            bf16* const GQD = (bf16*)(ws + WS_OREC + 280 * MiB); bf16* const GKI = GQD + (size_t)2 * MALL * 256; bf16* const GKS = GKI + (size_t)2 * MALL * 256; float* const GEB = (float*)(ws + WS_OREC + 384 * MiB);
            if (SON(13) && IN(PH_GLAPREP)) REPS(13) p_gla_prep(F, PROJ, GQD, GKI, GKS, GEB);
#if !MK_NAIVE_S5
            if (SON(17) && IN(PH_GLAPREP)) {
                __syncthreads();
                pg8::Gemm g{(const bf16*)(ws + WS_A2), (const bf16*)(ws + WS_S5W1), 32 * S5_ROWS, 256, 256, 512};
                pg8::GroupOrder S{9, 288, F.G, F.vcu};
                pg8::EpiF32Plain E{(float*)(ws + WS_SLOC)};
                pg8::gemm_phase<pg8::EpiF32Plain, pg8::GroupOrder, true, true>(F.lds, g, S, E);
            }
#endif
            SEAM(PH_GLAPREP);
#if !MK_NAIVE_S5
            if (SON(18) && IN(PH_GLA)) { p_s5_scan(F, (const float*)(ws + WS_SLOC), (bf16*)(ws + WS_A2)); __syncthreads(); }
#endif
            if (SON(3) && IN(PH_GLA)) REPS(3) rec_mfma<64, 32, true>(F, GQD, GKI, GKS, (size_t)MALL * 256, 256, 0, 0, PROJ, N0, C0_V, 128, GEB, (bf16*)(ws + WS_OREC), (size_t)MALL * 512, 512, 0);
#endif
            SEAM(PH_GLA);
#if MK_NAIVE_S5
            if (SON(4) && IN(PH_S5)) s5_naive(F, PROJ, (float*)(ws + WS_OREC) + (size_t)2 * MALL * 512);
#else
            if (SON(4) && IN(PH_S5)) {
                pg8::Gemm g{(const bf16*)(ws + WS_A2), (const bf16*)(ws + WS_S5W2), 32 * S5_ROWS, 256, 512, 512};
                pg8::GroupOrder S{9, 288, F.G, F.vcu};
                pg8::EpiS5Out E{(const bf16*)(ws + WS_A2), (bf16*)(ws + WS_YPRE), ka_fresh().I(I_S5D)};
                pg8::gemm_phase<pg8::EpiS5Out, pg8::GroupOrder, true, true>(F.lds, g, S, E);
            }
#endif
            if (SON(5) && IN(PH_FIN0)) REPS(5) p_finish0(F);
            SEAM(PH_FIN0);
            if (SON(6) && IN(PH_GLU)) {
                pg8::Gemm g{(const bf16*)(ws + WS_YPRE), (const bf16*)(ws + WS_WGLUT), MALL, 512, 512, 512};
                pg8::StaticOrder S; S.init(g.M, g.N, F.G, (int)blockIdx.x);
                pg8::EpiGlu E{(const bf16*)(ws + WS_YPRE), (bf16*)(ws + WS_MIX), 1024, 512, ka_fresh().I(I_GLUB)};
                pg8::gemm_phase<pg8::EpiGlu, pg8::StaticOrder, true, true>(F.lds, g, S, E);
            }
            SEAM(PH_GLU);
        } else {
            if (SON(14) && IN(PH_ROPE)) p_rope(F);
            SEAM(PH_ROPE);
#if MK_NAIVE_RET
            if (SON(15) && IN(PH_RET)) rec_naive<256, false>(F, PROJ, N1, C1_Q, C1_K, C1_V, 512, 8, (float*)(ws + WS_OREC), (size_t)NLAT * 2048, 2048, NCTX);
#else
            if (SON(15) && IN(PH_RET)) REPS(15) rec_mfma<256, 64, false>(F, PROJ, PROJ, PROJ, 0, N1, C1_Q, C1_K, PROJ, N1, C1_V, 512, nullptr, (bf16*)(ws + WS_OREC), (size_t)NLAT * 2048, 2048, NCTX);
#endif
            SEAM(PH_RET);
            if (SON(16) && IN(PH_FIN1)) REPS(16) p_finish1(F);
            SEAM(PH_FIN1);
        }
        const int po = layer ? PH_OUT1 : PH_OUT0;
        if (SON(7) && IN(po)) {
            pg8::Gemm g{(const bf16*)(ws + WS_MIX), (const bf16*)(ws + (layer ? WS_WOUT1T : WS_WOUT0T)), layer ? NLAT : MALL, 1024, layer ? 2048 : 1024, layer ? 2048 : 1024};
            pg8::StaticOrder S; S.init(g.M, g.N, F.G, (int)blockIdx.x);
            pg8::EpiResid E{ka_fresh().I(I_CTX), layer ? (const float*)(XRES + (size_t)NCTX * 1024) : ka_fresh().I(I_X), XRES, MOD + (size_t)layer * 9 * 6144 + 2048, layer ? 8 : 0};
            pg8::gemm_phase<pg8::EpiResid, pg8::StaticOrder, true, true>(F.lds, g, S, E);
        }
        SEAM(po);
        if (SON(8) && IN(po + 1)) p_router(F, layer);
        SEAM(po + 1);
        if (SON(10) && IN(po + 3)) {
            const int nt = moe_tables(F, layer);
            pg8::Gemm g{H, (const bf16*)(ws + WS_WGUT) + (size_t)layer * 32 * 2048 * 1024, nt * 256, 2048, 1024, 1024};
            pg8::MoeOrder S{(const PG8_LAS unsigned char*)(F.lds + L_TILEE), nt, 8, F.G, F.vcu, (const int*)(ws + WS_ELIST), (const PG8_LAS int*)(F.lds + L_TPOS), (const PG8_LAS int*)(F.lds + L_TCNT), layer ? NCTX : 0};
            pg8::EpiSwiglu E{(bf16*)(ws + WS_ACT), ka_fresh().I(I_BGU) + (size_t)layer * 32 * 2048};
            pg8::gemm_phase<pg8::EpiSwiglu, pg8::MoeOrder, true, true, true>(F.lds, g, S, E);
        }
        SEAM(po + 3);
        if (SON(11) && IN(po + 4)) {
            const int nt = moe_tables(F, layer);
            pg8::Gemm g{(const bf16*)(ws + WS_ACT), (const bf16*)(ws + WS_WDNT) + (size_t)layer * 32 * 1024 * 1024, nt * 256, 1024, 1024, 1024};
            pg8::MoeOrder S{(const PG8_LAS unsigned char*)(F.lds + L_TILEE), nt, 4, F.G, F.vcu, (const int*)(ws + WS_ELIST), (const PG8_LAS int*)(F.lds + L_TPOS), (const PG8_LAS int*)(F.lds + L_TCNT), 0};
            pg8::EpiDown E{(bf16*)(ws + WS_YSLOT), (const int*)(ws + WS_ELIST), (const PG8_LAS int*)(F.lds + L_TPOS), (const PG8_LAS int*)(F.lds + L_TCNT), (const float*)(ws + WS_WSLOT), ka_fresh().I(I_BDN) + (size_t)layer * 32 * 1024};
            pg8::gemm_phase<pg8::EpiDown, pg8::MoeOrder, true, true>(F.lds, g, S, E);
        }
        SEAM(po + 4);
        if (SON(12) && IN(po + 5)) p_combine(F, layer);
        SEAM(po + 5);
    }
__global__ void __launch_bounds__(NTHR, 2) mk_fwd(Args) {
    extern __shared__ __attribute__((aligned(16))) unsigned char lds[];
    Frame F;
    F.lds = (LAS unsigned char*)lds;
    F.MISC = (volatile LAS unsigned*)(F.lds + L_MISC);
    F.tid = threadIdx.x; F.lane = F.tid & 63; F.wave = __builtin_amdgcn_readfirstlane(F.tid >> 6);
    F.G = gridDim.x; { const int bx = blockIdx.x; F.vcu = (F.G % 8 == 0) ? (bx % 8) * (F.G / 8) + bx / 8 : bx; }
    const KA A0 = ka_fresh();
    unsigned char* ws = A0.WS();
    F.ctl = (unsigned*)(ws + WS_CTL);
    if (F.tid < 64) F.MISC[F.tid] = 0u;
    __syncthreads();
    const int lo = A0.LO(), hi = A0.HI();
    XcdBarrier bar; bar.bar = F.ctl + CW_BAR; bar.x = 0; bar.st = nullptr;
    if (hi - lo > 1) bar = xcd_barrier_post(F.ctl + CW_BAR, F.MISC + 8);

    STAMP(0);
    if (SON(0) && IN(0)) { REPS(0) { p0_prologue(F); __syncthreads(); } } SEAM(0);
    if (SON(1) && IN(1)) { REPS(1) p_norm1_l0(F); } SEAM(1);
    layer_body<0>(F, lo, hi, bar);
    layer_body<1>(F, lo, hi, bar);
}

#ifndef MK_MULTI
#define MK_MULTI 0
#endif
extern "C" void kernel_launch(void* const* d_in, const int* in_sizes, int n_in, void* d_out, int out_size, void* d_ws, size_t ws_size, hipStream_t stream) {
    static int grid = 0;
    if (grid == 0) {
        if (n_in != 34 || out_size != NLAT * D || ws_size < WS_END) { fprintf(stderr, "kernel_launch: unexpected sizes: n_in %d out %d ws %zu (need %zu)\n", n_in, out_size, ws_size, (size_t)WS_END); grid = -1; return; }
        int dev = 0, cus = 0;
        if (hipGetDevice(&dev) != hipSuccess || hipDeviceGetAttribute(&cus, hipDeviceAttributeMultiprocessorCount, dev) != hipSuccess) { grid = -1; return; }
        if (hipFuncSetAttribute((const void*)mk_fwd, hipFuncAttributeMaxDynamicSharedMemorySize, LDS_BYTES) != hipSuccess) { fprintf(stderr, "kernel_launch: hipFuncSetAttribute failed\n"); grid = -1; return; }
        int per_cu = 0;
        if (hipOccupancyMaxActiveBlocksPerMultiprocessor(&per_cu, (const void*)mk_fwd, NTHR, LDS_BYTES) != hipSuccess || per_cu < 1) fprintf(stderr, "kernel_launch: occupancy query says %d\n", per_cu);
        (void)hipGetLastError();
        grid = cus;
    }
    if (grid < 0) return;
    (void)in_sizes;
    (void)hipMemsetAsync((char*)d_ws + WS_CTL, 0, CTL_ZERO_BYTES, stream);
    Args a{};
    for (int i = 0; i < 34; ++i) a.in[i] = (const float*)d_in[i];
    a.out = (float*)d_out; a.ws = (unsigned char*)d_ws;
#if MK_MULTI
    for (int p = 0; p < NPH; ++p) { a.ph_lo = p; a.ph_hi = p + 1; hipLaunchKernelGGL(mk_fwd, dim3(grid), dim3(NTHR), LDS_BYTES, stream, a); }
#else
    a.ph_lo = 0; a.ph_hi = NPH; hipLaunchKernelGGL(mk_fwd, dim3(grid), dim3(NTHR), LDS_BYTES, stream, a);
#endif
}
```

```cpp
#include <hip/hip_runtime.h>
#include <cstdio>
#include <cstdint>
#include <cmath>
namespace pg8 {
#define PG8_LAS __attribute__((address_space(3)))
typedef unsigned short bf16_t;
typedef short bf16x8 __attribute__((ext_vector_type(8)));
typedef float f32x4 __attribute__((ext_vector_type(4)));
typedef unsigned u32x4 __attribute__((ext_vector_type(4)));
constexpr int BM = 256, BK = 64, HALF = 128, HTB = HALF * BK * 2  , STAGE_BYTES = 8 * HTB, NXCD = 8, WGM = 8;

__host__ __device__ __forceinline__ int lds_byte(int r, int c) { const int st = (r >> 4) * 2 + (c >> 5), rr = r & 15, cc = c & 31, ob = rr * 64 + cc * 2; return st * 1024 + (ob ^ (((ob >> 9) & 1) << 5)); }
__host__ __device__ __forceinline__ void stage_rc(int b, int& R, int& C) { const int st = b / 1024, sb = b % 1024, swz = sb ^ (((sb >> 9) & 1) << 5); R = (st >> 1) * 16 + swz / 64; C = (st & 1) * 32 + (swz % 64) / 2; }
__host__ __device__ __forceinline__ int perm32(int rho) { const int n = rho >> 4, i = rho & 15; return 8 * (i >> 2) + 4 * n + (i & 3); }

struct Unit { int pm, pn, pb, e; };
struct Gemm { const bf16_t* A; const bf16_t* Bt; int M, N, K, lda; };

struct StaticOrder {
    int nM, nN, nwg, G, c;
    __host__ __device__ void init(int M, int N, int G_, int c_) { nM = M / BM; nN = N / BM; nwg = nM * nN; G = G_; c = c_; }
    __host__ __device__ bool next(int i, Unit& u) const {
        const long L = (long)i * G + c; if (L >= nwg) return false;
        int wgid = (int)L; { const int q = nwg / NXCD, r = nwg % NXCD, xcd = wgid % NXCD, off = wgid / NXCD; wgid = (xcd < r ? xcd * (q + 1) : r * (q + 1) + (xcd - r) * q) + off; }
        const int nig = WGM * nN, gid = wgid / nig, fm = gid * WGM, gsz = (nM - fm) < WGM ? (nM - fm) : WGM;
        u.pm = fm + ((wgid % nig) % gsz); u.pn = (wgid % nig) / gsz; u.pb = u.pn; u.e = 0; return true;
    }
    __device__ __forceinline__ void a_ready(const Unit&) const {}
    __device__ __forceinline__ void done(const Unit&) const {}
};
__device__ __forceinline__ unsigned cvt_pk_bf16(float lo, float hi) { unsigned r; asm volatile("v_cvt_pk_bf16_f32 %0, %1, %2" : "=v"(r) : "v"(lo), "v"(hi)); return r; }
__device__ __forceinline__ float bflo(unsigned w) { return __uint_as_float(w << 16); }
__device__ __forceinline__ float bfhi(unsigned w) { return __uint_as_float(w & 0xffff0000u); }
__device__ __forceinline__ float sigmoidf_(float z) { return 1.0f / (1.0f + __expf(-z)); }

struct EpiStore {
    static constexpr bool PERM = true, AFTER_DRAIN = false;
    bf16_t* O; int ldc;
    __device__ __forceinline__ void operator()(const f32x4 (&acc)[2][2][4][2], const Unit& u, int wr, int wc, int fr, int fq) const {
        const int row0 = u.pm * BM + wr * 64 + fr, col0 = u.pn * BM + wc * 32 + 8 * fq;
#pragma unroll
        for (int ai = 0; ai < 2; ++ai)
#pragma unroll
            for (int m = 0; m < 4; ++m) { bf16_t* rowp = O + (size_t)(row0 + ai * HALF + m * 16) * ldc + col0;
#pragma unroll
                for (int bj = 0; bj < 2; ++bj) { const f32x4 v0 = acc[ai][bj][m][0], v1 = acc[ai][bj][m][1];
                    u32x4 w; w.x = cvt_pk_bf16(v0[0], v0[1]); w.y = cvt_pk_bf16(v0[2], v0[3]); w.z = cvt_pk_bf16(v1[0], v1[1]); w.w = cvt_pk_bf16(v1[2], v1[3]);
                    *(u32x4*)(rowp + bj * HALF) = w; } }
    }
};
struct EpiGlu {
    static constexpr bool PERM = true, AFTER_DRAIN = false;
    const bf16_t* Y; bf16_t* O; int ldo, ocol0; const float* bias;
    __device__ __forceinline__ void operator()(const f32x4 (&acc)[2][2][4][2], const Unit& u, int wr, int wc, int fr, int fq) const {
        const int row0 = u.pm * BM + wr * 64 + fr, col0 = u.pn * BM + wc * 32 + 8 * fq;
        f32x4 bv[2][2];
#pragma unroll
        for (int bj = 0; bj < 2; ++bj)
#pragma unroll
            for (int n = 0; n < 2; ++n) bv[bj][n] = *(const f32x4*)(bias + col0 + bj * HALF + 4 * n);
#pragma unroll
        for (int ai = 0; ai < 2; ++ai)
#pragma unroll
            for (int m = 0; m < 4; ++m) { const size_t row = (size_t)(row0 + ai * HALF + m * 16);
#pragma unroll
                for (int bj = 0; bj < 2; ++bj) { const int c = col0 + bj * HALF;
                    const u32x4 yv = *(const u32x4*)(Y + row * 512 + c);
                    const f32x4 z0 = acc[ai][bj][m][0] + bv[bj][0], z1 = acc[ai][bj][m][1] + bv[bj][1];
                    u32x4 w;
                    w.x = cvt_pk_bf16(bflo(yv.x) * sigmoidf_(z0[0]), bfhi(yv.x) * sigmoidf_(z0[1]));
                    w.y = cvt_pk_bf16(bflo(yv.y) * sigmoidf_(z0[2]), bfhi(yv.y) * sigmoidf_(z0[3]));
                    w.z = cvt_pk_bf16(bflo(yv.z) * sigmoidf_(z1[0]), bfhi(yv.z) * sigmoidf_(z1[1]));
                    w.w = cvt_pk_bf16(bflo(yv.w) * sigmoidf_(z1[2]), bfhi(yv.w) * sigmoidf_(z1[3]));
                    *(u32x4*)(O + row * ldo + ocol0 + c) = w; } }
    }
};
struct EpiResid {
    static constexpr bool PERM = false, AFTER_DRAIN = false;
    const float* base_ctx; const float* base_lat; float* out; const float* gate; int tile0;
    __device__ __forceinline__ void operator()(const f32x4 (&acc)[2][2][4][2], const Unit& u, int wr, int wc, int fr, int fq) const {
        const int gt = u.pm + tile0, bidx = gt < 8 ? 8 : ((gt - 8) >> 4);
        const float* bt = gt < 8 ? base_ctx + (size_t)gt * 256 * 1024 : base_lat + (size_t)(gt - 8) * 256 * 1024;
        float* ot = out + (size_t)gt * 256 * 1024;
        const int col0 = u.pn * BM + wc * 32 + 4 * fq;
        f32x4 gv[2][2];
#pragma unroll
        for (int bj = 0; bj < 2; ++bj)
#pragma unroll
            for (int n = 0; n < 2; ++n) gv[bj][n] = *(const f32x4*)(gate + bidx * 6144 + col0 + bj * HALF + n * 16);
#pragma unroll
        for (int ai = 0; ai < 2; ++ai)
#pragma unroll
            for (int m = 0; m < 4; ++m) { const size_t off = (size_t)(wr * 64 + fr + ai * HALF + m * 16) * 1024 + col0;
#pragma unroll
                for (int bj = 0; bj < 2; ++bj)
#pragma unroll
                    for (int n = 0; n < 2; ++n) { const f32x4 bs = *(const f32x4*)(bt + off + bj * HALF + n * 16);
                        *(f32x4*)(ot + off + bj * HALF + n * 16) = bs + gv[bj][n] * acc[ai][bj][m][n]; } }
    }
};
struct EpiSwiglu {
    static constexpr bool PERM = true, AFTER_DRAIN = false;
    bf16_t* ACT; const float* bgu;
    __device__ __forceinline__ void operator()(const f32x4 (&acc)[2][2][4][2], const Unit& u, int wr, int wc, int fr, int fq) const {
        const int row0 = u.pm * BM + wr * 64 + fr, lc0 = u.pn * 128 + wc * 32 + 8 * fq;
        const float* bb = bgu + (size_t)u.e * 2048 + lc0;
        f32x4 bg[2], bl[2];
#pragma unroll
        for (int n = 0; n < 2; ++n) { bg[n] = *(const f32x4*)(bb + 4 * n); bl[n] = *(const f32x4*)(bb + 1024 + 4 * n); }
#pragma unroll
        for (int ai = 0; ai < 2; ++ai)
#pragma unroll
            for (int m = 0; m < 4; ++m) { float a[8];
#pragma unroll
                for (int n = 0; n < 2; ++n)
#pragma unroll
                    for (int j = 0; j < 4; ++j) { const float g = fminf(acc[ai][0][m][n][j] + bg[n][j], 7.0f); float l = acc[ai][1][m][n][j] + bl[n][j]; l = fminf(fmaxf(l, -7.0f), 7.0f);
                        a[4 * n + j] = g * sigmoidf_(1.702f * g) * (l + 1.0f); }
                u32x4 w; w.x = cvt_pk_bf16(a[0], a[1]); w.y = cvt_pk_bf16(a[2], a[3]); w.z = cvt_pk_bf16(a[4], a[5]); w.w = cvt_pk_bf16(a[6], a[7]);
                *(u32x4*)(ACT + (size_t)(row0 + ai * HALF + m * 16) * 1024 + lc0) = w; }
    }
};
struct EpiDown {
    static constexpr bool PERM = true, AFTER_DRAIN = false;
    bf16_t* Y; const int* elist; const PG8_LAS int* tpos; const PG8_LAS int* tcnt; const float* w_slot; const float* bdn;
    __device__ __forceinline__ void operator()(const f32x4 (&acc)[2][2][4][2], const Unit& u, int wr, int wc, int fr, int fq) const {
        const int col0 = u.pn * BM + wc * 32 + 8 * fq, tp0 = tpos[u.pm], tc0 = tcnt[u.pm]; const int* el = elist + (size_t)u.e * 34816;
        f32x4 bv[2][2];
#pragma unroll
        for (int bj = 0; bj < 2; ++bj)
#pragma unroll
            for (int n = 0; n < 2; ++n) bv[bj][n] = *(const f32x4*)(bdn + (size_t)u.e * 1024 + col0 + bj * HALF + 4 * n);
#pragma unroll
        for (int ai = 0; ai < 2; ++ai)
#pragma unroll
            for (int m = 0; m < 4; ++m) { const int pos = tp0 + wr * 64 + fr + ai * HALF + m * 16; const int slot = pos < tc0 ? el[pos] : -1;
                if (slot >= 0) { const float ws = w_slot[slot]; bf16_t* rowp = Y + (size_t)slot * 1024 + col0;
#pragma unroll
                    for (int bj = 0; bj < 2; ++bj) { const f32x4 v0 = (acc[ai][bj][m][0] + bv[bj][0]) * ws, v1 = (acc[ai][bj][m][1] + bv[bj][1]) * ws;
                        u32x4 w; w.x = cvt_pk_bf16(v0[0], v0[1]); w.y = cvt_pk_bf16(v0[2], v0[3]); w.z = cvt_pk_bf16(v1[0], v1[1]); w.w = cvt_pk_bf16(v1[2], v1[3]);
                        *(u32x4*)(rowp + bj * HALF) = w; } } }
    }
};
struct MoeOrder {
    const PG8_LAS unsigned char* tile_e; int ntiles, NT, G, c; const int* elist; const PG8_LAS int* tpos; const PG8_LAS int* tcnt; int row0;
    __device__ __forceinline__ int rowidx(const Unit& u, int r) const { const int pos = tpos[u.pm] + r; const int s = pos < tcnt[u.pm] ? elist[(size_t)u.e * 34816 + pos] : 0; return row0 + (s >> 2); }
    __device__ __forceinline__ bool next(int i, Unit& u) const {
        const int L = i * G + c; if (L >= ntiles * NT) return false;
        const int T = L / NT; u.pm = T; u.pn = L - T * NT; u.e = __builtin_amdgcn_readfirstlane((int)tile_e[T]); u.pb = u.e * NT + u.pn; return true;
    }
    __device__ __forceinline__ void a_ready(const Unit&) const {}
    __device__ __forceinline__ void done(const Unit&) const {}
};

struct EpiStoreU {
    static constexpr bool PERM = true, AFTER_DRAIN = false;
    bf16_t* O; int ldc; bf16_t* A2;
    __device__ __forceinline__ void operator()(const f32x4 (&acc)[2][2][4][2], const Unit& u, int wr, int wc, int fr, int fq) const {
        const int row0 = u.pm * BM + wr * 64 + fr, col0 = u.pn * BM + wc * 32 + 8 * fq;
#pragma unroll
        for (int ai = 0; ai < 2; ++ai)
#pragma unroll
            for (int m = 0; m < 4; ++m) { const int R = row0 + ai * HALF + m * 16; bf16_t* rowp = O + (size_t)R * ldc + col0;
                int r, t; if (R < 2048) { r = (R >> 8) * 272 + ((R & 255) >> 4); t = R & 15; } else { const int R2 = R - 2048; r = (R2 >> 12) * 272 + 16 + ((R2 & 4095) >> 4); t = R2 & 15; }
#pragma unroll
                for (int bj = 0; bj < 2; ++bj) { const f32x4 v0 = acc[ai][bj][m][0], v1 = acc[ai][bj][m][1];
                    u32x4 w; w.x = cvt_pk_bf16(v0[0], v0[1]); w.y = cvt_pk_bf16(v0[2], v0[3]); w.z = cvt_pk_bf16(v1[0], v1[1]); w.w = cvt_pk_bf16(v1[2], v1[3]);
                    *(u32x4*)(rowp + bj * HALF) = w;
                    if (u.pn >= 6) { const int g = (u.pn - 6) * 16 + bj * 8 + wc * 2 + (fq >> 1);
                        *(u32x4*)(A2 + ((size_t)g * 2304 + r) * 512 + t * 16 + (fq & 1) * 8) = w; } } }
    }
};
struct EpiF32Plain {
    static constexpr bool PERM = true, AFTER_DRAIN = false;
    float* C;
    __device__ __forceinline__ void operator()(const f32x4 (&acc)[2][2][4][2], const Unit& u, int wr, int wc, int fr, int fq) const {
        float* base = C + (size_t)(u.pm * BM + wr * 64 + fr) * 256 + wc * 32 + 8 * fq;
#pragma unroll
        for (int ai = 0; ai < 2; ++ai)
#pragma unroll
            for (int m = 0; m < 4; ++m) {
#pragma unroll
                for (int bj = 0; bj < 2; ++bj) { float* p = base + (ai * HALF + m * 16) * 256 + bj * HALF;
                    *(f32x4*)p = acc[ai][bj][m][0]; *(f32x4*)(p + 4) = acc[ai][bj][m][1]; } }
    }
};
struct EpiS5Out {
    static constexpr bool PERM = true, AFTER_DRAIN = false;
    const bf16_t* A2; bf16_t* YP; const float* dskip;
    __device__ __forceinline__ void operator()(const f32x4 (&acc)[2][2][4][2], const Unit& u, int wr, int wc, int fr, int fq) const {
        const int g = u.e;
#pragma unroll
        for (int ai = 0; ai < 2; ++ai)
#pragma unroll
            for (int m = 0; m < 4; ++m) { const int rr = (u.pm - g * 9) * BM + wr * 64 + fr + ai * HALF + m * 16;
                if (rr < 2176) { const int b = rr / 272, n = rr - b * 272;
                    const int tok0 = n < 16 ? b * 256 + n * 16 : 2048 + b * 4096 + (n - 16) * 16;
#pragma unroll
                    for (int bj = 0; bj < 2; ++bj) { const int col = bj * HALF + wc * 32 + 8 * fq, t = col >> 4, c0 = col & 15;
                        const u32x4 uv = *(const u32x4*)(A2 + ((size_t)g * 2304 + rr) * 512 + col);
                        const f32x4 d0 = *(const f32x4*)(dskip + g * 16 + c0), d1 = *(const f32x4*)(dskip + g * 16 + c0 + 4);
                        float y[8];
                        y[0] = acc[ai][bj][m][0][0] + d0[0] * bflo(uv.x); y[1] = acc[ai][bj][m][0][1] + d0[1] * bfhi(uv.x); y[2] = acc[ai][bj][m][0][2] + d0[2] * bflo(uv.y); y[3] = acc[ai][bj][m][0][3] + d0[3] * bfhi(uv.y);
                        y[4] = acc[ai][bj][m][1][0] + d1[0] * bflo(uv.z); y[5] = acc[ai][bj][m][1][1] + d1[1] * bfhi(uv.z); y[6] = acc[ai][bj][m][1][2] + d1[2] * bflo(uv.w); y[7] = acc[ai][bj][m][1][3] + d1[3] * bfhi(uv.w);
#pragma unroll
                        for (int j = 0; j < 8; ++j) { const float z = y[j], th = 0.7978845608f * (z + 0.044715f * z * z * z); const float e2 = __expf(2.0f * th); y[j] = 0.5f * z * (1.0f + (1.0f - 2.0f / (e2 + 1.0f))); }
                        u32x4 w; w.x = cvt_pk_bf16(y[0], y[1]); w.y = cvt_pk_bf16(y[2], y[3]); w.z = cvt_pk_bf16(y[4], y[5]); w.w = cvt_pk_bf16(y[6], y[7]);
                        *(u32x4*)(YP + (size_t)(tok0 + t) * 512 + g * 16 + c0) = w; } } }
    }
};
struct GroupOrder {
    int tpg, nunits, G, c;
    __device__ __forceinline__ bool next(int i, Unit& u) const { const int L = i * G + c; if (L >= nunits) return false; u.pm = L; u.pn = 0; u.e = L / tpg; u.pb = u.e; return true; }
    __device__ __forceinline__ void a_ready(const Unit&) const {}
    __device__ __forceinline__ void done(const Unit&) const {}
};
template <class Epi, class Sched, bool ALIGN_EPI = false, bool SP2 = false, bool GATHER = false>
__device__ __forceinline__ void gemm_phase(PG8_LAS unsigned char* lds, const Gemm g, const Sched& S, const Epi& E) {
    static_assert(!GATHER || SP2, "gathered A staging is implemented in the SP2 loop only");
    const int tid = threadIdx.x, wid = __builtin_amdgcn_readfirstlane(tid >> 6), lane = tid & 63, wr = wid >> 2, wc = wid & 3, fr = lane & 15, fq = lane >> 4;
    int K_ = g.K; asm volatile("" : "+s"(K_));
    const int K = K_, nt = K / BK;
    unsigned voffA[2], voffB[2];
#pragma unroll
    for (int i = 0; i < 2; ++i) { int R, C; stage_rc(tid * 16 + i * 8192, R, C); const int Rb = Epi::PERM ? ((R & ~31) + perm32(R & 31)) : R;
        voffA[i] = (unsigned)(R * g.lda + C) * 2u; voffB[i] = (unsigned)(Rb * K + C) * 2u; }
    const size_t kstep = (size_t)(BK * 2);
    const size_t hstep = (size_t)HALF * K * 2;
    const size_t tstep = 2 * hstep;
    const size_t hstepA = (size_t)HALF * g.lda * 2, tstepA = 2 * hstepA;
    const unsigned ldsw = (unsigned)wid * 1024u;
    const int aoff = lds_byte(wr * 64 + fr, fq * 8), boff = lds_byte(wc * 32 + fr, fq * 8);
#define PG8_SA(b, h) (((b) * 2 + (h)) * HTB)
#define PG8_SB(b, h) ((4 + (b) * 2 + (h)) * HTB)
#define PG8_STAGE(bufoff, gbase, voff) do { _Pragma("unroll") for (int _i = 0; _i < 2; ++_i) \
        __builtin_amdgcn_global_load_lds((const unsigned*)((const char*)(gbase) + (voff)[_i]), (PG8_LAS unsigned*)(lds + (bufoff) + ldsw + _i * 8192), 16, 0, 0); } while (0)
#define PG8_STAGE_H0(bufoff, gbase) do { if constexpr (GATHER) PG8_STAGE(bufoff, gbase, voffA0); else PG8_STAGE(bufoff, gbase, voffA); } while (0)
#define PG8_STAGE_H1(bufoff, gbase) do { if constexpr (GATHER) PG8_STAGE(bufoff, gbase, voffA1); else PG8_STAGE(bufoff, (gbase) + hstepA, voffA); } while (0)
#define PG8_GOFF(unit, h, dst) do { _Pragma("unroll") for (int _i = 0; _i < 2; ++_i) { int _R, _C; stage_rc(tid * 16 + _i * 8192, _R, _C); dst[_i] = (unsigned)S.rowidx(unit, (h) * HALF + _R); } } while (0)
#define PG8_GCONV(dst, src) do { _Pragma("unroll") for (int _i = 0; _i < 2; ++_i) { int _R, _C; stage_rc(tid * 16 + _i * 8192, _R, _C); dst[_i] = (src[_i] * (unsigned)g.lda + (unsigned)_C) * 2u; } } while (0)
#define PG8_LDA(dst, b, h) do { _Pragma("unroll") for (int m = 0; m < 4; ++m) _Pragma("unroll") for (int k = 0; k < 2; ++k) dst[m][k] = *(const PG8_LAS bf16x8*)(lds + PG8_SA(b, h) + aoff + m * 2048 + k * 1024); } while (0)
#define PG8_LDB(dst, b, h) do { _Pragma("unroll") for (int n = 0; n < 2; ++n) _Pragma("unroll") for (int k = 0; k < 2; ++k) dst[n][k] = *(const PG8_LAS bf16x8*)(lds + PG8_SB(b, h) + boff + n * 2048 + k * 1024); } while (0)
#define PG8_MMA(ai, bj, At, Bt) do { __builtin_amdgcn_s_setprio(1); _Pragma("unroll") for (int m = 0; m < 4; ++m) _Pragma("unroll") for (int n = 0; n < 2; ++n) _Pragma("unroll") for (int k = 0; k < 2; ++k) \
        acc[ai][bj][m][n] = __builtin_amdgcn_mfma_f32_16x16x32_bf16(Bt[n][k], At[m][k], acc[ai][bj][m][n], 0, 0, 0); __builtin_amdgcn_s_setprio(0); } while (0)
#define PG8_WAIT_V(n) asm volatile("s_waitcnt vmcnt(" #n ")" ::: "memory")
#define PG8_WAIT_L(n) asm volatile("s_waitcnt lgkmcnt(" #n ")" ::: "memory")
#define PG8_BAR __builtin_amdgcn_s_barrier()
#define PG8_SCHED __builtin_amdgcn_sched_barrier(0)
    Unit cur, nxt; int ui = 0;
    if (!S.next(0, cur)) return;
    f32x4 acc[2][2][4][2];
#pragma unroll
    for (int a = 0; a < 2; ++a)
#pragma unroll
        for (int b = 0; b < 2; ++b)
#pragma unroll
            for (int m = 0; m < 4; ++m)
#pragma unroll
                for (int n = 0; n < 2; ++n) acc[a][b][m][n] = (f32x4){0.f, 0.f, 0.f, 0.f};
    bf16x8 At[4][2], B0[2][2], B1[2][2];
    const char* cA = (const char*)g.A + (GATHER ? (size_t)0 : (size_t)cur.pm * tstepA);
    unsigned voffA0[2] = {0u, 0u}, voffA1[2] = {0u, 0u}, nidx0[2] = {0u, 0u}, nidx1[2] = {0u, 0u};
    if constexpr (GATHER) { PG8_GOFF(cur, 0, nidx0); PG8_GOFF(cur, 1, nidx1); PG8_GCONV(voffA0, nidx0); PG8_GCONV(voffA1, nidx1); } const char* cB = (const char*)g.Bt + (size_t)cur.pb * tstep;
    S.a_ready(cur);
    if constexpr (SP2) {
        PG8_STAGE(PG8_SB(0, 0), cB, voffB); PG8_STAGE(PG8_SB(0, 1), cB + hstep, voffB); PG8_STAGE_H0(PG8_SA(0, 0), cA); PG8_STAGE_H1(PG8_SA(0, 1), cA);
        if (wr == 1) PG8_BAR;
        PG8_WAIT_V(2); PG8_BAR;
        PG8_STAGE(PG8_SB(1, 0), cB + kstep, voffB); PG8_STAGE_H0(PG8_SA(1, 0), cA + kstep); PG8_STAGE(PG8_SB(1, 1), cB + hstep + kstep, voffB);
        PG8_WAIT_V(6); PG8_BAR;
    } else {
        PG8_STAGE(PG8_SB(0, 0), cB, voffB); PG8_STAGE_H0(PG8_SA(0, 0), cA); PG8_STAGE(PG8_SB(0, 1), cB + hstep, voffB); PG8_STAGE_H1(PG8_SA(0, 1), cA);
        if (wr == 1) PG8_BAR;
        PG8_WAIT_V(4); PG8_BAR;
        PG8_STAGE(PG8_SB(1, 0), cB + kstep, voffB); PG8_STAGE_H0(PG8_SA(1, 0), cA + kstep); PG8_STAGE(PG8_SB(1, 1), cB + hstep + kstep, voffB);
        PG8_WAIT_V(6); PG8_BAR;
    }
    for (;;) {
        const bool has_next = S.next(ui + 1, nxt);
        const char* nA = (has_next && !GATHER) ? (const char*)g.A + (size_t)nxt.pm * tstepA : cA; const char* nB = has_next ? (const char*)g.Bt + (size_t)nxt.pb * tstep : cB;
        for (int t = 0; t < nt; t += 2) {
            const bool last = (t == nt - 2);
            const char* a1 = cA + (size_t)(t + 1) * kstep;
            const char* a2 = last ? nA : cA + (size_t)(t + 2) * kstep; const char* b2 = last ? nB : cB + (size_t)(t + 2) * kstep;
            const char* a3 = a2 + kstep; const char* b3 = b2 + kstep;
            if (last && has_next) S.a_ready(nxt);
            if constexpr (GATHER) { if (has_next && t == nt - 4) { PG8_GOFF(nxt, 0, nidx0); PG8_GOFF(nxt, 1, nidx1); }
                                    if (has_next && last) PG8_GCONV(voffA0, nidx0); }
            if constexpr (SP2) {
            PG8_LDB(B0, 0, 0); PG8_LDB(B1, 0, 1); PG8_SCHED; PG8_LDA(At, 0, 0); PG8_STAGE_H1(PG8_SA(1, 1), a1);
            if constexpr (GATHER) { if (has_next && last) PG8_GCONV(voffA1, nidx1); }
            PG8_WAIT_V(8); PG8_WAIT_L(0); PG8_BAR; PG8_MMA(0, 0, At, B0); PG8_MMA(0, 1, At, B1); PG8_BAR; PG8_SCHED;
            PG8_LDA(At, 0, 1); PG8_STAGE(PG8_SB(0, 0), b2, voffB); PG8_STAGE(PG8_SB(0, 1), b2 + hstep, voffB); PG8_STAGE_H0(PG8_SA(0, 0), a2);
            PG8_WAIT_V(8); PG8_WAIT_L(0); PG8_BAR; PG8_MMA(1, 0, At, B0); PG8_MMA(1, 1, At, B1); PG8_BAR; PG8_SCHED;
            PG8_LDB(B0, 1, 0); PG8_LDB(B1, 1, 1); PG8_SCHED; PG8_LDA(At, 1, 0); PG8_STAGE_H1(PG8_SA(0, 1), a2);
            PG8_WAIT_V(8); PG8_WAIT_L(0); PG8_BAR; PG8_MMA(0, 0, At, B0); PG8_MMA(0, 1, At, B1); PG8_BAR; PG8_SCHED;
            PG8_LDA(At, 1, 1); PG8_STAGE(PG8_SB(1, 0), b3, voffB); PG8_STAGE(PG8_SB(1, 1), b3 + hstep, voffB); PG8_STAGE_H0(PG8_SA(1, 0), a3);
            PG8_WAIT_V(8); PG8_WAIT_L(0); PG8_BAR; PG8_MMA(1, 0, At, B0); PG8_MMA(1, 1, At, B1); PG8_BAR; PG8_SCHED;
            } else {
            PG8_LDB(B0, 0, 0); PG8_SCHED; PG8_LDA(At, 0, 0); PG8_STAGE(PG8_SA(1, 1), a1 + hstepA, voffA);
            PG8_WAIT_L(8); PG8_BAR; PG8_WAIT_L(0); PG8_MMA(0, 0, At, B0); PG8_BAR; PG8_SCHED;
            PG8_LDB(B1, 0, 1); PG8_STAGE(PG8_SB(0, 0), b2, voffB);
            PG8_BAR; PG8_WAIT_L(0); PG8_MMA(0, 1, At, B1); PG8_BAR;
            PG8_LDA(At, 0, 1); PG8_STAGE(PG8_SA(0, 0), a2, voffA);
            PG8_BAR; PG8_WAIT_L(0); PG8_MMA(1, 0, At, B0); PG8_BAR; PG8_SCHED;
            PG8_STAGE(PG8_SB(0, 1), b2 + hstep, voffB);
            PG8_WAIT_V(6); PG8_BAR; PG8_MMA(1, 1, At, B1); PG8_BAR;
            PG8_LDB(B0, 1, 0); PG8_SCHED; PG8_LDA(At, 1, 0); PG8_STAGE(PG8_SA(0, 1), a2 + hstepA, voffA);
            PG8_WAIT_L(8); PG8_BAR; PG8_WAIT_L(0); PG8_MMA(0, 0, At, B0); PG8_BAR; PG8_SCHED;
            PG8_LDB(B1, 1, 1); PG8_STAGE(PG8_SB(1, 0), b3, voffB);
            PG8_BAR; PG8_WAIT_L(0); PG8_MMA(0, 1, At, B1); PG8_BAR;
            PG8_LDA(At, 1, 1); PG8_STAGE(PG8_SA(1, 0), a3, voffA);
            PG8_BAR; PG8_WAIT_L(0); PG8_MMA(1, 0, At, B0); PG8_BAR; PG8_SCHED;
            PG8_STAGE(PG8_SB(1, 1), b3 + hstep, voffB);
            PG8_WAIT_V(6); PG8_BAR; PG8_MMA(1, 1, At, B1); PG8_BAR;
            }
        }
        if constexpr (ALIGN_EPI) { if (wr == 0) PG8_BAR; }
        if constexpr (!Epi::AFTER_DRAIN) { E(acc, cur, wr, wc, fr, fq); S.done(cur); }
        if (!has_next) break;
#pragma unroll
        for (int a = 0; a < 2; ++a)
#pragma unroll
            for (int b = 0; b < 2; ++b)
#pragma unroll
                for (int m = 0; m < 4; ++m)
#pragma unroll
                    for (int n = 0; n < 2; ++n) acc[a][b][m][n] = (f32x4){0.f, 0.f, 0.f, 0.f};
        cur = nxt; cA = nA; cB = nB; ++ui;
        if constexpr (ALIGN_EPI) { if (wr == 1) PG8_BAR; }
    }
    PG8_WAIT_V(0);
    if constexpr (!ALIGN_EPI) { if (wr == 0) PG8_BAR; }
    PG8_BAR;
    if constexpr (Epi::AFTER_DRAIN) { E.fused(acc, cur, wr, wc, fr, fq, lds, wid, lane); S.done(cur); }
#undef PG8_SA
#undef PG8_SB
#undef PG8_STAGE
#undef PG8_STAGE_H0
#undef PG8_STAGE_H1
#undef PG8_GOFF
#undef PG8_GCONV
#undef PG8_LDA
#undef PG8_LDB
#undef PG8_MMA
#undef PG8_WAIT_V
#undef PG8_WAIT_L
#undef PG8_BAR
#undef PG8_SCHED
}
}
constexpr int NWAVES = 8, NTHR = 512;
constexpr int D = 1024, NB = 8, SEQ = 4096, CTX = 256;
constexpr int NCTX = NB * CTX, NLAT = NB * SEQ, MALL = NCTX + NLAT;
constexpr int N0 = 2304, N1 = 6144;
constexpr int C0_Q = 0, C0_K = 256, C0_V = 512, C0_G = 1024, C0_U = 1536, C0_LOW = 2048;
constexpr int C1_Q = 0, C1_K = 1024, C1_V = 2048, C1_G = 4096;
constexpr int NE = 32, MAXTILES = 576;
constexpr float EPS = 1e-6f;
constexpr int NPH = 24;
enum { PH_PRO = 0, PH_NORM1, PH_INPROJ0, PH_GLAPREP, PH_GLA, PH_S5, PH_FIN0, PH_GLU, PH_OUT0, PH_ROUTER0, PH_GATHER0, PH_GU0, PH_DOWN0, PH_COMB0,
       PH_INPROJ1, PH_ROPE, PH_RET, PH_FIN1, PH_OUT1, PH_ROUTER1, PH_GATHER1, PH_GU1, PH_DOWN1, PH_COMB1 };
#ifndef MK_NAIVE_GLA
#define MK_NAIVE_GLA 0
#endif
#ifndef MK_NAIVE_S5
#define MK_NAIVE_S5 0
#endif
#ifndef MK_NAIVE_RET
#define MK_NAIVE_RET 0
#endif
constexpr size_t MiB = 1u << 20;
constexpr size_t WS_CTL = 0, CTL_ZERO_BYTES = 1 * MiB;
constexpr size_t WS_MOD = 1 * MiB;
constexpr size_t WS_WIN0T = 2 * MiB, WS_WOUT0T = 7 * MiB, WS_WGLUT = 9 * MiB, WS_WIN1T = 10 * MiB, WS_WOUT1T = 22 * MiB;
constexpr size_t WS_SELE = 26 * MiB, WS_WSLOT = 27 * MiB, WS_SPOS = 28 * MiB, WS_PROW = 29 * MiB;
constexpr size_t WS_WGUT = 32 * MiB, WS_WDNT = 288 * MiB;
constexpr size_t WS_XRES = 416 * MiB, WS_H = 552 * MiB, WS_MIX = 620 * MiB, WS_YPRE = 688 * MiB;
constexpr size_t WS_PROJ = 748 * MiB, WS_OREC = 1156 * MiB;
constexpr size_t WS_XG = 748 * MiB, WS_ACT = 1036 * MiB, WS_YSLOT = 1324 * MiB;
constexpr size_t WS_S5W1 = 1556 * MiB, WS_S5W2 = 1560 * MiB, WS_A2 = 1568 * MiB, WS_SLOC = 1668 * MiB;
constexpr size_t WS_ELIST = 1740 * MiB;
constexpr size_t WS_END = 1746 * MiB;
constexpr int CW_TMO = 0, CW_BAR = 4096, CW_GCNT = 16384;
constexpr int RING_BYTES = 131072, LDSCTL_OFF = RING_BYTES, LDS_BYTES = 147456;
constexpr int L_MISC = LDSCTL_OFF;
constexpr int L_TILEE = LDSCTL_OFF + 256;
constexpr int L_TSTART = LDSCTL_OFF + 1024;
constexpr int L_LCNT = LDSCTL_OFF + 1280;
constexpr int L_GBASE = LDSCTL_OFF + 1536;
constexpr int L_BLKE = LDSCTL_OFF + 2048;
constexpr int L_BLKP = LDSCTL_OFF + 5120;
constexpr int L_TPOS = L_BLKE, L_TCNT = L_BLKP;

#define GAS __attribute__((address_space(1)))
#define LAS __attribute__((address_space(3)))
typedef unsigned short bf16;
typedef unsigned v4u __attribute__((ext_vector_type(4)));
typedef unsigned v2u __attribute__((ext_vector_type(2)));
typedef float f32x4 __attribute__((ext_vector_type(4)));
typedef GAS unsigned gu32;
#define RLX_AGENT __ATOMIC_RELAXED, __HIP_MEMORY_SCOPE_AGENT
#define LDS_WAIT() asm volatile("s_waitcnt lgkmcnt(0)" ::: "memory")
#define VM_WAIT() asm volatile("s_waitcnt vmcnt(0)" ::: "memory")
__device__ __forceinline__ unsigned f2bf(float f) { unsigned u = __builtin_bit_cast(unsigned, f); return (u + 0x7fffu + ((u >> 16) & 1u)) >> 16; }
__device__ __forceinline__ unsigned pk2(float lo, float hi) { return f2bf(lo) | (f2bf(hi) << 16); }
__device__ __forceinline__ float bf2f(unsigned b) { return __uint_as_float(b << 16); }
__device__ __forceinline__ float blo(unsigned w) { return __uint_as_float(w << 16); }
__device__ __forceinline__ float bhi(unsigned w) { return __uint_as_float(w & 0xffff0000u); }
__device__ __forceinline__ float wave_sum(float v) {
#pragma unroll
    for (int o = 1; o < 64; o <<= 1) v += __shfl_xor(v, o);
    return v;
}
__device__ __forceinline__ float silu_(float z) { return z / (1.0f + __expf(-z)); }
#define XB_TMO      128
#define XB_XCNT(j)  (256  + 64 * (j))
#define XB_XSUB(j)  (1280 + 64 * (j))
#define XB_XGEN(j)  (2304 + 64 * (j))
#define XB_TOP      3328
#define XB_TOPGEN   3392
#define XCD_BAR_WORDS 3456
#define XB_SPIN_CAP (1u << 22)

__device__ __forceinline__ unsigned xb_ld(unsigned* p)              { return __hip_atomic_load(p, __ATOMIC_RELAXED, __HIP_MEMORY_SCOPE_AGENT); }
__device__ __forceinline__ unsigned xb_add(unsigned* p, unsigned v) { return __hip_atomic_fetch_add(p, v, __ATOMIC_RELAXED, __HIP_MEMORY_SCOPE_AGENT); }
__device__ __forceinline__ unsigned xb_xcc_id() { return (unsigned)__builtin_amdgcn_s_getreg((3 << 11) | 20) & 0xFu; }
#define XB_SPIN(cond, bar) do { unsigned _sp = 0; while (cond) { __builtin_amdgcn_s_sleep(1); \
    if ((++_sp & 255u) == 0u) { if (xb_ld(&(bar)[XB_TMO])) break; if (_sp > XB_SPIN_CAP) { atomicAdd(&(bar)[XB_TMO], 1u); break; } } } } while (0)

struct XcdBarrier {
    unsigned* bar; unsigned x;
    volatile LAS unsigned* st;
};

__device__ __forceinline__ XcdBarrier xcd_barrier_post(unsigned* bar, volatile LAS unsigned* st) {
    XcdBarrier b; b.bar = bar; b.x = xb_xcc_id(); b.st = st;
    if (threadIdx.x == 0) (void)xb_add(&bar[XB_XCNT(b.x)], 1u);
    return b;
}
__device__ __forceinline__ void xcd_barrier_complete(unsigned* bar, unsigned x, unsigned& nloc, unsigned& nx) {
    const unsigned G = gridDim.x * gridDim.y * gridDim.z;
    unsigned sum, cnt, mine, sp = 0u;
    for (;;) {
        sum = 0u; cnt = 0u; mine = 0u;
#pragma unroll
        for (unsigned j = 0; j < 16; ++j) { const unsigned c = xb_ld(&bar[XB_XCNT(j)]); sum += c; cnt += (c > 0u) ? 1u : 0u; mine = (j == x) ? c : mine; }
        if (sum == G) break;
        __builtin_amdgcn_s_sleep(1);
        if ((++sp & 255u) == 0u) { if (xb_ld(&bar[XB_TMO])) break; if (sp > XB_SPIN_CAP) { atomicAdd(&bar[XB_TMO], 1u); break; } }
    }
    nloc = mine > 0u ? mine : 1u; nx = cnt > 0u ? cnt : 1u;
}

__device__ __forceinline__ void xcd_barrier(const XcdBarrier& b) {
    asm volatile("s_waitcnt vmcnt(0)" ::: "memory");
    __syncthreads();
    if (threadIdx.x == 0) {
        unsigned* bar = b.bar;
        __builtin_amdgcn_s_waitcnt(0);
        unsigned nloc = b.st[0], nx = b.st[1];
        if (nloc == 0u) { xcd_barrier_complete(bar, b.x, nloc, nx); b.st[0] = nloc; b.st[1] = nx; }
        const unsigned old = xb_add(&bar[XB_XSUB(b.x)], 1u);
        const unsigned gen = old / nloc;
        if (old + 1u == (gen + 1u) * nloc) {
            __builtin_amdgcn_fence(__ATOMIC_RELEASE, "agent");
            asm volatile("s_waitcnt vmcnt(0)" ::: "memory");
            const unsigned og = xb_add(&bar[XB_TOP], 1u);
            const unsigned tg = og / nx;
            if (og + 1u == (tg + 1u) * nx) xb_add(&bar[XB_TOPGEN], 1u);
            else XB_SPIN(xb_ld(&bar[XB_TOPGEN]) == tg, bar);
            __builtin_amdgcn_fence(__ATOMIC_ACQUIRE, "agent");
            xb_add(&bar[XB_XGEN(b.x)], 1u);
            asm volatile("s_waitcnt vmcnt(0)" ::: "memory");
        } else {
            XB_SPIN(xb_ld(&bar[XB_XGEN(b.x)]) == gen, bar);
            __builtin_amdgcn_fence(__ATOMIC_ACQUIRE, "agent");
            asm volatile("s_waitcnt vmcnt(0)" ::: "memory");
        }
    }
    __syncthreads();
}
struct Args { const float* in[34]; float* out; unsigned char* ws; int ph_lo, ph_hi; };
#define CAS __attribute__((address_space(4)))
struct KA {
    const CAS unsigned char* p;
    __device__ __forceinline__ const float* I(int i) const { return *(const float* const CAS*)(p + 8 * i); }
    __device__ __forceinline__ float* OUT() const { return *(float* const CAS*)(p + 8 * 34); }
    __device__ __forceinline__ unsigned char* WS() const { return *(unsigned char* const CAS*)(p + 8 * 35); }
    __device__ __forceinline__ int LO() const { return *(const CAS int*)(p + 8 * 36); }
    __device__ __forceinline__ int HI() const { return *(const CAS int*)(p + 8 * 36 + 4); }
};
__device__ __forceinline__ KA ka_fresh() { KA a; a.p = (const CAS unsigned char*)__builtin_amdgcn_kernarg_segment_ptr(); asm volatile("" : "+s"(a.p)); return a; }
static_assert(sizeof(Args) == 8 * 36 + 8, "kernarg layout");
struct Frame {
    LAS unsigned char* lds;
    volatile LAS unsigned* MISC;
    unsigned* ctl;
    int tid, lane, wave, vcu, G;
};
enum { I_X = 0, I_C, I_CTX, I_CCTX, I_ADAW, I_ADAB, I_N1G, I_N2G, I_ABWIN, I_ABWOUT, I_GLAWA, I_GLABA, I_GLANG, I_LAMRE, I_LAMIM, I_LOGSTEP, I_BRE, I_BIM, I_CRE, I_CIM,
       I_S5D, I_GLUW, I_GLUB, I_RETWIN, I_RETWOUT, I_RETDEC, I_RETNG, I_WROUTER, I_BROUTER, I_WGU, I_BGU, I_WDN, I_BDN, I_FNG };

constexpr int S5_ROWS = 2304, S5_CH = 272;
struct S5Par { float lr, li, step; };
__device__ __forceinline__ void s5_cpow(float lr, float li, float step, float n, float& ar, float& ai) { const float mag = expf(lr * step * n); float s, c; sincosf(li * step * n, &s, &c); ar = mag * c; ai = mag * s; }
__device__ __forceinline__ void s5_zoh_f(float lr, float li, float step, float& fr, float& fi) { float ar, ai; s5_cpow(lr, li, step, 1.0f, ar, ai); const float den = lr * lr + li * li;
    fr = ((ar - 1.0f) * lr + ai * li) / den; fi = (ai * lr - (ar - 1.0f) * li) / den; }
__device__ __forceinline__ void s5_table_item(const KA& A, int kind, int idx, bf16* W1T, bf16* W2T, LAS float* scr, int lane) {
    if (kind == 0) {
        const int g = idx >> 8, n = idx & 255, dir = n >> 7, ri = (n >> 6) & 1, p = n & 63;
        const float lr = A.I(I_LAMRE)[(dir * 32 + g) * 64 + p], li = A.I(I_LAMIM)[(dir * 32 + g) * 64 + p], step = expf(A.I(I_LOGSTEP)[dir * 32 + g]);
        float fr, fi; s5_zoh_f(lr, li, step, fr, fi);
        const int t = lane >> 2, c0 = (lane & 3) * 4;
        float ar, ai; s5_cpow(lr, li, step, (float)(dir ? t : 15 - t), ar, ai);
        const float gr = ar * fr - ai * fi, gi = ar * fi + ai * fr;
        float o[4];
#pragma unroll
        for (int j = 0; j < 4; ++j) { const float br = A.I(I_BRE)[(g * 64 + p) * 16 + c0 + j], bi = A.I(I_BIM)[(g * 64 + p) * 16 + c0 + j]; o[j] = ri ? (gr * bi + gi * br) : (gr * br - gi * bi); }
        v2u w; w.x = pk2(o[0], o[1]); w.y = pk2(o[2], o[3]);
        *(GAS v2u*)(W1T + ((size_t)g * 256 + n) * 256 + 4 * lane) = w;
    } else if (kind == 1) {
        const int g = idx >> 8, n = idx & 255, t = n >> 4, cp = n & 15;
        const int dir = lane >> 5, ri = (lane >> 4) & 1, p0 = (lane & 15) * 4;
        const float step = expf(A.I(I_LOGSTEP)[dir * 32 + g]);
        float o[4];
#pragma unroll
        for (int j = 0; j < 4; ++j) { const int p = p0 + j;
            const float lr = A.I(I_LAMRE)[(dir * 32 + g) * 64 + p], li = A.I(I_LAMIM)[(dir * 32 + g) * 64 + p];
            float ar, ai; s5_cpow(lr, li, step, (float)(dir ? 16 - t : t + 1), ar, ai);
            const float cr = A.I(I_CRE)[((dir * 32 + g) * 16 + cp) * 64 + p], ci = A.I(I_CIM)[((dir * 32 + g) * 16 + cp) * 64 + p];
            o[j] = ri ? -(cr * ai + ci * ar) : (cr * ar - ci * ai); }
        v2u w; w.x = pk2(o[0], o[1]); w.y = pk2(o[2], o[3]);
        *(GAS v2u*)(W2T + ((size_t)g * 256 + n) * 512 + 256 + 4 * lane) = w;
    } else {
        const int g = idx >> 4, tau = idx & 15;
        {
#pragma unroll
            for (int dir = 0; dir < 2; ++dir) { const float lr = A.I(I_LAMRE)[(dir * 32 + g) * 64 + lane], li = A.I(I_LAMIM)[(dir * 32 + g) * 64 + lane], step = expf(A.I(I_LOGSTEP)[dir * 32 + g]);
                float fr, fi, ar, ai; s5_zoh_f(lr, li, step, fr, fi); s5_cpow(lr, li, step, (float)tau, ar, ai);
                scr[(dir * 64 + lane) * 2] = ar * fr - ai * fi; scr[(dir * 64 + lane) * 2 + 1] = ar * fi + ai * fr; }
        }
        LDS_WAIT(); asm volatile("" ::: "memory");
        const int cp = lane >> 2, c0 = (lane & 3) * 4;
        float kf[4] = {0.f, 0.f, 0.f, 0.f}, kb2[4] = {0.f, 0.f, 0.f, 0.f};
        for (int p = 0; p < 64; ++p) {
            const f32x4 b4r = *(const f32x4*)(A.I(I_BRE) + (g * 64 + p) * 16 + c0), b4i = *(const f32x4*)(A.I(I_BIM) + (g * 64 + p) * 16 + c0);
#pragma unroll
            for (int dir = 0; dir < 2; ++dir) { const float gr = scr[(dir * 64 + p) * 2], gi = scr[(dir * 64 + p) * 2 + 1];
                const float cr = A.I(I_CRE)[((dir * 32 + g) * 16 + cp) * 64 + p], ci = A.I(I_CIM)[((dir * 32 + g) * 16 + cp) * 64 + p];
#pragma unroll
                for (int j = 0; j < 4; ++j) { const float xr = gr * b4r[j] - gi * b4i[j], xi = gr * b4i[j] + gi * b4r[j]; const float v = cr * xr - ci * xi;
                    if (dir == 0) kf[j] += v; else kb2[j] += v; } }
        }
        LDS_WAIT(); asm volatile("" ::: "memory");
        bf16* Wg = W2T + (size_t)g * 256 * 512;
        if (tau == 0) { v2u w; w.x = pk2(kf[0] + kb2[0], kf[1] + kb2[1]); w.y = pk2(kf[2] + kb2[2], kf[3] + kb2[3]);
            for (int t = 0; t < 16; ++t) *(GAS v2u*)(Wg + (size_t)(t * 16 + cp) * 512 + t * 16 + c0) = w;
        } else { v2u wf, wb; wf.x = pk2(kf[0], kf[1]); wf.y = pk2(kf[2], kf[3]); wb.x = pk2(kb2[0], kb2[1]); wb.y = pk2(kb2[2], kb2[3]);
            for (int t = tau; t < 16; ++t) *(GAS v2u*)(Wg + (size_t)(t * 16 + cp) * 512 + (t - tau) * 16 + c0) = wf;
            for (int t = 0; t + tau < 16; ++t) *(GAS v2u*)(Wg + (size_t)(t * 16 + cp) * 512 + (t + tau) * 16 + c0) = wb; }
    }
}
__device__ __forceinline__ void p_s5_scan(Frame& F, const float* SLOC, bf16* A2) {
    const KA A = ka_fresh();
    if (F.tid >= 128) return;
    for (int idx = F.vcu * 128 + F.tid; idx < NB * 32 * 2 * 64; idx += F.G * 128) {
        const int p = idx & 63, dir = (idx >> 6) & 1, g = (idx >> 7) & 31, b = idx >> 12;
        const float lr = A.I(I_LAMRE)[(dir * 32 + g) * 64 + p], li = A.I(I_LAMIM)[(dir * 32 + g) * 64 + p], step = expf(A.I(I_LOGSTEP)[dir * 32 + g]);
        float ar, ai; s5_cpow(lr, li, step, 16.0f, ar, ai);
        float sr = 0.f, si = 0.f;
        const size_t rbase = (size_t)g * S5_ROWS + (size_t)b * S5_CH;
        for (int q0 = 0; q0 < S5_CH; q0 += 16) {
            float lre[16], lim[16];
#pragma unroll
            for (int u = 0; u < 16; ++u) { const int q = q0 + u, n = dir ? (q < 16 ? 15 - q : 271 - (q - 16)) : q; const float* sp = SLOC + (rbase + n) * 256 + dir * 128 + p; lre[u] = sp[0]; lim[u] = sp[64]; }
#pragma unroll
            for (int u = 0; u < 16; ++u) { const int q = q0 + u, n = dir ? (q < 16 ? 15 - q : 271 - (q - 16)) : q; bf16* ap = A2 + (rbase + n) * 512 + 256 + dir * 128 + p;
                ap[0] = (bf16)f2bf(sr); ap[64] = (bf16)f2bf(si);
                const float nr = ar * sr - ai * si + lre[u], ni = ar * si + ai * sr + lim[u]; sr = nr; si = ni; }
        }
    }
}
__device__ __forceinline__ void tr_item(const float* src, int ldsrc, int K, int srccol, float scale, bf16* dst, int dstrow0, int k0, LAS float* scr, int lane) {
    if (srccol >= 0) {
        float t[32]; const float* sp = src + (size_t)(k0 + (lane >> 5)) * ldsrc + srccol + (lane & 31);
#pragma unroll
        for (int i = 0; i < 32; ++i) t[i] = sp[(size_t)(2 * i) * ldsrc];
#pragma unroll
        for (int i = 0; i < 32; ++i) scr[(2 * i + (lane >> 5)) * 33 + (lane & 31)] = t[i] * scale;
    } else {
#pragma unroll 8
        for (int i = 0; i < 32; ++i) { const int kk = 2 * i + (lane >> 5); scr[kk * 33 + (lane & 31)] = 0.f; }
    }
    LDS_WAIT(); asm volatile("" ::: "memory");
    const int c = lane & 7;
#pragma unroll
    for (int j = 0; j < 4; ++j) { const int n = (lane >> 3) + 8 * j; const LAS float* s = scr + (8 * c) * 33 + n;
        v4u o; o.x = pk2(s[0 * 33], s[1 * 33]); o.y = pk2(s[2 * 33], s[3 * 33]); o.z = pk2(s[4 * 33], s[5 * 33]); o.w = pk2(s[6 * 33], s[7 * 33]);
        *(GAS v4u*)(dst + (size_t)(dstrow0 + n) * K + k0 + 8 * c) = o; }
    LDS_WAIT(); asm volatile("" ::: "memory");
}
__device__ __forceinline__ void p0_prologue(Frame& F) {
    const KA A = ka_fresh();
    unsigned char* ws = A.WS();
    LAS float* scr = (LAS float*)(F.lds + F.wave * 8704);
    LAS float* sl = (LAS float*)(F.lds + 69632);
    for (int idx = F.tid; idx < 9 * 1024; idx += NTHR) { const int b = idx >> 10, k = idx & 1023; const float cv = b < 8 ? A.I(I_C)[b * 1024 + k] : A.I(I_CCTX)[k]; sl[k * 12 + b] = silu_(cv); }
    __syncthreads();
    const int gw = F.vcu * NWAVES + F.wave, NGW = F.G * NWAVES, lane = F.lane;
    for (int m = F.vcu; m < 192; m += F.G) {
        const int layer = m / 96, col = (m % 96) * 64 + lane;
        const float* w = A.I(I_ADAW) + (size_t)layer * 1024 * 6144 + (size_t)(F.wave * 128) * 6144 + col;
        float acc[9];
#pragma unroll
        for (int b = 0; b < 9; ++b) acc[b] = 0.f;
        for (int k0 = 0; k0 < 128; k0 += 16) {
            float wv[16];
#pragma unroll
            for (int u = 0; u < 16; ++u) wv[u] = w[(size_t)(k0 + u) * 6144];
#pragma unroll
            for (int u = 0; u < 16; ++u) {
#pragma unroll
                for (int b = 0; b < 9; ++b) acc[b] += sl[(F.wave * 128 + k0 + u) * 12 + b] * wv[u]; }
        }
        LAS float* red = (LAS float*)(F.lds);
#pragma unroll
        for (int b = 0; b < 9; ++b) red[(F.wave * 9 + b) * 64 + lane] = acc[b];
        __syncthreads();
        for (int idx = F.tid; idx < 9 * 64; idx += NTHR) { const int b = idx >> 6, l = idx & 63; float s = 0.f;
#pragma unroll
            for (int wv2 = 0; wv2 < 8; ++wv2) s += red[(wv2 * 9 + b) * 64 + l];
            const int c2 = (m % 96) * 64 + l;
            ((float*)(ws + WS_MOD))[(size_t)layer * 9 * 6144 + b * 6144 + c2] = s + A.I(I_ADAB)[layer * 6144 + c2]; }
        __syncthreads();
    }
    constexpr int I_S5A = 8192, I_S5B = 8192, I_S5C = 512, I_IN0 = 1152, I_OUT0 = 512, I_GLU = 128, I_IN1 = 3072, I_OUT1 = 1024, I_GU = 65536, I_DN = 32768;
    constexpr int NITEMS = I_S5A + I_S5B + I_S5C + I_IN0 + I_OUT0 + I_GLU + I_IN1 + I_OUT1 + I_GU + I_DN;
    for (int it = gw; it < NITEMS; it += NGW) {
        int r = it;
        if (r < I_S5A) { s5_table_item(A, 0, r, (bf16*)(ws + WS_S5W1), (bf16*)(ws + WS_S5W2), scr, lane); continue; }
        r -= I_S5A;
        if (r < I_S5B) { s5_table_item(A, 1, r, (bf16*)(ws + WS_S5W1), (bf16*)(ws + WS_S5W2), scr, lane); continue; }
        r -= I_S5B;
        if (r < I_S5C) { s5_table_item(A, 2, r, (bf16*)(ws + WS_S5W1), (bf16*)(ws + WS_S5W2), scr, lane); continue; }
        r -= I_S5C;
        if (r < I_IN0) { const int kb = r / 72, n0 = (r % 72) * 32;
            const int sc = n0 < 1536 ? n0 : (n0 < 2048 ? n0 + 32 : (n0 == 2048 ? 1536 : -1));
            tr_item(A.I(I_ABWIN), 2080, 1024, sc, n0 < 256 ? 0.125f : 1.0f, (bf16*)(ws + WS_WIN0T), n0, kb * 64, scr, lane); continue; }
        r -= I_IN0;
        if (r < I_OUT0) { tr_item(A.I(I_ABWOUT), 1024, 1024, (r % 32) * 32, 1.0f, (bf16*)(ws + WS_WOUT0T), (r % 32) * 32, (r / 32) * 64, scr, lane); continue; }
        r -= I_OUT0;
        if (r < I_GLU) { tr_item(A.I(I_GLUW), 512, 512, (r % 16) * 32, 1.0f, (bf16*)(ws + WS_WGLUT), (r % 16) * 32, (r / 16) * 64, scr, lane); continue; }
        r -= I_GLU;
        if (r < I_IN1) { const int n0 = (r % 192) * 32;
            tr_item(A.I(I_RETWIN), 6144, 1024, n0, (n0 >= 1024 && n0 < 2048) ? 0.0625f : 1.0f, (bf16*)(ws + WS_WIN1T), n0, (r / 192) * 64, scr, lane); continue; }
        r -= I_IN1;
        if (r < I_OUT1) { tr_item(A.I(I_RETWOUT), 1024, 2048, (r % 32) * 32, 1.0f, (bf16*)(ws + WS_WOUT1T), (r % 32) * 32, (r / 32) * 64, scr, lane); continue; }
        r -= I_OUT1;
        if (r < I_GU) { const int mat = r >> 10, q = r & 1023, kb = q >> 6, n0 = (q & 63) * 32;
            const int pn = n0 >> 8, bj = (n0 >> 7) & 1, lc = n0 & 127;
            tr_item(A.I(I_WGU) + (size_t)mat * 1024 * 2048, 2048, 1024, bj * 1024 + pn * 128 + lc, 1.0f, (bf16*)(ws + WS_WGUT) + (size_t)mat * 2048 * 1024, n0, kb * 64, scr, lane); continue; }
        r -= I_GU;
        { const int mat = r >> 9, q = r & 511, kb = q >> 5, n0 = (q & 31) * 32;
          tr_item(A.I(I_WDN) + (size_t)mat * 1024 * 1024, 1024, 1024, n0, 1.0f, (bf16*)(ws + WS_WDNT) + (size_t)mat * 1024 * 1024, n0, kb * 64, scr, lane); }
    }
}
__device__ __forceinline__ void modnorm_store(const f32x4 (&v)[4], const float* g, const float* sc, const float* sh, bf16* hrow, int lane, f32x4 (&h)[4]) {
    float ss = 0.f;
#pragma unroll
    for (int j = 0; j < 4; ++j) ss += (v[j].x * v[j].x + v[j].y * v[j].y) + (v[j].z * v[j].z + v[j].w * v[j].w);
    const float r = rsqrtf(wave_sum(ss) * (1.0f / 1024.0f) + EPS);
#pragma unroll
    for (int j = 0; j < 4; ++j) { const int o = 64 * j + lane;
        const f32x4 gg = ((const f32x4*)g)[o], s4 = ((const f32x4*)sc)[o], h4 = ((const f32x4*)sh)[o];
        h[j] = v[j] * r * gg * (s4 + 1.0f) + h4;
        v2u w; w.x = pk2(h[j].x, h[j].y); w.y = pk2(h[j].z, h[j].w);
        ((GAS v2u*)hrow)[o] = w; }
}
__device__ __forceinline__ int bidx_of_row(int row) { return row < NCTX ? 8 : ((row - NCTX) >> 12); }
__device__ __forceinline__ void p_norm1_l0(Frame& F) {
    const KA A = ka_fresh();
    const int gw = F.vcu * NWAVES + F.wave, NGW = F.G * NWAVES, lane = F.lane;
    const float* mod = (const float*)(A.WS() + WS_MOD);
    bf16* H = (bf16*)(A.WS() + WS_H);
    for (int row = gw; row < MALL; row += NGW) {
        const float* xr = row < NCTX ? A.I(I_CTX) + (size_t)row * 1024 : A.I(I_X) + (size_t)(row - NCTX) * 1024;
        f32x4 v[4], h[4];
#pragma unroll
        for (int j = 0; j < 4; ++j) v[j] = ((const f32x4*)xr)[64 * j + lane];
        const float* m = mod + bidx_of_row(row) * 6144;
        modnorm_store(v, A.I(I_N1G), m + 1024, m, H + (size_t)row * 1024, lane, h);
    }
}
__device__ __forceinline__ int seq_row(int b, int dir, int s) {
    return s < CTX ? b * CTX + (dir ? CTX - 1 - s : s) : NCTX + b * SEQ + (dir ? SEQ - 1 - (s - CTX) : (s - CTX));
}
template <int DK, bool GLA>
__device__ __forceinline__ void rec_naive(Frame& F, const bf16* P, int ldp, int qc, int kc, int vc, int DV, int nvs,
                                          float* O, size_t odir_stride, int ldo, int orow0) {
    const KA A = ka_fresh();
    constexpr int KPW = DK / 8, TB = 16;
    LAS float* qs = (LAS float*)(F.lds);
    LAS float* ks = (LAS float*)(F.lds + 16384);
    LAS float* vv = (LAS float*)(F.lds + 32768);
    LAS float* dec = (LAS float*)(F.lds + 36864);
    LAS float* opart = (LAS float*)(F.lds + 40960);
    const int tid = F.tid, lane = F.lane, wave = F.wave;
    const int nitems = NB * 4 * 2 * nvs;
    for (int it = F.vcu; it < nitems; it += F.G) {
        const int vs = it % nvs, dir = (it / nvs) & 1, h = (it / (2 * nvs)) & 3, b = it / (8 * nvs);
        float gamma = 0.f;
        if (!GLA) { const float lg = A.I(I_RETDEC)[dir * 4 + h]; gamma = 1.0f / (1.0f + expf(-lg)); }
        float S[KPW];
#pragma unroll
        for (int i = 0; i < KPW; ++i) S[i] = 0.f;
        for (int s0 = 0; s0 < CTX + SEQ; s0 += TB) {
            for (int idx = tid; idx < TB * DK; idx += NTHR) { const int i = idx / DK, kk = idx % DK; const size_t rb = (size_t)seq_row(b, dir, s0 + i) * ldp;
                qs[idx] = bf2f(P[rb + qc + h * DK + kk]); ks[idx] = bf2f(P[rb + kc + h * DK + kk]); }
            for (int idx = tid; idx < TB * 64; idx += NTHR) { const int i = idx >> 6, c = idx & 63; const size_t rb = (size_t)seq_row(b, dir, s0 + i) * ldp;
                vv[idx] = bf2f(P[rb + vc + h * DV + vs * 64 + c]);
                if (GLA) { float z = A.I(I_GLABA)[dir * 256 + h * 64 + c];
#pragma unroll
                    for (int r = 0; r < 16; ++r) z += bf2f(P[rb + C0_LOW + dir * 16 + r]) * A.I(I_GLAWA)[(dir * 16 + r) * 256 + h * 64 + c];
                    const float ls = fminf(z, 0.f) - log1pf(expf(-fabsf(z)));
                    dec[idx] = expf(ls * (1.0f / 16.0f)); } }
            __syncthreads();
#pragma unroll 1
            for (int i = 0; i < TB; ++i) { const float vval = vv[i * 64 + lane]; float part = 0.f;
#pragma unroll
                for (int kk = 0; kk < KPW; ++kk) { const int kidx = wave * KPW + kk; const float d = GLA ? dec[i * 64 + kidx] : gamma;
                    S[kk] = d * S[kk] + ks[i * DK + kidx] * vval; part += qs[i * DK + kidx] * S[kk]; }
                opart[(i * 8 + wave) * 64 + lane] = part; }
            __syncthreads();
            for (int idx = tid; idx < TB * 64; idx += NTHR) { const int i = idx >> 6, c = idx & 63; float sum = 0.f;
#pragma unroll
                for (int w = 0; w < 8; ++w) sum += opart[(i * 8 + w) * 64 + c];
                const int row = seq_row(b, dir, s0 + i);
                if (row >= orow0) O[(size_t)dir * odir_stride + (size_t)(row - orow0) * ldo + h * DV + vs * 64 + c] = sum; }
        }
        __syncthreads();
    }
}
__device__ __forceinline__ void s5_naive(Frame& F, const bf16* P, float* Y  ) {
    const KA A = ka_fresh();
    const int lane = F.lane;
    if (F.wave >= 2) return;
    for (int chain = F.vcu * 2 + F.wave; chain < NB * 32 * 2; chain += F.G * 2) {
        const int dir = chain & 1, g = (chain >> 1) & 31, b = chain >> 6;
        const float step = expf(A.I(I_LOGSTEP)[dir * 32 + g]);
        const float lr = A.I(I_LAMRE)[(dir * 32 + g) * 64 + lane], li = A.I(I_LAMIM)[(dir * 32 + g) * 64 + lane];
        const float mag = expf(lr * step), lbr = mag * cosf(li * step), lbi = mag * sinf(li * step), den = lr * lr + li * li;
        const float fr = ((lbr - 1.0f) * lr + lbi * li) / den, fi = (lbi * lr - (lbr - 1.0f) * li) / den;
        float bbr[16], bbi[16], cr[16], ci[16];
#pragma unroll
        for (int c = 0; c < 16; ++c) { const float br = A.I(I_BRE)[(g * 64 + lane) * 16 + c], bi = A.I(I_BIM)[(g * 64 + lane) * 16 + c];
            bbr[c] = fr * br - fi * bi; bbi[c] = fr * bi + fi * br;
            cr[c] = A.I(I_CRE)[((dir * 32 + g) * 16 + c) * 64 + lane]; ci[c] = A.I(I_CIM)[((dir * 32 + g) * 16 + c) * 64 + lane]; }
        float sr = 0.f, si = 0.f;
        for (int s0 = 0; s0 < CTX + SEQ; s0 += 4) {
            v4u uu[4][2];
#pragma unroll
            for (int i = 0; i < 4; ++i) { const v4u* up = (const v4u*)(P + (size_t)seq_row(b, dir, s0 + i) * N0 + C0_U + g * 16); uu[i][0] = up[0]; uu[i][1] = up[1]; }
#pragma unroll
            for (int i = 0; i < 4; ++i) {
                float u[16];
#pragma unroll
                for (int q = 0; q < 2; ++q) { u[8 * q + 0] = blo(uu[i][q].x); u[8 * q + 1] = bhi(uu[i][q].x); u[8 * q + 2] = blo(uu[i][q].y); u[8 * q + 3] = bhi(uu[i][q].y);
                    u[8 * q + 4] = blo(uu[i][q].z); u[8 * q + 5] = bhi(uu[i][q].z); u[8 * q + 6] = blo(uu[i][q].w); u[8 * q + 7] = bhi(uu[i][q].w); }
                float br = 0.f, bi = 0.f;
#pragma unroll
                for (int c = 0; c < 16; ++c) { br += bbr[c] * u[c]; bi += bbi[c] * u[c]; }
                const float nr = lbr * sr - lbi * si + br, ni = lbr * si + lbi * sr + bi; sr = nr; si = ni;
                float v[16];
#pragma unroll
                for (int c = 0; c < 16; ++c) v[c] = cr[c] * sr - ci[c] * si;
                const bool b5 = (lane & 32) != 0, b4 = (lane & 16) != 0, b3 = (lane & 8) != 0, b2 = (lane & 4) != 0;
                float w8[8], w4[4], w2[2];
#pragma unroll
                for (int k = 0; k < 8; ++k) { const float send = b5 ? v[k] : v[k + 8], keep = b5 ? v[k + 8] : v[k]; w8[k] = keep + __shfl_xor(send, 32); }
#pragma unroll
                for (int k = 0; k < 4; ++k) { const float send = b4 ? w8[k] : w8[k + 4], keep = b4 ? w8[k + 4] : w8[k]; w4[k] = keep + __shfl_xor(send, 16); }
#pragma unroll
                for (int k = 0; k < 2; ++k) { const float send = b3 ? w4[k] : w4[k + 2], keep = b3 ? w4[k + 2] : w4[k]; w2[k] = keep + __shfl_xor(send, 8); }
                float w1; { const float send = b2 ? w2[0] : w2[1], keep = b2 ? w2[1] : w2[0]; w1 = keep + __shfl_xor(send, 4); }
                w1 += __shfl_xor(w1, 2); w1 += __shfl_xor(w1, 1);
                const int c = (b5 ? 8 : 0) + (b4 ? 4 : 0) + (b3 ? 2 : 0) + (b2 ? 1 : 0);
                if ((lane & 3) == 0) Y[(size_t)dir * MALL * 512 + (size_t)seq_row(b, dir, s0 + i) * 512 + g * 16 + c] = w1;
            }
        }
    }
}
__device__ __forceinline__ void unpack8(const v4u w, float (&f)[8]) { f[0] = blo(w.x); f[1] = bhi(w.x); f[2] = blo(w.y); f[3] = bhi(w.y); f[4] = blo(w.z); f[5] = bhi(w.z); f[6] = blo(w.w); f[7] = bhi(w.w); }
__device__ __forceinline__ v4u pack8(const float (&f)[8]) { v4u w; w.x = pk2(f[0], f[1]); w.y = pk2(f[2], f[3]); w.z = pk2(f[4], f[5]); w.w = pk2(f[6], f[7]); return w; }
__device__ __forceinline__ void p_finish0(Frame& F) {
    const KA A = ka_fresh();
    const int gw = F.vcu * NWAVES + F.wave, NGW = F.G * NWAVES, lane = F.lane, e0 = lane * 8;
    const bf16* P = (const bf16*)(A.WS() + WS_PROJ);
    const float* GO = (const float*)(A.WS() + WS_OREC);
    const float* SY = GO + (size_t)2 * MALL * 512;
    bf16* MIX = (bf16*)(A.WS() + WS_MIX); bf16* YP = (bf16*)(A.WS() + WS_YPRE);
    for (int row = gw; row < MALL; row += NGW) {
        float o[8], gg[8], ng[8];
#if MK_NAIVE_GLA
        { const f32x4* a = (const f32x4*)(GO + (size_t)row * 512 + e0); const f32x4* bq = (const f32x4*)(GO + (size_t)(MALL + row) * 512 + e0);
          const f32x4 a0 = a[0] + bq[0], a1 = a[1] + bq[1]; o[0] = a0.x; o[1] = a0.y; o[2] = a0.z; o[3] = a0.w; o[4] = a1.x; o[5] = a1.y; o[6] = a1.z; o[7] = a1.w; }
#else
        { const bf16* GO16 = (const bf16*)GO; float f0[8], f1[8]; unpack8(*(const v4u*)(GO16 + (size_t)row * 512 + e0), f0); unpack8(*(const v4u*)(GO16 + (size_t)(MALL + row) * 512 + e0), f1);
#pragma unroll
          for (int j = 0; j < 8; ++j) o[j] = f0[j] + f1[j]; }
#endif
        float ss = 0.f;
#pragma unroll
        for (int j = 0; j < 8; ++j) ss += o[j] * o[j];
        ss += __shfl_xor(ss, 1); ss += __shfl_xor(ss, 2); ss += __shfl_xor(ss, 4); ss += __shfl_xor(ss, 8);
        const float r = rsqrtf(ss * (1.0f / 128.0f) + EPS);
        unpack8(*(const v4u*)(P + (size_t)row * N0 + C0_G + e0), gg);
        { const f32x4* n4 = (const f32x4*)(A.I(I_GLANG) + (e0 & 127)); const f32x4 n0 = n4[0], n1 = n4[1]; ng[0] = n0.x; ng[1] = n0.y; ng[2] = n0.z; ng[3] = n0.w; ng[4] = n1.x; ng[5] = n1.y; ng[6] = n1.z; ng[7] = n1.w; }
        float res[8];
#pragma unroll
        for (int j = 0; j < 8; ++j) res[j] = o[j] * r * ng[j] * silu_(gg[j]);
        *(GAS v4u*)(MIX + (size_t)row * 1024 + e0) = pack8(res);
#if MK_NAIVE_S5
        float u[8], y[8];
        unpack8(*(const v4u*)(P + (size_t)row * N0 + C0_U + e0), u);
        { const f32x4* a = (const f32x4*)(SY + (size_t)row * 512 + e0); const f32x4* bq = (const f32x4*)(SY + (size_t)(MALL + row) * 512 + e0);
          const f32x4 a0 = a[0] + bq[0], a1 = a[1] + bq[1]; y[0] = a0.x; y[1] = a0.y; y[2] = a0.z; y[3] = a0.w; y[4] = a1.x; y[5] = a1.y; y[6] = a1.z; y[7] = a1.w; }
#pragma unroll
        for (int j = 0; j < 8; ++j) { const float t = y[j] + A.I(I_S5D)[e0 + j] * u[j]; res[j] = 0.5f * t * (1.0f + tanhf(0.7978845608f * (t + 0.044715f * t * t * t))); }
        *(GAS v4u*)(YP + (size_t)row * 512 + e0) = pack8(res);
#endif
    }
}
__device__ __forceinline__ void p_finish1(Frame& F) {
    const KA A = ka_fresh();
    const int gw = F.vcu * NWAVES + F.wave, NGW = F.G * NWAVES, lane = F.lane;
    const bf16* P = (const bf16*)(A.WS() + WS_PROJ);
    const float* RO = (const float*)(A.WS() + WS_OREC);
    bf16* MIX = (bf16*)(A.WS() + WS_MIX);
    for (int lrow = gw; lrow < NLAT; lrow += NGW) {
#pragma unroll 1
        for (int h = 0; h < 4; ++h) { const int e0 = h * 512 + lane * 8;
            float o[8], gg[8];
#if MK_NAIVE_RET
            { const f32x4* a = (const f32x4*)(RO + (size_t)lrow * 2048 + e0); const f32x4* bq = (const f32x4*)(RO + (size_t)(NLAT + lrow) * 2048 + e0);
              const f32x4 a0 = a[0] + bq[0], a1 = a[1] + bq[1]; o[0] = a0.x; o[1] = a0.y; o[2] = a0.z; o[3] = a0.w; o[4] = a1.x; o[5] = a1.y; o[6] = a1.z; o[7] = a1.w; }
#else
            { const bf16* RO16 = (const bf16*)RO; float f0[8], f1[8]; unpack8(*(const v4u*)(RO16 + (size_t)lrow * 2048 + e0), f0); unpack8(*(const v4u*)(RO16 + (size_t)(NLAT + lrow) * 2048 + e0), f1);
#pragma unroll
              for (int j = 0; j < 8; ++j) o[j] = f0[j] + f1[j]; }
#endif
            float s = 0.f;
#pragma unroll
            for (int j = 0; j < 8; ++j) s += o[j];
            const float mu = wave_sum(s) * (1.0f / 512.0f); float q = 0.f;
#pragma unroll
            for (int j = 0; j < 8; ++j) { o[j] -= mu; q += o[j] * o[j]; }
            const float r = rsqrtf(wave_sum(q) * (1.0f / 512.0f) + EPS);
            unpack8(*(const v4u*)(P + (size_t)(NCTX + lrow) * N1 + C1_G + e0), gg);
            float res[8];
#pragma unroll
            for (int j = 0; j < 8; ++j) res[j] = o[j] * r * A.I(I_RETNG)[e0 + j] * silu_(gg[j]);
            *(GAS v4u*)(MIX + (size_t)lrow * 2048 + e0) = pack8(res); }
    }
}
__device__ __forceinline__ void p_rope(Frame& F) {
    const KA A = ka_fresh();
    const int gw = F.vcu * NWAVES + F.wave, NGW = F.G * NWAVES, lane = F.lane;
    bf16* P = (bf16*)(A.WS() + WS_PROJ);
    LAS float* ct = (LAS float*)F.lds;
    LAS float* st = ct + 4096;
    for (int i = F.tid; i < 4096; i += NTHR) { const int pos = i >> 6, fi = i & 63; float sn, cs; sincosf((float)pos * expf(-(float)fi * (9.210340371976184f / 64.0f)), &sn, &cs); ct[i] = cs; st[i] = sn; }
    __syncthreads();
    for (int lrow = gw; lrow < NLAT; lrow += NGW) {
        const int t = lrow & (SEQ - 1), pr = t >> 6, pc = t & 63;
        bf16* rp = P + (size_t)(NCTX + lrow) * N1;
        v4u a[2], b2[2]; int off[2], pos[2], f0[2];
#pragma unroll
        for (int q = 0; q < 2; ++q) { const int task = lane + 64 * q, tens = task >> 4, half = (task >> 3) & 1, ch = task & 7;
            off[q] = tens * 256 + half * 128 + ch * 8; pos[q] = half ? pc : pr; f0[q] = ch * 8;
            a[q] = *(const v4u*)(rp + off[q]); b2[q] = *(const v4u*)(rp + off[q] + 64); }
#pragma unroll
        for (int q = 0; q < 2; ++q) { float x[8], y[8], xo[8], yo[8]; unpack8(a[q], x); unpack8(b2[q], y);
            const f32x4 c0 = *(const LAS f32x4*)(ct + pos[q] * 64 + f0[q]), c1 = *(const LAS f32x4*)(ct + pos[q] * 64 + f0[q] + 4), s0 = *(const LAS f32x4*)(st + pos[q] * 64 + f0[q]), s1 = *(const LAS f32x4*)(st + pos[q] * 64 + f0[q] + 4);
#pragma unroll
            for (int j = 0; j < 8; ++j) { const float cs = j < 4 ? c0[j & 3] : c1[j & 3], sn = j < 4 ? s0[j & 3] : s1[j & 3]; xo[j] = x[j] * cs - y[j] * sn; yo[j] = x[j] * sn + y[j] * cs; }
            *(GAS v4u*)(rp + off[q]) = pack8(xo); *(GAS v4u*)(rp + off[q] + 64) = pack8(yo); }
    }
}
__device__ __forceinline__ void p_router(Frame& F, int layer) {
    const KA A = ka_fresh();
    const int tid = F.tid, lane = F.lane, wave = F.wave;
    const int moe_row0 = layer ? NCTX : 0, NTOK = layer ? NLAT : MALL;
    const int RPB = (NTOK + F.G - 1) / F.G;
    unsigned char* ws = A.WS();
    int* prow = (int*)(ws + WS_PROW); int* sel_e = (int*)(ws + WS_SELE); float* w_slot = (float*)(ws + WS_WSLOT); int* slot_pos = (int*)(ws + WS_SPOS);
    LAS float* Wt = (LAS float*)F.lds;
    LAS int* lcnt = (LAS int*)(F.lds + L_LCNT); LAS int* gbase = (LAS int*)(F.lds + L_GBASE);
    LAS int* blk_e = (LAS int*)(F.lds + L_BLKE); LAS int* blk_p = (LAS int*)(F.lds + L_BLKP);
    const float* wr = A.I(I_WROUTER) + (size_t)layer * 1024 * 32;
    for (int idx = tid; idx < 32768; idx += NTHR) Wt[(idx & 31) * 1024 + (idx >> 5)] = wr[idx];
    if (tid < 32) lcnt[tid] = 0;
    __syncthreads();
    const float* mod = (const float*)(ws + WS_MOD) + (size_t)layer * 9 * 6144;
    const float* XR = (const float*)(ws + WS_XRES); bf16* H = (bf16*)(ws + WS_H);
    const int tok0 = F.vcu * RPB;
    for (int lr = wave; lr < RPB; lr += NWAVES) {
        const int tok = tok0 + lr; if (tok >= NTOK) break;
        const int row = moe_row0 + tok;
        f32x4 v[4], h[4];
#pragma unroll
        for (int j = 0; j < 4; ++j) v[j] = ((const f32x4*)(XR + (size_t)row * 1024))[64 * j + lane];
        const float* m = mod + bidx_of_row(row) * 6144;
        modnorm_store(v, A.I(I_N2G) + layer * 1024, m + 4096, m + 3072, H + (size_t)row * 1024, lane, h);
        float pa[32];
#pragma unroll
        for (int e = 0; e < 32; ++e) { float a = 0.f;
#pragma unroll
            for (int j = 0; j < 4; ++j) { const f32x4 w4 = *(const LAS f32x4*)(Wt + e * 1024 + 4 * (64 * j + lane)); a += (h[j].x * w4.x + h[j].y * w4.y) + (h[j].z * w4.z + h[j].w * w4.w); }
            pa[e] = a; }
        float myl;
        { const bool b5 = (lane & 32) != 0, b4 = (lane & 16) != 0, b3 = (lane & 8) != 0, b2 = (lane & 4) != 0, b1 = (lane & 2) != 0;
          float w16[16], w8[8], w4[4], w2[2];
#pragma unroll
          for (int k = 0; k < 16; ++k) { const float send = b5 ? pa[k] : pa[k + 16], keep = b5 ? pa[k + 16] : pa[k]; w16[k] = keep + __shfl_xor(send, 32); }
#pragma unroll
          for (int k = 0; k < 8; ++k) { const float send = b4 ? w16[k] : w16[k + 8], keep = b4 ? w16[k + 8] : w16[k]; w8[k] = keep + __shfl_xor(send, 16); }
#pragma unroll
          for (int k = 0; k < 4; ++k) { const float send = b3 ? w8[k] : w8[k + 4], keep = b3 ? w8[k + 4] : w8[k]; w4[k] = keep + __shfl_xor(send, 8); }
#pragma unroll
          for (int k = 0; k < 2; ++k) { const float send = b2 ? w4[k] : w4[k + 2], keep = b2 ? w4[k + 2] : w4[k]; w2[k] = keep + __shfl_xor(send, 4); }
          { const float send = b1 ? w2[0] : w2[1], keep = b1 ? w2[1] : w2[0]; myl = keep + __shfl_xor(send, 2); }
          myl += __shfl_xor(myl, 1); }
        const int mye = lane >> 1;
        myl += A.I(I_BROUTER)[layer * 32 + mye];
        float bv[4]; int bi[4];
#pragma unroll
        for (int r = 0; r < 4; ++r) { float v = myl; int id = mye;
#pragma unroll
            for (int o = 1; o < 64; o <<= 1) { const float ov = __shfl_xor(v, o); const int oi = __shfl_xor(id, o); const bool take = ov > v || (ov == v && oi < id); v = take ? ov : v; id = take ? oi : id; }
            bv[r] = v; bi[r] = id; myl = (mye == id) ? -INFINITY : myl; }
        const float e1 = __expf(bv[1] - bv[0]), e2 = __expf(bv[2] - bv[0]), e3 = __expf(bv[3] - bv[0]), inv = 1.0f / (1.0f + e1 + e2 + e3);
        if (lane < 4) { const int ee = lane == 0 ? bi[0] : (lane == 1 ? bi[1] : (lane == 2 ? bi[2] : bi[3]));
            const float wv = (lane == 0 ? 1.0f : (lane == 1 ? e1 : (lane == 2 ? e2 : e3))) * inv;
            sel_e[tok * 4 + lane] = ee; w_slot[tok * 4 + lane] = wv;
            const int lp = __hip_atomic_fetch_add(lcnt + ee, 1, __ATOMIC_RELAXED, __HIP_MEMORY_SCOPE_WORKGROUP);
            blk_e[lr * 4 + lane] = ee; blk_p[lr * 4 + lane] = lp; }
    }
    __syncthreads();
    if (tid < 32) gbase[tid] = (int)__hip_atomic_fetch_add(F.ctl + CW_GCNT + 64 * layer + tid, (unsigned)lcnt[tid], RLX_AGENT);
    __syncthreads();
    int* elist = (int*)(ws + WS_ELIST);
    for (int idx = tid; idx < RPB * 4; idx += NTHR) { const int tok = tok0 + (idx >> 2); if (tok < NTOK) { const int e = blk_e[idx]; elist[(size_t)e * MALL + gbase[e] + blk_p[idx]] = tok * 4 + (idx & 3); } }
}
__device__ __forceinline__ int moe_tables(Frame& F, int layer) {
    LAS int* ts = (LAS int*)(F.lds + L_TSTART); LAS unsigned char* te = (LAS unsigned char*)(F.lds + L_TILEE);
    __syncthreads();
    if (F.tid == 0) { int acc = 0;
        for (int e = 0; e < 32; ++e) { ts[e] = acc; acc += ((int)__hip_atomic_load(F.ctl + CW_GCNT + 64 * layer + e, RLX_AGENT) + 255) >> 8; }
        ts[32] = acc > MAXTILES ? MAXTILES : acc; }
    __syncthreads();
    const int nt = ts[32];
    LAS int* tpos = (LAS int*)(F.lds + L_TPOS); LAS int* tcnt = (LAS int*)(F.lds + L_TCNT);
    for (int T = F.tid; T < nt; T += NTHR) { int e = 0;
        for (int q = 1; q < 32; ++q) e = (T >= ts[q]) ? q : e;
        te[T] = (unsigned char)e; tpos[T] = (T - ts[e]) * 256; tcnt[T] = (int)__hip_atomic_load(F.ctl + CW_GCNT + 64 * layer + e, RLX_AGENT); }
    __syncthreads();
    return nt;
}
__device__ __forceinline__ void p_combine(Frame& F, int layer, bool dry) {
    const KA A = ka_fresh();
    const int gw = F.vcu * NWAVES + F.wave, NGW = F.G * NWAVES, lane = F.lane;
    const int moe_row0 = layer ? NCTX : 0, NTOK = layer ? NLAT : MALL;
    unsigned char* ws = A.WS();
    const float* XR = (const float*)(ws + WS_XRES); float* XW = dry ? (float*)(ws + WS_PROJ) : (float*)(ws + WS_XRES); bf16* H = dry ? (bf16*)(ws + WS_PROJ + 160 * MiB) : (bf16*)(ws + WS_H); const bf16* YS = (const bf16*)(ws + WS_YSLOT);
    float* OUTP = dry ? (float*)(ws + WS_PROJ) : A.OUT();
    const float* mod = (const float*)(ws + WS_MOD);
    float palpha = 1.0f;
#if defined(MK_PROBE) && MK_PROBE >= 0
    {
      const unsigned* st = F.ctl + 20000 + 2 * MK_PROBE;
      const unsigned long long t0 = ((unsigned long long)__hip_atomic_load(st + 1, RLX_AGENT) << 32) | __hip_atomic_load(st, RLX_AGENT), t1 = ((unsigned long long)__hip_atomic_load(st + 3, RLX_AGENT) << 32) | __hip_atomic_load(st + 2, RLX_AGENT);
      palpha = 1.0f + exp2f((float)(t1 - t0) * 0.01f * 0.01f * 3.321928095f); }
#endif
    for (int tok = gw; tok < NTOK; tok += NGW) {
        const int row = moe_row0 + tok, bidx = bidx_of_row(row);
        const float* g2 = mod + (size_t)layer * 9 * 6144 + bidx * 6144 + 5120;
        f32x4 v[4];
#pragma unroll
        for (int j = 0; j < 4; ++j) { const int o = 64 * j + lane; f32x4 y = (f32x4){0.f, 0.f, 0.f, 0.f};
#pragma unroll
            for (int k = 0; k < 4; ++k) { const v2u w = ((const v2u*)(YS + (size_t)(tok * 4 + k) * 1024))[o]; y += (f32x4){blo(w.x), bhi(w.x), blo(w.y), bhi(w.y)}; }
            v[j] = ((const f32x4*)(XR + (size_t)row * 1024))[o] + ((const f32x4*)g2)[o] * y; }
        if (layer == 0) {
#pragma unroll
            for (int j = 0; j < 4; ++j) ((f32x4*)(XW + (size_t)row * 1024))[64 * j + lane] = v[j];
            const float* m1 = mod + (size_t)9 * 6144 + bidx * 6144; f32x4 h[4];
            modnorm_store(v, A.I(I_N1G) + 1024, m1 + 1024, m1, H + (size_t)row * 1024, lane, h);
        } else {
            float ss = 0.f;
#pragma unroll
            for (int j = 0; j < 4; ++j) ss += (v[j].x * v[j].x + v[j].y * v[j].y) + (v[j].z * v[j].z + v[j].w * v[j].w);
            const float r = rsqrtf(wave_sum(ss) * (1.0f / 1024.0f) + EPS);
#pragma unroll
            for (int j = 0; j < 4; ++j) { const int o = 64 * j + lane; ((f32x4*)(OUTP + (size_t)tok * 1024))[o] = v[j] * (r * palpha) * ((const f32x4*)A.I(I_FNG))[o]; }
        }
    }
}
typedef short s16x4 __attribute__((ext_vector_type(4)));
typedef short bfx8 __attribute__((ext_vector_type(8)));
typedef short v4i16_t __attribute__((ext_vector_type(4)));
#define MFMA16(a, b, c) __builtin_amdgcn_mfma_f32_16x16x32_bf16((a), (b), (c), 0, 0, 0)
__device__ __forceinline__ bfx8 frag_n(const LAS unsigned char* tile, int stride, int r0, int k0, int lane) {
    return *(const LAS bfx8*)(tile + (r0 + (lane & 15)) * stride + (k0 + 8 * (lane >> 4)) * 2);
}
__device__ __forceinline__ bfx8 frag_t(const LAS unsigned char* tile, int stride, int k0, int n0, int lane) {
    const int g = lane >> 4, q = (lane & 15) >> 2, p = lane & 3;
    const LAS unsigned char* a = tile + (k0 + 8 * g + q) * stride + (n0 + 4 * p) * 2;
    const s16x4 lo = __builtin_bit_cast(s16x4, __builtin_amdgcn_ds_read_tr16_b64_v4i16((LAS v4i16_t*)a));
    const s16x4 hi = __builtin_bit_cast(s16x4, __builtin_amdgcn_ds_read_tr16_b64_v4i16((LAS v4i16_t*)(a + 4 * stride)));
    return __builtin_shufflevector(lo, hi, 0, 1, 2, 3, 4, 5, 6, 7);
}
__device__ __forceinline__ v4u scale8(const v4u w, float s) { float f[8]; unpack8(w, f);
#pragma unroll
    for (int j = 0; j < 8; ++j) f[j] *= s;
    return pack8(f); }

template <int DK, int DVS, bool GLA, bool INTRA = true>
__device__ __forceinline__ void rec_mfma(Frame& F, const bf16* Qsrc, const bf16* Ksrc, const bf16* K2src, size_t qdir_stride, int ldq, int qcol, int kcol,
                                         const bf16* Vsrc, int ldv, int vcol, int DV, const float* EB,
                                         bf16* O, size_t odir_stride, int ldo, int orow0) {
    const KA A = ka_fresh();
    constexpr int SQ = DK * 2 + 16, SV = DVS * 2 + 16, SP = 144, SS = DK * 2 + 16;
    constexpr int O_QD = 0, O_KI = O_QD + 64 * SQ, O_KS = O_KI + 64 * SQ, O_V = O_KS + (GLA ? 64 * SQ : 0), O_VD = O_V + 64 * SV, O_P = O_VD + (GLA ? 0 : 64 * SV), O_ST = O_P + 64 * SP, O_EB = O_ST + DVS * SS;
    static_assert(O_EB + DK * 4 <= RING_BYTES, "rec_mfma LDS");
    constexpr int NVS = 0;  (void)NVS;
    constexpr int VT_PER = DVS / 32, KT_PER = DK / 64, QCH = DK / 8  , QN = (64 * QCH) / NTHR, VCH = DVS / 8, KSTEPS = DK / 32;
    static_assert(QN >= 1 && VT_PER >= 1 && KT_PER >= 1, "shape");
    const LAS unsigned char* L = F.lds;
    const int tid = F.tid, lane = F.lane, w = F.wave, it = w & 3, vg = w >> 2, kg = w & 3, g4 = lane >> 4, l15 = lane & 15;
    const int nvs = DV / DVS, nitems = NB * 4 * 2 * nvs;
    for (int item = F.vcu; item < nitems; item += F.G) {
        const int vs = item % nvs, dir = (item / nvs) & 1, h = (item / (2 * nvs)) & 3, b = item / (8 * nvs);
        float lg2 = 0.f;
        if (!GLA) { const float lgt = A.I(I_RETDEC)[dir * 4 + h]; lg2 = -log2f(1.0f + expf(-lgt)); }
        const bf16* qb = Qsrc + (GLA ? (size_t)dir * qdir_stride : 0) + qcol + h * DK;
        const bf16* kb = Ksrc + (GLA ? (size_t)dir * qdir_stride : 0) + kcol + h * DK;
        const bf16* k2b = GLA ? K2src + (size_t)dir * qdir_stride + kcol + h * DK : kb;
        const bf16* vb = Vsrc + vcol + h * DV + vs * DVS;
        f32x4 Sacc[VT_PER][KT_PER];
#pragma unroll
        for (int a = 0; a < VT_PER; ++a)
#pragma unroll
            for (int c2 = 0; c2 < KT_PER; ++c2) Sacc[a][c2] = (f32x4){0.f, 0.f, 0.f, 0.f};
        for (int i = tid; i < DVS * SS / 4; i += NTHR) ((LAS unsigned*)(F.lds + O_ST))[i] = 0u;
        v4u rq[QN], rk[QN], rk2[GLA ? QN : 1], rv; float peb = 0.f;
        rv = (v4u){0u, 0u, 0u, 0u};
#define REC_LOAD(c) do { \
            _Pragma("unroll") for (int n = 0; n < QN; ++n) { const int pi = tid + NTHR * n, r = pi / QCH, ch = pi % QCH; const size_t ro = (size_t)seq_row(b, dir, 64 * (c) + r) * ldq + ch * 8; \
                rq[n] = *(const v4u*)(qb + ro); rk[n] = *(const v4u*)(kb + ro); if (GLA) rk2[n] = *(const v4u*)(k2b + ro); } \
            if (tid < 64 * VCH) { const int r = tid / VCH, ch = tid % VCH; rv = *(const v4u*)(vb + (size_t)seq_row(b, dir, 64 * (c) + r) * ldv + ch * 8); } \
            if (GLA && tid < DK) peb = EB[(((size_t)dir * NB + b) * 68 + (c)) * (4 * DK) + h * DK + tid]; } while (0)
        REC_LOAD(0);
        for (int c = 0; c < 68; ++c) {
#pragma unroll
            for (int n = 0; n < QN; ++n) { const int pi = tid + NTHR * n, r = pi / QCH, ch = pi % QCH;
                *(LAS v4u*)(F.lds + O_QD + r * SQ + ch * 16) = rq[n]; *(LAS v4u*)(F.lds + O_KI + r * SQ + ch * 16) = rk[n];
                if (GLA) *(LAS v4u*)(F.lds + O_KS + r * SQ + ch * 16) = rk2[n]; }
            if (tid < 64 * VCH) { const int r = tid / VCH, ch = tid % VCH;
                if (INTRA) *(LAS v4u*)(F.lds + O_V + r * SV + ch * 16) = rv;
                if (!GLA) *(LAS v4u*)(F.lds + O_VD + r * SV + ch * 16) = scale8(rv, exp2f(lg2 * (float)(63 - r))); }
            if (GLA && tid < DK) ((LAS float*)(F.lds + O_EB))[tid] = peb;
            if (c + 1 < 68) REC_LOAD(c + 1);
            __syncthreads();
            if constexpr (INTRA) {
#pragma unroll
            for (int q2 = 0; q2 < 2; ++q2) { const int jt = 2 * vg + q2; f32x4 acc = (f32x4){0.f, 0.f, 0.f, 0.f};
                if (jt <= it) {
#pragma unroll
                    for (int ks = 0; ks < KSTEPS; ++ks) acc = MFMA16(frag_n(L + O_KI, SQ, 16 * jt, 32 * ks, lane), frag_n(L + O_QD, SQ, 16 * it, 32 * ks, lane), acc);
                    const int i = 16 * it + l15;
#pragma unroll
                    for (int r = 0; r < 4; ++r) { const int j = 16 * jt + 4 * g4 + r; float vv = (j <= i) ? acc[r] : 0.f; if (!GLA) vv *= exp2f(lg2 * (float)(i - j)); acc[r] = vv; }
                }
                v2u pw; pw.x = pk2(acc[0], acc[1]); pw.y = pk2(acc[2], acc[3]);
                *(LAS v2u*)(F.lds + O_P + (16 * it + l15) * SP + (16 * jt + 4 * g4) * 2) = pw; }
            }
            f32x4 oacc[VT_PER];
            const bool need_o = INTRA || orow0 == 0 || c >= 4;
#pragma unroll
            for (int a = 0; a < VT_PER; ++a) { oacc[a] = (f32x4){0.f, 0.f, 0.f, 0.f};
                if (need_o)
#pragma unroll
                for (int ks = 0; ks < KSTEPS; ++ks) oacc[a] = MFMA16(frag_n(L + O_ST, SS, 16 * (vg * VT_PER + a), 32 * ks, lane), frag_n(L + O_QD, SQ, 16 * it, 32 * ks, lane), oacc[a]);
                if (!GLA) oacc[a] *= exp2f(lg2 * (float)(16 * it + l15 + 1)); }
            if constexpr (INTRA) __syncthreads();
            { const int row = seq_row(b, dir, 64 * c + 16 * it + l15);
#pragma unroll
              for (int a = 0; a < VT_PER; ++a) { const int vt = vg * VT_PER + a;
                if constexpr (INTRA) {
#pragma unroll
                for (int js = 0; js < 2; ++js) oacc[a] = MFMA16(frag_t(L + O_V, SV, 32 * js, 16 * vt, lane), frag_n(L + O_P, SP, 16 * it, 32 * js, lane), oacc[a]); }
                if (row >= orow0) { v2u ow; ow.x = pk2(oacc[a][0], oacc[a][1]); ow.y = pk2(oacc[a][2], oacc[a][3]);
                    *(GAS v2u*)(O + (size_t)dir * odir_stride + (size_t)(row - orow0) * ldo + h * DV + vs * DVS + 16 * vt + 4 * g4) = ow; } } }
            { bfx8 fv[VT_PER][2];
#pragma unroll
              for (int a = 0; a < VT_PER; ++a)
#pragma unroll
                for (int js = 0; js < 2; ++js) fv[a][js] = frag_t(L + (GLA ? O_V : O_VD), SV, 32 * js, 16 * (vg * VT_PER + a), lane);
              const float g64 = GLA ? 1.0f : exp2f(lg2 * 64.0f);
#pragma unroll
              for (int c2 = 0; c2 < KT_PER; ++c2) { const int kt = kg * KT_PER + c2;
                const bfx8 fk0 = frag_t(L + (GLA ? O_KS : O_KI), SQ, 0, 16 * kt, lane), fk1 = frag_t(L + (GLA ? O_KS : O_KI), SQ, 32, 16 * kt, lane);
                f32x4 sc4 = (f32x4){g64, g64, g64, g64};
                if (GLA) sc4 = *(const LAS f32x4*)(L + O_EB + (16 * kt + 4 * g4) * 4);
#pragma unroll
                for (int a = 0; a < VT_PER; ++a) { f32x4 s = Sacc[a][c2] * sc4;
                    s = MFMA16(fk0, fv[a][0], s); s = MFMA16(fk1, fv[a][1], s); Sacc[a][c2] = s;
                    if constexpr (INTRA) { v2u sw; sw.x = pk2(s[0], s[1]); sw.y = pk2(s[2], s[3]);
                        *(LAS v2u*)(F.lds + O_ST + (16 * (vg * VT_PER + a) + l15) * SS + (16 * kt + 4 * g4) * 2) = sw; } } } }
            __syncthreads();
            if constexpr (!INTRA) {
#pragma unroll
              for (int c2 = 0; c2 < KT_PER; ++c2)
#pragma unroll
                for (int a = 0; a < VT_PER; ++a) { const f32x4 s = Sacc[a][c2]; v2u sw; sw.x = pk2(s[0], s[1]); sw.y = pk2(s[2], s[3]);
                    *(LAS v2u*)(F.lds + O_ST + (16 * (vg * VT_PER + a) + l15) * SS + (16 * (kg * KT_PER + c2) + 4 * g4) * 2) = sw; } }
        }
#undef REC_LOAD
    }
}
__device__ __forceinline__ void p_gla_prep(Frame& F, const bf16* P, bf16* QD, bf16* KI, bf16* KS, float* EB) {
    const KA A = ka_fresh();
    const int tid = F.tid;
    LAS float* lb = (LAS float*)F.lds;
    LAS float* wal = (LAS float*)(F.lds + 66560);
    LAS float* tot = (LAS float*)(F.lds + 66560 + 17408);
    constexpr int LBS = 260;
    int cur_dir = -1;
    for (int item = F.vcu; item < 2 * NB * 68; item += F.G) {
        const int c = item % 68, b = (item / 68) % NB, dir = item / (68 * NB);
        if (dir != cur_dir) { __syncthreads();
            for (int i = tid; i < 16 * 256; i += NTHR) wal[i] = A.I(I_GLAWA)[dir * 4096 + i];
            if (tid < 256) wal[4096 + tid] = A.I(I_GLABA)[dir * 256 + tid];
            cur_dir = dir; __syncthreads(); }
        const int t = tid >> 3, cg = tid & 7, row = seq_row(b, dir, 64 * c + t);
        {
            float lw[16]; { float f0[8], f1[8]; unpack8(*(const v4u*)(P + (size_t)row * N0 + C0_LOW + dir * 16), f0); unpack8(*(const v4u*)(P + (size_t)row * N0 + C0_LOW + dir * 16 + 8), f1);
#pragma unroll
                for (int j = 0; j < 8; ++j) { lw[j] = f0[j]; lw[8 + j] = f1[j]; } }
#pragma unroll
            for (int q = 0; q < 8; ++q) { const int col = cg * 32 + q * 4;
                f32x4 z = *(const LAS f32x4*)(wal + 4096 + col);
#pragma unroll
                for (int r = 0; r < 16; ++r) z += *(const LAS f32x4*)(wal + r * 256 + col) * lw[r];
                f32x4 o;
#pragma unroll
                for (int j = 0; j < 4; ++j) o[j] = (fminf(z[j], 0.f) - __logf(1.0f + __expf(-fabsf(z[j])))) * (1.0f / 16.0f);
                *(LAS f32x4*)(lb + t * LBS + col) = o; }
        }
        __syncthreads();
        {
            const int col = tid & 255, half = tid >> 8; float run = 0.f;
#pragma unroll 8
            for (int i = 0; i < 32; ++i) { run += lb[(32 * half + i) * LBS + col]; lb[(32 * half + i) * LBS + col] = run; }
            if (half == 0) tot[col] = run;
            __syncthreads();
            if (half == 1) { const float off = tot[col];
#pragma unroll 8
                for (int i = 32; i < 64; ++i) lb[i * LBS + col] += off; }
        }
        __syncthreads();
        {
#pragma unroll
            for (int q = 0; q < 4; ++q) { const int col = cg * 32 + q * 8;
                float qf[8], kf[8], o1[8], o2[8], o3[8];
                unpack8(*(const v4u*)(P + (size_t)row * N0 + C0_Q + col), qf); unpack8(*(const v4u*)(P + (size_t)row * N0 + C0_K + col), kf);
#pragma unroll
                for (int j = 0; j < 8; ++j) { const float bt = lb[t * LBS + col + j], bl = lb[63 * LBS + col + j]; const float eb = __expf(bt);
                    o1[j] = qf[j] * eb; o2[j] = kf[j] * __expf(-bt); o3[j] = kf[j] * __expf(bl - bt); }
                const size_t o = ((size_t)dir * MALL + row) * 256 + col;
                *(GAS v4u*)(QD + o) = pack8(o1); *(GAS v4u*)(KI + o) = pack8(o2); *(GAS v4u*)(KS + o) = pack8(o3); }
            if (tid < 256) EB[(((size_t)dir * NB + b) * 68 + c) * 256 + tid] = __expf(lb[63 * LBS + tid]);
        }
        __syncthreads();
    }
}
__device__ __forceinline__ void p_ret_intra_finish(Frame& F) {
    const KA A = ka_fresh();
    constexpr int SQ = 528, SP = 144, SV = 1040, O_Q = 0, O_K = 33792, O_V = 0, O_P = 67584, O_RED = O_P + 64 * SP;
    static_assert(64 * SV <= O_P && O_RED + 2 * 64 * 8 <= RING_BYTES, "LDS map");
    unsigned char* ws = A.WS();
    const bf16* P = (const bf16*)(ws + WS_PROJ); const bf16* RO = (const bf16*)(ws + WS_OREC); bf16* MIX = (bf16*)(ws + WS_MIX);
    const LAS unsigned char* L = F.lds;
    const int tid = F.tid, lane = F.lane, w = F.wave, it = w & 3, vg = w >> 2, g4 = lane >> 4, l15 = lane & 15;
    for (int unit = F.vcu; unit < NB * 64 * 4; unit += F.G) {
        const int h = unit & 3, n = (unit >> 2) & 63, b = unit >> 8;
        const int lrow0 = b * SEQ + 64 * n; const size_t prow0 = (size_t)(NCTX + lrow0) * N1;
        const float lgf = -log2f(1.0f + expf(-A.I(I_RETDEC)[h])), lgb = -log2f(1.0f + expf(-A.I(I_RETDEC)[4 + h]));
        { v4u rq[4], rk[4];
#pragma unroll
          for (int q = 0; q < 4; ++q) { const int pi = tid + NTHR * q, r = pi >> 5, ch = pi & 31; const size_t ro = prow0 + (size_t)r * N1 + h * 256 + ch * 8; rq[q] = *(const v4u*)(P + ro + C1_Q); rk[q] = *(const v4u*)(P + ro + C1_K); }
#pragma unroll
          for (int q = 0; q < 4; ++q) { const int pi = tid + NTHR * q, r = pi >> 5, ch = pi & 31; *(LAS v4u*)(F.lds + O_Q + r * SQ + ch * 16) = rq[q]; *(LAS v4u*)(F.lds + O_K + r * SQ + ch * 16) = rk[q]; } }
        v4u rv[8];
#pragma unroll
        for (int q = 0; q < 8; ++q) { const int pi = tid + NTHR * q, r = pi >> 6, ch = pi & 63; rv[q] = *(const v4u*)(P + prow0 + (size_t)r * N1 + C1_V + h * 512 + ch * 8); }
        __syncthreads();
#pragma unroll
        for (int q2 = 0; q2 < 2; ++q2) { const int jt = 2 * vg + q2; f32x4 acc = (f32x4){0.f, 0.f, 0.f, 0.f};
#pragma unroll
            for (int ks = 0; ks < 8; ++ks) acc = MFMA16(frag_n(L + O_K, SQ, 16 * jt, 32 * ks, lane), frag_n(L + O_Q, SQ, 16 * it, 32 * ks, lane), acc);
            const int i = 16 * it + l15;
#pragma unroll
            for (int r = 0; r < 4; ++r) { const int j = 16 * jt + 4 * g4 + r; const float m = (j <= i ? exp2f(lgf * (float)(i - j)) : 0.f) + (j >= i ? exp2f(lgb * (float)(j - i)) : 0.f); acc[r] *= m; }
            v2u pw; pw.x = pk2(acc[0], acc[1]); pw.y = pk2(acc[2], acc[3]);
            *(LAS v2u*)(F.lds + O_P + (16 * it + l15) * SP + (16 * jt + 4 * g4) * 2) = pw; }
        __syncthreads();
#pragma unroll
        for (int q = 0; q < 8; ++q) { const int pi = tid + NTHR * q, r = pi >> 6, ch = pi & 63; *(LAS v4u*)(F.lds + O_V + r * SV + ch * 16) = rv[q]; }
        const int lrow = lrow0 + 16 * it + l15;
        v2u oi[2][16];
#pragma unroll
        for (int d = 0; d < 2; ++d)
#pragma unroll
            for (int a = 0; a < 16; ++a) oi[d][a] = *(const v2u*)(RO + ((size_t)d * NLAT + lrow) * 2048 + h * 512 + 16 * (16 * vg + a) + 4 * g4);
        __syncthreads();
        f32x4 oacc[16];
#pragma unroll
        for (int a = 0; a < 16; ++a) oacc[a] = (f32x4){0.f, 0.f, 0.f, 0.f};
#pragma unroll
        for (int js = 0; js < 2; ++js) { const bfx8 pf = frag_n(L + O_P, SP, 16 * it, 32 * js, lane);
#pragma unroll
            for (int a = 0; a < 16; ++a) oacc[a] = MFMA16(frag_t(L + O_V, SV, 32 * js, 16 * (16 * vg + a), lane), pf, oacc[a]); }
        float s1 = 0.f, s2 = 0.f;
#pragma unroll
        for (int a = 0; a < 16; ++a) { oacc[a] += (f32x4){blo(oi[0][a].x) + blo(oi[1][a].x), bhi(oi[0][a].x) + bhi(oi[1][a].x), blo(oi[0][a].y) + blo(oi[1][a].y), bhi(oi[0][a].y) + bhi(oi[1][a].y)};
#pragma unroll
            for (int r = 0; r < 4; ++r) { s1 += oacc[a][r]; s2 += oacc[a][r] * oacc[a][r]; } }
        s1 += __shfl_xor(s1, 16); s2 += __shfl_xor(s2, 16); s1 += __shfl_xor(s1, 32); s2 += __shfl_xor(s2, 32);
        LAS float* red = (LAS float*)(F.lds + O_RED);
        if (g4 == 0) { red[(vg * 64 + 16 * it + l15) * 2] = s1; red[(vg * 64 + 16 * it + l15) * 2 + 1] = s2; }
        __syncthreads();
        { const float t1 = red[(16 * it + l15) * 2] + red[(64 + 16 * it + l15) * 2], t2 = red[(16 * it + l15) * 2 + 1] + red[(64 + 16 * it + l15) * 2 + 1];
          const float mu = t1 * (1.0f / 512.0f), var = fmaxf(t2 * (1.0f / 512.0f) - mu * mu, 0.f), rstd = rsqrtf(var + EPS);
          const bf16* gp = P + (size_t)(NCTX + lrow) * N1 + C1_G + h * 512; const float* ngp = A.I(I_RETNG) + h * 512; bf16* op = MIX + (size_t)lrow * 2048 + h * 512;
#pragma unroll
          for (int a = 0; a < 16; ++a) { const int v0 = 16 * (16 * vg + a) + 4 * g4; const v2u gw = *(const v2u*)(gp + v0); const f32x4 ng = *(const f32x4*)(ngp + v0);
              const float r0 = (oacc[a][0] - mu) * rstd * ng[0] * silu_(blo(gw.x)), r1 = (oacc[a][1] - mu) * rstd * ng[1] * silu_(bhi(gw.x)), r2 = (oacc[a][2] - mu) * rstd * ng[2] * silu_(blo(gw.y)), r3 = (oacc[a][3] - mu) * rstd * ng[3] * silu_(bhi(gw.y));
              v2u ow; ow.x = pk2(r0, r1); ow.y = pk2(r2, r3); *(GAS v2u*)(op + v0) = ow; } }
        __syncthreads();
    }
}
#ifndef MK_ONLY
#define MK_ONLY -1
#endif
#define SON(s) (MK_ONLY < 0 || MK_ONLY == (s))
#define IN(k) (lo <= (k) && (k) < hi)
#ifndef MK_PROBE
#define MK_PROBE -1
#endif
#ifndef MK_REP
#define MK_REP -1
#endif
#define REPS(s) for (int _rep = 0; _rep < ((MK_REP == (s)) ? 2 : 1); ++_rep)
#define STAMP(k) do { if (MK_PROBE >= 0 && blockIdx.x == 0 && F.tid == 0) { const unsigned long long _t = wall_clock64(); __hip_atomic_store(F.ctl + 20000 + 2 * (k), (unsigned)_t, RLX_AGENT); __hip_atomic_store(F.ctl + 20001 + 2 * (k), (unsigned)(_t >> 32), RLX_AGENT); } } while (0)
#define SEAM(k) do { if (IN(k) && IN((k) + 1)) { xcd_barrier(bar); STAMP((k) + 1); } } while (0)
template <int layer>
__device__ __forceinline__ void layer_body(Frame& F, const int lo, const int hi, const XcdBarrier& bar) {
    unsigned char* const ws = ka_fresh().WS();
    bf16* const H = (bf16*)(ws + WS_H);
    bf16* const PROJ = (bf16*)(ws + WS_PROJ);
    float* const XRES = (float*)(ws + WS_XRES);
    float* const MOD = (float*)(ws + WS_MOD);

        const int pb = layer ? PH_INPROJ1 : PH_INPROJ0;
        if (SON(2) && IN(pb)) {
            pg8::Gemm g{H, (const bf16*)(ws + (layer ? WS_WIN1T : WS_WIN0T)), MALL, layer ? N1 : N0, 1024, 1024};
            pg8::StaticOrder S; S.init(g.M, g.N, F.G, (int)blockIdx.x);
            if constexpr (layer == 0 && !MK_NAIVE_S5) { pg8::EpiStoreU E{PROJ, g.N, (bf16*)(ws + WS_A2)};
                pg8::gemm_phase<pg8::EpiStoreU, pg8::StaticOrder, true, true>(F.lds, g, S, E); }
            else { pg8::EpiStore E{PROJ, g.N};
                pg8::gemm_phase<pg8::EpiStore, pg8::StaticOrder, true, true>(F.lds, g, S, E); }
        }
        SEAM(pb);
        if (layer == 0) {
#if MK_NAIVE_GLA
            SEAM(PH_GLAPREP);
            if (SON(3) && IN(PH_GLA)) rec_naive<64, true>(F, PROJ, N0, C0_Q, C0_K, C0_V, 128, 2, (float*)(ws + WS_OREC), (size_t)MALL * 512, 512, 0);
#else
            bf16* const GQD = (bf16*)(ws + WS_OREC + 280 * MiB); bf16* const GKI = GQD + (size_t)2 * MALL * 256; bf16* const GKS = GKI + (size_t)2 * MALL * 256; float* const GEB = (float*)(ws + WS_OREC + 384 * MiB);
            if (SON(13) && IN(PH_GLAPREP)) REPS(13) p_gla_prep(F, PROJ, GQD, GKI, GKS, GEB);
#if !MK_NAIVE_S5
            if (SON(17) && IN(PH_GLAPREP)) {
                __syncthreads();
                pg8::Gemm g{(const bf16*)(ws + WS_A2), (const bf16*)(ws + WS_S5W1), 32 * S5_ROWS, 256, 256, 512};
                pg8::GroupOrder S{9, 288, F.G, F.vcu};
                pg8::EpiF32Plain E{(float*)(ws + WS_SLOC)};
                pg8::gemm_phase<pg8::EpiF32Plain, pg8::GroupOrder, true, true>(F.lds, g, S, E);
            }
#endif
            SEAM(PH_GLAPREP);
#if !MK_NAIVE_S5
            if (SON(18) && IN(PH_GLA)) { p_s5_scan(F, (const float*)(ws + WS_SLOC), (bf16*)(ws + WS_A2)); __syncthreads(); }
#endif
            if (SON(3) && IN(PH_GLA)) REPS(3) rec_mfma<64, 32, true>(F, GQD, GKI, GKS, (size_t)MALL * 256, 256, 0, 0, PROJ, N0, C0_V, 128, GEB, (bf16*)(ws + WS_OREC), (size_t)MALL * 512, 512, 0);
#endif
            SEAM(PH_GLA);
#if MK_NAIVE_S5
            if (SON(4) && IN(PH_S5)) s5_naive(F, PROJ, (float*)(ws + WS_OREC) + (size_t)2 * MALL * 512);
#else
            if (SON(4) && IN(PH_S5)) {
                pg8::Gemm g{(const bf16*)(ws + WS_A2), (const bf16*)(ws + WS_S5W2), 32 * S5_ROWS, 256, 512, 512};
                pg8::GroupOrder S{9, 288, F.G, F.vcu};
                pg8::EpiS5Out E{(const bf16*)(ws + WS_A2), (bf16*)(ws + WS_YPRE), ka_fresh().I(I_S5D)};
                pg8::gemm_phase<pg8::EpiS5Out, pg8::GroupOrder, true, true>(F.lds, g, S, E);
            }
#endif
            if (SON(5) && IN(PH_FIN0)) REPS(5) p_finish0(F);
            SEAM(PH_FIN0);
            if (SON(6) && IN(PH_GLU)) {
                pg8::Gemm g{(const bf16*)(ws + WS_YPRE), (const bf16*)(ws + WS_WGLUT), MALL, 512, 512, 512};
                pg8::StaticOrder S; S.init(g.M, g.N, F.G, (int)blockIdx.x);
                pg8::EpiGlu E{(const bf16*)(ws + WS_YPRE), (bf16*)(ws + WS_MIX), 1024, 512, ka_fresh().I(I_GLUB)};
                pg8::gemm_phase<pg8::EpiGlu, pg8::StaticOrder, true, true>(F.lds, g, S, E);
            }
            SEAM(PH_GLU);
        } else {
            if (SON(14) && IN(PH_ROPE)) p_rope(F);
            SEAM(PH_ROPE);
#if MK_NAIVE_RET
            if (SON(15) && IN(PH_RET)) rec_naive<256, false>(F, PROJ, N1, C1_Q, C1_K, C1_V, 512, 8, (float*)(ws + WS_OREC), (size_t)NLAT * 2048, 2048, NCTX);
#else
            if (SON(15) && IN(PH_RET)) REPS(15) rec_mfma<256, 64, false, false>(F, PROJ, PROJ, PROJ, 0, N1, C1_Q, C1_K, PROJ, N1, C1_V, 512, nullptr, (bf16*)(ws + WS_OREC), (size_t)NLAT * 2048, 2048, NCTX);
#endif
            SEAM(PH_RET);
            #if MK_NAIVE_RET
            if (SON(16) && IN(PH_FIN1)) p_finish1(F);
#else
            if (SON(16) && IN(PH_FIN1)) REPS(16) p_ret_intra_finish(F);
#endif
            SEAM(PH_FIN1);
        }
        const int po = layer ? PH_OUT1 : PH_OUT0;
        if (SON(7) && IN(po)) {
            pg8::Gemm g{(const bf16*)(ws + WS_MIX), (const bf16*)(ws + (layer ? WS_WOUT1T : WS_WOUT0T)), layer ? NLAT : MALL, 1024, layer ? 2048 : 1024, layer ? 2048 : 1024};
            pg8::StaticOrder S; S.init(g.M, g.N, F.G, (int)blockIdx.x);
            pg8::EpiResid E{ka_fresh().I(I_CTX), layer ? (const float*)(XRES + (size_t)NCTX * 1024) : ka_fresh().I(I_X), XRES, MOD + (size_t)layer * 9 * 6144 + 2048, layer ? 8 : 0};
            pg8::gemm_phase<pg8::EpiResid, pg8::StaticOrder, true, true>(F.lds, g, S, E);
        }
        SEAM(po);
        if (SON(8) && IN(po + 1)) p_router(F, layer);
        SEAM(po + 1);
        if (SON(10) && IN(po + 3)) {
            const int nt = moe_tables(F, layer);
            pg8::Gemm g{H, (const bf16*)(ws + WS_WGUT) + (size_t)layer * 32 * 2048 * 1024, nt * 256, 2048, 1024, 1024};
            pg8::MoeOrder S{(const PG8_LAS unsigned char*)(F.lds + L_TILEE), nt, 8, F.G, F.vcu, (const int*)(ws + WS_ELIST), (const PG8_LAS int*)(F.lds + L_TPOS), (const PG8_LAS int*)(F.lds + L_TCNT), layer ? NCTX : 0};
            pg8::EpiSwiglu E{(bf16*)(ws + WS_ACT), ka_fresh().I(I_BGU) + (size_t)layer * 32 * 2048};
            REPS(10) { pg8::gemm_phase<pg8::EpiSwiglu, pg8::MoeOrder, true, true, true>(F.lds, g, S, E); __syncthreads(); }
        }
        SEAM(po + 3);
        if (SON(11) && IN(po + 4)) {
            const int nt = moe_tables(F, layer);
            pg8::Gemm g{(const bf16*)(ws + WS_ACT), (const bf16*)(ws + WS_WDNT) + (size_t)layer * 32 * 1024 * 1024, nt * 256, 1024, 1024, 1024};
            pg8::MoeOrder S{(const PG8_LAS unsigned char*)(F.lds + L_TILEE), nt, 4, F.G, F.vcu, (const int*)(ws + WS_ELIST), (const PG8_LAS int*)(F.lds + L_TPOS), (const PG8_LAS int*)(F.lds + L_TCNT), 0};
            pg8::EpiDown E{(bf16*)(ws + WS_YSLOT), (const int*)(ws + WS_ELIST), (const PG8_LAS int*)(F.lds + L_TPOS), (const PG8_LAS int*)(F.lds + L_TCNT), (const float*)(ws + WS_WSLOT), ka_fresh().I(I_BDN) + (size_t)layer * 32 * 1024};
            REPS(11) { pg8::gemm_phase<pg8::EpiDown, pg8::MoeOrder, true, true>(F.lds, g, S, E); __syncthreads(); }
        }
        SEAM(po + 4);
        if (SON(12) && IN(po + 5)) {
#if MK_REP == 12
            p_combine(F, layer, true);
#endif
            p_combine(F, layer, false); }
        SEAM(po + 5);
    }
__global__ void __launch_bounds__(NTHR, 2) mk_fwd(Args) {
    extern __shared__ __attribute__((aligned(16))) unsigned char lds[];
    Frame F;
    F.lds = (LAS unsigned char*)lds;
    F.MISC = (volatile LAS unsigned*)(F.lds + L_MISC);
    F.tid = threadIdx.x; F.lane = F.tid & 63; F.wave = __builtin_amdgcn_readfirstlane(F.tid >> 6);
    F.G = gridDim.x; { const int bx = blockIdx.x; F.vcu = (F.G % 8 == 0) ? (bx % 8) * (F.G / 8) + bx / 8 : bx; }
    const KA A0 = ka_fresh();
    unsigned char* ws = A0.WS();
    F.ctl = (unsigned*)(ws + WS_CTL);
    if (F.tid < 64) F.MISC[F.tid] = 0u;
    __syncthreads();
    const int lo = A0.LO(), hi = A0.HI();
    XcdBarrier bar; bar.bar = F.ctl + CW_BAR; bar.x = 0; bar.st = nullptr;
    if (hi - lo > 1) bar = xcd_barrier_post(F.ctl + CW_BAR, F.MISC + 8);

    STAMP(0);
    if (SON(0) && IN(0)) { REPS(0) { p0_prologue(F); __syncthreads(); } } SEAM(0);
    if (SON(1) && IN(1)) { REPS(1) p_norm1_l0(F); } SEAM(1);
    layer_body<0>(F, lo, hi, bar);
    layer_body<1>(F, lo, hi, bar);
}

#ifndef MK_MULTI
#define MK_MULTI 0
#endif
extern "C" void kernel_launch(void* const* d_in, const int* in_sizes, int n_in, void* d_out, int out_size, void* d_ws, size_t ws_size, hipStream_t stream) {
    static int grid = 0;
    if (grid == 0) {
        if (n_in != 34 || out_size != NLAT * D || ws_size < WS_END) { fprintf(stderr, "kernel_launch: unexpected sizes: n_in %d out %d ws %zu (need %zu)\n", n_in, out_size, ws_size, (size_t)WS_END); grid = -1; return; }
        int dev = 0, cus = 0;
        if (hipGetDevice(&dev) != hipSuccess || hipDeviceGetAttribute(&cus, hipDeviceAttributeMultiprocessorCount, dev) != hipSuccess) { grid = -1; return; }
        if (hipFuncSetAttribute((const void*)mk_fwd, hipFuncAttributeMaxDynamicSharedMemorySize, LDS_BYTES) != hipSuccess) { fprintf(stderr, "kernel_launch: hipFuncSetAttribute failed\n"); grid = -1; return; }
        int per_cu = 0;
        if (hipOccupancyMaxActiveBlocksPerMultiprocessor(&per_cu, (const void*)mk_fwd, NTHR, LDS_BYTES) != hipSuccess || per_cu < 1) fprintf(stderr, "kernel_launch: occupancy query says %d\n", per_cu);
        (void)hipGetLastError();
        grid = cus;
    }
    if (grid < 0) return;
    (void)in_sizes;
    (void)hipMemsetAsync((char*)d_ws + WS_CTL, 0, CTL_ZERO_BYTES, stream);
    Args a{};
    for (int i = 0; i < 34; ++i) a.in[i] = (const float*)d_in[i];
    a.out = (float*)d_out; a.ws = (unsigned char*)d_ws;
#if MK_MULTI
    for (int p = 0; p < NPH; ++p) { a.ph_lo = p; a.ph_hi = p + 1; hipLaunchKernelGGL(mk_fwd, dim3(grid), dim3(NTHR), LDS_BYTES, stream, a); }
#else
    a.ph_lo = 0; a.ph_hi = NPH; hipLaunchKernelGGL(mk_fwd, dim3(grid), dim3(NTHR), LDS_BYTES, stream, a);
#endif
}
```

```cpp
#include <hip/hip_runtime.h>
#include <cstdio>
#include <cstdint>
#include <cmath>
namespace pg8 {
#define PG8_LAS __attribute__((address_space(3)))
typedef unsigned short bf16_t;
typedef short bf16x8 __attribute__((ext_vector_type(8)));
typedef float f32x4 __attribute__((ext_vector_type(4)));
typedef unsigned u32x4 __attribute__((ext_vector_type(4)));
constexpr int BM = 256, BK = 64, HALF = 128, HTB = HALF * BK * 2  , STAGE_BYTES = 8 * HTB, NXCD = 8, WGM = 8;

__host__ __device__ __forceinline__ int lds_byte(int r, int c) { const int st = (r >> 4) * 2 + (c >> 5), rr = r & 15, cc = c & 31, ob = rr * 64 + cc * 2; return st * 1024 + (ob ^ (((ob >> 9) & 1) << 5)); }
__host__ __device__ __forceinline__ void stage_rc(int b, int& R, int& C) { const int st = b / 1024, sb = b % 1024, swz = sb ^ (((sb >> 9) & 1) << 5); R = (st >> 1) * 16 + swz / 64; C = (st & 1) * 32 + (swz % 64) / 2; }
__host__ __device__ __forceinline__ int perm32(int rho) { const int n = rho >> 4, i = rho & 15; return 8 * (i >> 2) + 4 * n + (i & 3); }

struct Unit { int pm, pn, pb, e; };
struct Gemm { const bf16_t* A; const bf16_t* Bt; int M, N, K, lda; };

struct StaticOrder {
    int nM, nN, nwg, G, c;
    __host__ __device__ void init(int M, int N, int G_, int c_) { nM = M / BM; nN = N / BM; nwg = nM * nN; G = G_; c = c_; }
    __host__ __device__ bool next(int i, Unit& u) const {
        const long L = (long)i * G + c; if (L >= nwg) return false;
        int wgid = (int)L; { const int q = nwg / NXCD, r = nwg % NXCD, xcd = wgid % NXCD, off = wgid / NXCD; wgid = (xcd < r ? xcd * (q + 1) : r * (q + 1) + (xcd - r) * q) + off; }
        const int nig = WGM * nN, gid = wgid / nig, fm = gid * WGM, gsz = (nM - fm) < WGM ? (nM - fm) : WGM;
        u.pm = fm + ((wgid % nig) % gsz); u.pn = (wgid % nig) / gsz; u.pb = u.pn; u.e = 0; return true;
    }
    __device__ __forceinline__ void a_ready(const Unit&) const {}
    __device__ __forceinline__ void done(const Unit&) const {}
};
__device__ __forceinline__ unsigned cvt_pk_bf16(float lo, float hi) { unsigned r; asm volatile("v_cvt_pk_bf16_f32 %0, %1, %2" : "=v"(r) : "v"(lo), "v"(hi)); return r; }
__device__ __forceinline__ float bflo(unsigned w) { return __uint_as_float(w << 16); }
__device__ __forceinline__ float bfhi(unsigned w) { return __uint_as_float(w & 0xffff0000u); }
__device__ __forceinline__ float sigmoidf_(float z) { return 1.0f / (1.0f + __expf(-z)); }

struct EpiStore {
    static constexpr bool PERM = true, AFTER_DRAIN = false;
    bf16_t* O; int ldc;
    __device__ __forceinline__ void operator()(const f32x4 (&acc)[2][2][4][2], const Unit& u, int wr, int wc, int fr, int fq) const {
        const int row0 = u.pm * BM + wr * 64 + fr, col0 = u.pn * BM + wc * 32 + 8 * fq;
#pragma unroll
        for (int ai = 0; ai < 2; ++ai)
#pragma unroll
            for (int m = 0; m < 4; ++m) { bf16_t* rowp = O + (size_t)(row0 + ai * HALF + m * 16) * ldc + col0;
#pragma unroll
                for (int bj = 0; bj < 2; ++bj) { const f32x4 v0 = acc[ai][bj][m][0], v1 = acc[ai][bj][m][1];
                    u32x4 w; w.x = cvt_pk_bf16(v0[0], v0[1]); w.y = cvt_pk_bf16(v0[2], v0[3]); w.z = cvt_pk_bf16(v1[0], v1[1]); w.w = cvt_pk_bf16(v1[2], v1[3]);
                    *(u32x4*)(rowp + bj * HALF) = w; } }
    }
};
struct EpiGlu {
    static constexpr bool PERM = true, AFTER_DRAIN = false;
    const bf16_t* Y; bf16_t* O; int ldo, ocol0; const float* bias;
    __device__ __forceinline__ void operator()(const f32x4 (&acc)[2][2][4][2], const Unit& u, int wr, int wc, int fr, int fq) const {
        const int row0 = u.pm * BM + wr * 64 + fr, col0 = u.pn * BM + wc * 32 + 8 * fq;
        f32x4 bv[2][2];
#pragma unroll
        for (int bj = 0; bj < 2; ++bj)
#pragma unroll
            for (int n = 0; n < 2; ++n) bv[bj][n] = *(const f32x4*)(bias + col0 + bj * HALF + 4 * n);
#pragma unroll
        for (int ai = 0; ai < 2; ++ai)
#pragma unroll
            for (int m = 0; m < 4; ++m) { const size_t row = (size_t)(row0 + ai * HALF + m * 16);
#pragma unroll
                for (int bj = 0; bj < 2; ++bj) { const int c = col0 + bj * HALF;
                    const u32x4 yv = *(const u32x4*)(Y + row * 512 + c);
                    const f32x4 z0 = acc[ai][bj][m][0] + bv[bj][0], z1 = acc[ai][bj][m][1] + bv[bj][1];
                    u32x4 w;
                    w.x = cvt_pk_bf16(bflo(yv.x) * sigmoidf_(z0[0]), bfhi(yv.x) * sigmoidf_(z0[1]));
                    w.y = cvt_pk_bf16(bflo(yv.y) * sigmoidf_(z0[2]), bfhi(yv.y) * sigmoidf_(z0[3]));
                    w.z = cvt_pk_bf16(bflo(yv.z) * sigmoidf_(z1[0]), bfhi(yv.z) * sigmoidf_(z1[1]));
                    w.w = cvt_pk_bf16(bflo(yv.w) * sigmoidf_(z1[2]), bfhi(yv.w) * sigmoidf_(z1[3]));
                    *(u32x4*)(O + row * ldo + ocol0 + c) = w; } }
    }
};
struct EpiResid {
    static constexpr bool PERM = false, AFTER_DRAIN = false;
    const float* base_ctx; const float* base_lat; float* out; const float* gate; int tile0;
    __device__ __forceinline__ void operator()(const f32x4 (&acc)[2][2][4][2], const Unit& u, int wr, int wc, int fr, int fq) const {
        const int gt = u.pm + tile0, bidx = gt < 8 ? 8 : ((gt - 8) >> 4);
        const float* bt = gt < 8 ? base_ctx + (size_t)gt * 256 * 1024 : base_lat + (size_t)(gt - 8) * 256 * 1024;
        float* ot = out + (size_t)gt * 256 * 1024;
        const int col0 = u.pn * BM + wc * 32 + 4 * fq;
        f32x4 gv[2][2];
#pragma unroll
        for (int bj = 0; bj < 2; ++bj)
#pragma unroll
            for (int n = 0; n < 2; ++n) gv[bj][n] = *(const f32x4*)(gate + bidx * 6144 + col0 + bj * HALF + n * 16);
#pragma unroll
        for (int ai = 0; ai < 2; ++ai)
#pragma unroll
            for (int m = 0; m < 4; ++m) { const size_t off = (size_t)(wr * 64 + fr + ai * HALF + m * 16) * 1024 + col0;
#pragma unroll
                for (int bj = 0; bj < 2; ++bj)
#pragma unroll
                    for (int n = 0; n < 2; ++n) { const f32x4 bs = *(const f32x4*)(bt + off + bj * HALF + n * 16);
                        *(f32x4*)(ot + off + bj * HALF + n * 16) = bs + gv[bj][n] * acc[ai][bj][m][n]; } }
    }
};
struct EpiSwiglu {
    static constexpr bool PERM = true, AFTER_DRAIN = false;
    bf16_t* ACT; const float* bgu;
    __device__ __forceinline__ void operator()(const f32x4 (&acc)[2][2][4][2], const Unit& u, int wr, int wc, int fr, int fq) const {
        const int row0 = u.pm * BM + wr * 64 + fr, lc0 = u.pn * 128 + wc * 32 + 8 * fq;
        const float* bb = bgu + (size_t)u.e * 2048 + lc0;
        f32x4 bg[2], bl[2];
#pragma unroll
        for (int n = 0; n < 2; ++n) { bg[n] = *(const f32x4*)(bb + 4 * n); bl[n] = *(const f32x4*)(bb + 1024 + 4 * n); }
#pragma unroll
        for (int ai = 0; ai < 2; ++ai)
#pragma unroll
            for (int m = 0; m < 4; ++m) { float a[8];
#pragma unroll
                for (int n = 0; n < 2; ++n)
#pragma unroll
                    for (int j = 0; j < 4; ++j) { const float g = fminf(acc[ai][0][m][n][j] + bg[n][j], 7.0f); float l = acc[ai][1][m][n][j] + bl[n][j]; l = fminf(fmaxf(l, -7.0f), 7.0f);
                        a[4 * n + j] = g * sigmoidf_(1.702f * g) * (l + 1.0f); }
                u32x4 w; w.x = cvt_pk_bf16(a[0], a[1]); w.y = cvt_pk_bf16(a[2], a[3]); w.z = cvt_pk_bf16(a[4], a[5]); w.w = cvt_pk_bf16(a[6], a[7]);
                *(u32x4*)(ACT + (size_t)(row0 + ai * HALF + m * 16) * 1024 + lc0) = w; }
    }
};
struct EpiDown {
    static constexpr bool PERM = true, AFTER_DRAIN = false;
    bf16_t* Y; const int* elist; const PG8_LAS int* tpos; const PG8_LAS int* tcnt; const float* w_slot; const float* bdn;
    __device__ __forceinline__ void operator()(const f32x4 (&acc)[2][2][4][2], const Unit& u, int wr, int wc, int fr, int fq) const {
        const int col0 = u.pn * BM + wc * 32 + 8 * fq, tp0 = tpos[u.pm], tc0 = tcnt[u.pm]; const int* el = elist + (size_t)u.e * 34816;
        f32x4 bv[2][2];
#pragma unroll
        for (int bj = 0; bj < 2; ++bj)
#pragma unroll
            for (int n = 0; n < 2; ++n) bv[bj][n] = *(const f32x4*)(bdn + (size_t)u.e * 1024 + col0 + bj * HALF + 4 * n);
#pragma unroll
        for (int ai = 0; ai < 2; ++ai)
#pragma unroll
            for (int m = 0; m < 4; ++m) { const int pos = tp0 + wr * 64 + fr + ai * HALF + m * 16; const int slot = pos < tc0 ? el[pos] : -1;
                if (slot >= 0) { const float ws = w_slot[slot]; bf16_t* rowp = Y + (size_t)slot * 1024 + col0;
#pragma unroll
                    for (int bj = 0; bj < 2; ++bj) { const f32x4 v0 = (acc[ai][bj][m][0] + bv[bj][0]) * ws, v1 = (acc[ai][bj][m][1] + bv[bj][1]) * ws;
                        u32x4 w; w.x = cvt_pk_bf16(v0[0], v0[1]); w.y = cvt_pk_bf16(v0[2], v0[3]); w.z = cvt_pk_bf16(v1[0], v1[1]); w.w = cvt_pk_bf16(v1[2], v1[3]);
                        *(u32x4*)(rowp + bj * HALF) = w; } } }
    }
};
struct MoeOrder {
    const PG8_LAS unsigned char* tile_e; int ntiles, NT, G, c; const int* elist; const PG8_LAS int* tpos; const PG8_LAS int* tcnt; int row0;
    __device__ __forceinline__ int rowidx(const Unit& u, int r) const { const int pos = tpos[u.pm] + r; const int s = pos < tcnt[u.pm] ? elist[(size_t)u.e * 34816 + pos] : 0; return row0 + (s >> 2); }
    __device__ __forceinline__ bool next(int i, Unit& u) const {
        const int L = i * G + c; if (L >= ntiles * NT) return false;
        const int T = L / NT; u.pm = T; u.pn = L - T * NT; u.e = __builtin_amdgcn_readfirstlane((int)tile_e[T]); u.pb = u.e * NT + u.pn; return true;
    }
    __device__ __forceinline__ void a_ready(const Unit&) const {}
    __device__ __forceinline__ void done(const Unit&) const {}
};

struct EpiStoreU {
    static constexpr bool PERM = true, AFTER_DRAIN = false;
    bf16_t* O; int ldc; bf16_t* A2;
    __device__ __forceinline__ void operator()(const f32x4 (&acc)[2][2][4][2], const Unit& u, int wr, int wc, int fr, int fq) const {
        const int row0 = u.pm * BM + wr * 64 + fr, col0 = u.pn * BM + wc * 32 + 8 * fq;
#pragma unroll
        for (int ai = 0; ai < 2; ++ai)
#pragma unroll
            for (int m = 0; m < 4; ++m) { const int R = row0 + ai * HALF + m * 16; bf16_t* rowp = O + (size_t)R * ldc + col0;
                int r, t; if (R < 2048) { r = (R >> 8) * 272 + ((R & 255) >> 4); t = R & 15; } else { const int R2 = R - 2048; r = (R2 >> 12) * 272 + 16 + ((R2 & 4095) >> 4); t = R2 & 15; }
#pragma unroll
                for (int bj = 0; bj < 2; ++bj) { const f32x4 v0 = acc[ai][bj][m][0], v1 = acc[ai][bj][m][1];
                    u32x4 w; w.x = cvt_pk_bf16(v0[0], v0[1]); w.y = cvt_pk_bf16(v0[2], v0[3]); w.z = cvt_pk_bf16(v1[0], v1[1]); w.w = cvt_pk_bf16(v1[2], v1[3]);
                    *(u32x4*)(rowp + bj * HALF) = w;
                    if (u.pn >= 6) { const int g = (u.pn - 6) * 16 + bj * 8 + wc * 2 + (fq >> 1);
                        *(u32x4*)(A2 + ((size_t)g * 2304 + r) * 512 + t * 16 + (fq & 1) * 8) = w; } } }
    }
};
struct EpiF32Plain {
    static constexpr bool PERM = true, AFTER_DRAIN = false;
    float* C;
    __device__ __forceinline__ void operator()(const f32x4 (&acc)[2][2][4][2], const Unit& u, int wr, int wc, int fr, int fq) const {
        float* base = C + (size_t)(u.pm * BM + wr * 64 + fr) * 256 + wc * 32 + 8 * fq;
#pragma unroll
        for (int ai = 0; ai < 2; ++ai)
#pragma unroll
            for (int m = 0; m < 4; ++m) {
#pragma unroll
                for (int bj = 0; bj < 2; ++bj) { float* p = base + (ai * HALF + m * 16) * 256 + bj * HALF;
                    *(f32x4*)p = acc[ai][bj][m][0]; *(f32x4*)(p + 4) = acc[ai][bj][m][1]; } }
    }
};
struct EpiS5Out {
    static constexpr bool PERM = true, AFTER_DRAIN = false;
    const bf16_t* A2; bf16_t* YP; const float* dskip;
    __device__ __forceinline__ void operator()(const f32x4 (&acc)[2][2][4][2], const Unit& u, int wr, int wc, int fr, int fq) const {
        const int g = u.e;
#pragma unroll
        for (int ai = 0; ai < 2; ++ai)
#pragma unroll
            for (int m = 0; m < 4; ++m) { const int rr = (u.pm - g * 9) * BM + wr * 64 + fr + ai * HALF + m * 16;
                if (rr < 2176) { const int b = rr / 272, n = rr - b * 272;
                    const int tok0 = n < 16 ? b * 256 + n * 16 : 2048 + b * 4096 + (n - 16) * 16;
#pragma unroll
                    for (int bj = 0; bj < 2; ++bj) { const int col = bj * HALF + wc * 32 + 8 * fq, t = col >> 4, c0 = col & 15;
                        const u32x4 uv = *(const u32x4*)(A2 + ((size_t)g * 2304 + rr) * 512 + col);
                        const f32x4 d0 = *(const f32x4*)(dskip + g * 16 + c0), d1 = *(const f32x4*)(dskip + g * 16 + c0 + 4);
                        float y[8];
                        y[0] = acc[ai][bj][m][0][0] + d0[0] * bflo(uv.x); y[1] = acc[ai][bj][m][0][1] + d0[1] * bfhi(uv.x); y[2] = acc[ai][bj][m][0][2] + d0[2] * bflo(uv.y); y[3] = acc[ai][bj][m][0][3] + d0[3] * bfhi(uv.y);
                        y[4] = acc[ai][bj][m][1][0] + d1[0] * bflo(uv.z); y[5] = acc[ai][bj][m][1][1] + d1[1] * bfhi(uv.z); y[6] = acc[ai][bj][m][1][2] + d1[2] * bflo(uv.w); y[7] = acc[ai][bj][m][1][3] + d1[3] * bfhi(uv.w);
#pragma unroll
                        for (int j = 0; j < 8; ++j) { const float z = y[j], th = 0.7978845608f * (z + 0.044715f * z * z * z); const float e2 = __expf(2.0f * th); y[j] = 0.5f * z * (1.0f + (1.0f - 2.0f / (e2 + 1.0f))); }
                        u32x4 w; w.x = cvt_pk_bf16(y[0], y[1]); w.y = cvt_pk_bf16(y[2], y[3]); w.z = cvt_pk_bf16(y[4], y[5]); w.w = cvt_pk_bf16(y[6], y[7]);
                        *(u32x4*)(YP + (size_t)(tok0 + t) * 512 + g * 16 + c0) = w; } } }
    }
};
struct GroupOrder {
    int tpg, nunits, G, c;
    __device__ __forceinline__ bool next(int i, Unit& u) const { const int L = i * G + c; if (L >= nunits) return false; u.pm = L; u.pn = 0; u.e = L / tpg; u.pb = u.e; return true; }
    __device__ __forceinline__ void a_ready(const Unit&) const {}
    __device__ __forceinline__ void done(const Unit&) const {}
};
template <class Epi, class Sched, bool ALIGN_EPI = false, bool SP2 = false, bool GATHER = false>
__device__ __forceinline__ void gemm_phase(PG8_LAS unsigned char* lds, const Gemm g, const Sched& S, const Epi& E) {
    static_assert(!GATHER || SP2, "gathered A staging is implemented in the SP2 loop only");
    const int tid = threadIdx.x, wid = __builtin_amdgcn_readfirstlane(tid >> 6), lane = tid & 63, wr = wid >> 2, wc = wid & 3, fr = lane & 15, fq = lane >> 4;
    int K_ = g.K; asm volatile("" : "+s"(K_));
    const int K = K_, nt = K / BK;
    unsigned voffA[2], voffB[2];
#pragma unroll
    for (int i = 0; i < 2; ++i) { int R, C; stage_rc(tid * 16 + i * 8192, R, C); const int Rb = Epi::PERM ? ((R & ~31) + perm32(R & 31)) : R;
        voffA[i] = (unsigned)(R * g.lda + C) * 2u; voffB[i] = (unsigned)(Rb * K + C) * 2u; }
    const size_t kstep = (size_t)(BK * 2);
    const size_t hstep = (size_t)HALF * K * 2;
    const size_t tstep = 2 * hstep;
    const size_t hstepA = (size_t)HALF * g.lda * 2, tstepA = 2 * hstepA;
    const unsigned ldsw = (unsigned)wid * 1024u;
    const int aoff = lds_byte(wr * 64 + fr, fq * 8), boff = lds_byte(wc * 32 + fr, fq * 8);
#define PG8_SA(b, h) (((b) * 2 + (h)) * HTB)
#define PG8_SB(b, h) ((4 + (b) * 2 + (h)) * HTB)
#define PG8_STAGE(bufoff, gbase, voff) do { _Pragma("unroll") for (int _i = 0; _i < 2; ++_i) \
        __builtin_amdgcn_global_load_lds((const unsigned*)((const char*)(gbase) + (voff)[_i]), (PG8_LAS unsigned*)(lds + (bufoff) + ldsw + _i * 8192), 16, 0, 0); } while (0)
#define PG8_STAGE_H0(bufoff, gbase) do { if constexpr (GATHER) PG8_STAGE(bufoff, gbase, voffA0); else PG8_STAGE(bufoff, gbase, voffA); } while (0)
#define PG8_STAGE_H1(bufoff, gbase) do { if constexpr (GATHER) PG8_STAGE(bufoff, gbase, voffA1); else PG8_STAGE(bufoff, (gbase) + hstepA, voffA); } while (0)
#define PG8_GOFF(unit, h, dst) do { _Pragma("unroll") for (int _i = 0; _i < 2; ++_i) { int _R, _C; stage_rc(tid * 16 + _i * 8192, _R, _C); dst[_i] = (unsigned)S.rowidx(unit, (h) * HALF + _R); } } while (0)
#define PG8_GCONV(dst, src) do { _Pragma("unroll") for (int _i = 0; _i < 2; ++_i) { int _R, _C; stage_rc(tid * 16 + _i * 8192, _R, _C); dst[_i] = (src[_i] * (unsigned)g.lda + (unsigned)_C) * 2u; } } while (0)
#define PG8_LDA(dst, b, h) do { _Pragma("unroll") for (int m = 0; m < 4; ++m) _Pragma("unroll") for (int k = 0; k < 2; ++k) dst[m][k] = *(const PG8_LAS bf16x8*)(lds + PG8_SA(b, h) + aoff + m * 2048 + k * 1024); } while (0)
#define PG8_LDB(dst, b, h) do { _Pragma("unroll") for (int n = 0; n < 2; ++n) _Pragma("unroll") for (int k = 0; k < 2; ++k) dst[n][k] = *(const PG8_LAS bf16x8*)(lds + PG8_SB(b, h) + boff + n * 2048 + k * 1024); } while (0)
#define PG8_MMA(ai, bj, At, Bt) do { __builtin_amdgcn_s_setprio(1); _Pragma("unroll") for (int m = 0; m < 4; ++m) _Pragma("unroll") for (int n = 0; n < 2; ++n) _Pragma("unroll") for (int k = 0; k < 2; ++k) \
        acc[ai][bj][m][n] = __builtin_amdgcn_mfma_f32_16x16x32_bf16(Bt[n][k], At[m][k], acc[ai][bj][m][n], 0, 0, 0); __builtin_amdgcn_s_setprio(0); } while (0)
#define PG8_WAIT_V(n) asm volatile("s_waitcnt vmcnt(" #n ")" ::: "memory")
#define PG8_WAIT_L(n) asm volatile("s_waitcnt lgkmcnt(" #n ")" ::: "memory")
#define PG8_BAR __builtin_amdgcn_s_barrier()
#define PG8_SCHED __builtin_amdgcn_sched_barrier(0)
    Unit cur, nxt; int ui = 0;
    if (!S.next(0, cur)) return;
    f32x4 acc[2][2][4][2];
#pragma unroll
    for (int a = 0; a < 2; ++a)
#pragma unroll
        for (int b = 0; b < 2; ++b)
#pragma unroll
            for (int m = 0; m < 4; ++m)
#pragma unroll
                for (int n = 0; n < 2; ++n) acc[a][b][m][n] = (f32x4){0.f, 0.f, 0.f, 0.f};
    bf16x8 At[4][2], B0[2][2], B1[2][2];
    const char* cA = (const char*)g.A + (GATHER ? (size_t)0 : (size_t)cur.pm * tstepA);
    unsigned voffA0[2] = {0u, 0u}, voffA1[2] = {0u, 0u}, nidx0[2] = {0u, 0u}, nidx1[2] = {0u, 0u};
    if constexpr (GATHER) { PG8_GOFF(cur, 0, nidx0); PG8_GOFF(cur, 1, nidx1); PG8_GCONV(voffA0, nidx0); PG8_GCONV(voffA1, nidx1); } const char* cB = (const char*)g.Bt + (size_t)cur.pb * tstep;
    S.a_ready(cur);
    if constexpr (SP2) {
        PG8_STAGE(PG8_SB(0, 0), cB, voffB); PG8_STAGE(PG8_SB(0, 1), cB + hstep, voffB); PG8_STAGE_H0(PG8_SA(0, 0), cA); PG8_STAGE_H1(PG8_SA(0, 1), cA);
        if (wr == 1) PG8_BAR;
        PG8_WAIT_V(2); PG8_BAR;
        PG8_STAGE(PG8_SB(1, 0), cB + kstep, voffB); PG8_STAGE_H0(PG8_SA(1, 0), cA + kstep); PG8_STAGE(PG8_SB(1, 1), cB + hstep + kstep, voffB);
        PG8_WAIT_V(6); PG8_BAR;
    } else {
        PG8_STAGE(PG8_SB(0, 0), cB, voffB); PG8_STAGE_H0(PG8_SA(0, 0), cA); PG8_STAGE(PG8_SB(0, 1), cB + hstep, voffB); PG8_STAGE_H1(PG8_SA(0, 1), cA);
        if (wr == 1) PG8_BAR;
        PG8_WAIT_V(4); PG8_BAR;
        PG8_STAGE(PG8_SB(1, 0), cB + kstep, voffB); PG8_STAGE_H0(PG8_SA(1, 0), cA + kstep); PG8_STAGE(PG8_SB(1, 1), cB + hstep + kstep, voffB);
        PG8_WAIT_V(6); PG8_BAR;
    }
    for (;;) {
        const bool has_next = S.next(ui + 1, nxt);
        const char* nA = (has_next && !GATHER) ? (const char*)g.A + (size_t)nxt.pm * tstepA : cA; const char* nB = has_next ? (const char*)g.Bt + (size_t)nxt.pb * tstep : cB;
        for (int t = 0; t < nt; t += 2) {
            const bool last = (t == nt - 2);
            const char* a1 = cA + (size_t)(t + 1) * kstep;
            const char* a2 = last ? nA : cA + (size_t)(t + 2) * kstep; const char* b2 = last ? nB : cB + (size_t)(t + 2) * kstep;
            const char* a3 = a2 + kstep; const char* b3 = b2 + kstep;
            if (last && has_next) S.a_ready(nxt);
            if constexpr (GATHER) { if (has_next && t == nt - 4) { PG8_GOFF(nxt, 0, nidx0); PG8_GOFF(nxt, 1, nidx1); }
                                    if (has_next && last) PG8_GCONV(voffA0, nidx0); }
            if constexpr (SP2) {
            PG8_LDB(B0, 0, 0); PG8_LDB(B1, 0, 1); PG8_SCHED; PG8_LDA(At, 0, 0); PG8_STAGE_H1(PG8_SA(1, 1), a1);
            if constexpr (GATHER) { if (has_next && last) PG8_GCONV(voffA1, nidx1); }
            PG8_WAIT_V(8); PG8_WAIT_L(0); PG8_BAR; PG8_MMA(0, 0, At, B0); PG8_MMA(0, 1, At, B1); PG8_BAR; PG8_SCHED;
            PG8_LDA(At, 0, 1); PG8_STAGE(PG8_SB(0, 0), b2, voffB); PG8_STAGE(PG8_SB(0, 1), b2 + hstep, voffB); PG8_STAGE_H0(PG8_SA(0, 0), a2);
            PG8_WAIT_V(8); PG8_WAIT_L(0); PG8_BAR; PG8_MMA(1, 0, At, B0); PG8_MMA(1, 1, At, B1); PG8_BAR; PG8_SCHED;
            PG8_LDB(B0, 1, 0); PG8_LDB(B1, 1, 1); PG8_SCHED; PG8_LDA(At, 1, 0); PG8_STAGE_H1(PG8_SA(0, 1), a2);
            PG8_WAIT_V(8); PG8_WAIT_L(0); PG8_BAR; PG8_MMA(0, 0, At, B0); PG8_MMA(0, 1, At, B1); PG8_BAR; PG8_SCHED;
            PG8_LDA(At, 1, 1); PG8_STAGE(PG8_SB(1, 0), b3, voffB); PG8_STAGE(PG8_SB(1, 1), b3 + hstep, voffB); PG8_STAGE_H0(PG8_SA(1, 0), a3);
            PG8_WAIT_V(8); PG8_WAIT_L(0); PG8_BAR; PG8_MMA(1, 0, At, B0); PG8_MMA(1, 1, At, B1); PG8_BAR; PG8_SCHED;
            } else {
            PG8_LDB(B0, 0, 0); PG8_SCHED; PG8_LDA(At, 0, 0); PG8_STAGE(PG8_SA(1, 1), a1 + hstepA, voffA);
            PG8_WAIT_L(8); PG8_BAR; PG8_WAIT_L(0); PG8_MMA(0, 0, At, B0); PG8_BAR; PG8_SCHED;
            PG8_LDB(B1, 0, 1); PG8_STAGE(PG8_SB(0, 0), b2, voffB);
            PG8_BAR; PG8_WAIT_L(0); PG8_MMA(0, 1, At, B1); PG8_BAR;
            PG8_LDA(At, 0, 1); PG8_STAGE(PG8_SA(0, 0), a2, voffA);
            PG8_BAR; PG8_WAIT_L(0); PG8_MMA(1, 0, At, B0); PG8_BAR; PG8_SCHED;
            PG8_STAGE(PG8_SB(0, 1), b2 + hstep, voffB);
            PG8_WAIT_V(6); PG8_BAR; PG8_MMA(1, 1, At, B1); PG8_BAR;
            PG8_LDB(B0, 1, 0); PG8_SCHED; PG8_LDA(At, 1, 0); PG8_STAGE(PG8_SA(0, 1), a2 + hstepA, voffA);
            PG8_WAIT_L(8); PG8_BAR; PG8_WAIT_L(0); PG8_MMA(0, 0, At, B0); PG8_BAR; PG8_SCHED;
            PG8_LDB(B1, 1, 1); PG8_STAGE(PG8_SB(1, 0), b3, voffB);
            PG8_BAR; PG8_WAIT_L(0); PG8_MMA(0, 1, At, B1); PG8_BAR;
            PG8_LDA(At, 1, 1); PG8_STAGE(PG8_SA(1, 0), a3, voffA);
            PG8_BAR; PG8_WAIT_L(0); PG8_MMA(1, 0, At, B0); PG8_BAR; PG8_SCHED;
            PG8_STAGE(PG8_SB(1, 1), b3 + hstep, voffB);
            PG8_WAIT_V(6); PG8_BAR; PG8_MMA(1, 1, At, B1); PG8_BAR;
            }
        }
        if constexpr (ALIGN_EPI) { if (wr == 0) PG8_BAR; }
        if constexpr (!Epi::AFTER_DRAIN) { E(acc, cur, wr, wc, fr, fq); S.done(cur); }
        if (!has_next) break;
#pragma unroll
        for (int a = 0; a < 2; ++a)
#pragma unroll
            for (int b = 0; b < 2; ++b)
#pragma unroll
                for (int m = 0; m < 4; ++m)
#pragma unroll
                    for (int n = 0; n < 2; ++n) acc[a][b][m][n] = (f32x4){0.f, 0.f, 0.f, 0.f};
        cur = nxt; cA = nA; cB = nB; ++ui;
        if constexpr (ALIGN_EPI) { if (wr == 1) PG8_BAR; }
    }
    PG8_WAIT_V(0);
    if constexpr (!ALIGN_EPI) { if (wr == 0) PG8_BAR; }
    PG8_BAR;
    if constexpr (Epi::AFTER_DRAIN) { E.fused(acc, cur, wr, wc, fr, fq, lds, wid, lane); S.done(cur); }
#undef PG8_SA
#undef PG8_SB
#undef PG8_STAGE
#undef PG8_STAGE_H0
#undef PG8_STAGE_H1
#undef PG8_GOFF
#undef PG8_GCONV
#undef PG8_LDA
#undef PG8_LDB
#undef PG8_MMA
#undef PG8_WAIT_V
#undef PG8_WAIT_L
#undef PG8_BAR
#undef PG8_SCHED
}
}
constexpr int NWAVES = 8, NTHR = 512;
constexpr int D = 1024, NB = 8, SEQ = 4096, CTX = 256;
constexpr int NCTX = NB * CTX, NLAT = NB * SEQ, MALL = NCTX + NLAT;
constexpr int N0 = 2304, N1 = 6144;
constexpr int C0_Q = 0, C0_K = 256, C0_V = 512, C0_G = 1024, C0_U = 1536, C0_LOW = 2048;
constexpr int C1_Q = 0, C1_K = 1024, C1_V = 2048, C1_G = 4096;
constexpr int NE = 32, MAXTILES = 576;
constexpr float EPS = 1e-6f;
constexpr int NPH = 24;
enum { PH_PRO = 0, PH_NORM1, PH_INPROJ0, PH_GLAPREP, PH_GLA, PH_S5, PH_FIN0, PH_GLU, PH_OUT0, PH_ROUTER0, PH_GATHER0, PH_GU0, PH_DOWN0, PH_COMB0,
       PH_INPROJ1, PH_ROPE, PH_RET, PH_FIN1, PH_OUT1, PH_ROUTER1, PH_GATHER1, PH_GU1, PH_DOWN1, PH_COMB1 };
#ifndef MK_NAIVE_GLA
#define MK_NAIVE_GLA 0
#endif
#ifndef MK_NAIVE_S5
#define MK_NAIVE_S5 0
#endif
#ifndef MK_NAIVE_RET
#define MK_NAIVE_RET 0
#endif
constexpr size_t MiB = 1u << 20;
constexpr size_t WS_CTL = 0, CTL_ZERO_BYTES = 1 * MiB;
constexpr size_t WS_MOD = 1 * MiB;
constexpr size_t WS_WIN0T = 2 * MiB, WS_WOUT0T = 7 * MiB, WS_WGLUT = 9 * MiB, WS_WIN1T = 10 * MiB, WS_WOUT1T = 22 * MiB;
constexpr size_t WS_SELE = 26 * MiB, WS_WSLOT = 27 * MiB, WS_SPOS = 28 * MiB, WS_PROW = 29 * MiB;
constexpr size_t WS_WGUT = 32 * MiB, WS_WDNT = 288 * MiB;
constexpr size_t WS_XRES = 416 * MiB, WS_H = 552 * MiB, WS_MIX = 620 * MiB, WS_YPRE = 688 * MiB;
constexpr size_t WS_PROJ = 748 * MiB, WS_OREC = 1156 * MiB;
constexpr size_t WS_XG = 748 * MiB, WS_ACT = 1036 * MiB, WS_YSLOT = 1324 * MiB;
constexpr size_t WS_S5W1 = 1556 * MiB, WS_S5W2 = 1560 * MiB, WS_A2 = 1568 * MiB, WS_SLOC = 1668 * MiB;
constexpr size_t WS_ELIST = 1740 * MiB;
constexpr size_t WS_END = 1746 * MiB;
constexpr int CW_TMO = 0, CW_BAR = 4096, CW_GCNT = 16384;
constexpr int RING_BYTES = 131072, LDSCTL_OFF = RING_BYTES, LDS_BYTES = 147456;
constexpr int L_MISC = LDSCTL_OFF;
constexpr int L_TILEE = LDSCTL_OFF + 256;
constexpr int L_TSTART = LDSCTL_OFF + 1024;
constexpr int L_LCNT = LDSCTL_OFF + 1280;
constexpr int L_GBASE = LDSCTL_OFF + 1536;
constexpr int L_BLKE = LDSCTL_OFF + 2048;
constexpr int L_BLKP = LDSCTL_OFF + 5120;
constexpr int L_TPOS = L_BLKE, L_TCNT = L_BLKP;

#define GAS __attribute__((address_space(1)))
#define LAS __attribute__((address_space(3)))
typedef unsigned short bf16;
typedef unsigned v4u __attribute__((ext_vector_type(4)));
typedef unsigned v2u __attribute__((ext_vector_type(2)));
typedef float f32x4 __attribute__((ext_vector_type(4)));
typedef GAS unsigned gu32;
#define RLX_AGENT __ATOMIC_RELAXED, __HIP_MEMORY_SCOPE_AGENT
#define LDS_WAIT() asm volatile("s_waitcnt lgkmcnt(0)" ::: "memory")
#define VM_WAIT() asm volatile("s_waitcnt vmcnt(0)" ::: "memory")
__device__ __forceinline__ unsigned f2bf(float f) { unsigned u = __builtin_bit_cast(unsigned, f); return (u + 0x7fffu + ((u >> 16) & 1u)) >> 16; }
__device__ __forceinline__ unsigned pk2(float lo, float hi) { return f2bf(lo) | (f2bf(hi) << 16); }
__device__ __forceinline__ float bf2f(unsigned b) { return __uint_as_float(b << 16); }
__device__ __forceinline__ float blo(unsigned w) { return __uint_as_float(w << 16); }
__device__ __forceinline__ float bhi(unsigned w) { return __uint_as_float(w & 0xffff0000u); }
__device__ __forceinline__ float wave_sum(float v) {
#pragma unroll
    for (int o = 1; o < 64; o <<= 1) v += __shfl_xor(v, o);
    return v;
}
__device__ __forceinline__ float silu_(float z) { return z / (1.0f + __expf(-z)); }
#define XB_TMO      128
#define XB_XCNT(j)  (256  + 64 * (j))
#define XB_XSUB(j)  (1280 + 64 * (j))
#define XB_XGEN(j)  (2304 + 64 * (j))
#define XB_TOP      3328
#define XB_TOPGEN   3392
#define XCD_BAR_WORDS 3456
#define XB_SPIN_CAP (1u << 22)

__device__ __forceinline__ unsigned xb_ld(unsigned* p)              { return __hip_atomic_load(p, __ATOMIC_RELAXED, __HIP_MEMORY_SCOPE_AGENT); }
__device__ __forceinline__ unsigned xb_add(unsigned* p, unsigned v) { return __hip_atomic_fetch_add(p, v, __ATOMIC_RELAXED, __HIP_MEMORY_SCOPE_AGENT); }
__device__ __forceinline__ unsigned xb_xcc_id() { return (unsigned)__builtin_amdgcn_s_getreg((3 << 11) | 20) & 0xFu; }
#define XB_SPIN(cond, bar) do { unsigned _sp = 0; while (cond) { __builtin_amdgcn_s_sleep(1); \
    if ((++_sp & 255u) == 0u) { if (xb_ld(&(bar)[XB_TMO])) break; if (_sp > XB_SPIN_CAP) { atomicAdd(&(bar)[XB_TMO], 1u); break; } } } } while (0)

struct XcdBarrier {
    unsigned* bar; unsigned x;
    volatile LAS unsigned* st;
};

__device__ __forceinline__ XcdBarrier xcd_barrier_post(unsigned* bar, volatile LAS unsigned* st) {
    XcdBarrier b; b.bar = bar; b.x = xb_xcc_id(); b.st = st;
    if (threadIdx.x == 0) (void)xb_add(&bar[XB_XCNT(b.x)], 1u);
    return b;
}
__device__ __forceinline__ void xcd_barrier_complete(unsigned* bar, unsigned x, unsigned& nloc, unsigned& nx) {
    const unsigned G = gridDim.x * gridDim.y * gridDim.z;
    unsigned sum, cnt, mine, sp = 0u;
    for (;;) {
        sum = 0u; cnt = 0u; mine = 0u;
#pragma unroll
        for (unsigned j = 0; j < 16; ++j) { const unsigned c = xb_ld(&bar[XB_XCNT(j)]); sum += c; cnt += (c > 0u) ? 1u : 0u; mine = (j == x) ? c : mine; }
        if (sum == G) break;
        __builtin_amdgcn_s_sleep(1);
        if ((++sp & 255u) == 0u) { if (xb_ld(&bar[XB_TMO])) break; if (sp > XB_SPIN_CAP) { atomicAdd(&bar[XB_TMO], 1u); break; } }
    }
    nloc = mine > 0u ? mine : 1u; nx = cnt > 0u ? cnt : 1u;
}

__device__ __forceinline__ void xcd_barrier(const XcdBarrier& b) {
    asm volatile("s_waitcnt vmcnt(0)" ::: "memory");
    __syncthreads();
    if (threadIdx.x == 0) {
        unsigned* bar = b.bar;
        __builtin_amdgcn_s_waitcnt(0);
        unsigned nloc = b.st[0], nx = b.st[1];
        if (nloc == 0u) { xcd_barrier_complete(bar, b.x, nloc, nx); b.st[0] = nloc; b.st[1] = nx; }
        const unsigned old = xb_add(&bar[XB_XSUB(b.x)], 1u);
        const unsigned gen = old / nloc;
        if (old + 1u == (gen + 1u) * nloc) {
            __builtin_amdgcn_fence(__ATOMIC_RELEASE, "agent");
            asm volatile("s_waitcnt vmcnt(0)" ::: "memory");
            const unsigned og = xb_add(&bar[XB_TOP], 1u);
            const unsigned tg = og / nx;
            if (og + 1u == (tg + 1u) * nx) xb_add(&bar[XB_TOPGEN], 1u);
            else XB_SPIN(xb_ld(&bar[XB_TOPGEN]) == tg, bar);
            __builtin_amdgcn_fence(__ATOMIC_ACQUIRE, "agent");
            xb_add(&bar[XB_XGEN(b.x)], 1u);
            asm volatile("s_waitcnt vmcnt(0)" ::: "memory");
        } else {
            XB_SPIN(xb_ld(&bar[XB_XGEN(b.x)]) == gen, bar);
            __builtin_amdgcn_fence(__ATOMIC_ACQUIRE, "agent");
            asm volatile("s_waitcnt vmcnt(0)" ::: "memory");
        }
    }
    __syncthreads();
}
struct Args { const float* in[34]; float* out; unsigned char* ws; int ph_lo, ph_hi; };
#define CAS __attribute__((address_space(4)))
struct KA {
    const CAS unsigned char* p;
    __device__ __forceinline__ const float* I(int i) const { return *(const float* const CAS*)(p + 8 * i); }
    __device__ __forceinline__ float* OUT() const { return *(float* const CAS*)(p + 8 * 34); }
    __device__ __forceinline__ unsigned char* WS() const { return *(unsigned char* const CAS*)(p + 8 * 35); }
    __device__ __forceinline__ int LO() const { return *(const CAS int*)(p + 8 * 36); }
    __device__ __forceinline__ int HI() const { return *(const CAS int*)(p + 8 * 36 + 4); }
};
__device__ __forceinline__ KA ka_fresh() { KA a; a.p = (const CAS unsigned char*)__builtin_amdgcn_kernarg_segment_ptr(); asm volatile("" : "+s"(a.p)); return a; }
static_assert(sizeof(Args) == 8 * 36 + 8, "kernarg layout");
struct Frame {
    LAS unsigned char* lds;
    volatile LAS unsigned* MISC;
    unsigned* ctl;
    int tid, lane, wave, vcu, G;
};
enum { I_X = 0, I_C, I_CTX, I_CCTX, I_ADAW, I_ADAB, I_N1G, I_N2G, I_ABWIN, I_ABWOUT, I_GLAWA, I_GLABA, I_GLANG, I_LAMRE, I_LAMIM, I_LOGSTEP, I_BRE, I_BIM, I_CRE, I_CIM,
       I_S5D, I_GLUW, I_GLUB, I_RETWIN, I_RETWOUT, I_RETDEC, I_RETNG, I_WROUTER, I_BROUTER, I_WGU, I_BGU, I_WDN, I_BDN, I_FNG };

constexpr int S5_ROWS = 2304, S5_CH = 272;
struct S5Par { float lr, li, step; };
__device__ __forceinline__ void s5_cpow(float lr, float li, float step, float n, float& ar, float& ai) { const float mag = expf(lr * step * n); float s, c; sincosf(li * step * n, &s, &c); ar = mag * c; ai = mag * s; }
__device__ __forceinline__ void s5_zoh_f(float lr, float li, float step, float& fr, float& fi) { float ar, ai; s5_cpow(lr, li, step, 1.0f, ar, ai); const float den = lr * lr + li * li;
    fr = ((ar - 1.0f) * lr + ai * li) / den; fi = (ai * lr - (ar - 1.0f) * li) / den; }
__device__ __forceinline__ void s5_table_item(const KA& A, int kind, int idx, bf16* W1T, bf16* W2T, LAS float* scr, int lane) {
    if (kind == 0) {
        const int g = idx >> 8, n = idx & 255, dir = n >> 7, ri = (n >> 6) & 1, p = n & 63;
        const float lr = A.I(I_LAMRE)[(dir * 32 + g) * 64 + p], li = A.I(I_LAMIM)[(dir * 32 + g) * 64 + p], step = expf(A.I(I_LOGSTEP)[dir * 32 + g]);
        float fr, fi; s5_zoh_f(lr, li, step, fr, fi);
        const int t = lane >> 2, c0 = (lane & 3) * 4;
        float ar, ai; s5_cpow(lr, li, step, (float)(dir ? t : 15 - t), ar, ai);
        const float gr = ar * fr - ai * fi, gi = ar * fi + ai * fr;
        float o[4];
#pragma unroll
        for (int j = 0; j < 4; ++j) { const float br = A.I(I_BRE)[(g * 64 + p) * 16 + c0 + j], bi = A.I(I_BIM)[(g * 64 + p) * 16 + c0 + j]; o[j] = ri ? (gr * bi + gi * br) : (gr * br - gi * bi); }
        v2u w; w.x = pk2(o[0], o[1]); w.y = pk2(o[2], o[3]);
        *(GAS v2u*)(W1T + ((size_t)g * 256 + n) * 256 + 4 * lane) = w;
    } else if (kind == 1) {
        const int g = idx >> 8, n = idx & 255, t = n >> 4, cp = n & 15;
        const int dir = lane >> 5, ri = (lane >> 4) & 1, p0 = (lane & 15) * 4;
        const float step = expf(A.I(I_LOGSTEP)[dir * 32 + g]);
        float o[4];
#pragma unroll
        for (int j = 0; j < 4; ++j) { const int p = p0 + j;
            const float lr = A.I(I_LAMRE)[(dir * 32 + g) * 64 + p], li = A.I(I_LAMIM)[(dir * 32 + g) * 64 + p];
            float ar, ai; s5_cpow(lr, li, step, (float)(dir ? 16 - t : t + 1), ar, ai);
            const float cr = A.I(I_CRE)[((dir * 32 + g) * 16 + cp) * 64 + p], ci = A.I(I_CIM)[((dir * 32 + g) * 16 + cp) * 64 + p];
            o[j] = ri ? -(cr * ai + ci * ar) : (cr * ar - ci * ai); }
        v2u w; w.x = pk2(o[0], o[1]); w.y = pk2(o[2], o[3]);
        *(GAS v2u*)(W2T + ((size_t)g * 256 + n) * 512 + 256 + 4 * lane) = w;
    } else {
        const int g = idx >> 4, tau = idx & 15;
        {
#pragma unroll
            for (int dir = 0; dir < 2; ++dir) { const float lr = A.I(I_LAMRE)[(dir * 32 + g) * 64 + lane], li = A.I(I_LAMIM)[(dir * 32 + g) * 64 + lane], step = expf(A.I(I_LOGSTEP)[dir * 32 + g]);
                float fr, fi, ar, ai; s5_zoh_f(lr, li, step, fr, fi); s5_cpow(lr, li, step, (float)tau, ar, ai);
                scr[(dir * 64 + lane) * 2] = ar * fr - ai * fi; scr[(dir * 64 + lane) * 2 + 1] = ar * fi + ai * fr; }
        }
        LDS_WAIT(); asm volatile("" ::: "memory");
        const int cp = lane >> 2, c0 = (lane & 3) * 4;
        float kf[4] = {0.f, 0.f, 0.f, 0.f}, kb2[4] = {0.f, 0.f, 0.f, 0.f};
        for (int p = 0; p < 64; ++p) {
            const f32x4 b4r = *(const f32x4*)(A.I(I_BRE) + (g * 64 + p) * 16 + c0), b4i = *(const f32x4*)(A.I(I_BIM) + (g * 64 + p) * 16 + c0);
#pragma unroll
            for (int dir = 0; dir < 2; ++dir) { const float gr = scr[(dir * 64 + p) * 2], gi = scr[(dir * 64 + p) * 2 + 1];
                const float cr = A.I(I_CRE)[((dir * 32 + g) * 16 + cp) * 64 + p], ci = A.I(I_CIM)[((dir * 32 + g) * 16 + cp) * 64 + p];
#pragma unroll
                for (int j = 0; j < 4; ++j) { const float xr = gr * b4r[j] - gi * b4i[j], xi = gr * b4i[j] + gi * b4r[j]; const float v = cr * xr - ci * xi;
                    if (dir == 0) kf[j] += v; else kb2[j] += v; } }
        }
        LDS_WAIT(); asm volatile("" ::: "memory");
        bf16* Wg = W2T + (size_t)g * 256 * 512;
        if (tau == 0) { v2u w; w.x = pk2(kf[0] + kb2[0], kf[1] + kb2[1]); w.y = pk2(kf[2] + kb2[2], kf[3] + kb2[3]);
            for (int t = 0; t < 16; ++t) *(GAS v2u*)(Wg + (size_t)(t * 16 + cp) * 512 + t * 16 + c0) = w;
        } else { v2u wf, wb; wf.x = pk2(kf[0], kf[1]); wf.y = pk2(kf[2], kf[3]); wb.x = pk2(kb2[0], kb2[1]); wb.y = pk2(kb2[2], kb2[3]);
            for (int t = tau; t < 16; ++t) *(GAS v2u*)(Wg + (size_t)(t * 16 + cp) * 512 + (t - tau) * 16 + c0) = wf;
            for (int t = 0; t + tau < 16; ++t) *(GAS v2u*)(Wg + (size_t)(t * 16 + cp) * 512 + (t + tau) * 16 + c0) = wb; }
    }
}
__device__ __forceinline__ void p_s5_scan(Frame& F, const float* SLOC, bf16* A2) {
    const KA A = ka_fresh();
    if (F.tid >= 128) return;
    for (int idx = F.vcu * 128 + F.tid; idx < NB * 32 * 2 * 64; idx += F.G * 128) {
        const int p = idx & 63, dir = (idx >> 6) & 1, g = (idx >> 7) & 31, b = idx >> 12;
        const float lr = A.I(I_LAMRE)[(dir * 32 + g) * 64 + p], li = A.I(I_LAMIM)[(dir * 32 + g) * 64 + p], step = expf(A.I(I_LOGSTEP)[dir * 32 + g]);
        float ar, ai; s5_cpow(lr, li, step, 16.0f, ar, ai);
        float sr = 0.f, si = 0.f;
        const size_t rbase = (size_t)g * S5_ROWS + (size_t)b * S5_CH;
        for (int q0 = 0; q0 < S5_CH; q0 += 16) {
            float lre[16], lim[16];
#pragma unroll
            for (int u = 0; u < 16; ++u) { const int q = q0 + u, n = dir ? (q < 16 ? 15 - q : 271 - (q - 16)) : q; const float* sp = SLOC + (rbase + n) * 256 + dir * 128 + p; lre[u] = sp[0]; lim[u] = sp[64]; }
#pragma unroll
            for (int u = 0; u < 16; ++u) { const int q = q0 + u, n = dir ? (q < 16 ? 15 - q : 271 - (q - 16)) : q; bf16* ap = A2 + (rbase + n) * 512 + 256 + dir * 128 + p;
                ap[0] = (bf16)f2bf(sr); ap[64] = (bf16)f2bf(si);
                const float nr = ar * sr - ai * si + lre[u], ni = ar * si + ai * sr + lim[u]; sr = nr; si = ni; }
        }
    }
}
__device__ __forceinline__ void tr_item(const float* src, int ldsrc, int K, int srccol, float scale, bf16* dst, int dstrow0, int k0, LAS float* scr, int lane) {
    if (srccol >= 0) {
        float t[32]; const float* sp = src + (size_t)(k0 + (lane >> 5)) * ldsrc + srccol + (lane & 31);
#pragma unroll
        for (int i = 0; i < 32; ++i) t[i] = sp[(size_t)(2 * i) * ldsrc];
#pragma unroll
        for (int i = 0; i < 32; ++i) scr[(2 * i + (lane >> 5)) * 33 + (lane & 31)] = t[i] * scale;
    } else {
#pragma unroll 8
        for (int i = 0; i < 32; ++i) { const int kk = 2 * i + (lane >> 5); scr[kk * 33 + (lane & 31)] = 0.f; }
    }
    LDS_WAIT(); asm volatile("" ::: "memory");
    const int c = lane & 7;
#pragma unroll
    for (int j = 0; j < 4; ++j) { const int n = (lane >> 3) + 8 * j; const LAS float* s = scr + (8 * c) * 33 + n;
        v4u o; o.x = pk2(s[0 * 33], s[1 * 33]); o.y = pk2(s[2 * 33], s[3 * 33]); o.z = pk2(s[4 * 33], s[5 * 33]); o.w = pk2(s[6 * 33], s[7 * 33]);
        *(GAS v4u*)(dst + (size_t)(dstrow0 + n) * K + k0 + 8 * c) = o; }
    LDS_WAIT(); asm volatile("" ::: "memory");
}
__device__ __forceinline__ void p0_prologue(Frame& F) {
    const KA A = ka_fresh();
    unsigned char* ws = A.WS();
    LAS float* scr = (LAS float*)(F.lds + F.wave * 8704);
    LAS float* sl = (LAS float*)(F.lds + 69632);
    for (int idx = F.tid; idx < 9 * 1024; idx += NTHR) { const int b = idx >> 10, k = idx & 1023; const float cv = b < 8 ? A.I(I_C)[b * 1024 + k] : A.I(I_CCTX)[k]; sl[k * 12 + b] = silu_(cv); }
    __syncthreads();
    const int gw = F.vcu * NWAVES + F.wave, NGW = F.G * NWAVES, lane = F.lane;
    for (int m = F.vcu; m < 192; m += F.G) {
        const int layer = m / 96, col = (m % 96) * 64 + lane;
        const float* w = A.I(I_ADAW) + (size_t)layer * 1024 * 6144 + (size_t)(F.wave * 128) * 6144 + col;
        float acc[9];
#pragma unroll
        for (int b = 0; b < 9; ++b) acc[b] = 0.f;
        for (int k0 = 0; k0 < 128; k0 += 16) {
            float wv[16];
#pragma unroll
            for (int u = 0; u < 16; ++u) wv[u] = w[(size_t)(k0 + u) * 6144];
#pragma unroll
            for (int u = 0; u < 16; ++u) {
#pragma unroll
                for (int b = 0; b < 9; ++b) acc[b] += sl[(F.wave * 128 + k0 + u) * 12 + b] * wv[u]; }
        }
        LAS float* red = (LAS float*)(F.lds);
#pragma unroll
        for (int b = 0; b < 9; ++b) red[(F.wave * 9 + b) * 64 + lane] = acc[b];
        __syncthreads();
        for (int idx = F.tid; idx < 9 * 64; idx += NTHR) { const int b = idx >> 6, l = idx & 63; float s = 0.f;
#pragma unroll
            for (int wv2 = 0; wv2 < 8; ++wv2) s += red[(wv2 * 9 + b) * 64 + l];
            const int c2 = (m % 96) * 64 + l;
            ((float*)(ws + WS_MOD))[(size_t)layer * 9 * 6144 + b * 6144 + c2] = s + A.I(I_ADAB)[layer * 6144 + c2]; }
        __syncthreads();
    }
    constexpr int I_S5A = 8192, I_S5B = 8192, I_S5C = 512, I_IN0 = 1152, I_OUT0 = 512, I_GLU = 128, I_IN1 = 3072, I_OUT1 = 1024, I_GU = 65536, I_DN = 32768;
    constexpr int NITEMS = I_S5A + I_S5B + I_S5C + I_IN0 + I_OUT0 + I_GLU + I_IN1 + I_OUT1 + I_GU + I_DN;
    for (int it = gw; it < NITEMS; it += NGW) {
        int r = it;
        if (r < I_S5A) { s5_table_item(A, 0, r, (bf16*)(ws + WS_S5W1), (bf16*)(ws + WS_S5W2), scr, lane); continue; }
        r -= I_S5A;
        if (r < I_S5B) { s5_table_item(A, 1, r, (bf16*)(ws + WS_S5W1), (bf16*)(ws + WS_S5W2), scr, lane); continue; }
        r -= I_S5B;
        if (r < I_S5C) { s5_table_item(A, 2, r, (bf16*)(ws + WS_S5W1), (bf16*)(ws + WS_S5W2), scr, lane); continue; }
        r -= I_S5C;
        if (r < I_IN0) { const int kb = r / 72, n0 = (r % 72) * 32;
            const int sc = n0 < 1536 ? n0 : (n0 < 2048 ? n0 + 32 : (n0 == 2048 ? 1536 : -1));
            tr_item(A.I(I_ABWIN), 2080, 1024, sc, n0 < 256 ? 0.125f : 1.0f, (bf16*)(ws + WS_WIN0T), n0, kb * 64, scr, lane); continue; }
        r -= I_IN0;
        if (r < I_OUT0) { tr_item(A.I(I_ABWOUT), 1024, 1024, (r % 32) * 32, 1.0f, (bf16*)(ws + WS_WOUT0T), (r % 32) * 32, (r / 32) * 64, scr, lane); continue; }
        r -= I_OUT0;
        if (r < I_GLU) { tr_item(A.I(I_GLUW), 512, 512, (r % 16) * 32, 1.0f, (bf16*)(ws + WS_WGLUT), (r % 16) * 32, (r / 16) * 64, scr, lane); continue; }
        r -= I_GLU;
        if (r < I_IN1) { const int n0 = (r % 192) * 32;
            tr_item(A.I(I_RETWIN), 6144, 1024, n0, (n0 >= 1024 && n0 < 2048) ? 0.0625f : 1.0f, (bf16*)(ws + WS_WIN1T), n0, (r / 192) * 64, scr, lane); continue; }
        r -= I_IN1;
        if (r < I_OUT1) { tr_item(A.I(I_RETWOUT), 1024, 2048, (r % 32) * 32, 1.0f, (bf16*)(ws + WS_WOUT1T), (r % 32) * 32, (r / 32) * 64, scr, lane); continue; }
        r -= I_OUT1;
        if (r < I_GU) { const int mat = r >> 10, q = r & 1023, kb = q >> 6, n0 = (q & 63) * 32;
            const int pn = n0 >> 8, bj = (n0 >> 7) & 1, lc = n0 & 127;
            tr_item(A.I(I_WGU) + (size_t)mat * 1024 * 2048, 2048, 1024, bj * 1024 + pn * 128 + lc, 1.0f, (bf16*)(ws + WS_WGUT) + (size_t)mat * 2048 * 1024, n0, kb * 64, scr, lane); continue; }
        r -= I_GU;
        { const int mat = r >> 9, q = r & 511, kb = q >> 5, n0 = (q & 31) * 32;
          tr_item(A.I(I_WDN) + (size_t)mat * 1024 * 1024, 1024, 1024, n0, 1.0f, (bf16*)(ws + WS_WDNT) + (size_t)mat * 1024 * 1024, n0, kb * 64, scr, lane); }
    }
}
__device__ __forceinline__ void modnorm_store(const f32x4 (&v)[4], const float* g, const float* sc, const float* sh, bf16* hrow, int lane, f32x4 (&h)[4]) {
    float ss = 0.f;
#pragma unroll
    for (int j = 0; j < 4; ++j) ss += (v[j].x * v[j].x + v[j].y * v[j].y) + (v[j].z * v[j].z + v[j].w * v[j].w);
    const float r = rsqrtf(wave_sum(ss) * (1.0f / 1024.0f) + EPS);
#pragma unroll
    for (int j = 0; j < 4; ++j) { const int o = 64 * j + lane;
        const f32x4 gg = ((const f32x4*)g)[o], s4 = ((const f32x4*)sc)[o], h4 = ((const f32x4*)sh)[o];
        h[j] = v[j] * r * gg * (s4 + 1.0f) + h4;
        v2u w; w.x = pk2(h[j].x, h[j].y); w.y = pk2(h[j].z, h[j].w);
        ((GAS v2u*)hrow)[o] = w; }
}
__device__ __forceinline__ int bidx_of_row(int row) { return row < NCTX ? 8 : ((row - NCTX) >> 12); }
__device__ __forceinline__ void p_norm1_l0(Frame& F) {
    const KA A = ka_fresh();
    const int gw = F.vcu * NWAVES + F.wave, NGW = F.G * NWAVES, lane = F.lane;
    const float* mod = (const float*)(A.WS() + WS_MOD);
    bf16* H = (bf16*)(A.WS() + WS_H);
    for (int row = gw; row < MALL; row += NGW) {
        const float* xr = row < NCTX ? A.I(I_CTX) + (size_t)row * 1024 : A.I(I_X) + (size_t)(row - NCTX) * 1024;
        f32x4 v[4], h[4];
#pragma unroll
        for (int j = 0; j < 4; ++j) v[j] = ((const f32x4*)xr)[64 * j + lane];
        const float* m = mod + bidx_of_row(row) * 6144;
        modnorm_store(v, A.I(I_N1G), m + 1024, m, H + (size_t)row * 1024, lane, h);
    }
}
__device__ __forceinline__ int seq_row(int b, int dir, int s) {
    return s < CTX ? b * CTX + (dir ? CTX - 1 - s : s) : NCTX + b * SEQ + (dir ? SEQ - 1 - (s - CTX) : (s - CTX));
}
template <int DK, bool GLA>
__device__ __forceinline__ void rec_naive(Frame& F, const bf16* P, int ldp, int qc, int kc, int vc, int DV, int nvs,
                                          float* O, size_t odir_stride, int ldo, int orow0) {
    const KA A = ka_fresh();
    constexpr int KPW = DK / 8, TB = 16;
    LAS float* qs = (LAS float*)(F.lds);
    LAS float* ks = (LAS float*)(F.lds + 16384);
    LAS float* vv = (LAS float*)(F.lds + 32768);
    LAS float* dec = (LAS float*)(F.lds + 36864);
    LAS float* opart = (LAS float*)(F.lds + 40960);
    const int tid = F.tid, lane = F.lane, wave = F.wave;
    const int nitems = NB * 4 * 2 * nvs;
    for (int it = F.vcu; it < nitems; it += F.G) {
        const int vs = it % nvs, dir = (it / nvs) & 1, h = (it / (2 * nvs)) & 3, b = it / (8 * nvs);
        float gamma = 0.f;
        if (!GLA) { const float lg = A.I(I_RETDEC)[dir * 4 + h]; gamma = 1.0f / (1.0f + expf(-lg)); }
        float S[KPW];
#pragma unroll
        for (int i = 0; i < KPW; ++i) S[i] = 0.f;
        for (int s0 = 0; s0 < CTX + SEQ; s0 += TB) {
            for (int idx = tid; idx < TB * DK; idx += NTHR) { const int i = idx / DK, kk = idx % DK; const size_t rb = (size_t)seq_row(b, dir, s0 + i) * ldp;
                qs[idx] = bf2f(P[rb + qc + h * DK + kk]); ks[idx] = bf2f(P[rb + kc + h * DK + kk]); }
            for (int idx = tid; idx < TB * 64; idx += NTHR) { const int i = idx >> 6, c = idx & 63; const size_t rb = (size_t)seq_row(b, dir, s0 + i) * ldp;
                vv[idx] = bf2f(P[rb + vc + h * DV + vs * 64 + c]);
                if (GLA) { float z = A.I(I_GLABA)[dir * 256 + h * 64 + c];
#pragma unroll
                    for (int r = 0; r < 16; ++r) z += bf2f(P[rb + C0_LOW + dir * 16 + r]) * A.I(I_GLAWA)[(dir * 16 + r) * 256 + h * 64 + c];
                    const float ls = fminf(z, 0.f) - log1pf(expf(-fabsf(z)));
                    dec[idx] = expf(ls * (1.0f / 16.0f)); } }
            __syncthreads();
#pragma unroll 1
            for (int i = 0; i < TB; ++i) { const float vval = vv[i * 64 + lane]; float part = 0.f;
#pragma unroll
                for (int kk = 0; kk < KPW; ++kk) { const int kidx = wave * KPW + kk; const float d = GLA ? dec[i * 64 + kidx] : gamma;
                    S[kk] = d * S[kk] + ks[i * DK + kidx] * vval; part += qs[i * DK + kidx] * S[kk]; }
                opart[(i * 8 + wave) * 64 + lane] = part; }
            __syncthreads();
            for (int idx = tid; idx < TB * 64; idx += NTHR) { const int i = idx >> 6, c = idx & 63; float sum = 0.f;
#pragma unroll
                for (int w = 0; w < 8; ++w) sum += opart[(i * 8 + w) * 64 + c];
                const int row = seq_row(b, dir, s0 + i);
                if (row >= orow0) O[(size_t)dir * odir_stride + (size_t)(row - orow0) * ldo + h * DV + vs * 64 + c] = sum; }
        }
        __syncthreads();
    }
}
__device__ __forceinline__ void s5_naive(Frame& F, const bf16* P, float* Y  ) {
    const KA A = ka_fresh();
    const int lane = F.lane;
    if (F.wave >= 2) return;
    for (int chain = F.vcu * 2 + F.wave; chain < NB * 32 * 2; chain += F.G * 2) {
        const int dir = chain & 1, g = (chain >> 1) & 31, b = chain >> 6;
        const float step = expf(A.I(I_LOGSTEP)[dir * 32 + g]);
        const float lr = A.I(I_LAMRE)[(dir * 32 + g) * 64 + lane], li = A.I(I_LAMIM)[(dir * 32 + g) * 64 + lane];
        const float mag = expf(lr * step), lbr = mag * cosf(li * step), lbi = mag * sinf(li * step), den = lr * lr + li * li;
        const float fr = ((lbr - 1.0f) * lr + lbi * li) / den, fi = (lbi * lr - (lbr - 1.0f) * li) / den;
        float bbr[16], bbi[16], cr[16], ci[16];
#pragma unroll
        for (int c = 0; c < 16; ++c) { const float br = A.I(I_BRE)[(g * 64 + lane) * 16 + c], bi = A.I(I_BIM)[(g * 64 + lane) * 16 + c];
            bbr[c] = fr * br - fi * bi; bbi[c] = fr * bi + fi * br;
            cr[c] = A.I(I_CRE)[((dir * 32 + g) * 16 + c) * 64 + lane]; ci[c] = A.I(I_CIM)[((dir * 32 + g) * 16 + c) * 64 + lane]; }
        float sr = 0.f, si = 0.f;
        for (int s0 = 0; s0 < CTX + SEQ; s0 += 4) {
            v4u uu[4][2];
#pragma unroll
            for (int i = 0; i < 4; ++i) { const v4u* up = (const v4u*)(P + (size_t)seq_row(b, dir, s0 + i) * N0 + C0_U + g * 16); uu[i][0] = up[0]; uu[i][1] = up[1]; }
#pragma unroll
            for (int i = 0; i < 4; ++i) {
                float u[16];
#pragma unroll
                for (int q = 0; q < 2; ++q) { u[8 * q + 0] = blo(uu[i][q].x); u[8 * q + 1] = bhi(uu[i][q].x); u[8 * q + 2] = blo(uu[i][q].y); u[8 * q + 3] = bhi(uu[i][q].y);
                    u[8 * q + 4] = blo(uu[i][q].z); u[8 * q + 5] = bhi(uu[i][q].z); u[8 * q + 6] = blo(uu[i][q].w); u[8 * q + 7] = bhi(uu[i][q].w); }
                float br = 0.f, bi = 0.f;
#pragma unroll
                for (int c = 0; c < 16; ++c) { br += bbr[c] * u[c]; bi += bbi[c] * u[c]; }
                const float nr = lbr * sr - lbi * si + br, ni = lbr * si + lbi * sr + bi; sr = nr; si = ni;
                float v[16];
#pragma unroll
                for (int c = 0; c < 16; ++c) v[c] = cr[c] * sr - ci[c] * si;
                const bool b5 = (lane & 32) != 0, b4 = (lane & 16) != 0, b3 = (lane & 8) != 0, b2 = (lane & 4) != 0;
                float w8[8], w4[4], w2[2];
#pragma unroll
                for (int k = 0; k < 8; ++k) { const float send = b5 ? v[k] : v[k + 8], keep = b5 ? v[k + 8] : v[k]; w8[k] = keep + __shfl_xor(send, 32); }
#pragma unroll
                for (int k = 0; k < 4; ++k) { const float send = b4 ? w8[k] : w8[k + 4], keep = b4 ? w8[k + 4] : w8[k]; w4[k] = keep + __shfl_xor(send, 16); }
#pragma unroll
                for (int k = 0; k < 2; ++k) { const float send = b3 ? w4[k] : w4[k + 2], keep = b3 ? w4[k + 2] : w4[k]; w2[k] = keep + __shfl_xor(send, 8); }
                float w1; { const float send = b2 ? w2[0] : w2[1], keep = b2 ? w2[1] : w2[0]; w1 = keep + __shfl_xor(send, 4); }
                w1 += __shfl_xor(w1, 2); w1 += __shfl_xor(w1, 1);
                const int c = (b5 ? 8 : 0) + (b4 ? 4 : 0) + (b3 ? 2 : 0) + (b2 ? 1 : 0);
                if ((lane & 3) == 0) Y[(size_t)dir * MALL * 512 + (size_t)seq_row(b, dir, s0 + i) * 512 + g * 16 + c] = w1;
            }
        }
    }
}
__device__ __forceinline__ void unpack8(const v4u w, float (&f)[8]) { f[0] = blo(w.x); f[1] = bhi(w.x); f[2] = blo(w.y); f[3] = bhi(w.y); f[4] = blo(w.z); f[5] = bhi(w.z); f[6] = blo(w.w); f[7] = bhi(w.w); }
__device__ __forceinline__ v4u pack8(const float (&f)[8]) { v4u w; w.x = pk2(f[0], f[1]); w.y = pk2(f[2], f[3]); w.z = pk2(f[4], f[5]); w.w = pk2(f[6], f[7]); return w; }
__device__ __forceinline__ void p_finish0(Frame& F) {
    const KA A = ka_fresh();
    const int gw = F.vcu * NWAVES + F.wave, NGW = F.G * NWAVES, lane = F.lane, e0 = lane * 8;
    const bf16* P = (const bf16*)(A.WS() + WS_PROJ);
    const float* GO = (const float*)(A.WS() + WS_OREC);
    const float* SY = GO + (size_t)2 * MALL * 512;
    bf16* MIX = (bf16*)(A.WS() + WS_MIX); bf16* YP = (bf16*)(A.WS() + WS_YPRE);
    for (int row = gw; row < MALL; row += NGW) {
        float o[8], gg[8], ng[8];
#if MK_NAIVE_GLA
        { const f32x4* a = (const f32x4*)(GO + (size_t)row * 512 + e0); const f32x4* bq = (const f32x4*)(GO + (size_t)(MALL + row) * 512 + e0);
          const f32x4 a0 = a[0] + bq[0], a1 = a[1] + bq[1]; o[0] = a0.x; o[1] = a0.y; o[2] = a0.z; o[3] = a0.w; o[4] = a1.x; o[5] = a1.y; o[6] = a1.z; o[7] = a1.w; }
#else
        { const bf16* GO16 = (const bf16*)GO; float f0[8], f1[8]; unpack8(*(const v4u*)(GO16 + (size_t)row * 512 + e0), f0); unpack8(*(const v4u*)(GO16 + (size_t)(MALL + row) * 512 + e0), f1);
#pragma unroll
          for (int j = 0; j < 8; ++j) o[j] = f0[j] + f1[j]; }
#endif
        float ss = 0.f;
#pragma unroll
        for (int j = 0; j < 8; ++j) ss += o[j] * o[j];
        ss += __shfl_xor(ss, 1); ss += __shfl_xor(ss, 2); ss += __shfl_xor(ss, 4); ss += __shfl_xor(ss, 8);
        const float r = rsqrtf(ss * (1.0f / 128.0f) + EPS);
        unpack8(*(const v4u*)(P + (size_t)row * N0 + C0_G + e0), gg);
        { const f32x4* n4 = (const f32x4*)(A.I(I_GLANG) + (e0 & 127)); const f32x4 n0 = n4[0], n1 = n4[1]; ng[0] = n0.x; ng[1] = n0.y; ng[2] = n0.z; ng[3] = n0.w; ng[4] = n1.x; ng[5] = n1.y; ng[6] = n1.z; ng[7] = n1.w; }
        float res[8];
#pragma unroll
        for (int j = 0; j < 8; ++j) res[j] = o[j] * r * ng[j] * silu_(gg[j]);
        *(GAS v4u*)(MIX + (size_t)row * 1024 + e0) = pack8(res);
#if MK_NAIVE_S5
        float u[8], y[8];
        unpack8(*(const v4u*)(P + (size_t)row * N0 + C0_U + e0), u);
        { const f32x4* a = (const f32x4*)(SY + (size_t)row * 512 + e0); const f32x4* bq = (const f32x4*)(SY + (size_t)(MALL + row) * 512 + e0);
          const f32x4 a0 = a[0] + bq[0], a1 = a[1] + bq[1]; y[0] = a0.x; y[1] = a0.y; y[2] = a0.z; y[3] = a0.w; y[4] = a1.x; y[5] = a1.y; y[6] = a1.z; y[7] = a1.w; }
#pragma unroll
        for (int j = 0; j < 8; ++j) { const float t = y[j] + A.I(I_S5D)[e0 + j] * u[j]; res[j] = 0.5f * t * (1.0f + tanhf(0.7978845608f * (t + 0.044715f * t * t * t))); }
        *(GAS v4u*)(YP + (size_t)row * 512 + e0) = pack8(res);
#endif
    }
}
__device__ __forceinline__ void p_finish1(Frame& F) {
    const KA A = ka_fresh();
    const int gw = F.vcu * NWAVES + F.wave, NGW = F.G * NWAVES, lane = F.lane;
    const bf16* P = (const bf16*)(A.WS() + WS_PROJ);
    const float* RO = (const float*)(A.WS() + WS_OREC);
    bf16* MIX = (bf16*)(A.WS() + WS_MIX);
    for (int lrow = gw; lrow < NLAT; lrow += NGW) {
#pragma unroll 1
        for (int h = 0; h < 4; ++h) { const int e0 = h * 512 + lane * 8;
            float o[8], gg[8];
#if MK_NAIVE_RET
            { const f32x4* a = (const f32x4*)(RO + (size_t)lrow * 2048 + e0); const f32x4* bq = (const f32x4*)(RO + (size_t)(NLAT + lrow) * 2048 + e0);
              const f32x4 a0 = a[0] + bq[0], a1 = a[1] + bq[1]; o[0] = a0.x; o[1] = a0.y; o[2] = a0.z; o[3] = a0.w; o[4] = a1.x; o[5] = a1.y; o[6] = a1.z; o[7] = a1.w; }
#else
            { const bf16* RO16 = (const bf16*)RO; float f0[8], f1[8]; unpack8(*(const v4u*)(RO16 + (size_t)lrow * 2048 + e0), f0); unpack8(*(const v4u*)(RO16 + (size_t)(NLAT + lrow) * 2048 + e0), f1);
#pragma unroll
              for (int j = 0; j < 8; ++j) o[j] = f0[j] + f1[j]; }
#endif
            float s = 0.f;
#pragma unroll
            for (int j = 0; j < 8; ++j) s += o[j];
            const float mu = wave_sum(s) * (1.0f / 512.0f); float q = 0.f;
#pragma unroll
            for (int j = 0; j < 8; ++j) { o[j] -= mu; q += o[j] * o[j]; }
            const float r = rsqrtf(wave_sum(q) * (1.0f / 512.0f) + EPS);
            unpack8(*(const v4u*)(P + (size_t)(NCTX + lrow) * N1 + C1_G + e0), gg);
            float res[8];
#pragma unroll
            for (int j = 0; j < 8; ++j) res[j] = o[j] * r * A.I(I_RETNG)[e0 + j] * silu_(gg[j]);
            *(GAS v4u*)(MIX + (size_t)lrow * 2048 + e0) = pack8(res); }
    }
}
__device__ __forceinline__ void p_rope(Frame& F) {
    const KA A = ka_fresh();
    const int gw = F.vcu * NWAVES + F.wave, NGW = F.G * NWAVES, lane = F.lane;
    bf16* P = (bf16*)(A.WS() + WS_PROJ);
    LAS float* ct = (LAS float*)F.lds;
    LAS float* st = ct + 4096;
    for (int i = F.tid; i < 4096; i += NTHR) { const int pos = i >> 6, fi = i & 63; float sn, cs; sincosf((float)pos * expf(-(float)fi * (9.210340371976184f / 64.0f)), &sn, &cs); ct[i] = cs; st[i] = sn; }
    __syncthreads();
    for (int lrow = gw; lrow < NLAT; lrow += NGW) {
        const int t = lrow & (SEQ - 1), pr = t >> 6, pc = t & 63;
        bf16* rp = P + (size_t)(NCTX + lrow) * N1;
        v4u a[2], b2[2]; int off[2], pos[2], f0[2];
#pragma unroll
        for (int q = 0; q < 2; ++q) { const int task = lane + 64 * q, tens = task >> 4, half = (task >> 3) & 1, ch = task & 7;
            off[q] = tens * 256 + half * 128 + ch * 8; pos[q] = half ? pc : pr; f0[q] = ch * 8;
            a[q] = *(const v4u*)(rp + off[q]); b2[q] = *(const v4u*)(rp + off[q] + 64); }
#pragma unroll
        for (int q = 0; q < 2; ++q) { float x[8], y[8], xo[8], yo[8]; unpack8(a[q], x); unpack8(b2[q], y);
            const f32x4 c0 = *(const LAS f32x4*)(ct + pos[q] * 64 + f0[q]), c1 = *(const LAS f32x4*)(ct + pos[q] * 64 + f0[q] + 4), s0 = *(const LAS f32x4*)(st + pos[q] * 64 + f0[q]), s1 = *(const LAS f32x4*)(st + pos[q] * 64 + f0[q] + 4);
#pragma unroll
            for (int j = 0; j < 8; ++j) { const float cs = j < 4 ? c0[j & 3] : c1[j & 3], sn = j < 4 ? s0[j & 3] : s1[j & 3]; xo[j] = x[j] * cs - y[j] * sn; yo[j] = x[j] * sn + y[j] * cs; }
            *(GAS v4u*)(rp + off[q]) = pack8(xo); *(GAS v4u*)(rp + off[q] + 64) = pack8(yo); }
    }
}
__device__ __forceinline__ void p_router(Frame& F, int layer) {
    const KA A = ka_fresh();
    const int tid = F.tid, lane = F.lane, wave = F.wave;
    const int moe_row0 = layer ? NCTX : 0, NTOK = layer ? NLAT : MALL;
    const int RPB = (NTOK + F.G - 1) / F.G;
    unsigned char* ws = A.WS();
    int* prow = (int*)(ws + WS_PROW); int* sel_e = (int*)(ws + WS_SELE); float* w_slot = (float*)(ws + WS_WSLOT); int* slot_pos = (int*)(ws + WS_SPOS);
    LAS float* Wt = (LAS float*)F.lds;
    LAS int* lcnt = (LAS int*)(F.lds + L_LCNT); LAS int* gbase = (LAS int*)(F.lds + L_GBASE);
    LAS int* blk_e = (LAS int*)(F.lds + L_BLKE); LAS int* blk_p = (LAS int*)(F.lds + L_BLKP);
    const float* wr = A.I(I_WROUTER) + (size_t)layer * 1024 * 32;
    for (int idx = tid; idx < 32768; idx += NTHR) Wt[(idx & 31) * 1024 + (idx >> 5)] = wr[idx];
    if (tid < 32) lcnt[tid] = 0;
    __syncthreads();
    const float* mod = (const float*)(ws + WS_MOD) + (size_t)layer * 9 * 6144;
    const float* XR = (const float*)(ws + WS_XRES); bf16* H = (bf16*)(ws + WS_H);
    const int tok0 = F.vcu * RPB;
    for (int lr = wave; lr < RPB; lr += NWAVES) {
        const int tok = tok0 + lr; if (tok >= NTOK) break;
        const int row = moe_row0 + tok;
        f32x4 v[4], h[4];
#pragma unroll
        for (int j = 0; j < 4; ++j) v[j] = ((const f32x4*)(XR + (size_t)row * 1024))[64 * j + lane];
        const float* m = mod + bidx_of_row(row) * 6144;
        modnorm_store(v, A.I(I_N2G) + layer * 1024, m + 4096, m + 3072, H + (size_t)row * 1024, lane, h);
        float pa[32];
#pragma unroll
        for (int e = 0; e < 32; ++e) { float a = 0.f;
#pragma unroll
            for (int j = 0; j < 4; ++j) { const f32x4 w4 = *(const LAS f32x4*)(Wt + e * 1024 + 4 * (64 * j + lane)); a += (h[j].x * w4.x + h[j].y * w4.y) + (h[j].z * w4.z + h[j].w * w4.w); }
            pa[e] = a; }
        float myl;
        { const bool b5 = (lane & 32) != 0, b4 = (lane & 16) != 0, b3 = (lane & 8) != 0, b2 = (lane & 4) != 0, b1 = (lane & 2) != 0;
          float w16[16], w8[8], w4[4], w2[2];
#pragma unroll
          for (int k = 0; k < 16; ++k) { const float send = b5 ? pa[k] : pa[k + 16], keep = b5 ? pa[k + 16] : pa[k]; w16[k] = keep + __shfl_xor(send, 32); }
#pragma unroll
          for (int k = 0; k < 8; ++k) { const float send = b4 ? w16[k] : w16[k + 8], keep = b4 ? w16[k + 8] : w16[k]; w8[k] = keep + __shfl_xor(send, 16); }
#pragma unroll
          for (int k = 0; k < 4; ++k) { const float send = b3 ? w8[k] : w8[k + 4], keep = b3 ? w8[k + 4] : w8[k]; w4[k] = keep + __shfl_xor(send, 8); }
#pragma unroll
          for (int k = 0; k < 2; ++k) { const float send = b2 ? w4[k] : w4[k + 2], keep = b2 ? w4[k + 2] : w4[k]; w2[k] = keep + __shfl_xor(send, 4); }
          { const float send = b1 ? w2[0] : w2[1], keep = b1 ? w2[1] : w2[0]; myl = keep + __shfl_xor(send, 2); }
          myl += __shfl_xor(myl, 1); }
        const int mye = lane >> 1;
        myl += A.I(I_BROUTER)[layer * 32 + mye];
        float bv[4]; int bi[4];
#pragma unroll
        for (int r = 0; r < 4; ++r) { float v = myl; int id = mye;
#pragma unroll
            for (int o = 1; o < 64; o <<= 1) { const float ov = __shfl_xor(v, o); const int oi = __shfl_xor(id, o); const bool take = ov > v || (ov == v && oi < id); v = take ? ov : v; id = take ? oi : id; }
            bv[r] = v; bi[r] = id; myl = (mye == id) ? -INFINITY : myl; }
        const float e1 = __expf(bv[1] - bv[0]), e2 = __expf(bv[2] - bv[0]), e3 = __expf(bv[3] - bv[0]), inv = 1.0f / (1.0f + e1 + e2 + e3);
        if (lane < 4) { const int ee = lane == 0 ? bi[0] : (lane == 1 ? bi[1] : (lane == 2 ? bi[2] : bi[3]));
            const float wv = (lane == 0 ? 1.0f : (lane == 1 ? e1 : (lane == 2 ? e2 : e3))) * inv;
            sel_e[tok * 4 + lane] = ee; w_slot[tok * 4 + lane] = wv;
            const int lp = __hip_atomic_fetch_add(lcnt + ee, 1, __ATOMIC_RELAXED, __HIP_MEMORY_SCOPE_WORKGROUP);
            blk_e[lr * 4 + lane] = ee; blk_p[lr * 4 + lane] = lp; }
    }
    __syncthreads();
    if (tid < 32) gbase[tid] = (int)__hip_atomic_fetch_add(F.ctl + CW_GCNT + 64 * layer + tid, (unsigned)lcnt[tid], RLX_AGENT);
    __syncthreads();
    int* elist = (int*)(ws + WS_ELIST);
    for (int idx = tid; idx < RPB * 4; idx += NTHR) { const int tok = tok0 + (idx >> 2); if (tok < NTOK) { const int e = blk_e[idx]; elist[(size_t)e * MALL + gbase[e] + blk_p[idx]] = tok * 4 + (idx & 3); } }
}
__device__ __forceinline__ int moe_tables(Frame& F, int layer) {
    LAS int* ts = (LAS int*)(F.lds + L_TSTART); LAS unsigned char* te = (LAS unsigned char*)(F.lds + L_TILEE);
    __syncthreads();
    if (F.tid == 0) { int acc = 0;
        for (int e = 0; e < 32; ++e) { ts[e] = acc; acc += ((int)__hip_atomic_load(F.ctl + CW_GCNT + 64 * layer + e, RLX_AGENT) + 255) >> 8; }
        ts[32] = acc > MAXTILES ? MAXTILES : acc; }
    __syncthreads();
    const int nt = ts[32];
    LAS int* tpos = (LAS int*)(F.lds + L_TPOS); LAS int* tcnt = (LAS int*)(F.lds + L_TCNT);
    for (int T = F.tid; T < nt; T += NTHR) { int e = 0;
        for (int q = 1; q < 32; ++q) e = (T >= ts[q]) ? q : e;
        te[T] = (unsigned char)e; tpos[T] = (T - ts[e]) * 256; tcnt[T] = (int)__hip_atomic_load(F.ctl + CW_GCNT + 64 * layer + e, RLX_AGENT); }
    __syncthreads();
    return nt;
}
__device__ __forceinline__ void p_combine(Frame& F, int layer, bool dry) {
    const KA A = ka_fresh();
    const int gw = F.vcu * NWAVES + F.wave, NGW = F.G * NWAVES, lane = F.lane;
    const int moe_row0 = layer ? NCTX : 0, NTOK = layer ? NLAT : MALL;
    unsigned char* ws = A.WS();
    const float* XR = (const float*)(ws + WS_XRES); float* XW = dry ? (float*)(ws + WS_PROJ) : (float*)(ws + WS_XRES); bf16* H = dry ? (bf16*)(ws + WS_PROJ + 160 * MiB) : (bf16*)(ws + WS_H); const bf16* YS = (const bf16*)(ws + WS_YSLOT);
    float* OUTP = dry ? (float*)(ws + WS_PROJ) : A.OUT();
    const float* mod = (const float*)(ws + WS_MOD);
    float palpha = 1.0f;
#if defined(MK_PROBE) && MK_PROBE >= 0
    {
      const unsigned* st = F.ctl + 20000 + 2 * MK_PROBE;
      const unsigned long long t0 = ((unsigned long long)__hip_atomic_load(st + 1, RLX_AGENT) << 32) | __hip_atomic_load(st, RLX_AGENT), t1 = ((unsigned long long)__hip_atomic_load(st + 3, RLX_AGENT) << 32) | __hip_atomic_load(st + 2, RLX_AGENT);
      palpha = 1.0f + exp2f((float)(t1 - t0) * 0.01f * 0.01f * 3.321928095f); }
#endif
    for (int tok = gw; tok < NTOK; tok += NGW) {
        const int row = moe_row0 + tok, bidx = bidx_of_row(row);
        const float* g2 = mod + (size_t)layer * 9 * 6144 + bidx * 6144 + 5120;
        f32x4 v[4];
#pragma unroll
        for (int j = 0; j < 4; ++j) { const int o = 64 * j + lane; f32x4 y = (f32x4){0.f, 0.f, 0.f, 0.f};
#pragma unroll
            for (int k = 0; k < 4; ++k) { const v2u w = ((const v2u*)(YS + (size_t)(tok * 4 + k) * 1024))[o]; y += (f32x4){blo(w.x), bhi(w.x), blo(w.y), bhi(w.y)}; }
            v[j] = ((const f32x4*)(XR + (size_t)row * 1024))[o] + ((const f32x4*)g2)[o] * y; }
        if (layer == 0) {
#pragma unroll
            for (int j = 0; j < 4; ++j) ((f32x4*)(XW + (size_t)row * 1024))[64 * j + lane] = v[j];
            const float* m1 = mod + (size_t)9 * 6144 + bidx * 6144; f32x4 h[4];
            modnorm_store(v, A.I(I_N1G) + 1024, m1 + 1024, m1, H + (size_t)row * 1024, lane, h);
        } else {
            float ss = 0.f;
#pragma unroll
            for (int j = 0; j < 4; ++j) ss += (v[j].x * v[j].x + v[j].y * v[j].y) + (v[j].z * v[j].z + v[j].w * v[j].w);
            const float r = rsqrtf(wave_sum(ss) * (1.0f / 1024.0f) + EPS);
#pragma unroll
            for (int j = 0; j < 4; ++j) { const int o = 64 * j + lane; ((f32x4*)(OUTP + (size_t)tok * 1024))[o] = v[j] * (r * palpha) * ((const f32x4*)A.I(I_FNG))[o]; }
        }
    }
}
typedef short s16x4 __attribute__((ext_vector_type(4)));
typedef short bfx8 __attribute__((ext_vector_type(8)));
typedef short v4i16_t __attribute__((ext_vector_type(4)));
#define MFMA16(a, b, c) __builtin_amdgcn_mfma_f32_16x16x32_bf16((a), (b), (c), 0, 0, 0)
__device__ __forceinline__ bfx8 frag_n(const LAS unsigned char* tile, int stride, int r0, int k0, int lane) {
    return *(const LAS bfx8*)(tile + (r0 + (lane & 15)) * stride + (k0 + 8 * (lane >> 4)) * 2);
}
__device__ __forceinline__ bfx8 frag_t(const LAS unsigned char* tile, int stride, int k0, int n0, int lane) {
    const int g = lane >> 4, q = (lane & 15) >> 2, p = lane & 3;
    const LAS unsigned char* a = tile + (k0 + 8 * g + q) * stride + (n0 + 4 * p) * 2;
    const s16x4 lo = __builtin_bit_cast(s16x4, __builtin_amdgcn_ds_read_tr16_b64_v4i16((LAS v4i16_t*)a));
    const s16x4 hi = __builtin_bit_cast(s16x4, __builtin_amdgcn_ds_read_tr16_b64_v4i16((LAS v4i16_t*)(a + 4 * stride)));
    return __builtin_shufflevector(lo, hi, 0, 1, 2, 3, 4, 5, 6, 7);
}
__device__ __forceinline__ v4u scale8(const v4u w, float s) { float f[8]; unpack8(w, f);
#pragma unroll
    for (int j = 0; j < 8; ++j) f[j] *= s;
    return pack8(f); }

template <int DK, int DVS, bool GLA, bool INTRA = true>
__device__ __forceinline__ void rec_mfma(Frame& F, const bf16* Qsrc, const bf16* Ksrc, const bf16* K2src, size_t qdir_stride, int ldq, int qcol, int kcol,
                                         const bf16* Vsrc, int ldv, int vcol, int DV, const float* EB,
                                         bf16* O, size_t odir_stride, int ldo, int orow0) {
    const KA A = ka_fresh();
    constexpr int SQ = DK * 2 + 16, SV = DVS * 2 + 16, SP = 144, SS = DK * 2 + 16;
    constexpr int O_QD = 0, O_KI = O_QD + 64 * SQ, O_KS = O_KI + 64 * SQ, O_V = O_KS + (GLA ? 64 * SQ : 0), O_VD = O_V + 64 * SV, O_P = O_VD + (GLA ? 0 : 64 * SV), O_ST = O_P + 64 * SP, O_EB = O_ST + DVS * SS;
    static_assert(O_EB + DK * 4 <= RING_BYTES, "rec_mfma LDS");
    constexpr int NVS = 0;  (void)NVS;
    constexpr int VT_PER = DVS / 32, KT_PER = DK / 64, QCH = DK / 8  , QN = (64 * QCH) / NTHR, VCH = DVS / 8, KSTEPS = DK / 32;
    static_assert(QN >= 1 && VT_PER >= 1 && KT_PER >= 1, "shape");
    const LAS unsigned char* L = F.lds;
    const int tid = F.tid, lane = F.lane, w = F.wave, it = w & 3, vg = w >> 2, kg = w & 3, g4 = lane >> 4, l15 = lane & 15;
    const int nvs = DV / DVS, nitems = NB * 4 * 2 * nvs;
    for (int item = F.vcu; item < nitems; item += F.G) {
        const int vs = item % nvs, dir = (item / nvs) & 1, h = (item / (2 * nvs)) & 3, b = item / (8 * nvs);
        float lg2 = 0.f;
        if (!GLA) { const float lgt = A.I(I_RETDEC)[dir * 4 + h]; lg2 = -log2f(1.0f + expf(-lgt)); }
        const bf16* qb = Qsrc + (GLA ? (size_t)dir * qdir_stride : 0) + qcol + h * DK;
        const bf16* kb = Ksrc + (GLA ? (size_t)dir * qdir_stride : 0) + kcol + h * DK;
        const bf16* k2b = GLA ? K2src + (size_t)dir * qdir_stride + kcol + h * DK : kb;
        const bf16* vb = Vsrc + vcol + h * DV + vs * DVS;
        f32x4 Sacc[VT_PER][KT_PER];
#pragma unroll
        for (int a = 0; a < VT_PER; ++a)
#pragma unroll
            for (int c2 = 0; c2 < KT_PER; ++c2) Sacc[a][c2] = (f32x4){0.f, 0.f, 0.f, 0.f};
        for (int i = tid; i < DVS * SS / 4; i += NTHR) ((LAS unsigned*)(F.lds + O_ST))[i] = 0u;
        v4u rq[QN], rk[QN], rk2[GLA ? QN : 1], rv; float peb = 0.f;
        rv = (v4u){0u, 0u, 0u, 0u};
#define REC_LOAD(c) do { \
            const int rowc_ = seq_row(b, dir, 64 * (c));                   \
            _Pragma("unroll") for (int n = 0; n < QN; ++n) { const int pi = tid + NTHR * n, r = pi / QCH, ch = pi % QCH; const size_t ro = (size_t)(rowc_ + (dir ? -r : r)) * ldq + ch * 8; \
                rq[n] = *(const v4u*)(qb + ro); rk[n] = *(const v4u*)(kb + ro); if (GLA) rk2[n] = *(const v4u*)(k2b + ro); } \
            if (tid < 64 * VCH) { const int r = tid / VCH, ch = tid % VCH; rv = *(const v4u*)(vb + (size_t)(rowc_ + (dir ? -r : r)) * ldv + ch * 8); } \
            if (GLA && tid < DK) peb = EB[(((size_t)dir * NB + b) * 68 + (c)) * (4 * DK) + h * DK + tid]; } while (0)
        REC_LOAD(0);
        for (int c = 0; c < 68; ++c) {
#pragma unroll
            for (int n = 0; n < QN; ++n) { const int pi = tid + NTHR * n, r = pi / QCH, ch = pi % QCH;
                *(LAS v4u*)(F.lds + O_QD + r * SQ + ch * 16) = rq[n]; *(LAS v4u*)(F.lds + O_KI + r * SQ + ch * 16) = rk[n];
                if (GLA) *(LAS v4u*)(F.lds + O_KS + r * SQ + ch * 16) = rk2[n]; }
            if (tid < 64 * VCH) { const int r = tid / VCH, ch = tid % VCH;
                if (INTRA) *(LAS v4u*)(F.lds + O_V + r * SV + ch * 16) = rv;
                if (!GLA) *(LAS v4u*)(F.lds + O_VD + r * SV + ch * 16) = scale8(rv, __builtin_amdgcn_exp2f(lg2 * (float)(63 - r))); }
            if (GLA && tid < DK) ((LAS float*)(F.lds + O_EB))[tid] = peb;
            if (c + 1 < 68) REC_LOAD(c + 1);
            __syncthreads();
            if constexpr (INTRA) {
#pragma unroll
            for (int q2 = 0; q2 < 2; ++q2) { const int jt = 2 * vg + q2; f32x4 acc = (f32x4){0.f, 0.f, 0.f, 0.f};
                if (jt <= it) {
#pragma unroll
                    for (int ks = 0; ks < KSTEPS; ++ks) acc = MFMA16(frag_n(L + O_KI, SQ, 16 * jt, 32 * ks, lane), frag_n(L + O_QD, SQ, 16 * it, 32 * ks, lane), acc);
                    const int i = 16 * it + l15;
#pragma unroll
                    for (int r = 0; r < 4; ++r) { const int j = 16 * jt + 4 * g4 + r; float vv = (j <= i) ? acc[r] : 0.f; if (!GLA) vv *= __builtin_amdgcn_exp2f(lg2 * (float)(i - j)); acc[r] = vv; }
                }
                v2u pw; pw.x = pk2(acc[0], acc[1]); pw.y = pk2(acc[2], acc[3]);
                *(LAS v2u*)(F.lds + O_P + (16 * it + l15) * SP + (16 * jt + 4 * g4) * 2) = pw; }
            }
            f32x4 oacc[VT_PER];
            const bool need_o = INTRA || orow0 == 0 || c >= 4;
#pragma unroll
            for (int a = 0; a < VT_PER; ++a) { oacc[a] = (f32x4){0.f, 0.f, 0.f, 0.f};
                if (need_o)
#pragma unroll
                for (int ks = 0; ks < KSTEPS; ++ks) oacc[a] = MFMA16(frag_n(L + O_ST, SS, 16 * (vg * VT_PER + a), 32 * ks, lane), frag_n(L + O_QD, SQ, 16 * it, 32 * ks, lane), oacc[a]);
                if (!GLA) oacc[a] *= __builtin_amdgcn_exp2f(lg2 * (float)(16 * it + l15 + 1)); }
            if constexpr (INTRA) __syncthreads();
            { const int row = seq_row(b, dir, 64 * c + 16 * it + l15);
#pragma unroll
              for (int a = 0; a < VT_PER; ++a) { const int vt = vg * VT_PER + a;
                if constexpr (INTRA) {
#pragma unroll
                for (int js = 0; js < 2; ++js) oacc[a] = MFMA16(frag_t(L + O_V, SV, 32 * js, 16 * vt, lane), frag_n(L + O_P, SP, 16 * it, 32 * js, lane), oacc[a]); }
                if (row >= orow0) { v2u ow; ow.x = pk2(oacc[a][0], oacc[a][1]); ow.y = pk2(oacc[a][2], oacc[a][3]);
                    *(GAS v2u*)(O + (size_t)dir * odir_stride + (size_t)(row - orow0) * ldo + h * DV + vs * DVS + 16 * vt + 4 * g4) = ow; } } }
            { bfx8 fv[VT_PER][2];
#pragma unroll
              for (int a = 0; a < VT_PER; ++a)
#pragma unroll
                for (int js = 0; js < 2; ++js) fv[a][js] = frag_t(L + (GLA ? O_V : O_VD), SV, 32 * js, 16 * (vg * VT_PER + a), lane);
              const float g64 = GLA ? 1.0f : __builtin_amdgcn_exp2f(lg2 * 64.0f);
#pragma unroll
              for (int c2 = 0; c2 < KT_PER; ++c2) { const int kt = kg * KT_PER + c2;
                const bfx8 fk0 = frag_t(L + (GLA ? O_KS : O_KI), SQ, 0, 16 * kt, lane), fk1 = frag_t(L + (GLA ? O_KS : O_KI), SQ, 32, 16 * kt, lane);
                f32x4 sc4 = (f32x4){g64, g64, g64, g64};
                if (GLA) sc4 = *(const LAS f32x4*)(L + O_EB + (16 * kt + 4 * g4) * 4);
#pragma unroll
                for (int a = 0; a < VT_PER; ++a) { f32x4 s = Sacc[a][c2] * sc4;
                    s = MFMA16(fk0, fv[a][0], s); s = MFMA16(fk1, fv[a][1], s); Sacc[a][c2] = s;
                    if constexpr (INTRA) { v2u sw; sw.x = pk2(s[0], s[1]); sw.y = pk2(s[2], s[3]);
                        *(LAS v2u*)(F.lds + O_ST + (16 * (vg * VT_PER + a) + l15) * SS + (16 * kt + 4 * g4) * 2) = sw; } } } }
            __syncthreads();
            if constexpr (!INTRA) {
#pragma unroll
              for (int c2 = 0; c2 < KT_PER; ++c2)
#pragma unroll
                for (int a = 0; a < VT_PER; ++a) { const f32x4 s = Sacc[a][c2]; v2u sw; sw.x = pk2(s[0], s[1]); sw.y = pk2(s[2], s[3]);
                    *(LAS v2u*)(F.lds + O_ST + (16 * (vg * VT_PER + a) + l15) * SS + (16 * (kg * KT_PER + c2) + 4 * g4) * 2) = sw; } }
        }
#undef REC_LOAD
    }
}
__device__ __forceinline__ void p_gla_prep(Frame& F, const bf16* P, bf16* QD, bf16* KI, bf16* KS, float* EB) {
    const KA A = ka_fresh();
    const int tid = F.tid;
    LAS float* lb = (LAS float*)F.lds;
    LAS float* wal = (LAS float*)(F.lds + 66560);
    LAS float* tot = (LAS float*)(F.lds + 66560 + 17408);
    constexpr int LBS = 260;
    int cur_dir = -1;
    for (int item = F.vcu; item < 2 * NB * 68; item += F.G) {
        const int c = item % 68, b = (item / 68) % NB, dir = item / (68 * NB);
        if (dir != cur_dir) { __syncthreads();
            for (int i = tid; i < 16 * 256; i += NTHR) wal[i] = A.I(I_GLAWA)[dir * 4096 + i];
            if (tid < 256) wal[4096 + tid] = A.I(I_GLABA)[dir * 256 + tid];
            cur_dir = dir; __syncthreads(); }
        const int t = tid >> 3, cg = tid & 7, row = seq_row(b, dir, 64 * c + t);
        {
            float lw[16]; { float f0[8], f1[8]; unpack8(*(const v4u*)(P + (size_t)row * N0 + C0_LOW + dir * 16), f0); unpack8(*(const v4u*)(P + (size_t)row * N0 + C0_LOW + dir * 16 + 8), f1);
#pragma unroll
                for (int j = 0; j < 8; ++j) { lw[j] = f0[j]; lw[8 + j] = f1[j]; } }
#pragma unroll
            for (int q = 0; q < 8; ++q) { const int col = cg * 32 + q * 4;
                f32x4 z = *(const LAS f32x4*)(wal + 4096 + col);
#pragma unroll
                for (int r = 0; r < 16; ++r) z += *(const LAS f32x4*)(wal + r * 256 + col) * lw[r];
                f32x4 o;
#pragma unroll
                for (int j = 0; j < 4; ++j) o[j] = (fminf(z[j], 0.f) - __logf(1.0f + __expf(-fabsf(z[j])))) * (1.0f / 16.0f);
                *(LAS f32x4*)(lb + t * LBS + col) = o; }
        }
        __syncthreads();
        {
            const int col = tid & 255, half = tid >> 8; float run = 0.f;
#pragma unroll 8
            for (int i = 0; i < 32; ++i) { run += lb[(32 * half + i) * LBS + col]; lb[(32 * half + i) * LBS + col] = run; }
            if (half == 0) tot[col] = run;
            __syncthreads();
            if (half == 1) { const float off = tot[col];
#pragma unroll 8
                for (int i = 32; i < 64; ++i) lb[i * LBS + col] += off; }
        }
        __syncthreads();
        {
#pragma unroll
            for (int q = 0; q < 4; ++q) { const int col = cg * 32 + q * 8;
                float qf[8], kf[8], o1[8], o2[8], o3[8];
                unpack8(*(const v4u*)(P + (size_t)row * N0 + C0_Q + col), qf); unpack8(*(const v4u*)(P + (size_t)row * N0 + C0_K + col), kf);
#pragma unroll
                for (int j = 0; j < 8; ++j) { const float bt = lb[t * LBS + col + j], bl = lb[63 * LBS + col + j]; const float eb = __expf(bt);
                    o1[j] = qf[j] * eb; o2[j] = kf[j] * __expf(-bt); o3[j] = kf[j] * __expf(bl - bt); }
                const size_t o = ((size_t)dir * MALL + row) * 256 + col;
                *(GAS v4u*)(QD + o) = pack8(o1); *(GAS v4u*)(KI + o) = pack8(o2); *(GAS v4u*)(KS + o) = pack8(o3); }
            if (tid < 256) EB[(((size_t)dir * NB + b) * 68 + c) * 256 + tid] = __expf(lb[63 * LBS + tid]);
        }
        __syncthreads();
    }
}
__device__ __forceinline__ void p_ret_intra_finish(Frame& F) {
    const KA A = ka_fresh();
    constexpr int SQ = 528, SP = 144, SV = 1040, O_Q = 0, O_K = 33792, O_V = 0, O_P = 67584, O_RED = O_P + 64 * SP;
    static_assert(64 * SV <= O_P && O_RED + 2 * 64 * 8 <= RING_BYTES, "LDS map");
    unsigned char* ws = A.WS();
    const bf16* P = (const bf16*)(ws + WS_PROJ); const bf16* RO = (const bf16*)(ws + WS_OREC); bf16* MIX = (bf16*)(ws + WS_MIX);
    const LAS unsigned char* L = F.lds;
    const int tid = F.tid, lane = F.lane, w = F.wave, it = w & 3, vg = w >> 2, g4 = lane >> 4, l15 = lane & 15;
    v4u rq[4], rk[4];
#define RIF_LOADQK(u_) do { const int h_ = (u_) & 3, n_ = ((u_) >> 2) & 63, b_ = (u_) >> 8; const size_t p0_ = (size_t)(NCTX + b_ * SEQ + 64 * n_) * N1; \
        _Pragma("unroll") for (int q = 0; q < 4; ++q) { const int pi = tid + NTHR * q, r = pi >> 5, ch = pi & 31; const size_t ro = p0_ + (size_t)r * N1 + h_ * 256 + ch * 8; rq[q] = *(const v4u*)(P + ro + C1_Q); rk[q] = *(const v4u*)(P + ro + C1_K); } } while (0)
    if (F.vcu < NB * 64 * 4) RIF_LOADQK(F.vcu);
    for (int unit = F.vcu; unit < NB * 64 * 4; unit += F.G) {
        const int h = unit & 3, n = (unit >> 2) & 63, b = unit >> 8;
        const int lrow0 = b * SEQ + 64 * n; const size_t prow0 = (size_t)(NCTX + lrow0) * N1;
        const float lgf = -log2f(1.0f + expf(-A.I(I_RETDEC)[h])), lgb = -log2f(1.0f + expf(-A.I(I_RETDEC)[4 + h]));
#pragma unroll
        for (int q = 0; q < 4; ++q) { const int pi = tid + NTHR * q, r = pi >> 5, ch = pi & 31; *(LAS v4u*)(F.lds + O_Q + r * SQ + ch * 16) = rq[q]; *(LAS v4u*)(F.lds + O_K + r * SQ + ch * 16) = rk[q]; }
        v4u rv[8];
#pragma unroll
        for (int q = 0; q < 8; ++q) { const int pi = tid + NTHR * q, r = pi >> 6, ch = pi & 63; rv[q] = *(const v4u*)(P + prow0 + (size_t)r * N1 + C1_V + h * 512 + ch * 8); }
        __syncthreads();
#pragma unroll
        for (int q2 = 0; q2 < 2; ++q2) { const int jt = 2 * vg + q2; f32x4 acc = (f32x4){0.f, 0.f, 0.f, 0.f};
#pragma unroll
            for (int ks = 0; ks < 8; ++ks) acc = MFMA16(frag_n(L + O_K, SQ, 16 * jt, 32 * ks, lane), frag_n(L + O_Q, SQ, 16 * it, 32 * ks, lane), acc);
            const int i = 16 * it + l15;
#pragma unroll
            for (int r = 0; r < 4; ++r) { const int j = 16 * jt + 4 * g4 + r; const float m = (j <= i ? exp2f(lgf * (float)(i - j)) : 0.f) + (j >= i ? exp2f(lgb * (float)(j - i)) : 0.f); acc[r] *= m; }
            v2u pw; pw.x = pk2(acc[0], acc[1]); pw.y = pk2(acc[2], acc[3]);
            *(LAS v2u*)(F.lds + O_P + (16 * it + l15) * SP + (16 * jt + 4 * g4) * 2) = pw; }
        __syncthreads();
        if (unit + F.G < NB * 64 * 4) RIF_LOADQK(unit + F.G);
#pragma unroll
        for (int q = 0; q < 8; ++q) { const int pi = tid + NTHR * q, r = pi >> 6, ch = pi & 63; *(LAS v4u*)(F.lds + O_V + r * SV + ch * 16) = rv[q]; }
        const int lrow = lrow0 + 16 * it + l15;
        v2u oi[2][16];
#pragma unroll
        for (int d = 0; d < 2; ++d)
#pragma unroll
            for (int a = 0; a < 16; ++a) oi[d][a] = *(const v2u*)(RO + ((size_t)d * NLAT + lrow) * 2048 + h * 512 + 16 * (16 * vg + a) + 4 * g4);
        __syncthreads();
        f32x4 oacc[16];
#pragma unroll
        for (int a = 0; a < 16; ++a) oacc[a] = (f32x4){0.f, 0.f, 0.f, 0.f};
#pragma unroll
        for (int js = 0; js < 2; ++js) { const bfx8 pf = frag_n(L + O_P, SP, 16 * it, 32 * js, lane);
#pragma unroll
            for (int a = 0; a < 16; ++a) oacc[a] = MFMA16(frag_t(L + O_V, SV, 32 * js, 16 * (16 * vg + a), lane), pf, oacc[a]); }
        float s1 = 0.f, s2 = 0.f;
#pragma unroll
        for (int a = 0; a < 16; ++a) { oacc[a] += (f32x4){blo(oi[0][a].x) + blo(oi[1][a].x), bhi(oi[0][a].x) + bhi(oi[1][a].x), blo(oi[0][a].y) + blo(oi[1][a].y), bhi(oi[0][a].y) + bhi(oi[1][a].y)};
#pragma unroll
            for (int r = 0; r < 4; ++r) { s1 += oacc[a][r]; s2 += oacc[a][r] * oacc[a][r]; } }
        s1 += __shfl_xor(s1, 16); s2 += __shfl_xor(s2, 16); s1 += __shfl_xor(s1, 32); s2 += __shfl_xor(s2, 32);
        LAS float* red = (LAS float*)(F.lds + O_RED);
        if (g4 == 0) { red[(vg * 64 + 16 * it + l15) * 2] = s1; red[(vg * 64 + 16 * it + l15) * 2 + 1] = s2; }
        __syncthreads();
        { const float t1 = red[(16 * it + l15) * 2] + red[(64 + 16 * it + l15) * 2], t2 = red[(16 * it + l15) * 2 + 1] + red[(64 + 16 * it + l15) * 2 + 1];
          const float mu = t1 * (1.0f / 512.0f), var = fmaxf(t2 * (1.0f / 512.0f) - mu * mu, 0.f), rstd = rsqrtf(var + EPS);
          const bf16* gp = P + (size_t)(NCTX + lrow) * N1 + C1_G + h * 512; const float* ngp = A.I(I_RETNG) + h * 512; bf16* op = MIX + (size_t)lrow * 2048 + h * 512;
#pragma unroll
          for (int a = 0; a < 16; ++a) { const int v0 = 16 * (16 * vg + a) + 4 * g4; const v2u gw = *(const v2u*)(gp + v0); const f32x4 ng = *(const f32x4*)(ngp + v0);
              const float r0 = (oacc[a][0] - mu) * rstd * ng[0] * silu_(blo(gw.x)), r1 = (oacc[a][1] - mu) * rstd * ng[1] * silu_(bhi(gw.x)), r2 = (oacc[a][2] - mu) * rstd * ng[2] * silu_(blo(gw.y)), r3 = (oacc[a][3] - mu) * rstd * ng[3] * silu_(bhi(gw.y));
              v2u ow; ow.x = pk2(r0, r1); ow.y = pk2(r2, r3); *(GAS v2u*)(op + v0) = ow; } }
        __syncthreads();
    }
}
#undef RIF_LOADQK
#ifndef MK_ONLY
#define MK_ONLY -1
#endif
#define SON(s) (MK_ONLY < 0 || MK_ONLY == (s))
#define IN(k) (lo <= (k) && (k) < hi)
#ifndef MK_PROBE
#define MK_PROBE -1
#endif
#ifndef MK_REP
#define MK_REP -1
#endif
#define REPS(s) for (int _rep = 0; _rep < ((MK_REP == (s)) ? 2 : 1); ++_rep)
#define STAMP(k) do { if (MK_PROBE >= 0 && blockIdx.x == 0 && F.tid == 0) { const unsigned long long _t = wall_clock64(); __hip_atomic_store(F.ctl + 20000 + 2 * (k), (unsigned)_t, RLX_AGENT); __hip_atomic_store(F.ctl + 20001 + 2 * (k), (unsigned)(_t >> 32), RLX_AGENT); } } while (0)
#define SEAM(k) do { if (IN(k) && IN((k) + 1)) { xcd_barrier(bar); STAMP((k) + 1); } } while (0)
template <int layer>
__device__ __forceinline__ void layer_body(Frame& F, const int lo, const int hi, const XcdBarrier& bar) {
    unsigned char* const ws = ka_fresh().WS();
    bf16* const H = (bf16*)(ws + WS_H);
    bf16* const PROJ = (bf16*)(ws + WS_PROJ);
    float* const XRES = (float*)(ws + WS_XRES);
    float* const MOD = (float*)(ws + WS_MOD);

        const int pb = layer ? PH_INPROJ1 : PH_INPROJ0;
        if (SON(2) && IN(pb)) {
            pg8::Gemm g{H, (const bf16*)(ws + (layer ? WS_WIN1T : WS_WIN0T)), MALL, layer ? N1 : N0, 1024, 1024};
            pg8::StaticOrder S; S.init(g.M, g.N, F.G, (int)blockIdx.x);
            if constexpr (layer == 0 && !MK_NAIVE_S5) { pg8::EpiStoreU E{PROJ, g.N, (bf16*)(ws + WS_A2)};
                pg8::gemm_phase<pg8::EpiStoreU, pg8::StaticOrder, true, true>(F.lds, g, S, E); }
            else { pg8::EpiStore E{PROJ, g.N};
                pg8::gemm_phase<pg8::EpiStore, pg8::StaticOrder, true, true>(F.lds, g, S, E); }
        }
        SEAM(pb);
        if (layer == 0) {
#if MK_NAIVE_GLA
            SEAM(PH_GLAPREP);
            if (SON(3) && IN(PH_GLA)) rec_naive<64, true>(F, PROJ, N0, C0_Q, C0_K, C0_V, 128, 2, (float*)(ws + WS_OREC), (size_t)MALL * 512, 512, 0);
#else
            bf16* const GQD = (bf16*)(ws + WS_OREC + 280 * MiB); bf16* const GKI = GQD + (size_t)2 * MALL * 256; bf16* const GKS = GKI + (size_t)2 * MALL * 256; float* const GEB = (float*)(ws + WS_OREC + 384 * MiB);
            if (SON(13) && IN(PH_GLAPREP)) REPS(13) p_gla_prep(F, PROJ, GQD, GKI, GKS, GEB);
#if !MK_NAIVE_S5
            if (SON(17) && IN(PH_GLAPREP)) {
                __syncthreads();
                pg8::Gemm g{(const bf16*)(ws + WS_A2), (const bf16*)(ws + WS_S5W1), 32 * S5_ROWS, 256, 256, 512};
                pg8::GroupOrder S{9, 288, F.G, F.vcu};
                pg8::EpiF32Plain E{(float*)(ws + WS_SLOC)};
                pg8::gemm_phase<pg8::EpiF32Plain, pg8::GroupOrder, true, true>(F.lds, g, S, E);
            }
#endif
            SEAM(PH_GLAPREP);
#if !MK_NAIVE_S5
            if (SON(18) && IN(PH_GLA)) { p_s5_scan(F, (const float*)(ws + WS_SLOC), (bf16*)(ws + WS_A2)); __syncthreads(); }
#endif
            if (SON(3) && IN(PH_GLA)) REPS(3) rec_mfma<64, 32, true>(F, GQD, GKI, GKS, (size_t)MALL * 256, 256, 0, 0, PROJ, N0, C0_V, 128, GEB, (bf16*)(ws + WS_OREC), (size_t)MALL * 512, 512, 0);
#endif
            SEAM(PH_GLA);
#if MK_NAIVE_S5
            if (SON(4) && IN(PH_S5)) s5_naive(F, PROJ, (float*)(ws + WS_OREC) + (size_t)2 * MALL * 512);
#else
            if (SON(4) && IN(PH_S5)) {
                pg8::Gemm g{(const bf16*)(ws + WS_A2), (const bf16*)(ws + WS_S5W2), 32 * S5_ROWS, 256, 512, 512};
                pg8::GroupOrder S{9, 288, F.G, F.vcu};
                pg8::EpiS5Out E{(const bf16*)(ws + WS_A2), (bf16*)(ws + WS_YPRE), ka_fresh().I(I_S5D)};
                pg8::gemm_phase<pg8::EpiS5Out, pg8::GroupOrder, true, true>(F.lds, g, S, E);
            }
#endif
            if (SON(5) && IN(PH_FIN0)) REPS(5) p_finish0(F);
            SEAM(PH_FIN0);
            if (SON(6) && IN(PH_GLU)) {
                pg8::Gemm g{(const bf16*)(ws + WS_YPRE), (const bf16*)(ws + WS_WGLUT), MALL, 512, 512, 512};
                pg8::StaticOrder S; S.init(g.M, g.N, F.G, (int)blockIdx.x);
                pg8::EpiGlu E{(const bf16*)(ws + WS_YPRE), (bf16*)(ws + WS_MIX), 1024, 512, ka_fresh().I(I_GLUB)};
                pg8::gemm_phase<pg8::EpiGlu, pg8::StaticOrder, true, true>(F.lds, g, S, E);
            }
            SEAM(PH_GLU);
        } else {
            if (SON(14) && IN(PH_ROPE)) p_rope(F);
            SEAM(PH_ROPE);
#if MK_NAIVE_RET
            if (SON(15) && IN(PH_RET)) rec_naive<256, false>(F, PROJ, N1, C1_Q, C1_K, C1_V, 512, 8, (float*)(ws + WS_OREC), (size_t)NLAT * 2048, 2048, NCTX);
#else
            if (SON(15) && IN(PH_RET)) REPS(15) rec_mfma<256, 64, false, false>(F, PROJ, PROJ, PROJ, 0, N1, C1_Q, C1_K, PROJ, N1, C1_V, 512, nullptr, (bf16*)(ws + WS_OREC), (size_t)NLAT * 2048, 2048, NCTX);
#endif
            SEAM(PH_RET);
            #if MK_NAIVE_RET
            if (SON(16) && IN(PH_FIN1)) p_finish1(F);
#else
            if (SON(16) && IN(PH_FIN1)) REPS(16) p_ret_intra_finish(F);
#endif
            SEAM(PH_FIN1);
        }
        const int po = layer ? PH_OUT1 : PH_OUT0;
        if (SON(7) && IN(po)) {
            pg8::Gemm g{(const bf16*)(ws + WS_MIX), (const bf16*)(ws + (layer ? WS_WOUT1T : WS_WOUT0T)), layer ? NLAT : MALL, 1024, layer ? 2048 : 1024, layer ? 2048 : 1024};
            pg8::StaticOrder S; S.init(g.M, g.N, F.G, (int)blockIdx.x);
            pg8::EpiResid E{ka_fresh().I(I_CTX), layer ? (const float*)(XRES + (size_t)NCTX * 1024) : ka_fresh().I(I_X), XRES, MOD + (size_t)layer * 9 * 6144 + 2048, layer ? 8 : 0};
            pg8::gemm_phase<pg8::EpiResid, pg8::StaticOrder, true, true>(F.lds, g, S, E);
        }
        SEAM(po);
        if (SON(8) && IN(po + 1)) p_router(F, layer);
        SEAM(po + 1);
        if (SON(10) && IN(po + 3)) {
            const int nt = moe_tables(F, layer);
            pg8::Gemm g{H, (const bf16*)(ws + WS_WGUT) + (size_t)layer * 32 * 2048 * 1024, nt * 256, 2048, 1024, 1024};
            pg8::MoeOrder S{(const PG8_LAS unsigned char*)(F.lds + L_TILEE), nt, 8, F.G, F.vcu, (const int*)(ws + WS_ELIST), (const PG8_LAS int*)(F.lds + L_TPOS), (const PG8_LAS int*)(F.lds + L_TCNT), layer ? NCTX : 0};
            pg8::EpiSwiglu E{(bf16*)(ws + WS_ACT), ka_fresh().I(I_BGU) + (size_t)layer * 32 * 2048};
            REPS(10) { pg8::gemm_phase<pg8::EpiSwiglu, pg8::MoeOrder, true, true, true>(F.lds, g, S, E); __syncthreads(); }
        }
        SEAM(po + 3);
        if (SON(11) && IN(po + 4)) {
            const int nt = moe_tables(F, layer);
            pg8::Gemm g{(const bf16*)(ws + WS_ACT), (const bf16*)(ws + WS_WDNT) + (size_t)layer * 32 * 1024 * 1024, nt * 256, 1024, 1024, 1024};
            pg8::MoeOrder S{(const PG8_LAS unsigned char*)(F.lds + L_TILEE), nt, 4, F.G, F.vcu, (const int*)(ws + WS_ELIST), (const PG8_LAS int*)(F.lds + L_TPOS), (const PG8_LAS int*)(F.lds + L_TCNT), 0};
            pg8::EpiDown E{(bf16*)(ws + WS_YSLOT), (const int*)(ws + WS_ELIST), (const PG8_LAS int*)(F.lds + L_TPOS), (const PG8_LAS int*)(F.lds + L_TCNT), (const float*)(ws + WS_WSLOT), ka_fresh().I(I_BDN) + (size_t)layer * 32 * 1024};
            REPS(11) { pg8::gemm_phase<pg8::EpiDown, pg8::MoeOrder, true, true>(F.lds, g, S, E); __syncthreads(); }
        }
        SEAM(po + 4);
        if (SON(12) && IN(po + 5)) {
#if MK_REP == 12
            p_combine(F, layer, true);
#endif
            p_combine(F, layer, false); }
        SEAM(po + 5);
    }
__global__ void __launch_bounds__(NTHR, 2) mk_fwd(Args) {
    extern __shared__ __attribute__((aligned(16))) unsigned char lds[];
    Frame F;
    F.lds = (LAS unsigned char*)lds;
    F.MISC = (volatile LAS unsigned*)(F.lds + L_MISC);
    F.tid = threadIdx.x; F.lane = F.tid & 63; F.wave = __builtin_amdgcn_readfirstlane(F.tid >> 6);
    F.G = gridDim.x; { const int bx = blockIdx.x; F.vcu = (F.G % 8 == 0) ? (bx % 8) * (F.G / 8) + bx / 8 : bx; }
    const KA A0 = ka_fresh();
    unsigned char* ws = A0.WS();
    F.ctl = (unsigned*)(ws + WS_CTL);
    if (F.tid < 64) F.MISC[F.tid] = 0u;
    __syncthreads();
    const int lo = A0.LO(), hi = A0.HI();
    XcdBarrier bar; bar.bar = F.ctl + CW_BAR; bar.x = 0; bar.st = nullptr;
    if (hi - lo > 1) bar = xcd_barrier_post(F.ctl + CW_BAR, F.MISC + 8);

    STAMP(0);
    if (SON(0) && IN(0)) { REPS(0) { p0_prologue(F); __syncthreads(); } } SEAM(0);
    if (SON(1) && IN(1)) { REPS(1) p_norm1_l0(F); } SEAM(1);
    layer_body<0>(F, lo, hi, bar);
    layer_body<1>(F, lo, hi, bar);
}

#ifndef MK_MULTI
#define MK_MULTI 0
#endif
extern "C" void kernel_launch(void* const* d_in, const int* in_sizes, int n_in, void* d_out, int out_size, void* d_ws, size_t ws_size, hipStream_t stream) {
    static int grid = 0;
    if (grid == 0) {
        if (n_in != 34 || out_size != NLAT * D || ws_size < WS_END) { fprintf(stderr, "kernel_launch: unexpected sizes: n_in %d out %d ws %zu (need %zu)\n", n_in, out_size, ws_size, (size_t)WS_END); grid = -1; return; }
        int dev = 0, cus = 0;
        if (hipGetDevice(&dev) != hipSuccess || hipDeviceGetAttribute(&cus, hipDeviceAttributeMultiprocessorCount, dev) != hipSuccess) { grid = -1; return; }
        if (hipFuncSetAttribute((const void*)mk_fwd, hipFuncAttributeMaxDynamicSharedMemorySize, LDS_BYTES) != hipSuccess) { fprintf(stderr, "kernel_launch: hipFuncSetAttribute failed\n"); grid = -1; return; }
        int per_cu = 0;
        if (hipOccupancyMaxActiveBlocksPerMultiprocessor(&per_cu, (const void*)mk_fwd, NTHR, LDS_BYTES) != hipSuccess || per_cu < 1) fprintf(stderr, "kernel_launch: occupancy query says %d\n", per_cu);
        (void)hipGetLastError();
        grid = cus;
    }
    if (grid < 0) return;
    (void)in_sizes;
    (void)hipMemsetAsync((char*)d_ws + WS_CTL, 0, CTL_ZERO_BYTES, stream);
    Args a{};
    for (int i = 0; i < 34; ++i) a.in[i] = (const float*)d_in[i];
    a.out = (float*)d_out; a.ws = (unsigned char*)d_ws;
#if MK_MULTI
    for (int p = 0; p < NPH; ++p) { a.ph_lo = p; a.ph_hi = p + 1; hipLaunchKernelGGL(mk_fwd, dim3(grid), dim3(NTHR), LDS_BYTES, stream, a); }
#else
    a.ph_lo = 0; a.ph_hi = NPH; hipLaunchKernelGGL(mk_fwd, dim3(grid), dim3(NTHR), LDS_BYTES, stream, a);
#endif
}
```

```cpp
#include <hip/hip_runtime.h>
#include <cstdio>
#include <cstdint>
#include <cmath>
namespace pg8 {
#define PG8_LAS __attribute__((address_space(3)))
typedef unsigned short bf16_t;
typedef short bf16x8 __attribute__((ext_vector_type(8)));
typedef float f32x4 __attribute__((ext_vector_type(4)));
typedef unsigned u32x4 __attribute__((ext_vector_type(4)));
constexpr int BM = 256, BK = 64, HALF = 128, HTB = HALF * BK * 2  , STAGE_BYTES = 8 * HTB, NXCD = 8, WGM = 8;

__host__ __device__ __forceinline__ int lds_byte(int r, int c) { const int st = (r >> 4) * 2 + (c >> 5), rr = r & 15, cc = c & 31, ob = rr * 64 + cc * 2; return st * 1024 + (ob ^ (((ob >> 9) & 1) << 5)); }
__host__ __device__ __forceinline__ void stage_rc(int b, int& R, int& C) { const int st = b / 1024, sb = b % 1024, swz = sb ^ (((sb >> 9) & 1) << 5); R = (st >> 1) * 16 + swz / 64; C = (st & 1) * 32 + (swz % 64) / 2; }
__host__ __device__ __forceinline__ int perm32(int rho) { const int n = rho >> 4, i = rho & 15; return 8 * (i >> 2) + 4 * n + (i & 3); }

struct Unit { int pm, pn, pb, e; };
struct Gemm { const bf16_t* A; const bf16_t* Bt; int M, N, K, lda; };

struct StaticOrder {
    int nM, nN, nwg, G, c;
    __host__ __device__ void init(int M, int N, int G_, int c_) { nM = M / BM; nN = N / BM; nwg = nM * nN; G = G_; c = c_; }
    __host__ __device__ bool next(int i, Unit& u) const {
        const long L = (long)i * G + c; if (L >= nwg) return false;
        int wgid = (int)L; { const int q = nwg / NXCD, r = nwg % NXCD, xcd = wgid % NXCD, off = wgid / NXCD; wgid = (xcd < r ? xcd * (q + 1) : r * (q + 1) + (xcd - r) * q) + off; }
        const int nig = WGM * nN, gid = wgid / nig, fm = gid * WGM, gsz = (nM - fm) < WGM ? (nM - fm) : WGM;
        u.pm = fm + ((wgid % nig) % gsz); u.pn = (wgid % nig) / gsz; u.pb = u.pn; u.e = 0; return true;
    }
    __device__ __forceinline__ void a_ready(const Unit&) const {}
    __device__ __forceinline__ void done(const Unit&) const {}
};
__device__ __forceinline__ unsigned cvt_pk_bf16(float lo, float hi) { unsigned r; asm volatile("v_cvt_pk_bf16_f32 %0, %1, %2" : "=v"(r) : "v"(lo), "v"(hi)); return r; }
__device__ __forceinline__ float bflo(unsigned w) { return __uint_as_float(w << 16); }
__device__ __forceinline__ float bfhi(unsigned w) { return __uint_as_float(w & 0xffff0000u); }
__device__ __forceinline__ float sigmoidf_(float z) { return 1.0f / (1.0f + __expf(-z)); }

struct EpiStore {
    static constexpr bool PERM = true, AFTER_DRAIN = false;
    bf16_t* O; int ldc;
    __device__ __forceinline__ void operator()(const f32x4 (&acc)[2][2][4][2], const Unit& u, int wr, int wc, int fr, int fq) const {
        const int row0 = u.pm * BM + wr * 64 + fr, col0 = u.pn * BM + wc * 32 + 8 * fq;
#pragma unroll
        for (int ai = 0; ai < 2; ++ai)
#pragma unroll
            for (int m = 0; m < 4; ++m) { bf16_t* rowp = O + (size_t)(row0 + ai * HALF + m * 16) * ldc + col0;
#pragma unroll
                for (int bj = 0; bj < 2; ++bj) { const f32x4 v0 = acc[ai][bj][m][0], v1 = acc[ai][bj][m][1];
                    u32x4 w; w.x = cvt_pk_bf16(v0[0], v0[1]); w.y = cvt_pk_bf16(v0[2], v0[3]); w.z = cvt_pk_bf16(v1[0], v1[1]); w.w = cvt_pk_bf16(v1[2], v1[3]);
                    *(u32x4*)(rowp + bj * HALF) = w; } }
    }
};
struct EpiGlu {
    static constexpr bool PERM = true, AFTER_DRAIN = false;
    const bf16_t* Y; bf16_t* O; int ldo, ocol0; const float* bias;
    __device__ __forceinline__ void operator()(const f32x4 (&acc)[2][2][4][2], const Unit& u, int wr, int wc, int fr, int fq) const {
        const int row0 = u.pm * BM + wr * 64 + fr, col0 = u.pn * BM + wc * 32 + 8 * fq;
        f32x4 bv[2][2];
#pragma unroll
        for (int bj = 0; bj < 2; ++bj)
#pragma unroll
            for (int n = 0; n < 2; ++n) bv[bj][n] = *(const f32x4*)(bias + col0 + bj * HALF + 4 * n);
#pragma unroll
        for (int ai = 0; ai < 2; ++ai)
#pragma unroll
            for (int m = 0; m < 4; ++m) { const size_t row = (size_t)(row0 + ai * HALF + m * 16);
#pragma unroll
                for (int bj = 0; bj < 2; ++bj) { const int c = col0 + bj * HALF;
                    const u32x4 yv = *(const u32x4*)(Y + row * 512 + c);
                    const f32x4 z0 = acc[ai][bj][m][0] + bv[bj][0], z1 = acc[ai][bj][m][1] + bv[bj][1];
                    u32x4 w;
                    w.x = cvt_pk_bf16(bflo(yv.x) * sigmoidf_(z0[0]), bfhi(yv.x) * sigmoidf_(z0[1]));
                    w.y = cvt_pk_bf16(bflo(yv.y) * sigmoidf_(z0[2]), bfhi(yv.y) * sigmoidf_(z0[3]));
                    w.z = cvt_pk_bf16(bflo(yv.z) * sigmoidf_(z1[0]), bfhi(yv.z) * sigmoidf_(z1[1]));
                    w.w = cvt_pk_bf16(bflo(yv.w) * sigmoidf_(z1[2]), bfhi(yv.w) * sigmoidf_(z1[3]));
                    *(u32x4*)(O + row * ldo + ocol0 + c) = w; } }
    }
};
template <bool BASE_F32> struct EpiResid {
    static constexpr bool PERM = true, AFTER_DRAIN = false;
    const float* base_ctx; const float* base_lat; bf16_t* out; const float* gate; int tile0;
    __device__ __forceinline__ void operator()(const f32x4 (&acc)[2][2][4][2], const Unit& u, int wr, int wc, int fr, int fq) const {
        const int gt = u.pm + tile0, bidx = gt < 8 ? 8 : ((gt - 8) >> 4);
        const float* bt = gt < 8 ? base_ctx + (size_t)gt * 256 * 1024 : base_lat + (size_t)(gt - 8) * 256 * 1024;
        bf16_t* ot = out + (size_t)gt * 256 * 1024;
        const int col0 = u.pn * BM + wc * 32 + 8 * fq;
        f32x4 gv[2][2];
#pragma unroll
        for (int bj = 0; bj < 2; ++bj)
#pragma unroll
            for (int n = 0; n < 2; ++n) gv[bj][n] = *(const f32x4*)(gate + bidx * 6144 + col0 + bj * HALF + 4 * n);
#pragma unroll
        for (int ai = 0; ai < 2; ++ai)
#pragma unroll
            for (int m = 0; m < 4; ++m) { const size_t off = (size_t)(wr * 64 + fr + ai * HALF + m * 16) * 1024 + col0;
#pragma unroll
                for (int bj = 0; bj < 2; ++bj) { f32x4 b0, b1;
                    if constexpr (BASE_F32) { b0 = *(const f32x4*)(bt + off + bj * HALF); b1 = *(const f32x4*)(bt + off + bj * HALF + 4); }
                    else { const u32x4 bw = *(const u32x4*)(ot + off + bj * HALF); b0 = (f32x4){bflo(bw.x), bfhi(bw.x), bflo(bw.y), bfhi(bw.y)}; b1 = (f32x4){bflo(bw.z), bfhi(bw.z), bflo(bw.w), bfhi(bw.w)}; }
                    const f32x4 v0 = b0 + gv[bj][0] * acc[ai][bj][m][0], v1 = b1 + gv[bj][1] * acc[ai][bj][m][1];
                    u32x4 w; w.x = cvt_pk_bf16(v0[0], v0[1]); w.y = cvt_pk_bf16(v0[2], v0[3]); w.z = cvt_pk_bf16(v1[0], v1[1]); w.w = cvt_pk_bf16(v1[2], v1[3]);
                    *(u32x4*)(ot + off + bj * HALF) = w; } }
    }
};
struct EpiSwiglu {
    static constexpr bool PERM = true, AFTER_DRAIN = false;
    bf16_t* ACT; const float* bgu;
    __device__ __forceinline__ void operator()(const f32x4 (&acc)[2][2][4][2], const Unit& u, int wr, int wc, int fr, int fq) const {
        const int row0 = u.pm * BM + wr * 64 + fr, lc0 = u.pn * 128 + wc * 32 + 8 * fq;
        const float* bb = bgu + (size_t)u.e * 2048 + lc0;
        f32x4 bg[2], bl[2];
#pragma unroll
        for (int n = 0; n < 2; ++n) { bg[n] = *(const f32x4*)(bb + 4 * n); bl[n] = *(const f32x4*)(bb + 1024 + 4 * n); }
#pragma unroll
        for (int ai = 0; ai < 2; ++ai)
#pragma unroll
            for (int m = 0; m < 4; ++m) { float a[8];
#pragma unroll
                for (int n = 0; n < 2; ++n)
#pragma unroll
                    for (int j = 0; j < 4; ++j) { const float g = fminf(acc[ai][0][m][n][j] + bg[n][j], 7.0f); float l = acc[ai][1][m][n][j] + bl[n][j]; l = fminf(fmaxf(l, -7.0f), 7.0f);
                        a[4 * n + j] = g * sigmoidf_(1.702f * g) * (l + 1.0f); }
                u32x4 w; w.x = cvt_pk_bf16(a[0], a[1]); w.y = cvt_pk_bf16(a[2], a[3]); w.z = cvt_pk_bf16(a[4], a[5]); w.w = cvt_pk_bf16(a[6], a[7]);
                *(u32x4*)(ACT + (size_t)(row0 + ai * HALF + m * 16) * 1024 + lc0) = w; }
    }
};
struct EpiDown {
    static constexpr bool PERM = true, AFTER_DRAIN = false;
    bf16_t* Y; const int* elist; const PG8_LAS int* tpos; const PG8_LAS int* tcnt; const float* w_slot; const float* bdn;
    __device__ __forceinline__ void operator()(const f32x4 (&acc)[2][2][4][2], const Unit& u, int wr, int wc, int fr, int fq) const {
        const int col0 = u.pn * BM + wc * 32 + 8 * fq, tp0 = tpos[u.pm], tc0 = tcnt[u.pm]; const int* el = elist + (size_t)u.e * 34816;
        f32x4 bv[2][2];
#pragma unroll
        for (int bj = 0; bj < 2; ++bj)
#pragma unroll
            for (int n = 0; n < 2; ++n) bv[bj][n] = *(const f32x4*)(bdn + (size_t)u.e * 1024 + col0 + bj * HALF + 4 * n);
#pragma unroll
        for (int ai = 0; ai < 2; ++ai)
#pragma unroll
            for (int m = 0; m < 4; ++m) { const int pos = tp0 + wr * 64 + fr + ai * HALF + m * 16; const int slot = pos < tc0 ? el[pos] : -1;
                if (slot >= 0) { const float ws = w_slot[slot]; bf16_t* rowp = Y + (size_t)slot * 1024 + col0;
#pragma unroll
                    for (int bj = 0; bj < 2; ++bj) { const f32x4 v0 = (acc[ai][bj][m][0] + bv[bj][0]) * ws, v1 = (acc[ai][bj][m][1] + bv[bj][1]) * ws;
                        u32x4 w; w.x = cvt_pk_bf16(v0[0], v0[1]); w.y = cvt_pk_bf16(v0[2], v0[3]); w.z = cvt_pk_bf16(v1[0], v1[1]); w.w = cvt_pk_bf16(v1[2], v1[3]);
                        *(u32x4*)(rowp + bj * HALF) = w; } } }
    }
};
struct MoeOrder {
    const PG8_LAS unsigned char* tile_e; int ntiles, NT, G, c; const int* elist; const PG8_LAS int* tpos; const PG8_LAS int* tcnt; int row0;
    __device__ __forceinline__ int rowidx(const Unit& u, int r) const { const int pos = tpos[u.pm] + r; const int s = pos < tcnt[u.pm] ? elist[(size_t)u.e * 34816 + pos] : 0; return row0 + (s >> 2); }
    __device__ __forceinline__ bool next(int i, Unit& u) const {
        const int L = i * G + c; if (L >= ntiles * NT) return false;
        const int T = L / NT; u.pm = T; u.pn = L - T * NT; u.e = __builtin_amdgcn_readfirstlane((int)tile_e[T]); u.pb = u.e * NT + u.pn; return true;
    }
    __device__ __forceinline__ void a_ready(const Unit&) const {}
    __device__ __forceinline__ void done(const Unit&) const {}
};

struct EpiStoreU {
    static constexpr bool PERM = true, AFTER_DRAIN = false;
    bf16_t* O; int ldc; bf16_t* A2;
    __device__ __forceinline__ void operator()(const f32x4 (&acc)[2][2][4][2], const Unit& u, int wr, int wc, int fr, int fq) const {
        const int row0 = u.pm * BM + wr * 64 + fr, col0 = u.pn * BM + wc * 32 + 8 * fq;
#pragma unroll
        for (int ai = 0; ai < 2; ++ai)
#pragma unroll
            for (int m = 0; m < 4; ++m) { const int R = row0 + ai * HALF + m * 16; bf16_t* rowp = O + (size_t)R * ldc + col0;
                int r, t; if (R < 2048) { r = (R >> 8) * 272 + ((R & 255) >> 4); t = R & 15; } else { const int R2 = R - 2048; r = (R2 >> 12) * 272 + 16 + ((R2 & 4095) >> 4); t = R2 & 15; }
#pragma unroll
                for (int bj = 0; bj < 2; ++bj) { const f32x4 v0 = acc[ai][bj][m][0], v1 = acc[ai][bj][m][1];
                    u32x4 w; w.x = cvt_pk_bf16(v0[0], v0[1]); w.y = cvt_pk_bf16(v0[2], v0[3]); w.z = cvt_pk_bf16(v1[0], v1[1]); w.w = cvt_pk_bf16(v1[2], v1[3]);
                    *(u32x4*)(rowp + bj * HALF) = w;
                    if (u.pn >= 6) { const int g = (u.pn - 6) * 16 + bj * 8 + wc * 2 + (fq >> 1);
                        *(u32x4*)(A2 + ((size_t)g * 2304 + r) * 512 + t * 16 + (fq & 1) * 8) = w; } } }
    }
};
struct EpiF32Plain {
    static constexpr bool PERM = true, AFTER_DRAIN = false;
    float* C;
    __device__ __forceinline__ void operator()(const f32x4 (&acc)[2][2][4][2], const Unit& u, int wr, int wc, int fr, int fq) const {
        float* base = C + (size_t)(u.pm * BM + wr * 64 + fr) * 256 + wc * 32 + 8 * fq;
#pragma unroll
        for (int ai = 0; ai < 2; ++ai)
#pragma unroll
            for (int m = 0; m < 4; ++m) {
#pragma unroll
                for (int bj = 0; bj < 2; ++bj) { float* p = base + (ai * HALF + m * 16) * 256 + bj * HALF;
                    *(f32x4*)p = acc[ai][bj][m][0]; *(f32x4*)(p + 4) = acc[ai][bj][m][1]; } }
    }
};
struct EpiS5Out {
    static constexpr bool PERM = true, AFTER_DRAIN = false;
    const bf16_t* A2; bf16_t* YP; const float* dskip;
    __device__ __forceinline__ void operator()(const f32x4 (&acc)[2][2][4][2], const Unit& u, int wr, int wc, int fr, int fq) const {
        const int g = u.e;
#pragma unroll
        for (int ai = 0; ai < 2; ++ai)
#pragma unroll
            for (int m = 0; m < 4; ++m) { const int rr = (u.pm - g * 9) * BM + wr * 64 + fr + ai * HALF + m * 16;
                if (rr < 2176) { const int b = rr / 272, n = rr - b * 272;
                    const int tok0 = n < 16 ? b * 256 + n * 16 : 2048 + b * 4096 + (n - 16) * 16;
#pragma unroll
                    for (int bj = 0; bj < 2; ++bj) { const int col = bj * HALF + wc * 32 + 8 * fq, t = col >> 4, c0 = col & 15;
                        const u32x4 uv = *(const u32x4*)(A2 + ((size_t)g * 2304 + rr) * 512 + col);
                        const f32x4 d0 = *(const f32x4*)(dskip + g * 16 + c0), d1 = *(const f32x4*)(dskip + g * 16 + c0 + 4);
                        float y[8];
                        y[0] = acc[ai][bj][m][0][0] + d0[0] * bflo(uv.x); y[1] = acc[ai][bj][m][0][1] + d0[1] * bfhi(uv.x); y[2] = acc[ai][bj][m][0][2] + d0[2] * bflo(uv.y); y[3] = acc[ai][bj][m][0][3] + d0[3] * bfhi(uv.y);
                        y[4] = acc[ai][bj][m][1][0] + d1[0] * bflo(uv.z); y[5] = acc[ai][bj][m][1][1] + d1[1] * bfhi(uv.z); y[6] = acc[ai][bj][m][1][2] + d1[2] * bflo(uv.w); y[7] = acc[ai][bj][m][1][3] + d1[3] * bfhi(uv.w);
#pragma unroll
                        for (int j = 0; j < 8; ++j) { const float z = y[j], th = 0.7978845608f * (z + 0.044715f * z * z * z); const float e2 = __expf(2.0f * th); y[j] = 0.5f * z * (1.0f + (1.0f - 2.0f / (e2 + 1.0f))); }
                        u32x4 w; w.x = cvt_pk_bf16(y[0], y[1]); w.y = cvt_pk_bf16(y[2], y[3]); w.z = cvt_pk_bf16(y[4], y[5]); w.w = cvt_pk_bf16(y[6], y[7]);
                        *(u32x4*)(YP + (size_t)(tok0 + t) * 512 + g * 16 + c0) = w; } } }
    }
};
struct GroupOrder {
    int tpg, nunits, G, c;
    __device__ __forceinline__ bool next(int i, Unit& u) const { const int L = i * G + c; if (L >= nunits) return false; u.pm = L; u.pn = 0; u.e = L / tpg; u.pb = u.e; return true; }
    __device__ __forceinline__ void a_ready(const Unit&) const {}
    __device__ __forceinline__ void done(const Unit&) const {}
};
template <class Epi, class Sched, bool ALIGN_EPI = false, bool SP2 = false, bool GATHER = false>
__device__ __forceinline__ void gemm_phase(PG8_LAS unsigned char* lds, const Gemm g, const Sched& S, const Epi& E) {
    static_assert(!GATHER || SP2, "gathered A staging is implemented in the SP2 loop only");
    const int tid = threadIdx.x, wid = __builtin_amdgcn_readfirstlane(tid >> 6), lane = tid & 63, wr = wid >> 2, wc = wid & 3, fr = lane & 15, fq = lane >> 4;
    int K_ = g.K; asm volatile("" : "+s"(K_));
    const int K = K_, nt = K / BK;
    unsigned voffA[2], voffB[2];
#pragma unroll
    for (int i = 0; i < 2; ++i) { int R, C; stage_rc(tid * 16 + i * 8192, R, C); const int Rb = Epi::PERM ? ((R & ~31) + perm32(R & 31)) : R;
        voffA[i] = (unsigned)(R * g.lda + C) * 2u; voffB[i] = (unsigned)(Rb * K + C) * 2u; }
    const size_t kstep = (size_t)(BK * 2);
    const size_t hstep = (size_t)HALF * K * 2;
    const size_t tstep = 2 * hstep;
    const size_t hstepA = (size_t)HALF * g.lda * 2, tstepA = 2 * hstepA;
    const unsigned ldsw = (unsigned)wid * 1024u;
    const int aoff = lds_byte(wr * 64 + fr, fq * 8), boff = lds_byte(wc * 32 + fr, fq * 8);
#define PG8_SA(b, h) (((b) * 2 + (h)) * HTB)
#define PG8_SB(b, h) ((4 + (b) * 2 + (h)) * HTB)
#define PG8_STAGE(bufoff, gbase, voff) do { _Pragma("unroll") for (int _i = 0; _i < 2; ++_i) \
        __builtin_amdgcn_global_load_lds((const unsigned*)((const char*)(gbase) + (voff)[_i]), (PG8_LAS unsigned*)(lds + (bufoff) + ldsw + _i * 8192), 16, 0, 0); } while (0)
#define PG8_STAGE_H0(bufoff, gbase) do { if constexpr (GATHER) PG8_STAGE(bufoff, gbase, voffA0); else PG8_STAGE(bufoff, gbase, voffA); } while (0)
#define PG8_STAGE_H1(bufoff, gbase) do { if constexpr (GATHER) PG8_STAGE(bufoff, gbase, voffA1); else PG8_STAGE(bufoff, (gbase) + hstepA, voffA); } while (0)
#define PG8_GOFF(unit, h, dst) do { _Pragma("unroll") for (int _i = 0; _i < 2; ++_i) { int _R, _C; stage_rc(tid * 16 + _i * 8192, _R, _C); dst[_i] = (unsigned)S.rowidx(unit, (h) * HALF + _R); } } while (0)
#define PG8_GCONV(dst, src) do { _Pragma("unroll") for (int _i = 0; _i < 2; ++_i) { int _R, _C; stage_rc(tid * 16 + _i * 8192, _R, _C); dst[_i] = (src[_i] * (unsigned)g.lda + (unsigned)_C) * 2u; } } while (0)
#define PG8_LDA(dst, b, h) do { _Pragma("unroll") for (int m = 0; m < 4; ++m) _Pragma("unroll") for (int k = 0; k < 2; ++k) dst[m][k] = *(const PG8_LAS bf16x8*)(lds + PG8_SA(b, h) + aoff + m * 2048 + k * 1024); } while (0)
#define PG8_LDB(dst, b, h) do { _Pragma("unroll") for (int n = 0; n < 2; ++n) _Pragma("unroll") for (int k = 0; k < 2; ++k) dst[n][k] = *(const PG8_LAS bf16x8*)(lds + PG8_SB(b, h) + boff + n * 2048 + k * 1024); } while (0)
#define PG8_MMA(ai, bj, At, Bt) do { __builtin_amdgcn_s_setprio(1); _Pragma("unroll") for (int m = 0; m < 4; ++m) _Pragma("unroll") for (int n = 0; n < 2; ++n) _Pragma("unroll") for (int k = 0; k < 2; ++k) \
        acc[ai][bj][m][n] = __builtin_amdgcn_mfma_f32_16x16x32_bf16(Bt[n][k], At[m][k], acc[ai][bj][m][n], 0, 0, 0); __builtin_amdgcn_s_setprio(0); } while (0)
#define PG8_WAIT_V(n) asm volatile("s_waitcnt vmcnt(" #n ")" ::: "memory")
#define PG8_WAIT_L(n) asm volatile("s_waitcnt lgkmcnt(" #n ")" ::: "memory")
#define PG8_BAR __builtin_amdgcn_s_barrier()
#define PG8_SCHED __builtin_amdgcn_sched_barrier(0)
    Unit cur, nxt; int ui = 0;
    if (!S.next(0, cur)) return;
    f32x4 acc[2][2][4][2];
#pragma unroll
    for (int a = 0; a < 2; ++a)
#pragma unroll
        for (int b = 0; b < 2; ++b)
#pragma unroll
            for (int m = 0; m < 4; ++m)
#pragma unroll
                for (int n = 0; n < 2; ++n) acc[a][b][m][n] = (f32x4){0.f, 0.f, 0.f, 0.f};
    bf16x8 At[4][2], B0[2][2], B1[2][2];
    const char* cA = (const char*)g.A + (GATHER ? (size_t)0 : (size_t)cur.pm * tstepA);
    unsigned voffA0[2] = {0u, 0u}, voffA1[2] = {0u, 0u}, nidx0[2] = {0u, 0u}, nidx1[2] = {0u, 0u};
    if constexpr (GATHER) { PG8_GOFF(cur, 0, nidx0); PG8_GOFF(cur, 1, nidx1); PG8_GCONV(voffA0, nidx0); PG8_GCONV(voffA1, nidx1); } const char* cB = (const char*)g.Bt + (size_t)cur.pb * tstep;
    S.a_ready(cur);
    if constexpr (SP2) {
        PG8_STAGE(PG8_SB(0, 0), cB, voffB); PG8_STAGE(PG8_SB(0, 1), cB + hstep, voffB); PG8_STAGE_H0(PG8_SA(0, 0), cA); PG8_STAGE_H1(PG8_SA(0, 1), cA);
        if (wr == 1) PG8_BAR;
        PG8_WAIT_V(2); PG8_BAR;
        PG8_STAGE(PG8_SB(1, 0), cB + kstep, voffB); PG8_STAGE_H0(PG8_SA(1, 0), cA + kstep); PG8_STAGE(PG8_SB(1, 1), cB + hstep + kstep, voffB);
        PG8_WAIT_V(6); PG8_BAR;
    } else {
        PG8_STAGE(PG8_SB(0, 0), cB, voffB); PG8_STAGE_H0(PG8_SA(0, 0), cA); PG8_STAGE(PG8_SB(0, 1), cB + hstep, voffB); PG8_STAGE_H1(PG8_SA(0, 1), cA);
        if (wr == 1) PG8_BAR;
        PG8_WAIT_V(4); PG8_BAR;
        PG8_STAGE(PG8_SB(1, 0), cB + kstep, voffB); PG8_STAGE_H0(PG8_SA(1, 0), cA + kstep); PG8_STAGE(PG8_SB(1, 1), cB + hstep + kstep, voffB);
        PG8_WAIT_V(6); PG8_BAR;
    }
    for (;;) {
        const bool has_next = S.next(ui + 1, nxt);
        const char* nA = (has_next && !GATHER) ? (const char*)g.A + (size_t)nxt.pm * tstepA : cA; const char* nB = has_next ? (const char*)g.Bt + (size_t)nxt.pb * tstep : cB;
        for (int t = 0; t < nt; t += 2) {
            const bool last = (t == nt - 2);
            const char* a1 = cA + (size_t)(t + 1) * kstep;
            const char* a2 = last ? nA : cA + (size_t)(t + 2) * kstep; const char* b2 = last ? nB : cB + (size_t)(t + 2) * kstep;
            const char* a3 = a2 + kstep; const char* b3 = b2 + kstep;
            if (last && has_next) S.a_ready(nxt);
            if constexpr (GATHER) { if (has_next && t == nt - 4) { PG8_GOFF(nxt, 0, nidx0); PG8_GOFF(nxt, 1, nidx1); }
                                    if (has_next && last) PG8_GCONV(voffA0, nidx0); }
            if constexpr (SP2) {
            PG8_LDB(B0, 0, 0); PG8_LDB(B1, 0, 1); PG8_SCHED; PG8_LDA(At, 0, 0); PG8_STAGE_H1(PG8_SA(1, 1), a1);
            if constexpr (GATHER) { if (has_next && last) PG8_GCONV(voffA1, nidx1); }
            PG8_WAIT_V(8); PG8_WAIT_L(0); PG8_BAR; PG8_MMA(0, 0, At, B0); PG8_MMA(0, 1, At, B1); PG8_BAR; PG8_SCHED;
            PG8_LDA(At, 0, 1); PG8_STAGE(PG8_SB(0, 0), b2, voffB); PG8_STAGE(PG8_SB(0, 1), b2 + hstep, voffB); PG8_STAGE_H0(PG8_SA(0, 0), a2);
            PG8_WAIT_V(8); PG8_WAIT_L(0); PG8_BAR; PG8_MMA(1, 0, At, B0); PG8_MMA(1, 1, At, B1); PG8_BAR; PG8_SCHED;
            PG8_LDB(B0, 1, 0); PG8_LDB(B1, 1, 1); PG8_SCHED; PG8_LDA(At, 1, 0); PG8_STAGE_H1(PG8_SA(0, 1), a2);
            PG8_WAIT_V(8); PG8_WAIT_L(0); PG8_BAR; PG8_MMA(0, 0, At, B0); PG8_MMA(0, 1, At, B1); PG8_BAR; PG8_SCHED;
            PG8_LDA(At, 1, 1); PG8_STAGE(PG8_SB(1, 0), b3, voffB); PG8_STAGE(PG8_SB(1, 1), b3 + hstep, voffB); PG8_STAGE_H0(PG8_SA(1, 0), a3);
            PG8_WAIT_V(8); PG8_WAIT_L(0); PG8_BAR; PG8_MMA(1, 0, At, B0); PG8_MMA(1, 1, At, B1); PG8_BAR; PG8_SCHED;
            } else {
            PG8_LDB(B0, 0, 0); PG8_SCHED; PG8_LDA(At, 0, 0); PG8_STAGE(PG8_SA(1, 1), a1 + hstepA, voffA);
            PG8_WAIT_L(8); PG8_BAR; PG8_WAIT_L(0); PG8_MMA(0, 0, At, B0); PG8_BAR; PG8_SCHED;
            PG8_LDB(B1, 0, 1); PG8_STAGE(PG8_SB(0, 0), b2, voffB);
            PG8_BAR; PG8_WAIT_L(0); PG8_MMA(0, 1, At, B1); PG8_BAR;
            PG8_LDA(At, 0, 1); PG8_STAGE(PG8_SA(0, 0), a2, voffA);
            PG8_BAR; PG8_WAIT_L(0); PG8_MMA(1, 0, At, B0); PG8_BAR; PG8_SCHED;
            PG8_STAGE(PG8_SB(0, 1), b2 + hstep, voffB);
            PG8_WAIT_V(6); PG8_BAR; PG8_MMA(1, 1, At, B1); PG8_BAR;
            PG8_LDB(B0, 1, 0); PG8_SCHED; PG8_LDA(At, 1, 0); PG8_STAGE(PG8_SA(0, 1), a2 + hstepA, voffA);
            PG8_WAIT_L(8); PG8_BAR; PG8_WAIT_L(0); PG8_MMA(0, 0, At, B0); PG8_BAR; PG8_SCHED;
            PG8_LDB(B1, 1, 1); PG8_STAGE(PG8_SB(1, 0), b3, voffB);
            PG8_BAR; PG8_WAIT_L(0); PG8_MMA(0, 1, At, B1); PG8_BAR;
            PG8_LDA(At, 1, 1); PG8_STAGE(PG8_SA(1, 0), a3, voffA);
            PG8_BAR; PG8_WAIT_L(0); PG8_MMA(1, 0, At, B0); PG8_BAR; PG8_SCHED;
            PG8_STAGE(PG8_SB(1, 1), b3 + hstep, voffB);
            PG8_WAIT_V(6); PG8_BAR; PG8_MMA(1, 1, At, B1); PG8_BAR;
            }
        }
        if constexpr (ALIGN_EPI) { if (wr == 0) PG8_BAR; }
        if constexpr (!Epi::AFTER_DRAIN) { E(acc, cur, wr, wc, fr, fq); S.done(cur); }
        if (!has_next) break;
#pragma unroll
        for (int a = 0; a < 2; ++a)
#pragma unroll
            for (int b = 0; b < 2; ++b)
#pragma unroll
                for (int m = 0; m < 4; ++m)
#pragma unroll
                    for (int n = 0; n < 2; ++n) acc[a][b][m][n] = (f32x4){0.f, 0.f, 0.f, 0.f};
        cur = nxt; cA = nA; cB = nB; ++ui;
        if constexpr (ALIGN_EPI) { if (wr == 1) PG8_BAR; }
    }
    PG8_WAIT_V(0);
    if constexpr (!ALIGN_EPI) { if (wr == 0) PG8_BAR; }
    PG8_BAR;
    if constexpr (Epi::AFTER_DRAIN) { E.fused(acc, cur, wr, wc, fr, fq, lds, wid, lane); S.done(cur); }
#undef PG8_SA
#undef PG8_SB
#undef PG8_STAGE
#undef PG8_STAGE_H0
#undef PG8_STAGE_H1
#undef PG8_GOFF
#undef PG8_GCONV
#undef PG8_LDA
#undef PG8_LDB
#undef PG8_MMA
#undef PG8_WAIT_V
#undef PG8_WAIT_L
#undef PG8_BAR
#undef PG8_SCHED
}
}
constexpr int NWAVES = 8, NTHR = 512;
constexpr int D = 1024, NB = 8, SEQ = 4096, CTX = 256;
constexpr int NCTX = NB * CTX, NLAT = NB * SEQ, MALL = NCTX + NLAT;
constexpr int N0 = 2304, N1 = 6144;
constexpr int C0_Q = 0, C0_K = 256, C0_V = 512, C0_G = 1024, C0_U = 1536, C0_LOW = 2048;
constexpr int C1_Q = 0, C1_K = 1024, C1_V = 2048, C1_G = 4096;
constexpr int NE = 32, MAXTILES = 576;
constexpr float EPS = 1e-6f;
constexpr int NPH = 24;
enum { PH_PRO = 0, PH_NORM1, PH_INPROJ0, PH_GLAPREP, PH_GLA, PH_S5, PH_FIN0, PH_GLU, PH_OUT0, PH_ROUTER0, PH_GATHER0, PH_GU0, PH_DOWN0, PH_COMB0,
       PH_INPROJ1, PH_ROPE, PH_RET, PH_FIN1, PH_OUT1, PH_ROUTER1, PH_GATHER1, PH_GU1, PH_DOWN1, PH_COMB1 };
#ifndef MK_NAIVE_GLA
#define MK_NAIVE_GLA 0
#endif
#ifndef MK_NAIVE_S5
#define MK_NAIVE_S5 0
#endif
#ifndef MK_NAIVE_RET
#define MK_NAIVE_RET 0
#endif
constexpr size_t MiB = 1u << 20;
constexpr size_t WS_CTL = 0, CTL_ZERO_BYTES = 1 * MiB;
constexpr size_t WS_MOD = 1 * MiB;
constexpr size_t WS_WIN0T = 2 * MiB, WS_WOUT0T = 7 * MiB, WS_WGLUT = 9 * MiB, WS_WIN1T = 10 * MiB, WS_WOUT1T = 22 * MiB;
constexpr size_t WS_SELE = 26 * MiB, WS_WSLOT = 27 * MiB, WS_SPOS = 28 * MiB, WS_PROW = 29 * MiB;
constexpr size_t WS_WGUT = 32 * MiB, WS_WDNT = 288 * MiB;
constexpr size_t WS_XRES = 416 * MiB, WS_H = 552 * MiB, WS_MIX = 620 * MiB, WS_YPRE = 688 * MiB;
constexpr size_t WS_PROJ = 748 * MiB, WS_OREC = 1156 * MiB;
constexpr size_t WS_XG = 748 * MiB, WS_ACT = 1036 * MiB, WS_YSLOT = 1324 * MiB;
constexpr size_t WS_S5W1 = 1556 * MiB, WS_S5W2 = 1560 * MiB, WS_A2 = 1568 * MiB, WS_SLOC = 1668 * MiB;
constexpr size_t WS_ELIST = 1740 * MiB;
constexpr size_t WS_END = 1746 * MiB;
constexpr int CW_TMO = 0, CW_BAR = 4096, CW_GCNT = 16384;
constexpr int RING_BYTES = 131072, LDSCTL_OFF = RING_BYTES, LDS_BYTES = 147456;
constexpr int L_MISC = LDSCTL_OFF;
constexpr int L_TILEE = LDSCTL_OFF + 256;
constexpr int L_TSTART = LDSCTL_OFF + 1024;
constexpr int L_LCNT = LDSCTL_OFF + 1280;
constexpr int L_GBASE = LDSCTL_OFF + 1536;
constexpr int L_BLKE = LDSCTL_OFF + 2048;
constexpr int L_BLKP = LDSCTL_OFF + 5120;
constexpr int L_TPOS = L_BLKE, L_TCNT = L_BLKP;

#define GAS __attribute__((address_space(1)))
#define LAS __attribute__((address_space(3)))
typedef unsigned short bf16;
typedef unsigned v4u __attribute__((ext_vector_type(4)));
typedef unsigned v2u __attribute__((ext_vector_type(2)));
typedef float f32x4 __attribute__((ext_vector_type(4)));
typedef GAS unsigned gu32;
#define RLX_AGENT __ATOMIC_RELAXED, __HIP_MEMORY_SCOPE_AGENT
#define LDS_WAIT() asm volatile("s_waitcnt lgkmcnt(0)" ::: "memory")
#define VM_WAIT() asm volatile("s_waitcnt vmcnt(0)" ::: "memory")
__device__ __forceinline__ unsigned f2bf(float f) { unsigned u = __builtin_bit_cast(unsigned, f); return (u + 0x7fffu + ((u >> 16) & 1u)) >> 16; }
__device__ __forceinline__ unsigned pk2(float lo, float hi) { return f2bf(lo) | (f2bf(hi) << 16); }
__device__ __forceinline__ float bf2f(unsigned b) { return __uint_as_float(b << 16); }
__device__ __forceinline__ float blo(unsigned w) { return __uint_as_float(w << 16); }
__device__ __forceinline__ float bhi(unsigned w) { return __uint_as_float(w & 0xffff0000u); }
__device__ __forceinline__ float wave_sum(float v) {
#pragma unroll
    for (int o = 1; o < 64; o <<= 1) v += __shfl_xor(v, o);
    return v;
}
__device__ __forceinline__ float silu_(float z) { return z / (1.0f + __expf(-z)); }
#define XB_TMO      128
#define XB_XCNT(j)  (256  + 64 * (j))
#define XB_XSUB(j)  (1280 + 64 * (j))
#define XB_XGEN(j)  (2304 + 64 * (j))
#define XB_TOP      3328
#define XB_TOPGEN   3392
#define XCD_BAR_WORDS 3456
#define XB_SPIN_CAP (1u << 22)

__device__ __forceinline__ unsigned xb_ld(unsigned* p)              { return __hip_atomic_load(p, __ATOMIC_RELAXED, __HIP_MEMORY_SCOPE_AGENT); }
__device__ __forceinline__ unsigned xb_add(unsigned* p, unsigned v) { return __hip_atomic_fetch_add(p, v, __ATOMIC_RELAXED, __HIP_MEMORY_SCOPE_AGENT); }
__device__ __forceinline__ unsigned xb_xcc_id() { return (unsigned)__builtin_amdgcn_s_getreg((3 << 11) | 20) & 0xFu; }
#define XB_SPIN(cond, bar) do { unsigned _sp = 0; while (cond) { __builtin_amdgcn_s_sleep(1); \
    if ((++_sp & 255u) == 0u) { if (xb_ld(&(bar)[XB_TMO])) break; if (_sp > XB_SPIN_CAP) { atomicAdd(&(bar)[XB_TMO], 1u); break; } } } } while (0)

struct XcdBarrier {
    unsigned* bar; unsigned x;
    volatile LAS unsigned* st;
};

__device__ __forceinline__ XcdBarrier xcd_barrier_post(unsigned* bar, volatile LAS unsigned* st) {
    XcdBarrier b; b.bar = bar; b.x = xb_xcc_id(); b.st = st;
    if (threadIdx.x == 0) (void)xb_add(&bar[XB_XCNT(b.x)], 1u);
    return b;
}
__device__ __forceinline__ void xcd_barrier_complete(unsigned* bar, unsigned x, unsigned& nloc, unsigned& nx) {
    const unsigned G = gridDim.x * gridDim.y * gridDim.z;
    unsigned sum, cnt, mine, sp = 0u;
    for (;;) {
        sum = 0u; cnt = 0u; mine = 0u;
#pragma unroll
        for (unsigned j = 0; j < 16; ++j) { const unsigned c = xb_ld(&bar[XB_XCNT(j)]); sum += c; cnt += (c > 0u) ? 1u : 0u; mine = (j == x) ? c : mine; }
        if (sum == G) break;
        __builtin_amdgcn_s_sleep(1);
        if ((++sp & 255u) == 0u) { if (xb_ld(&bar[XB_TMO])) break; if (sp > XB_SPIN_CAP) { atomicAdd(&bar[XB_TMO], 1u); break; } }
    }
    nloc = mine > 0u ? mine : 1u; nx = cnt > 0u ? cnt : 1u;
}

__device__ __forceinline__ void xcd_barrier(const XcdBarrier& b) {
    asm volatile("s_waitcnt vmcnt(0)" ::: "memory");
    __syncthreads();
    if (threadIdx.x == 0) {
        unsigned* bar = b.bar;
        __builtin_amdgcn_s_waitcnt(0);
        unsigned nloc = b.st[0], nx = b.st[1];
        if (nloc == 0u) { xcd_barrier_complete(bar, b.x, nloc, nx); b.st[0] = nloc; b.st[1] = nx; }
        const unsigned old = xb_add(&bar[XB_XSUB(b.x)], 1u);
        const unsigned gen = old / nloc;
        if (old + 1u == (gen + 1u) * nloc) {
            __builtin_amdgcn_fence(__ATOMIC_RELEASE, "agent");
            asm volatile("s_waitcnt vmcnt(0)" ::: "memory");
            const unsigned og = xb_add(&bar[XB_TOP], 1u);
            const unsigned tg = og / nx;
            if (og + 1u == (tg + 1u) * nx) xb_add(&bar[XB_TOPGEN], 1u);
            else XB_SPIN(xb_ld(&bar[XB_TOPGEN]) == tg, bar);
            __builtin_amdgcn_fence(__ATOMIC_ACQUIRE, "agent");
            xb_add(&bar[XB_XGEN(b.x)], 1u);
            asm volatile("s_waitcnt vmcnt(0)" ::: "memory");
        } else {
            XB_SPIN(xb_ld(&bar[XB_XGEN(b.x)]) == gen, bar);
            __builtin_amdgcn_fence(__ATOMIC_ACQUIRE, "agent");
            asm volatile("s_waitcnt vmcnt(0)" ::: "memory");
        }
    }
    __syncthreads();
}
struct Args { const float* in[34]; float* out; unsigned char* ws; int ph_lo, ph_hi; };
#define CAS __attribute__((address_space(4)))
struct KA {
    const CAS unsigned char* p;
    __device__ __forceinline__ const float* I(int i) const { return *(const float* const CAS*)(p + 8 * i); }
    __device__ __forceinline__ float* OUT() const { return *(float* const CAS*)(p + 8 * 34); }
    __device__ __forceinline__ unsigned char* WS() const { return *(unsigned char* const CAS*)(p + 8 * 35); }
    __device__ __forceinline__ int LO() const { return *(const CAS int*)(p + 8 * 36); }
    __device__ __forceinline__ int HI() const { return *(const CAS int*)(p + 8 * 36 + 4); }
};
__device__ __forceinline__ KA ka_fresh() { KA a; a.p = (const CAS unsigned char*)__builtin_amdgcn_kernarg_segment_ptr(); asm volatile("" : "+s"(a.p)); return a; }
static_assert(sizeof(Args) == 8 * 36 + 8, "kernarg layout");
struct Frame {
    LAS unsigned char* lds;
    volatile LAS unsigned* MISC;
    unsigned* ctl;
    int tid, lane, wave, vcu, G;
};
enum { I_X = 0, I_C, I_CTX, I_CCTX, I_ADAW, I_ADAB, I_N1G, I_N2G, I_ABWIN, I_ABWOUT, I_GLAWA, I_GLABA, I_GLANG, I_LAMRE, I_LAMIM, I_LOGSTEP, I_BRE, I_BIM, I_CRE, I_CIM,
       I_S5D, I_GLUW, I_GLUB, I_RETWIN, I_RETWOUT, I_RETDEC, I_RETNG, I_WROUTER, I_BROUTER, I_WGU, I_BGU, I_WDN, I_BDN, I_FNG };

constexpr int S5_ROWS = 2304, S5_CH = 272;
struct S5Par { float lr, li, step; };
__device__ __forceinline__ void s5_cpow(float lr, float li, float step, float n, float& ar, float& ai) { const float mag = expf(lr * step * n); float s, c; sincosf(li * step * n, &s, &c); ar = mag * c; ai = mag * s; }
__device__ __forceinline__ void s5_zoh_f(float lr, float li, float step, float& fr, float& fi) { float ar, ai; s5_cpow(lr, li, step, 1.0f, ar, ai); const float den = lr * lr + li * li;
    fr = ((ar - 1.0f) * lr + ai * li) / den; fi = (ai * lr - (ar - 1.0f) * li) / den; }
__device__ __forceinline__ void s5_table_item(const KA& A, int kind, int idx, bf16* W1T, bf16* W2T, LAS float* scr, int lane) {
    if (kind == 0) {
        const int g = idx >> 8, n = idx & 255, dir = n >> 7, ri = (n >> 6) & 1, p = n & 63;
        const float lr = A.I(I_LAMRE)[(dir * 32 + g) * 64 + p], li = A.I(I_LAMIM)[(dir * 32 + g) * 64 + p], step = expf(A.I(I_LOGSTEP)[dir * 32 + g]);
        float fr, fi; s5_zoh_f(lr, li, step, fr, fi);
        const int t = lane >> 2, c0 = (lane & 3) * 4;
        float ar, ai; s5_cpow(lr, li, step, (float)(dir ? t : 15 - t), ar, ai);
        const float gr = ar * fr - ai * fi, gi = ar * fi + ai * fr;
        float o[4];
#pragma unroll
        for (int j = 0; j < 4; ++j) { const float br = A.I(I_BRE)[(g * 64 + p) * 16 + c0 + j], bi = A.I(I_BIM)[(g * 64 + p) * 16 + c0 + j]; o[j] = ri ? (gr * bi + gi * br) : (gr * br - gi * bi); }
        v2u w; w.x = pk2(o[0], o[1]); w.y = pk2(o[2], o[3]);
        *(GAS v2u*)(W1T + ((size_t)g * 256 + n) * 256 + 4 * lane) = w;
    } else if (kind == 1) {
        const int g = idx >> 8, n = idx & 255, t = n >> 4, cp = n & 15;
        const int dir = lane >> 5, ri = (lane >> 4) & 1, p0 = (lane & 15) * 4;
        const float step = expf(A.I(I_LOGSTEP)[dir * 32 + g]);
        float o[4];
#pragma unroll
        for (int j = 0; j < 4; ++j) { const int p = p0 + j;
            const float lr = A.I(I_LAMRE)[(dir * 32 + g) * 64 + p], li = A.I(I_LAMIM)[(dir * 32 + g) * 64 + p];
            float ar, ai; s5_cpow(lr, li, step, (float)(dir ? 16 - t : t + 1), ar, ai);
            const float cr = A.I(I_CRE)[((dir * 32 + g) * 16 + cp) * 64 + p], ci = A.I(I_CIM)[((dir * 32 + g) * 16 + cp) * 64 + p];
            o[j] = ri ? -(cr * ai + ci * ar) : (cr * ar - ci * ai); }
        v2u w; w.x = pk2(o[0], o[1]); w.y = pk2(o[2], o[3]);
        *(GAS v2u*)(W2T + ((size_t)g * 256 + n) * 512 + 256 + 4 * lane) = w;
    } else {
        const int g = idx >> 4, tau = idx & 15;
        {
#pragma unroll
            for (int dir = 0; dir < 2; ++dir) { const float lr = A.I(I_LAMRE)[(dir * 32 + g) * 64 + lane], li = A.I(I_LAMIM)[(dir * 32 + g) * 64 + lane], step = expf(A.I(I_LOGSTEP)[dir * 32 + g]);
                float fr, fi, ar, ai; s5_zoh_f(lr, li, step, fr, fi); s5_cpow(lr, li, step, (float)tau, ar, ai);
                scr[(dir * 64 + lane) * 2] = ar * fr - ai * fi; scr[(dir * 64 + lane) * 2 + 1] = ar * fi + ai * fr; }
        }
        LDS_WAIT(); asm volatile("" ::: "memory");
        const int cp = lane >> 2, c0 = (lane & 3) * 4;
        float kf[4] = {0.f, 0.f, 0.f, 0.f}, kb2[4] = {0.f, 0.f, 0.f, 0.f};
        for (int p = 0; p < 64; ++p) {
            const f32x4 b4r = *(const f32x4*)(A.I(I_BRE) + (g * 64 + p) * 16 + c0), b4i = *(const f32x4*)(A.I(I_BIM) + (g * 64 + p) * 16 + c0);
#pragma unroll
            for (int dir = 0; dir < 2; ++dir) { const float gr = scr[(dir * 64 + p) * 2], gi = scr[(dir * 64 + p) * 2 + 1];
                const float cr = A.I(I_CRE)[((dir * 32 + g) * 16 + cp) * 64 + p], ci = A.I(I_CIM)[((dir * 32 + g) * 16 + cp) * 64 + p];
#pragma unroll
                for (int j = 0; j < 4; ++j) { const float xr = gr * b4r[j] - gi * b4i[j], xi = gr * b4i[j] + gi * b4r[j]; const float v = cr * xr - ci * xi;
                    if (dir == 0) kf[j] += v; else kb2[j] += v; } }
        }
        LDS_WAIT(); asm volatile("" ::: "memory");
        bf16* Wg = W2T + (size_t)g * 256 * 512;
        if (tau == 0) { v2u w; w.x = pk2(kf[0] + kb2[0], kf[1] + kb2[1]); w.y = pk2(kf[2] + kb2[2], kf[3] + kb2[3]);
            for (int t = 0; t < 16; ++t) *(GAS v2u*)(Wg + (size_t)(t * 16 + cp) * 512 + t * 16 + c0) = w;
        } else { v2u wf, wb; wf.x = pk2(kf[0], kf[1]); wf.y = pk2(kf[2], kf[3]); wb.x = pk2(kb2[0], kb2[1]); wb.y = pk2(kb2[2], kb2[3]);
            for (int t = tau; t < 16; ++t) *(GAS v2u*)(Wg + (size_t)(t * 16 + cp) * 512 + (t - tau) * 16 + c0) = wf;
            for (int t = 0; t + tau < 16; ++t) *(GAS v2u*)(Wg + (size_t)(t * 16 + cp) * 512 + (t + tau) * 16 + c0) = wb; }
    }
}
__device__ __forceinline__ void p_s5_scan(Frame& F, const float* SLOC, bf16* A2) {
    const KA A = ka_fresh();
    if (F.tid >= 128) return;
    for (int idx = F.vcu * 128 + F.tid; idx < NB * 32 * 2 * 64; idx += F.G * 128) {
        const int p = idx & 63, dir = (idx >> 6) & 1, g = (idx >> 7) & 31, b = idx >> 12;
        const float lr = A.I(I_LAMRE)[(dir * 32 + g) * 64 + p], li = A.I(I_LAMIM)[(dir * 32 + g) * 64 + p], step = expf(A.I(I_LOGSTEP)[dir * 32 + g]);
        float ar, ai; s5_cpow(lr, li, step, 16.0f, ar, ai);
        float sr = 0.f, si = 0.f;
        const size_t rbase = (size_t)g * S5_ROWS + (size_t)b * S5_CH;
        for (int q0 = 0; q0 < S5_CH; q0 += 16) {
            float lre[16], lim[16];
#pragma unroll
            for (int u = 0; u < 16; ++u) { const int q = q0 + u, n = dir ? (q < 16 ? 15 - q : 271 - (q - 16)) : q; const float* sp = SLOC + (rbase + n) * 256 + dir * 128 + p; lre[u] = sp[0]; lim[u] = sp[64]; }
#pragma unroll
            for (int u = 0; u < 16; ++u) { const int q = q0 + u, n = dir ? (q < 16 ? 15 - q : 271 - (q - 16)) : q; bf16* ap = A2 + (rbase + n) * 512 + 256 + dir * 128 + p;
                ap[0] = (bf16)f2bf(sr); ap[64] = (bf16)f2bf(si);
                const float nr = ar * sr - ai * si + lre[u], ni = ar * si + ai * sr + lim[u]; sr = nr; si = ni; }
        }
    }
}
__device__ __forceinline__ void tr_item(const float* src, int ldsrc, int K, int srccol, float scale, bf16* dst, int dstrow0, int k0, LAS float* scr, int lane) {
    if (srccol >= 0) {
        float t[32]; const float* sp = src + (size_t)(k0 + (lane >> 5)) * ldsrc + srccol + (lane & 31);
#pragma unroll
        for (int i = 0; i < 32; ++i) t[i] = sp[(size_t)(2 * i) * ldsrc];
#pragma unroll
        for (int i = 0; i < 32; ++i) scr[(2 * i + (lane >> 5)) * 33 + (lane & 31)] = t[i] * scale;
    } else {
#pragma unroll 8
        for (int i = 0; i < 32; ++i) { const int kk = 2 * i + (lane >> 5); scr[kk * 33 + (lane & 31)] = 0.f; }
    }
    LDS_WAIT(); asm volatile("" ::: "memory");
    const int c = lane & 7;
#pragma unroll
    for (int j = 0; j < 4; ++j) { const int n = (lane >> 3) + 8 * j; const LAS float* s = scr + (8 * c) * 33 + n;
        v4u o; o.x = pk2(s[0 * 33], s[1 * 33]); o.y = pk2(s[2 * 33], s[3 * 33]); o.z = pk2(s[4 * 33], s[5 * 33]); o.w = pk2(s[6 * 33], s[7 * 33]);
        *(GAS v4u*)(dst + (size_t)(dstrow0 + n) * K + k0 + 8 * c) = o; }
    LDS_WAIT(); asm volatile("" ::: "memory");
}
__device__ __forceinline__ void p0_prologue(Frame& F) {
    const KA A = ka_fresh();
    unsigned char* ws = A.WS();
    LAS float* scr = (LAS float*)(F.lds + F.wave * 8704);
    LAS float* sl = (LAS float*)(F.lds + 69632);
    for (int idx = F.tid; idx < 9 * 1024; idx += NTHR) { const int b = idx >> 10, k = idx & 1023; const float cv = b < 8 ? A.I(I_C)[b * 1024 + k] : A.I(I_CCTX)[k]; sl[k * 12 + b] = silu_(cv); }
    __syncthreads();
    const int gw = F.vcu * NWAVES + F.wave, NGW = F.G * NWAVES, lane = F.lane;
    for (int m = F.vcu; m < 192; m += F.G) {
        const int layer = m / 96, col = (m % 96) * 64 + lane;
        const float* w = A.I(I_ADAW) + (size_t)layer * 1024 * 6144 + (size_t)(F.wave * 128) * 6144 + col;
        float acc[9];
#pragma unroll
        for (int b = 0; b < 9; ++b) acc[b] = 0.f;
        for (int k0 = 0; k0 < 128; k0 += 16) {
            float wv[16];
#pragma unroll
            for (int u = 0; u < 16; ++u) wv[u] = w[(size_t)(k0 + u) * 6144];
#pragma unroll
            for (int u = 0; u < 16; ++u) {
#pragma unroll
                for (int b = 0; b < 9; ++b) acc[b] += sl[(F.wave * 128 + k0 + u) * 12 + b] * wv[u]; }
        }
        LAS float* red = (LAS float*)(F.lds);
#pragma unroll
        for (int b = 0; b < 9; ++b) red[(F.wave * 9 + b) * 64 + lane] = acc[b];
        __syncthreads();
        for (int idx = F.tid; idx < 9 * 64; idx += NTHR) { const int b = idx >> 6, l = idx & 63; float s = 0.f;
#pragma unroll
            for (int wv2 = 0; wv2 < 8; ++wv2) s += red[(wv2 * 9 + b) * 64 + l];
            const int c2 = (m % 96) * 64 + l;
            ((float*)(ws + WS_MOD))[(size_t)layer * 9 * 6144 + b * 6144 + c2] = s + A.I(I_ADAB)[layer * 6144 + c2]; }
        __syncthreads();
    }
    constexpr int I_S5A = 8192, I_S5B = 8192, I_S5C = 512, I_IN0 = 1152, I_OUT0 = 512, I_GLU = 128, I_IN1 = 3072, I_OUT1 = 1024, I_GU = 65536, I_DN = 32768;
    constexpr int NITEMS = I_S5A + I_S5B + I_S5C + I_IN0 + I_OUT0 + I_GLU + I_IN1 + I_OUT1 + I_GU + I_DN;
    for (int it = gw; it < NITEMS; it += NGW) {
        int r = it;
        if (r < I_S5A) { s5_table_item(A, 0, r, (bf16*)(ws + WS_S5W1), (bf16*)(ws + WS_S5W2), scr, lane); continue; }
        r -= I_S5A;
        if (r < I_S5B) { s5_table_item(A, 1, r, (bf16*)(ws + WS_S5W1), (bf16*)(ws + WS_S5W2), scr, lane); continue; }
        r -= I_S5B;
        if (r < I_S5C) { s5_table_item(A, 2, r, (bf16*)(ws + WS_S5W1), (bf16*)(ws + WS_S5W2), scr, lane); continue; }
        r -= I_S5C;
        if (r < I_IN0) { const int kb = r / 72, n0 = (r % 72) * 32;
            const int sc = n0 < 1536 ? n0 : (n0 < 2048 ? n0 + 32 : (n0 == 2048 ? 1536 : -1));
            tr_item(A.I(I_ABWIN), 2080, 1024, sc, n0 < 256 ? 0.125f : 1.0f, (bf16*)(ws + WS_WIN0T), n0, kb * 64, scr, lane); continue; }
        r -= I_IN0;
        if (r < I_OUT0) { tr_item(A.I(I_ABWOUT), 1024, 1024, (r % 32) * 32, 1.0f, (bf16*)(ws + WS_WOUT0T), (r % 32) * 32, (r / 32) * 64, scr, lane); continue; }
        r -= I_OUT0;
        if (r < I_GLU) { tr_item(A.I(I_GLUW), 512, 512, (r % 16) * 32, 1.0f, (bf16*)(ws + WS_WGLUT), (r % 16) * 32, (r / 16) * 64, scr, lane); continue; }
        r -= I_GLU;
        if (r < I_IN1) { const int n0 = (r % 192) * 32;
            tr_item(A.I(I_RETWIN), 6144, 1024, n0, (n0 >= 1024 && n0 < 2048) ? 0.0625f : 1.0f, (bf16*)(ws + WS_WIN1T), n0, (r / 192) * 64, scr, lane); continue; }
        r -= I_IN1;
        if (r < I_OUT1) { tr_item(A.I(I_RETWOUT), 1024, 2048, (r % 32) * 32, 1.0f, (bf16*)(ws + WS_WOUT1T), (r % 32) * 32, (r / 32) * 64, scr, lane); continue; }
        r -= I_OUT1;
        if (r < I_GU) { const int mat = r >> 10, q = r & 1023, kb = q >> 6, n0 = (q & 63) * 32;
            const int pn = n0 >> 8, bj = (n0 >> 7) & 1, lc = n0 & 127;
            tr_item(A.I(I_WGU) + (size_t)mat * 1024 * 2048, 2048, 1024, bj * 1024 + pn * 128 + lc, 1.0f, (bf16*)(ws + WS_WGUT) + (size_t)mat * 2048 * 1024, n0, kb * 64, scr, lane); continue; }
        r -= I_GU;
        { const int mat = r >> 9, q = r & 511, kb = q >> 5, n0 = (q & 31) * 32;
          tr_item(A.I(I_WDN) + (size_t)mat * 1024 * 1024, 1024, 1024, n0, 1.0f, (bf16*)(ws + WS_WDNT) + (size_t)mat * 1024 * 1024, n0, kb * 64, scr, lane); }
    }
}
__device__ __forceinline__ void modnorm_store(const f32x4 (&v)[4], const float* g, const float* sc, const float* sh, bf16* hrow, int lane, f32x4 (&h)[4]) {
    float ss = 0.f;
#pragma unroll
    for (int j = 0; j < 4; ++j) ss += (v[j].x * v[j].x + v[j].y * v[j].y) + (v[j].z * v[j].z + v[j].w * v[j].w);
    const float r = rsqrtf(wave_sum(ss) * (1.0f / 1024.0f) + EPS);
#pragma unroll
    for (int j = 0; j < 4; ++j) { const int o = 64 * j + lane;
        const f32x4 gg = ((const f32x4*)g)[o], s4 = ((const f32x4*)sc)[o], h4 = ((const f32x4*)sh)[o];
        h[j] = v[j] * r * gg * (s4 + 1.0f) + h4;
        v2u w; w.x = pk2(h[j].x, h[j].y); w.y = pk2(h[j].z, h[j].w);
        ((GAS v2u*)hrow)[o] = w; }
}
__device__ __forceinline__ int bidx_of_row(int row) { return row < NCTX ? 8 : ((row - NCTX) >> 12); }
__device__ __forceinline__ void p_norm1_l0(Frame& F) {
    const KA A = ka_fresh();
    const int gw = F.vcu * NWAVES + F.wave, NGW = F.G * NWAVES, lane = F.lane;
    const float* mod = (const float*)(A.WS() + WS_MOD);
    bf16* H = (bf16*)(A.WS() + WS_H);
    for (int row = gw; row < MALL; row += NGW) {
        const float* xr = row < NCTX ? A.I(I_CTX) + (size_t)row * 1024 : A.I(I_X) + (size_t)(row - NCTX) * 1024;
        f32x4 v[4], h[4];
#pragma unroll
        for (int j = 0; j < 4; ++j) v[j] = ((const f32x4*)xr)[64 * j + lane];
        const float* m = mod + bidx_of_row(row) * 6144;
        modnorm_store(v, A.I(I_N1G), m + 1024, m, H + (size_t)row * 1024, lane, h);
    }
}
__device__ __forceinline__ int seq_row(int b, int dir, int s) {
    return s < CTX ? b * CTX + (dir ? CTX - 1 - s : s) : NCTX + b * SEQ + (dir ? SEQ - 1 - (s - CTX) : (s - CTX));
}
template <int DK, bool GLA>
__device__ __forceinline__ void rec_naive(Frame& F, const bf16* P, int ldp, int qc, int kc, int vc, int DV, int nvs,
                                          float* O, size_t odir_stride, int ldo, int orow0) {
    const KA A = ka_fresh();
    constexpr int KPW = DK / 8, TB = 16;
    LAS float* qs = (LAS float*)(F.lds);
    LAS float* ks = (LAS float*)(F.lds + 16384);
    LAS float* vv = (LAS float*)(F.lds + 32768);
    LAS float* dec = (LAS float*)(F.lds + 36864);
    LAS float* opart = (LAS float*)(F.lds + 40960);
    const int tid = F.tid, lane = F.lane, wave = F.wave;
    const int nitems = NB * 4 * 2 * nvs;
    for (int it = F.vcu; it < nitems; it += F.G) {
        const int vs = it % nvs, dir = (it / nvs) & 1, h = (it / (2 * nvs)) & 3, b = it / (8 * nvs);
        float gamma = 0.f;
        if (!GLA) { const float lg = A.I(I_RETDEC)[dir * 4 + h]; gamma = 1.0f / (1.0f + expf(-lg)); }
        float S[KPW];
#pragma unroll
        for (int i = 0; i < KPW; ++i) S[i] = 0.f;
        for (int s0 = 0; s0 < CTX + SEQ; s0 += TB) {
            for (int idx = tid; idx < TB * DK; idx += NTHR) { const int i = idx / DK, kk = idx % DK; const size_t rb = (size_t)seq_row(b, dir, s0 + i) * ldp;
                qs[idx] = bf2f(P[rb + qc + h * DK + kk]); ks[idx] = bf2f(P[rb + kc + h * DK + kk]); }
            for (int idx = tid; idx < TB * 64; idx += NTHR) { const int i = idx >> 6, c = idx & 63; const size_t rb = (size_t)seq_row(b, dir, s0 + i) * ldp;
                vv[idx] = bf2f(P[rb + vc + h * DV + vs * 64 + c]);
                if (GLA) { float z = A.I(I_GLABA)[dir * 256 + h * 64 + c];
#pragma unroll
                    for (int r = 0; r < 16; ++r) z += bf2f(P[rb + C0_LOW + dir * 16 + r]) * A.I(I_GLAWA)[(dir * 16 + r) * 256 + h * 64 + c];
                    const float ls = fminf(z, 0.f) - log1pf(expf(-fabsf(z)));
                    dec[idx] = expf(ls * (1.0f / 16.0f)); } }
            __syncthreads();
#pragma unroll 1
            for (int i = 0; i < TB; ++i) { const float vval = vv[i * 64 + lane]; float part = 0.f;
#pragma unroll
                for (int kk = 0; kk < KPW; ++kk) { const int kidx = wave * KPW + kk; const float d = GLA ? dec[i * 64 + kidx] : gamma;
                    S[kk] = d * S[kk] + ks[i * DK + kidx] * vval; part += qs[i * DK + kidx] * S[kk]; }
                opart[(i * 8 + wave) * 64 + lane] = part; }
            __syncthreads();
            for (int idx = tid; idx < TB * 64; idx += NTHR) { const int i = idx >> 6, c = idx & 63; float sum = 0.f;
#pragma unroll
                for (int w = 0; w < 8; ++w) sum += opart[(i * 8 + w) * 64 + c];
                const int row = seq_row(b, dir, s0 + i);
                if (row >= orow0) O[(size_t)dir * odir_stride + (size_t)(row - orow0) * ldo + h * DV + vs * 64 + c] = sum; }
        }
        __syncthreads();
    }
}
__device__ __forceinline__ void s5_naive(Frame& F, const bf16* P, float* Y  ) {
    const KA A = ka_fresh();
    const int lane = F.lane;
    if (F.wave >= 2) return;
    for (int chain = F.vcu * 2 + F.wave; chain < NB * 32 * 2; chain += F.G * 2) {
        const int dir = chain & 1, g = (chain >> 1) & 31, b = chain >> 6;
        const float step = expf(A.I(I_LOGSTEP)[dir * 32 + g]);
        const float lr = A.I(I_LAMRE)[(dir * 32 + g) * 64 + lane], li = A.I(I_LAMIM)[(dir * 32 + g) * 64 + lane];
        const float mag = expf(lr * step), lbr = mag * cosf(li * step), lbi = mag * sinf(li * step), den = lr * lr + li * li;
        const float fr = ((lbr - 1.0f) * lr + lbi * li) / den, fi = (lbi * lr - (lbr - 1.0f) * li) / den;
        float bbr[16], bbi[16], cr[16], ci[16];
#pragma unroll
        for (int c = 0; c < 16; ++c) { const float br = A.I(I_BRE)[(g * 64 + lane) * 16 + c], bi = A.I(I_BIM)[(g * 64 + lane) * 16 + c];
            bbr[c] = fr * br - fi * bi; bbi[c] = fr * bi + fi * br;
            cr[c] = A.I(I_CRE)[((dir * 32 + g) * 16 + c) * 64 + lane]; ci[c] = A.I(I_CIM)[((dir * 32 + g) * 16 + c) * 64 + lane]; }
        float sr = 0.f, si = 0.f;
        for (int s0 = 0; s0 < CTX + SEQ; s0 += 4) {
            v4u uu[4][2];
#pragma unroll
            for (int i = 0; i < 4; ++i) { const v4u* up = (const v4u*)(P + (size_t)seq_row(b, dir, s0 + i) * N0 + C0_U + g * 16); uu[i][0] = up[0]; uu[i][1] = up[1]; }
#pragma unroll
            for (int i = 0; i < 4; ++i) {
                float u[16];
#pragma unroll
                for (int q = 0; q < 2; ++q) { u[8 * q + 0] = blo(uu[i][q].x); u[8 * q + 1] = bhi(uu[i][q].x); u[8 * q + 2] = blo(uu[i][q].y); u[8 * q + 3] = bhi(uu[i][q].y);
                    u[8 * q + 4] = blo(uu[i][q].z); u[8 * q + 5] = bhi(uu[i][q].z); u[8 * q + 6] = blo(uu[i][q].w); u[8 * q + 7] = bhi(uu[i][q].w); }
                float br = 0.f, bi = 0.f;
#pragma unroll
                for (int c = 0; c < 16; ++c) { br += bbr[c] * u[c]; bi += bbi[c] * u[c]; }
                const float nr = lbr * sr - lbi * si + br, ni = lbr * si + lbi * sr + bi; sr = nr; si = ni;
                float v[16];
#pragma unroll
                for (int c = 0; c < 16; ++c) v[c] = cr[c] * sr - ci[c] * si;
                const bool b5 = (lane & 32) != 0, b4 = (lane & 16) != 0, b3 = (lane & 8) != 0, b2 = (lane & 4) != 0;
                float w8[8], w4[4], w2[2];
#pragma unroll
                for (int k = 0; k < 8; ++k) { const float send = b5 ? v[k] : v[k + 8], keep = b5 ? v[k + 8] : v[k]; w8[k] = keep + __shfl_xor(send, 32); }
#pragma unroll
                for (int k = 0; k < 4; ++k) { const float send = b4 ? w8[k] : w8[k + 4], keep = b4 ? w8[k + 4] : w8[k]; w4[k] = keep + __shfl_xor(send, 16); }
#pragma unroll
                for (int k = 0; k < 2; ++k) { const float send = b3 ? w4[k] : w4[k + 2], keep = b3 ? w4[k + 2] : w4[k]; w2[k] = keep + __shfl_xor(send, 8); }
                float w1; { const float send = b2 ? w2[0] : w2[1], keep = b2 ? w2[1] : w2[0]; w1 = keep + __shfl_xor(send, 4); }
                w1 += __shfl_xor(w1, 2); w1 += __shfl_xor(w1, 1);
                const int c = (b5 ? 8 : 0) + (b4 ? 4 : 0) + (b3 ? 2 : 0) + (b2 ? 1 : 0);
                if ((lane & 3) == 0) Y[(size_t)dir * MALL * 512 + (size_t)seq_row(b, dir, s0 + i) * 512 + g * 16 + c] = w1;
            }
        }
    }
}
__device__ __forceinline__ void unpack8(const v4u w, float (&f)[8]) { f[0] = blo(w.x); f[1] = bhi(w.x); f[2] = blo(w.y); f[3] = bhi(w.y); f[4] = blo(w.z); f[5] = bhi(w.z); f[6] = blo(w.w); f[7] = bhi(w.w); }
__device__ __forceinline__ v4u pack8(const float (&f)[8]) { v4u w; w.x = pk2(f[0], f[1]); w.y = pk2(f[2], f[3]); w.z = pk2(f[4], f[5]); w.w = pk2(f[6], f[7]); return w; }
__device__ __forceinline__ void p_finish0(Frame& F) {
    const KA A = ka_fresh();
    const int gw = F.vcu * NWAVES + F.wave, NGW = F.G * NWAVES, lane = F.lane, e0 = lane * 8;
    const bf16* P = (const bf16*)(A.WS() + WS_PROJ);
    const float* GO = (const float*)(A.WS() + WS_OREC);
    const float* SY = GO + (size_t)2 * MALL * 512;
    bf16* MIX = (bf16*)(A.WS() + WS_MIX); bf16* YP = (bf16*)(A.WS() + WS_YPRE);
    for (int row = gw; row < MALL; row += NGW) {
        float o[8], gg[8], ng[8];
#if MK_NAIVE_GLA
        { const f32x4* a = (const f32x4*)(GO + (size_t)row * 512 + e0); const f32x4* bq = (const f32x4*)(GO + (size_t)(MALL + row) * 512 + e0);
          const f32x4 a0 = a[0] + bq[0], a1 = a[1] + bq[1]; o[0] = a0.x; o[1] = a0.y; o[2] = a0.z; o[3] = a0.w; o[4] = a1.x; o[5] = a1.y; o[6] = a1.z; o[7] = a1.w; }
#else
        { const bf16* GO16 = (const bf16*)GO; float f0[8], f1[8]; unpack8(*(const v4u*)(GO16 + (size_t)row * 512 + e0), f0); unpack8(*(const v4u*)(GO16 + (size_t)(MALL + row) * 512 + e0), f1);
#pragma unroll
          for (int j = 0; j < 8; ++j) o[j] = f0[j] + f1[j]; }
#endif
        float ss = 0.f;
#pragma unroll
        for (int j = 0; j < 8; ++j) ss += o[j] * o[j];
        ss += __shfl_xor(ss, 1); ss += __shfl_xor(ss, 2); ss += __shfl_xor(ss, 4); ss += __shfl_xor(ss, 8);
        const float r = rsqrtf(ss * (1.0f / 128.0f) + EPS);
        unpack8(*(const v4u*)(P + (size_t)row * N0 + C0_G + e0), gg);
        { const f32x4* n4 = (const f32x4*)(A.I(I_GLANG) + (e0 & 127)); const f32x4 n0 = n4[0], n1 = n4[1]; ng[0] = n0.x; ng[1] = n0.y; ng[2] = n0.z; ng[3] = n0.w; ng[4] = n1.x; ng[5] = n1.y; ng[6] = n1.z; ng[7] = n1.w; }
        float res[8];
#pragma unroll
        for (int j = 0; j < 8; ++j) res[j] = o[j] * r * ng[j] * silu_(gg[j]);
        *(GAS v4u*)(MIX + (size_t)row * 1024 + e0) = pack8(res);
#if MK_NAIVE_S5
        float u[8], y[8];
        unpack8(*(const v4u*)(P + (size_t)row * N0 + C0_U + e0), u);
        { const f32x4* a = (const f32x4*)(SY + (size_t)row * 512 + e0); const f32x4* bq = (const f32x4*)(SY + (size_t)(MALL + row) * 512 + e0);
          const f32x4 a0 = a[0] + bq[0], a1 = a[1] + bq[1]; y[0] = a0.x; y[1] = a0.y; y[2] = a0.z; y[3] = a0.w; y[4] = a1.x; y[5] = a1.y; y[6] = a1.z; y[7] = a1.w; }
#pragma unroll
        for (int j = 0; j < 8; ++j) { const float t = y[j] + A.I(I_S5D)[e0 + j] * u[j]; res[j] = 0.5f * t * (1.0f + tanhf(0.7978845608f * (t + 0.044715f * t * t * t))); }
        *(GAS v4u*)(YP + (size_t)row * 512 + e0) = pack8(res);
#endif
    }
}
__device__ __forceinline__ void p_finish1(Frame& F) {
    const KA A = ka_fresh();
    const int gw = F.vcu * NWAVES + F.wave, NGW = F.G * NWAVES, lane = F.lane;
    const bf16* P = (const bf16*)(A.WS() + WS_PROJ);
    const float* RO = (const float*)(A.WS() + WS_OREC);
    bf16* MIX = (bf16*)(A.WS() + WS_MIX);
    for (int lrow = gw; lrow < NLAT; lrow += NGW) {
#pragma unroll 1
        for (int h = 0; h < 4; ++h) { const int e0 = h * 512 + lane * 8;
            float o[8], gg[8];
#if MK_NAIVE_RET
            { const f32x4* a = (const f32x4*)(RO + (size_t)lrow * 2048 + e0); const f32x4* bq = (const f32x4*)(RO + (size_t)(NLAT + lrow) * 2048 + e0);
              const f32x4 a0 = a[0] + bq[0], a1 = a[1] + bq[1]; o[0] = a0.x; o[1] = a0.y; o[2] = a0.z; o[3] = a0.w; o[4] = a1.x; o[5] = a1.y; o[6] = a1.z; o[7] = a1.w; }
#else
            { const bf16* RO16 = (const bf16*)RO; float f0[8], f1[8]; unpack8(*(const v4u*)(RO16 + (size_t)lrow * 2048 + e0), f0); unpack8(*(const v4u*)(RO16 + (size_t)(NLAT + lrow) * 2048 + e0), f1);
#pragma unroll
              for (int j = 0; j < 8; ++j) o[j] = f0[j] + f1[j]; }
#endif
            float s = 0.f;
#pragma unroll
            for (int j = 0; j < 8; ++j) s += o[j];
            const float mu = wave_sum(s) * (1.0f / 512.0f); float q = 0.f;
#pragma unroll
            for (int j = 0; j < 8; ++j) { o[j] -= mu; q += o[j] * o[j]; }
            const float r = rsqrtf(wave_sum(q) * (1.0f / 512.0f) + EPS);
            unpack8(*(const v4u*)(P + (size_t)(NCTX + lrow) * N1 + C1_G + e0), gg);
            float res[8];
#pragma unroll
            for (int j = 0; j < 8; ++j) res[j] = o[j] * r * A.I(I_RETNG)[e0 + j] * silu_(gg[j]);
            *(GAS v4u*)(MIX + (size_t)lrow * 2048 + e0) = pack8(res); }
    }
}
__device__ __forceinline__ void p_rope(Frame& F) {
    const KA A = ka_fresh();
    const int gw = F.vcu * NWAVES + F.wave, NGW = F.G * NWAVES, lane = F.lane;
    bf16* P = (bf16*)(A.WS() + WS_PROJ);
    LAS float* ct = (LAS float*)F.lds;
    LAS float* st = ct + 4096;
    for (int i = F.tid; i < 4096; i += NTHR) { const int pos = i >> 6, fi = i & 63; float sn, cs; sincosf((float)pos * expf(-(float)fi * (9.210340371976184f / 64.0f)), &sn, &cs); ct[i] = cs; st[i] = sn; }
    __syncthreads();
    for (int lrow = gw; lrow < NLAT; lrow += NGW) {
        const int t = lrow & (SEQ - 1), pr = t >> 6, pc = t & 63;
        bf16* rp = P + (size_t)(NCTX + lrow) * N1;
        v4u a[2], b2[2]; int off[2], pos[2], f0[2];
#pragma unroll
        for (int q = 0; q < 2; ++q) { const int task = lane + 64 * q, tens = task >> 4, half = (task >> 3) & 1, ch = task & 7;
            off[q] = tens * 256 + half * 128 + ch * 8; pos[q] = half ? pc : pr; f0[q] = ch * 8;
            a[q] = *(const v4u*)(rp + off[q]); b2[q] = *(const v4u*)(rp + off[q] + 64); }
#pragma unroll
        for (int q = 0; q < 2; ++q) { float x[8], y[8], xo[8], yo[8]; unpack8(a[q], x); unpack8(b2[q], y);
            const f32x4 c0 = *(const LAS f32x4*)(ct + pos[q] * 64 + f0[q]), c1 = *(const LAS f32x4*)(ct + pos[q] * 64 + f0[q] + 4), s0 = *(const LAS f32x4*)(st + pos[q] * 64 + f0[q]), s1 = *(const LAS f32x4*)(st + pos[q] * 64 + f0[q] + 4);
#pragma unroll
            for (int j = 0; j < 8; ++j) { const float cs = j < 4 ? c0[j & 3] : c1[j & 3], sn = j < 4 ? s0[j & 3] : s1[j & 3]; xo[j] = x[j] * cs - y[j] * sn; yo[j] = x[j] * sn + y[j] * cs; }
            *(GAS v4u*)(rp + off[q]) = pack8(xo); *(GAS v4u*)(rp + off[q] + 64) = pack8(yo); }
    }
}
__device__ __forceinline__ void p_router(Frame& F, int layer) {
    const KA A = ka_fresh();
    const int tid = F.tid, lane = F.lane, wave = F.wave;
    const int moe_row0 = layer ? NCTX : 0, NTOK = layer ? NLAT : MALL;
    const int RPB = (NTOK + F.G - 1) / F.G;
    unsigned char* ws = A.WS();
    int* prow = (int*)(ws + WS_PROW); int* sel_e = (int*)(ws + WS_SELE); float* w_slot = (float*)(ws + WS_WSLOT); int* slot_pos = (int*)(ws + WS_SPOS);
    LAS float* Wt = (LAS float*)F.lds;
    LAS int* lcnt = (LAS int*)(F.lds + L_LCNT); LAS int* gbase = (LAS int*)(F.lds + L_GBASE);
    LAS int* blk_e = (LAS int*)(F.lds + L_BLKE); LAS int* blk_p = (LAS int*)(F.lds + L_BLKP);
    const float* wr = A.I(I_WROUTER) + (size_t)layer * 1024 * 32;
    for (int idx = tid; idx < 32768; idx += NTHR) Wt[(idx & 31) * 1024 + (idx >> 5)] = wr[idx];
    if (tid < 32) lcnt[tid] = 0;
    __syncthreads();
    const float* mod = (const float*)(ws + WS_MOD) + (size_t)layer * 9 * 6144;
    const bf16* XR = (const bf16*)(ws + WS_XRES); bf16* H = (bf16*)(ws + WS_H);
    const int tok0 = F.vcu * RPB;
    for (int lr = wave; lr < RPB; lr += NWAVES) {
        const int tok = tok0 + lr; if (tok >= NTOK) break;
        const int row = moe_row0 + tok;
        f32x4 v[4], h[4];
#pragma unroll
        for (int j = 0; j < 4; ++j) { const v2u xw = ((const v2u*)(XR + (size_t)row * 1024))[64 * j + lane]; v[j] = (f32x4){blo(xw.x), bhi(xw.x), blo(xw.y), bhi(xw.y)}; }
        const float* m = mod + bidx_of_row(row) * 6144;
        modnorm_store(v, A.I(I_N2G) + layer * 1024, m + 4096, m + 3072, H + (size_t)row * 1024, lane, h);
        float pa[32];
#pragma unroll
        for (int e = 0; e < 32; ++e) { float a = 0.f;
#pragma unroll
            for (int j = 0; j < 4; ++j) { const f32x4 w4 = *(const LAS f32x4*)(Wt + e * 1024 + 4 * (64 * j + lane)); a += (h[j].x * w4.x + h[j].y * w4.y) + (h[j].z * w4.z + h[j].w * w4.w); }
            pa[e] = a; }
        float myl;
        { const bool b5 = (lane & 32) != 0, b4 = (lane & 16) != 0, b3 = (lane & 8) != 0, b2 = (lane & 4) != 0, b1 = (lane & 2) != 0;
          float w16[16], w8[8], w4[4], w2[2];
#pragma unroll
          for (int k = 0; k < 16; ++k) { const float send = b5 ? pa[k] : pa[k + 16], keep = b5 ? pa[k + 16] : pa[k]; w16[k] = keep + __shfl_xor(send, 32); }
#pragma unroll
          for (int k = 0; k < 8; ++k) { const float send = b4 ? w16[k] : w16[k + 8], keep = b4 ? w16[k + 8] : w16[k]; w8[k] = keep + __shfl_xor(send, 16); }
#pragma unroll
          for (int k = 0; k < 4; ++k) { const float send = b3 ? w8[k] : w8[k + 4], keep = b3 ? w8[k + 4] : w8[k]; w4[k] = keep + __shfl_xor(send, 8); }
#pragma unroll
          for (int k = 0; k < 2; ++k) { const float send = b2 ? w4[k] : w4[k + 2], keep = b2 ? w4[k + 2] : w4[k]; w2[k] = keep + __shfl_xor(send, 4); }
          { const float send = b1 ? w2[0] : w2[1], keep = b1 ? w2[1] : w2[0]; myl = keep + __shfl_xor(send, 2); }
          myl += __shfl_xor(myl, 1); }
        const int mye = lane >> 1;
        myl += A.I(I_BROUTER)[layer * 32 + mye];
        float bv[4]; int bi[4];
#pragma unroll
        for (int r = 0; r < 4; ++r) { float v = myl; int id = mye;
#pragma unroll
            for (int o = 1; o < 64; o <<= 1) { const float ov = __shfl_xor(v, o); const int oi = __shfl_xor(id, o); const bool take = ov > v || (ov == v && oi < id); v = take ? ov : v; id = take ? oi : id; }
            bv[r] = v; bi[r] = id; myl = (mye == id) ? -INFINITY : myl; }
        const float e1 = __expf(bv[1] - bv[0]), e2 = __expf(bv[2] - bv[0]), e3 = __expf(bv[3] - bv[0]), inv = 1.0f / (1.0f + e1 + e2 + e3);
        if (lane < 4) { const int ee = lane == 0 ? bi[0] : (lane == 1 ? bi[1] : (lane == 2 ? bi[2] : bi[3]));
            const float wv = (lane == 0 ? 1.0f : (lane == 1 ? e1 : (lane == 2 ? e2 : e3))) * inv;
            sel_e[tok * 4 + lane] = ee; w_slot[tok * 4 + lane] = wv;
            const int lp = __hip_atomic_fetch_add(lcnt + ee, 1, __ATOMIC_RELAXED, __HIP_MEMORY_SCOPE_WORKGROUP);
            blk_e[lr * 4 + lane] = ee; blk_p[lr * 4 + lane] = lp; }
    }
    __syncthreads();
    if (tid < 32) gbase[tid] = (int)__hip_atomic_fetch_add(F.ctl + CW_GCNT + 64 * layer + tid, (unsigned)lcnt[tid], RLX_AGENT);
    __syncthreads();
    int* elist = (int*)(ws + WS_ELIST);
    for (int idx = tid; idx < RPB * 4; idx += NTHR) { const int tok = tok0 + (idx >> 2); if (tok < NTOK) { const int e = blk_e[idx]; elist[(size_t)e * MALL + gbase[e] + blk_p[idx]] = tok * 4 + (idx & 3); } }
}
__device__ __forceinline__ int moe_tables(Frame& F, int layer) {
    LAS int* ts = (LAS int*)(F.lds + L_TSTART); LAS unsigned char* te = (LAS unsigned char*)(F.lds + L_TILEE);
    __syncthreads();
    if (F.tid == 0) { int acc = 0;
        for (int e = 0; e < 32; ++e) { ts[e] = acc; acc += ((int)__hip_atomic_load(F.ctl + CW_GCNT + 64 * layer + e, RLX_AGENT) + 255) >> 8; }
        ts[32] = acc > MAXTILES ? MAXTILES : acc; }
    __syncthreads();
    const int nt = ts[32];
    LAS int* tpos = (LAS int*)(F.lds + L_TPOS); LAS int* tcnt = (LAS int*)(F.lds + L_TCNT);
    for (int T = F.tid; T < nt; T += NTHR) { int e = 0;
        for (int q = 1; q < 32; ++q) e = (T >= ts[q]) ? q : e;
        te[T] = (unsigned char)e; tpos[T] = (T - ts[e]) * 256; tcnt[T] = (int)__hip_atomic_load(F.ctl + CW_GCNT + 64 * layer + e, RLX_AGENT); }
    __syncthreads();
    return nt;
}
__device__ __forceinline__ void p_combine(Frame& F, int layer, bool dry) {
    const KA A = ka_fresh();
    const int gw = F.vcu * NWAVES + F.wave, NGW = F.G * NWAVES, lane = F.lane;
    const int moe_row0 = layer ? NCTX : 0, NTOK = layer ? NLAT : MALL;
    unsigned char* ws = A.WS();
    const bf16* XR = (const bf16*)(ws + WS_XRES); bf16* XW = dry ? (bf16*)(ws + WS_PROJ) : (bf16*)(ws + WS_XRES); bf16* H = dry ? (bf16*)(ws + WS_PROJ + 160 * MiB) : (bf16*)(ws + WS_H); const bf16* YS = (const bf16*)(ws + WS_YSLOT);
    float* OUTP = dry ? (float*)(ws + WS_PROJ) : A.OUT();
    const float* mod = (const float*)(ws + WS_MOD);
    float palpha = 1.0f;
#if defined(MK_PROBE) && MK_PROBE >= 0
    {
      const unsigned* st = F.ctl + 20000 + 2 * MK_PROBE;
      const unsigned long long t0 = ((unsigned long long)__hip_atomic_load(st + 1, RLX_AGENT) << 32) | __hip_atomic_load(st, RLX_AGENT), t1 = ((unsigned long long)__hip_atomic_load(st + 3, RLX_AGENT) << 32) | __hip_atomic_load(st + 2, RLX_AGENT);
      palpha = 1.0f + exp2f((float)(t1 - t0) * 0.01f * 0.01f * 3.321928095f); }
#endif
    for (int tok = gw; tok < NTOK; tok += NGW) {
        const int row = moe_row0 + tok, bidx = bidx_of_row(row);
        const float* g2 = mod + (size_t)layer * 9 * 6144 + bidx * 6144 + 5120;
        f32x4 v[4];
#pragma unroll
        for (int j = 0; j < 4; ++j) { const int o = 64 * j + lane; f32x4 y = (f32x4){0.f, 0.f, 0.f, 0.f};
#pragma unroll
            for (int k = 0; k < 4; ++k) { const v2u w = ((const v2u*)(YS + (size_t)(tok * 4 + k) * 1024))[o]; y += (f32x4){blo(w.x), bhi(w.x), blo(w.y), bhi(w.y)}; }
            const v2u xw = ((const v2u*)(XR + (size_t)row * 1024))[o];
            v[j] = (f32x4){blo(xw.x), bhi(xw.x), blo(xw.y), bhi(xw.y)} + ((const f32x4*)g2)[o] * y; }
        if (layer == 0) {
#pragma unroll
            for (int j = 0; j < 4; ++j) { v2u w; w.x = pk2(v[j].x, v[j].y); w.y = pk2(v[j].z, v[j].w); ((GAS v2u*)(XW + (size_t)row * 1024))[64 * j + lane] = w; }
            const float* m1 = mod + (size_t)9 * 6144 + bidx * 6144; f32x4 h[4];
            modnorm_store(v, A.I(I_N1G) + 1024, m1 + 1024, m1, H + (size_t)row * 1024, lane, h);
        } else {
            float ss = 0.f;
#pragma unroll
            for (int j = 0; j < 4; ++j) ss += (v[j].x * v[j].x + v[j].y * v[j].y) + (v[j].z * v[j].z + v[j].w * v[j].w);
            const float r = rsqrtf(wave_sum(ss) * (1.0f / 1024.0f) + EPS);
#pragma unroll
            for (int j = 0; j < 4; ++j) { const int o = 64 * j + lane; ((f32x4*)(OUTP + (size_t)tok * 1024))[o] = v[j] * (r * palpha) * ((const f32x4*)A.I(I_FNG))[o]; }
        }
    }
}
typedef short s16x4 __attribute__((ext_vector_type(4)));
typedef short bfx8 __attribute__((ext_vector_type(8)));
typedef short v4i16_t __attribute__((ext_vector_type(4)));
#define MFMA16(a, b, c) __builtin_amdgcn_mfma_f32_16x16x32_bf16((a), (b), (c), 0, 0, 0)
__device__ __forceinline__ bfx8 frag_n(const LAS unsigned char* tile, int stride, int r0, int k0, int lane) {
    return *(const LAS bfx8*)(tile + (r0 + (lane & 15)) * stride + (k0 + 8 * (lane >> 4)) * 2);
}
__device__ __forceinline__ bfx8 frag_t(const LAS unsigned char* tile, int stride, int k0, int n0, int lane) {
    const int g = lane >> 4, q = (lane & 15) >> 2, p = lane & 3;
    const LAS unsigned char* a = tile + (k0 + 8 * g + q) * stride + (n0 + 4 * p) * 2;
    const s16x4 lo = __builtin_bit_cast(s16x4, __builtin_amdgcn_ds_read_tr16_b64_v4i16((LAS v4i16_t*)a));
    const s16x4 hi = __builtin_bit_cast(s16x4, __builtin_amdgcn_ds_read_tr16_b64_v4i16((LAS v4i16_t*)(a + 4 * stride)));
    return __builtin_shufflevector(lo, hi, 0, 1, 2, 3, 4, 5, 6, 7);
}
__device__ __forceinline__ v4u scale8(const v4u w, float s) { float f[8]; unpack8(w, f);
#pragma unroll
    for (int j = 0; j < 8; ++j) f[j] *= s;
    return pack8(f); }

template <int DK, int DVS, bool GLA, bool INTRA = true>
__device__ __forceinline__ void rec_mfma(Frame& F, const bf16* Qsrc, const bf16* Ksrc, const bf16* K2src, size_t qdir_stride, int ldq, int qcol, int kcol,
                                         const bf16* Vsrc, int ldv, int vcol, int DV, const float* EB,
                                         bf16* O, size_t odir_stride, int ldo, int orow0) {
    const KA A = ka_fresh();
    constexpr int SQ = DK * 2 + 16, SV = DVS * 2 + 16, SP = 144, SS = DK * 2 + 16;
    constexpr int O_QD = 0, O_KI = O_QD + 64 * SQ, O_KS = O_KI + 64 * SQ, O_V = O_KS + (GLA ? 64 * SQ : 0), O_VD = O_V + 64 * SV, O_P = O_VD + (GLA ? 0 : 64 * SV), O_ST = O_P + 64 * SP, O_EB = O_ST + DVS * SS;
    static_assert(O_EB + DK * 4 <= RING_BYTES, "rec_mfma LDS");
    constexpr int NVS = 0;  (void)NVS;
    constexpr int VT_PER = DVS / 32, KT_PER = DK / 64, QCH = DK / 8  , QN = (64 * QCH) / NTHR, VCH = DVS / 8, KSTEPS = DK / 32;
    static_assert(QN >= 1 && VT_PER >= 1 && KT_PER >= 1, "shape");
    const LAS unsigned char* L = F.lds;
    const int tid = F.tid, lane = F.lane, w = F.wave, it = w & 3, vg = w >> 2, kg = w & 3, g4 = lane >> 4, l15 = lane & 15;
    const int nvs = DV / DVS, nitems = NB * 4 * 2 * nvs;
    for (int item = F.vcu; item < nitems; item += F.G) {
        const int vs = item % nvs, dir = (item / nvs) & 1, h = (item / (2 * nvs)) & 3, b = item / (8 * nvs);
        float lg2 = 0.f;
        if (!GLA) { const float lgt = A.I(I_RETDEC)[dir * 4 + h]; lg2 = -log2f(1.0f + expf(-lgt)); }
        const bf16* qb = Qsrc + (GLA ? (size_t)dir * qdir_stride : 0) + qcol + h * DK;
        const bf16* kb = Ksrc + (GLA ? (size_t)dir * qdir_stride : 0) + kcol + h * DK;
        const bf16* k2b = GLA ? K2src + (size_t)dir * qdir_stride + kcol + h * DK : kb;
        const bf16* vb = Vsrc + vcol + h * DV + vs * DVS;
        f32x4 Sacc[VT_PER][KT_PER];
#pragma unroll
        for (int a = 0; a < VT_PER; ++a)
#pragma unroll
            for (int c2 = 0; c2 < KT_PER; ++c2) Sacc[a][c2] = (f32x4){0.f, 0.f, 0.f, 0.f};
        for (int i = tid; i < DVS * SS / 4; i += NTHR) ((LAS unsigned*)(F.lds + O_ST))[i] = 0u;
        v4u rq[QN], rk[QN], rk2[GLA ? QN : 1], rv; float peb = 0.f;
        rv = (v4u){0u, 0u, 0u, 0u};
#define REC_LOAD(c) do { \
            const int rowc_ = seq_row(b, dir, 64 * (c));                   \
            _Pragma("unroll") for (int n = 0; n < QN; ++n) { const int pi = tid + NTHR * n, r = pi / QCH, ch = pi % QCH; const size_t ro = (size_t)(rowc_ + (dir ? -r : r)) * ldq + ch * 8; \
                rq[n] = *(const v4u*)(qb + ro); rk[n] = *(const v4u*)(kb + ro); if (GLA) rk2[n] = *(const v4u*)(k2b + ro); } \
            if (tid < 64 * VCH) { const int r = tid / VCH, ch = tid % VCH; rv = *(const v4u*)(vb + (size_t)(rowc_ + (dir ? -r : r)) * ldv + ch * 8); } \
            if (GLA && tid < DK) peb = EB[(((size_t)dir * NB + b) * 68 + (c)) * (4 * DK) + h * DK + tid]; } while (0)
        REC_LOAD(0);
        for (int c = 0; c < 68; ++c) {
#pragma unroll
            for (int n = 0; n < QN; ++n) { const int pi = tid + NTHR * n, r = pi / QCH, ch = pi % QCH;
                *(LAS v4u*)(F.lds + O_QD + r * SQ + ch * 16) = rq[n]; *(LAS v4u*)(F.lds + O_KI + r * SQ + ch * 16) = rk[n];
                if (GLA) *(LAS v4u*)(F.lds + O_KS + r * SQ + ch * 16) = rk2[n]; }
            if (tid < 64 * VCH) { const int r = tid / VCH, ch = tid % VCH;
                if (INTRA) *(LAS v4u*)(F.lds + O_V + r * SV + ch * 16) = rv;
                if (!GLA) *(LAS v4u*)(F.lds + O_VD + r * SV + ch * 16) = scale8(rv, __builtin_amdgcn_exp2f(lg2 * (float)(63 - r))); }
            if (GLA && tid < DK) ((LAS float*)(F.lds + O_EB))[tid] = peb;
            if (c + 1 < 68) REC_LOAD(c + 1);
            __syncthreads();
            if constexpr (INTRA) {
#pragma unroll
            for (int q2 = 0; q2 < 2; ++q2) { const int jt = 2 * vg + q2; f32x4 acc = (f32x4){0.f, 0.f, 0.f, 0.f};
                if (jt <= it) {
#pragma unroll
                    for (int ks = 0; ks < KSTEPS; ++ks) acc = MFMA16(frag_n(L + O_KI, SQ, 16 * jt, 32 * ks, lane), frag_n(L + O_QD, SQ, 16 * it, 32 * ks, lane), acc);
                    const int i = 16 * it + l15;
#pragma unroll
                    for (int r = 0; r < 4; ++r) { const int j = 16 * jt + 4 * g4 + r; float vv = (j <= i) ? acc[r] : 0.f; if (!GLA) vv *= __builtin_amdgcn_exp2f(lg2 * (float)(i - j)); acc[r] = vv; }
                }
                v2u pw; pw.x = pk2(acc[0], acc[1]); pw.y = pk2(acc[2], acc[3]);
                *(LAS v2u*)(F.lds + O_P + (16 * it + l15) * SP + (16 * jt + 4 * g4) * 2) = pw; }
            }
            f32x4 oacc[VT_PER];
            const bool need_o = INTRA || orow0 == 0 || c >= 4;
#pragma unroll
            for (int a = 0; a < VT_PER; ++a) { oacc[a] = (f32x4){0.f, 0.f, 0.f, 0.f};
                if (need_o)
#pragma unroll
                for (int ks = 0; ks < KSTEPS; ++ks) oacc[a] = MFMA16(frag_n(L + O_ST, SS, 16 * (vg * VT_PER + a), 32 * ks, lane), frag_n(L + O_QD, SQ, 16 * it, 32 * ks, lane), oacc[a]);
                if (!GLA) oacc[a] *= __builtin_amdgcn_exp2f(lg2 * (float)(16 * it + l15 + 1)); }
            if constexpr (INTRA) __syncthreads();
            { const int row = seq_row(b, dir, 64 * c + 16 * it + l15);
#pragma unroll
              for (int a = 0; a < VT_PER; ++a) { const int vt = vg * VT_PER + a;
                if constexpr (INTRA) {
#pragma unroll
                for (int js = 0; js < 2; ++js) oacc[a] = MFMA16(frag_t(L + O_V, SV, 32 * js, 16 * vt, lane), frag_n(L + O_P, SP, 16 * it, 32 * js, lane), oacc[a]); }
                if (row >= orow0) { v2u ow; ow.x = pk2(oacc[a][0], oacc[a][1]); ow.y = pk2(oacc[a][2], oacc[a][3]);
                    *(GAS v2u*)(O + (size_t)dir * odir_stride + (size_t)(row - orow0) * ldo + h * DV + vs * DVS + 16 * vt + 4 * g4) = ow; } } }
            { bfx8 fv[VT_PER][2];
#pragma unroll
              for (int a = 0; a < VT_PER; ++a)
#pragma unroll
                for (int js = 0; js < 2; ++js) fv[a][js] = frag_t(L + (GLA ? O_V : O_VD), SV, 32 * js, 16 * (vg * VT_PER + a), lane);
              const float g64 = GLA ? 1.0f : __builtin_amdgcn_exp2f(lg2 * 64.0f);
#pragma unroll
              for (int c2 = 0; c2 < KT_PER; ++c2) { const int kt = kg * KT_PER + c2;
                const bfx8 fk0 = frag_t(L + (GLA ? O_KS : O_KI), SQ, 0, 16 * kt, lane), fk1 = frag_t(L + (GLA ? O_KS : O_KI), SQ, 32, 16 * kt, lane);
                f32x4 sc4 = (f32x4){g64, g64, g64, g64};
                if (GLA) sc4 = *(const LAS f32x4*)(L + O_EB + (16 * kt + 4 * g4) * 4);
#pragma unroll
                for (int a = 0; a < VT_PER; ++a) { f32x4 s = Sacc[a][c2] * sc4;
                    s = MFMA16(fk0, fv[a][0], s); s = MFMA16(fk1, fv[a][1], s); Sacc[a][c2] = s;
                    if constexpr (INTRA) { v2u sw; sw.x = pk2(s[0], s[1]); sw.y = pk2(s[2], s[3]);
                        *(LAS v2u*)(F.lds + O_ST + (16 * (vg * VT_PER + a) + l15) * SS + (16 * kt + 4 * g4) * 2) = sw; } } } }
            __syncthreads();
            if constexpr (!INTRA) {
#pragma unroll
              for (int c2 = 0; c2 < KT_PER; ++c2)
#pragma unroll
                for (int a = 0; a < VT_PER; ++a) { const f32x4 s = Sacc[a][c2]; v2u sw; sw.x = pk2(s[0], s[1]); sw.y = pk2(s[2], s[3]);
                    *(LAS v2u*)(F.lds + O_ST + (16 * (vg * VT_PER + a) + l15) * SS + (16 * (kg * KT_PER + c2) + 4 * g4) * 2) = sw; } }
        }
#undef REC_LOAD
    }
}
__device__ __forceinline__ void p_gla_prep(Frame& F, const bf16* P, bf16* QD, bf16* KI, bf16* KS, float* EB) {
    const KA A = ka_fresh();
    const int tid = F.tid;
    LAS float* lb = (LAS float*)F.lds;
    LAS float* wal = (LAS float*)(F.lds + 66560);
    LAS float* tot = (LAS float*)(F.lds + 66560 + 17408);
    constexpr int LBS = 260;
    int cur_dir = -1;
    for (int item = F.vcu; item < 2 * NB * 68; item += F.G) {
        const int c = item % 68, b = (item / 68) % NB, dir = item / (68 * NB);
        if (dir != cur_dir) { __syncthreads();
            for (int i = tid; i < 16 * 256; i += NTHR) wal[i] = A.I(I_GLAWA)[dir * 4096 + i];
            if (tid < 256) wal[4096 + tid] = A.I(I_GLABA)[dir * 256 + tid];
            cur_dir = dir; __syncthreads(); }
        const int t = tid >> 3, cg = tid & 7, row = seq_row(b, dir, 64 * c + t);
        {
            float lw[16]; { float f0[8], f1[8]; unpack8(*(const v4u*)(P + (size_t)row * N0 + C0_LOW + dir * 16), f0); unpack8(*(const v4u*)(P + (size_t)row * N0 + C0_LOW + dir * 16 + 8), f1);
#pragma unroll
                for (int j = 0; j < 8; ++j) { lw[j] = f0[j]; lw[8 + j] = f1[j]; } }
#pragma unroll
            for (int q = 0; q < 8; ++q) { const int col = cg * 32 + q * 4;
                f32x4 z = *(const LAS f32x4*)(wal + 4096 + col);
#pragma unroll
                for (int r = 0; r < 16; ++r) z += *(const LAS f32x4*)(wal + r * 256 + col) * lw[r];
                f32x4 o;
#pragma unroll
                for (int j = 0; j < 4; ++j) o[j] = (fminf(z[j], 0.f) - __logf(1.0f + __expf(-fabsf(z[j])))) * (1.0f / 16.0f);
                *(LAS f32x4*)(lb + t * LBS + col) = o; }
        }
        __syncthreads();
        {
            const int col = tid & 255, half = tid >> 8; float run = 0.f;
#pragma unroll 8
            for (int i = 0; i < 32; ++i) { run += lb[(32 * half + i) * LBS + col]; lb[(32 * half + i) * LBS + col] = run; }
            if (half == 0) tot[col] = run;
            __syncthreads();
            if (half == 1) { const float off = tot[col];
#pragma unroll 8
                for (int i = 32; i < 64; ++i) lb[i * LBS + col] += off; }
        }
        __syncthreads();
        {
#pragma unroll
            for (int q = 0; q < 4; ++q) { const int col = cg * 32 + q * 8;
                float qf[8], kf[8], o1[8], o2[8], o3[8];
                unpack8(*(const v4u*)(P + (size_t)row * N0 + C0_Q + col), qf); unpack8(*(const v4u*)(P + (size_t)row * N0 + C0_K + col), kf);
#pragma unroll
                for (int j = 0; j < 8; ++j) { const float bt = lb[t * LBS + col + j], bl = lb[63 * LBS + col + j]; const float eb = __expf(bt);
                    o1[j] = qf[j] * eb; o2[j] = kf[j] * __expf(-bt); o3[j] = kf[j] * __expf(bl - bt); }
                const size_t o = ((size_t)dir * MALL + row) * 256 + col;
                *(GAS v4u*)(QD + o) = pack8(o1); *(GAS v4u*)(KI + o) = pack8(o2); *(GAS v4u*)(KS + o) = pack8(o3); }
            if (tid < 256) EB[(((size_t)dir * NB + b) * 68 + c) * 256 + tid] = __expf(lb[63 * LBS + tid]);
        }
        __syncthreads();
    }
}
__device__ __forceinline__ void p_ret_intra_finish(Frame& F) {
    const KA A = ka_fresh();
    constexpr int SQ = 528, SP = 144, SV = 1040, O_Q = 0, O_K = 33792, O_V = 0, O_P = 67584, O_RED = O_P + 64 * SP;
    static_assert(64 * SV <= O_P && O_RED + 2 * 64 * 8 <= RING_BYTES, "LDS map");
    unsigned char* ws = A.WS();
    const bf16* P = (const bf16*)(ws + WS_PROJ); const bf16* RO = (const bf16*)(ws + WS_OREC); bf16* MIX = (bf16*)(ws + WS_MIX);
    const LAS unsigned char* L = F.lds;
    const int tid = F.tid, lane = F.lane, w = F.wave, it = w & 3, vg = w >> 2, g4 = lane >> 4, l15 = lane & 15;
    v4u rq[4], rk[4];
#define RIF_LOADQK(u_) do { const int h_ = (u_) & 3, n_ = ((u_) >> 2) & 63, b_ = (u_) >> 8; const size_t p0_ = (size_t)(NCTX + b_ * SEQ + 64 * n_) * N1; \
        _Pragma("unroll") for (int q = 0; q < 4; ++q) { const int pi = tid + NTHR * q, r = pi >> 5, ch = pi & 31; const size_t ro = p0_ + (size_t)r * N1 + h_ * 256 + ch * 8; rq[q] = *(const v4u*)(P + ro + C1_Q); rk[q] = *(const v4u*)(P + ro + C1_K); } } while (0)
    if (F.vcu < NB * 64 * 4) RIF_LOADQK(F.vcu);
    for (int unit = F.vcu; unit < NB * 64 * 4; unit += F.G) {
        const int h = unit & 3, n = (unit >> 2) & 63, b = unit >> 8;
        const int lrow0 = b * SEQ + 64 * n; const size_t prow0 = (size_t)(NCTX + lrow0) * N1;
        const float lgf = -log2f(1.0f + expf(-A.I(I_RETDEC)[h])), lgb = -log2f(1.0f + expf(-A.I(I_RETDEC)[4 + h]));
#pragma unroll
        for (int q = 0; q < 4; ++q) { const int pi = tid + NTHR * q, r = pi >> 5, ch = pi & 31; *(LAS v4u*)(F.lds + O_Q + r * SQ + ch * 16) = rq[q]; *(LAS v4u*)(F.lds + O_K + r * SQ + ch * 16) = rk[q]; }
        v4u rv[8];
#pragma unroll
        for (int q = 0; q < 8; ++q) { const int pi = tid + NTHR * q, r = pi >> 6, ch = pi & 63; rv[q] = *(const v4u*)(P + prow0 + (size_t)r * N1 + C1_V + h * 512 + ch * 8); }
        __syncthreads();
#pragma unroll
        for (int q2 = 0; q2 < 2; ++q2) { const int jt = 2 * vg + q2; f32x4 acc = (f32x4){0.f, 0.f, 0.f, 0.f};
#pragma unroll
            for (int ks = 0; ks < 8; ++ks) acc = MFMA16(frag_n(L + O_K, SQ, 16 * jt, 32 * ks, lane), frag_n(L + O_Q, SQ, 16 * it, 32 * ks, lane), acc);
            const int i = 16 * it + l15;
#pragma unroll
            for (int r = 0; r < 4; ++r) { const int j = 16 * jt + 4 * g4 + r; const float m = (j <= i ? exp2f(lgf * (float)(i - j)) : 0.f) + (j >= i ? exp2f(lgb * (float)(j - i)) : 0.f); acc[r] *= m; }
            v2u pw; pw.x = pk2(acc[0], acc[1]); pw.y = pk2(acc[2], acc[3]);
            *(LAS v2u*)(F.lds + O_P + (16 * it + l15) * SP + (16 * jt + 4 * g4) * 2) = pw; }
        __syncthreads();
        if (unit + F.G < NB * 64 * 4) RIF_LOADQK(unit + F.G);
#pragma unroll
        for (int q = 0; q < 8; ++q) { const int pi = tid + NTHR * q, r = pi >> 6, ch = pi & 63; *(LAS v4u*)(F.lds + O_V + r * SV + ch * 16) = rv[q]; }
        const int lrow = lrow0 + 16 * it + l15;
        v2u oi[2][16];
#pragma unroll
        for (int d = 0; d < 2; ++d)
#pragma unroll
            for (int a = 0; a < 16; ++a) oi[d][a] = *(const v2u*)(RO + ((size_t)d * NLAT + lrow) * 2048 + h * 512 + 16 * (16 * vg + a) + 4 * g4);
        __syncthreads();
        f32x4 oacc[16];
#pragma unroll
        for (int a = 0; a < 16; ++a) oacc[a] = (f32x4){0.f, 0.f, 0.f, 0.f};
#pragma unroll
        for (int js = 0; js < 2; ++js) { const bfx8 pf = frag_n(L + O_P, SP, 16 * it, 32 * js, lane);
#pragma unroll
            for (int a = 0; a < 16; ++a) oacc[a] = MFMA16(frag_t(L + O_V, SV, 32 * js, 16 * (16 * vg + a), lane), pf, oacc[a]); }
        float s1 = 0.f, s2 = 0.f;
#pragma unroll
        for (int a = 0; a < 16; ++a) { oacc[a] += (f32x4){blo(oi[0][a].x) + blo(oi[1][a].x), bhi(oi[0][a].x) + bhi(oi[1][a].x), blo(oi[0][a].y) + blo(oi[1][a].y), bhi(oi[0][a].y) + bhi(oi[1][a].y)};
#pragma unroll
            for (int r = 0; r < 4; ++r) { s1 += oacc[a][r]; s2 += oacc[a][r] * oacc[a][r]; } }
        s1 += __shfl_xor(s1, 16); s2 += __shfl_xor(s2, 16); s1 += __shfl_xor(s1, 32); s2 += __shfl_xor(s2, 32);
        LAS float* red = (LAS float*)(F.lds + O_RED);
        if (g4 == 0) { red[(vg * 64 + 16 * it + l15) * 2] = s1; red[(vg * 64 + 16 * it + l15) * 2 + 1] = s2; }
        __syncthreads();
        { const float t1 = red[(16 * it + l15) * 2] + red[(64 + 16 * it + l15) * 2], t2 = red[(16 * it + l15) * 2 + 1] + red[(64 + 16 * it + l15) * 2 + 1];
          const float mu = t1 * (1.0f / 512.0f), var = fmaxf(t2 * (1.0f / 512.0f) - mu * mu, 0.f), rstd = rsqrtf(var + EPS);
          const bf16* gp = P + (size_t)(NCTX + lrow) * N1 + C1_G + h * 512; const float* ngp = A.I(I_RETNG) + h * 512; bf16* op = MIX + (size_t)lrow * 2048 + h * 512;
#pragma unroll
          for (int a = 0; a < 16; ++a) { const int v0 = 16 * (16 * vg + a) + 4 * g4; const v2u gw = *(const v2u*)(gp + v0); const f32x4 ng = *(const f32x4*)(ngp + v0);
              const float r0 = (oacc[a][0] - mu) * rstd * ng[0] * silu_(blo(gw.x)), r1 = (oacc[a][1] - mu) * rstd * ng[1] * silu_(bhi(gw.x)), r2 = (oacc[a][2] - mu) * rstd * ng[2] * silu_(blo(gw.y)), r3 = (oacc[a][3] - mu) * rstd * ng[3] * silu_(bhi(gw.y));
              v2u ow; ow.x = pk2(r0, r1); ow.y = pk2(r2, r3); *(GAS v2u*)(op + v0) = ow; } }
        __syncthreads();
    }
}
#undef RIF_LOADQK
#ifndef MK_ONLY
#define MK_ONLY -1
#endif
#define SON(s) (MK_ONLY < 0 || MK_ONLY == (s))
#define IN(k) (lo <= (k) && (k) < hi)
#ifndef MK_PROBE
#define MK_PROBE -1
#endif
#ifndef MK_REP
#define MK_REP -1
#endif
#define REPS(s) for (int _rep = 0; _rep < ((MK_REP == (s)) ? 2 : 1); ++_rep)
#define STAMP(k) do { if (MK_PROBE >= 0 && blockIdx.x == 0 && F.tid == 0) { const unsigned long long _t = wall_clock64(); __hip_atomic_store(F.ctl + 20000 + 2 * (k), (unsigned)_t, RLX_AGENT); __hip_atomic_store(F.ctl + 20001 + 2 * (k), (unsigned)(_t >> 32), RLX_AGENT); } } while (0)
#define SEAM(k) do { if (IN(k) && IN((k) + 1)) { xcd_barrier(bar); STAMP((k) + 1); } } while (0)
template <int layer>
__device__ __forceinline__ void layer_body(Frame& F, const int lo, const int hi, const XcdBarrier& bar) {
    unsigned char* const ws = ka_fresh().WS();
    bf16* const H = (bf16*)(ws + WS_H);
    bf16* const PROJ = (bf16*)(ws + WS_PROJ);
    float* const XRES = (float*)(ws + WS_XRES);
    float* const MOD = (float*)(ws + WS_MOD);

        const int pb = layer ? PH_INPROJ1 : PH_INPROJ0;
        if (SON(2) && IN(pb)) {
            pg8::Gemm g{H, (const bf16*)(ws + (layer ? WS_WIN1T : WS_WIN0T)), MALL, layer ? N1 : N0, 1024, 1024};
            pg8::StaticOrder S; S.init(g.M, g.N, F.G, (int)blockIdx.x);
            if constexpr (layer == 0 && !MK_NAIVE_S5) { pg8::EpiStoreU E{PROJ, g.N, (bf16*)(ws + WS_A2)};
                pg8::gemm_phase<pg8::EpiStoreU, pg8::StaticOrder, true, true>(F.lds, g, S, E); }
            else { pg8::EpiStore E{PROJ, g.N};
                pg8::gemm_phase<pg8::EpiStore, pg8::StaticOrder, true, true>(F.lds, g, S, E); }
        }
        SEAM(pb);
        if (layer == 0) {
#if MK_NAIVE_GLA
            SEAM(PH_GLAPREP);
            if (SON(3) && IN(PH_GLA)) rec_naive<64, true>(F, PROJ, N0, C0_Q, C0_K, C0_V, 128, 2, (float*)(ws + WS_OREC), (size_t)MALL * 512, 512, 0);
#else
            bf16* const GQD = (bf16*)(ws + WS_OREC + 280 * MiB); bf16* const GKI = GQD + (size_t)2 * MALL * 256; bf16* const GKS = GKI + (size_t)2 * MALL * 256; float* const GEB = (float*)(ws + WS_OREC + 384 * MiB);
            if (SON(13) && IN(PH_GLAPREP)) REPS(13) p_gla_prep(F, PROJ, GQD, GKI, GKS, GEB);
#if !MK_NAIVE_S5
            if (SON(17) && IN(PH_GLAPREP)) {
                __syncthreads();
                pg8::Gemm g{(const bf16*)(ws + WS_A2), (const bf16*)(ws + WS_S5W1), 32 * S5_ROWS, 256, 256, 512};
                pg8::GroupOrder S{9, 288, F.G, F.vcu};
                pg8::EpiF32Plain E{(float*)(ws + WS_SLOC)};
                pg8::gemm_phase<pg8::EpiF32Plain, pg8::GroupOrder, true, true>(F.lds, g, S, E);
            }
#endif
            SEAM(PH_GLAPREP);
#if !MK_NAIVE_S5
            if (SON(18) && IN(PH_GLA)) { p_s5_scan(F, (const float*)(ws + WS_SLOC), (bf16*)(ws + WS_A2)); __syncthreads(); }
#endif
            if (SON(3) && IN(PH_GLA)) REPS(3) rec_mfma<64, 32, true>(F, GQD, GKI, GKS, (size_t)MALL * 256, 256, 0, 0, PROJ, N0, C0_V, 128, GEB, (bf16*)(ws + WS_OREC), (size_t)MALL * 512, 512, 0);
#endif
            SEAM(PH_GLA);
#if MK_NAIVE_S5
            if (SON(4) && IN(PH_S5)) s5_naive(F, PROJ, (float*)(ws + WS_OREC) + (size_t)2 * MALL * 512);
#else
            if (SON(4) && IN(PH_S5)) {
                pg8::Gemm g{(const bf16*)(ws + WS_A2), (const bf16*)(ws + WS_S5W2), 32 * S5_ROWS, 256, 512, 512};
                pg8::GroupOrder S{9, 288, F.G, F.vcu};
                pg8::EpiS5Out E{(const bf16*)(ws + WS_A2), (bf16*)(ws + WS_YPRE), ka_fresh().I(I_S5D)};
                pg8::gemm_phase<pg8::EpiS5Out, pg8::GroupOrder, true, true>(F.lds, g, S, E);
            }
#endif
            if (SON(5) && IN(PH_FIN0)) REPS(5) p_finish0(F);
            SEAM(PH_FIN0);
            if (SON(6) && IN(PH_GLU)) {
                pg8::Gemm g{(const bf16*)(ws + WS_YPRE), (const bf16*)(ws + WS_WGLUT), MALL, 512, 512, 512};
                pg8::StaticOrder S; S.init(g.M, g.N, F.G, (int)blockIdx.x);
                pg8::EpiGlu E{(const bf16*)(ws + WS_YPRE), (bf16*)(ws + WS_MIX), 1024, 512, ka_fresh().I(I_GLUB)};
                pg8::gemm_phase<pg8::EpiGlu, pg8::StaticOrder, true, true>(F.lds, g, S, E);
            }
            SEAM(PH_GLU);
        } else {
            if (SON(14) && IN(PH_ROPE)) p_rope(F);
            SEAM(PH_ROPE);
#if MK_NAIVE_RET
            if (SON(15) && IN(PH_RET)) rec_naive<256, false>(F, PROJ, N1, C1_Q, C1_K, C1_V, 512, 8, (float*)(ws + WS_OREC), (size_t)NLAT * 2048, 2048, NCTX);
#else
            if (SON(15) && IN(PH_RET)) REPS(15) rec_mfma<256, 64, false, false>(F, PROJ, PROJ, PROJ, 0, N1, C1_Q, C1_K, PROJ, N1, C1_V, 512, nullptr, (bf16*)(ws + WS_OREC), (size_t)NLAT * 2048, 2048, NCTX);
#endif
            SEAM(PH_RET);
            #if MK_NAIVE_RET
            if (SON(16) && IN(PH_FIN1)) p_finish1(F);
#else
            if (SON(16) && IN(PH_FIN1)) REPS(16) p_ret_intra_finish(F);
#endif
            SEAM(PH_FIN1);
        }
        const int po = layer ? PH_OUT1 : PH_OUT0;
        if (SON(7) && IN(po)) {
            pg8::Gemm g{(const bf16*)(ws + WS_MIX), (const bf16*)(ws + (layer ? WS_WOUT1T : WS_WOUT0T)), layer ? NLAT : MALL, 1024, layer ? 2048 : 1024, layer ? 2048 : 1024};
            pg8::StaticOrder S; S.init(g.M, g.N, F.G, (int)blockIdx.x);
            pg8::EpiResid<layer == 0> E{ka_fresh().I(I_CTX), ka_fresh().I(I_X), (bf16*)XRES, MOD + (size_t)layer * 9 * 6144 + 2048, layer ? 8 : 0};
            pg8::gemm_phase<pg8::EpiResid<layer == 0>, pg8::StaticOrder, true, true>(F.lds, g, S, E);
        }
        SEAM(po);
        if (SON(8) && IN(po + 1)) p_router(F, layer);
        SEAM(po + 1);
        if (SON(10) && IN(po + 3)) {
            const int nt = moe_tables(F, layer);
            pg8::Gemm g{H, (const bf16*)(ws + WS_WGUT) + (size_t)layer * 32 * 2048 * 1024, nt * 256, 2048, 1024, 1024};
            pg8::MoeOrder S{(const PG8_LAS unsigned char*)(F.lds + L_TILEE), nt, 8, F.G, F.vcu, (const int*)(ws + WS_ELIST), (const PG8_LAS int*)(F.lds + L_TPOS), (const PG8_LAS int*)(F.lds + L_TCNT), layer ? NCTX : 0};
            pg8::EpiSwiglu E{(bf16*)(ws + WS_ACT), ka_fresh().I(I_BGU) + (size_t)layer * 32 * 2048};
            REPS(10) { pg8::gemm_phase<pg8::EpiSwiglu, pg8::MoeOrder, true, true, true>(F.lds, g, S, E); __syncthreads(); }
        }
        SEAM(po + 3);
        if (SON(11) && IN(po + 4)) {
            const int nt = moe_tables(F, layer);
            pg8::Gemm g{(const bf16*)(ws + WS_ACT), (const bf16*)(ws + WS_WDNT) + (size_t)layer * 32 * 1024 * 1024, nt * 256, 1024, 1024, 1024};
            pg8::MoeOrder S{(const PG8_LAS unsigned char*)(F.lds + L_TILEE), nt, 4, F.G, F.vcu, (const int*)(ws + WS_ELIST), (const PG8_LAS int*)(F.lds + L_TPOS), (const PG8_LAS int*)(F.lds + L_TCNT), 0};
            pg8::EpiDown E{(bf16*)(ws + WS_YSLOT), (const int*)(ws + WS_ELIST), (const PG8_LAS int*)(F.lds + L_TPOS), (const PG8_LAS int*)(F.lds + L_TCNT), (const float*)(ws + WS_WSLOT), ka_fresh().I(I_BDN) + (size_t)layer * 32 * 1024};
            REPS(11) { pg8::gemm_phase<pg8::EpiDown, pg8::MoeOrder, true, true>(F.lds, g, S, E); __syncthreads(); }
        }
        SEAM(po + 4);
        if (SON(12) && IN(po + 5)) {
#if MK_REP == 12
            p_combine(F, layer, true);
#endif
            p_combine(F, layer, false); }
        SEAM(po + 5);
    }
__global__ void __launch_bounds__(NTHR, 2) mk_fwd(Args) {
    extern __shared__ __attribute__((aligned(16))) unsigned char lds[];
    Frame F;
    F.lds = (LAS unsigned char*)lds;
    F.MISC = (volatile LAS unsigned*)(F.lds + L_MISC);
    F.tid = threadIdx.x; F.lane = F.tid & 63; F.wave = __builtin_amdgcn_readfirstlane(F.tid >> 6);
    F.G = gridDim.x; { const int bx = blockIdx.x; F.vcu = (F.G % 8 == 0) ? (bx % 8) * (F.G / 8) + bx / 8 : bx; }
    const KA A0 = ka_fresh();
    unsigned char* ws = A0.WS();
    F.ctl = (unsigned*)(ws + WS_CTL);
    if (F.tid < 64) F.MISC[F.tid] = 0u;
    __syncthreads();
    const int lo = A0.LO(), hi = A0.HI();
    XcdBarrier bar; bar.bar = F.ctl + CW_BAR; bar.x = 0; bar.st = nullptr;
    if (hi - lo > 1) bar = xcd_barrier_post(F.ctl + CW_BAR, F.MISC + 8);

    STAMP(0);
    if (SON(0) && IN(0)) { REPS(0) { p0_prologue(F); __syncthreads(); } } SEAM(0);
    if (SON(1) && IN(1)) { REPS(1) p_norm1_l0(F); } SEAM(1);
    layer_body<0>(F, lo, hi, bar);
    layer_body<1>(F, lo, hi, bar);
}

#ifndef MK_MULTI
#define MK_MULTI 0
#endif
extern "C" void kernel_launch(void* const* d_in, const int* in_sizes, int n_in, void* d_out, int out_size, void* d_ws, size_t ws_size, hipStream_t stream) {
    static int grid = 0;
    if (grid == 0) {
        if (n_in != 34 || out_size != NLAT * D || ws_size < WS_END) { fprintf(stderr, "kernel_launch: unexpected sizes: n_in %d out %d ws %zu (need %zu)\n", n_in, out_size, ws_size, (size_t)WS_END); grid = -1; return; }
        int dev = 0, cus = 0;
        if (hipGetDevice(&dev) != hipSuccess || hipDeviceGetAttribute(&cus, hipDeviceAttributeMultiprocessorCount, dev) != hipSuccess) { grid = -1; return; }
        if (hipFuncSetAttribute((const void*)mk_fwd, hipFuncAttributeMaxDynamicSharedMemorySize, LDS_BYTES) != hipSuccess) { fprintf(stderr, "kernel_launch: hipFuncSetAttribute failed\n"); grid = -1; return; }
        int per_cu = 0;
        if (hipOccupancyMaxActiveBlocksPerMultiprocessor(&per_cu, (const void*)mk_fwd, NTHR, LDS_BYTES) != hipSuccess || per_cu < 1) fprintf(stderr, "kernel_launch: occupancy query says %d\n", per_cu);
        (void)hipGetLastError();
        grid = cus;
    }
    if (grid < 0) return;
    (void)in_sizes;
    (void)hipMemsetAsync((char*)d_ws + WS_CTL, 0, CTL_ZERO_BYTES, stream);
    Args a{};
    for (int i = 0; i < 34; ++i) a.in[i] = (const float*)d_in[i];
    a.out = (float*)d_out; a.ws = (unsigned char*)d_ws;
#if MK_MULTI
    for (int p = 0; p < NPH; ++p) { a.ph_lo = p; a.ph_hi = p + 1; hipLaunchKernelGGL(mk_fwd, dim3(grid), dim3(NTHR), LDS_BYTES, stream, a); }
#else
    a.ph_lo = 0; a.ph_hi = NPH; hipLaunchKernelGGL(mk_fwd, dim3(grid), dim3(NTHR), LDS_BYTES, stream, a);
#endif
}
```

```cpp
#include <hip/hip_runtime.h>
#include <cstdio>
#include <cstdint>
#include <cmath>
namespace pg8 {
#define PG8_LAS __attribute__((address_space(3)))
typedef unsigned short bf16_t;
typedef short bf16x8 __attribute__((ext_vector_type(8)));
typedef float f32x4 __attribute__((ext_vector_type(4)));
typedef unsigned u32x4 __attribute__((ext_vector_type(4)));
constexpr int BM = 256, BK = 64, HALF = 128, HTB = HALF * BK * 2  , STAGE_BYTES = 8 * HTB, NXCD = 8, WGM = 8;

__host__ __device__ __forceinline__ int lds_byte(int r, int c) { const int st = (r >> 4) * 2 + (c >> 5), rr = r & 15, cc = c & 31, ob = rr * 64 + cc * 2; return st * 1024 + (ob ^ (((ob >> 9) & 1) << 5)); }
__host__ __device__ __forceinline__ void stage_rc(int b, int& R, int& C) { const int st = b / 1024, sb = b % 1024, swz = sb ^ (((sb >> 9) & 1) << 5); R = (st >> 1) * 16 + swz / 64; C = (st & 1) * 32 + (swz % 64) / 2; }
__host__ __device__ __forceinline__ int perm32(int rho) { const int n = rho >> 4, i = rho & 15; return 8 * (i >> 2) + 4 * n + (i & 3); }

struct Unit { int pm, pn, pb, e; };
struct Gemm { const bf16_t* A; const bf16_t* Bt; int M, N, K, lda; };

struct StaticOrder {
    int nM, nN, nwg, G, c;
    __host__ __device__ void init(int M, int N, int G_, int c_) { nM = M / BM; nN = N / BM; nwg = nM * nN; G = G_; c = c_; }
    __host__ __device__ bool next(int i, Unit& u) const {
        const long L = (long)i * G + c; if (L >= nwg) return false;
        int wgid = (int)L; { const int q = nwg / NXCD, r = nwg % NXCD, xcd = wgid % NXCD, off = wgid / NXCD; wgid = (xcd < r ? xcd * (q + 1) : r * (q + 1) + (xcd - r) * q) + off; }
        const int nig = WGM * nN, gid = wgid / nig, fm = gid * WGM, gsz = (nM - fm) < WGM ? (nM - fm) : WGM;
        u.pm = fm + ((wgid % nig) % gsz); u.pn = (wgid % nig) / gsz; u.pb = u.pn; u.e = 0; return true;
    }
    __device__ __forceinline__ void a_ready(const Unit&) const {}
    __device__ __forceinline__ void done(const Unit&) const {}
};
__device__ __forceinline__ unsigned cvt_pk_bf16(float lo, float hi) { unsigned r; asm volatile("v_cvt_pk_bf16_f32 %0, %1, %2" : "=v"(r) : "v"(lo), "v"(hi)); return r; }
__device__ __forceinline__ float bflo(unsigned w) { return __uint_as_float(w << 16); }
__device__ __forceinline__ float bfhi(unsigned w) { return __uint_as_float(w & 0xffff0000u); }
__device__ __forceinline__ float sigmoidf_(float z) { return __builtin_amdgcn_rcpf(1.0f + __expf(-z)); }

struct EpiStore {
    static constexpr bool PERM = true, AFTER_DRAIN = false;
    bf16_t* O; int ldc;
    __device__ __forceinline__ void operator()(const f32x4 (&acc)[2][2][4][2], const Unit& u, int wr, int wc, int fr, int fq) const {
        const int row0 = u.pm * BM + wr * 64 + fr, col0 = u.pn * BM + wc * 32 + 8 * fq;
#pragma unroll
        for (int ai = 0; ai < 2; ++ai)
#pragma unroll
            for (int m = 0; m < 4; ++m) { bf16_t* rowp = O + (size_t)(row0 + ai * HALF + m * 16) * ldc + col0;
#pragma unroll
                for (int bj = 0; bj < 2; ++bj) { const f32x4 v0 = acc[ai][bj][m][0], v1 = acc[ai][bj][m][1];
                    u32x4 w; w.x = cvt_pk_bf16(v0[0], v0[1]); w.y = cvt_pk_bf16(v0[2], v0[3]); w.z = cvt_pk_bf16(v1[0], v1[1]); w.w = cvt_pk_bf16(v1[2], v1[3]);
                    *(u32x4*)(rowp + bj * HALF) = w; } }
    }
};
struct EpiGlu {
    static constexpr bool PERM = true, AFTER_DRAIN = false;
    const bf16_t* Y; bf16_t* O; int ldo, ocol0; const float* bias;
    __device__ __forceinline__ void operator()(const f32x4 (&acc)[2][2][4][2], const Unit& u, int wr, int wc, int fr, int fq) const {
        const int row0 = u.pm * BM + wr * 64 + fr, col0 = u.pn * BM + wc * 32 + 8 * fq;
        f32x4 bv[2][2];
#pragma unroll
        for (int bj = 0; bj < 2; ++bj)
#pragma unroll
            for (int n = 0; n < 2; ++n) bv[bj][n] = *(const f32x4*)(bias + col0 + bj * HALF + 4 * n);
#pragma unroll
        for (int ai = 0; ai < 2; ++ai)
#pragma unroll
            for (int m = 0; m < 4; ++m) { const size_t row = (size_t)(row0 + ai * HALF + m * 16);
#pragma unroll
                for (int bj = 0; bj < 2; ++bj) { const int c = col0 + bj * HALF;
                    const u32x4 yv = *(const u32x4*)(Y + row * 512 + c);
                    const f32x4 z0 = acc[ai][bj][m][0] + bv[bj][0], z1 = acc[ai][bj][m][1] + bv[bj][1];
                    u32x4 w;
                    w.x = cvt_pk_bf16(bflo(yv.x) * sigmoidf_(z0[0]), bfhi(yv.x) * sigmoidf_(z0[1]));
                    w.y = cvt_pk_bf16(bflo(yv.y) * sigmoidf_(z0[2]), bfhi(yv.y) * sigmoidf_(z0[3]));
                    w.z = cvt_pk_bf16(bflo(yv.z) * sigmoidf_(z1[0]), bfhi(yv.z) * sigmoidf_(z1[1]));
                    w.w = cvt_pk_bf16(bflo(yv.w) * sigmoidf_(z1[2]), bfhi(yv.w) * sigmoidf_(z1[3]));
                    *(u32x4*)(O + row * ldo + ocol0 + c) = w; } }
    }
};
template <bool BASE_F32> struct EpiResid {
    static constexpr bool PERM = true, AFTER_DRAIN = false;
    const float* base_ctx; const float* base_lat; bf16_t* out; const float* gate; int tile0;
    __device__ __forceinline__ void operator()(const f32x4 (&acc)[2][2][4][2], const Unit& u, int wr, int wc, int fr, int fq) const {
        const int gt = u.pm + tile0, bidx = gt < 8 ? 8 : ((gt - 8) >> 4);
        const float* bt = gt < 8 ? base_ctx + (size_t)gt * 256 * 1024 : base_lat + (size_t)(gt - 8) * 256 * 1024;
        bf16_t* ot = out + (size_t)gt * 256 * 1024;
        const int col0 = u.pn * BM + wc * 32 + 8 * fq;
        f32x4 gv[2][2];
#pragma unroll
        for (int bj = 0; bj < 2; ++bj)
#pragma unroll
            for (int n = 0; n < 2; ++n) gv[bj][n] = *(const f32x4*)(gate + bidx * 6144 + col0 + bj * HALF + 4 * n);
#pragma unroll
        for (int ai = 0; ai < 2; ++ai)
#pragma unroll
            for (int m = 0; m < 4; ++m) { const size_t off = (size_t)(wr * 64 + fr + ai * HALF + m * 16) * 1024 + col0;
#pragma unroll
                for (int bj = 0; bj < 2; ++bj) { f32x4 b0, b1;
                    if constexpr (BASE_F32) { b0 = *(const f32x4*)(bt + off + bj * HALF); b1 = *(const f32x4*)(bt + off + bj * HALF + 4); }
                    else { const u32x4 bw = *(const u32x4*)(ot + off + bj * HALF); b0 = (f32x4){bflo(bw.x), bfhi(bw.x), bflo(bw.y), bfhi(bw.y)}; b1 = (f32x4){bflo(bw.z), bfhi(bw.z), bflo(bw.w), bfhi(bw.w)}; }
                    const f32x4 v0 = b0 + gv[bj][0] * acc[ai][bj][m][0], v1 = b1 + gv[bj][1] * acc[ai][bj][m][1];
                    u32x4 w; w.x = cvt_pk_bf16(v0[0], v0[1]); w.y = cvt_pk_bf16(v0[2], v0[3]); w.z = cvt_pk_bf16(v1[0], v1[1]); w.w = cvt_pk_bf16(v1[2], v1[3]);
                    *(u32x4*)(ot + off + bj * HALF) = w; } }
    }
};
struct EpiSwiglu {
    static constexpr bool PERM = true, AFTER_DRAIN = false;
    bf16_t* ACT; const float* bgu;
    __device__ __forceinline__ void operator()(const f32x4 (&acc)[2][2][4][2], const Unit& u, int wr, int wc, int fr, int fq) const {
        const int row0 = u.pm * BM + wr * 64 + fr, lc0 = u.pn * 128 + wc * 32 + 8 * fq;
        const float* bb = bgu + (size_t)u.e * 2048 + lc0;
        f32x4 bg[2], bl[2];
#pragma unroll
        for (int n = 0; n < 2; ++n) { bg[n] = *(const f32x4*)(bb + 4 * n); bl[n] = *(const f32x4*)(bb + 1024 + 4 * n); }
#pragma unroll
        for (int ai = 0; ai < 2; ++ai)
#pragma unroll
            for (int m = 0; m < 4; ++m) { float a[8];
#pragma unroll
                for (int n = 0; n < 2; ++n)
#pragma unroll
                    for (int j = 0; j < 4; ++j) { const float g = fminf(acc[ai][0][m][n][j] + bg[n][j], 7.0f); float l = acc[ai][1][m][n][j] + bl[n][j]; l = fminf(fmaxf(l, -7.0f), 7.0f);
                        a[4 * n + j] = g * sigmoidf_(1.702f * g) * (l + 1.0f); }
                u32x4 w; w.x = cvt_pk_bf16(a[0], a[1]); w.y = cvt_pk_bf16(a[2], a[3]); w.z = cvt_pk_bf16(a[4], a[5]); w.w = cvt_pk_bf16(a[6], a[7]);
                *(u32x4*)(ACT + (size_t)(row0 + ai * HALF + m * 16) * 1024 + lc0) = w; }
    }
};
struct EpiDown {
    static constexpr bool PERM = true, AFTER_DRAIN = false;
    bf16_t* Y; const int* elist; const PG8_LAS int* tpos; const PG8_LAS int* tcnt; const float* w_slot; const float* bdn;
    __device__ __forceinline__ void operator()(const f32x4 (&acc)[2][2][4][2], const Unit& u, int wr, int wc, int fr, int fq) const {
        const int col0 = u.pn * BM + wc * 32 + 8 * fq, tp0 = tpos[u.pm], tc0 = tcnt[u.pm]; const int* el = elist + (size_t)u.e * 34816;
        f32x4 bv[2][2];
#pragma unroll
        for (int bj = 0; bj < 2; ++bj)
#pragma unroll
            for (int n = 0; n < 2; ++n) bv[bj][n] = *(const f32x4*)(bdn + (size_t)u.e * 1024 + col0 + bj * HALF + 4 * n);
#pragma unroll
        for (int ai = 0; ai < 2; ++ai)
#pragma unroll
            for (int m = 0; m < 4; ++m) { const int pos = tp0 + wr * 64 + fr + ai * HALF + m * 16; const int slot = pos < tc0 ? el[pos] : -1;
                if (slot >= 0) { const float ws = w_slot[slot]; bf16_t* rowp = Y + (size_t)slot * 1024 + col0;
#pragma unroll
                    for (int bj = 0; bj < 2; ++bj) { const f32x4 v0 = (acc[ai][bj][m][0] + bv[bj][0]) * ws, v1 = (acc[ai][bj][m][1] + bv[bj][1]) * ws;
                        u32x4 w; w.x = cvt_pk_bf16(v0[0], v0[1]); w.y = cvt_pk_bf16(v0[2], v0[3]); w.z = cvt_pk_bf16(v1[0], v1[1]); w.w = cvt_pk_bf16(v1[2], v1[3]);
                        *(u32x4*)(rowp + bj * HALF) = w; } } }
    }
};
struct MoeOrder {
    const PG8_LAS unsigned char* tile_e; int ntiles, NT, G, c; const int* elist; const PG8_LAS int* tpos; const PG8_LAS int* tcnt; int row0;
    __device__ __forceinline__ int rowidx(const Unit& u, int r) const { const int pos = tpos[u.pm] + r; const int s = pos < tcnt[u.pm] ? elist[(size_t)u.e * 34816 + pos] : 0; return row0 + (s >> 2); }
    __device__ __forceinline__ bool next(int i, Unit& u) const {
        const int L = i * G + c; if (L >= ntiles * NT) return false;
        const int T = L / NT; u.pm = T; u.pn = L - T * NT; u.e = __builtin_amdgcn_readfirstlane((int)tile_e[T]); u.pb = u.e * NT + u.pn; return true;
    }
    __device__ __forceinline__ void a_ready(const Unit&) const {}
    __device__ __forceinline__ void done(const Unit&) const {}
};

struct EpiStoreU {
    static constexpr bool PERM = true, AFTER_DRAIN = false;
    bf16_t* O; int ldc; bf16_t* A2;
    __device__ __forceinline__ void operator()(const f32x4 (&acc)[2][2][4][2], const Unit& u, int wr, int wc, int fr, int fq) const {
        const int row0 = u.pm * BM + wr * 64 + fr, col0 = u.pn * BM + wc * 32 + 8 * fq;
#pragma unroll
        for (int ai = 0; ai < 2; ++ai)
#pragma unroll
            for (int m = 0; m < 4; ++m) { const int R = row0 + ai * HALF + m * 16; bf16_t* rowp = O + (size_t)R * ldc + col0;
                int r, t; if (R < 2048) { r = (R >> 8) * 272 + ((R & 255) >> 4); t = R & 15; } else { const int R2 = R - 2048; r = (R2 >> 12) * 272 + 16 + ((R2 & 4095) >> 4); t = R2 & 15; }
#pragma unroll
                for (int bj = 0; bj < 2; ++bj) { const f32x4 v0 = acc[ai][bj][m][0], v1 = acc[ai][bj][m][1];
                    u32x4 w; w.x = cvt_pk_bf16(v0[0], v0[1]); w.y = cvt_pk_bf16(v0[2], v0[3]); w.z = cvt_pk_bf16(v1[0], v1[1]); w.w = cvt_pk_bf16(v1[2], v1[3]);
                    *(u32x4*)(rowp + bj * HALF) = w;
                    if (u.pn >= 6) { const int g = (u.pn - 6) * 16 + bj * 8 + wc * 2 + (fq >> 1);
                        *(u32x4*)(A2 + ((size_t)g * 2304 + r) * 512 + t * 16 + (fq & 1) * 8) = w; } } }
    }
};
struct EpiF32Plain {
    static constexpr bool PERM = true, AFTER_DRAIN = false;
    float* C;
    __device__ __forceinline__ void operator()(const f32x4 (&acc)[2][2][4][2], const Unit& u, int wr, int wc, int fr, int fq) const {
        float* base = C + (size_t)(u.pm * BM + wr * 64 + fr) * 256 + wc * 32 + 8 * fq;
#pragma unroll
        for (int ai = 0; ai < 2; ++ai)
#pragma unroll
            for (int m = 0; m < 4; ++m) {
#pragma unroll
                for (int bj = 0; bj < 2; ++bj) { float* p = base + (ai * HALF + m * 16) * 256 + bj * HALF;
                    *(f32x4*)p = acc[ai][bj][m][0]; *(f32x4*)(p + 4) = acc[ai][bj][m][1]; } }
    }
};
struct EpiS5Out {
    static constexpr bool PERM = true, AFTER_DRAIN = false;
    const bf16_t* A2; bf16_t* YP; const float* dskip;
    __device__ __forceinline__ void operator()(const f32x4 (&acc)[2][2][4][2], const Unit& u, int wr, int wc, int fr, int fq) const {
        const int g = u.e;
#pragma unroll
        for (int ai = 0; ai < 2; ++ai)
#pragma unroll
            for (int m = 0; m < 4; ++m) { const int rr = (u.pm - g * 9) * BM + wr * 64 + fr + ai * HALF + m * 16;
                if (rr < 2176) { const int b = rr / 272, n = rr - b * 272;
                    const int tok0 = n < 16 ? b * 256 + n * 16 : 2048 + b * 4096 + (n - 16) * 16;
#pragma unroll
                    for (int bj = 0; bj < 2; ++bj) { const int col = bj * HALF + wc * 32 + 8 * fq, t = col >> 4, c0 = col & 15;
                        const u32x4 uv = *(const u32x4*)(A2 + ((size_t)g * 2304 + rr) * 512 + col);
                        const f32x4 d0 = *(const f32x4*)(dskip + g * 16 + c0), d1 = *(const f32x4*)(dskip + g * 16 + c0 + 4);
                        float y[8];
                        y[0] = acc[ai][bj][m][0][0] + d0[0] * bflo(uv.x); y[1] = acc[ai][bj][m][0][1] + d0[1] * bfhi(uv.x); y[2] = acc[ai][bj][m][0][2] + d0[2] * bflo(uv.y); y[3] = acc[ai][bj][m][0][3] + d0[3] * bfhi(uv.y);
                        y[4] = acc[ai][bj][m][1][0] + d1[0] * bflo(uv.z); y[5] = acc[ai][bj][m][1][1] + d1[1] * bfhi(uv.z); y[6] = acc[ai][bj][m][1][2] + d1[2] * bflo(uv.w); y[7] = acc[ai][bj][m][1][3] + d1[3] * bfhi(uv.w);
#pragma unroll
                        for (int j = 0; j < 8; ++j) { const float z = y[j], th = 0.7978845608f * (z + 0.044715f * z * z * z); const float e2 = __expf(2.0f * th); y[j] = 0.5f * z * (1.0f + (1.0f - 2.0f * __builtin_amdgcn_rcpf(e2 + 1.0f))); }
                        u32x4 w; w.x = cvt_pk_bf16(y[0], y[1]); w.y = cvt_pk_bf16(y[2], y[3]); w.z = cvt_pk_bf16(y[4], y[5]); w.w = cvt_pk_bf16(y[6], y[7]);
                        *(u32x4*)(YP + (size_t)(tok0 + t) * 512 + g * 16 + c0) = w; } } }
    }
};
struct GroupOrder {
    int tpg, nunits, G, c;
    __device__ __forceinline__ bool next(int i, Unit& u) const { const int L = i * G + c; if (L >= nunits) return false; u.pm = L; u.pn = 0; u.e = L / tpg; u.pb = u.e; return true; }
    __device__ __forceinline__ void a_ready(const Unit&) const {}
    __device__ __forceinline__ void done(const Unit&) const {}
};
template <class Epi, class Sched, bool ALIGN_EPI = false, bool SP2 = false, bool GATHER = false>
__device__ __forceinline__ void gemm_phase(PG8_LAS unsigned char* lds, const Gemm g, const Sched& S, const Epi& E) {
    static_assert(!GATHER || SP2, "gathered A staging is implemented in the SP2 loop only");
    const int tid = threadIdx.x, wid = __builtin_amdgcn_readfirstlane(tid >> 6), lane = tid & 63, wr = wid >> 2, wc = wid & 3, fr = lane & 15, fq = lane >> 4;
    int K_ = g.K; asm volatile("" : "+s"(K_));
    const int K = K_, nt = K / BK;
    unsigned voffA[2], voffB[2];
#pragma unroll
    for (int i = 0; i < 2; ++i) { int R, C; stage_rc(tid * 16 + i * 8192, R, C); const int Rb = Epi::PERM ? ((R & ~31) + perm32(R & 31)) : R;
        voffA[i] = (unsigned)(R * g.lda + C) * 2u; voffB[i] = (unsigned)(Rb * K + C) * 2u; }
    const size_t kstep = (size_t)(BK * 2);
    const size_t hstep = (size_t)HALF * K * 2;
    const size_t tstep = 2 * hstep;
    const size_t hstepA = (size_t)HALF * g.lda * 2, tstepA = 2 * hstepA;
    const unsigned ldsw = (unsigned)wid * 1024u;
    const int aoff = lds_byte(wr * 64 + fr, fq * 8), boff = lds_byte(wc * 32 + fr, fq * 8);
#define PG8_SA(b, h) (((b) * 2 + (h)) * HTB)
#define PG8_SB(b, h) ((4 + (b) * 2 + (h)) * HTB)
#define PG8_STAGE(bufoff, gbase, voff) do { _Pragma("unroll") for (int _i = 0; _i < 2; ++_i) \
        __builtin_amdgcn_global_load_lds((const unsigned*)((const char*)(gbase) + (voff)[_i]), (PG8_LAS unsigned*)(lds + (bufoff) + ldsw + _i * 8192), 16, 0, 0); } while (0)
#define PG8_STAGE_H0(bufoff, gbase) do { if constexpr (GATHER) PG8_STAGE(bufoff, gbase, voffA0); else PG8_STAGE(bufoff, gbase, voffA); } while (0)
#define PG8_STAGE_H1(bufoff, gbase) do { if constexpr (GATHER) PG8_STAGE(bufoff, gbase, voffA1); else PG8_STAGE(bufoff, (gbase) + hstepA, voffA); } while (0)
#define PG8_GOFF(unit, h, dst) do { _Pragma("unroll") for (int _i = 0; _i < 2; ++_i) { int _R, _C; stage_rc(tid * 16 + _i * 8192, _R, _C); dst[_i] = (unsigned)S.rowidx(unit, (h) * HALF + _R); } } while (0)
#define PG8_GCONV(dst, src) do { _Pragma("unroll") for (int _i = 0; _i < 2; ++_i) { int _R, _C; stage_rc(tid * 16 + _i * 8192, _R, _C); dst[_i] = (src[_i] * (unsigned)g.lda + (unsigned)_C) * 2u; } } while (0)
#define PG8_LDA(dst, b, h) do { _Pragma("unroll") for (int m = 0; m < 4; ++m) _Pragma("unroll") for (int k = 0; k < 2; ++k) dst[m][k] = *(const PG8_LAS bf16x8*)(lds + PG8_SA(b, h) + aoff + m * 2048 + k * 1024); } while (0)
#define PG8_LDB(dst, b, h) do { _Pragma("unroll") for (int n = 0; n < 2; ++n) _Pragma("unroll") for (int k = 0; k < 2; ++k) dst[n][k] = *(const PG8_LAS bf16x8*)(lds + PG8_SB(b, h) + boff + n * 2048 + k * 1024); } while (0)
#define PG8_MMA(ai, bj, At, Bt) do { __builtin_amdgcn_s_setprio(1); _Pragma("unroll") for (int m = 0; m < 4; ++m) _Pragma("unroll") for (int n = 0; n < 2; ++n) _Pragma("unroll") for (int k = 0; k < 2; ++k) \
        acc[ai][bj][m][n] = __builtin_amdgcn_mfma_f32_16x16x32_bf16(Bt[n][k], At[m][k], acc[ai][bj][m][n], 0, 0, 0); __builtin_amdgcn_s_setprio(0); } while (0)
#define PG8_WAIT_V(n) asm volatile("s_waitcnt vmcnt(" #n ")" ::: "memory")
#define PG8_WAIT_L(n) asm volatile("s_waitcnt lgkmcnt(" #n ")" ::: "memory")
#define PG8_BAR __builtin_amdgcn_s_barrier()
#define PG8_SCHED __builtin_amdgcn_sched_barrier(0)
    Unit cur, nxt; int ui = 0;
    if (!S.next(0, cur)) return;
    f32x4 acc[2][2][4][2];
#pragma unroll
    for (int a = 0; a < 2; ++a)
#pragma unroll
        for (int b = 0; b < 2; ++b)
#pragma unroll
            for (int m = 0; m < 4; ++m)
#pragma unroll
                for (int n = 0; n < 2; ++n) acc[a][b][m][n] = (f32x4){0.f, 0.f, 0.f, 0.f};
    bf16x8 At[4][2], B0[2][2], B1[2][2];
    const char* cA = (const char*)g.A + (GATHER ? (size_t)0 : (size_t)cur.pm * tstepA);
    unsigned voffA0[2] = {0u, 0u}, voffA1[2] = {0u, 0u}, nidx0[2] = {0u, 0u}, nidx1[2] = {0u, 0u};
    if constexpr (GATHER) { PG8_GOFF(cur, 0, nidx0); PG8_GOFF(cur, 1, nidx1); PG8_GCONV(voffA0, nidx0); PG8_GCONV(voffA1, nidx1); } const char* cB = (const char*)g.Bt + (size_t)cur.pb * tstep;
    S.a_ready(cur);
    if constexpr (SP2) {
        PG8_STAGE(PG8_SB(0, 0), cB, voffB); PG8_STAGE(PG8_SB(0, 1), cB + hstep, voffB); PG8_STAGE_H0(PG8_SA(0, 0), cA); PG8_STAGE_H1(PG8_SA(0, 1), cA);
        if (wr == 1) PG8_BAR;
        PG8_WAIT_V(2); PG8_BAR;
        PG8_STAGE(PG8_SB(1, 0), cB + kstep, voffB); PG8_STAGE_H0(PG8_SA(1, 0), cA + kstep); PG8_STAGE(PG8_SB(1, 1), cB + hstep + kstep, voffB);
        PG8_WAIT_V(6); PG8_BAR;
    } else {
        PG8_STAGE(PG8_SB(0, 0), cB, voffB); PG8_STAGE_H0(PG8_SA(0, 0), cA); PG8_STAGE(PG8_SB(0, 1), cB + hstep, voffB); PG8_STAGE_H1(PG8_SA(0, 1), cA);
        if (wr == 1) PG8_BAR;
        PG8_WAIT_V(4); PG8_BAR;
        PG8_STAGE(PG8_SB(1, 0), cB + kstep, voffB); PG8_STAGE_H0(PG8_SA(1, 0), cA + kstep); PG8_STAGE(PG8_SB(1, 1), cB + hstep + kstep, voffB);
        PG8_WAIT_V(6); PG8_BAR;
    }
    for (;;) {
        const bool has_next = S.next(ui + 1, nxt);
        const char* nA = (has_next && !GATHER) ? (const char*)g.A + (size_t)nxt.pm * tstepA : cA; const char* nB = has_next ? (const char*)g.Bt + (size_t)nxt.pb * tstep : cB;
        for (int t = 0; t < nt; t += 2) {
            const bool last = (t == nt - 2);
            const char* a1 = cA + (size_t)(t + 1) * kstep;
            const char* a2 = last ? nA : cA + (size_t)(t + 2) * kstep; const char* b2 = last ? nB : cB + (size_t)(t + 2) * kstep;
            const char* a3 = a2 + kstep; const char* b3 = b2 + kstep;
            if (last && has_next) S.a_ready(nxt);
            if constexpr (GATHER) { if (has_next && t == nt - 4) { PG8_GOFF(nxt, 0, nidx0); PG8_GOFF(nxt, 1, nidx1); }
                                    if (has_next && last) PG8_GCONV(voffA0, nidx0); }
            if constexpr (SP2) {
            PG8_LDB(B0, 0, 0); PG8_LDB(B1, 0, 1); PG8_SCHED; PG8_LDA(At, 0, 0); PG8_STAGE_H1(PG8_SA(1, 1), a1);
            if constexpr (GATHER) { if (has_next && last) PG8_GCONV(voffA1, nidx1); }
            PG8_WAIT_V(8); PG8_WAIT_L(0); PG8_BAR; PG8_MMA(0, 0, At, B0); PG8_MMA(0, 1, At, B1); PG8_BAR; PG8_SCHED;
            PG8_LDA(At, 0, 1); PG8_STAGE(PG8_SB(0, 0), b2, voffB); PG8_STAGE(PG8_SB(0, 1), b2 + hstep, voffB); PG8_STAGE_H0(PG8_SA(0, 0), a2);
            PG8_WAIT_V(8); PG8_WAIT_L(0); PG8_BAR; PG8_MMA(1, 0, At, B0); PG8_MMA(1, 1, At, B1); PG8_BAR; PG8_SCHED;
            PG8_LDB(B0, 1, 0); PG8_LDB(B1, 1, 1); PG8_SCHED; PG8_LDA(At, 1, 0); PG8_STAGE_H1(PG8_SA(0, 1), a2);
            PG8_WAIT_V(8); PG8_WAIT_L(0); PG8_BAR; PG8_MMA(0, 0, At, B0); PG8_MMA(0, 1, At, B1); PG8_BAR; PG8_SCHED;
            PG8_LDA(At, 1, 1); PG8_STAGE(PG8_SB(1, 0), b3, voffB); PG8_STAGE(PG8_SB(1, 1), b3 + hstep, voffB); PG8_STAGE_H0(PG8_SA(1, 0), a3);
            PG8_WAIT_V(8); PG8_WAIT_L(0); PG8_BAR; PG8_MMA(1, 0, At, B0); PG8_MMA(1, 1, At, B1); PG8_BAR; PG8_SCHED;
            } else {
            PG8_LDB(B0, 0, 0); PG8_SCHED; PG8_LDA(At, 0, 0); PG8_STAGE(PG8_SA(1, 1), a1 + hstepA, voffA);
            PG8_WAIT_L(8); PG8_BAR; PG8_WAIT_L(0); PG8_MMA(0, 0, At, B0); PG8_BAR; PG8_SCHED;
            PG8_LDB(B1, 0, 1); PG8_STAGE(PG8_SB(0, 0), b2, voffB);
            PG8_BAR; PG8_WAIT_L(0); PG8_MMA(0, 1, At, B1); PG8_BAR;
            PG8_LDA(At, 0, 1); PG8_STAGE(PG8_SA(0, 0), a2, voffA);
            PG8_BAR; PG8_WAIT_L(0); PG8_MMA(1, 0, At, B0); PG8_BAR; PG8_SCHED;
            PG8_STAGE(PG8_SB(0, 1), b2 + hstep, voffB);
            PG8_WAIT_V(6); PG8_BAR; PG8_MMA(1, 1, At, B1); PG8_BAR;
            PG8_LDB(B0, 1, 0); PG8_SCHED; PG8_LDA(At, 1, 0); PG8_STAGE(PG8_SA(0, 1), a2 + hstepA, voffA);
            PG8_WAIT_L(8); PG8_BAR; PG8_WAIT_L(0); PG8_MMA(0, 0, At, B0); PG8_BAR; PG8_SCHED;
            PG8_LDB(B1, 1, 1); PG8_STAGE(PG8_SB(1, 0), b3, voffB);
            PG8_BAR; PG8_WAIT_L(0); PG8_MMA(0, 1, At, B1); PG8_BAR;
            PG8_LDA(At, 1, 1); PG8_STAGE(PG8_SA(1, 0), a3, voffA);
            PG8_BAR; PG8_WAIT_L(0); PG8_MMA(1, 0, At, B0); PG8_BAR; PG8_SCHED;
            PG8_STAGE(PG8_SB(1, 1), b3 + hstep, voffB);
            PG8_WAIT_V(6); PG8_BAR; PG8_MMA(1, 1, At, B1); PG8_BAR;
            }
        }
        if constexpr (ALIGN_EPI) { if (wr == 0) PG8_BAR; }
        if constexpr (!Epi::AFTER_DRAIN) { E(acc, cur, wr, wc, fr, fq); S.done(cur); }
        if (!has_next) break;
#pragma unroll
        for (int a = 0; a < 2; ++a)
#pragma unroll
            for (int b = 0; b < 2; ++b)
#pragma unroll
                for (int m = 0; m < 4; ++m)
#pragma unroll
                    for (int n = 0; n < 2; ++n) acc[a][b][m][n] = (f32x4){0.f, 0.f, 0.f, 0.f};
        cur = nxt; cA = nA; cB = nB; ++ui;
        if constexpr (ALIGN_EPI) { if (wr == 1) PG8_BAR; }
    }
    PG8_WAIT_V(0);
    if constexpr (!ALIGN_EPI) { if (wr == 0) PG8_BAR; }
    PG8_BAR;
    if constexpr (Epi::AFTER_DRAIN) { E.fused(acc, cur, wr, wc, fr, fq, lds, wid, lane); S.done(cur); }
#undef PG8_SA
#undef PG8_SB
#undef PG8_STAGE
#undef PG8_STAGE_H0
#undef PG8_STAGE_H1
#undef PG8_GOFF
#undef PG8_GCONV
#undef PG8_LDA
#undef PG8_LDB
#undef PG8_MMA
#undef PG8_WAIT_V
#undef PG8_WAIT_L
#undef PG8_BAR
#undef PG8_SCHED
}
}
constexpr int NWAVES = 8, NTHR = 512;
constexpr int D = 1024, NB = 8, SEQ = 4096, CTX = 256;
constexpr int NCTX = NB * CTX, NLAT = NB * SEQ, MALL = NCTX + NLAT;
constexpr int N0 = 2304, N1 = 6144;
constexpr int C0_Q = 0, C0_K = 256, C0_V = 512, C0_G = 1024, C0_U = 1536, C0_LOW = 2048;
constexpr int C1_Q = 0, C1_K = 1024, C1_V = 2048, C1_G = 4096;
constexpr int NE = 32, MAXTILES = 576;
constexpr float EPS = 1e-6f;
constexpr int NPH = 24;
enum { PH_PRO = 0, PH_NORM1, PH_INPROJ0, PH_GLAPREP, PH_GLA, PH_S5, PH_FIN0, PH_GLU, PH_OUT0, PH_ROUTER0, PH_GATHER0, PH_GU0, PH_DOWN0, PH_COMB0,
       PH_INPROJ1, PH_ROPE, PH_RET, PH_FIN1, PH_OUT1, PH_ROUTER1, PH_GATHER1, PH_GU1, PH_DOWN1, PH_COMB1 };
#ifndef MK_NAIVE_GLA
#define MK_NAIVE_GLA 0
#endif
#ifndef MK_NAIVE_S5
#define MK_NAIVE_S5 0
#endif
#ifndef MK_NAIVE_RET
#define MK_NAIVE_RET 0
#endif
constexpr size_t MiB = 1u << 20;
constexpr size_t WS_CTL = 0, CTL_ZERO_BYTES = 1 * MiB;
constexpr size_t WS_MOD = 1 * MiB;
constexpr size_t WS_WIN0T = 2 * MiB, WS_WOUT0T = 7 * MiB, WS_WGLUT = 9 * MiB, WS_WIN1T = 10 * MiB, WS_WOUT1T = 22 * MiB;
constexpr size_t WS_SELE = 26 * MiB, WS_WSLOT = 27 * MiB, WS_SPOS = 28 * MiB, WS_PROW = 29 * MiB;
constexpr size_t WS_WGUT = 32 * MiB, WS_WDNT = 288 * MiB;
constexpr size_t WS_XRES = 416 * MiB, WS_H = 552 * MiB, WS_MIX = 620 * MiB, WS_YPRE = 688 * MiB;
constexpr size_t WS_PROJ = 748 * MiB, WS_OREC = 1156 * MiB;
constexpr size_t WS_XG = 748 * MiB, WS_ACT = 1036 * MiB, WS_YSLOT = 1324 * MiB;
constexpr size_t WS_S5W1 = 1556 * MiB, WS_S5W2 = 1560 * MiB, WS_A2 = 1568 * MiB, WS_SLOC = 1668 * MiB;
constexpr size_t WS_ELIST = 1740 * MiB;
constexpr size_t WS_END = 1746 * MiB;
constexpr int CW_TMO = 0, CW_BAR = 4096, CW_GCNT = 16384;
constexpr int RING_BYTES = 131072, LDSCTL_OFF = RING_BYTES, LDS_BYTES = 147456;
constexpr int L_MISC = LDSCTL_OFF;
constexpr int L_TILEE = LDSCTL_OFF + 256;
constexpr int L_TSTART = LDSCTL_OFF + 1024;
constexpr int L_LCNT = LDSCTL_OFF + 1280;
constexpr int L_GBASE = LDSCTL_OFF + 1536;
constexpr int L_BLKE = LDSCTL_OFF + 2048;
constexpr int L_BLKP = LDSCTL_OFF + 5120;
constexpr int L_TPOS = L_BLKE, L_TCNT = L_BLKP;

#define GAS __attribute__((address_space(1)))
#define LAS __attribute__((address_space(3)))
typedef unsigned short bf16;
typedef unsigned v4u __attribute__((ext_vector_type(4)));
typedef unsigned v2u __attribute__((ext_vector_type(2)));
typedef float f32x4 __attribute__((ext_vector_type(4)));
typedef GAS unsigned gu32;
#define RLX_AGENT __ATOMIC_RELAXED, __HIP_MEMORY_SCOPE_AGENT
#define LDS_WAIT() asm volatile("s_waitcnt lgkmcnt(0)" ::: "memory")
#define VM_WAIT() asm volatile("s_waitcnt vmcnt(0)" ::: "memory")
__device__ __forceinline__ unsigned f2bf(float f) { unsigned u = __builtin_bit_cast(unsigned, f); return (u + 0x7fffu + ((u >> 16) & 1u)) >> 16; }
__device__ __forceinline__ unsigned pk2(float lo, float hi) { return f2bf(lo) | (f2bf(hi) << 16); }
__device__ __forceinline__ float bf2f(unsigned b) { return __uint_as_float(b << 16); }
__device__ __forceinline__ float blo(unsigned w) { return __uint_as_float(w << 16); }
__device__ __forceinline__ float bhi(unsigned w) { return __uint_as_float(w & 0xffff0000u); }
__device__ __forceinline__ float wave_sum(float v) {
#pragma unroll
    for (int o = 1; o < 64; o <<= 1) v += __shfl_xor(v, o);
    return v;
}
__device__ __forceinline__ float silu_(float z) { return z * __builtin_amdgcn_rcpf(1.0f + __expf(-z)); }
#define XB_TMO      128
#define XB_XCNT(j)  (256  + 64 * (j))
#define XB_XSUB(j)  (1280 + 64 * (j))
#define XB_XGEN(j)  (2304 + 64 * (j))
#define XB_TOP      3328
#define XB_TOPGEN   3392
#define XCD_BAR_WORDS 3456
#define XB_SPIN_CAP (1u << 22)

__device__ __forceinline__ unsigned xb_ld(unsigned* p)              { return __hip_atomic_load(p, __ATOMIC_RELAXED, __HIP_MEMORY_SCOPE_AGENT); }
__device__ __forceinline__ unsigned xb_add(unsigned* p, unsigned v) { return __hip_atomic_fetch_add(p, v, __ATOMIC_RELAXED, __HIP_MEMORY_SCOPE_AGENT); }
__device__ __forceinline__ unsigned xb_xcc_id() { return (unsigned)__builtin_amdgcn_s_getreg((3 << 11) | 20) & 0xFu; }
#define XB_SPIN(cond, bar) do { unsigned _sp = 0; while (cond) { __builtin_amdgcn_s_sleep(1); \
    if ((++_sp & 255u) == 0u) { if (xb_ld(&(bar)[XB_TMO])) break; if (_sp > XB_SPIN_CAP) { atomicAdd(&(bar)[XB_TMO], 1u); break; } } } } while (0)

struct XcdBarrier {
    unsigned* bar; unsigned x;
    volatile LAS unsigned* st;
};

__device__ __forceinline__ XcdBarrier xcd_barrier_post(unsigned* bar, volatile LAS unsigned* st) {
    XcdBarrier b; b.bar = bar; b.x = xb_xcc_id(); b.st = st;
    if (threadIdx.x == 0) (void)xb_add(&bar[XB_XCNT(b.x)], 1u);
    return b;
}
__device__ __forceinline__ void xcd_barrier_complete(unsigned* bar, unsigned x, unsigned& nloc, unsigned& nx) {
    const unsigned G = gridDim.x * gridDim.y * gridDim.z;
    unsigned sum, cnt, mine, sp = 0u;
    for (;;) {
        sum = 0u; cnt = 0u; mine = 0u;
#pragma unroll
        for (unsigned j = 0; j < 16; ++j) { const unsigned c = xb_ld(&bar[XB_XCNT(j)]); sum += c; cnt += (c > 0u) ? 1u : 0u; mine = (j == x) ? c : mine; }
        if (sum == G) break;
        __builtin_amdgcn_s_sleep(1);
        if ((++sp & 255u) == 0u) { if (xb_ld(&bar[XB_TMO])) break; if (sp > XB_SPIN_CAP) { atomicAdd(&bar[XB_TMO], 1u); break; } }
    }
    nloc = mine > 0u ? mine : 1u; nx = cnt > 0u ? cnt : 1u;
}

__device__ __forceinline__ void xcd_barrier(const XcdBarrier& b) {
    asm volatile("s_waitcnt vmcnt(0)" ::: "memory");
    __syncthreads();
    if (threadIdx.x == 0) {
        unsigned* bar = b.bar;
        __builtin_amdgcn_s_waitcnt(0);
        unsigned nloc = b.st[0], nx = b.st[1];
        if (nloc == 0u) { xcd_barrier_complete(bar, b.x, nloc, nx); b.st[0] = nloc; b.st[1] = nx; }
        const unsigned old = xb_add(&bar[XB_XSUB(b.x)], 1u);
        const unsigned gen = old / nloc;
        if (old + 1u == (gen + 1u) * nloc) {
            __builtin_amdgcn_fence(__ATOMIC_RELEASE, "agent");
            asm volatile("s_waitcnt vmcnt(0)" ::: "memory");
            const unsigned og = xb_add(&bar[XB_TOP], 1u);
            const unsigned tg = og / nx;
            if (og + 1u == (tg + 1u) * nx) xb_add(&bar[XB_TOPGEN], 1u);
            else XB_SPIN(xb_ld(&bar[XB_TOPGEN]) == tg, bar);
            __builtin_amdgcn_fence(__ATOMIC_ACQUIRE, "agent");
            xb_add(&bar[XB_XGEN(b.x)], 1u);
            asm volatile("s_waitcnt vmcnt(0)" ::: "memory");
        } else {
            XB_SPIN(xb_ld(&bar[XB_XGEN(b.x)]) == gen, bar);
            __builtin_amdgcn_fence(__ATOMIC_ACQUIRE, "agent");
            asm volatile("s_waitcnt vmcnt(0)" ::: "memory");
        }
    }
    __syncthreads();
}
struct Args { const float* in[34]; float* out; unsigned char* ws; int ph_lo, ph_hi; };
#define CAS __attribute__((address_space(4)))
struct KA {
    const CAS unsigned char* p;
    __device__ __forceinline__ const float* I(int i) const { return *(const float* const CAS*)(p + 8 * i); }
    __device__ __forceinline__ float* OUT() const { return *(float* const CAS*)(p + 8 * 34); }
    __device__ __forceinline__ unsigned char* WS() const { return *(unsigned char* const CAS*)(p + 8 * 35); }
    __device__ __forceinline__ int LO() const { return *(const CAS int*)(p + 8 * 36); }
    __device__ __forceinline__ int HI() const { return *(const CAS int*)(p + 8 * 36 + 4); }
};
__device__ __forceinline__ KA ka_fresh() { KA a; a.p = (const CAS unsigned char*)__builtin_amdgcn_kernarg_segment_ptr(); asm volatile("" : "+s"(a.p)); return a; }
static_assert(sizeof(Args) == 8 * 36 + 8, "kernarg layout");
struct Frame {
    LAS unsigned char* lds;
    volatile LAS unsigned* MISC;
    unsigned* ctl;
    int tid, lane, wave, vcu, G;
};
enum { I_X = 0, I_C, I_CTX, I_CCTX, I_ADAW, I_ADAB, I_N1G, I_N2G, I_ABWIN, I_ABWOUT, I_GLAWA, I_GLABA, I_GLANG, I_LAMRE, I_LAMIM, I_LOGSTEP, I_BRE, I_BIM, I_CRE, I_CIM,
       I_S5D, I_GLUW, I_GLUB, I_RETWIN, I_RETWOUT, I_RETDEC, I_RETNG, I_WROUTER, I_BROUTER, I_WGU, I_BGU, I_WDN, I_BDN, I_FNG };

constexpr int S5_ROWS = 2304, S5_CH = 272;
struct S5Par { float lr, li, step; };
__device__ __forceinline__ void s5_cpow(float lr, float li, float step, float n, float& ar, float& ai) { const float mag = expf(lr * step * n); float s, c; sincosf(li * step * n, &s, &c); ar = mag * c; ai = mag * s; }
__device__ __forceinline__ void s5_zoh_f(float lr, float li, float step, float& fr, float& fi) { float ar, ai; s5_cpow(lr, li, step, 1.0f, ar, ai); const float den = lr * lr + li * li;
    fr = ((ar - 1.0f) * lr + ai * li) / den; fi = (ai * lr - (ar - 1.0f) * li) / den; }
__device__ __forceinline__ void s5_table_item(const KA& A, int kind, int idx, bf16* W1T, bf16* W2T, LAS float* scr, int lane) {
    if (kind == 0) {
        const int g = idx >> 8, n = idx & 255, dir = n >> 7, ri = (n >> 6) & 1, p = n & 63;
        const float lr = A.I(I_LAMRE)[(dir * 32 + g) * 64 + p], li = A.I(I_LAMIM)[(dir * 32 + g) * 64 + p], step = expf(A.I(I_LOGSTEP)[dir * 32 + g]);
        float fr, fi; s5_zoh_f(lr, li, step, fr, fi);
        const int t = lane >> 2, c0 = (lane & 3) * 4;
        float ar, ai; s5_cpow(lr, li, step, (float)(dir ? t : 15 - t), ar, ai);
        const float gr = ar * fr - ai * fi, gi = ar * fi + ai * fr;
        float o[4];
#pragma unroll
        for (int j = 0; j < 4; ++j) { const float br = A.I(I_BRE)[(g * 64 + p) * 16 + c0 + j], bi = A.I(I_BIM)[(g * 64 + p) * 16 + c0 + j]; o[j] = ri ? (gr * bi + gi * br) : (gr * br - gi * bi); }
        v2u w; w.x = pk2(o[0], o[1]); w.y = pk2(o[2], o[3]);
        *(GAS v2u*)(W1T + ((size_t)g * 256 + n) * 256 + 4 * lane) = w;
    } else if (kind == 1) {
        const int g = idx >> 8, n = idx & 255, t = n >> 4, cp = n & 15;
        const int dir = lane >> 5, ri = (lane >> 4) & 1, p0 = (lane & 15) * 4;
        const float step = expf(A.I(I_LOGSTEP)[dir * 32 + g]);
        float o[4];
#pragma unroll
        for (int j = 0; j < 4; ++j) { const int p = p0 + j;
            const float lr = A.I(I_LAMRE)[(dir * 32 + g) * 64 + p], li = A.I(I_LAMIM)[(dir * 32 + g) * 64 + p];
            float ar, ai; s5_cpow(lr, li, step, (float)(dir ? 16 - t : t + 1), ar, ai);
            const float cr = A.I(I_CRE)[((dir * 32 + g) * 16 + cp) * 64 + p], ci = A.I(I_CIM)[((dir * 32 + g) * 16 + cp) * 64 + p];
            o[j] = ri ? -(cr * ai + ci * ar) : (cr * ar - ci * ai); }
        v2u w; w.x = pk2(o[0], o[1]); w.y = pk2(o[2], o[3]);
        *(GAS v2u*)(W2T + ((size_t)g * 256 + n) * 512 + 256 + 4 * lane) = w;
    } else {
        const int g = idx >> 4, tau = idx & 15;
        {
#pragma unroll
            for (int dir = 0; dir < 2; ++dir) { const float lr = A.I(I_LAMRE)[(dir * 32 + g) * 64 + lane], li = A.I(I_LAMIM)[(dir * 32 + g) * 64 + lane], step = expf(A.I(I_LOGSTEP)[dir * 32 + g]);
                float fr, fi, ar, ai; s5_zoh_f(lr, li, step, fr, fi); s5_cpow(lr, li, step, (float)tau, ar, ai);
                scr[(dir * 64 + lane) * 2] = ar * fr - ai * fi; scr[(dir * 64 + lane) * 2 + 1] = ar * fi + ai * fr; }
        }
        LDS_WAIT(); asm volatile("" ::: "memory");
        const int cp = lane >> 2, c0 = (lane & 3) * 4;
        float kf[4] = {0.f, 0.f, 0.f, 0.f}, kb2[4] = {0.f, 0.f, 0.f, 0.f};
        for (int p = 0; p < 64; ++p) {
            const f32x4 b4r = *(const f32x4*)(A.I(I_BRE) + (g * 64 + p) * 16 + c0), b4i = *(const f32x4*)(A.I(I_BIM) + (g * 64 + p) * 16 + c0);
#pragma unroll
            for (int dir = 0; dir < 2; ++dir) { const float gr = scr[(dir * 64 + p) * 2], gi = scr[(dir * 64 + p) * 2 + 1];
                const float cr = A.I(I_CRE)[((dir * 32 + g) * 16 + cp) * 64 + p], ci = A.I(I_CIM)[((dir * 32 + g) * 16 + cp) * 64 + p];
#pragma unroll
                for (int j = 0; j < 4; ++j) { const float xr = gr * b4r[j] - gi * b4i[j], xi = gr * b4i[j] + gi * b4r[j]; const float v = cr * xr - ci * xi;
                    if (dir == 0) kf[j] += v; else kb2[j] += v; } }
        }
        LDS_WAIT(); asm volatile("" ::: "memory");
        bf16* Wg = W2T + (size_t)g * 256 * 512;
        if (tau == 0) { v2u w; w.x = pk2(kf[0] + kb2[0], kf[1] + kb2[1]); w.y = pk2(kf[2] + kb2[2], kf[3] + kb2[3]);
            for (int t = 0; t < 16; ++t) *(GAS v2u*)(Wg + (size_t)(t * 16 + cp) * 512 + t * 16 + c0) = w;
        } else { v2u wf, wb; wf.x = pk2(kf[0], kf[1]); wf.y = pk2(kf[2], kf[3]); wb.x = pk2(kb2[0], kb2[1]); wb.y = pk2(kb2[2], kb2[3]);
            for (int t = tau; t < 16; ++t) *(GAS v2u*)(Wg + (size_t)(t * 16 + cp) * 512 + (t - tau) * 16 + c0) = wf;
            for (int t = 0; t + tau < 16; ++t) *(GAS v2u*)(Wg + (size_t)(t * 16 + cp) * 512 + (t + tau) * 16 + c0) = wb; }
    }
}
__device__ __forceinline__ void p_s5_scan(Frame& F, const float* SLOC, bf16* A2) {
    const KA A = ka_fresh();
    if (F.tid >= 128) return;
    for (int idx = F.vcu * 128 + F.tid; idx < NB * 32 * 2 * 64; idx += F.G * 128) {
        const int p = idx & 63, dir = (idx >> 6) & 1, g = (idx >> 7) & 31, b = idx >> 12;
        const float lr = A.I(I_LAMRE)[(dir * 32 + g) * 64 + p], li = A.I(I_LAMIM)[(dir * 32 + g) * 64 + p], step = expf(A.I(I_LOGSTEP)[dir * 32 + g]);
        float ar, ai; s5_cpow(lr, li, step, 16.0f, ar, ai);
        float sr = 0.f, si = 0.f;
        const size_t rbase = (size_t)g * S5_ROWS + (size_t)b * S5_CH;
        for (int q0 = 0; q0 < S5_CH; q0 += 16) {
            float lre[16], lim[16];
#pragma unroll
            for (int u = 0; u < 16; ++u) { const int q = q0 + u, n = dir ? (q < 16 ? 15 - q : 271 - (q - 16)) : q; const float* sp = SLOC + (rbase + n) * 256 + dir * 128 + p; lre[u] = sp[0]; lim[u] = sp[64]; }
#pragma unroll
            for (int u = 0; u < 16; ++u) { const int q = q0 + u, n = dir ? (q < 16 ? 15 - q : 271 - (q - 16)) : q; bf16* ap = A2 + (rbase + n) * 512 + 256 + dir * 128 + p;
                ap[0] = (bf16)f2bf(sr); ap[64] = (bf16)f2bf(si);
                const float nr = ar * sr - ai * si + lre[u], ni = ar * si + ai * sr + lim[u]; sr = nr; si = ni; }
        }
    }
}
__device__ __forceinline__ void tr_item(const float* src, int ldsrc, int K, int srccol, float scale, bf16* dst, int dstrow0, int k0, LAS float* scr, int lane) {
    if (srccol >= 0) {
        float t[32]; const float* sp = src + (size_t)(k0 + (lane >> 5)) * ldsrc + srccol + (lane & 31);
#pragma unroll
        for (int i = 0; i < 32; ++i) t[i] = sp[(size_t)(2 * i) * ldsrc];
#pragma unroll
        for (int i = 0; i < 32; ++i) scr[(2 * i + (lane >> 5)) * 33 + (lane & 31)] = t[i] * scale;
    } else {
#pragma unroll 8
        for (int i = 0; i < 32; ++i) { const int kk = 2 * i + (lane >> 5); scr[kk * 33 + (lane & 31)] = 0.f; }
    }
    LDS_WAIT(); asm volatile("" ::: "memory");
    const int c = lane & 7;
#pragma unroll
    for (int j = 0; j < 4; ++j) { const int n = (lane >> 3) + 8 * j; const LAS float* s = scr + (8 * c) * 33 + n;
        v4u o; o.x = pk2(s[0 * 33], s[1 * 33]); o.y = pk2(s[2 * 33], s[3 * 33]); o.z = pk2(s[4 * 33], s[5 * 33]); o.w = pk2(s[6 * 33], s[7 * 33]);
        *(GAS v4u*)(dst + (size_t)(dstrow0 + n) * K + k0 + 8 * c) = o; }
    LDS_WAIT(); asm volatile("" ::: "memory");
}
__device__ __forceinline__ void p0_prologue(Frame& F) {
    const KA A = ka_fresh();
    unsigned char* ws = A.WS();
    LAS float* scr = (LAS float*)(F.lds + F.wave * 8704);
    LAS float* sl = (LAS float*)(F.lds + 69632);
    for (int idx = F.tid; idx < 9 * 1024; idx += NTHR) { const int b = idx >> 10, k = idx & 1023; const float cv = b < 8 ? A.I(I_C)[b * 1024 + k] : A.I(I_CCTX)[k]; sl[k * 12 + b] = silu_(cv); }
    __syncthreads();
    const int gw = F.vcu * NWAVES + F.wave, NGW = F.G * NWAVES, lane = F.lane;
    for (int m = F.vcu; m < 192; m += F.G) {
        const int layer = m / 96, col = (m % 96) * 64 + lane;
        const float* w = A.I(I_ADAW) + (size_t)layer * 1024 * 6144 + (size_t)(F.wave * 128) * 6144 + col;
        float acc[9];
#pragma unroll
        for (int b = 0; b < 9; ++b) acc[b] = 0.f;
        for (int k0 = 0; k0 < 128; k0 += 16) {
            float wv[16];
#pragma unroll
            for (int u = 0; u < 16; ++u) wv[u] = w[(size_t)(k0 + u) * 6144];
#pragma unroll
            for (int u = 0; u < 16; ++u) {
#pragma unroll
                for (int b = 0; b < 9; ++b) acc[b] += sl[(F.wave * 128 + k0 + u) * 12 + b] * wv[u]; }
        }
        LAS float* red = (LAS float*)(F.lds);
#pragma unroll
        for (int b = 0; b < 9; ++b) red[(F.wave * 9 + b) * 64 + lane] = acc[b];
        __syncthreads();
        for (int idx = F.tid; idx < 9 * 64; idx += NTHR) { const int b = idx >> 6, l = idx & 63; float s = 0.f;
#pragma unroll
            for (int wv2 = 0; wv2 < 8; ++wv2) s += red[(wv2 * 9 + b) * 64 + l];
            const int c2 = (m % 96) * 64 + l;
            ((float*)(ws + WS_MOD))[(size_t)layer * 9 * 6144 + b * 6144 + c2] = s + A.I(I_ADAB)[layer * 6144 + c2]; }
        __syncthreads();
    }
    constexpr int I_S5A = 8192, I_S5B = 8192, I_S5C = 512, I_IN0 = 1152, I_OUT0 = 512, I_GLU = 128, I_IN1 = 3072, I_OUT1 = 1024, I_GU = 65536, I_DN = 32768;
    constexpr int NITEMS = I_S5A + I_S5B + I_S5C + I_IN0 + I_OUT0 + I_GLU + I_IN1 + I_OUT1 + I_GU + I_DN;
    for (int it = gw; it < NITEMS; it += NGW) {
        int r = it;
        if (r < I_S5A) { s5_table_item(A, 0, r, (bf16*)(ws + WS_S5W1), (bf16*)(ws + WS_S5W2), scr, lane); continue; }
        r -= I_S5A;
        if (r < I_S5B) { s5_table_item(A, 1, r, (bf16*)(ws + WS_S5W1), (bf16*)(ws + WS_S5W2), scr, lane); continue; }
        r -= I_S5B;
        if (r < I_S5C) { s5_table_item(A, 2, r, (bf16*)(ws + WS_S5W1), (bf16*)(ws + WS_S5W2), scr, lane); continue; }
        r -= I_S5C;
        if (r < I_IN0) { const int kb = r / 72, n0 = (r % 72) * 32;
            const int sc = n0 < 1536 ? n0 : (n0 < 2048 ? n0 + 32 : (n0 == 2048 ? 1536 : -1));
            tr_item(A.I(I_ABWIN), 2080, 1024, sc, n0 < 256 ? 0.125f : 1.0f, (bf16*)(ws + WS_WIN0T), n0, kb * 64, scr, lane); continue; }
        r -= I_IN0;
        if (r < I_OUT0) { tr_item(A.I(I_ABWOUT), 1024, 1024, (r % 32) * 32, 1.0f, (bf16*)(ws + WS_WOUT0T), (r % 32) * 32, (r / 32) * 64, scr, lane); continue; }
        r -= I_OUT0;
        if (r < I_GLU) { tr_item(A.I(I_GLUW), 512, 512, (r % 16) * 32, 1.0f, (bf16*)(ws + WS_WGLUT), (r % 16) * 32, (r / 16) * 64, scr, lane); continue; }
        r -= I_GLU;
        if (r < I_IN1) { const int n0 = (r % 192) * 32;
            tr_item(A.I(I_RETWIN), 6144, 1024, n0, (n0 >= 1024 && n0 < 2048) ? 0.0625f : 1.0f, (bf16*)(ws + WS_WIN1T), n0, (r / 192) * 64, scr, lane); continue; }
        r -= I_IN1;
        if (r < I_OUT1) { tr_item(A.I(I_RETWOUT), 1024, 2048, (r % 32) * 32, 1.0f, (bf16*)(ws + WS_WOUT1T), (r % 32) * 32, (r / 32) * 64, scr, lane); continue; }
        r -= I_OUT1;
        if (r < I_GU) { const int mat = r >> 10, q = r & 1023, kb = q >> 6, n0 = (q & 63) * 32;
            const int pn = n0 >> 8, bj = (n0 >> 7) & 1, lc = n0 & 127;
            tr_item(A.I(I_WGU) + (size_t)mat * 1024 * 2048, 2048, 1024, bj * 1024 + pn * 128 + lc, 1.0f, (bf16*)(ws + WS_WGUT) + (size_t)mat * 2048 * 1024, n0, kb * 64, scr, lane); continue; }
        r -= I_GU;
        { const int mat = r >> 9, q = r & 511, kb = q >> 5, n0 = (q & 31) * 32;
          tr_item(A.I(I_WDN) + (size_t)mat * 1024 * 1024, 1024, 1024, n0, 1.0f, (bf16*)(ws + WS_WDNT) + (size_t)mat * 1024 * 1024, n0, kb * 64, scr, lane); }
    }
}
__device__ __forceinline__ void modnorm_store(const f32x4 (&v)[4], const float* g, const float* sc, const float* sh, bf16* hrow, int lane, f32x4 (&h)[4]) {
    float ss = 0.f;
#pragma unroll
    for (int j = 0; j < 4; ++j) ss += (v[j].x * v[j].x + v[j].y * v[j].y) + (v[j].z * v[j].z + v[j].w * v[j].w);
    const float r = rsqrtf(wave_sum(ss) * (1.0f / 1024.0f) + EPS);
#pragma unroll
    for (int j = 0; j < 4; ++j) { const int o = 64 * j + lane;
        const f32x4 gg = ((const f32x4*)g)[o], s4 = ((const f32x4*)sc)[o], h4 = ((const f32x4*)sh)[o];
        h[j] = v[j] * r * gg * (s4 + 1.0f) + h4;
        v2u w; w.x = pk2(h[j].x, h[j].y); w.y = pk2(h[j].z, h[j].w);
        ((GAS v2u*)hrow)[o] = w; }
}
__device__ __forceinline__ int bidx_of_row(int row) { return row < NCTX ? 8 : ((row - NCTX) >> 12); }
__device__ __forceinline__ void p_norm1_l0(Frame& F) {
    const KA A = ka_fresh();
    const int gw = F.vcu * NWAVES + F.wave, NGW = F.G * NWAVES, lane = F.lane;
    const float* mod = (const float*)(A.WS() + WS_MOD);
    bf16* H = (bf16*)(A.WS() + WS_H);
    for (int row = gw; row < MALL; row += NGW) {
        const float* xr = row < NCTX ? A.I(I_CTX) + (size_t)row * 1024 : A.I(I_X) + (size_t)(row - NCTX) * 1024;
        f32x4 v[4], h[4];
#pragma unroll
        for (int j = 0; j < 4; ++j) v[j] = ((const f32x4*)xr)[64 * j + lane];
        const float* m = mod + bidx_of_row(row) * 6144;
        modnorm_store(v, A.I(I_N1G), m + 1024, m, H + (size_t)row * 1024, lane, h);
    }
}
__device__ __forceinline__ int seq_row(int b, int dir, int s) {
    return s < CTX ? b * CTX + (dir ? CTX - 1 - s : s) : NCTX + b * SEQ + (dir ? SEQ - 1 - (s - CTX) : (s - CTX));
}
template <int DK, bool GLA>
__device__ __forceinline__ void rec_naive(Frame& F, const bf16* P, int ldp, int qc, int kc, int vc, int DV, int nvs,
                                          float* O, size_t odir_stride, int ldo, int orow0) {
    const KA A = ka_fresh();
    constexpr int KPW = DK / 8, TB = 16;
    LAS float* qs = (LAS float*)(F.lds);
    LAS float* ks = (LAS float*)(F.lds + 16384);
    LAS float* vv = (LAS float*)(F.lds + 32768);
    LAS float* dec = (LAS float*)(F.lds + 36864);
    LAS float* opart = (LAS float*)(F.lds + 40960);
    const int tid = F.tid, lane = F.lane, wave = F.wave;
    const int nitems = NB * 4 * 2 * nvs;
    for (int it = F.vcu; it < nitems; it += F.G) {
        const int vs = it % nvs, dir = (it / nvs) & 1, h = (it / (2 * nvs)) & 3, b = it / (8 * nvs);
        float gamma = 0.f;
        if (!GLA) { const float lg = A.I(I_RETDEC)[dir * 4 + h]; gamma = 1.0f / (1.0f + expf(-lg)); }
        float S[KPW];
#pragma unroll
        for (int i = 0; i < KPW; ++i) S[i] = 0.f;
        for (int s0 = 0; s0 < CTX + SEQ; s0 += TB) {
            for (int idx = tid; idx < TB * DK; idx += NTHR) { const int i = idx / DK, kk = idx % DK; const size_t rb = (size_t)seq_row(b, dir, s0 + i) * ldp;
                qs[idx] = bf2f(P[rb + qc + h * DK + kk]); ks[idx] = bf2f(P[rb + kc + h * DK + kk]); }
            for (int idx = tid; idx < TB * 64; idx += NTHR) { const int i = idx >> 6, c = idx & 63; const size_t rb = (size_t)seq_row(b, dir, s0 + i) * ldp;
                vv[idx] = bf2f(P[rb + vc + h * DV + vs * 64 + c]);
                if (GLA) { float z = A.I(I_GLABA)[dir * 256 + h * 64 + c];
#pragma unroll
                    for (int r = 0; r < 16; ++r) z += bf2f(P[rb + C0_LOW + dir * 16 + r]) * A.I(I_GLAWA)[(dir * 16 + r) * 256 + h * 64 + c];
                    const float ls = fminf(z, 0.f) - log1pf(expf(-fabsf(z)));
                    dec[idx] = expf(ls * (1.0f / 16.0f)); } }
            __syncthreads();
#pragma unroll 1
            for (int i = 0; i < TB; ++i) { const float vval = vv[i * 64 + lane]; float part = 0.f;
#pragma unroll
                for (int kk = 0; kk < KPW; ++kk) { const int kidx = wave * KPW + kk; const float d = GLA ? dec[i * 64 + kidx] : gamma;
                    S[kk] = d * S[kk] + ks[i * DK + kidx] * vval; part += qs[i * DK + kidx] * S[kk]; }
                opart[(i * 8 + wave) * 64 + lane] = part; }
            __syncthreads();
            for (int idx = tid; idx < TB * 64; idx += NTHR) { const int i = idx >> 6, c = idx & 63; float sum = 0.f;
#pragma unroll
                for (int w = 0; w < 8; ++w) sum += opart[(i * 8 + w) * 64 + c];
                const int row = seq_row(b, dir, s0 + i);
                if (row >= orow0) O[(size_t)dir * odir_stride + (size_t)(row - orow0) * ldo + h * DV + vs * 64 + c] = sum; }
        }
        __syncthreads();
    }
}
__device__ __forceinline__ void s5_naive(Frame& F, const bf16* P, float* Y  ) {
    const KA A = ka_fresh();
    const int lane = F.lane;
    if (F.wave >= 2) return;
    for (int chain = F.vcu * 2 + F.wave; chain < NB * 32 * 2; chain += F.G * 2) {
        const int dir = chain & 1, g = (chain >> 1) & 31, b = chain >> 6;
        const float step = expf(A.I(I_LOGSTEP)[dir * 32 + g]);
        const float lr = A.I(I_LAMRE)[(dir * 32 + g) * 64 + lane], li = A.I(I_LAMIM)[(dir * 32 + g) * 64 + lane];
        const float mag = expf(lr * step), lbr = mag * cosf(li * step), lbi = mag * sinf(li * step), den = lr * lr + li * li;
        const float fr = ((lbr - 1.0f) * lr + lbi * li) / den, fi = (lbi * lr - (lbr - 1.0f) * li) / den;
        float bbr[16], bbi[16], cr[16], ci[16];
#pragma unroll
        for (int c = 0; c < 16; ++c) { const float br = A.I(I_BRE)[(g * 64 + lane) * 16 + c], bi = A.I(I_BIM)[(g * 64 + lane) * 16 + c];
            bbr[c] = fr * br - fi * bi; bbi[c] = fr * bi + fi * br;
            cr[c] = A.I(I_CRE)[((dir * 32 + g) * 16 + c) * 64 + lane]; ci[c] = A.I(I_CIM)[((dir * 32 + g) * 16 + c) * 64 + lane]; }
        float sr = 0.f, si = 0.f;
        for (int s0 = 0; s0 < CTX + SEQ; s0 += 4) {
            v4u uu[4][2];
#pragma unroll
            for (int i = 0; i < 4; ++i) { const v4u* up = (const v4u*)(P + (size_t)seq_row(b, dir, s0 + i) * N0 + C0_U + g * 16); uu[i][0] = up[0]; uu[i][1] = up[1]; }
#pragma unroll
            for (int i = 0; i < 4; ++i) {
                float u[16];
#pragma unroll
                for (int q = 0; q < 2; ++q) { u[8 * q + 0] = blo(uu[i][q].x); u[8 * q + 1] = bhi(uu[i][q].x); u[8 * q + 2] = blo(uu[i][q].y); u[8 * q + 3] = bhi(uu[i][q].y);
                    u[8 * q + 4] = blo(uu[i][q].z); u[8 * q + 5] = bhi(uu[i][q].z); u[8 * q + 6] = blo(uu[i][q].w); u[8 * q + 7] = bhi(uu[i][q].w); }
                float br = 0.f, bi = 0.f;
#pragma unroll
                for (int c = 0; c < 16; ++c) { br += bbr[c] * u[c]; bi += bbi[c] * u[c]; }
                const float nr = lbr * sr - lbi * si + br, ni = lbr * si + lbi * sr + bi; sr = nr; si = ni;
                float v[16];
#pragma unroll
                for (int c = 0; c < 16; ++c) v[c] = cr[c] * sr - ci[c] * si;
                const bool b5 = (lane & 32) != 0, b4 = (lane & 16) != 0, b3 = (lane & 8) != 0, b2 = (lane & 4) != 0;
                float w8[8], w4[4], w2[2];
#pragma unroll
                for (int k = 0; k < 8; ++k) { const float send = b5 ? v[k] : v[k + 8], keep = b5 ? v[k + 8] : v[k]; w8[k] = keep + __shfl_xor(send, 32); }
#pragma unroll
                for (int k = 0; k < 4; ++k) { const float send = b4 ? w8[k] : w8[k + 4], keep = b4 ? w8[k + 4] : w8[k]; w4[k] = keep + __shfl_xor(send, 16); }
#pragma unroll
                for (int k = 0; k < 2; ++k) { const float send = b3 ? w4[k] : w4[k + 2], keep = b3 ? w4[k + 2] : w4[k]; w2[k] = keep + __shfl_xor(send, 8); }
                float w1; { const float send = b2 ? w2[0] : w2[1], keep = b2 ? w2[1] : w2[0]; w1 = keep + __shfl_xor(send, 4); }
                w1 += __shfl_xor(w1, 2); w1 += __shfl_xor(w1, 1);
                const int c = (b5 ? 8 : 0) + (b4 ? 4 : 0) + (b3 ? 2 : 0) + (b2 ? 1 : 0);
                if ((lane & 3) == 0) Y[(size_t)dir * MALL * 512 + (size_t)seq_row(b, dir, s0 + i) * 512 + g * 16 + c] = w1;
            }
        }
    }
}
__device__ __forceinline__ void unpack8(const v4u w, float (&f)[8]) { f[0] = blo(w.x); f[1] = bhi(w.x); f[2] = blo(w.y); f[3] = bhi(w.y); f[4] = blo(w.z); f[5] = bhi(w.z); f[6] = blo(w.w); f[7] = bhi(w.w); }
__device__ __forceinline__ v4u pack8(const float (&f)[8]) { v4u w; w.x = pk2(f[0], f[1]); w.y = pk2(f[2], f[3]); w.z = pk2(f[4], f[5]); w.w = pk2(f[6], f[7]); return w; }
__device__ __forceinline__ void p_finish0(Frame& F) {
    const KA A = ka_fresh();
    const int gw = F.vcu * NWAVES + F.wave, NGW = F.G * NWAVES, lane = F.lane, e0 = lane * 8;
    const bf16* P = (const bf16*)(A.WS() + WS_PROJ);
    const float* GO = (const float*)(A.WS() + WS_OREC);
    const float* SY = GO + (size_t)2 * MALL * 512;
    bf16* MIX = (bf16*)(A.WS() + WS_MIX); bf16* YP = (bf16*)(A.WS() + WS_YPRE);
    for (int row = gw; row < MALL; row += NGW) {
        float o[8], gg[8], ng[8];
#if MK_NAIVE_GLA
        { const f32x4* a = (const f32x4*)(GO + (size_t)row * 512 + e0); const f32x4* bq = (const f32x4*)(GO + (size_t)(MALL + row) * 512 + e0);
          const f32x4 a0 = a[0] + bq[0], a1 = a[1] + bq[1]; o[0] = a0.x; o[1] = a0.y; o[2] = a0.z; o[3] = a0.w; o[4] = a1.x; o[5] = a1.y; o[6] = a1.z; o[7] = a1.w; }
#else
        { const bf16* GO16 = (const bf16*)GO; float f0[8], f1[8]; unpack8(*(const v4u*)(GO16 + (size_t)row * 512 + e0), f0); unpack8(*(const v4u*)(GO16 + (size_t)(MALL + row) * 512 + e0), f1);
#pragma unroll
          for (int j = 0; j < 8; ++j) o[j] = f0[j] + f1[j]; }
#endif
        float ss = 0.f;
#pragma unroll
        for (int j = 0; j < 8; ++j) ss += o[j] * o[j];
        ss += __shfl_xor(ss, 1); ss += __shfl_xor(ss, 2); ss += __shfl_xor(ss, 4); ss += __shfl_xor(ss, 8);
        const float r = rsqrtf(ss * (1.0f / 128.0f) + EPS);
        unpack8(*(const v4u*)(P + (size_t)row * N0 + C0_G + e0), gg);
        { const f32x4* n4 = (const f32x4*)(A.I(I_GLANG) + (e0 & 127)); const f32x4 n0 = n4[0], n1 = n4[1]; ng[0] = n0.x; ng[1] = n0.y; ng[2] = n0.z; ng[3] = n0.w; ng[4] = n1.x; ng[5] = n1.y; ng[6] = n1.z; ng[7] = n1.w; }
        float res[8];
#pragma unroll
        for (int j = 0; j < 8; ++j) res[j] = o[j] * r * ng[j] * silu_(gg[j]);
        *(GAS v4u*)(MIX + (size_t)row * 1024 + e0) = pack8(res);
#if MK_NAIVE_S5
        float u[8], y[8];
        unpack8(*(const v4u*)(P + (size_t)row * N0 + C0_U + e0), u);
        { const f32x4* a = (const f32x4*)(SY + (size_t)row * 512 + e0); const f32x4* bq = (const f32x4*)(SY + (size_t)(MALL + row) * 512 + e0);
          const f32x4 a0 = a[0] + bq[0], a1 = a[1] + bq[1]; y[0] = a0.x; y[1] = a0.y; y[2] = a0.z; y[3] = a0.w; y[4] = a1.x; y[5] = a1.y; y[6] = a1.z; y[7] = a1.w; }
#pragma unroll
        for (int j = 0; j < 8; ++j) { const float t = y[j] + A.I(I_S5D)[e0 + j] * u[j]; res[j] = 0.5f * t * (1.0f + tanhf(0.7978845608f * (t + 0.044715f * t * t * t))); }
        *(GAS v4u*)(YP + (size_t)row * 512 + e0) = pack8(res);
#endif
    }
}
__device__ __forceinline__ void p_finish1(Frame& F) {
    const KA A = ka_fresh();
    const int gw = F.vcu * NWAVES + F.wave, NGW = F.G * NWAVES, lane = F.lane;
    const bf16* P = (const bf16*)(A.WS() + WS_PROJ);
    const float* RO = (const float*)(A.WS() + WS_OREC);
    bf16* MIX = (bf16*)(A.WS() + WS_MIX);
    for (int lrow = gw; lrow < NLAT; lrow += NGW) {
#pragma unroll 1
        for (int h = 0; h < 4; ++h) { const int e0 = h * 512 + lane * 8;
            float o[8], gg[8];
#if MK_NAIVE_RET
            { const f32x4* a = (const f32x4*)(RO + (size_t)lrow * 2048 + e0); const f32x4* bq = (const f32x4*)(RO + (size_t)(NLAT + lrow) * 2048 + e0);
              const f32x4 a0 = a[0] + bq[0], a1 = a[1] + bq[1]; o[0] = a0.x; o[1] = a0.y; o[2] = a0.z; o[3] = a0.w; o[4] = a1.x; o[5] = a1.y; o[6] = a1.z; o[7] = a1.w; }
#else
            { const bf16* RO16 = (const bf16*)RO; float f0[8], f1[8]; unpack8(*(const v4u*)(RO16 + (size_t)lrow * 2048 + e0), f0); unpack8(*(const v4u*)(RO16 + (size_t)(NLAT + lrow) * 2048 + e0), f1);
#pragma unroll
              for (int j = 0; j < 8; ++j) o[j] = f0[j] + f1[j]; }
#endif
            float s = 0.f;
#pragma unroll
            for (int j = 0; j < 8; ++j) s += o[j];
            const float mu = wave_sum(s) * (1.0f / 512.0f); float q = 0.f;
#pragma unroll
            for (int j = 0; j < 8; ++j) { o[j] -= mu; q += o[j] * o[j]; }
            const float r = rsqrtf(wave_sum(q) * (1.0f / 512.0f) + EPS);
            unpack8(*(const v4u*)(P + (size_t)(NCTX + lrow) * N1 + C1_G + e0), gg);
            float res[8];
#pragma unroll
            for (int j = 0; j < 8; ++j) res[j] = o[j] * r * A.I(I_RETNG)[e0 + j] * silu_(gg[j]);
            *(GAS v4u*)(MIX + (size_t)lrow * 2048 + e0) = pack8(res); }
    }
}
__device__ __forceinline__ void p_rope(Frame& F) {
    const KA A = ka_fresh();
    const int gw = F.vcu * NWAVES + F.wave, NGW = F.G * NWAVES, lane = F.lane;
    bf16* P = (bf16*)(A.WS() + WS_PROJ);
    LAS float* ct = (LAS float*)F.lds;
    LAS float* st = ct + 4096;
    for (int i = F.tid; i < 4096; i += NTHR) { const int pos = i >> 6, fi = i & 63; float sn, cs; sincosf((float)pos * expf(-(float)fi * (9.210340371976184f / 64.0f)), &sn, &cs); ct[i] = cs; st[i] = sn; }
    __syncthreads();
    for (int lrow = gw; lrow < NLAT; lrow += NGW) {
        const int t = lrow & (SEQ - 1), pr = t >> 6, pc = t & 63;
        bf16* rp = P + (size_t)(NCTX + lrow) * N1;
        v4u a[2], b2[2]; int off[2], pos[2], f0[2];
#pragma unroll
        for (int q = 0; q < 2; ++q) { const int task = lane + 64 * q, tens = task >> 4, half = (task >> 3) & 1, ch = task & 7;
            off[q] = tens * 256 + half * 128 + ch * 8; pos[q] = half ? pc : pr; f0[q] = ch * 8;
            a[q] = *(const v4u*)(rp + off[q]); b2[q] = *(const v4u*)(rp + off[q] + 64); }
#pragma unroll
        for (int q = 0; q < 2; ++q) { float x[8], y[8], xo[8], yo[8]; unpack8(a[q], x); unpack8(b2[q], y);
            const f32x4 c0 = *(const LAS f32x4*)(ct + pos[q] * 64 + f0[q]), c1 = *(const LAS f32x4*)(ct + pos[q] * 64 + f0[q] + 4), s0 = *(const LAS f32x4*)(st + pos[q] * 64 + f0[q]), s1 = *(const LAS f32x4*)(st + pos[q] * 64 + f0[q] + 4);
#pragma unroll
            for (int j = 0; j < 8; ++j) { const float cs = j < 4 ? c0[j & 3] : c1[j & 3], sn = j < 4 ? s0[j & 3] : s1[j & 3]; xo[j] = x[j] * cs - y[j] * sn; yo[j] = x[j] * sn + y[j] * cs; }
            *(GAS v4u*)(rp + off[q]) = pack8(xo); *(GAS v4u*)(rp + off[q] + 64) = pack8(yo); }
    }
}
__device__ __forceinline__ void p_router(Frame& F, int layer) {
    const KA A = ka_fresh();
    const int tid = F.tid, lane = F.lane, wave = F.wave;
    const int moe_row0 = layer ? NCTX : 0, NTOK = layer ? NLAT : MALL;
    const int RPB = (NTOK + F.G - 1) / F.G;
    unsigned char* ws = A.WS();
    int* prow = (int*)(ws + WS_PROW); int* sel_e = (int*)(ws + WS_SELE); float* w_slot = (float*)(ws + WS_WSLOT); int* slot_pos = (int*)(ws + WS_SPOS);
    LAS float* Wt = (LAS float*)F.lds;
    LAS int* lcnt = (LAS int*)(F.lds + L_LCNT); LAS int* gbase = (LAS int*)(F.lds + L_GBASE);
    LAS int* blk_e = (LAS int*)(F.lds + L_BLKE); LAS int* blk_p = (LAS int*)(F.lds + L_BLKP);
    const float* wr = A.I(I_WROUTER) + (size_t)layer * 1024 * 32;
    for (int idx = tid; idx < 32768; idx += NTHR) Wt[(idx & 31) * 1024 + (idx >> 5)] = wr[idx];
    if (tid < 32) lcnt[tid] = 0;
    __syncthreads();
    const float* mod = (const float*)(ws + WS_MOD) + (size_t)layer * 9 * 6144;
    const bf16* XR = (const bf16*)(ws + WS_XRES); bf16* H = (bf16*)(ws + WS_H);
    const int tok0 = F.vcu * RPB;
    for (int lr = wave; lr < RPB; lr += NWAVES) {
        const int tok = tok0 + lr; if (tok >= NTOK) break;
        const int row = moe_row0 + tok;
        f32x4 v[4], h[4];
#pragma unroll
        for (int j = 0; j < 4; ++j) { const v2u xw = ((const v2u*)(XR + (size_t)row * 1024))[64 * j + lane]; v[j] = (f32x4){blo(xw.x), bhi(xw.x), blo(xw.y), bhi(xw.y)}; }
        const float* m = mod + bidx_of_row(row) * 6144;
        modnorm_store(v, A.I(I_N2G) + layer * 1024, m + 4096, m + 3072, H + (size_t)row * 1024, lane, h);
        float pa[32];
#pragma unroll
        for (int e = 0; e < 32; ++e) { float a = 0.f;
#pragma unroll
            for (int j = 0; j < 4; ++j) { const f32x4 w4 = *(const LAS f32x4*)(Wt + e * 1024 + 4 * (64 * j + lane)); a += (h[j].x * w4.x + h[j].y * w4.y) + (h[j].z * w4.z + h[j].w * w4.w); }
            pa[e] = a; }
        float myl;
        { const bool b5 = (lane & 32) != 0, b4 = (lane & 16) != 0, b3 = (lane & 8) != 0, b2 = (lane & 4) != 0, b1 = (lane & 2) != 0;
          float w16[16], w8[8], w4[4], w2[2];
#pragma unroll
          for (int k = 0; k < 16; ++k) { const float send = b5 ? pa[k] : pa[k + 16], keep = b5 ? pa[k + 16] : pa[k]; w16[k] = keep + __shfl_xor(send, 32); }
#pragma unroll
          for (int k = 0; k < 8; ++k) { const float send = b4 ? w16[k] : w16[k + 8], keep = b4 ? w16[k + 8] : w16[k]; w8[k] = keep + __shfl_xor(send, 16); }
#pragma unroll
          for (int k = 0; k < 4; ++k) { const float send = b3 ? w8[k] : w8[k + 4], keep = b3 ? w8[k + 4] : w8[k]; w4[k] = keep + __shfl_xor(send, 8); }
#pragma unroll
          for (int k = 0; k < 2; ++k) { const float send = b2 ? w4[k] : w4[k + 2], keep = b2 ? w4[k + 2] : w4[k]; w2[k] = keep + __shfl_xor(send, 4); }
          { const float send = b1 ? w2[0] : w2[1], keep = b1 ? w2[1] : w2[0]; myl = keep + __shfl_xor(send, 2); }
          myl += __shfl_xor(myl, 1); }
        const int mye = lane >> 1;
        myl += A.I(I_BROUTER)[layer * 32 + mye];
        float bv[4]; int bi[4];
#pragma unroll
        for (int r = 0; r < 4; ++r) { float v = myl; int id = mye;
#pragma unroll
            for (int o = 1; o < 64; o <<= 1) { const float ov = __shfl_xor(v, o); const int oi = __shfl_xor(id, o); const bool take = ov > v || (ov == v && oi < id); v = take ? ov : v; id = take ? oi : id; }
            bv[r] = v; bi[r] = id; myl = (mye == id) ? -INFINITY : myl; }
        const float e1 = __expf(bv[1] - bv[0]), e2 = __expf(bv[2] - bv[0]), e3 = __expf(bv[3] - bv[0]), inv = 1.0f / (1.0f + e1 + e2 + e3);
        if (lane < 4) { const int ee = lane == 0 ? bi[0] : (lane == 1 ? bi[1] : (lane == 2 ? bi[2] : bi[3]));
            const float wv = (lane == 0 ? 1.0f : (lane == 1 ? e1 : (lane == 2 ? e2 : e3))) * inv;
            sel_e[tok * 4 + lane] = ee; w_slot[tok * 4 + lane] = wv;
            const int lp = __hip_atomic_fetch_add(lcnt + ee, 1, __ATOMIC_RELAXED, __HIP_MEMORY_SCOPE_WORKGROUP);
            blk_e[lr * 4 + lane] = ee; blk_p[lr * 4 + lane] = lp; }
    }
    __syncthreads();
    if (tid < 32) gbase[tid] = (int)__hip_atomic_fetch_add(F.ctl + CW_GCNT + 64 * layer + tid, (unsigned)lcnt[tid], RLX_AGENT);
    __syncthreads();
    int* elist = (int*)(ws + WS_ELIST);
    for (int idx = tid; idx < RPB * 4; idx += NTHR) { const int tok = tok0 + (idx >> 2); if (tok < NTOK) { const int e = blk_e[idx]; elist[(size_t)e * MALL + gbase[e] + blk_p[idx]] = tok * 4 + (idx & 3); } }
}
__device__ __forceinline__ int moe_tables(Frame& F, int layer) {
    LAS int* ts = (LAS int*)(F.lds + L_TSTART); LAS unsigned char* te = (LAS unsigned char*)(F.lds + L_TILEE);
    __syncthreads();
    if (F.tid == 0) { int acc = 0;
        for (int e = 0; e < 32; ++e) { ts[e] = acc; acc += ((int)__hip_atomic_load(F.ctl + CW_GCNT + 64 * layer + e, RLX_AGENT) + 255) >> 8; }
        ts[32] = acc > MAXTILES ? MAXTILES : acc; }
    __syncthreads();
    const int nt = ts[32];
    LAS int* tpos = (LAS int*)(F.lds + L_TPOS); LAS int* tcnt = (LAS int*)(F.lds + L_TCNT);
    for (int T = F.tid; T < nt; T += NTHR) { int e = 0;
        for (int q = 1; q < 32; ++q) e = (T >= ts[q]) ? q : e;
        te[T] = (unsigned char)e; tpos[T] = (T - ts[e]) * 256; tcnt[T] = (int)__hip_atomic_load(F.ctl + CW_GCNT + 64 * layer + e, RLX_AGENT); }
    __syncthreads();
    return nt;
}
__device__ __forceinline__ void p_combine(Frame& F, int layer, bool dry) {
    const KA A = ka_fresh();
    const int gw = F.vcu * NWAVES + F.wave, NGW = F.G * NWAVES, lane = F.lane;
    const int moe_row0 = layer ? NCTX : 0, NTOK = layer ? NLAT : MALL;
    unsigned char* ws = A.WS();
    const bf16* XR = (const bf16*)(ws + WS_XRES); bf16* XW = dry ? (bf16*)(ws + WS_PROJ) : (bf16*)(ws + WS_XRES); bf16* H = dry ? (bf16*)(ws + WS_PROJ + 160 * MiB) : (bf16*)(ws + WS_H); const bf16* YS = (const bf16*)(ws + WS_YSLOT);
    float* OUTP = dry ? (float*)(ws + WS_PROJ) : A.OUT();
    const float* mod = (const float*)(ws + WS_MOD);
    float palpha = 1.0f;
#if defined(MK_PROBE) && MK_PROBE >= 0
    {
      const unsigned* st = F.ctl + 20000 + 2 * MK_PROBE;
      const unsigned long long t0 = ((unsigned long long)__hip_atomic_load(st + 1, RLX_AGENT) << 32) | __hip_atomic_load(st, RLX_AGENT), t1 = ((unsigned long long)__hip_atomic_load(st + 3, RLX_AGENT) << 32) | __hip_atomic_load(st + 2, RLX_AGENT);
      palpha = 1.0f + exp2f((float)(t1 - t0) * 0.01f * 0.01f * 3.321928095f); }
#endif
    for (int tok = gw; tok < NTOK; tok += NGW) {
        const int row = moe_row0 + tok, bidx = bidx_of_row(row);
        const float* g2 = mod + (size_t)layer * 9 * 6144 + bidx * 6144 + 5120;
        f32x4 v[4];
#pragma unroll
        for (int j = 0; j < 4; ++j) { const int o = 64 * j + lane; f32x4 y = (f32x4){0.f, 0.f, 0.f, 0.f};
#pragma unroll
            for (int k = 0; k < 4; ++k) { const v2u w = ((const v2u*)(YS + (size_t)(tok * 4 + k) * 1024))[o]; y += (f32x4){blo(w.x), bhi(w.x), blo(w.y), bhi(w.y)}; }
            const v2u xw = ((const v2u*)(XR + (size_t)row * 1024))[o];
            v[j] = (f32x4){blo(xw.x), bhi(xw.x), blo(xw.y), bhi(xw.y)} + ((const f32x4*)g2)[o] * y; }
        if (layer == 0) {
#pragma unroll
            for (int j = 0; j < 4; ++j) { v2u w; w.x = pk2(v[j].x, v[j].y); w.y = pk2(v[j].z, v[j].w); ((GAS v2u*)(XW + (size_t)row * 1024))[64 * j + lane] = w; }
            const float* m1 = mod + (size_t)9 * 6144 + bidx * 6144; f32x4 h[4];
            modnorm_store(v, A.I(I_N1G) + 1024, m1 + 1024, m1, H + (size_t)row * 1024, lane, h);
        } else {
            float ss = 0.f;
#pragma unroll
            for (int j = 0; j < 4; ++j) ss += (v[j].x * v[j].x + v[j].y * v[j].y) + (v[j].z * v[j].z + v[j].w * v[j].w);
            const float r = rsqrtf(wave_sum(ss) * (1.0f / 1024.0f) + EPS);
#pragma unroll
            for (int j = 0; j < 4; ++j) { const int o = 64 * j + lane; ((f32x4*)(OUTP + (size_t)tok * 1024))[o] = v[j] * (r * palpha) * ((const f32x4*)A.I(I_FNG))[o]; }
        }
    }
}
typedef short s16x4 __attribute__((ext_vector_type(4)));
typedef short bfx8 __attribute__((ext_vector_type(8)));
typedef short v4i16_t __attribute__((ext_vector_type(4)));
#define MFMA16(a, b, c) __builtin_amdgcn_mfma_f32_16x16x32_bf16((a), (b), (c), 0, 0, 0)
__device__ __forceinline__ bfx8 frag_n(const LAS unsigned char* tile, int stride, int r0, int k0, int lane) {
    return *(const LAS bfx8*)(tile + (r0 + (lane & 15)) * stride + (k0 + 8 * (lane >> 4)) * 2);
}
__device__ __forceinline__ bfx8 frag_t(const LAS unsigned char* tile, int stride, int k0, int n0, int lane) {
    const int g = lane >> 4, q = (lane & 15) >> 2, p = lane & 3;
    const LAS unsigned char* a = tile + (k0 + 8 * g + q) * stride + (n0 + 4 * p) * 2;
    const s16x4 lo = __builtin_bit_cast(s16x4, __builtin_amdgcn_ds_read_tr16_b64_v4i16((LAS v4i16_t*)a));
    const s16x4 hi = __builtin_bit_cast(s16x4, __builtin_amdgcn_ds_read_tr16_b64_v4i16((LAS v4i16_t*)(a + 4 * stride)));
    return __builtin_shufflevector(lo, hi, 0, 1, 2, 3, 4, 5, 6, 7);
}
__device__ __forceinline__ v4u scale8(const v4u w, float s) { float f[8]; unpack8(w, f);
#pragma unroll
    for (int j = 0; j < 8; ++j) f[j] *= s;
    return pack8(f); }

template <int DK, int DVS, bool GLA, bool INTRA = true>
__device__ __forceinline__ void rec_mfma(Frame& F, const bf16* Qsrc, const bf16* Ksrc, const bf16* K2src, size_t qdir_stride, int ldq, int qcol, int kcol,
                                         const bf16* Vsrc, int ldv, int vcol, int DV, const float* EB,
                                         bf16* O, size_t odir_stride, int ldo, int orow0) {
    const KA A = ka_fresh();
    constexpr int SQ = DK * 2 + 16, SV = DVS * 2 + 16, SP = 144, SS = DK * 2 + 16;
    constexpr int O_QD = 0, O_KI = O_QD + 64 * SQ, O_KS = O_KI + 64 * SQ, O_V = O_KS + (GLA ? 64 * SQ : 0), O_VD = O_V + 64 * SV, O_P = O_VD + (GLA ? 0 : 64 * SV), O_ST = O_P + 64 * SP, O_EB = O_ST + DVS * SS;
    static_assert(O_EB + DK * 4 <= RING_BYTES, "rec_mfma LDS");
    constexpr int NVS = 0;  (void)NVS;
    constexpr int VT_PER = DVS / 32, KT_PER = DK / 64, QCH = DK / 8  , QN = (64 * QCH) / NTHR, VCH = DVS / 8, KSTEPS = DK / 32;
    static_assert(QN >= 1 && VT_PER >= 1 && KT_PER >= 1, "shape");
    const LAS unsigned char* L = F.lds;
    const int tid = F.tid, lane = F.lane, w = F.wave, it = w & 3, vg = w >> 2, kg = w & 3, g4 = lane >> 4, l15 = lane & 15;
    const int nvs = DV / DVS, nitems = NB * 4 * 2 * nvs;
    for (int item = F.vcu; item < nitems; item += F.G) {
        const int vs = item % nvs, dir = (item / nvs) & 1, h = (item / (2 * nvs)) & 3, b = item / (8 * nvs);
        float lg2 = 0.f;
        if (!GLA) { const float lgt = A.I(I_RETDEC)[dir * 4 + h]; lg2 = -log2f(1.0f + expf(-lgt)); }
        const bf16* qb = Qsrc + (GLA ? (size_t)dir * qdir_stride : 0) + qcol + h * DK;
        const bf16* kb = Ksrc + (GLA ? (size_t)dir * qdir_stride : 0) + kcol + h * DK;
        const bf16* k2b = GLA ? K2src + (size_t)dir * qdir_stride + kcol + h * DK : kb;
        const bf16* vb = Vsrc + vcol + h * DV + vs * DVS;
        f32x4 Sacc[VT_PER][KT_PER];
#pragma unroll
        for (int a = 0; a < VT_PER; ++a)
#pragma unroll
            for (int c2 = 0; c2 < KT_PER; ++c2) Sacc[a][c2] = (f32x4){0.f, 0.f, 0.f, 0.f};
        for (int i = tid; i < DVS * SS / 4; i += NTHR) ((LAS unsigned*)(F.lds + O_ST))[i] = 0u;
        v4u rq[QN], rk[QN], rk2[GLA ? QN : 1], rv; float peb = 0.f;
        rv = (v4u){0u, 0u, 0u, 0u};
#define REC_LOAD(c) do { \
            const int rowc_ = seq_row(b, dir, 64 * (c));                   \
            _Pragma("unroll") for (int n = 0; n < QN; ++n) { const int pi = tid + NTHR * n, r = pi / QCH, ch = pi % QCH; const size_t ro = (size_t)(rowc_ + (dir ? -r : r)) * ldq + ch * 8; \
                rq[n] = *(const v4u*)(qb + ro); rk[n] = *(const v4u*)(kb + ro); if (GLA) rk2[n] = *(const v4u*)(k2b + ro); } \
            if (tid < 64 * VCH) { const int r = tid / VCH, ch = tid % VCH; rv = *(const v4u*)(vb + (size_t)(rowc_ + (dir ? -r : r)) * ldv + ch * 8); } \
            if (GLA && tid < DK) peb = EB[(((size_t)dir * NB + b) * 68 + (c)) * (4 * DK) + h * DK + tid]; } while (0)
        REC_LOAD(0);
        for (int c = 0; c < 68; ++c) {
#pragma unroll
            for (int n = 0; n < QN; ++n) { const int pi = tid + NTHR * n, r = pi / QCH, ch = pi % QCH;
                *(LAS v4u*)(F.lds + O_QD + r * SQ + ch * 16) = rq[n]; *(LAS v4u*)(F.lds + O_KI + r * SQ + ch * 16) = rk[n];
                if (GLA) *(LAS v4u*)(F.lds + O_KS + r * SQ + ch * 16) = rk2[n]; }
            if (tid < 64 * VCH) { const int r = tid / VCH, ch = tid % VCH;
                if (INTRA) *(LAS v4u*)(F.lds + O_V + r * SV + ch * 16) = rv;
                if (!GLA) *(LAS v4u*)(F.lds + O_VD + r * SV + ch * 16) = scale8(rv, __builtin_amdgcn_exp2f(lg2 * (float)(63 - r))); }
            if (GLA && tid < DK) ((LAS float*)(F.lds + O_EB))[tid] = peb;
            if (c + 1 < 68) REC_LOAD(c + 1);
            __syncthreads();
            if constexpr (INTRA) {
#pragma unroll
            for (int q2 = 0; q2 < 2; ++q2) { const int jt = 2 * vg + q2; f32x4 acc = (f32x4){0.f, 0.f, 0.f, 0.f};
                if (jt <= it) {
#pragma unroll
                    for (int ks = 0; ks < KSTEPS; ++ks) acc = MFMA16(frag_n(L + O_KI, SQ, 16 * jt, 32 * ks, lane), frag_n(L + O_QD, SQ, 16 * it, 32 * ks, lane), acc);
                    const int i = 16 * it + l15;
#pragma unroll
                    for (int r = 0; r < 4; ++r) { const int j = 16 * jt + 4 * g4 + r; float vv = (j <= i) ? acc[r] : 0.f; if (!GLA) vv *= __builtin_amdgcn_exp2f(lg2 * (float)(i - j)); acc[r] = vv; }
                }
                v2u pw; pw.x = pk2(acc[0], acc[1]); pw.y = pk2(acc[2], acc[3]);
                *(LAS v2u*)(F.lds + O_P + (16 * it + l15) * SP + (16 * jt + 4 * g4) * 2) = pw; }
            }
            f32x4 oacc[VT_PER];
            const bool need_o = INTRA || orow0 == 0 || c >= 4;
#pragma unroll
            for (int a = 0; a < VT_PER; ++a) { oacc[a] = (f32x4){0.f, 0.f, 0.f, 0.f};
                if (need_o)
#pragma unroll
                for (int ks = 0; ks < KSTEPS; ++ks) oacc[a] = MFMA16(frag_n(L + O_ST, SS, 16 * (vg * VT_PER + a), 32 * ks, lane), frag_n(L + O_QD, SQ, 16 * it, 32 * ks, lane), oacc[a]);
                if (!GLA) oacc[a] *= __builtin_amdgcn_exp2f(lg2 * (float)(16 * it + l15 + 1)); }
            if constexpr (INTRA) __syncthreads();
            { const int row = seq_row(b, dir, 64 * c + 16 * it + l15);
#pragma unroll
              for (int a = 0; a < VT_PER; ++a) { const int vt = vg * VT_PER + a;
                if constexpr (INTRA) {
#pragma unroll
                for (int js = 0; js < 2; ++js) oacc[a] = MFMA16(frag_t(L + O_V, SV, 32 * js, 16 * vt, lane), frag_n(L + O_P, SP, 16 * it, 32 * js, lane), oacc[a]); }
                if (row >= orow0) { v2u ow; ow.x = pk2(oacc[a][0], oacc[a][1]); ow.y = pk2(oacc[a][2], oacc[a][3]);
                    *(GAS v2u*)(O + (size_t)dir * odir_stride + (size_t)(row - orow0) * ldo + h * DV + vs * DVS + 16 * vt + 4 * g4) = ow; } } }
            { bfx8 fv[VT_PER][2];
#pragma unroll
              for (int a = 0; a < VT_PER; ++a)
#pragma unroll
                for (int js = 0; js < 2; ++js) fv[a][js] = frag_t(L + (GLA ? O_V : O_VD), SV, 32 * js, 16 * (vg * VT_PER + a), lane);
              const float g64 = GLA ? 1.0f : __builtin_amdgcn_exp2f(lg2 * 64.0f);
#pragma unroll
              for (int c2 = 0; c2 < KT_PER; ++c2) { const int kt = kg * KT_PER + c2;
                const bfx8 fk0 = frag_t(L + (GLA ? O_KS : O_KI), SQ, 0, 16 * kt, lane), fk1 = frag_t(L + (GLA ? O_KS : O_KI), SQ, 32, 16 * kt, lane);
                f32x4 sc4 = (f32x4){g64, g64, g64, g64};
                if (GLA) sc4 = *(const LAS f32x4*)(L + O_EB + (16 * kt + 4 * g4) * 4);
#pragma unroll
                for (int a = 0; a < VT_PER; ++a) { f32x4 s = Sacc[a][c2] * sc4;
                    s = MFMA16(fk0, fv[a][0], s); s = MFMA16(fk1, fv[a][1], s); Sacc[a][c2] = s;
                    if constexpr (INTRA) { v2u sw; sw.x = pk2(s[0], s[1]); sw.y = pk2(s[2], s[3]);
                        *(LAS v2u*)(F.lds + O_ST + (16 * (vg * VT_PER + a) + l15) * SS + (16 * kt + 4 * g4) * 2) = sw; } } } }
            __syncthreads();
            if constexpr (!INTRA) {
#pragma unroll
              for (int c2 = 0; c2 < KT_PER; ++c2)
#pragma unroll
                for (int a = 0; a < VT_PER; ++a) { const f32x4 s = Sacc[a][c2]; v2u sw; sw.x = pk2(s[0], s[1]); sw.y = pk2(s[2], s[3]);
                    *(LAS v2u*)(F.lds + O_ST + (16 * (vg * VT_PER + a) + l15) * SS + (16 * (kg * KT_PER + c2) + 4 * g4) * 2) = sw; } }
        }
#undef REC_LOAD
    }
}
__device__ __forceinline__ void p_gla_prep(Frame& F, const bf16* P, bf16* QD, bf16* KI, bf16* KS, float* EB) {
    const KA A = ka_fresh();
    const int tid = F.tid;
    LAS float* lb = (LAS float*)F.lds;
    LAS float* wal = (LAS float*)(F.lds + 66560);
    LAS float* tot = (LAS float*)(F.lds + 66560 + 17408);
    constexpr int LBS = 260;
    int cur_dir = -1;
    for (int item = F.vcu; item < 2 * NB * 68; item += F.G) {
        const int c = item % 68, b = (item / 68) % NB, dir = item / (68 * NB);
        if (dir != cur_dir) { __syncthreads();
            for (int i = tid; i < 16 * 256; i += NTHR) wal[i] = A.I(I_GLAWA)[dir * 4096 + i];
            if (tid < 256) wal[4096 + tid] = A.I(I_GLABA)[dir * 256 + tid];
            cur_dir = dir; __syncthreads(); }
        const int t = tid >> 3, cg = tid & 7, row = seq_row(b, dir, 64 * c + t);
        {
            float lw[16]; { float f0[8], f1[8]; unpack8(*(const v4u*)(P + (size_t)row * N0 + C0_LOW + dir * 16), f0); unpack8(*(const v4u*)(P + (size_t)row * N0 + C0_LOW + dir * 16 + 8), f1);
#pragma unroll
                for (int j = 0; j < 8; ++j) { lw[j] = f0[j]; lw[8 + j] = f1[j]; } }
#pragma unroll
            for (int q = 0; q < 8; ++q) { const int col = cg * 32 + q * 4;
                f32x4 z = *(const LAS f32x4*)(wal + 4096 + col);
#pragma unroll
                for (int r = 0; r < 16; ++r) z += *(const LAS f32x4*)(wal + r * 256 + col) * lw[r];
                f32x4 o;
#pragma unroll
                for (int j = 0; j < 4; ++j) o[j] = (fminf(z[j], 0.f) - __logf(1.0f + __expf(-fabsf(z[j])))) * (1.0f / 16.0f);
                *(LAS f32x4*)(lb + t * LBS + col) = o; }
        }
        __syncthreads();
        {
            const int col = tid & 255, half = tid >> 8; float run = 0.f;
#pragma unroll 8
            for (int i = 0; i < 32; ++i) { run += lb[(32 * half + i) * LBS + col]; lb[(32 * half + i) * LBS + col] = run; }
            if (half == 0) tot[col] = run;
            __syncthreads();
            if (half == 1) { const float off = tot[col];
#pragma unroll 8
                for (int i = 32; i < 64; ++i) lb[i * LBS + col] += off; }
        }
        __syncthreads();
        {
#pragma unroll
            for (int q = 0; q < 4; ++q) { const int col = cg * 32 + q * 8;
                float qf[8], kf[8], o1[8], o2[8], o3[8];
                unpack8(*(const v4u*)(P + (size_t)row * N0 + C0_Q + col), qf); unpack8(*(const v4u*)(P + (size_t)row * N0 + C0_K + col), kf);
#pragma unroll
                for (int j = 0; j < 8; ++j) { const float bt = lb[t * LBS + col + j], bl = lb[63 * LBS + col + j]; const float eb = __expf(bt);
                    o1[j] = qf[j] * eb; o2[j] = kf[j] * __expf(-bt); o3[j] = kf[j] * __expf(bl - bt); }
                const size_t o = ((size_t)dir * MALL + row) * 256 + col;
                *(GAS v4u*)(QD + o) = pack8(o1); *(GAS v4u*)(KI + o) = pack8(o2); *(GAS v4u*)(KS + o) = pack8(o3); }
            if (tid < 256) EB[(((size_t)dir * NB + b) * 68 + c) * 256 + tid] = __expf(lb[63 * LBS + tid]);
        }
        __syncthreads();
    }
}
__device__ __forceinline__ void p_ret_intra_finish(Frame& F) {
    const KA A = ka_fresh();
    constexpr int SQ = 528, SP = 144, SV = 1040, O_Q = 0, O_K = 33792, O_V = 0, O_P = 67584, O_RED = O_P + 64 * SP;
    static_assert(64 * SV <= O_P && O_RED + 2 * 64 * 8 <= RING_BYTES, "LDS map");
    unsigned char* ws = A.WS();
    const bf16* P = (const bf16*)(ws + WS_PROJ); const bf16* RO = (const bf16*)(ws + WS_OREC); bf16* MIX = (bf16*)(ws + WS_MIX);
    const LAS unsigned char* L = F.lds;
    const int tid = F.tid, lane = F.lane, w = F.wave, it = w & 3, vg = w >> 2, g4 = lane >> 4, l15 = lane & 15;
    v4u rq[4], rk[4];
#define RIF_LOADQK(u_) do { const int h_ = (u_) & 3, n_ = ((u_) >> 2) & 63, b_ = (u_) >> 8; const size_t p0_ = (size_t)(NCTX + b_ * SEQ + 64 * n_) * N1; \
        _Pragma("unroll") for (int q = 0; q < 4; ++q) { const int pi = tid + NTHR * q, r = pi >> 5, ch = pi & 31; const size_t ro = p0_ + (size_t)r * N1 + h_ * 256 + ch * 8; rq[q] = *(const v4u*)(P + ro + C1_Q); rk[q] = *(const v4u*)(P + ro + C1_K); } } while (0)
    if (F.vcu < NB * 64 * 4) RIF_LOADQK(F.vcu);
    for (int unit = F.vcu; unit < NB * 64 * 4; unit += F.G) {
        const int h = unit & 3, n = (unit >> 2) & 63, b = unit >> 8;
        const int lrow0 = b * SEQ + 64 * n; const size_t prow0 = (size_t)(NCTX + lrow0) * N1;
        const float lgf = -log2f(1.0f + expf(-A.I(I_RETDEC)[h])), lgb = -log2f(1.0f + expf(-A.I(I_RETDEC)[4 + h]));
#pragma unroll
        for (int q = 0; q < 4; ++q) { const int pi = tid + NTHR * q, r = pi >> 5, ch = pi & 31; *(LAS v4u*)(F.lds + O_Q + r * SQ + ch * 16) = rq[q]; *(LAS v4u*)(F.lds + O_K + r * SQ + ch * 16) = rk[q]; }
        v4u rv[8];
#pragma unroll
        for (int q = 0; q < 8; ++q) { const int pi = tid + NTHR * q, r = pi >> 6, ch = pi & 63; rv[q] = *(const v4u*)(P + prow0 + (size_t)r * N1 + C1_V + h * 512 + ch * 8); }
        __syncthreads();
#pragma unroll
        for (int q2 = 0; q2 < 2; ++q2) { const int jt = 2 * vg + q2; f32x4 acc = (f32x4){0.f, 0.f, 0.f, 0.f};
#pragma unroll
            for (int ks = 0; ks < 8; ++ks) acc = MFMA16(frag_n(L + O_K, SQ, 16 * jt, 32 * ks, lane), frag_n(L + O_Q, SQ, 16 * it, 32 * ks, lane), acc);
            const int i = 16 * it + l15;
#pragma unroll
            for (int r = 0; r < 4; ++r) { const int j = 16 * jt + 4 * g4 + r; const float m = (j <= i ? exp2f(lgf * (float)(i - j)) : 0.f) + (j >= i ? exp2f(lgb * (float)(j - i)) : 0.f); acc[r] *= m; }
            v2u pw; pw.x = pk2(acc[0], acc[1]); pw.y = pk2(acc[2], acc[3]);
            *(LAS v2u*)(F.lds + O_P + (16 * it + l15) * SP + (16 * jt + 4 * g4) * 2) = pw; }
        __syncthreads();
        if (unit + F.G < NB * 64 * 4) RIF_LOADQK(unit + F.G);
#pragma unroll
        for (int q = 0; q < 8; ++q) { const int pi = tid + NTHR * q, r = pi >> 6, ch = pi & 63; *(LAS v4u*)(F.lds + O_V + r * SV + ch * 16) = rv[q]; }
        const int lrow = lrow0 + 16 * it + l15;
        v2u oi[2][16];
#pragma unroll
        for (int d = 0; d < 2; ++d)
#pragma unroll
            for (int a = 0; a < 16; ++a) oi[d][a] = *(const v2u*)(RO + ((size_t)d * NLAT + lrow) * 2048 + h * 512 + 16 * (16 * vg + a) + 4 * g4);
        __syncthreads();
        f32x4 oacc[16];
#pragma unroll
        for (int a = 0; a < 16; ++a) oacc[a] = (f32x4){0.f, 0.f, 0.f, 0.f};
#pragma unroll
        for (int js = 0; js < 2; ++js) { const bfx8 pf = frag_n(L + O_P, SP, 16 * it, 32 * js, lane);
#pragma unroll
            for (int a = 0; a < 16; ++a) oacc[a] = MFMA16(frag_t(L + O_V, SV, 32 * js, 16 * (16 * vg + a), lane), pf, oacc[a]); }
        float s1 = 0.f, s2 = 0.f;
#pragma unroll
        for (int a = 0; a < 16; ++a) { oacc[a] += (f32x4){blo(oi[0][a].x) + blo(oi[1][a].x), bhi(oi[0][a].x) + bhi(oi[1][a].x), blo(oi[0][a].y) + blo(oi[1][a].y), bhi(oi[0][a].y) + bhi(oi[1][a].y)};
#pragma unroll
            for (int r = 0; r < 4; ++r) { s1 += oacc[a][r]; s2 += oacc[a][r] * oacc[a][r]; } }
        s1 += __shfl_xor(s1, 16); s2 += __shfl_xor(s2, 16); s1 += __shfl_xor(s1, 32); s2 += __shfl_xor(s2, 32);
        LAS float* red = (LAS float*)(F.lds + O_RED);
        if (g4 == 0) { red[(vg * 64 + 16 * it + l15) * 2] = s1; red[(vg * 64 + 16 * it + l15) * 2 + 1] = s2; }
        __syncthreads();
        { const float t1 = red[(16 * it + l15) * 2] + red[(64 + 16 * it + l15) * 2], t2 = red[(16 * it + l15) * 2 + 1] + red[(64 + 16 * it + l15) * 2 + 1];
          const float mu = t1 * (1.0f / 512.0f), var = fmaxf(t2 * (1.0f / 512.0f) - mu * mu, 0.f), rstd = rsqrtf(var + EPS);
          const bf16* gp = P + (size_t)(NCTX + lrow) * N1 + C1_G + h * 512; const float* ngp = A.I(I_RETNG) + h * 512; bf16* op = MIX + (size_t)lrow * 2048 + h * 512;
#pragma unroll
          for (int a = 0; a < 16; ++a) { const int v0 = 16 * (16 * vg + a) + 4 * g4; const v2u gw = *(const v2u*)(gp + v0); const f32x4 ng = *(const f32x4*)(ngp + v0);
              const float r0 = (oacc[a][0] - mu) * rstd * ng[0] * silu_(blo(gw.x)), r1 = (oacc[a][1] - mu) * rstd * ng[1] * silu_(bhi(gw.x)), r2 = (oacc[a][2] - mu) * rstd * ng[2] * silu_(blo(gw.y)), r3 = (oacc[a][3] - mu) * rstd * ng[3] * silu_(bhi(gw.y));
              v2u ow; ow.x = pk2(r0, r1); ow.y = pk2(r2, r3); *(GAS v2u*)(op + v0) = ow; } }
        __syncthreads();
    }
}
#undef RIF_LOADQK
#ifndef MK_ONLY
#define MK_ONLY -1
#endif
#define SON(s) (MK_ONLY < 0 || MK_ONLY == (s))
#define IN(k) (lo <= (k) && (k) < hi)
#ifndef MK_PROBE
#define MK_PROBE -1
#endif
#ifndef MK_REP
#define MK_REP -1
#endif
#define REPS(s) for (int _rep = 0; _rep < ((MK_REP == (s)) ? 2 : 1); ++_rep)
#define STAMP(k) do { if (MK_PROBE >= 0 && blockIdx.x == 0 && F.tid == 0) { const unsigned long long _t = wall_clock64(); __hip_atomic_store(F.ctl + 20000 + 2 * (k), (unsigned)_t, RLX_AGENT); __hip_atomic_store(F.ctl + 20001 + 2 * (k), (unsigned)(_t >> 32), RLX_AGENT); } } while (0)
#define SEAM(k) do { if (IN(k) && IN((k) + 1)) { xcd_barrier(bar); STAMP((k) + 1); } } while (0)
template <int layer>
__device__ __forceinline__ void layer_body(Frame& F, const int lo, const int hi, const XcdBarrier& bar) {
    unsigned char* const ws = ka_fresh().WS();
    bf16* const H = (bf16*)(ws + WS_H);
    bf16* const PROJ = (bf16*)(ws + WS_PROJ);
    float* const XRES = (float*)(ws + WS_XRES);
    float* const MOD = (float*)(ws + WS_MOD);

        const int pb = layer ? PH_INPROJ1 : PH_INPROJ0;
        if (SON(2) && IN(pb)) {
            pg8::Gemm g{H, (const bf16*)(ws + (layer ? WS_WIN1T : WS_WIN0T)), MALL, layer ? N1 : N0, 1024, 1024};
            pg8::StaticOrder S; S.init(g.M, g.N, F.G, (int)blockIdx.x);
            if constexpr (layer == 0 && !MK_NAIVE_S5) { pg8::EpiStoreU E{PROJ, g.N, (bf16*)(ws + WS_A2)};
                pg8::gemm_phase<pg8::EpiStoreU, pg8::StaticOrder, true, true>(F.lds, g, S, E); }
            else { pg8::EpiStore E{PROJ, g.N};
                pg8::gemm_phase<pg8::EpiStore, pg8::StaticOrder, true, true>(F.lds, g, S, E); }
        }
        SEAM(pb);
        if (layer == 0) {
#if MK_NAIVE_GLA
            SEAM(PH_GLAPREP);
            if (SON(3) && IN(PH_GLA)) rec_naive<64, true>(F, PROJ, N0, C0_Q, C0_K, C0_V, 128, 2, (float*)(ws + WS_OREC), (size_t)MALL * 512, 512, 0);
#else
            bf16* const GQD = (bf16*)(ws + WS_OREC + 280 * MiB); bf16* const GKI = GQD + (size_t)2 * MALL * 256; bf16* const GKS = GKI + (size_t)2 * MALL * 256; float* const GEB = (float*)(ws + WS_OREC + 384 * MiB);
            if (SON(13) && IN(PH_GLAPREP)) REPS(13) p_gla_prep(F, PROJ, GQD, GKI, GKS, GEB);
#if !MK_NAIVE_S5
            if (SON(17) && IN(PH_GLAPREP)) {
                __syncthreads();
                pg8::Gemm g{(const bf16*)(ws + WS_A2), (const bf16*)(ws + WS_S5W1), 32 * S5_ROWS, 256, 256, 512};
                pg8::GroupOrder S{9, 288, F.G, F.vcu};
                pg8::EpiF32Plain E{(float*)(ws + WS_SLOC)};
                pg8::gemm_phase<pg8::EpiF32Plain, pg8::GroupOrder, true, true>(F.lds, g, S, E);
            }
#endif
            SEAM(PH_GLAPREP);
#if !MK_NAIVE_S5
            if (SON(18) && IN(PH_GLA)) { p_s5_scan(F, (const float*)(ws + WS_SLOC), (bf16*)(ws + WS_A2)); __syncthreads(); }
#endif
            if (SON(3) && IN(PH_GLA)) REPS(3) rec_mfma<64, 32, true>(F, GQD, GKI, GKS, (size_t)MALL * 256, 256, 0, 0, PROJ, N0, C0_V, 128, GEB, (bf16*)(ws + WS_OREC), (size_t)MALL * 512, 512, 0);
#endif
            SEAM(PH_GLA);
#if MK_NAIVE_S5
            if (SON(4) && IN(PH_S5)) s5_naive(F, PROJ, (float*)(ws + WS_OREC) + (size_t)2 * MALL * 512);
#else
            if (SON(4) && IN(PH_S5)) {
                pg8::Gemm g{(const bf16*)(ws + WS_A2), (const bf16*)(ws + WS_S5W2), 32 * S5_ROWS, 256, 512, 512};
                pg8::GroupOrder S{9, 288, F.G, F.vcu};
                pg8::EpiS5Out E{(const bf16*)(ws + WS_A2), (bf16*)(ws + WS_YPRE), ka_fresh().I(I_S5D)};
                pg8::gemm_phase<pg8::EpiS5Out, pg8::GroupOrder, true, true>(F.lds, g, S, E);
            }
#endif
            if (SON(5) && IN(PH_FIN0)) REPS(5) p_finish0(F);
            SEAM(PH_FIN0);
            if (SON(6) && IN(PH_GLU)) {
                pg8::Gemm g{(const bf16*)(ws + WS_YPRE), (const bf16*)(ws + WS_WGLUT), MALL, 512, 512, 512};
                pg8::StaticOrder S; S.init(g.M, g.N, F.G, (int)blockIdx.x);
                pg8::EpiGlu E{(const bf16*)(ws + WS_YPRE), (bf16*)(ws + WS_MIX), 1024, 512, ka_fresh().I(I_GLUB)};
                pg8::gemm_phase<pg8::EpiGlu, pg8::StaticOrder, true, true>(F.lds, g, S, E);
            }
            SEAM(PH_GLU);
        } else {
            if (SON(14) && IN(PH_ROPE)) p_rope(F);
            SEAM(PH_ROPE);
#if MK_NAIVE_RET
            if (SON(15) && IN(PH_RET)) rec_naive<256, false>(F, PROJ, N1, C1_Q, C1_K, C1_V, 512, 8, (float*)(ws + WS_OREC), (size_t)NLAT * 2048, 2048, NCTX);
#else
            if (SON(15) && IN(PH_RET)) REPS(15) rec_mfma<256, 64, false, false>(F, PROJ, PROJ, PROJ, 0, N1, C1_Q, C1_K, PROJ, N1, C1_V, 512, nullptr, (bf16*)(ws + WS_OREC), (size_t)NLAT * 2048, 2048, NCTX);
#endif
            SEAM(PH_RET);
            #if MK_NAIVE_RET
            if (SON(16) && IN(PH_FIN1)) p_finish1(F);
#else
            if (SON(16) && IN(PH_FIN1)) REPS(16) p_ret_intra_finish(F);
#endif
            SEAM(PH_FIN1);
        }
        const int po = layer ? PH_OUT1 : PH_OUT0;
        if (SON(7) && IN(po)) {
            pg8::Gemm g{(const bf16*)(ws + WS_MIX), (const bf16*)(ws + (layer ? WS_WOUT1T : WS_WOUT0T)), layer ? NLAT : MALL, 1024, layer ? 2048 : 1024, layer ? 2048 : 1024};
            pg8::StaticOrder S; S.init(g.M, g.N, F.G, (int)blockIdx.x);
            pg8::EpiResid<layer == 0> E{ka_fresh().I(I_CTX), ka_fresh().I(I_X), (bf16*)XRES, MOD + (size_t)layer * 9 * 6144 + 2048, layer ? 8 : 0};
            pg8::gemm_phase<pg8::EpiResid<layer == 0>, pg8::StaticOrder, true, true>(F.lds, g, S, E);
        }
        SEAM(po);
        if (SON(8) && IN(po + 1)) p_router(F, layer);
        SEAM(po + 1);
        if (SON(10) && IN(po + 3)) {
            const int nt = moe_tables(F, layer);
            pg8::Gemm g{H, (const bf16*)(ws + WS_WGUT) + (size_t)layer * 32 * 2048 * 1024, nt * 256, 2048, 1024, 1024};
            pg8::MoeOrder S{(const PG8_LAS unsigned char*)(F.lds + L_TILEE), nt, 8, F.G, F.vcu, (const int*)(ws + WS_ELIST), (const PG8_LAS int*)(F.lds + L_TPOS), (const PG8_LAS int*)(F.lds + L_TCNT), layer ? NCTX : 0};
            pg8::EpiSwiglu E{(bf16*)(ws + WS_ACT), ka_fresh().I(I_BGU) + (size_t)layer * 32 * 2048};
            REPS(10) { pg8::gemm_phase<pg8::EpiSwiglu, pg8::MoeOrder, true, true, true>(F.lds, g, S, E); __syncthreads(); }
        }
        SEAM(po + 3);
        if (SON(11) && IN(po + 4)) {
            const int nt = moe_tables(F, layer);
            pg8::Gemm g{(const bf16*)(ws + WS_ACT), (const bf16*)(ws + WS_WDNT) + (size_t)layer * 32 * 1024 * 1024, nt * 256, 1024, 1024, 1024};
            pg8::MoeOrder S{(const PG8_LAS unsigned char*)(F.lds + L_TILEE), nt, 4, F.G, F.vcu, (const int*)(ws + WS_ELIST), (const PG8_LAS int*)(F.lds + L_TPOS), (const PG8_LAS int*)(F.lds + L_TCNT), 0};
            pg8::EpiDown E{(bf16*)(ws + WS_YSLOT), (const int*)(ws + WS_ELIST), (const PG8_LAS int*)(F.lds + L_TPOS), (const PG8_LAS int*)(F.lds + L_TCNT), (const float*)(ws + WS_WSLOT), ka_fresh().I(I_BDN) + (size_t)layer * 32 * 1024};
            REPS(11) { pg8::gemm_phase<pg8::EpiDown, pg8::MoeOrder, true, true>(F.lds, g, S, E); __syncthreads(); }
        }
        SEAM(po + 4);
        if (SON(12) && IN(po + 5)) {
#if MK_REP == 12
            p_combine(F, layer, true);
#endif
            p_combine(F, layer, false); }
        SEAM(po + 5);
    }
__global__ void __launch_bounds__(NTHR, 2) mk_fwd(Args) {
    extern __shared__ __attribute__((aligned(16))) unsigned char lds[];
    Frame F;
    F.lds = (LAS unsigned char*)lds;
    F.MISC = (volatile LAS unsigned*)(F.lds + L_MISC);
    F.tid = threadIdx.x; F.lane = F.tid & 63; F.wave = __builtin_amdgcn_readfirstlane(F.tid >> 6);
    F.G = gridDim.x; { const int bx = blockIdx.x; F.vcu = (F.G % 8 == 0) ? (bx % 8) * (F.G / 8) + bx / 8 : bx; }
    const KA A0 = ka_fresh();
    unsigned char* ws = A0.WS();
    F.ctl = (unsigned*)(ws + WS_CTL);
    if (F.tid < 64) F.MISC[F.tid] = 0u;
    __syncthreads();
    const int lo = A0.LO(), hi = A0.HI();
    XcdBarrier bar; bar.bar = F.ctl + CW_BAR; bar.x = 0; bar.st = nullptr;
    if (hi - lo > 1) bar = xcd_barrier_post(F.ctl + CW_BAR, F.MISC + 8);

    STAMP(0);
    if (SON(0) && IN(0)) { REPS(0) { p0_prologue(F); __syncthreads(); } } SEAM(0);
    if (SON(1) && IN(1)) { REPS(1) p_norm1_l0(F); } SEAM(1);
    layer_body<0>(F, lo, hi, bar);
    layer_body<1>(F, lo, hi, bar);
}

#ifndef MK_MULTI
#define MK_MULTI 0
#endif
extern "C" void kernel_launch(void* const* d_in, const int* in_sizes, int n_in, void* d_out, int out_size, void* d_ws, size_t ws_size, hipStream_t stream) {
    static int grid = 0;
    if (grid == 0) {
        if (n_in != 34 || out_size != NLAT * D || ws_size < WS_END) { fprintf(stderr, "kernel_launch: unexpected sizes: n_in %d out %d ws %zu (need %zu)\n", n_in, out_size, ws_size, (size_t)WS_END); grid = -1; return; }
        int dev = 0, cus = 0;
        if (hipGetDevice(&dev) != hipSuccess || hipDeviceGetAttribute(&cus, hipDeviceAttributeMultiprocessorCount, dev) != hipSuccess) { grid = -1; return; }
        if (hipFuncSetAttribute((const void*)mk_fwd, hipFuncAttributeMaxDynamicSharedMemorySize, LDS_BYTES) != hipSuccess) { fprintf(stderr, "kernel_launch: hipFuncSetAttribute failed\n"); grid = -1; return; }
        int per_cu = 0;
        if (hipOccupancyMaxActiveBlocksPerMultiprocessor(&per_cu, (const void*)mk_fwd, NTHR, LDS_BYTES) != hipSuccess || per_cu < 1) fprintf(stderr, "kernel_launch: occupancy query says %d\n", per_cu);
        (void)hipGetLastError();
        grid = cus;
    }
    if (grid < 0) return;
    (void)in_sizes;
    (void)hipMemsetAsync((char*)d_ws + WS_CTL, 0, CTL_ZERO_BYTES, stream);
    Args a{};
    for (int i = 0; i < 34; ++i) a.in[i] = (const float*)d_in[i];
    a.out = (float*)d_out; a.ws = (unsigned char*)d_ws;
#if MK_MULTI
    for (int p = 0; p < NPH; ++p) { a.ph_lo = p; a.ph_hi = p + 1; hipLaunchKernelGGL(mk_fwd, dim3(grid), dim3(NTHR), LDS_BYTES, stream, a); }
#else
    a.ph_lo = 0; a.ph_hi = NPH; hipLaunchKernelGGL(mk_fwd, dim3(grid), dim3(NTHR), LDS_BYTES, stream, a);
#endif
}
```

```cpp
#include <hip/hip_runtime.h>
#include <cstdio>
#include <cstdint>
#include <cmath>
namespace pg8 {
#define PG8_LAS __attribute__((address_space(3)))
typedef unsigned short bf16_t;
typedef short bf16x8 __attribute__((ext_vector_type(8)));
typedef float f32x4 __attribute__((ext_vector_type(4)));
typedef unsigned u32x4 __attribute__((ext_vector_type(4)));
constexpr int BM = 256, BK = 64, HALF = 128, HTB = HALF * BK * 2  , STAGE_BYTES = 8 * HTB, NXCD = 8, WGM = 8;

__host__ __device__ __forceinline__ int lds_byte(int r, int c) { const int st = (r >> 4) * 2 + (c >> 5), rr = r & 15, cc = c & 31, ob = rr * 64 + cc * 2; return st * 1024 + (ob ^ (((ob >> 9) & 1) << 5)); }
__host__ __device__ __forceinline__ void stage_rc(int b, int& R, int& C) { const int st = b / 1024, sb = b % 1024, swz = sb ^ (((sb >> 9) & 1) << 5); R = (st >> 1) * 16 + swz / 64; C = (st & 1) * 32 + (swz % 64) / 2; }
__host__ __device__ __forceinline__ int perm32(int rho) { const int n = rho >> 4, i = rho & 15; return 8 * (i >> 2) + 4 * n + (i & 3); }

struct Unit { int pm, pn, pb, e; };
struct Gemm { const bf16_t* A; const bf16_t* Bt; int M, N, K, lda; };

struct StaticOrder {
    int nM, nN, nwg, G, c;
    __host__ __device__ void init(int M, int N, int G_, int c_) { nM = M / BM; nN = N / BM; nwg = nM * nN; G = G_; c = c_; }
    __host__ __device__ bool next(int i, Unit& u) const {
        const long L = (long)i * G + c; if (L >= nwg) return false;
        int wgid = (int)L; { const int q = nwg / NXCD, r = nwg % NXCD, xcd = wgid % NXCD, off = wgid / NXCD; wgid = (xcd < r ? xcd * (q + 1) : r * (q + 1) + (xcd - r) * q) + off; }
        const int nig = WGM * nN, gid = wgid / nig, fm = gid * WGM, gsz = (nM - fm) < WGM ? (nM - fm) : WGM;
        u.pm = fm + ((wgid % nig) % gsz); u.pn = (wgid % nig) / gsz; u.pb = u.pn; u.e = 0; return true;
    }
    __device__ __forceinline__ void a_ready(const Unit&) const {}
    __device__ __forceinline__ void done(const Unit&) const {}
};
__device__ __forceinline__ unsigned cvt_pk_bf16(float lo, float hi) { unsigned r; asm volatile("v_cvt_pk_bf16_f32 %0, %1, %2" : "=v"(r) : "v"(lo), "v"(hi)); return r; }
__device__ __forceinline__ float bflo(unsigned w) { return __uint_as_float(w << 16); }
__device__ __forceinline__ float bfhi(unsigned w) { return __uint_as_float(w & 0xffff0000u); }
__device__ __forceinline__ float sigmoidf_(float z) { return __builtin_amdgcn_rcpf(1.0f + __expf(-z)); }

struct EpiStore {
    static constexpr bool PERM = true, AFTER_DRAIN = false;
    bf16_t* O; int ldc;
    __device__ __forceinline__ void operator()(const f32x4 (&acc)[2][2][4][2], const Unit& u, int wr, int wc, int fr, int fq) const {
        const int row0 = u.pm * BM + wr * 64 + fr, col0 = u.pn * BM + wc * 32 + 8 * fq;
#pragma unroll
        for (int ai = 0; ai < 2; ++ai)
#pragma unroll
            for (int m = 0; m < 4; ++m) { bf16_t* rowp = O + (size_t)(row0 + ai * HALF + m * 16) * ldc + col0;
#pragma unroll
                for (int bj = 0; bj < 2; ++bj) { const f32x4 v0 = acc[ai][bj][m][0], v1 = acc[ai][bj][m][1];
                    u32x4 w; w.x = cvt_pk_bf16(v0[0], v0[1]); w.y = cvt_pk_bf16(v0[2], v0[3]); w.z = cvt_pk_bf16(v1[0], v1[1]); w.w = cvt_pk_bf16(v1[2], v1[3]);
                    *(u32x4*)(rowp + bj * HALF) = w; } }
    }
};
struct EpiGlu {
    static constexpr bool PERM = true, AFTER_DRAIN = false;
    const bf16_t* Y; bf16_t* O; int ldo, ocol0; const float* bias;
    __device__ __forceinline__ void operator()(const f32x4 (&acc)[2][2][4][2], const Unit& u, int wr, int wc, int fr, int fq) const {
        const int row0 = u.pm * BM + wr * 64 + fr, col0 = u.pn * BM + wc * 32 + 8 * fq;
        f32x4 bv[2][2];
#pragma unroll
        for (int bj = 0; bj < 2; ++bj)
#pragma unroll
            for (int n = 0; n < 2; ++n) bv[bj][n] = *(const f32x4*)(bias + col0 + bj * HALF + 4 * n);
#pragma unroll
        for (int ai = 0; ai < 2; ++ai)
#pragma unroll
            for (int m = 0; m < 4; ++m) { const size_t row = (size_t)(row0 + ai * HALF + m * 16);
#pragma unroll
                for (int bj = 0; bj < 2; ++bj) { const int c = col0 + bj * HALF;
                    const u32x4 yv = *(const u32x4*)(Y + row * 512 + c);
                    const f32x4 z0 = acc[ai][bj][m][0] + bv[bj][0], z1 = acc[ai][bj][m][1] + bv[bj][1];
                    u32x4 w;
                    w.x = cvt_pk_bf16(bflo(yv.x) * sigmoidf_(z0[0]), bfhi(yv.x) * sigmoidf_(z0[1]));
                    w.y = cvt_pk_bf16(bflo(yv.y) * sigmoidf_(z0[2]), bfhi(yv.y) * sigmoidf_(z0[3]));
                    w.z = cvt_pk_bf16(bflo(yv.z) * sigmoidf_(z1[0]), bfhi(yv.z) * sigmoidf_(z1[1]));
                    w.w = cvt_pk_bf16(bflo(yv.w) * sigmoidf_(z1[2]), bfhi(yv.w) * sigmoidf_(z1[3]));
                    *(u32x4*)(O + row * ldo + ocol0 + c) = w; } }
    }
};
template <bool BASE_F32> struct EpiResid {
    static constexpr bool PERM = true, AFTER_DRAIN = false;
    const float* base_ctx; const float* base_lat; bf16_t* out; const float* gate; int tile0;
    __device__ __forceinline__ void operator()(const f32x4 (&acc)[2][2][4][2], const Unit& u, int wr, int wc, int fr, int fq) const {
        const int gt = u.pm + tile0, bidx = gt < 8 ? 8 : ((gt - 8) >> 4);
        const float* bt = gt < 8 ? base_ctx + (size_t)gt * 256 * 1024 : base_lat + (size_t)(gt - 8) * 256 * 1024;
        bf16_t* ot = out + (size_t)gt * 256 * 1024;
        const int col0 = u.pn * BM + wc * 32 + 8 * fq;
        f32x4 gv[2][2];
#pragma unroll
        for (int bj = 0; bj < 2; ++bj)
#pragma unroll
            for (int n = 0; n < 2; ++n) gv[bj][n] = *(const f32x4*)(gate + bidx * 6144 + col0 + bj * HALF + 4 * n);
#pragma unroll
        for (int ai = 0; ai < 2; ++ai)
#pragma unroll
            for (int m = 0; m < 4; ++m) { const size_t off = (size_t)(wr * 64 + fr + ai * HALF + m * 16) * 1024 + col0;
#pragma unroll
                for (int bj = 0; bj < 2; ++bj) { f32x4 b0, b1;
                    if constexpr (BASE_F32) { b0 = *(const f32x4*)(bt + off + bj * HALF); b1 = *(const f32x4*)(bt + off + bj * HALF + 4); }
                    else { const u32x4 bw = *(const u32x4*)(ot + off + bj * HALF); b0 = (f32x4){bflo(bw.x), bfhi(bw.x), bflo(bw.y), bfhi(bw.y)}; b1 = (f32x4){bflo(bw.z), bfhi(bw.z), bflo(bw.w), bfhi(bw.w)}; }
                    const f32x4 v0 = b0 + gv[bj][0] * acc[ai][bj][m][0], v1 = b1 + gv[bj][1] * acc[ai][bj][m][1];
                    u32x4 w; w.x = cvt_pk_bf16(v0[0], v0[1]); w.y = cvt_pk_bf16(v0[2], v0[3]); w.z = cvt_pk_bf16(v1[0], v1[1]); w.w = cvt_pk_bf16(v1[2], v1[3]);
                    *(u32x4*)(ot + off + bj * HALF) = w; } }
    }
};
struct EpiSwiglu {
    static constexpr bool PERM = true, AFTER_DRAIN = false;
    bf16_t* ACT; const float* bgu;
    __device__ __forceinline__ void operator()(const f32x4 (&acc)[2][2][4][2], const Unit& u, int wr, int wc, int fr, int fq) const {
        const int row0 = u.pm * BM + wr * 64 + fr, lc0 = u.pn * 128 + wc * 32 + 8 * fq;
        const float* bb = bgu + (size_t)u.e * 2048 + lc0;
        f32x4 bg[2], bl[2];
#pragma unroll
        for (int n = 0; n < 2; ++n) { bg[n] = *(const f32x4*)(bb + 4 * n); bl[n] = *(const f32x4*)(bb + 1024 + 4 * n); }
#pragma unroll
        for (int ai = 0; ai < 2; ++ai)
#pragma unroll
            for (int m = 0; m < 4; ++m) { float a[8];
#pragma unroll
                for (int n = 0; n < 2; ++n)
#pragma unroll
                    for (int j = 0; j < 4; ++j) { const float g = fminf(acc[ai][0][m][n][j] + bg[n][j], 7.0f); float l = acc[ai][1][m][n][j] + bl[n][j]; l = fminf(fmaxf(l, -7.0f), 7.0f);
                        a[4 * n + j] = g * sigmoidf_(1.702f * g) * (l + 1.0f); }
                u32x4 w; w.x = cvt_pk_bf16(a[0], a[1]); w.y = cvt_pk_bf16(a[2], a[3]); w.z = cvt_pk_bf16(a[4], a[5]); w.w = cvt_pk_bf16(a[6], a[7]);
                *(u32x4*)(ACT + (size_t)(row0 + ai * HALF + m * 16) * 1024 + lc0) = w; }
    }
};
struct EpiDown {
    static constexpr bool PERM = true, AFTER_DRAIN = false;
    bf16_t* Y; const int* elist; const PG8_LAS int* tpos; const PG8_LAS int* tcnt; const float* w_slot; const float* bdn;
    __device__ __forceinline__ void operator()(const f32x4 (&acc)[2][2][4][2], const Unit& u, int wr, int wc, int fr, int fq) const {
        const int col0 = u.pn * BM + wc * 32 + 8 * fq, tp0 = tpos[u.pm], tc0 = tcnt[u.pm]; const int* el = elist + (size_t)u.e * 34816;
        f32x4 bv[2][2];
#pragma unroll
        for (int bj = 0; bj < 2; ++bj)
#pragma unroll
            for (int n = 0; n < 2; ++n) bv[bj][n] = *(const f32x4*)(bdn + (size_t)u.e * 1024 + col0 + bj * HALF + 4 * n);
#pragma unroll
        for (int ai = 0; ai < 2; ++ai)
#pragma unroll
            for (int m = 0; m < 4; ++m) { const int pos = tp0 + wr * 64 + fr + ai * HALF + m * 16; const int slot = pos < tc0 ? el[pos] : -1;
                if (slot >= 0) { const float ws = w_slot[slot]; bf16_t* rowp = Y + (size_t)slot * 1024 + col0;
#pragma unroll
                    for (int bj = 0; bj < 2; ++bj) { const f32x4 v0 = (acc[ai][bj][m][0] + bv[bj][0]) * ws, v1 = (acc[ai][bj][m][1] + bv[bj][1]) * ws;
                        u32x4 w; w.x = cvt_pk_bf16(v0[0], v0[1]); w.y = cvt_pk_bf16(v0[2], v0[3]); w.z = cvt_pk_bf16(v1[0], v1[1]); w.w = cvt_pk_bf16(v1[2], v1[3]);
                        *(u32x4*)(rowp + bj * HALF) = w; } } }
    }
};
struct MoeOrder {
    const PG8_LAS unsigned char* tile_e; int ntiles, NT, G, c; const int* elist; const PG8_LAS int* tpos; const PG8_LAS int* tcnt; int row0;
    __device__ __forceinline__ int rowidx(const Unit& u, int r) const { const int pos = tpos[u.pm] + r; const int s = pos < tcnt[u.pm] ? elist[(size_t)u.e * 34816 + pos] : 0; return row0 + (s >> 2); }
    __device__ __forceinline__ bool next(int i, Unit& u) const {
        const int L = i * G + c; if (L >= ntiles * NT) return false;
        const int T = L / NT; u.pm = T; u.pn = L - T * NT; u.e = __builtin_amdgcn_readfirstlane((int)tile_e[T]); u.pb = u.e * NT + u.pn; return true;
    }
    __device__ __forceinline__ void a_ready(const Unit&) const {}
    __device__ __forceinline__ void done(const Unit&) const {}
};

struct EpiStoreU {
    static constexpr bool PERM = true, AFTER_DRAIN = false;
    bf16_t* O; int ldc; bf16_t* A2;
    __device__ __forceinline__ void operator()(const f32x4 (&acc)[2][2][4][2], const Unit& u, int wr, int wc, int fr, int fq) const {
        const int row0 = u.pm * BM + wr * 64 + fr, col0 = u.pn * BM + wc * 32 + 8 * fq;
#pragma unroll
        for (int ai = 0; ai < 2; ++ai)
#pragma unroll
            for (int m = 0; m < 4; ++m) { const int R = row0 + ai * HALF + m * 16; bf16_t* rowp = O + (size_t)R * ldc + col0;
                int r, t; if (R < 2048) { r = (R >> 8) * 272 + ((R & 255) >> 4); t = R & 15; } else { const int R2 = R - 2048; r = (R2 >> 12) * 272 + 16 + ((R2 & 4095) >> 4); t = R2 & 15; }
#pragma unroll
                for (int bj = 0; bj < 2; ++bj) { const f32x4 v0 = acc[ai][bj][m][0], v1 = acc[ai][bj][m][1];
                    u32x4 w; w.x = cvt_pk_bf16(v0[0], v0[1]); w.y = cvt_pk_bf16(v0[2], v0[3]); w.z = cvt_pk_bf16(v1[0], v1[1]); w.w = cvt_pk_bf16(v1[2], v1[3]);
                    *(u32x4*)(rowp + bj * HALF) = w;
                    if (u.pn >= 6) { const int g = (u.pn - 6) * 16 + bj * 8 + wc * 2 + (fq >> 1);
                        *(u32x4*)(A2 + ((size_t)g * 2304 + r) * 512 + t * 16 + (fq & 1) * 8) = w; } } }
    }
};
struct EpiF32Plain {
    static constexpr bool PERM = true, AFTER_DRAIN = false;
    float* C;
    __device__ __forceinline__ void operator()(const f32x4 (&acc)[2][2][4][2], const Unit& u, int wr, int wc, int fr, int fq) const {
        float* base = C + (size_t)(u.pm * BM + wr * 64 + fr) * 256 + wc * 32 + 8 * fq;
#pragma unroll
        for (int ai = 0; ai < 2; ++ai)
#pragma unroll
            for (int m = 0; m < 4; ++m) {
#pragma unroll
                for (int bj = 0; bj < 2; ++bj) { float* p = base + (ai * HALF + m * 16) * 256 + bj * HALF;
                    *(f32x4*)p = acc[ai][bj][m][0]; *(f32x4*)(p + 4) = acc[ai][bj][m][1]; } }
    }
};
struct EpiS5Out {
    static constexpr bool PERM = true, AFTER_DRAIN = false;
    const bf16_t* A2; bf16_t* YP; const float* dskip;
    __device__ __forceinline__ void operator()(const f32x4 (&acc)[2][2][4][2], const Unit& u, int wr, int wc, int fr, int fq) const {
        const int g = u.e;
#pragma unroll
        for (int ai = 0; ai < 2; ++ai)
#pragma unroll
            for (int m = 0; m < 4; ++m) { const int rr = (u.pm - g * 9) * BM + wr * 64 + fr + ai * HALF + m * 16;
                if (rr < 2176) { const int b = rr / 272, n = rr - b * 272;
                    const int tok0 = n < 16 ? b * 256 + n * 16 : 2048 + b * 4096 + (n - 16) * 16;
#pragma unroll
                    for (int bj = 0; bj < 2; ++bj) { const int col = bj * HALF + wc * 32 + 8 * fq, t = col >> 4, c0 = col & 15;
                        const u32x4 uv = *(const u32x4*)(A2 + ((size_t)g * 2304 + rr) * 512 + col);
                        const f32x4 d0 = *(const f32x4*)(dskip + g * 16 + c0), d1 = *(const f32x4*)(dskip + g * 16 + c0 + 4);
                        float y[8];
                        y[0] = acc[ai][bj][m][0][0] + d0[0] * bflo(uv.x); y[1] = acc[ai][bj][m][0][1] + d0[1] * bfhi(uv.x); y[2] = acc[ai][bj][m][0][2] + d0[2] * bflo(uv.y); y[3] = acc[ai][bj][m][0][3] + d0[3] * bfhi(uv.y);
                        y[4] = acc[ai][bj][m][1][0] + d1[0] * bflo(uv.z); y[5] = acc[ai][bj][m][1][1] + d1[1] * bfhi(uv.z); y[6] = acc[ai][bj][m][1][2] + d1[2] * bflo(uv.w); y[7] = acc[ai][bj][m][1][3] + d1[3] * bfhi(uv.w);
#pragma unroll
                        for (int j = 0; j < 8; ++j) { const float z = y[j], th = 0.7978845608f * (z + 0.044715f * z * z * z); const float e2 = __expf(2.0f * th); y[j] = 0.5f * z * (1.0f + (1.0f - 2.0f * __builtin_amdgcn_rcpf(e2 + 1.0f))); }
                        u32x4 w; w.x = cvt_pk_bf16(y[0], y[1]); w.y = cvt_pk_bf16(y[2], y[3]); w.z = cvt_pk_bf16(y[4], y[5]); w.w = cvt_pk_bf16(y[6], y[7]);
                        *(u32x4*)(YP + (size_t)(tok0 + t) * 512 + g * 16 + c0) = w; } } }
    }
};
struct GroupOrder {
    int tpg, nunits, G, c;
    __device__ __forceinline__ bool next(int i, Unit& u) const { const int L = i * G + c; if (L >= nunits) return false; u.pm = L; u.pn = 0; u.e = L / tpg; u.pb = u.e; return true; }
    __device__ __forceinline__ void a_ready(const Unit&) const {}
    __device__ __forceinline__ void done(const Unit&) const {}
};
template <class Epi, class Sched, bool ALIGN_EPI = false, bool SP2 = false, bool GATHER = false>
__device__ __forceinline__ void gemm_phase(PG8_LAS unsigned char* lds, const Gemm g, const Sched& S, const Epi& E) {
    static_assert(!GATHER || SP2, "gathered A staging is implemented in the SP2 loop only");
    const int tid = threadIdx.x, wid = __builtin_amdgcn_readfirstlane(tid >> 6), lane = tid & 63, wr = wid >> 2, wc = wid & 3, fr = lane & 15, fq = lane >> 4;
    int K_ = g.K; asm volatile("" : "+s"(K_));
    const int K = K_, nt = K / BK;
    unsigned voffA[2], voffB[2];
#pragma unroll
    for (int i = 0; i < 2; ++i) { int R, C; stage_rc(tid * 16 + i * 8192, R, C); const int Rb = Epi::PERM ? ((R & ~31) + perm32(R & 31)) : R;
        voffA[i] = (unsigned)(R * g.lda + C) * 2u; voffB[i] = (unsigned)(Rb * K + C) * 2u; }
    const size_t kstep = (size_t)(BK * 2);
    const size_t hstep = (size_t)HALF * K * 2;
    const size_t tstep = 2 * hstep;
    const size_t hstepA = (size_t)HALF * g.lda * 2, tstepA = 2 * hstepA;
    const unsigned ldsw = (unsigned)wid * 1024u;
    const int aoff = lds_byte(wr * 64 + fr, fq * 8), boff = lds_byte(wc * 32 + fr, fq * 8);
#define PG8_SA(b, h) (((b) * 2 + (h)) * HTB)
#define PG8_SB(b, h) ((4 + (b) * 2 + (h)) * HTB)
#define PG8_STAGE(bufoff, gbase, voff) do { _Pragma("unroll") for (int _i = 0; _i < 2; ++_i) \
        __builtin_amdgcn_global_load_lds((const unsigned*)((const char*)(gbase) + (voff)[_i]), (PG8_LAS unsigned*)(lds + (bufoff) + ldsw + _i * 8192), 16, 0, 0); } while (0)
#define PG8_STAGE_H0(bufoff, gbase) do { if constexpr (GATHER) PG8_STAGE(bufoff, gbase, voffA0); else PG8_STAGE(bufoff, gbase, voffA); } while (0)
#define PG8_STAGE_H1(bufoff, gbase) do { if constexpr (GATHER) PG8_STAGE(bufoff, gbase, voffA1); else PG8_STAGE(bufoff, (gbase) + hstepA, voffA); } while (0)
#define PG8_GOFF(unit, h, dst) do { _Pragma("unroll") for (int _i = 0; _i < 2; ++_i) { int _R, _C; stage_rc(tid * 16 + _i * 8192, _R, _C); dst[_i] = (unsigned)S.rowidx(unit, (h) * HALF + _R); } } while (0)
#define PG8_GCONV(dst, src) do { _Pragma("unroll") for (int _i = 0; _i < 2; ++_i) { int _R, _C; stage_rc(tid * 16 + _i * 8192, _R, _C); dst[_i] = (src[_i] * (unsigned)g.lda + (unsigned)_C) * 2u; } } while (0)
#define PG8_LDA(dst, b, h) do { _Pragma("unroll") for (int m = 0; m < 4; ++m) _Pragma("unroll") for (int k = 0; k < 2; ++k) dst[m][k] = *(const PG8_LAS bf16x8*)(lds + PG8_SA(b, h) + aoff + m * 2048 + k * 1024); } while (0)
#define PG8_LDB(dst, b, h) do { _Pragma("unroll") for (int n = 0; n < 2; ++n) _Pragma("unroll") for (int k = 0; k < 2; ++k) dst[n][k] = *(const PG8_LAS bf16x8*)(lds + PG8_SB(b, h) + boff + n * 2048 + k * 1024); } while (0)
#define PG8_MMA(ai, bj, At, Bt) do { __builtin_amdgcn_s_setprio(1); _Pragma("unroll") for (int m = 0; m < 4; ++m) _Pragma("unroll") for (int n = 0; n < 2; ++n) _Pragma("unroll") for (int k = 0; k < 2; ++k) \
        acc[ai][bj][m][n] = __builtin_amdgcn_mfma_f32_16x16x32_bf16(Bt[n][k], At[m][k], acc[ai][bj][m][n], 0, 0, 0); __builtin_amdgcn_s_setprio(0); } while (0)
#define PG8_WAIT_V(n) asm volatile("s_waitcnt vmcnt(" #n ")" ::: "memory")
#define PG8_WAIT_L(n) asm volatile("s_waitcnt lgkmcnt(" #n ")" ::: "memory")
#define PG8_BAR __builtin_amdgcn_s_barrier()
#define PG8_SCHED __builtin_amdgcn_sched_barrier(0)
    Unit cur, nxt; int ui = 0;
    if (!S.next(0, cur)) return;
    f32x4 acc[2][2][4][2];
#pragma unroll
    for (int a = 0; a < 2; ++a)
#pragma unroll
        for (int b = 0; b < 2; ++b)
#pragma unroll
            for (int m = 0; m < 4; ++m)
#pragma unroll
                for (int n = 0; n < 2; ++n) acc[a][b][m][n] = (f32x4){0.f, 0.f, 0.f, 0.f};
    bf16x8 At[4][2], B0[2][2], B1[2][2];
    const char* cA = (const char*)g.A + (GATHER ? (size_t)0 : (size_t)cur.pm * tstepA);
    unsigned voffA0[2] = {0u, 0u}, voffA1[2] = {0u, 0u}, nidx0[2] = {0u, 0u}, nidx1[2] = {0u, 0u};
    if constexpr (GATHER) { PG8_GOFF(cur, 0, nidx0); PG8_GOFF(cur, 1, nidx1); PG8_GCONV(voffA0, nidx0); PG8_GCONV(voffA1, nidx1); } const char* cB = (const char*)g.Bt + (size_t)cur.pb * tstep;
    S.a_ready(cur);
    if constexpr (SP2) {
        PG8_STAGE(PG8_SB(0, 0), cB, voffB); PG8_STAGE(PG8_SB(0, 1), cB + hstep, voffB); PG8_STAGE_H0(PG8_SA(0, 0), cA); PG8_STAGE_H1(PG8_SA(0, 1), cA);
        if (wr == 1) PG8_BAR;
        PG8_WAIT_V(2); PG8_BAR;
        PG8_STAGE(PG8_SB(1, 0), cB + kstep, voffB); PG8_STAGE_H0(PG8_SA(1, 0), cA + kstep); PG8_STAGE(PG8_SB(1, 1), cB + hstep + kstep, voffB);
        PG8_WAIT_V(6); PG8_BAR;
    } else {
        PG8_STAGE(PG8_SB(0, 0), cB, voffB); PG8_STAGE_H0(PG8_SA(0, 0), cA); PG8_STAGE(PG8_SB(0, 1), cB + hstep, voffB); PG8_STAGE_H1(PG8_SA(0, 1), cA);
        if (wr == 1) PG8_BAR;
        PG8_WAIT_V(4); PG8_BAR;
        PG8_STAGE(PG8_SB(1, 0), cB + kstep, voffB); PG8_STAGE_H0(PG8_SA(1, 0), cA + kstep); PG8_STAGE(PG8_SB(1, 1), cB + hstep + kstep, voffB);
        PG8_WAIT_V(6); PG8_BAR;
    }
    for (;;) {
        const bool has_next = S.next(ui + 1, nxt);
        const char* nA = (has_next && !GATHER) ? (const char*)g.A + (size_t)nxt.pm * tstepA : cA; const char* nB = has_next ? (const char*)g.Bt + (size_t)nxt.pb * tstep : cB;
        for (int t = 0; t < nt; t += 2) {
            const bool last = (t == nt - 2);
            const char* a1 = cA + (size_t)(t + 1) * kstep;
            const char* a2 = last ? nA : cA + (size_t)(t + 2) * kstep; const char* b2 = last ? nB : cB + (size_t)(t + 2) * kstep;
            const char* a3 = a2 + kstep; const char* b3 = b2 + kstep;
            if (last && has_next) S.a_ready(nxt);
            if constexpr (GATHER) { if (has_next && t == nt - 4) { PG8_GOFF(nxt, 0, nidx0); PG8_GOFF(nxt, 1, nidx1); }
                                    if (has_next && last) PG8_GCONV(voffA0, nidx0); }
            if constexpr (SP2) {
            PG8_LDB(B0, 0, 0); PG8_LDB(B1, 0, 1); PG8_SCHED; PG8_LDA(At, 0, 0); PG8_STAGE_H1(PG8_SA(1, 1), a1);
            if constexpr (GATHER) { if (has_next && last) PG8_GCONV(voffA1, nidx1); }
            PG8_WAIT_V(8); PG8_WAIT_L(0); PG8_BAR; PG8_MMA(0, 0, At, B0); PG8_MMA(0, 1, At, B1); PG8_BAR; PG8_SCHED;
            PG8_LDA(At, 0, 1); PG8_STAGE(PG8_SB(0, 0), b2, voffB); PG8_STAGE(PG8_SB(0, 1), b2 + hstep, voffB); PG8_STAGE_H0(PG8_SA(0, 0), a2);
            PG8_WAIT_V(8); PG8_WAIT_L(0); PG8_BAR; PG8_MMA(1, 0, At, B0); PG8_MMA(1, 1, At, B1); PG8_BAR; PG8_SCHED;
            PG8_LDB(B0, 1, 0); PG8_LDB(B1, 1, 1); PG8_SCHED; PG8_LDA(At, 1, 0); PG8_STAGE_H1(PG8_SA(0, 1), a2);
            PG8_WAIT_V(8); PG8_WAIT_L(0); PG8_BAR; PG8_MMA(0, 0, At, B0); PG8_MMA(0, 1, At, B1); PG8_BAR; PG8_SCHED;
            PG8_LDA(At, 1, 1); PG8_STAGE(PG8_SB(1, 0), b3, voffB); PG8_STAGE(PG8_SB(1, 1), b3 + hstep, voffB); PG8_STAGE_H0(PG8_SA(1, 0), a3);
            PG8_WAIT_V(8); PG8_WAIT_L(0); PG8_BAR; PG8_MMA(1, 0, At, B0); PG8_MMA(1, 1, At, B1); PG8_BAR; PG8_SCHED;
            } else {
            PG8_LDB(B0, 0, 0); PG8_SCHED; PG8_LDA(At, 0, 0); PG8_STAGE(PG8_SA(1, 1), a1 + hstepA, voffA);
            PG8_WAIT_L(8); PG8_BAR; PG8_WAIT_L(0); PG8_MMA(0, 0, At, B0); PG8_BAR; PG8_SCHED;
            PG8_LDB(B1, 0, 1); PG8_STAGE(PG8_SB(0, 0), b2, voffB);
            PG8_BAR; PG8_WAIT_L(0); PG8_MMA(0, 1, At, B1); PG8_BAR;
            PG8_LDA(At, 0, 1); PG8_STAGE(PG8_SA(0, 0), a2, voffA);
            PG8_BAR; PG8_WAIT_L(0); PG8_MMA(1, 0, At, B0); PG8_BAR; PG8_SCHED;
            PG8_STAGE(PG8_SB(0, 1), b2 + hstep, voffB);
            PG8_WAIT_V(6); PG8_BAR; PG8_MMA(1, 1, At, B1); PG8_BAR;
            PG8_LDB(B0, 1, 0); PG8_SCHED; PG8_LDA(At, 1, 0); PG8_STAGE(PG8_SA(0, 1), a2 + hstepA, voffA);
            PG8_WAIT_L(8); PG8_BAR; PG8_WAIT_L(0); PG8_MMA(0, 0, At, B0); PG8_BAR; PG8_SCHED;
            PG8_LDB(B1, 1, 1); PG8_STAGE(PG8_SB(1, 0), b3, voffB);
            PG8_BAR; PG8_WAIT_L(0); PG8_MMA(0, 1, At, B1); PG8_BAR;
            PG8_LDA(At, 1, 1); PG8_STAGE(PG8_SA(1, 0), a3, voffA);
            PG8_BAR; PG8_WAIT_L(0); PG8_MMA(1, 0, At, B0); PG8_BAR; PG8_SCHED;
            PG8_STAGE(PG8_SB(1, 1), b3 + hstep, voffB);
            PG8_WAIT_V(6); PG8_BAR; PG8_MMA(1, 1, At, B1); PG8_BAR;
            }
        }
        if constexpr (ALIGN_EPI) { if (wr == 0) PG8_BAR; }
        if constexpr (!Epi::AFTER_DRAIN) { E(acc, cur, wr, wc, fr, fq); S.done(cur); }
        if (!has_next) break;
#pragma unroll
        for (int a = 0; a < 2; ++a)
#pragma unroll
            for (int b = 0; b < 2; ++b)
#pragma unroll
                for (int m = 0; m < 4; ++m)
#pragma unroll
                    for (int n = 0; n < 2; ++n) acc[a][b][m][n] = (f32x4){0.f, 0.f, 0.f, 0.f};
        cur = nxt; cA = nA; cB = nB; ++ui;
        if constexpr (ALIGN_EPI) { if (wr == 1) PG8_BAR; }
    }
    PG8_WAIT_V(0);
    if constexpr (!ALIGN_EPI) { if (wr == 0) PG8_BAR; }
    PG8_BAR;
    if constexpr (Epi::AFTER_DRAIN) { E.fused(acc, cur, wr, wc, fr, fq, lds, wid, lane); S.done(cur); }
#undef PG8_SA
#undef PG8_SB
#undef PG8_STAGE
#undef PG8_STAGE_H0
#undef PG8_STAGE_H1
#undef PG8_GOFF
#undef PG8_GCONV
#undef PG8_LDA
#undef PG8_LDB
#undef PG8_MMA
#undef PG8_WAIT_V
#undef PG8_WAIT_L
#undef PG8_BAR
#undef PG8_SCHED
}
}
constexpr int NWAVES = 8, NTHR = 512;
constexpr int D = 1024, NB = 8, SEQ = 4096, CTX = 256;
constexpr int NCTX = NB * CTX, NLAT = NB * SEQ, MALL = NCTX + NLAT;
constexpr int N0 = 2304, N1 = 6144;
constexpr int C0_Q = 0, C0_K = 256, C0_V = 512, C0_G = 1024, C0_U = 1536, C0_LOW = 2048;
constexpr int C1_Q = 0, C1_K = 1024, C1_V = 2048, C1_G = 4096;
constexpr int NE = 32, MAXTILES = 576;
constexpr float EPS = 1e-6f;
constexpr int NPH = 24;
enum { PH_PRO = 0, PH_NORM1, PH_INPROJ0, PH_GLAPREP, PH_GLA, PH_S5, PH_FIN0, PH_GLU, PH_OUT0, PH_ROUTER0, PH_GATHER0, PH_GU0, PH_DOWN0, PH_COMB0,
       PH_INPROJ1, PH_ROPE, PH_RET, PH_FIN1, PH_OUT1, PH_ROUTER1, PH_GATHER1, PH_GU1, PH_DOWN1, PH_COMB1 };
#ifndef MK_NAIVE_GLA
#define MK_NAIVE_GLA 0
#endif
#ifndef MK_NAIVE_S5
#define MK_NAIVE_S5 0
#endif
#ifndef MK_NAIVE_RET
#define MK_NAIVE_RET 0
#endif
constexpr size_t MiB = 1u << 20;
constexpr size_t WS_CTL = 0, CTL_ZERO_BYTES = 1 * MiB;
constexpr size_t WS_MOD = 1 * MiB;
constexpr size_t WS_WIN0T = 2 * MiB, WS_WOUT0T = 7 * MiB, WS_WGLUT = 9 * MiB, WS_WIN1T = 10 * MiB, WS_WOUT1T = 22 * MiB;
constexpr size_t WS_SELE = 26 * MiB, WS_WSLOT = 27 * MiB, WS_SPOS = 28 * MiB, WS_PROW = 29 * MiB;
constexpr size_t WS_WGUT = 32 * MiB, WS_WDNT = 288 * MiB;
constexpr size_t WS_XRES = 416 * MiB, WS_H = 552 * MiB, WS_MIX = 620 * MiB, WS_YPRE = 688 * MiB;
constexpr size_t WS_PROJ = 748 * MiB, WS_OREC = 1156 * MiB;
constexpr size_t WS_XG = 748 * MiB, WS_ACT = 1036 * MiB, WS_YSLOT = 1324 * MiB;
constexpr size_t WS_S5W1 = 1556 * MiB, WS_S5W2 = 1560 * MiB, WS_A2 = 1568 * MiB, WS_SLOC = 1668 * MiB;
constexpr size_t WS_ELIST = 1740 * MiB;
constexpr size_t WS_END = 1746 * MiB;
constexpr int CW_TMO = 0, CW_BAR = 4096, CW_GCNT = 16384;
constexpr int RING_BYTES = 131072, LDSCTL_OFF = RING_BYTES, LDS_BYTES = 147456;
constexpr int L_MISC = LDSCTL_OFF;
constexpr int L_TILEE = LDSCTL_OFF + 256;
constexpr int L_TSTART = LDSCTL_OFF + 1024;
constexpr int L_LCNT = LDSCTL_OFF + 1280;
constexpr int L_GBASE = LDSCTL_OFF + 1536;
constexpr int L_BLKE = LDSCTL_OFF + 2048;
constexpr int L_BLKP = LDSCTL_OFF + 5120;
constexpr int L_TPOS = L_BLKE, L_TCNT = L_BLKP;

#define GAS __attribute__((address_space(1)))
#define LAS __attribute__((address_space(3)))
typedef unsigned short bf16;
typedef unsigned v4u __attribute__((ext_vector_type(4)));
typedef unsigned v2u __attribute__((ext_vector_type(2)));
typedef float f32x4 __attribute__((ext_vector_type(4)));
typedef GAS unsigned gu32;
#define RLX_AGENT __ATOMIC_RELAXED, __HIP_MEMORY_SCOPE_AGENT
#define LDS_WAIT() asm volatile("s_waitcnt lgkmcnt(0)" ::: "memory")
#define VM_WAIT() asm volatile("s_waitcnt vmcnt(0)" ::: "memory")
__device__ __forceinline__ unsigned f2bf(float f) { unsigned u = __builtin_bit_cast(unsigned, f); return (u + 0x7fffu + ((u >> 16) & 1u)) >> 16; }
typedef float f32x2_t __attribute__((ext_vector_type(2))); typedef __bf16 bf16x2_t __attribute__((ext_vector_type(2)));
__device__ __forceinline__ unsigned pk2(float lo, float hi) { f32x2_t v = {lo, hi}; bf16x2_t b = __builtin_convertvector(v, bf16x2_t); return __builtin_bit_cast(unsigned, b); }
__device__ __forceinline__ float bf2f(unsigned b) { return __uint_as_float(b << 16); }
__device__ __forceinline__ float blo(unsigned w) { return __uint_as_float(w << 16); }
__device__ __forceinline__ float bhi(unsigned w) { return __uint_as_float(w & 0xffff0000u); }
__device__ __forceinline__ float wave_sum(float v) {
#pragma unroll
    for (int o = 1; o < 64; o <<= 1) v += __shfl_xor(v, o);
    return v;
}
__device__ __forceinline__ float silu_(float z) { return z * __builtin_amdgcn_rcpf(1.0f + __expf(-z)); }
#define XB_TMO      128
#define XB_XCNT(j)  (256  + 64 * (j))
#define XB_XSUB(j)  (1280 + 64 * (j))
#define XB_XGEN(j)  (2304 + 64 * (j))
#define XB_TOP      3328
#define XB_TOPGEN   3392
#define XCD_BAR_WORDS 3456
#define XB_SPIN_CAP (1u << 22)

__device__ __forceinline__ unsigned xb_ld(unsigned* p)              { return __hip_atomic_load(p, __ATOMIC_RELAXED, __HIP_MEMORY_SCOPE_AGENT); }
__device__ __forceinline__ unsigned xb_add(unsigned* p, unsigned v) { return __hip_atomic_fetch_add(p, v, __ATOMIC_RELAXED, __HIP_MEMORY_SCOPE_AGENT); }
__device__ __forceinline__ unsigned xb_xcc_id() { return (unsigned)__builtin_amdgcn_s_getreg((3 << 11) | 20) & 0xFu; }
#define XB_SPIN(cond, bar) do { unsigned _sp = 0; while (cond) { __builtin_amdgcn_s_sleep(1); \
    if ((++_sp & 255u) == 0u) { if (xb_ld(&(bar)[XB_TMO])) break; if (_sp > XB_SPIN_CAP) { atomicAdd(&(bar)[XB_TMO], 1u); break; } } } } while (0)

struct XcdBarrier {
    unsigned* bar; unsigned x;
    volatile LAS unsigned* st;
};

__device__ __forceinline__ XcdBarrier xcd_barrier_post(unsigned* bar, volatile LAS unsigned* st) {
    XcdBarrier b; b.bar = bar; b.x = xb_xcc_id(); b.st = st;
    if (threadIdx.x == 0) (void)xb_add(&bar[XB_XCNT(b.x)], 1u);
    return b;
}
__device__ __forceinline__ void xcd_barrier_complete(unsigned* bar, unsigned x, unsigned& nloc, unsigned& nx) {
    const unsigned G = gridDim.x * gridDim.y * gridDim.z;
    unsigned sum, cnt, mine, sp = 0u;
    for (;;) {
        sum = 0u; cnt = 0u; mine = 0u;
#pragma unroll
        for (unsigned j = 0; j < 16; ++j) { const unsigned c = xb_ld(&bar[XB_XCNT(j)]); sum += c; cnt += (c > 0u) ? 1u : 0u; mine = (j == x) ? c : mine; }
        if (sum == G) break;
        __builtin_amdgcn_s_sleep(1);
        if ((++sp & 255u) == 0u) { if (xb_ld(&bar[XB_TMO])) break; if (sp > XB_SPIN_CAP) { atomicAdd(&bar[XB_TMO], 1u); break; } }
    }
    nloc = mine > 0u ? mine : 1u; nx = cnt > 0u ? cnt : 1u;
}

__device__ __forceinline__ void xcd_barrier(const XcdBarrier& b) {
    asm volatile("s_waitcnt vmcnt(0)" ::: "memory");
    __syncthreads();
    if (threadIdx.x == 0) {
        unsigned* bar = b.bar;
        __builtin_amdgcn_s_waitcnt(0);
        unsigned nloc = b.st[0], nx = b.st[1];
        if (nloc == 0u) { xcd_barrier_complete(bar, b.x, nloc, nx); b.st[0] = nloc; b.st[1] = nx; }
        const unsigned old = xb_add(&bar[XB_XSUB(b.x)], 1u);
        const unsigned gen = old / nloc;
        if (old + 1u == (gen + 1u) * nloc) {
            __builtin_amdgcn_fence(__ATOMIC_RELEASE, "agent");
            asm volatile("s_waitcnt vmcnt(0)" ::: "memory");
            const unsigned og = xb_add(&bar[XB_TOP], 1u);
            const unsigned tg = og / nx;
            if (og + 1u == (tg + 1u) * nx) xb_add(&bar[XB_TOPGEN], 1u);
            else XB_SPIN(xb_ld(&bar[XB_TOPGEN]) == tg, bar);
            __builtin_amdgcn_fence(__ATOMIC_ACQUIRE, "agent");
            xb_add(&bar[XB_XGEN(b.x)], 1u);
            asm volatile("s_waitcnt vmcnt(0)" ::: "memory");
        } else {
            XB_SPIN(xb_ld(&bar[XB_XGEN(b.x)]) == gen, bar);
            __builtin_amdgcn_fence(__ATOMIC_ACQUIRE, "agent");
            asm volatile("s_waitcnt vmcnt(0)" ::: "memory");
        }
    }
    __syncthreads();
}
struct Args { const float* in[34]; float* out; unsigned char* ws; int ph_lo, ph_hi; };
#define CAS __attribute__((address_space(4)))
struct KA {
    const CAS unsigned char* p;
    __device__ __forceinline__ const float* I(int i) const { return *(const float* const CAS*)(p + 8 * i); }
    __device__ __forceinline__ float* OUT() const { return *(float* const CAS*)(p + 8 * 34); }
    __device__ __forceinline__ unsigned char* WS() const { return *(unsigned char* const CAS*)(p + 8 * 35); }
    __device__ __forceinline__ int LO() const { return *(const CAS int*)(p + 8 * 36); }
    __device__ __forceinline__ int HI() const { return *(const CAS int*)(p + 8 * 36 + 4); }
};
__device__ __forceinline__ KA ka_fresh() { KA a; a.p = (const CAS unsigned char*)__builtin_amdgcn_kernarg_segment_ptr(); asm volatile("" : "+s"(a.p)); return a; }
static_assert(sizeof(Args) == 8 * 36 + 8, "kernarg layout");
struct Frame {
    LAS unsigned char* lds;
    volatile LAS unsigned* MISC;
    unsigned* ctl;
    int tid, lane, wave, vcu, G;
};
enum { I_X = 0, I_C, I_CTX, I_CCTX, I_ADAW, I_ADAB, I_N1G, I_N2G, I_ABWIN, I_ABWOUT, I_GLAWA, I_GLABA, I_GLANG, I_LAMRE, I_LAMIM, I_LOGSTEP, I_BRE, I_BIM, I_CRE, I_CIM,
       I_S5D, I_GLUW, I_GLUB, I_RETWIN, I_RETWOUT, I_RETDEC, I_RETNG, I_WROUTER, I_BROUTER, I_WGU, I_BGU, I_WDN, I_BDN, I_FNG };

constexpr int S5_ROWS = 2304, S5_CH = 272;
struct S5Par { float lr, li, step; };
__device__ __forceinline__ void s5_cpow(float lr, float li, float step, float n, float& ar, float& ai) { const float mag = expf(lr * step * n); float s, c; sincosf(li * step * n, &s, &c); ar = mag * c; ai = mag * s; }
__device__ __forceinline__ void s5_zoh_f(float lr, float li, float step, float& fr, float& fi) { float ar, ai; s5_cpow(lr, li, step, 1.0f, ar, ai); const float den = lr * lr + li * li;
    fr = ((ar - 1.0f) * lr + ai * li) / den; fi = (ai * lr - (ar - 1.0f) * li) / den; }
__device__ __forceinline__ void s5_table_item(const KA& A, int kind, int idx, bf16* W1T, bf16* W2T, LAS float* scr, int lane) {
    if (kind == 0) {
        const int g = idx >> 8, n = idx & 255, dir = n >> 7, ri = (n >> 6) & 1, p = n & 63;
        const float lr = A.I(I_LAMRE)[(dir * 32 + g) * 64 + p], li = A.I(I_LAMIM)[(dir * 32 + g) * 64 + p], step = expf(A.I(I_LOGSTEP)[dir * 32 + g]);
        float fr, fi; s5_zoh_f(lr, li, step, fr, fi);
        const int t = lane >> 2, c0 = (lane & 3) * 4;
        float ar, ai; s5_cpow(lr, li, step, (float)(dir ? t : 15 - t), ar, ai);
        const float gr = ar * fr - ai * fi, gi = ar * fi + ai * fr;
        float o[4];
#pragma unroll
        for (int j = 0; j < 4; ++j) { const float br = A.I(I_BRE)[(g * 64 + p) * 16 + c0 + j], bi = A.I(I_BIM)[(g * 64 + p) * 16 + c0 + j]; o[j] = ri ? (gr * bi + gi * br) : (gr * br - gi * bi); }
        v2u w; w.x = pk2(o[0], o[1]); w.y = pk2(o[2], o[3]);
        *(GAS v2u*)(W1T + ((size_t)g * 256 + n) * 256 + 4 * lane) = w;
    } else if (kind == 1) {
        const int g = idx >> 8, n = idx & 255, t = n >> 4, cp = n & 15;
        const int dir = lane >> 5, ri = (lane >> 4) & 1, p0 = (lane & 15) * 4;
        const float step = expf(A.I(I_LOGSTEP)[dir * 32 + g]);
        float o[4];
#pragma unroll
        for (int j = 0; j < 4; ++j) { const int p = p0 + j;
            const float lr = A.I(I_LAMRE)[(dir * 32 + g) * 64 + p], li = A.I(I_LAMIM)[(dir * 32 + g) * 64 + p];
            float ar, ai; s5_cpow(lr, li, step, (float)(dir ? 16 - t : t + 1), ar, ai);
            const float cr = A.I(I_CRE)[((dir * 32 + g) * 16 + cp) * 64 + p], ci = A.I(I_CIM)[((dir * 32 + g) * 16 + cp) * 64 + p];
            o[j] = ri ? -(cr * ai + ci * ar) : (cr * ar - ci * ai); }
        v2u w; w.x = pk2(o[0], o[1]); w.y = pk2(o[2], o[3]);
        *(GAS v2u*)(W2T + ((size_t)g * 256 + n) * 512 + 256 + 4 * lane) = w;
    } else {
        const int g = idx >> 4, tau = idx & 15;
        {
#pragma unroll
            for (int dir = 0; dir < 2; ++dir) { const float lr = A.I(I_LAMRE)[(dir * 32 + g) * 64 + lane], li = A.I(I_LAMIM)[(dir * 32 + g) * 64 + lane], step = expf(A.I(I_LOGSTEP)[dir * 32 + g]);
                float fr, fi, ar, ai; s5_zoh_f(lr, li, step, fr, fi); s5_cpow(lr, li, step, (float)tau, ar, ai);
                scr[(dir * 64 + lane) * 2] = ar * fr - ai * fi; scr[(dir * 64 + lane) * 2 + 1] = ar * fi + ai * fr; }
        }
        LDS_WAIT(); asm volatile("" ::: "memory");
        const int cp = lane >> 2, c0 = (lane & 3) * 4;
        float kf[4] = {0.f, 0.f, 0.f, 0.f}, kb2[4] = {0.f, 0.f, 0.f, 0.f};
        for (int p = 0; p < 64; ++p) {
            const f32x4 b4r = *(const f32x4*)(A.I(I_BRE) + (g * 64 + p) * 16 + c0), b4i = *(const f32x4*)(A.I(I_BIM) + (g * 64 + p) * 16 + c0);
#pragma unroll
            for (int dir = 0; dir < 2; ++dir) { const float gr = scr[(dir * 64 + p) * 2], gi = scr[(dir * 64 + p) * 2 + 1];
                const float cr = A.I(I_CRE)[((dir * 32 + g) * 16 + cp) * 64 + p], ci = A.I(I_CIM)[((dir * 32 + g) * 16 + cp) * 64 + p];
#pragma unroll
                for (int j = 0; j < 4; ++j) { const float xr = gr * b4r[j] - gi * b4i[j], xi = gr * b4i[j] + gi * b4r[j]; const float v = cr * xr - ci * xi;
                    if (dir == 0) kf[j] += v; else kb2[j] += v; } }
        }
        LDS_WAIT(); asm volatile("" ::: "memory");
        bf16* Wg = W2T + (size_t)g * 256 * 512;
        if (tau == 0) { v2u w; w.x = pk2(kf[0] + kb2[0], kf[1] + kb2[1]); w.y = pk2(kf[2] + kb2[2], kf[3] + kb2[3]);
            for (int t = 0; t < 16; ++t) *(GAS v2u*)(Wg + (size_t)(t * 16 + cp) * 512 + t * 16 + c0) = w;
        } else { v2u wf, wb; wf.x = pk2(kf[0], kf[1]); wf.y = pk2(kf[2], kf[3]); wb.x = pk2(kb2[0], kb2[1]); wb.y = pk2(kb2[2], kb2[3]);
            for (int t = tau; t < 16; ++t) *(GAS v2u*)(Wg + (size_t)(t * 16 + cp) * 512 + (t - tau) * 16 + c0) = wf;
            for (int t = 0; t + tau < 16; ++t) *(GAS v2u*)(Wg + (size_t)(t * 16 + cp) * 512 + (t + tau) * 16 + c0) = wb; }
    }
}
__device__ __forceinline__ void p_s5_scan(Frame& F, const float* SLOC, bf16* A2) {
    const KA A = ka_fresh();
    if (F.tid >= 128) return;
    for (int idx = F.vcu * 128 + F.tid; idx < NB * 32 * 2 * 64; idx += F.G * 128) {
        const int p = idx & 63, dir = (idx >> 6) & 1, g = (idx >> 7) & 31, b = idx >> 12;
        const float lr = A.I(I_LAMRE)[(dir * 32 + g) * 64 + p], li = A.I(I_LAMIM)[(dir * 32 + g) * 64 + p], step = expf(A.I(I_LOGSTEP)[dir * 32 + g]);
        float ar, ai; s5_cpow(lr, li, step, 16.0f, ar, ai);
        float sr = 0.f, si = 0.f;
        const size_t rbase = (size_t)g * S5_ROWS + (size_t)b * S5_CH;
        for (int q0 = 0; q0 < S5_CH; q0 += 16) {
            float lre[16], lim[16];
#pragma unroll
            for (int u = 0; u < 16; ++u) { const int q = q0 + u, n = dir ? (q < 16 ? 15 - q : 271 - (q - 16)) : q; const float* sp = SLOC + (rbase + n) * 256 + dir * 128 + p; lre[u] = sp[0]; lim[u] = sp[64]; }
#pragma unroll
            for (int u = 0; u < 16; ++u) { const int q = q0 + u, n = dir ? (q < 16 ? 15 - q : 271 - (q - 16)) : q; bf16* ap = A2 + (rbase + n) * 512 + 256 + dir * 128 + p;
                ap[0] = (bf16)f2bf(sr); ap[64] = (bf16)f2bf(si);
                const float nr = ar * sr - ai * si + lre[u], ni = ar * si + ai * sr + lim[u]; sr = nr; si = ni; }
        }
    }
}
__device__ __forceinline__ void tr_item(const float* src, int ldsrc, int K, int srccol, float scale, bf16* dst, int dstrow0, int k0, LAS float* scr, int lane) {
    if (srccol >= 0) {
        float t[32]; const float* sp = src + (size_t)(k0 + (lane >> 5)) * ldsrc + srccol + (lane & 31);
#pragma unroll
        for (int i = 0; i < 32; ++i) t[i] = sp[(size_t)(2 * i) * ldsrc];
#pragma unroll
        for (int i = 0; i < 32; ++i) scr[(2 * i + (lane >> 5)) * 33 + (lane & 31)] = t[i] * scale;
    } else {
#pragma unroll 8
        for (int i = 0; i < 32; ++i) { const int kk = 2 * i + (lane >> 5); scr[kk * 33 + (lane & 31)] = 0.f; }
    }
    LDS_WAIT(); asm volatile("" ::: "memory");
    const int c = lane & 7;
#pragma unroll
    for (int j = 0; j < 4; ++j) { const int n = (lane >> 3) + 8 * j; const LAS float* s = scr + (8 * c) * 33 + n;
        v4u o; o.x = pk2(s[0 * 33], s[1 * 33]); o.y = pk2(s[2 * 33], s[3 * 33]); o.z = pk2(s[4 * 33], s[5 * 33]); o.w = pk2(s[6 * 33], s[7 * 33]);
        *(GAS v4u*)(dst + (size_t)(dstrow0 + n) * K + k0 + 8 * c) = o; }
    LDS_WAIT(); asm volatile("" ::: "memory");
}
__device__ __forceinline__ void p0_prologue(Frame& F) {
    const KA A = ka_fresh();
    unsigned char* ws = A.WS();
    LAS float* scr = (LAS float*)(F.lds + F.wave * 8704);
    LAS float* sl = (LAS float*)(F.lds + 69632);
    for (int idx = F.tid; idx < 9 * 1024; idx += NTHR) { const int b = idx >> 10, k = idx & 1023; const float cv = b < 8 ? A.I(I_C)[b * 1024 + k] : A.I(I_CCTX)[k]; sl[k * 12 + b] = silu_(cv); }
    __syncthreads();
    const int gw = F.vcu * NWAVES + F.wave, NGW = F.G * NWAVES, lane = F.lane;
    for (int m = F.vcu; m < 192; m += F.G) {
        const int layer = m / 96, col = (m % 96) * 64 + lane;
        const float* w = A.I(I_ADAW) + (size_t)layer * 1024 * 6144 + (size_t)(F.wave * 128) * 6144 + col;
        float acc[9];
#pragma unroll
        for (int b = 0; b < 9; ++b) acc[b] = 0.f;
        for (int k0 = 0; k0 < 128; k0 += 16) {
            float wv[16];
#pragma unroll
            for (int u = 0; u < 16; ++u) wv[u] = w[(size_t)(k0 + u) * 6144];
#pragma unroll
            for (int u = 0; u < 16; ++u) {
#pragma unroll
                for (int b = 0; b < 9; ++b) acc[b] += sl[(F.wave * 128 + k0 + u) * 12 + b] * wv[u]; }
        }
        LAS float* red = (LAS float*)(F.lds);
#pragma unroll
        for (int b = 0; b < 9; ++b) red[(F.wave * 9 + b) * 64 + lane] = acc[b];
        __syncthreads();
        for (int idx = F.tid; idx < 9 * 64; idx += NTHR) { const int b = idx >> 6, l = idx & 63; float s = 0.f;
#pragma unroll
            for (int wv2 = 0; wv2 < 8; ++wv2) s += red[(wv2 * 9 + b) * 64 + l];
            const int c2 = (m % 96) * 64 + l;
            ((float*)(ws + WS_MOD))[(size_t)layer * 9 * 6144 + b * 6144 + c2] = s + A.I(I_ADAB)[layer * 6144 + c2]; }
        __syncthreads();
    }
    constexpr int I_S5A = 8192, I_S5B = 8192, I_S5C = 512, I_IN0 = 1152, I_OUT0 = 512, I_GLU = 128, I_IN1 = 3072, I_OUT1 = 1024, I_GU = 65536, I_DN = 32768;
    constexpr int NITEMS = I_S5A + I_S5B + I_S5C + I_IN0 + I_OUT0 + I_GLU + I_IN1 + I_OUT1 + I_GU + I_DN;
    for (int it = gw; it < NITEMS; it += NGW) {
        int r = it;
        if (r < I_S5A) { s5_table_item(A, 0, r, (bf16*)(ws + WS_S5W1), (bf16*)(ws + WS_S5W2), scr, lane); continue; }
        r -= I_S5A;
        if (r < I_S5B) { s5_table_item(A, 1, r, (bf16*)(ws + WS_S5W1), (bf16*)(ws + WS_S5W2), scr, lane); continue; }
        r -= I_S5B;
        if (r < I_S5C) { s5_table_item(A, 2, r, (bf16*)(ws + WS_S5W1), (bf16*)(ws + WS_S5W2), scr, lane); continue; }
        r -= I_S5C;
        if (r < I_IN0) { const int kb = r / 72, n0 = (r % 72) * 32;
            const int sc = n0 < 1536 ? n0 : (n0 < 2048 ? n0 + 32 : (n0 == 2048 ? 1536 : -1));
            tr_item(A.I(I_ABWIN), 2080, 1024, sc, n0 < 256 ? 0.125f : 1.0f, (bf16*)(ws + WS_WIN0T), n0, kb * 64, scr, lane); continue; }
        r -= I_IN0;
        if (r < I_OUT0) { tr_item(A.I(I_ABWOUT), 1024, 1024, (r % 32) * 32, 1.0f, (bf16*)(ws + WS_WOUT0T), (r % 32) * 32, (r / 32) * 64, scr, lane); continue; }
        r -= I_OUT0;
        if (r < I_GLU) { tr_item(A.I(I_GLUW), 512, 512, (r % 16) * 32, 1.0f, (bf16*)(ws + WS_WGLUT), (r % 16) * 32, (r / 16) * 64, scr, lane); continue; }
        r -= I_GLU;
        if (r < I_IN1) { const int n0 = (r % 192) * 32;
            tr_item(A.I(I_RETWIN), 6144, 1024, n0, (n0 >= 1024 && n0 < 2048) ? 0.0625f : 1.0f, (bf16*)(ws + WS_WIN1T), n0, (r / 192) * 64, scr, lane); continue; }
        r -= I_IN1;
        if (r < I_OUT1) { tr_item(A.I(I_RETWOUT), 1024, 2048, (r % 32) * 32, 1.0f, (bf16*)(ws + WS_WOUT1T), (r % 32) * 32, (r / 32) * 64, scr, lane); continue; }
        r -= I_OUT1;
        if (r < I_GU) { const int mat = r >> 10, q = r & 1023, kb = q >> 6, n0 = (q & 63) * 32;
            const int pn = n0 >> 8, bj = (n0 >> 7) & 1, lc = n0 & 127;
            tr_item(A.I(I_WGU) + (size_t)mat * 1024 * 2048, 2048, 1024, bj * 1024 + pn * 128 + lc, 1.0f, (bf16*)(ws + WS_WGUT) + (size_t)mat * 2048 * 1024, n0, kb * 64, scr, lane); continue; }
        r -= I_GU;
        { const int mat = r >> 9, q = r & 511, kb = q >> 5, n0 = (q & 31) * 32;
          tr_item(A.I(I_WDN) + (size_t)mat * 1024 * 1024, 1024, 1024, n0, 1.0f, (bf16*)(ws + WS_WDNT) + (size_t)mat * 1024 * 1024, n0, kb * 64, scr, lane); }
    }
}
__device__ __forceinline__ void modnorm_store(const f32x4 (&v)[4], const float* g, const float* sc, const float* sh, bf16* hrow, int lane, f32x4 (&h)[4]) {
    float ss = 0.f;
#pragma unroll
    for (int j = 0; j < 4; ++j) ss += (v[j].x * v[j].x + v[j].y * v[j].y) + (v[j].z * v[j].z + v[j].w * v[j].w);
    const float r = rsqrtf(wave_sum(ss) * (1.0f / 1024.0f) + EPS);
#pragma unroll
    for (int j = 0; j < 4; ++j) { const int o = 64 * j + lane;
        const f32x4 gg = ((const f32x4*)g)[o], s4 = ((const f32x4*)sc)[o], h4 = ((const f32x4*)sh)[o];
        h[j] = v[j] * r * gg * (s4 + 1.0f) + h4;
        v2u w; w.x = pk2(h[j].x, h[j].y); w.y = pk2(h[j].z, h[j].w);
        ((GAS v2u*)hrow)[o] = w; }
}
__device__ __forceinline__ int bidx_of_row(int row) { return row < NCTX ? 8 : ((row - NCTX) >> 12); }
__device__ __forceinline__ void p_norm1_l0(Frame& F) {
    const KA A = ka_fresh();
    const int gw = F.vcu * NWAVES + F.wave, NGW = F.G * NWAVES, lane = F.lane;
    const float* mod = (const float*)(A.WS() + WS_MOD);
    bf16* H = (bf16*)(A.WS() + WS_H);
    for (int row = gw; row < MALL; row += NGW) {
        const float* xr = row < NCTX ? A.I(I_CTX) + (size_t)row * 1024 : A.I(I_X) + (size_t)(row - NCTX) * 1024;
        f32x4 v[4], h[4];
#pragma unroll
        for (int j = 0; j < 4; ++j) v[j] = ((const f32x4*)xr)[64 * j + lane];
        const float* m = mod + bidx_of_row(row) * 6144;
        modnorm_store(v, A.I(I_N1G), m + 1024, m, H + (size_t)row * 1024, lane, h);
    }
}
__device__ __forceinline__ int seq_row(int b, int dir, int s) {
    return s < CTX ? b * CTX + (dir ? CTX - 1 - s : s) : NCTX + b * SEQ + (dir ? SEQ - 1 - (s - CTX) : (s - CTX));
}
template <int DK, bool GLA>
__device__ __forceinline__ void rec_naive(Frame& F, const bf16* P, int ldp, int qc, int kc, int vc, int DV, int nvs,
                                          float* O, size_t odir_stride, int ldo, int orow0) {
    const KA A = ka_fresh();
    constexpr int KPW = DK / 8, TB = 16;
    LAS float* qs = (LAS float*)(F.lds);
    LAS float* ks = (LAS float*)(F.lds + 16384);
    LAS float* vv = (LAS float*)(F.lds + 32768);
    LAS float* dec = (LAS float*)(F.lds + 36864);
    LAS float* opart = (LAS float*)(F.lds + 40960);
    const int tid = F.tid, lane = F.lane, wave = F.wave;
    const int nitems = NB * 4 * 2 * nvs;
    for (int it = F.vcu; it < nitems; it += F.G) {
        const int vs = it % nvs, dir = (it / nvs) & 1, h = (it / (2 * nvs)) & 3, b = it / (8 * nvs);
        float gamma = 0.f;
        if (!GLA) { const float lg = A.I(I_RETDEC)[dir * 4 + h]; gamma = 1.0f / (1.0f + expf(-lg)); }
        float S[KPW];
#pragma unroll
        for (int i = 0; i < KPW; ++i) S[i] = 0.f;
        for (int s0 = 0; s0 < CTX + SEQ; s0 += TB) {
            for (int idx = tid; idx < TB * DK; idx += NTHR) { const int i = idx / DK, kk = idx % DK; const size_t rb = (size_t)seq_row(b, dir, s0 + i) * ldp;
                qs[idx] = bf2f(P[rb + qc + h * DK + kk]); ks[idx] = bf2f(P[rb + kc + h * DK + kk]); }
            for (int idx = tid; idx < TB * 64; idx += NTHR) { const int i = idx >> 6, c = idx & 63; const size_t rb = (size_t)seq_row(b, dir, s0 + i) * ldp;
                vv[idx] = bf2f(P[rb + vc + h * DV + vs * 64 + c]);
                if (GLA) { float z = A.I(I_GLABA)[dir * 256 + h * 64 + c];
#pragma unroll
                    for (int r = 0; r < 16; ++r) z += bf2f(P[rb + C0_LOW + dir * 16 + r]) * A.I(I_GLAWA)[(dir * 16 + r) * 256 + h * 64 + c];
                    const float ls = fminf(z, 0.f) - log1pf(expf(-fabsf(z)));
                    dec[idx] = expf(ls * (1.0f / 16.0f)); } }
            __syncthreads();
#pragma unroll 1
            for (int i = 0; i < TB; ++i) { const float vval = vv[i * 64 + lane]; float part = 0.f;
#pragma unroll
                for (int kk = 0; kk < KPW; ++kk) { const int kidx = wave * KPW + kk; const float d = GLA ? dec[i * 64 + kidx] : gamma;
                    S[kk] = d * S[kk] + ks[i * DK + kidx] * vval; part += qs[i * DK + kidx] * S[kk]; }
                opart[(i * 8 + wave) * 64 + lane] = part; }
            __syncthreads();
            for (int idx = tid; idx < TB * 64; idx += NTHR) { const int i = idx >> 6, c = idx & 63; float sum = 0.f;
#pragma unroll
                for (int w = 0; w < 8; ++w) sum += opart[(i * 8 + w) * 64 + c];
                const int row = seq_row(b, dir, s0 + i);
                if (row >= orow0) O[(size_t)dir * odir_stride + (size_t)(row - orow0) * ldo + h * DV + vs * 64 + c] = sum; }
        }
        __syncthreads();
    }
}
__device__ __forceinline__ void s5_naive(Frame& F, const bf16* P, float* Y  ) {
    const KA A = ka_fresh();
    const int lane = F.lane;
    if (F.wave >= 2) return;
    for (int chain = F.vcu * 2 + F.wave; chain < NB * 32 * 2; chain += F.G * 2) {
        const int dir = chain & 1, g = (chain >> 1) & 31, b = chain >> 6;
        const float step = expf(A.I(I_LOGSTEP)[dir * 32 + g]);
        const float lr = A.I(I_LAMRE)[(dir * 32 + g) * 64 + lane], li = A.I(I_LAMIM)[(dir * 32 + g) * 64 + lane];
        const float mag = expf(lr * step), lbr = mag * cosf(li * step), lbi = mag * sinf(li * step), den = lr * lr + li * li;
        const float fr = ((lbr - 1.0f) * lr + lbi * li) / den, fi = (lbi * lr - (lbr - 1.0f) * li) / den;
        float bbr[16], bbi[16], cr[16], ci[16];
#pragma unroll
        for (int c = 0; c < 16; ++c) { const float br = A.I(I_BRE)[(g * 64 + lane) * 16 + c], bi = A.I(I_BIM)[(g * 64 + lane) * 16 + c];
            bbr[c] = fr * br - fi * bi; bbi[c] = fr * bi + fi * br;
            cr[c] = A.I(I_CRE)[((dir * 32 + g) * 16 + c) * 64 + lane]; ci[c] = A.I(I_CIM)[((dir * 32 + g) * 16 + c) * 64 + lane]; }
        float sr = 0.f, si = 0.f;
        for (int s0 = 0; s0 < CTX + SEQ; s0 += 4) {
            v4u uu[4][2];
#pragma unroll
            for (int i = 0; i < 4; ++i) { const v4u* up = (const v4u*)(P + (size_t)seq_row(b, dir, s0 + i) * N0 + C0_U + g * 16); uu[i][0] = up[0]; uu[i][1] = up[1]; }
#pragma unroll
            for (int i = 0; i < 4; ++i) {
                float u[16];
#pragma unroll
                for (int q = 0; q < 2; ++q) { u[8 * q + 0] = blo(uu[i][q].x); u[8 * q + 1] = bhi(uu[i][q].x); u[8 * q + 2] = blo(uu[i][q].y); u[8 * q + 3] = bhi(uu[i][q].y);
                    u[8 * q + 4] = blo(uu[i][q].z); u[8 * q + 5] = bhi(uu[i][q].z); u[8 * q + 6] = blo(uu[i][q].w); u[8 * q + 7] = bhi(uu[i][q].w); }
                float br = 0.f, bi = 0.f;
#pragma unroll
                for (int c = 0; c < 16; ++c) { br += bbr[c] * u[c]; bi += bbi[c] * u[c]; }
                const float nr = lbr * sr - lbi * si + br, ni = lbr * si + lbi * sr + bi; sr = nr; si = ni;
                float v[16];
#pragma unroll
                for (int c = 0; c < 16; ++c) v[c] = cr[c] * sr - ci[c] * si;
                const bool b5 = (lane & 32) != 0, b4 = (lane & 16) != 0, b3 = (lane & 8) != 0, b2 = (lane & 4) != 0;
                float w8[8], w4[4], w2[2];
#pragma unroll
                for (int k = 0; k < 8; ++k) { const float send = b5 ? v[k] : v[k + 8], keep = b5 ? v[k + 8] : v[k]; w8[k] = keep + __shfl_xor(send, 32); }
#pragma unroll
                for (int k = 0; k < 4; ++k) { const float send = b4 ? w8[k] : w8[k + 4], keep = b4 ? w8[k + 4] : w8[k]; w4[k] = keep + __shfl_xor(send, 16); }
#pragma unroll
                for (int k = 0; k < 2; ++k) { const float send = b3 ? w4[k] : w4[k + 2], keep = b3 ? w4[k + 2] : w4[k]; w2[k] = keep + __shfl_xor(send, 8); }
                float w1; { const float send = b2 ? w2[0] : w2[1], keep = b2 ? w2[1] : w2[0]; w1 = keep + __shfl_xor(send, 4); }
                w1 += __shfl_xor(w1, 2); w1 += __shfl_xor(w1, 1);
                const int c = (b5 ? 8 : 0) + (b4 ? 4 : 0) + (b3 ? 2 : 0) + (b2 ? 1 : 0);
                if ((lane & 3) == 0) Y[(size_t)dir * MALL * 512 + (size_t)seq_row(b, dir, s0 + i) * 512 + g * 16 + c] = w1;
            }
        }
    }
}
__device__ __forceinline__ void unpack8(const v4u w, float (&f)[8]) { f[0] = blo(w.x); f[1] = bhi(w.x); f[2] = blo(w.y); f[3] = bhi(w.y); f[4] = blo(w.z); f[5] = bhi(w.z); f[6] = blo(w.w); f[7] = bhi(w.w); }
__device__ __forceinline__ v4u pack8(const float (&f)[8]) { v4u w; w.x = pk2(f[0], f[1]); w.y = pk2(f[2], f[3]); w.z = pk2(f[4], f[5]); w.w = pk2(f[6], f[7]); return w; }
__device__ __forceinline__ void p_finish0(Frame& F) {
    const KA A = ka_fresh();
    const int gw = F.vcu * NWAVES + F.wave, NGW = F.G * NWAVES, lane = F.lane, e0 = lane * 8;
    const bf16* P = (const bf16*)(A.WS() + WS_PROJ);
    const float* GO = (const float*)(A.WS() + WS_OREC);
    const float* SY = GO + (size_t)2 * MALL * 512;
    bf16* MIX = (bf16*)(A.WS() + WS_MIX); bf16* YP = (bf16*)(A.WS() + WS_YPRE);
    for (int row = gw; row < MALL; row += NGW) {
        float o[8], gg[8], ng[8];
#if MK_NAIVE_GLA
        { const f32x4* a = (const f32x4*)(GO + (size_t)row * 512 + e0); const f32x4* bq = (const f32x4*)(GO + (size_t)(MALL + row) * 512 + e0);
          const f32x4 a0 = a[0] + bq[0], a1 = a[1] + bq[1]; o[0] = a0.x; o[1] = a0.y; o[2] = a0.z; o[3] = a0.w; o[4] = a1.x; o[5] = a1.y; o[6] = a1.z; o[7] = a1.w; }
#else
        { const bf16* GO16 = (const bf16*)GO; float f0[8], f1[8]; unpack8(*(const v4u*)(GO16 + (size_t)row * 512 + e0), f0); unpack8(*(const v4u*)(GO16 + (size_t)(MALL + row) * 512 + e0), f1);
#pragma unroll
          for (int j = 0; j < 8; ++j) o[j] = f0[j] + f1[j]; }
#endif
        float ss = 0.f;
#pragma unroll
        for (int j = 0; j < 8; ++j) ss += o[j] * o[j];
        ss += __shfl_xor(ss, 1); ss += __shfl_xor(ss, 2); ss += __shfl_xor(ss, 4); ss += __shfl_xor(ss, 8);
        const float r = rsqrtf(ss * (1.0f / 128.0f) + EPS);
        unpack8(*(const v4u*)(P + (size_t)row * N0 + C0_G + e0), gg);
        { const f32x4* n4 = (const f32x4*)(A.I(I_GLANG) + (e0 & 127)); const f32x4 n0 = n4[0], n1 = n4[1]; ng[0] = n0.x; ng[1] = n0.y; ng[2] = n0.z; ng[3] = n0.w; ng[4] = n1.x; ng[5] = n1.y; ng[6] = n1.z; ng[7] = n1.w; }
        float res[8];
#pragma unroll
        for (int j = 0; j < 8; ++j) res[j] = o[j] * r * ng[j] * silu_(gg[j]);
        *(GAS v4u*)(MIX + (size_t)row * 1024 + e0) = pack8(res);
#if MK_NAIVE_S5
        float u[8], y[8];
        unpack8(*(const v4u*)(P + (size_t)row * N0 + C0_U + e0), u);
        { const f32x4* a = (const f32x4*)(SY + (size_t)row * 512 + e0); const f32x4* bq = (const f32x4*)(SY + (size_t)(MALL + row) * 512 + e0);
          const f32x4 a0 = a[0] + bq[0], a1 = a[1] + bq[1]; y[0] = a0.x; y[1] = a0.y; y[2] = a0.z; y[3] = a0.w; y[4] = a1.x; y[5] = a1.y; y[6] = a1.z; y[7] = a1.w; }
#pragma unroll
        for (int j = 0; j < 8; ++j) { const float t = y[j] + A.I(I_S5D)[e0 + j] * u[j]; res[j] = 0.5f * t * (1.0f + tanhf(0.7978845608f * (t + 0.044715f * t * t * t))); }
        *(GAS v4u*)(YP + (size_t)row * 512 + e0) = pack8(res);
#endif
    }
}
__device__ __forceinline__ void p_finish1(Frame& F) {
    const KA A = ka_fresh();
    const int gw = F.vcu * NWAVES + F.wave, NGW = F.G * NWAVES, lane = F.lane;
    const bf16* P = (const bf16*)(A.WS() + WS_PROJ);
    const float* RO = (const float*)(A.WS() + WS_OREC);
    bf16* MIX = (bf16*)(A.WS() + WS_MIX);
    for (int lrow = gw; lrow < NLAT; lrow += NGW) {
#pragma unroll 1
        for (int h = 0; h < 4; ++h) { const int e0 = h * 512 + lane * 8;
            float o[8], gg[8];
#if MK_NAIVE_RET
            { const f32x4* a = (const f32x4*)(RO + (size_t)lrow * 2048 + e0); const f32x4* bq = (const f32x4*)(RO + (size_t)(NLAT + lrow) * 2048 + e0);
              const f32x4 a0 = a[0] + bq[0], a1 = a[1] + bq[1]; o[0] = a0.x; o[1] = a0.y; o[2] = a0.z; o[3] = a0.w; o[4] = a1.x; o[5] = a1.y; o[6] = a1.z; o[7] = a1.w; }
#else
            { const bf16* RO16 = (const bf16*)RO; float f0[8], f1[8]; unpack8(*(const v4u*)(RO16 + (size_t)lrow * 2048 + e0), f0); unpack8(*(const v4u*)(RO16 + (size_t)(NLAT + lrow) * 2048 + e0), f1);
#pragma unroll
              for (int j = 0; j < 8; ++j) o[j] = f0[j] + f1[j]; }
#endif
            float s = 0.f;
#pragma unroll
            for (int j = 0; j < 8; ++j) s += o[j];
            const float mu = wave_sum(s) * (1.0f / 512.0f); float q = 0.f;
#pragma unroll
            for (int j = 0; j < 8; ++j) { o[j] -= mu; q += o[j] * o[j]; }
            const float r = rsqrtf(wave_sum(q) * (1.0f / 512.0f) + EPS);
            unpack8(*(const v4u*)(P + (size_t)(NCTX + lrow) * N1 + C1_G + e0), gg);
            float res[8];
#pragma unroll
            for (int j = 0; j < 8; ++j) res[j] = o[j] * r * A.I(I_RETNG)[e0 + j] * silu_(gg[j]);
            *(GAS v4u*)(MIX + (size_t)lrow * 2048 + e0) = pack8(res); }
    }
}
__device__ __forceinline__ void p_rope(Frame& F) {
    const KA A = ka_fresh();
    const int gw = F.vcu * NWAVES + F.wave, NGW = F.G * NWAVES, lane = F.lane;
    bf16* P = (bf16*)(A.WS() + WS_PROJ);
    LAS float* ct = (LAS float*)F.lds;
    LAS float* st = ct + 4096;
    for (int i = F.tid; i < 4096; i += NTHR) { const int pos = i >> 6, fi = i & 63; float sn, cs; sincosf((float)pos * expf(-(float)fi * (9.210340371976184f / 64.0f)), &sn, &cs); ct[i] = cs; st[i] = sn; }
    __syncthreads();
    for (int lrow = gw; lrow < NLAT; lrow += NGW) {
        const int t = lrow & (SEQ - 1), pr = t >> 6, pc = t & 63;
        bf16* rp = P + (size_t)(NCTX + lrow) * N1;
        v4u a[2], b2[2]; int off[2], pos[2], f0[2];
#pragma unroll
        for (int q = 0; q < 2; ++q) { const int task = lane + 64 * q, tens = task >> 4, half = (task >> 3) & 1, ch = task & 7;
            off[q] = tens * 256 + half * 128 + ch * 8; pos[q] = half ? pc : pr; f0[q] = ch * 8;
            a[q] = *(const v4u*)(rp + off[q]); b2[q] = *(const v4u*)(rp + off[q] + 64); }
#pragma unroll
        for (int q = 0; q < 2; ++q) { float x[8], y[8], xo[8], yo[8]; unpack8(a[q], x); unpack8(b2[q], y);
            const f32x4 c0 = *(const LAS f32x4*)(ct + pos[q] * 64 + f0[q]), c1 = *(const LAS f32x4*)(ct + pos[q] * 64 + f0[q] + 4), s0 = *(const LAS f32x4*)(st + pos[q] * 64 + f0[q]), s1 = *(const LAS f32x4*)(st + pos[q] * 64 + f0[q] + 4);
#pragma unroll
            for (int j = 0; j < 8; ++j) { const float cs = j < 4 ? c0[j & 3] : c1[j & 3], sn = j < 4 ? s0[j & 3] : s1[j & 3]; xo[j] = x[j] * cs - y[j] * sn; yo[j] = x[j] * sn + y[j] * cs; }
            *(GAS v4u*)(rp + off[q]) = pack8(xo); *(GAS v4u*)(rp + off[q] + 64) = pack8(yo); }
    }
}
__device__ __forceinline__ void p_router(Frame& F, int layer) {
    const KA A = ka_fresh();
    const int tid = F.tid, lane = F.lane, wave = F.wave;
    const int moe_row0 = layer ? NCTX : 0, NTOK = layer ? NLAT : MALL;
    const int RPB = (NTOK + F.G - 1) / F.G;
    unsigned char* ws = A.WS();
    int* prow = (int*)(ws + WS_PROW); int* sel_e = (int*)(ws + WS_SELE); float* w_slot = (float*)(ws + WS_WSLOT); int* slot_pos = (int*)(ws + WS_SPOS);
    LAS float* Wt = (LAS float*)F.lds;
    LAS int* lcnt = (LAS int*)(F.lds + L_LCNT); LAS int* gbase = (LAS int*)(F.lds + L_GBASE);
    LAS int* blk_e = (LAS int*)(F.lds + L_BLKE); LAS int* blk_p = (LAS int*)(F.lds + L_BLKP);
    const float* wr = A.I(I_WROUTER) + (size_t)layer * 1024 * 32;
    for (int idx = tid; idx < 32768; idx += NTHR) Wt[(idx & 31) * 1024 + (idx >> 5)] = wr[idx];
    if (tid < 32) lcnt[tid] = 0;
    __syncthreads();
    const float* mod = (const float*)(ws + WS_MOD) + (size_t)layer * 9 * 6144;
    const bf16* XR = (const bf16*)(ws + WS_XRES); bf16* H = (bf16*)(ws + WS_H);
    const int tok0 = F.vcu * RPB;
    for (int lr = wave; lr < RPB; lr += NWAVES) {
        const int tok = tok0 + lr; if (tok >= NTOK) break;
        const int row = moe_row0 + tok;
        f32x4 v[4], h[4];
#pragma unroll
        for (int j = 0; j < 4; ++j) { const v2u xw = ((const v2u*)(XR + (size_t)row * 1024))[64 * j + lane]; v[j] = (f32x4){blo(xw.x), bhi(xw.x), blo(xw.y), bhi(xw.y)}; }
        const float* m = mod + bidx_of_row(row) * 6144;
        modnorm_store(v, A.I(I_N2G) + layer * 1024, m + 4096, m + 3072, H + (size_t)row * 1024, lane, h);
        float pa[32];
#pragma unroll
        for (int e = 0; e < 32; ++e) { float a = 0.f;
#pragma unroll
            for (int j = 0; j < 4; ++j) { const f32x4 w4 = *(const LAS f32x4*)(Wt + e * 1024 + 4 * (64 * j + lane)); a += (h[j].x * w4.x + h[j].y * w4.y) + (h[j].z * w4.z + h[j].w * w4.w); }
            pa[e] = a; }
        float myl;
        { const bool b5 = (lane & 32) != 0, b4 = (lane & 16) != 0, b3 = (lane & 8) != 0, b2 = (lane & 4) != 0, b1 = (lane & 2) != 0;
          float w16[16], w8[8], w4[4], w2[2];
#pragma unroll
          for (int k = 0; k < 16; ++k) { const float send = b5 ? pa[k] : pa[k + 16], keep = b5 ? pa[k + 16] : pa[k]; w16[k] = keep + __shfl_xor(send, 32); }
#pragma unroll
          for (int k = 0; k < 8; ++k) { const float send = b4 ? w16[k] : w16[k + 8], keep = b4 ? w16[k + 8] : w16[k]; w8[k] = keep + __shfl_xor(send, 16); }
#pragma unroll
          for (int k = 0; k < 4; ++k) { const float send = b3 ? w8[k] : w8[k + 4], keep = b3 ? w8[k + 4] : w8[k]; w4[k] = keep + __shfl_xor(send, 8); }
#pragma unroll
          for (int k = 0; k < 2; ++k) { const float send = b2 ? w4[k] : w4[k + 2], keep = b2 ? w4[k + 2] : w4[k]; w2[k] = keep + __shfl_xor(send, 4); }
          { const float send = b1 ? w2[0] : w2[1], keep = b1 ? w2[1] : w2[0]; myl = keep + __shfl_xor(send, 2); }
          myl += __shfl_xor(myl, 1); }
        const int mye = lane >> 1;
        myl += A.I(I_BROUTER)[layer * 32 + mye];
        float bv[4]; int bi[4];
#pragma unroll
        for (int r = 0; r < 4; ++r) { float v = myl; int id = mye;
#pragma unroll
            for (int o = 1; o < 64; o <<= 1) { const float ov = __shfl_xor(v, o); const int oi = __shfl_xor(id, o); const bool take = ov > v || (ov == v && oi < id); v = take ? ov : v; id = take ? oi : id; }
            bv[r] = v; bi[r] = id; myl = (mye == id) ? -INFINITY : myl; }
        const float e1 = __expf(bv[1] - bv[0]), e2 = __expf(bv[2] - bv[0]), e3 = __expf(bv[3] - bv[0]), inv = 1.0f / (1.0f + e1 + e2 + e3);
        if (lane < 4) { const int ee = lane == 0 ? bi[0] : (lane == 1 ? bi[1] : (lane == 2 ? bi[2] : bi[3]));
            const float wv = (lane == 0 ? 1.0f : (lane == 1 ? e1 : (lane == 2 ? e2 : e3))) * inv;
            sel_e[tok * 4 + lane] = ee; w_slot[tok * 4 + lane] = wv;
            const int lp = __hip_atomic_fetch_add(lcnt + ee, 1, __ATOMIC_RELAXED, __HIP_MEMORY_SCOPE_WORKGROUP);
            blk_e[lr * 4 + lane] = ee; blk_p[lr * 4 + lane] = lp; }
    }
    __syncthreads();
    if (tid < 32) gbase[tid] = (int)__hip_atomic_fetch_add(F.ctl + CW_GCNT + 64 * layer + tid, (unsigned)lcnt[tid], RLX_AGENT);
    __syncthreads();
    int* elist = (int*)(ws + WS_ELIST);
    for (int idx = tid; idx < RPB * 4; idx += NTHR) { const int tok = tok0 + (idx >> 2); if (tok < NTOK) { const int e = blk_e[idx]; elist[(size_t)e * MALL + gbase[e] + blk_p[idx]] = tok * 4 + (idx & 3); } }
}
__device__ __forceinline__ int moe_tables(Frame& F, int layer) {
    LAS int* ts = (LAS int*)(F.lds + L_TSTART); LAS unsigned char* te = (LAS unsigned char*)(F.lds + L_TILEE);
    __syncthreads();
    if (F.tid == 0) { int acc = 0;
        for (int e = 0; e < 32; ++e) { ts[e] = acc; acc += ((int)__hip_atomic_load(F.ctl + CW_GCNT + 64 * layer + e, RLX_AGENT) + 255) >> 8; }
        ts[32] = acc > MAXTILES ? MAXTILES : acc; }
    __syncthreads();
    const int nt = ts[32];
    LAS int* tpos = (LAS int*)(F.lds + L_TPOS); LAS int* tcnt = (LAS int*)(F.lds + L_TCNT);
    for (int T = F.tid; T < nt; T += NTHR) { int e = 0;
        for (int q = 1; q < 32; ++q) e = (T >= ts[q]) ? q : e;
        te[T] = (unsigned char)e; tpos[T] = (T - ts[e]) * 256; tcnt[T] = (int)__hip_atomic_load(F.ctl + CW_GCNT + 64 * layer + e, RLX_AGENT); }
    __syncthreads();
    return nt;
}
__device__ __forceinline__ void p_combine(Frame& F, int layer, bool dry) {
    const KA A = ka_fresh();
    const int gw = F.vcu * NWAVES + F.wave, NGW = F.G * NWAVES, lane = F.lane;
    const int moe_row0 = layer ? NCTX : 0, NTOK = layer ? NLAT : MALL;
    unsigned char* ws = A.WS();
    const bf16* XR = (const bf16*)(ws + WS_XRES); bf16* XW = dry ? (bf16*)(ws + WS_PROJ) : (bf16*)(ws + WS_XRES); bf16* H = dry ? (bf16*)(ws + WS_PROJ + 160 * MiB) : (bf16*)(ws + WS_H); const bf16* YS = (const bf16*)(ws + WS_YSLOT);
    float* OUTP = dry ? (float*)(ws + WS_PROJ) : A.OUT();
    const float* mod = (const float*)(ws + WS_MOD);
    float palpha = 1.0f;
#if defined(MK_PROBE) && MK_PROBE >= 0
    {
      const unsigned* st = F.ctl + 20000 + 2 * MK_PROBE;
      const unsigned long long t0 = ((unsigned long long)__hip_atomic_load(st + 1, RLX_AGENT) << 32) | __hip_atomic_load(st, RLX_AGENT), t1 = ((unsigned long long)__hip_atomic_load(st + 3, RLX_AGENT) << 32) | __hip_atomic_load(st + 2, RLX_AGENT);
      palpha = 1.0f + exp2f((float)(t1 - t0) * 0.01f * 0.01f * 3.321928095f); }
#endif
    for (int tok = gw; tok < NTOK; tok += NGW) {
        const int row = moe_row0 + tok, bidx = bidx_of_row(row);
        const float* g2 = mod + (size_t)layer * 9 * 6144 + bidx * 6144 + 5120;
        f32x4 v[4];
#pragma unroll
        for (int j = 0; j < 4; ++j) { const int o = 64 * j + lane; f32x4 y = (f32x4){0.f, 0.f, 0.f, 0.f};
#pragma unroll
            for (int k = 0; k < 4; ++k) { const v2u w = ((const v2u*)(YS + (size_t)(tok * 4 + k) * 1024))[o]; y += (f32x4){blo(w.x), bhi(w.x), blo(w.y), bhi(w.y)}; }
            const v2u xw = ((const v2u*)(XR + (size_t)row * 1024))[o];
            v[j] = (f32x4){blo(xw.x), bhi(xw.x), blo(xw.y), bhi(xw.y)} + ((const f32x4*)g2)[o] * y; }
        if (layer == 0) {
#pragma unroll
            for (int j = 0; j < 4; ++j) { v2u w; w.x = pk2(v[j].x, v[j].y); w.y = pk2(v[j].z, v[j].w); ((GAS v2u*)(XW + (size_t)row * 1024))[64 * j + lane] = w; }
            const float* m1 = mod + (size_t)9 * 6144 + bidx * 6144; f32x4 h[4];
            modnorm_store(v, A.I(I_N1G) + 1024, m1 + 1024, m1, H + (size_t)row * 1024, lane, h);
        } else {
            float ss = 0.f;
#pragma unroll
            for (int j = 0; j < 4; ++j) ss += (v[j].x * v[j].x + v[j].y * v[j].y) + (v[j].z * v[j].z + v[j].w * v[j].w);
            const float r = rsqrtf(wave_sum(ss) * (1.0f / 1024.0f) + EPS);
#pragma unroll
            for (int j = 0; j < 4; ++j) { const int o = 64 * j + lane; ((f32x4*)(OUTP + (size_t)tok * 1024))[o] = v[j] * (r * palpha) * ((const f32x4*)A.I(I_FNG))[o]; }
        }
    }
}
typedef short s16x4 __attribute__((ext_vector_type(4)));
typedef short bfx8 __attribute__((ext_vector_type(8)));
typedef short v4i16_t __attribute__((ext_vector_type(4)));
#define MFMA16(a, b, c) __builtin_amdgcn_mfma_f32_16x16x32_bf16((a), (b), (c), 0, 0, 0)
__device__ __forceinline__ bfx8 frag_n(const LAS unsigned char* tile, int stride, int r0, int k0, int lane) {
    return *(const LAS bfx8*)(tile + (r0 + (lane & 15)) * stride + (k0 + 8 * (lane >> 4)) * 2);
}
__device__ __forceinline__ bfx8 frag_t(const LAS unsigned char* tile, int stride, int k0, int n0, int lane) {
    const int g = lane >> 4, q = (lane & 15) >> 2, p = lane & 3;
    const LAS unsigned char* a = tile + (k0 + 8 * g + q) * stride + (n0 + 4 * p) * 2;
    const s16x4 lo = __builtin_bit_cast(s16x4, __builtin_amdgcn_ds_read_tr16_b64_v4i16((LAS v4i16_t*)a));
    const s16x4 hi = __builtin_bit_cast(s16x4, __builtin_amdgcn_ds_read_tr16_b64_v4i16((LAS v4i16_t*)(a + 4 * stride)));
    return __builtin_shufflevector(lo, hi, 0, 1, 2, 3, 4, 5, 6, 7);
}
__device__ __forceinline__ v4u scale8(const v4u w, float s) { float f[8]; unpack8(w, f);
#pragma unroll
    for (int j = 0; j < 8; ++j) f[j] *= s;
    return pack8(f); }

template <int DK, int DVS, bool GLA, bool INTRA = true>
__device__ __forceinline__ void rec_mfma(Frame& F, const bf16* Qsrc, const bf16* Ksrc, const bf16* K2src, size_t qdir_stride, int ldq, int qcol, int kcol,
                                         const bf16* Vsrc, int ldv, int vcol, int DV, const float* EB,
                                         bf16* O, size_t odir_stride, int ldo, int orow0) {
    const KA A = ka_fresh();
    constexpr int SQ = DK * 2 + 16, SV = DVS * 2 + 16, SP = 144, SS = DK * 2 + 16;
    constexpr int O_QD = 0, O_KI = O_QD + 64 * SQ, O_KS = O_KI + 64 * SQ, O_V = O_KS + (GLA ? 64 * SQ : 0), O_VD = O_V + 64 * SV, O_P = O_VD + (GLA ? 0 : 64 * SV), O_ST = O_P + 64 * SP, O_EB = O_ST + DVS * SS;
    static_assert(O_EB + DK * 4 <= RING_BYTES, "rec_mfma LDS");
    constexpr int NVS = 0;  (void)NVS;
    constexpr int VT_PER = DVS / 32, KT_PER = DK / 64, QCH = DK / 8  , QN = (64 * QCH) / NTHR, VCH = DVS / 8, KSTEPS = DK / 32;
    static_assert(QN >= 1 && VT_PER >= 1 && KT_PER >= 1, "shape");
    const LAS unsigned char* L = F.lds;
    const int tid = F.tid, lane = F.lane, w = F.wave, it = w & 3, vg = w >> 2, kg = w & 3, g4 = lane >> 4, l15 = lane & 15;
    const int nvs = DV / DVS, nitems = NB * 4 * 2 * nvs;
    for (int item = F.vcu; item < nitems; item += F.G) {
        const int vs = item % nvs, dir = (item / nvs) & 1, h = (item / (2 * nvs)) & 3, b = item / (8 * nvs);
        float lg2 = 0.f;
        if (!GLA) { const float lgt = A.I(I_RETDEC)[dir * 4 + h]; lg2 = -log2f(1.0f + expf(-lgt)); }
        const bf16* qb = Qsrc + (GLA ? (size_t)dir * qdir_stride : 0) + qcol + h * DK;
        const bf16* kb = Ksrc + (GLA ? (size_t)dir * qdir_stride : 0) + kcol + h * DK;
        const bf16* k2b = GLA ? K2src + (size_t)dir * qdir_stride + kcol + h * DK : kb;
        const bf16* vb = Vsrc + vcol + h * DV + vs * DVS;
        f32x4 Sacc[VT_PER][KT_PER];
#pragma unroll
        for (int a = 0; a < VT_PER; ++a)
#pragma unroll
            for (int c2 = 0; c2 < KT_PER; ++c2) Sacc[a][c2] = (f32x4){0.f, 0.f, 0.f, 0.f};
        for (int i = tid; i < DVS * SS / 4; i += NTHR) ((LAS unsigned*)(F.lds + O_ST))[i] = 0u;
        v4u rq[QN], rk[QN], rk2[GLA ? QN : 1], rv; float peb = 0.f;
        rv = (v4u){0u, 0u, 0u, 0u};
#define REC_LOAD(c) do { \
            const int rowc_ = seq_row(b, dir, 64 * (c));                   \
            _Pragma("unroll") for (int n = 0; n < QN; ++n) { const int pi = tid + NTHR * n, r = pi / QCH, ch = pi % QCH; const size_t ro = (size_t)(rowc_ + (dir ? -r : r)) * ldq + ch * 8; \
                rq[n] = *(const v4u*)(qb + ro); rk[n] = *(const v4u*)(kb + ro); if (GLA) rk2[n] = *(const v4u*)(k2b + ro); } \
            if (tid < 64 * VCH) { const int r = tid / VCH, ch = tid % VCH; rv = *(const v4u*)(vb + (size_t)(rowc_ + (dir ? -r : r)) * ldv + ch * 8); } \
            if (GLA && tid < DK) peb = EB[(((size_t)dir * NB + b) * 68 + (c)) * (4 * DK) + h * DK + tid]; } while (0)
        REC_LOAD(0);
        for (int c = 0; c < 68; ++c) {
#pragma unroll
            for (int n = 0; n < QN; ++n) { const int pi = tid + NTHR * n, r = pi / QCH, ch = pi % QCH;
                *(LAS v4u*)(F.lds + O_QD + r * SQ + ch * 16) = rq[n]; *(LAS v4u*)(F.lds + O_KI + r * SQ + ch * 16) = rk[n];
                if (GLA) *(LAS v4u*)(F.lds + O_KS + r * SQ + ch * 16) = rk2[n]; }
            if (tid < 64 * VCH) { const int r = tid / VCH, ch = tid % VCH;
                if (INTRA) *(LAS v4u*)(F.lds + O_V + r * SV + ch * 16) = rv;
                if (!GLA) *(LAS v4u*)(F.lds + O_VD + r * SV + ch * 16) = scale8(rv, __builtin_amdgcn_exp2f(lg2 * (float)(63 - r))); }
            if (GLA && tid < DK) ((LAS float*)(F.lds + O_EB))[tid] = peb;
            if (c + 1 < 68) REC_LOAD(c + 1);
            __syncthreads();
            if constexpr (INTRA) {
#pragma unroll
            for (int q2 = 0; q2 < 2; ++q2) { const int jt = 2 * vg + q2; f32x4 acc = (f32x4){0.f, 0.f, 0.f, 0.f};
                if (jt <= it) {
#pragma unroll
                    for (int ks = 0; ks < KSTEPS; ++ks) acc = MFMA16(frag_n(L + O_KI, SQ, 16 * jt, 32 * ks, lane), frag_n(L + O_QD, SQ, 16 * it, 32 * ks, lane), acc);
                    const int i = 16 * it + l15;
#pragma unroll
                    for (int r = 0; r < 4; ++r) { const int j = 16 * jt + 4 * g4 + r; float vv = (j <= i) ? acc[r] : 0.f; if (!GLA) vv *= __builtin_amdgcn_exp2f(lg2 * (float)(i - j)); acc[r] = vv; }
                }
                v2u pw; pw.x = pk2(acc[0], acc[1]); pw.y = pk2(acc[2], acc[3]);
                *(LAS v2u*)(F.lds + O_P + (16 * it + l15) * SP + (16 * jt + 4 * g4) * 2) = pw; }
            }
            f32x4 oacc[VT_PER];
            const bool need_o = INTRA || orow0 == 0 || c >= 4;
#pragma unroll
            for (int a = 0; a < VT_PER; ++a) { oacc[a] = (f32x4){0.f, 0.f, 0.f, 0.f};
                if (need_o)
#pragma unroll
                for (int ks = 0; ks < KSTEPS; ++ks) oacc[a] = MFMA16(frag_n(L + O_ST, SS, 16 * (vg * VT_PER + a), 32 * ks, lane), frag_n(L + O_QD, SQ, 16 * it, 32 * ks, lane), oacc[a]);
                if (!GLA) oacc[a] *= __builtin_amdgcn_exp2f(lg2 * (float)(16 * it + l15 + 1)); }
            if constexpr (INTRA) __syncthreads();
            { const int row = seq_row(b, dir, 64 * c + 16 * it + l15);
#pragma unroll
              for (int a = 0; a < VT_PER; ++a) { const int vt = vg * VT_PER + a;
                if constexpr (INTRA) {
#pragma unroll
                for (int js = 0; js < 2; ++js) oacc[a] = MFMA16(frag_t(L + O_V, SV, 32 * js, 16 * vt, lane), frag_n(L + O_P, SP, 16 * it, 32 * js, lane), oacc[a]); }
                if (row >= orow0) { v2u ow; ow.x = pk2(oacc[a][0], oacc[a][1]); ow.y = pk2(oacc[a][2], oacc[a][3]);
                    *(GAS v2u*)(O + (size_t)dir * odir_stride + (size_t)(row - orow0) * ldo + h * DV + vs * DVS + 16 * vt + 4 * g4) = ow; } } }
            { bfx8 fv[VT_PER][2];
#pragma unroll
              for (int a = 0; a < VT_PER; ++a)
#pragma unroll
                for (int js = 0; js < 2; ++js) fv[a][js] = frag_t(L + (GLA ? O_V : O_VD), SV, 32 * js, 16 * (vg * VT_PER + a), lane);
              const float g64 = GLA ? 1.0f : __builtin_amdgcn_exp2f(lg2 * 64.0f);
#pragma unroll
              for (int c2 = 0; c2 < KT_PER; ++c2) { const int kt = kg * KT_PER + c2;
                const bfx8 fk0 = frag_t(L + (GLA ? O_KS : O_KI), SQ, 0, 16 * kt, lane), fk1 = frag_t(L + (GLA ? O_KS : O_KI), SQ, 32, 16 * kt, lane);
                f32x4 sc4 = (f32x4){g64, g64, g64, g64};
                if (GLA) sc4 = *(const LAS f32x4*)(L + O_EB + (16 * kt + 4 * g4) * 4);
#pragma unroll
                for (int a = 0; a < VT_PER; ++a) { f32x4 s = Sacc[a][c2] * sc4;
                    s = MFMA16(fk0, fv[a][0], s); s = MFMA16(fk1, fv[a][1], s); Sacc[a][c2] = s;
                    if constexpr (INTRA) { v2u sw; sw.x = pk2(s[0], s[1]); sw.y = pk2(s[2], s[3]);
                        *(LAS v2u*)(F.lds + O_ST + (16 * (vg * VT_PER + a) + l15) * SS + (16 * kt + 4 * g4) * 2) = sw; } } } }
            __syncthreads();
            if constexpr (!INTRA) {
#pragma unroll
              for (int c2 = 0; c2 < KT_PER; ++c2)
#pragma unroll
                for (int a = 0; a < VT_PER; ++a) { const f32x4 s = Sacc[a][c2]; v2u sw; sw.x = pk2(s[0], s[1]); sw.y = pk2(s[2], s[3]);
                    *(LAS v2u*)(F.lds + O_ST + (16 * (vg * VT_PER + a) + l15) * SS + (16 * (kg * KT_PER + c2) + 4 * g4) * 2) = sw; } }
        }
#undef REC_LOAD
    }
}
__device__ __forceinline__ void p_gla_prep(Frame& F, const bf16* P, bf16* QD, bf16* KI, bf16* KS, float* EB) {
    const KA A = ka_fresh();
    const int tid = F.tid;
    LAS float* lb = (LAS float*)F.lds;
    LAS float* wal = (LAS float*)(F.lds + 66560);
    LAS float* tot = (LAS float*)(F.lds + 66560 + 17408);
    constexpr int LBS = 260;
    int cur_dir = -1;
    for (int item = F.vcu; item < 2 * NB * 68; item += F.G) {
        const int c = item % 68, b = (item / 68) % NB, dir = item / (68 * NB);
        if (dir != cur_dir) { __syncthreads();
            for (int i = tid; i < 16 * 256; i += NTHR) wal[i] = A.I(I_GLAWA)[dir * 4096 + i];
            if (tid < 256) wal[4096 + tid] = A.I(I_GLABA)[dir * 256 + tid];
            cur_dir = dir; __syncthreads(); }
        const int t = tid >> 3, cg = tid & 7, row = seq_row(b, dir, 64 * c + t);
        {
            float lw[16]; { float f0[8], f1[8]; unpack8(*(const v4u*)(P + (size_t)row * N0 + C0_LOW + dir * 16), f0); unpack8(*(const v4u*)(P + (size_t)row * N0 + C0_LOW + dir * 16 + 8), f1);
#pragma unroll
                for (int j = 0; j < 8; ++j) { lw[j] = f0[j]; lw[8 + j] = f1[j]; } }
#pragma unroll
            for (int q = 0; q < 8; ++q) { const int col = cg * 32 + q * 4;
                f32x4 z = *(const LAS f32x4*)(wal + 4096 + col);
#pragma unroll
                for (int r = 0; r < 16; ++r) z += *(const LAS f32x4*)(wal + r * 256 + col) * lw[r];
                f32x4 o;
#pragma unroll
                for (int j = 0; j < 4; ++j) o[j] = (fminf(z[j], 0.f) - __logf(1.0f + __expf(-fabsf(z[j])))) * (1.0f / 16.0f);
                *(LAS f32x4*)(lb + t * LBS + col) = o; }
        }
        __syncthreads();
        {
            const int col = tid & 255, half = tid >> 8; float run = 0.f;
#pragma unroll 8
            for (int i = 0; i < 32; ++i) { run += lb[(32 * half + i) * LBS + col]; lb[(32 * half + i) * LBS + col] = run; }
            if (half == 0) tot[col] = run;
            __syncthreads();
            if (half == 1) { const float off = tot[col];
#pragma unroll 8
                for (int i = 32; i < 64; ++i) lb[i * LBS + col] += off; }
        }
        __syncthreads();
        {
#pragma unroll
            for (int q = 0; q < 4; ++q) { const int col = cg * 32 + q * 8;
                float qf[8], kf[8], o1[8], o2[8], o3[8];
                unpack8(*(const v4u*)(P + (size_t)row * N0 + C0_Q + col), qf); unpack8(*(const v4u*)(P + (size_t)row * N0 + C0_K + col), kf);
#pragma unroll
                for (int j = 0; j < 8; ++j) { const float bt = lb[t * LBS + col + j], bl = lb[63 * LBS + col + j]; const float eb = __expf(bt);
                    o1[j] = qf[j] * eb; o2[j] = kf[j] * __expf(-bt); o3[j] = kf[j] * __expf(bl - bt); }
                const size_t o = ((size_t)dir * MALL + row) * 256 + col;
                *(GAS v4u*)(QD + o) = pack8(o1); *(GAS v4u*)(KI + o) = pack8(o2); *(GAS v4u*)(KS + o) = pack8(o3); }
            if (tid < 256) EB[(((size_t)dir * NB + b) * 68 + c) * 256 + tid] = __expf(lb[63 * LBS + tid]);
        }
        __syncthreads();
    }
}
__device__ __forceinline__ void p_ret_intra_finish(Frame& F) {
    const KA A = ka_fresh();
    constexpr int SQ = 528, SP = 144, SV = 1040, O_Q = 0, O_K = 33792, O_V = 0, O_P = 67584, O_RED = O_P + 64 * SP;
    static_assert(64 * SV <= O_P && O_RED + 2 * 64 * 8 <= RING_BYTES, "LDS map");
    unsigned char* ws = A.WS();
    const bf16* P = (const bf16*)(ws + WS_PROJ); const bf16* RO = (const bf16*)(ws + WS_OREC); bf16* MIX = (bf16*)(ws + WS_MIX);
    const LAS unsigned char* L = F.lds;
    const int tid = F.tid, lane = F.lane, w = F.wave, it = w & 3, vg = w >> 2, g4 = lane >> 4, l15 = lane & 15;
    v4u rq[4], rk[4];
#define RIF_LOADQK(u_) do { const int h_ = (u_) & 3, n_ = ((u_) >> 2) & 63, b_ = (u_) >> 8; const size_t p0_ = (size_t)(NCTX + b_ * SEQ + 64 * n_) * N1; \
        _Pragma("unroll") for (int q = 0; q < 4; ++q) { const int pi = tid + NTHR * q, r = pi >> 5, ch = pi & 31; const size_t ro = p0_ + (size_t)r * N1 + h_ * 256 + ch * 8; rq[q] = *(const v4u*)(P + ro + C1_Q); rk[q] = *(const v4u*)(P + ro + C1_K); } } while (0)
    if (F.vcu < NB * 64 * 4) RIF_LOADQK(F.vcu);
    for (int unit = F.vcu; unit < NB * 64 * 4; unit += F.G) {
        const int h = unit & 3, n = (unit >> 2) & 63, b = unit >> 8;
        const int lrow0 = b * SEQ + 64 * n; const size_t prow0 = (size_t)(NCTX + lrow0) * N1;
        const float lgf = -log2f(1.0f + expf(-A.I(I_RETDEC)[h])), lgb = -log2f(1.0f + expf(-A.I(I_RETDEC)[4 + h]));
#pragma unroll
        for (int q = 0; q < 4; ++q) { const int pi = tid + NTHR * q, r = pi >> 5, ch = pi & 31; *(LAS v4u*)(F.lds + O_Q + r * SQ + ch * 16) = rq[q]; *(LAS v4u*)(F.lds + O_K + r * SQ + ch * 16) = rk[q]; }
        v4u rv[8];
#pragma unroll
        for (int q = 0; q < 8; ++q) { const int pi = tid + NTHR * q, r = pi >> 6, ch = pi & 63; rv[q] = *(const v4u*)(P + prow0 + (size_t)r * N1 + C1_V + h * 512 + ch * 8); }
        __syncthreads();
#pragma unroll
        for (int q2 = 0; q2 < 2; ++q2) { const int jt = 2 * vg + q2; f32x4 acc = (f32x4){0.f, 0.f, 0.f, 0.f};
#pragma unroll
            for (int ks = 0; ks < 8; ++ks) acc = MFMA16(frag_n(L + O_K, SQ, 16 * jt, 32 * ks, lane), frag_n(L + O_Q, SQ, 16 * it, 32 * ks, lane), acc);
            const int i = 16 * it + l15;
#pragma unroll
            for (int r = 0; r < 4; ++r) { const int j = 16 * jt + 4 * g4 + r; const float m = (j <= i ? exp2f(lgf * (float)(i - j)) : 0.f) + (j >= i ? exp2f(lgb * (float)(j - i)) : 0.f); acc[r] *= m; }
            v2u pw; pw.x = pk2(acc[0], acc[1]); pw.y = pk2(acc[2], acc[3]);
            *(LAS v2u*)(F.lds + O_P + (16 * it + l15) * SP + (16 * jt + 4 * g4) * 2) = pw; }
        __syncthreads();
        if (unit + F.G < NB * 64 * 4) RIF_LOADQK(unit + F.G);
#pragma unroll
        for (int q = 0; q < 8; ++q) { const int pi = tid + NTHR * q, r = pi >> 6, ch = pi & 63; *(LAS v4u*)(F.lds + O_V + r * SV + ch * 16) = rv[q]; }
        const int lrow = lrow0 + 16 * it + l15;
        v2u oi[2][16];
#pragma unroll
        for (int d = 0; d < 2; ++d)
#pragma unroll
            for (int a = 0; a < 16; ++a) oi[d][a] = *(const v2u*)(RO + ((size_t)d * NLAT + lrow) * 2048 + h * 512 + 16 * (16 * vg + a) + 4 * g4);
        __syncthreads();
        f32x4 oacc[16];
#pragma unroll
        for (int a = 0; a < 16; ++a) oacc[a] = (f32x4){0.f, 0.f, 0.f, 0.f};
#pragma unroll
        for (int js = 0; js < 2; ++js) { const bfx8 pf = frag_n(L + O_P, SP, 16 * it, 32 * js, lane);
#pragma unroll
            for (int a = 0; a < 16; ++a) oacc[a] = MFMA16(frag_t(L + O_V, SV, 32 * js, 16 * (16 * vg + a), lane), pf, oacc[a]); }
        float s1 = 0.f, s2 = 0.f;
#pragma unroll
        for (int a = 0; a < 16; ++a) { oacc[a] += (f32x4){blo(oi[0][a].x) + blo(oi[1][a].x), bhi(oi[0][a].x) + bhi(oi[1][a].x), blo(oi[0][a].y) + blo(oi[1][a].y), bhi(oi[0][a].y) + bhi(oi[1][a].y)};
#pragma unroll
            for (int r = 0; r < 4; ++r) { s1 += oacc[a][r]; s2 += oacc[a][r] * oacc[a][r]; } }
        s1 += __shfl_xor(s1, 16); s2 += __shfl_xor(s2, 16); s1 += __shfl_xor(s1, 32); s2 += __shfl_xor(s2, 32);
        LAS float* red = (LAS float*)(F.lds + O_RED);
        if (g4 == 0) { red[(vg * 64 + 16 * it + l15) * 2] = s1; red[(vg * 64 + 16 * it + l15) * 2 + 1] = s2; }
        __syncthreads();
        { const float t1 = red[(16 * it + l15) * 2] + red[(64 + 16 * it + l15) * 2], t2 = red[(16 * it + l15) * 2 + 1] + red[(64 + 16 * it + l15) * 2 + 1];
          const float mu = t1 * (1.0f / 512.0f), var = fmaxf(t2 * (1.0f / 512.0f) - mu * mu, 0.f), rstd = rsqrtf(var + EPS);
          const bf16* gp = P + (size_t)(NCTX + lrow) * N1 + C1_G + h * 512; const float* ngp = A.I(I_RETNG) + h * 512; bf16* op = MIX + (size_t)lrow * 2048 + h * 512;
#pragma unroll
          for (int a = 0; a < 16; ++a) { const int v0 = 16 * (16 * vg + a) + 4 * g4; const v2u gw = *(const v2u*)(gp + v0); const f32x4 ng = *(const f32x4*)(ngp + v0);
              const float r0 = (oacc[a][0] - mu) * rstd * ng[0] * silu_(blo(gw.x)), r1 = (oacc[a][1] - mu) * rstd * ng[1] * silu_(bhi(gw.x)), r2 = (oacc[a][2] - mu) * rstd * ng[2] * silu_(blo(gw.y)), r3 = (oacc[a][3] - mu) * rstd * ng[3] * silu_(bhi(gw.y));
              v2u ow; ow.x = pk2(r0, r1); ow.y = pk2(r2, r3); *(GAS v2u*)(op + v0) = ow; } }
        __syncthreads();
    }
}
#undef RIF_LOADQK
#ifndef MK_ONLY
#define MK_ONLY -1
#endif
#define SON(s) (MK_ONLY < 0 || MK_ONLY == (s))
#define IN(k) (lo <= (k) && (k) < hi)
#ifndef MK_PROBE
#define MK_PROBE -1
#endif
#ifndef MK_REP
#define MK_REP -1
#endif
#define REPS(s) for (int _rep = 0; _rep < ((MK_REP == (s)) ? 2 : 1); ++_rep)
#define STAMP(k) do { if (MK_PROBE >= 0 && blockIdx.x == 0 && F.tid == 0) { const unsigned long long _t = wall_clock64(); __hip_atomic_store(F.ctl + 20000 + 2 * (k), (unsigned)_t, RLX_AGENT); __hip_atomic_store(F.ctl + 20001 + 2 * (k), (unsigned)(_t >> 32), RLX_AGENT); } } while (0)
#define SEAM(k) do { if (IN(k) && IN((k) + 1)) { xcd_barrier(bar); STAMP((k) + 1); } } while (0)
template <int layer>
__device__ __forceinline__ void layer_body(Frame& F, const int lo, const int hi, const XcdBarrier& bar) {
    unsigned char* const ws = ka_fresh().WS();
    bf16* const H = (bf16*)(ws + WS_H);
    bf16* const PROJ = (bf16*)(ws + WS_PROJ);
    float* const XRES = (float*)(ws + WS_XRES);
    float* const MOD = (float*)(ws + WS_MOD);

        const int pb = layer ? PH_INPROJ1 : PH_INPROJ0;
        if (SON(2) && IN(pb)) {
            pg8::Gemm g{H, (const bf16*)(ws + (layer ? WS_WIN1T : WS_WIN0T)), MALL, layer ? N1 : N0, 1024, 1024};
            pg8::StaticOrder S; S.init(g.M, g.N, F.G, (int)blockIdx.x);
            if constexpr (layer == 0 && !MK_NAIVE_S5) { pg8::EpiStoreU E{PROJ, g.N, (bf16*)(ws + WS_A2)};
                pg8::gemm_phase<pg8::EpiStoreU, pg8::StaticOrder, true, true>(F.lds, g, S, E); }
            else { pg8::EpiStore E{PROJ, g.N};
                pg8::gemm_phase<pg8::EpiStore, pg8::StaticOrder, true, true>(F.lds, g, S, E); }
        }
        SEAM(pb);
        if (layer == 0) {
#if MK_NAIVE_GLA
            SEAM(PH_GLAPREP);
            if (SON(3) && IN(PH_GLA)) rec_naive<64, true>(F, PROJ, N0, C0_Q, C0_K, C0_V, 128, 2, (float*)(ws + WS_OREC), (size_t)MALL * 512, 512, 0);
#else
            bf16* const GQD = (bf16*)(ws + WS_OREC + 280 * MiB); bf16* const GKI = GQD + (size_t)2 * MALL * 256; bf16* const GKS = GKI + (size_t)2 * MALL * 256; float* const GEB = (float*)(ws + WS_OREC + 384 * MiB);
            if (SON(13) && IN(PH_GLAPREP)) REPS(13) p_gla_prep(F, PROJ, GQD, GKI, GKS, GEB);
#if !MK_NAIVE_S5
            if (SON(17) && IN(PH_GLAPREP)) {
                __syncthreads();
                pg8::Gemm g{(const bf16*)(ws + WS_A2), (const bf16*)(ws + WS_S5W1), 32 * S5_ROWS, 256, 256, 512};
                pg8::GroupOrder S{9, 288, F.G, F.vcu};
                pg8::EpiF32Plain E{(float*)(ws + WS_SLOC)};
                pg8::gemm_phase<pg8::EpiF32Plain, pg8::GroupOrder, true, true>(F.lds, g, S, E);
            }
#endif
            SEAM(PH_GLAPREP);
#if !MK_NAIVE_S5
            if (SON(18) && IN(PH_GLA)) { p_s5_scan(F, (const float*)(ws + WS_SLOC), (bf16*)(ws + WS_A2)); __syncthreads(); }
#endif
            if (SON(3) && IN(PH_GLA)) REPS(3) rec_mfma<64, 32, true>(F, GQD, GKI, GKS, (size_t)MALL * 256, 256, 0, 0, PROJ, N0, C0_V, 128, GEB, (bf16*)(ws + WS_OREC), (size_t)MALL * 512, 512, 0);
#endif
            SEAM(PH_GLA);
#if MK_NAIVE_S5
            if (SON(4) && IN(PH_S5)) s5_naive(F, PROJ, (float*)(ws + WS_OREC) + (size_t)2 * MALL * 512);
#else
            if (SON(4) && IN(PH_S5)) {
                pg8::Gemm g{(const bf16*)(ws + WS_A2), (const bf16*)(ws + WS_S5W2), 32 * S5_ROWS, 256, 512, 512};
                pg8::GroupOrder S{9, 288, F.G, F.vcu};
                pg8::EpiS5Out E{(const bf16*)(ws + WS_A2), (bf16*)(ws + WS_YPRE), ka_fresh().I(I_S5D)};
                pg8::gemm_phase<pg8::EpiS5Out, pg8::GroupOrder, true, true>(F.lds, g, S, E);
            }
#endif
            if (SON(5) && IN(PH_FIN0)) REPS(5) p_finish0(F);
            SEAM(PH_FIN0);
            if (SON(6) && IN(PH_GLU)) {
                pg8::Gemm g{(const bf16*)(ws + WS_YPRE), (const bf16*)(ws + WS_WGLUT), MALL, 512, 512, 512};
                pg8::StaticOrder S; S.init(g.M, g.N, F.G, (int)blockIdx.x);
                pg8::EpiGlu E{(const bf16*)(ws + WS_YPRE), (bf16*)(ws + WS_MIX), 1024, 512, ka_fresh().I(I_GLUB)};
                pg8::gemm_phase<pg8::EpiGlu, pg8::StaticOrder, true, true>(F.lds, g, S, E);
            }
            SEAM(PH_GLU);
        } else {
            if (SON(14) && IN(PH_ROPE)) p_rope(F);
            SEAM(PH_ROPE);
#if MK_NAIVE_RET
            if (SON(15) && IN(PH_RET)) rec_naive<256, false>(F, PROJ, N1, C1_Q, C1_K, C1_V, 512, 8, (float*)(ws + WS_OREC), (size_t)NLAT * 2048, 2048, NCTX);
#else
            if (SON(15) && IN(PH_RET)) REPS(15) rec_mfma<256, 64, false, false>(F, PROJ, PROJ, PROJ, 0, N1, C1_Q, C1_K, PROJ, N1, C1_V, 512, nullptr, (bf16*)(ws + WS_OREC), (size_t)NLAT * 2048, 2048, NCTX);
#endif
            SEAM(PH_RET);
            #if MK_NAIVE_RET
            if (SON(16) && IN(PH_FIN1)) p_finish1(F);
#else
            if (SON(16) && IN(PH_FIN1)) REPS(16) p_ret_intra_finish(F);
#endif
            SEAM(PH_FIN1);
        }
        const int po = layer ? PH_OUT1 : PH_OUT0;
        if (SON(7) && IN(po)) {
            pg8::Gemm g{(const bf16*)(ws + WS_MIX), (const bf16*)(ws + (layer ? WS_WOUT1T : WS_WOUT0T)), layer ? NLAT : MALL, 1024, layer ? 2048 : 1024, layer ? 2048 : 1024};
            pg8::StaticOrder S; S.init(g.M, g.N, F.G, (int)blockIdx.x);
            pg8::EpiResid<layer == 0> E{ka_fresh().I(I_CTX), ka_fresh().I(I_X), (bf16*)XRES, MOD + (size_t)layer * 9 * 6144 + 2048, layer ? 8 : 0};
            pg8::gemm_phase<pg8::EpiResid<layer == 0>, pg8::StaticOrder, true, true>(F.lds, g, S, E);
        }
        SEAM(po);
        if (SON(8) && IN(po + 1)) p_router(F, layer);
        SEAM(po + 1);
        if (SON(10) && IN(po + 3)) {
            const int nt = moe_tables(F, layer);
            pg8::Gemm g{H, (const bf16*)(ws + WS_WGUT) + (size_t)layer * 32 * 2048 * 1024, nt * 256, 2048, 1024, 1024};
            pg8::MoeOrder S{(const PG8_LAS unsigned char*)(F.lds + L_TILEE), nt, 8, F.G, F.vcu, (const int*)(ws + WS_ELIST), (const PG8_LAS int*)(F.lds + L_TPOS), (const PG8_LAS int*)(F.lds + L_TCNT), layer ? NCTX : 0};
            pg8::EpiSwiglu E{(bf16*)(ws + WS_ACT), ka_fresh().I(I_BGU) + (size_t)layer * 32 * 2048};
            REPS(10) { pg8::gemm_phase<pg8::EpiSwiglu, pg8::MoeOrder, true, true, true>(F.lds, g, S, E); __syncthreads(); }
        }
        SEAM(po + 3);
        if (SON(11) && IN(po + 4)) {
            const int nt = moe_tables(F, layer);
            pg8::Gemm g{(const bf16*)(ws + WS_ACT), (const bf16*)(ws + WS_WDNT) + (size_t)layer * 32 * 1024 * 1024, nt * 256, 1024, 1024, 1024};
            pg8::MoeOrder S{(const PG8_LAS unsigned char*)(F.lds + L_TILEE), nt, 4, F.G, F.vcu, (const int*)(ws + WS_ELIST), (const PG8_LAS int*)(F.lds + L_TPOS), (const PG8_LAS int*)(F.lds + L_TCNT), 0};
            pg8::EpiDown E{(bf16*)(ws + WS_YSLOT), (const int*)(ws + WS_ELIST), (const PG8_LAS int*)(F.lds + L_TPOS), (const PG8_LAS int*)(F.lds + L_TCNT), (const float*)(ws + WS_WSLOT), ka_fresh().I(I_BDN) + (size_t)layer * 32 * 1024};
            REPS(11) { pg8::gemm_phase<pg8::EpiDown, pg8::MoeOrder, true, true>(F.lds, g, S, E); __syncthreads(); }
        }
        SEAM(po + 4);
        if (SON(12) && IN(po + 5)) {
#if MK_REP == 12
            p_combine(F, layer, true);
#endif
            p_combine(F, layer, false); }
        SEAM(po + 5);
    }
__global__ void __launch_bounds__(NTHR, 2) mk_fwd(Args) {
    extern __shared__ __attribute__((aligned(16))) unsigned char lds[];
    Frame F;
    F.lds = (LAS unsigned char*)lds;
    F.MISC = (volatile LAS unsigned*)(F.lds + L_MISC);
    F.tid = threadIdx.x; F.lane = F.tid & 63; F.wave = __builtin_amdgcn_readfirstlane(F.tid >> 6);
    F.G = gridDim.x; { const int bx = blockIdx.x; F.vcu = (F.G % 8 == 0) ? (bx % 8) * (F.G / 8) + bx / 8 : bx; }
    const KA A0 = ka_fresh();
    unsigned char* ws = A0.WS();
    F.ctl = (unsigned*)(ws + WS_CTL);
    if (F.tid < 64) F.MISC[F.tid] = 0u;
    __syncthreads();
    const int lo = A0.LO(), hi = A0.HI();
    XcdBarrier bar; bar.bar = F.ctl + CW_BAR; bar.x = 0; bar.st = nullptr;
    if (hi - lo > 1) bar = xcd_barrier_post(F.ctl + CW_BAR, F.MISC + 8);

    STAMP(0);
    if (SON(0) && IN(0)) { REPS(0) { p0_prologue(F); __syncthreads(); } } SEAM(0);
    if (SON(1) && IN(1)) { REPS(1) p_norm1_l0(F); } SEAM(1);
    layer_body<0>(F, lo, hi, bar);
    layer_body<1>(F, lo, hi, bar);
}

#ifndef MK_MULTI
#define MK_MULTI 0
#endif
extern "C" void kernel_launch(void* const* d_in, const int* in_sizes, int n_in, void* d_out, int out_size, void* d_ws, size_t ws_size, hipStream_t stream) {
    static int grid = 0;
    if (grid == 0) {
        if (n_in != 34 || out_size != NLAT * D || ws_size < WS_END) { fprintf(stderr, "kernel_launch: unexpected sizes: n_in %d out %d ws %zu (need %zu)\n", n_in, out_size, ws_size, (size_t)WS_END); grid = -1; return; }
        int dev = 0, cus = 0;
        if (hipGetDevice(&dev) != hipSuccess || hipDeviceGetAttribute(&cus, hipDeviceAttributeMultiprocessorCount, dev) != hipSuccess) { grid = -1; return; }
        if (hipFuncSetAttribute((const void*)mk_fwd, hipFuncAttributeMaxDynamicSharedMemorySize, LDS_BYTES) != hipSuccess) { fprintf(stderr, "kernel_launch: hipFuncSetAttribute failed\n"); grid = -1; return; }
        int per_cu = 0;
        if (hipOccupancyMaxActiveBlocksPerMultiprocessor(&per_cu, (const void*)mk_fwd, NTHR, LDS_BYTES) != hipSuccess || per_cu < 1) fprintf(stderr, "kernel_launch: occupancy query says %d\n", per_cu);
        (void)hipGetLastError();
        grid = cus;
    }
    if (grid < 0) return;
    (void)in_sizes;
    (void)hipMemsetAsync((char*)d_ws + WS_CTL, 0, CTL_ZERO_BYTES, stream);
    Args a{};
    for (int i = 0; i < 34; ++i) a.in[i] = (const float*)d_in[i];
    a.out = (float*)d_out; a.ws = (unsigned char*)d_ws;
#if MK_MULTI
    for (int p = 0; p < NPH; ++p) { a.ph_lo = p; a.ph_hi = p + 1; hipLaunchKernelGGL(mk_fwd, dim3(grid), dim3(NTHR), LDS_BYTES, stream, a); }
#else
    a.ph_lo = 0; a.ph_hi = NPH; hipLaunchKernelGGL(mk_fwd, dim3(grid), dim3(NTHR), LDS_BYTES, stream, a);
#endif
}
```
